# Optimizing an MI355X kernel written in HIP

```python
import math
import jax, jax.numpy as jnp
from jax import lax
import numpy as np

D_MODEL = 1024
BATCH = 8
SEQ = 4096
DEPTH = 2

GRID_W = 64
CONV_W = 256
RWKV_HEADS = 4
RWKV_HEAD_DIM = 64
RWKV_W = RWKV_HEADS * RWKV_HEAD_DIM
DECAY_RANK = 16
ICLR_RANK = 16
GATE_RANK = 32
DECAY_SCALE = math.exp(-0.5)
GN_EPS = 64e-5
NA_HEADS = 4
NA_HEAD_DIM = 64
NA_W = NA_HEADS * NA_HEAD_DIM
NA_KH = 8
NA_KW = 16
SGU_HEADS = 4
SGU_HEAD_DIM = 64
SGU_W = SGU_HEADS * SGU_HEAD_DIM
SGU_CHUNK = 128
N_GROUPS = 4
GROUP_W = 256
D_MIX = CONV_W + RWKV_W + NA_W + SGU_W
D_FF = 2816
NORM_EPS = 1e-6
IN_SPLITS = (CONV_W, CONV_W, CONV_W,
             RWKV_W, RWKV_W, RWKV_W,
             DECAY_RANK, DECAY_RANK, ICLR_RANK, ICLR_RANK,
             GATE_RANK,
             NA_W, NA_W, NA_W,
             SGU_W, SGU_W)
D_IN_PROJ = sum(IN_SPLITS)

kernel_name = "hybrid_parallel_heads_encoder"


def rms_norm(x, g):
    x32 = x.astype(jnp.float32)
    y = x32 * lax.rsqrt(jnp.mean(x32 * x32, axis=-1, keepdims=True) + NORM_EPS)
    return (y * g).astype(x.dtype)


def dwconv3(x, w):
    xp = jnp.pad(x, ((0, 0), (1, 1), (0, 0)))
    return xp[:, :-2] * w[0] + xp[:, 1:-1] * w[1] + xp[:, 2:] * w[2]


def wkv7_scan(r, w, k, v, kk, a, reverse):
    B, T, H, dh = r.shape

    def step(S, inp):
        r_t, w_t, k_t, v_t, kk_t, a_t = inp
        sa = jnp.einsum('bhvk,bhk->bhv', S, -kk_t)
        S = (S * w_t[:, :, None, :]
             + sa[..., None] * (kk_t * a_t)[:, :, None, :]
             + v_t[..., None] * k_t[:, :, None, :])
        return S, jnp.einsum('bhvk,bhk->bhv', S, r_t)

    xs = (jnp.swapaxes(r, 0, 1), jnp.swapaxes(w, 0, 1), jnp.swapaxes(k, 0, 1),
          jnp.swapaxes(v, 0, 1), jnp.swapaxes(kk, 0, 1), jnp.swapaxes(a, 0, 1))
    S0 = jnp.zeros((B, H, dh, dh), jnp.float32)
    _, ys = lax.scan(step, S0, xs, reverse=reverse)
    return jnp.swapaxes(ys, 0, 1)


def rwkv7_mix(r, k, v, dec_f, dec_b, iclr_f, iclr_b, g_dn,
              w0, w_up, a0, a_up, g_up, k_k, k_a, r_k, lnx_w, lnx_b):
    dt = r.dtype
    B, T, _ = r.shape
    f = lambda t: t.astype(jnp.float32)
    heads = lambda t: t.reshape(B, T, RWKV_HEADS, RWKV_HEAD_DIM)
    r, k, v = f(r), f(k), f(v)
    rh, kh, vh = heads(r), heads(k), heads(v)
    kk = heads(k * f(k_k))
    kk = kk * lax.rsqrt(jnp.sum(kk * kk, axis=-1, keepdims=True) + 1e-12)
    g = jax.nn.sigmoid(f(g_dn)) @ f(g_up)
    y = jnp.zeros_like(rh)
    for d, (dn_w, dn_a) in enumerate(((dec_f, iclr_f), (dec_b, iclr_b))):
        log_w = -DECAY_SCALE * jax.nn.sigmoid(f(w0[d]) + jnp.tanh(f(dn_w)) @ f(w_up[d]))
        a = jax.nn.sigmoid(f(a0[d]) + f(dn_a) @ f(a_up[d]))
        k_eff = k * (1.0 + (a - 1.0) * f(k_a))
        y = y + wkv7_scan(rh, heads(jnp.exp(log_w)), heads(k_eff), vh, kk, heads(a),
                          reverse=(d == 1))
    mu = jnp.mean(y, axis=-1, keepdims=True)
    var = jnp.mean(jnp.square(y - mu), axis=-1, keepdims=True)
    y = ((y - mu) * lax.rsqrt(var + GN_EPS)).reshape(B, T, RWKV_W) * f(lnx_w) + f(lnx_b)
    bonus = (jnp.sum(rh * kh * f(r_k), axis=-1, keepdims=True) * vh).reshape(B, T, RWKV_W)
    return ((y + bonus) * g).astype(dt)


def neighborhood_attention(q, k, v, rpb):
    B, T, _ = q.shape
    rows = T // GRID_W
    kh = min(NA_KH, rows)
    grid = lambda t: t.reshape(B, rows, GRID_W, NA_HEADS, NA_HEAD_DIM)
    qg = grid(q) * (NA_HEAD_DIM ** -0.5)
    kg, vg = grid(k), grid(v)
    r = jnp.arange(rows)
    row_start = jnp.clip(r - kh // 2, 0, rows - kh)
    row_idx = row_start[:, None] + jnp.arange(kh)[None, :]
    k_band = kg[:, row_idx]
    v_band = vg[:, row_idx]
    s = jnp.einsum('brqhd,brkwhd->bhrqkw', qg, k_band).astype(jnp.float32)
    c = jnp.arange(GRID_W)
    col_start = jnp.clip(c - NA_KW // 2, 0, GRID_W - NA_KW)
    col_mask = (c[None, :] >= col_start[:, None]) & (c[None, :] < col_start[:, None] + NA_KW)
    dy = row_idx - r[:, None] + (NA_KH - 1)
    dx = jnp.clip(c[None, :] - c[:, None], -(NA_KW - 1), NA_KW - 1) + (NA_KW - 1)
    bias = rpb[:, dy[:, None, :, None], dx[None, :, None, :]]
    s = s + bias[None].astype(jnp.float32)
    s = jnp.where(col_mask[None, None, None, :, None, :], s, -1e30)
    p = jax.nn.softmax(s, axis=(-2, -1))
    o = jnp.einsum('bhrqkw,brkwhd->brqhd', p.astype(v.dtype), v_band)
    return o.reshape(B, T, NA_W)


def layer_norm(x, g):
    x32 = x.astype(jnp.float32)
    mu = jnp.mean(x32, axis=-1, keepdims=True)
    var = jnp.mean(jnp.square(x32 - mu), axis=-1, keepdims=True)
    return ((x32 - mu) * lax.rsqrt(var + NORM_EPS) * g).astype(x.dtype)


def spatial_gating(u, v, norm_w, w_s, b_s):
    B, T, _ = u.shape
    u = jax.nn.gelu(u)
    v = layer_norm(jax.nn.gelu(v), norm_w)
    vc = v.reshape(B, T // SGU_CHUNK, SGU_CHUNK, SGU_HEADS, SGU_HEAD_DIM)
    mixed = jnp.einsum('hpq,bnqhd->bnphd', w_s, vc) + jnp.swapaxes(b_s, 0, 1)[:, :, None]
    return u * mixed.reshape(B, T, SGU_W)


def setup_inputs(seed: int = 0) -> dict:
    key = jax.random.key(seed)
    ks = jax.random.split(key, 26)
    L = DEPTH
    nrm = lambda k, shape, scale: jax.random.normal(k, shape, jnp.float32) * scale
    gain = lambda k, shape, base=1.0: base + 0.05 * jax.random.normal(k, shape, jnp.float32)
    return {
        "x": nrm(ks[0], (BATCH, SEQ, D_MODEL), 1.0),
        "norm_mix_pre": gain(ks[1], (L, D_MODEL)),
        "norm_mix_post": gain(ks[2], (L, D_MODEL)),
        "norm_ffn_pre": gain(ks[3], (L, D_MODEL)),
        "norm_ffn_post": gain(ks[4], (L, D_MODEL)),
        "w_in": nrm(ks[5], (L, D_MODEL, D_IN_PROJ), D_MODEL ** -0.5),
        "conv_a_w": nrm(ks[6], (L, 3, CONV_W), 3 ** -0.5),
        "rwkv_w0": nrm(ks[7], (L, 2, RWKV_W), 0.5),
        "rwkv_w_up": nrm(ks[8], (L, 2, DECAY_RANK, RWKV_W), DECAY_RANK ** -0.5),
        "rwkv_a0": nrm(ks[9], (L, 2, RWKV_W), 0.5),
        "rwkv_a_up": nrm(ks[10], (L, 2, ICLR_RANK, RWKV_W), ICLR_RANK ** -0.5),
        "rwkv_g_up": nrm(ks[11], (L, GATE_RANK, RWKV_W), GATE_RANK ** -0.5),
        "rwkv_k_k": gain(ks[12], (L, RWKV_W), 0.85),
        "rwkv_k_a": gain(ks[13], (L, RWKV_W)),
        "rwkv_r_k": nrm(ks[14], (L, RWKV_HEADS, RWKV_HEAD_DIM), 0.1),
        "rwkv_lnx_w": gain(ks[15], (L, RWKV_W)),
        "rwkv_lnx_b": nrm(ks[16], (L, RWKV_W), 0.02),
        "na_rpb": nrm(ks[17], (L, NA_HEADS, 2 * NA_KH - 1, 2 * NA_KW - 1), 0.1),
        "sgu_norm": gain(ks[18], (L, SGU_W)),
        "sgu_w": nrm(ks[19], (L, SGU_HEADS, SGU_CHUNK, SGU_CHUNK), SGU_CHUNK ** -0.5),
        "sgu_b": gain(ks[20], (L, SGU_HEADS, SGU_CHUNK)),
        "merge_gain": gain(ks[21], (L, D_MIX)),
        "w_out": nrm(ks[22], (L, D_MIX, D_MODEL), D_MIX ** -0.5),
        "ffn_w_up": nrm(ks[23], (L, D_MODEL, 2 * D_FF), D_MODEL ** -0.5),
        "ffn_conv": nrm(ks[24], (L, 3, D_FF), 3 ** -0.5),
        "ffn_w_down": nrm(ks[25], (L, D_FF, D_MODEL), D_FF ** -0.5),
    }


def reference(x, norm_mix_pre, norm_mix_post, norm_ffn_pre, norm_ffn_post, w_in, conv_a_w,
              rwkv_w0, rwkv_w_up, rwkv_a0, rwkv_a_up, rwkv_g_up, rwkv_k_k, rwkv_k_a, rwkv_r_k,
              rwkv_lnx_w, rwkv_lnx_b, na_rpb, sgu_norm, sgu_w, sgu_b, merge_gain, w_out,
              ffn_w_up, ffn_conv, ffn_w_down):
    B, T, _ = x.shape
    split_points = np.cumsum(IN_SPLITS)[:-1].tolist()
    for l in range(DEPTH):
        h = rms_norm(x, norm_mix_pre[l])
        proj = h @ w_in[l]
        (c_h, c_b, c_c, r, k, v, dec_f, dec_b, iclr_f, iclr_b, g_dn,
         q_na, k_na, v_na, u_sg, v_sg) = jnp.split(proj, split_points, axis=-1)
        y_conv = c_b * dwconv3(c_c * c_h, conv_a_w[l])
        y_rwkv = rwkv7_mix(r, k, v, dec_f, dec_b, iclr_f, iclr_b, g_dn,
                           rwkv_w0[l], rwkv_w_up[l], rwkv_a0[l], rwkv_a_up[l], rwkv_g_up[l],
                           rwkv_k_k[l], rwkv_k_a[l], rwkv_r_k[l], rwkv_lnx_w[l], rwkv_lnx_b[l])
        y_na = neighborhood_attention(q_na, k_na, v_na, na_rpb[l])
        y_sgu = spatial_gating(u_sg, v_sg, sgu_norm[l], sgu_w[l], sgu_b[l])
        groups = jnp.stack([y_conv, y_rwkv, y_na, y_sgu], axis=2)
        merged = rms_norm(groups, 1.0).reshape(B, T, D_MIX) * merge_gain[l]
        x = x + rms_norm(merged @ w_out[l], norm_mix_post[l])
        h = rms_norm(x, norm_ffn_pre[l])
        gate, lin = jnp.split(h @ ffn_w_up[l], 2, axis=-1)
        hid = jax.nn.gelu(dwconv3(gate, ffn_conv[l])) * lin
        x = x + rms_norm(hid @ ffn_w_down[l], norm_ffn_post[l])
    return x
```

```cpp
#include <hip/hip_runtime.h>
#include <cstdio>
#include <cstdint>
namespace pg8 {
#define PG8_LAS __attribute__((address_space(3)))
typedef unsigned short bf16_t;
typedef short bf16x8 __attribute__((ext_vector_type(8)));
typedef float f32x4 __attribute__((ext_vector_type(4)));
typedef unsigned u32x4 __attribute__((ext_vector_type(4)));
constexpr int BM = 256, BK = 64, HALF = 128, HTB = HALF * BK * 2  , STAGE_BYTES = 8 * HTB, NXCD = 8, WGM = 8;

__host__ __device__ __forceinline__ int lds_byte(int r, int c) { const int st = (r >> 4) * 2 + (c >> 5), rr = r & 15, cc = c & 31, ob = rr * 64 + cc * 2; return st * 1024 + (ob ^ (((ob >> 9) & 1) << 5)); }
__host__ __device__ __forceinline__ void stage_rc(int b, int& R, int& C) { const int st = b / 1024, sb = b % 1024, swz = sb ^ (((sb >> 9) & 1) << 5); R = (st >> 1) * 16 + swz / 64; C = (st & 1) * 32 + (swz % 64) / 2; }
__host__ __device__ __forceinline__ int perm32(int rho) { const int n = rho >> 4, i = rho & 15; return 8 * (i >> 2) + 4 * n + (i & 3); }

struct Unit { int pm, pn; };
struct Gemm { const bf16_t* A; const bf16_t* Bt; int M, N, K; };

struct StaticOrder {
    int nM, nN, nwg, G, c;
    __host__ __device__ void init(int M, int N, int G_, int c_) { nM = M / BM; nN = N / BM; nwg = nM * nN; G = G_; c = c_; }
    __host__ __device__ bool next(int i, Unit& u) const {
        const long L = (long)i * G + c; if (L >= nwg) return false;
        int wgid = (int)L; { const int q = nwg / NXCD, r = nwg % NXCD, xcd = wgid % NXCD, off = wgid / NXCD; wgid = (xcd < r ? xcd * (q + 1) : r * (q + 1) + (xcd - r) * q) + off; }
        const int nig = WGM * nN, gid = wgid / nig, fm = gid * WGM, gsz = (nM - fm) < WGM ? (nM - fm) : WGM;
        u.pm = fm + ((wgid % nig) % gsz); u.pn = (wgid % nig) / gsz; return true;
    }
    __device__ __forceinline__ void a_ready(const Unit&) const {}
    __device__ __forceinline__ void done(const Unit&) const {}
};
__device__ __forceinline__ unsigned cvt_pk_bf16(float lo, float hi) { unsigned r; asm volatile("v_cvt_pk_bf16_f32 %0, %1, %2" : "=v"(r) : "v"(lo), "v"(hi)); return r; }
struct EpiRsBf16 {
    static constexpr bool AFTER_DRAIN = false;
    bf16_t* O; int ldc; const float* rs; int split_cols; size_t split_stride;
    __device__ __forceinline__ bool perm() const { return true; }
    __device__ __forceinline__ void operator()(const f32x4 (&acc)[2][2][4][2], const Unit& u, int wr, int wc, int fr, int fq) const {
        const int row0 = u.pm * BM + wr * 64 + fr; int colt = u.pn * BM; bf16_t* base = O;
        if (split_cols) { const int t = colt / split_cols; base += (size_t)t * split_stride; colt -= t * split_cols; }
        const int col0 = colt + wc * 32 + 8 * fq;
#pragma unroll
        for (int ai = 0; ai < 2; ++ai)
#pragma unroll
            for (int m = 0; m < 4; ++m) { const int row = row0 + ai * HALF + m * 16; const float s = rs[row]; bf16_t* rowp = base + (size_t)row * ldc + col0;
#pragma unroll
                for (int bj = 0; bj < 2; ++bj) { const f32x4 v0 = acc[ai][bj][m][0] * s, v1 = acc[ai][bj][m][1] * s;
                    u32x4 w; w.x = cvt_pk_bf16(v0[0], v0[1]); w.y = cvt_pk_bf16(v0[2], v0[3]); w.z = cvt_pk_bf16(v1[0], v1[1]); w.w = cvt_pk_bf16(v1[2], v1[3]);
                    *(u32x4*)(rowp + bj * HALF) = w; } }
    }
};
struct EpiF32Part {
    static constexpr bool AFTER_DRAIN = false;
    float* C; int ldc; float* part;
    __device__ __forceinline__ bool perm() const { return false; }
    __device__ __forceinline__ void operator()(const f32x4 (&acc)[2][2][4][2], const Unit& u, int wr, int wc, int fr, int fq) const {
        const int row0 = u.pm * BM + wr * 64 + fr, col0 = u.pn * BM + wc * 32 + 4 * fq;
#pragma unroll
        for (int ai = 0; ai < 2; ++ai)
#pragma unroll
            for (int m = 0; m < 4; ++m) { const int row = row0 + ai * HALF + m * 16; float* rowp = C + (size_t)row * ldc + col0; float ss = 0.f;
#pragma unroll
                for (int bj = 0; bj < 2; ++bj)
#pragma unroll
                    for (int n = 0; n < 2; ++n) { const f32x4 x = acc[ai][bj][m][n]; *(f32x4*)(rowp + bj * HALF + n * 16) = x; ss += (x[0] * x[0] + x[1] * x[1]) + (x[2] * x[2] + x[3] * x[3]); }
                ss += __shfl_xor(ss, 16); ss += __shfl_xor(ss, 32);
                if (fq == 0) part[(size_t)row * 16 + u.pn * 4 + wc] = ss; }
    }
};
struct EpiUni {
    static constexpr bool AFTER_DRAIN = false;
    int mode;
    EpiRsBf16 e0; EpiF32Part e1;
    __device__ __forceinline__ bool perm() const { return mode == 0; }
    __device__ __forceinline__ void operator()(const f32x4 (&acc)[2][2][4][2], const Unit& u, int wr, int wc, int fr, int fq) const { if (mode == 0) e0(acc, u, wr, wc, fr, fq); else e1(acc, u, wr, wc, fr, fq); }
};
template <class Epi, class Sched, bool ALIGN_EPI = false, bool SP2 = false>
__device__ __forceinline__ void gemm_phase(PG8_LAS unsigned char* lds, const Gemm g, const Sched& S, const Epi& E) {
    const int tid = threadIdx.x, wid = __builtin_amdgcn_readfirstlane(tid >> 6), lane = tid & 63, wr = wid >> 2, wc = wid & 3, fr = lane & 15, fq = lane >> 4;
    const int K = g.K, nt = K / BK;
    unsigned voffA[2], voffB[2];
#pragma unroll
    for (int i = 0; i < 2; ++i) { int R, C; stage_rc(tid * 16 + i * 8192, R, C); const int Rb = E.perm() ? ((R & ~31) + perm32(R & 31)) : R;
        voffA[i] = (unsigned)(R * K + C) * 2u; voffB[i] = (unsigned)(Rb * K + C) * 2u; }
    const size_t kstep = (size_t)(BK * 2);
    const size_t hstep = (size_t)HALF * K * 2;
    const size_t tstep = 2 * hstep;
    const unsigned ldsw = (unsigned)wid * 1024u;
    const int aoff = lds_byte(wr * 64 + fr, fq * 8), boff = lds_byte(wc * 32 + fr, fq * 8);
#define PG8_SA(b, h) (((b) * 2 + (h)) * HTB)
#define PG8_SB(b, h) ((4 + (b) * 2 + (h)) * HTB)
#define PG8_STAGE(bufoff, gbase, voff) do { _Pragma("unroll") for (int _i = 0; _i < 2; ++_i) \
        __builtin_amdgcn_global_load_lds((const unsigned*)((const char*)(gbase) + (voff)[_i]), (PG8_LAS unsigned*)(lds + (bufoff) + ldsw + _i * 8192), 16, 0, 0); } while (0)
#define PG8_LDA(dst, b, h) do { _Pragma("unroll") for (int m = 0; m < 4; ++m) _Pragma("unroll") for (int k = 0; k < 2; ++k) dst[m][k] = *(const PG8_LAS bf16x8*)(lds + PG8_SA(b, h) + aoff + m * 2048 + k * 1024); } while (0)
#define PG8_LDB(dst, b, h) do { _Pragma("unroll") for (int n = 0; n < 2; ++n) _Pragma("unroll") for (int k = 0; k < 2; ++k) dst[n][k] = *(const PG8_LAS bf16x8*)(lds + PG8_SB(b, h) + boff + n * 2048 + k * 1024); } while (0)
#define PG8_MMA(ai, bj, At, Bt) do { __builtin_amdgcn_s_setprio(1); _Pragma("unroll") for (int m = 0; m < 4; ++m) _Pragma("unroll") for (int n = 0; n < 2; ++n) _Pragma("unroll") for (int k = 0; k < 2; ++k) \
        acc[ai][bj][m][n] = __builtin_amdgcn_mfma_f32_16x16x32_bf16(Bt[n][k], At[m][k], acc[ai][bj][m][n], 0, 0, 0); __builtin_amdgcn_s_setprio(0); } while (0)
#define PG8_WAIT_V(n) asm volatile("s_waitcnt vmcnt(" #n ")" ::: "memory")
#define PG8_WAIT_L(n) asm volatile("s_waitcnt lgkmcnt(" #n ")" ::: "memory")
#define PG8_BAR __builtin_amdgcn_s_barrier()
#define PG8_SCHED __builtin_amdgcn_sched_barrier(0)
    Unit cur, nxt; int ui = 0;
    if (!S.next(0, cur)) return;
    f32x4 acc[2][2][4][2];
#pragma unroll
    for (int a = 0; a < 2; ++a)
#pragma unroll
        for (int b = 0; b < 2; ++b)
#pragma unroll
            for (int m = 0; m < 4; ++m)
#pragma unroll
                for (int n = 0; n < 2; ++n) acc[a][b][m][n] = (f32x4){0.f, 0.f, 0.f, 0.f};
    bf16x8 At[4][2], B0[2][2], B1[2][2];
    const char* cA = (const char*)g.A + (size_t)cur.pm * tstep; const char* cB = (const char*)g.Bt + (size_t)cur.pn * tstep;
    S.a_ready(cur);
    if constexpr (SP2) {
        PG8_STAGE(PG8_SB(0, 0), cB, voffB); PG8_STAGE(PG8_SB(0, 1), cB + hstep, voffB); PG8_STAGE(PG8_SA(0, 0), cA, voffA); PG8_STAGE(PG8_SA(0, 1), cA + hstep, voffA);
        if (wr == 1) PG8_BAR;
        PG8_WAIT_V(2); PG8_BAR;
        PG8_STAGE(PG8_SB(1, 0), cB + kstep, voffB); PG8_STAGE(PG8_SA(1, 0), cA + kstep, voffA); PG8_STAGE(PG8_SB(1, 1), cB + hstep + kstep, voffB);
        PG8_WAIT_V(6); PG8_BAR;
    } else {
        PG8_STAGE(PG8_SB(0, 0), cB, voffB); PG8_STAGE(PG8_SA(0, 0), cA, voffA); PG8_STAGE(PG8_SB(0, 1), cB + hstep, voffB); PG8_STAGE(PG8_SA(0, 1), cA + hstep, voffA);
        if (wr == 1) PG8_BAR;
        PG8_WAIT_V(4); PG8_BAR;
        PG8_STAGE(PG8_SB(1, 0), cB + kstep, voffB); PG8_STAGE(PG8_SA(1, 0), cA + kstep, voffA); PG8_STAGE(PG8_SB(1, 1), cB + hstep + kstep, voffB);
        PG8_WAIT_V(6); PG8_BAR;
    }
    for (;;) {
        const bool has_next = S.next(ui + 1, nxt);
        const char* nA = has_next ? (const char*)g.A + (size_t)nxt.pm * tstep : cA; const char* nB = has_next ? (const char*)g.Bt + (size_t)nxt.pn * tstep : cB;
        for (int t = 0; t < nt; t += 2) {
            const bool last = (t == nt - 2);
            const char* a1 = cA + (size_t)(t + 1) * kstep;
            const char* a2 = last ? nA : cA + (size_t)(t + 2) * kstep; const char* b2 = last ? nB : cB + (size_t)(t + 2) * kstep;
            const char* a3 = a2 + kstep; const char* b3 = b2 + kstep;
            if (last && has_next) S.a_ready(nxt);
            if constexpr (SP2) {
            PG8_LDB(B0, 0, 0); PG8_LDB(B1, 0, 1); PG8_SCHED; PG8_LDA(At, 0, 0); PG8_STAGE(PG8_SA(1, 1), a1 + hstep, voffA);
            PG8_WAIT_V(8); PG8_WAIT_L(0); PG8_BAR; PG8_MMA(0, 0, At, B0); PG8_MMA(0, 1, At, B1); PG8_BAR; PG8_SCHED;
            PG8_LDA(At, 0, 1); PG8_STAGE(PG8_SB(0, 0), b2, voffB); PG8_STAGE(PG8_SB(0, 1), b2 + hstep, voffB); PG8_STAGE(PG8_SA(0, 0), a2, voffA);
            PG8_WAIT_V(8); PG8_WAIT_L(0); PG8_BAR; PG8_MMA(1, 0, At, B0); PG8_MMA(1, 1, At, B1); PG8_BAR; PG8_SCHED;
            PG8_LDB(B0, 1, 0); PG8_LDB(B1, 1, 1); PG8_SCHED; PG8_LDA(At, 1, 0); PG8_STAGE(PG8_SA(0, 1), a2 + hstep, voffA);
            PG8_WAIT_V(8); PG8_WAIT_L(0); PG8_BAR; PG8_MMA(0, 0, At, B0); PG8_MMA(0, 1, At, B1); PG8_BAR; PG8_SCHED;
            PG8_LDA(At, 1, 1); PG8_STAGE(PG8_SB(1, 0), b3, voffB); PG8_STAGE(PG8_SB(1, 1), b3 + hstep, voffB); PG8_STAGE(PG8_SA(1, 0), a3, voffA);
            PG8_WAIT_V(8); PG8_WAIT_L(0); PG8_BAR; PG8_MMA(1, 0, At, B0); PG8_MMA(1, 1, At, B1); PG8_BAR; PG8_SCHED;
            } else {
            PG8_LDB(B0, 0, 0); PG8_SCHED; PG8_LDA(At, 0, 0); PG8_STAGE(PG8_SA(1, 1), a1 + hstep, voffA);
            PG8_WAIT_L(8); PG8_BAR; PG8_WAIT_L(0); PG8_MMA(0, 0, At, B0); PG8_BAR; PG8_SCHED;
            PG8_LDB(B1, 0, 1); PG8_STAGE(PG8_SB(0, 0), b2, voffB);
            PG8_BAR; PG8_WAIT_L(0); PG8_MMA(0, 1, At, B1); PG8_BAR;
            PG8_LDA(At, 0, 1); PG8_STAGE(PG8_SA(0, 0), a2, voffA);
            PG8_BAR; PG8_WAIT_L(0); PG8_MMA(1, 0, At, B0); PG8_BAR; PG8_SCHED;
            PG8_STAGE(PG8_SB(0, 1), b2 + hstep, voffB);
            PG8_WAIT_V(6); PG8_BAR; PG8_MMA(1, 1, At, B1); PG8_BAR;
            PG8_LDB(B0, 1, 0); PG8_SCHED; PG8_LDA(At, 1, 0); PG8_STAGE(PG8_SA(0, 1), a2 + hstep, voffA);
            PG8_WAIT_L(8); PG8_BAR; PG8_WAIT_L(0); PG8_MMA(0, 0, At, B0); PG8_BAR; PG8_SCHED;
            PG8_LDB(B1, 1, 1); PG8_STAGE(PG8_SB(1, 0), b3, voffB);
            PG8_BAR; PG8_WAIT_L(0); PG8_MMA(0, 1, At, B1); PG8_BAR;
            PG8_LDA(At, 1, 1); PG8_STAGE(PG8_SA(1, 0), a3, voffA);
            PG8_BAR; PG8_WAIT_L(0); PG8_MMA(1, 0, At, B0); PG8_BAR; PG8_SCHED;
            PG8_STAGE(PG8_SB(1, 1), b3 + hstep, voffB);
            PG8_WAIT_V(6); PG8_BAR; PG8_MMA(1, 1, At, B1); PG8_BAR;
            }
        }
        if constexpr (ALIGN_EPI) { if (wr == 0) PG8_BAR; }
        if constexpr (!Epi::AFTER_DRAIN) { E(acc, cur, wr, wc, fr, fq); S.done(cur); }
        if (!has_next) break;
#pragma unroll
        for (int a = 0; a < 2; ++a)
#pragma unroll
            for (int b = 0; b < 2; ++b)
#pragma unroll
                for (int m = 0; m < 4; ++m)
#pragma unroll
                    for (int n = 0; n < 2; ++n) acc[a][b][m][n] = (f32x4){0.f, 0.f, 0.f, 0.f};
        cur = nxt; cA = nA; cB = nB; ++ui;
        if constexpr (ALIGN_EPI) { if (wr == 1) PG8_BAR; }
    }
    PG8_WAIT_V(0);
    if constexpr (!ALIGN_EPI) { if (wr == 0) PG8_BAR; }
    PG8_BAR;
    if constexpr (Epi::AFTER_DRAIN) { E.fused(acc, cur, wr, wc, fr, fq, lds, wid, lane); S.done(cur); }
#undef PG8_SA
#undef PG8_SB
#undef PG8_STAGE
#undef PG8_LDA
#undef PG8_LDB
#undef PG8_MMA
#undef PG8_WAIT_V
#undef PG8_WAIT_L
#undef PG8_BAR
#undef PG8_SCHED
}
}

constexpr int NB = 8, T = 4096, DM = 1024, M = NB * T, DEPTH = 2;
constexpr int NPROJ = 2912, NPROJP = 3072, DFF = 2816, NUP = 2 * DFF;
constexpr int C_CH = 0, C_CB = 256, C_CC = 512, C_R = 768, C_K = 1024, C_V = 1280, C_DEC = 1536, C_GDN = 1600, C_NQ = 1632, C_NK = 1888, C_NV = 2144, C_SU = 2400, C_SV = 2656;
constexpr float NORM_EPS = 1e-6f, GN_EPS = 64e-5f, DECAY_SCALE = 0.60653065971263342f;
constexpr int NWAVES = 8, NTHREADS = 512;
constexpr size_t MiB = 1u << 20;
constexpr size_t WS_CTL = 0, CTL_ZERO_BYTES = 1 * MiB;
constexpr size_t WS_RS = 1 * MiB;
constexpr size_t WS_PART = 1 * MiB + 256 * 1024;
constexpr size_t WS_W = 4 * MiB, W_LAYER = 24 * MiB + 512 * 1024;
constexpr size_t W_IN = 0, W_OUT = 6 * MiB, W_UP = 8 * MiB, W_DN = 19 * MiB;
constexpr size_t WS_XB = 53 * MiB;
constexpr size_t WS_R = 117 * MiB;
constexpr size_t WS_PROJ = WS_R, WS_MERGED = WS_R + 192 * MiB, WS_PREP = WS_R + 256 * MiB;
constexpr size_t WS_YSC = WS_XB;
constexpr size_t WS_Y = WS_R;
constexpr size_t WS_G = WS_R, WS_L = WS_R + 176 * MiB;
constexpr size_t WS_END = 501 * MiB;
static_assert(WS_W + 2 * W_LAYER <= WS_XB && WS_PREP + 128 * MiB <= WS_END && WS_L + 176 * MiB <= WS_END && WS_PART + (size_t)M * 64 <= WS_W, "ws map");
constexpr int CW_BAR = 4096;
constexpr int RING_BYTES = 131072, LDSCTL_OFF = RING_BYTES, MISC_OFF = LDSCTL_OFF + 320, LDS_BYTES = 147456;

#define GAS __attribute__((address_space(1)))
#define LAS __attribute__((address_space(3)))
typedef unsigned short bf16;
typedef unsigned v4u __attribute__((ext_vector_type(4)));
typedef unsigned v2u __attribute__((ext_vector_type(2)));
typedef float f32x4 __attribute__((ext_vector_type(4)));
typedef short bf16x8 __attribute__((ext_vector_type(8)));
typedef short s16x4 __attribute__((ext_vector_type(4)));
typedef _Float16 h2 __attribute__((ext_vector_type(2)));
typedef GAS unsigned gu32;
#define RLX_AGENT __ATOMIC_RELAXED, __HIP_MEMORY_SCOPE_AGENT
__device__ __forceinline__ unsigned f2bf(float f) { unsigned u = __builtin_bit_cast(unsigned, f); return (u + 0x7fffu + ((u >> 16) & 1u)) >> 16; }
__device__ __forceinline__ unsigned pk2(float lo, float hi) { return f2bf(lo) | (f2bf(hi) << 16); }
__device__ __forceinline__ float bflo(unsigned w) { return __builtin_bit_cast(float, w << 16); }
__device__ __forceinline__ float bfhi(unsigned w) { return __builtin_bit_cast(float, w & 0xffff0000u); }
__device__ __forceinline__ float bf2f(unsigned short b) { return __builtin_bit_cast(float, (unsigned)b << 16); }
__device__ __forceinline__ h2 as_h2(unsigned u) { return __builtin_bit_cast(h2, u); }
__device__ __forceinline__ float wave_sum(float v) {
#pragma unroll
    for (int o = 1; o < 64; o <<= 1) v += __shfl_xor(v, o);
    return v;
}
template <int CTRL> __device__ __forceinline__ float dppmov(float x) { return __builtin_bit_cast(float, __builtin_amdgcn_update_dpp(0, __builtin_bit_cast(int, x), CTRL, 0xF, 0xF, true)); }
__device__ __forceinline__ float row16_sum(float x) { x += dppmov<0xB1>(x); x += dppmov<0x4E>(x); x += dppmov<0x141>(x); x += dppmov<0x140>(x); return x; }
__device__ __forceinline__ float row16_max(float x) { x = fmaxf(x, dppmov<0xB1>(x)); x = fmaxf(x, dppmov<0x4E>(x)); x = fmaxf(x, dppmov<0x141>(x)); x = fmaxf(x, dppmov<0x140>(x)); return x; }
__device__ __forceinline__ float sigmoidf_(float x) { return 1.f / (1.f + __expf(-x)); }
__device__ __forceinline__ float tanhf_(float x) { return 1.f - 2.f / (__expf(2.f * x) + 1.f); }
__device__ __forceinline__ float gelu_tanh(float x) { const float u = 1.5957691216057308f * x * (1.f + 0.044715f * x * x); return x / (1.f + __expf(-u)); }
#define XB_TMO      128
#define XB_XCNT(j)  (256  + 64 * (j))
#define XB_XSUB(j)  (1280 + 64 * (j))
#define XB_XGEN(j)  (2304 + 64 * (j))
#define XB_TOP      3328
#define XB_TOPGEN   3392
#define XCD_BAR_WORDS 3456
#define XB_SPIN_CAP (1u << 18)

__device__ __forceinline__ unsigned xb_ld(unsigned* p)              { return __hip_atomic_load(p, __ATOMIC_RELAXED, __HIP_MEMORY_SCOPE_AGENT); }
__device__ __forceinline__ unsigned xb_add(unsigned* p, unsigned v) { return __hip_atomic_fetch_add(p, v, __ATOMIC_RELAXED, __HIP_MEMORY_SCOPE_AGENT); }
__device__ __forceinline__ unsigned xb_xcc_id() { return (unsigned)__builtin_amdgcn_s_getreg((3 << 11) | 20) & 0xFu; }
#define XB_SPIN(cond, bar) do { unsigned _sp = 0; while (cond) { __builtin_amdgcn_s_sleep(1); \
    if ((++_sp & 255u) == 0u) { if (xb_ld(&(bar)[XB_TMO])) break; if (_sp > XB_SPIN_CAP) { atomicAdd(&(bar)[XB_TMO], 1u); break; } } } } while (0)

struct XcdBarrier {
    unsigned* bar; unsigned x;
    volatile LAS unsigned* st;
};

__device__ __forceinline__ XcdBarrier xcd_barrier_post(unsigned* bar, volatile LAS unsigned* st) {
    XcdBarrier b; b.bar = bar; b.x = xb_xcc_id(); b.st = st;
    if (threadIdx.x == 0) (void)xb_add(&bar[XB_XCNT(b.x)], 1u);
    return b;
}
__device__ __forceinline__ void xcd_barrier_complete(unsigned* bar, unsigned x, unsigned& nloc, unsigned& nx) {
    const unsigned G = gridDim.x * gridDim.y * gridDim.z;
    unsigned sum, cnt, mine, sp = 0u;
    for (;;) {
        sum = 0u; cnt = 0u; mine = 0u;
#pragma unroll
        for (unsigned j = 0; j < 16; ++j) { const unsigned c = xb_ld(&bar[XB_XCNT(j)]); sum += c; cnt += (c > 0u) ? 1u : 0u; mine = (j == x) ? c : mine; }
        if (sum == G) break;
        __builtin_amdgcn_s_sleep(1);
        if ((++sp & 255u) == 0u) { if (xb_ld(&bar[XB_TMO])) break; if (sp > XB_SPIN_CAP) { atomicAdd(&bar[XB_TMO], 1u); break; } }
    }
    nloc = mine > 0u ? mine : 1u; nx = cnt > 0u ? cnt : 1u;
}

__device__ __forceinline__ void xcd_barrier(const XcdBarrier& b) {
    asm volatile("s_waitcnt vmcnt(0)" ::: "memory");
    __syncthreads();
    if (threadIdx.x == 0) {
        unsigned* bar = b.bar;
        __builtin_amdgcn_s_waitcnt(0);
        unsigned nloc = b.st[0], nx = b.st[1];
        if (nloc == 0u) { xcd_barrier_complete(bar, b.x, nloc, nx); b.st[0] = nloc; b.st[1] = nx; }
        const unsigned old = xb_add(&bar[XB_XSUB(b.x)], 1u);
        const unsigned gen = old / nloc;
        if (old + 1u == (gen + 1u) * nloc) {
            __builtin_amdgcn_fence(__ATOMIC_RELEASE, "agent");
            asm volatile("s_waitcnt vmcnt(0)" ::: "memory");
            const unsigned og = xb_add(&bar[XB_TOP], 1u);
            const unsigned tg = og / nx;
            if (og + 1u == (tg + 1u) * nx) xb_add(&bar[XB_TOPGEN], 1u);
            else XB_SPIN(xb_ld(&bar[XB_TOPGEN]) == tg, bar);
            __builtin_amdgcn_fence(__ATOMIC_ACQUIRE, "agent");
            xb_add(&bar[XB_XGEN(b.x)], 1u);
            asm volatile("s_waitcnt vmcnt(0)" ::: "memory");
        } else {
            XB_SPIN(xb_ld(&bar[XB_XGEN(b.x)]) == gen, bar);
            __builtin_amdgcn_fence(__ATOMIC_ACQUIRE, "agent");
            asm volatile("s_waitcnt vmcnt(0)" ::: "memory");
        }
    }
    __syncthreads();
}

typedef __attribute__((address_space(4))) const unsigned long long kq_t;
struct Frame {
    LAS unsigned char* lds;
    volatile LAS unsigned* MISC;
    gu32* ctl;
    int tid, lane, wave, vcu, G;
    kq_t* karg; float* out; unsigned char* ws;
};
#define INP(F, i) ((const float*)(F).karg[(i)])
enum { I_X = 0, I_NMPRE, I_NMPOST, I_NFPRE, I_NFPOST, I_WIN, I_CONVW, I_RW0, I_RWUP, I_RA0, I_RAUP, I_RGUP, I_RKK, I_RKA, I_RRK, I_LNXW, I_LNXB, I_RPB, I_SGUN, I_SGUW, I_SGUB, I_MGAIN, I_WOUT, I_WUP, I_FCONV, I_WDN };
__device__ __forceinline__ int launder_u(int x) { asm volatile("" : "+v"(x)); return __builtin_amdgcn_readfirstlane(x); }
template <class P> __device__ __forceinline__ P launder_p(P p) { unsigned long long v = (unsigned long long)p; unsigned lo = (unsigned)v, hi = (unsigned)(v >> 32); asm volatile("" : "+v"(lo), "+v"(hi));
    lo = __builtin_amdgcn_readfirstlane(lo); hi = __builtin_amdgcn_readfirstlane(hi); return (P)(((unsigned long long)hi << 32) | lo); }
#define LAUNDER(F) do { asm volatile("" : "+v"((F).tid)); asm volatile("" : "+v"((F).lane)); (F).wave = launder_u((F).wave); (F).vcu = launder_u((F).vcu); (F).karg = launder_p((F).karg); (F).ws = launder_p((F).ws); (F).out = launder_p((F).out); } while (0)
#define LDS_WAIT() asm volatile("s_waitcnt lgkmcnt(0)" ::: "memory")
#define CFENCE() asm volatile("" ::: "memory")

__device__ __forceinline__ void p0_transpose_item(const float* W, const float* gain, int K, int N, bf16* WT, LAS float* scr, int item, int lane) {
    const int nblk = N / 32, kb = item / nblk, nb = item % nblk, k0 = 64 * kb, n0 = 32 * nb;
#pragma unroll 8
    for (int i = 0; i < 32; ++i) { const int kk = 2 * i + (lane >> 5); const float g = gain ? gain[k0 + kk] : 1.f; scr[kk * 33 + (lane & 31)] = W[(size_t)(k0 + kk) * N + n0 + (lane & 31)] * g; }
    LDS_WAIT(); CFENCE();
    const int c = lane & 7;
#pragma unroll
    for (int j = 0; j < 4; ++j) { const int n = (lane >> 3) + 8 * j; const LAS float* s = scr + (8 * c) * 33 + n;
        v4u o; o.x = pk2(s[0 * 33], s[1 * 33]); o.y = pk2(s[2 * 33], s[3 * 33]); o.z = pk2(s[4 * 33], s[5 * 33]); o.w = pk2(s[6 * 33], s[7 * 33]);
        *(GAS v4u*)(WT + (size_t)(n0 + n) * K + k0 + 8 * c) = o; }
    LDS_WAIT(); CFENCE();
}
__device__ __forceinline__ void row_to_bf16_rs(const float* xrow, bf16* orow, float* rs, int lane) {
    const GAS f32x4* xr = (const GAS f32x4*)xrow + lane;
    f32x4 v[4]; float s = 0.f;
#pragma unroll
    for (int j = 0; j < 4; ++j) { v[j] = xr[64 * j]; s += (v[j].x * v[j].x + v[j].y * v[j].y) + (v[j].z * v[j].z + v[j].w * v[j].w); }
    s = wave_sum(s);
    GAS v2u* o8 = (GAS v2u*)orow + lane;
#pragma unroll
    for (int j = 0; j < 4; ++j) { v2u o; o.x = pk2(v[j].x, v[j].y); o.y = pk2(v[j].z, v[j].w); o8[64 * j] = o; }
    if (lane == 0) *rs = 1.f / sqrtf(s * (1.f / DM) + NORM_EPS);
}
__device__ __forceinline__ void p0_prologue(Frame& F) {
    LAUNDER(F);
    LAS float* scr = (LAS float*)(F.lds + F.wave * 16384);
    const int gw = F.vcu * NWAVES + F.wave, NGW = F.G * NWAVES;
    constexpr int I_IN = (DM / 64) * (NPROJ / 32), I_OUT = (DM / 64) * (DM / 32), I_UP = (DM / 64) * (NUP / 32), I_DN = (DFF / 64) * (DM / 32), I_L = I_IN + I_OUT + I_UP + I_DN;
    for (int it = gw; it < DEPTH * I_L; it += NGW) {
        const int l = it / I_L; int r = it % I_L; unsigned char* wl = F.ws + WS_W + (size_t)l * W_LAYER;
        if (r < I_IN) { p0_transpose_item(INP(F, I_WIN) + (size_t)l * DM * NPROJ, INP(F, I_NMPRE) + l * DM, DM, NPROJ, (bf16*)(wl + W_IN), scr, r, F.lane); continue; } r -= I_IN;
        if (r < I_OUT) { p0_transpose_item(INP(F, I_WOUT) + (size_t)l * DM * DM, INP(F, I_MGAIN) + l * DM, DM, DM, (bf16*)(wl + W_OUT), scr, r, F.lane); continue; } r -= I_OUT;
        if (r < I_UP) { p0_transpose_item(INP(F, I_WUP) + (size_t)l * DM * NUP, INP(F, I_NFPRE) + l * DM, DM, NUP, (bf16*)(wl + W_UP), scr, r, F.lane); continue; } r -= I_UP;
        p0_transpose_item(INP(F, I_WDN) + (size_t)l * DFF * DM, nullptr, DFF, DM, (bf16*)(wl + W_DN), scr, r, F.lane);
    }
    for (int i = F.vcu * NTHREADS + F.tid; i < DEPTH * 20480; i += F.G * NTHREADS) { const int l = i / 20480, r = i % 20480;
        *(GAS v4u*)(F.ws + WS_W + (size_t)l * W_LAYER + W_IN + (size_t)NPROJ * DM * 2 + (size_t)r * 16) = (v4u){0u, 0u, 0u, 0u}; }
    for (int m = gw; m < M; m += NGW) row_to_bf16_rs(INP(F, I_X) + (size_t)m * DM, (bf16*)(F.ws + WS_XB) + (size_t)m * DM, (float*)(F.ws + WS_RS) + m, F.lane);
}

__device__ __forceinline__ void mix_convprep_tile(Frame& F, int l, int tile) {
    LAUNDER(F);
    const bf16* proj = (const bf16*)(F.ws + WS_PROJ); bf16* merged = (bf16*)(F.ws + WS_MERGED);
    const int m0 = tile * 64, bb = m0 / T, t0 = m0 % T;
    const int lane = F.lane, w = F.wave, tid = F.tid;
    LAS float* DEC = (LAS float*)F.lds;
#pragma unroll
    for (int i = 0; i < 8; ++i) { const int v = tid + 512 * i, tok = v >> 6, j = v & 63;
        const float x = bf2f(proj[(size_t)(m0 + tok) * NPROJP + C_DEC + j]);
        const int d = (j >> 4) & 1, kind = j >> 5;
        DEC[tok * 64 + d * 32 + kind * 16 + (j & 15)] = kind == 0 ? tanhf_(x) : x; }
    {
        const int c4 = 4 * lane; const float* cw = INP(F, I_CONVW) + l * 768;
        const f32x4 w0 = *(const f32x4*)(cw + c4), w1 = *(const f32x4*)(cw + 256 + c4), w2 = *(const f32x4*)(cw + 512 + c4);
        auto zload = [&](int t) -> f32x4 {
            if (t < 0 || t >= T) return (f32x4){0.f, 0.f, 0.f, 0.f};
            const bf16* row = proj + (size_t)(bb * T + t) * NPROJP;
            const v2u h = *(const GAS v2u*)(row + C_CH + c4), c = *(const GAS v2u*)(row + C_CC + c4);
            return (f32x4){bflo(h.x) * bflo(c.x), bfhi(h.x) * bfhi(c.x), bflo(h.y) * bflo(c.y), bfhi(h.y) * bfhi(c.y)}; };
        const int ts = t0 + 8 * w;
        f32x4 zp = zload(ts - 1), zc = zload(ts);
#pragma unroll 2
        for (int i = 0; i < 8; ++i) { const int t = ts + i; const f32x4 zn = zload(t + 1);
            const bf16* row = proj + (size_t)(bb * T + t) * NPROJP;
            const v2u b = *(const GAS v2u*)(row + C_CB + c4);
            const f32x4 bv = (f32x4){bflo(b.x), bfhi(b.x), bflo(b.y), bfhi(b.y)};
            const f32x4 y = bv * (w0 * zp + w1 * zc + w2 * zn);
            float ss = (y.x * y.x + y.y * y.y) + (y.z * y.z + y.w * y.w); ss = wave_sum(ss);
            const float sc = 1.f / sqrtf(ss * (1.f / 256.f) + NORM_EPS);
            v2u o; o.x = pk2(y.x * sc, y.y * sc); o.y = pk2(y.z * sc, y.w * sc);
            *(GAS v2u*)(merged + (size_t)(bb * T + t) * DM + 0 + c4) = o;
            zp = zc; zc = zn; }
    }
    __syncthreads();
    {
        const int c = tid & 255, d = tid >> 8, h = c >> 6;
        float wup[16], aup[16];
#pragma unroll
        for (int j = 0; j < 16; ++j) { wup[j] = INP(F, I_RWUP)[((size_t)(l * 2 + d) * 16 + j) * 256 + c]; aup[j] = INP(F, I_RAUP)[((size_t)(l * 2 + d) * 16 + j) * 256 + c]; }
        const float w0 = INP(F, I_RW0)[(l * 2 + d) * 256 + c], a0 = INP(F, I_RA0)[(l * 2 + d) * 256 + c], kk_g = INP(F, I_RKK)[l * 256 + c], ka_g = INP(F, I_RKA)[l * 256 + c];
        unsigned char* prep = F.ws + WS_PREP + ((size_t)((d * NB + bb) * 4 + h) * T) * 512 + (size_t)((c & 63) >> 1) * 16;
        for (int tok = 0; tok < 64; ++tok) {
            const LAS f32x4* dv = (const LAS f32x4*)(DEC + tok * 64 + d * 32);
            float lw = w0, la = a0;
#pragma unroll
            for (int q = 0; q < 4; ++q) { const f32x4 x = dv[q], y = dv[4 + q];
                lw += x.x * wup[4 * q] + x.y * wup[4 * q + 1] + x.z * wup[4 * q + 2] + x.w * wup[4 * q + 3];
                la += y.x * aup[4 * q] + y.y * aup[4 * q + 1] + y.z * aup[4 * q + 2] + y.w * aup[4 * q + 3]; }
            const float wv = __expf(-DECAY_SCALE * sigmoidf_(lw)), av = sigmoidf_(la);
            const float k = bf2f(proj[(size_t)(m0 + tok) * NPROJP + C_K + c]);
            const float kkr = k * kk_g; const float ss = wave_sum(kkr * kkr);
            const float kk = kkr / sqrtf(ss + 1e-12f);
            const float bv = kk * av, ke = k * (1.f + (av - 1.f) * ka_g);
            const float wo = __shfl_xor(wv, 1), kko = __shfl_xor(kk, 1), bo = __shfl_xor(bv, 1), keo = __shfl_xor(ke, 1);
            if ((c & 1) == 0) {
                h2 a = {(_Float16)wv, (_Float16)wo}, b = {(_Float16)kk, (_Float16)kko}, cc = {(_Float16)bv, (_Float16)bo}, dd = {(_Float16)ke, (_Float16)keo};
                v4u o; o.x = __builtin_bit_cast(unsigned, a); o.y = __builtin_bit_cast(unsigned, b); o.z = __builtin_bit_cast(unsigned, cc); o.w = __builtin_bit_cast(unsigned, dd);
                *(GAS v4u*)(prep + (size_t)(t0 + tok) * 512) = o; }
        }
    }
    __syncthreads();
}

__device__ __forceinline__ void mix_na_item(Frame& F, int l, int item, LAS unsigned char* wl, const LAS float* RPB) {
    LAUNDER(F);
    const bf16* proj = (const bf16*)(F.ws + WS_PROJ); bf16* merged = (bf16*)(F.ws + WS_MERGED);
    const int lane = F.lane, i = lane & 15, g = lane >> 4;
    const int qg = item & 3, r = (item >> 2) & 63, bb = item >> 8;
    const int c0 = 16 * qg;
    int rs = r - 4; rs = rs < 0 ? 0 : (rs > 56 ? 56 : rs);
    int cs = c0 - 8; cs = cs < 0 ? 0 : (cs > 32 ? 32 : cs);
    LAS unsigned char* PL = wl; LAS unsigned char* VL = wl + 4096; LAS unsigned char* OL = wl + 8192;
    const size_t rowbase = (size_t)bb * T;
    float ssq[4] = {0.f, 0.f, 0.f, 0.f};
#pragma unroll 1
    for (int h = 0; h < 4; ++h) {
        bf16x8 qf[2];
        { const bf16* qrow = proj + (rowbase + r * 64 + c0 + i) * NPROJP + C_NQ + h * 64 + 8 * g;
          qf[0] = *(const GAS bf16x8*)(qrow); qf[1] = *(const GAS bf16x8*)(qrow + 32); }
        f32x4 s[16];
#pragma unroll
        for (int kt = 0; kt < 16; ++kt) { const int kr = kt >> 1, hf = kt & 1;
            const bf16* krow = proj + (rowbase + (rs + kr) * 64 + cs + 16 * hf + i) * NPROJP + C_NK + h * 64 + 8 * g;
            const bf16x8 k0 = *(const GAS bf16x8*)(krow), k1 = *(const GAS bf16x8*)(krow + 32);
            f32x4 a = (f32x4){0.f, 0.f, 0.f, 0.f};
            a = __builtin_amdgcn_mfma_f32_16x16x32_bf16(qf[0], k0, a, 0, 0, 0);
            a = __builtin_amdgcn_mfma_f32_16x16x32_bf16(qf[1], k1, a, 0, 0, 0);
            s[kt] = a; if ((kt & 3) == 3) __builtin_amdgcn_sched_barrier(0); }
        float mx[4] = {-3e38f, -3e38f, -3e38f, -3e38f};
#pragma unroll
        for (int kt = 0; kt < 16; ++kt) { const int kr = kt >> 1, hf = kt & 1; const int cw = cs + 16 * hf + i; const int dy = rs + kr - r + 7;
#pragma unroll
            for (int e = 0; e < 4; ++e) { const int cq = c0 + 4 * g + e; int st = cq - 8; st = st < 0 ? 0 : (st > 48 ? 48 : st);
                int dx = cw - cq; dx = dx < -15 ? -15 : (dx > 15 ? 15 : dx); dx += 15;
                const bool valid = (cw >= st) && (cw < st + 16);
                float v = s[kt][e] * 0.125f + RPB[h * 465 + dy * 31 + dx];
                v = valid ? v : -1e30f; s[kt][e] = v; mx[e] = fmaxf(mx[e], v); } }
        float sm[4];
#pragma unroll
        for (int e = 0; e < 4; ++e) { mx[e] = row16_max(mx[e]); sm[e] = 0.f; }
#pragma unroll
        for (int kt = 0; kt < 16; ++kt)
#pragma unroll
            for (int e = 0; e < 4; ++e) { const float p = __expf(s[kt][e] - mx[e]); s[kt][e] = p; sm[e] += p; }
#pragma unroll
        for (int e = 0; e < 4; ++e) sm[e] = 1.f / row16_sum(sm[e]);
        f32x4 oh[4];
#pragma unroll
        for (int dt = 0; dt < 4; ++dt) oh[dt] = (f32x4){0.f, 0.f, 0.f, 0.f};
#pragma unroll
        for (int half = 0; half < 2; ++half) {
            CFENCE();
#pragma unroll
            for (int k8 = 0; k8 < 8; ++k8) { const int kt = 8 * half + k8; v2u pw; pw.x = pk2(s[kt][0] * sm[0], s[kt][1] * sm[1]); pw.y = pk2(s[kt][2] * sm[2], s[kt][3] * sm[3]);
                *(LAS v2u*)(PL + (16 * k8 + i) * 32 + 8 * g) = pw; }
            CFENCE();
#pragma unroll 1
            for (int k4 = 0; k4 < 4; ++k4) { const int kr = 4 * half + k4;
                CFENCE();
#pragma unroll
                for (int q = 0; q < 4; ++q) { const int e = lane + 64 * q, key = e >> 3, ch = e & 7;
                    const v4u vv = *(const GAS v4u*)(proj + (rowbase + (rs + kr) * 64 + cs + key) * NPROJP + C_NV + h * 64 + 8 * ch);
                    *(LAS v4u*)(VL + key * 128 + ch * 16) = vv; }
                CFENCE();
                const LAS unsigned char* pa = PL + (32 * k4 + 8 * g + (i >> 2)) * 32 + 8 * (i & 3);
                const s16x4 plo = __builtin_bit_cast(s16x4, __builtin_amdgcn_ds_read_tr16_b64_v4i16((LAS s16x4*)(pa)));
                const s16x4 phi = __builtin_bit_cast(s16x4, __builtin_amdgcn_ds_read_tr16_b64_v4i16((LAS s16x4*)(pa + 128)));
                const bf16x8 pf = (bf16x8){plo[0], plo[1], plo[2], plo[3], phi[0], phi[1], phi[2], phi[3]};
#pragma unroll
                for (int dt = 0; dt < 4; ++dt) {
                    const LAS unsigned char* va = VL + (8 * g + (i >> 2)) * 128 + (16 * dt + 4 * (i & 3)) * 2;
                    const s16x4 vlo = __builtin_bit_cast(s16x4, __builtin_amdgcn_ds_read_tr16_b64_v4i16((LAS s16x4*)(va)));
                    const s16x4 vhi = __builtin_bit_cast(s16x4, __builtin_amdgcn_ds_read_tr16_b64_v4i16((LAS s16x4*)(va + 512)));
                    const bf16x8 vf = (bf16x8){vlo[0], vlo[1], vlo[2], vlo[3], vhi[0], vhi[1], vhi[2], vhi[3]};
                    oh[dt] = __builtin_amdgcn_mfma_f32_16x16x32_bf16(pf, vf, oh[dt], 0, 0, 0); }
            }
        }
        CFENCE();
#pragma unroll
        for (int dt = 0; dt < 4; ++dt)
#pragma unroll
            for (int e = 0; e < 4; ++e) { ssq[e] += oh[dt][e] * oh[dt][e]; *(LAS unsigned short*)(OL + (4 * g + e) * 512 + (h * 64 + 16 * dt + i) * 2) = (unsigned short)f2bf(oh[dt][e]); }
        CFENCE();
    }
    LAS float* SCL = (LAS float*)VL;
    CFENCE();
#pragma unroll
    for (int e = 0; e < 4; ++e) { const float sc = 1.f / sqrtf(row16_sum(ssq[e]) * (1.f / 256.f) + NORM_EPS); if (i == 0) SCL[4 * g + e] = sc; }
    CFENCE();
#pragma unroll
    for (int q = 0; q < 8; ++q) { const int e = lane + 64 * q, row = e >> 5, ch = e & 31;
        const v4u v = *(const LAS v4u*)(OL + row * 512 + ch * 16); const float sc = SCL[row];
        v4u o;
#pragma unroll
        for (int t = 0; t < 4; ++t) o[t] = pk2(bflo(v[t]) * sc, bfhi(v[t]) * sc);
        *(GAS v4u*)(merged + (rowbase + r * 64 + c0 + row) * DM + 512 + 8 * ch) = o; }
    CFENCE();
}

constexpr int SG_PITCH = 528;
__device__ __forceinline__ void mix_sgu_item(Frame& F, int l, int item) {
    LAUNDER(F);
    const bf16* proj = (const bf16*)(F.ws + WS_PROJ); bf16* merged = (bf16*)(F.ws + WS_MERGED);
    const int lane = F.lane, w = F.wave, tid = F.tid, i = lane & 15, g = lane >> 4;
    const size_t m0 = (size_t)item * 128;
    LAS unsigned char* VI = F.lds; LAS float* SS = (LAS float*)(F.lds + 128 * SG_PITCH);
    { const int c4 = 4 * lane; const f32x4 gn = *(const f32x4*)(INP(F, I_SGUN) + l * 256 + c4);
      for (int q = 16 * w; q < 16 * w + 16; ++q) {
          const v2u x = *(const GAS v2u*)(proj + (m0 + q) * NPROJP + C_SV + c4);
          f32x4 v = (f32x4){gelu_tanh(bflo(x.x)), gelu_tanh(bfhi(x.x)), gelu_tanh(bflo(x.y)), gelu_tanh(bfhi(x.y))};
          const float mu = wave_sum((v.x + v.y) + (v.z + v.w)) * (1.f / 256.f);
          v = v - mu;
          const float var = wave_sum((v.x * v.x + v.y * v.y) + (v.z * v.z + v.w * v.w)) * (1.f / 256.f);
          const float rstd = 1.f / sqrtf(var + NORM_EPS);
          v2u o; o.x = pk2(v.x * rstd * gn.x, v.y * rstd * gn.y); o.y = pk2(v.z * rstd * gn.z, v.w * rstd * gn.w);
          *(LAS v2u*)(VI + q * SG_PITCH + c4 * 2) = o; } }
    __syncthreads();
    const int hh = w >> 1, ph = w & 1;
    f32x4 acc[4][4];
#pragma unroll
    for (int a = 0; a < 4; ++a)
#pragma unroll
        for (int b = 0; b < 4; ++b) acc[a][b] = (f32x4){0.f, 0.f, 0.f, 0.f};
    const float* ws_ = INP(F, I_SGUW) + ((size_t)(l * 4 + hh) * 128) * 128;
#pragma unroll 1
    for (int ks = 0; ks < 4; ++ks) {
        bf16x8 af[4], bfr[4];
#pragma unroll
        for (int pt = 0; pt < 4; ++pt) { const float* ap = ws_ + (size_t)(64 * ph + 16 * pt + i) * 128 + 32 * ks + 8 * g;
            const f32x4 x0 = *(const f32x4*)ap, x1 = *(const f32x4*)(ap + 4);
            const unsigned u0 = pk2(x0.x, x0.y), u1 = pk2(x0.z, x0.w), u2 = pk2(x1.x, x1.y), u3 = pk2(x1.z, x1.w);
            af[pt] = __builtin_bit_cast(bf16x8, (v4u){u0, u1, u2, u3}); }
#pragma unroll
        for (int dt = 0; dt < 4; ++dt) { const LAS unsigned char* va = VI + (32 * ks + 8 * g + (i >> 2)) * SG_PITCH + (hh * 64 + 16 * dt + 4 * (i & 3)) * 2;
            const s16x4 lo = __builtin_bit_cast(s16x4, __builtin_amdgcn_ds_read_tr16_b64_v4i16((LAS s16x4*)(va)));
            const s16x4 hi = __builtin_bit_cast(s16x4, __builtin_amdgcn_ds_read_tr16_b64_v4i16((LAS s16x4*)(va + 4 * SG_PITCH)));
            bfr[dt] = (bf16x8){lo[0], lo[1], lo[2], lo[3], hi[0], hi[1], hi[2], hi[3]}; }
#pragma unroll
        for (int pt = 0; pt < 4; ++pt)
#pragma unroll
            for (int dt = 0; dt < 4; ++dt) acc[pt][dt] = __builtin_amdgcn_mfma_f32_16x16x32_bf16(af[pt], bfr[dt], acc[pt][dt], 0, 0, 0);
    }
#pragma unroll
    for (int pt = 0; pt < 4; ++pt)
#pragma unroll
        for (int e = 0; e < 4; ++e) { const int p = 64 * ph + 16 * pt + 4 * g + e; const float bs = INP(F, I_SGUB)[(l * 4 + hh) * 128 + p]; float ss = 0.f;
#pragma unroll
            for (int dt = 0; dt < 4; ++dt) { const float u = gelu_tanh(bf2f(proj[(m0 + p) * NPROJP + C_SU + hh * 64 + 16 * dt + i]));
                const float v = u * (acc[pt][dt][e] + bs); acc[pt][dt][e] = v; ss += v * v; }
            ss = row16_sum(ss); if (i == 0) SS[p * 4 + hh] = ss; }
    __syncthreads();
#pragma unroll
    for (int pt = 0; pt < 4; ++pt)
#pragma unroll
        for (int e = 0; e < 4; ++e) { const int p = 64 * ph + 16 * pt + 4 * g + e; const f32x4 s4 = *(const LAS f32x4*)(SS + p * 4);
            const float sc = 1.f / sqrtf(((s4.x + s4.y) + (s4.z + s4.w)) * (1.f / 256.f) + NORM_EPS);
#pragma unroll
            for (int dt = 0; dt < 4; ++dt) *(LAS unsigned short*)(VI + p * SG_PITCH + (hh * 64 + 16 * dt + i) * 2) = (unsigned short)f2bf(acc[pt][dt][e] * sc); }
    __syncthreads();
#pragma unroll
    for (int q = 0; q < 8; ++q) { const int e = tid + 512 * q, row = e >> 5, ch = e & 31;
        const v4u v = *(const LAS v4u*)(VI + row * SG_PITCH + ch * 16);
        *(GAS v4u*)(merged + (m0 + row) * DM + 768 + 8 * ch) = v; }
    __syncthreads();
}

__device__ __forceinline__ void phase_mixers(Frame& F, int l) {
    LAUNDER(F);
#ifndef NO_CP
    for (int tile = F.vcu; tile < M / 64; tile += F.G) mix_convprep_tile(F, l, tile);
#endif
    LAS float* RPB = (LAS float*)(F.lds + RING_BYTES + 1024);
    for (int q = F.tid; q < 4 * 465; q += NTHREADS) RPB[q] = INP(F, I_RPB)[l * 4 * 465 + q];
    __syncthreads();
#ifndef NO_NA
    for (int it = F.vcu * NWAVES + F.wave; it < NB * 64 * 4; it += F.G * NWAVES) mix_na_item(F, l, it, F.lds + F.wave * 16384, RPB);
#endif
    __syncthreads();
#ifndef NO_SGU
    for (int it = F.vcu; it < NB * 32; it += F.G) mix_sgu_item(F, l, it);
#endif
}

constexpr int SC_CH = 64, SC_REC = 0, SC_RR = 32768, SC_VV = 40960, SC_BUF = 43008, SC_YB = 2 * SC_BUF;
__device__ __forceinline__ void phase_scan(Frame& F) {
    LAUNDER(F);
    const bf16* proj = (const bf16*)(F.ws + WS_PROJ);
    const int tid = F.tid, lane = F.lane, w = F.wave;
    const int ci = F.vcu >> 2, qt = F.vcu & 3, dir = ci >> 5, bb = (ci >> 2) & 7, h = ci & 3;
    const int cp = lane & 31, rowl = 2 * w + (lane >> 5);
    LAS unsigned char* lds = F.lds;
    const unsigned char* prep = F.ws + WS_PREP + ((size_t)((dir * NB + bb) * 4 + h) * T) * 512;
    const bf16* rbase = proj + (size_t)bb * T * NPROJP + C_R + h * 64;
    const bf16* vbase = proj + (size_t)bb * T * NPROJP + C_V + h * 64 + 16 * qt;
    bf16* ysc = (bf16*)(F.ws + WS_YSC) + ((size_t)dir * M + (size_t)bb * T) * 256 + h * 64 + 16 * qt;
    v4u prec[4]; unsigned prr[4]; unsigned short pvv[2];
    auto tmap = [&](int gs) -> int { return dir ? (T - 1 - gs) : gs; };
    auto issue = [&](int ch) {
#pragma unroll
        for (int i = 0; i < 4; ++i) { const int pi = tid + 512 * i, s = pi >> 5, c = pi & 31; prec[i] = *(const GAS v4u*)(prep + (size_t)tmap(ch * SC_CH + s) * 512 + c * 16); }
#pragma unroll
        for (int i = 0; i < 4; ++i) { const int e = tid + 512 * i, s = e >> 5, c = e & 31; prr[i] = *(const GAS unsigned*)(rbase + (size_t)tmap(ch * SC_CH + s) * NPROJP + 2 * c); }
#pragma unroll
        for (int i = 0; i < 2; ++i) { const int e = tid + 512 * i, s = e >> 4, r = e & 15; pvv[i] = vbase[(size_t)tmap(ch * SC_CH + s) * NPROJP + r]; }
    };
    auto commit = [&](int buf) {
        LAS unsigned char* B = lds + buf * SC_BUF;
#pragma unroll
        for (int i = 0; i < 4; ++i) { const int pi = tid + 512 * i; *(LAS v4u*)(B + SC_REC + pi * 16) = prec[i]; }
#pragma unroll
        for (int i = 0; i < 4; ++i) { const int e = tid + 512 * i, s = e >> 5, c = e & 31; *(LAS unsigned*)(B + SC_RR + ((s >> 2) * 32 + c) * 16 + (s & 3) * 4) = prr[i]; }
#pragma unroll
        for (int i = 0; i < 2; ++i) { const int e = tid + 512 * i, s = e >> 4, r = e & 15; *(LAS unsigned short*)(B + SC_VV + ((s >> 3) * 16 + r) * 16 + (s & 7) * 2) = pvv[i]; }
    };
    float S0 = 0.f, S1 = 0.f, ybuf = 0.f;
    issue(0); commit(0); __syncthreads();
    for (int ch = 0; ch < T / SC_CH; ++ch) {
        if (ch + 1 < T / SC_CH) issue(ch + 1);
        const LAS unsigned char* B = lds + (ch & 1) * SC_BUF;
#pragma unroll 1
        for (int g8 = 0; g8 < 8; ++g8) {
            const v4u vq = *(const LAS v4u*)(B + SC_VV + (g8 * 16 + rowl) * 16);
#pragma unroll
            for (int g4 = 0; g4 < 2; ++g4) {
                const v4u rq = *(const LAS v4u*)(B + SC_RR + ((g8 * 2 + g4) * 32 + cp) * 16);
#pragma unroll
                for (int j = 0; j < 4; ++j) {
                    const int s8 = g4 * 4 + j, s = g8 * 8 + s8;
                    const v4u rec = *(const LAS v4u*)(B + SC_REC + s * 512 + cp * 16);
                    const h2 wv = as_h2(rec.x), kv = as_h2(rec.y), bv = as_h2(rec.z), ev = as_h2(rec.w);
                    const unsigned vw = vq[s8 >> 1]; const float vv = (s8 & 1) ? bfhi(vw) : bflo(vw);
                    const unsigned rw = rq[j]; const float r0 = bflo(rw), r1 = bfhi(rw);
                    float part = S0 * (float)kv.x + S1 * (float)kv.y;
                    part = row16_sum(part); part += __shfl_xor(part, 16);
                    const float nsa = -part;
                    S0 = S0 * (float)wv.x + (nsa * (float)bv.x + vv * (float)ev.x);
                    S1 = S1 * (float)wv.y + (nsa * (float)bv.y + vv * (float)ev.y);
                    float yp = S0 * r0 + S1 * r1;
                    yp = row16_sum(yp);
                    yp += __builtin_bit_cast(float, __builtin_amdgcn_update_dpp(0, __builtin_bit_cast(int, yp), 0x142, 0xA, 0xF, false));
                    ybuf = ((lane & 15) == (s & 15)) ? yp : ybuf;
                }
            }
            if (g8 & 1) { if (lane & 16) *(LAS unsigned short*)(lds + SC_YB + (((g8 >> 1) * 16 + (lane & 15)) * 16 + rowl) * 2) = (unsigned short)f2bf(ybuf); }
        }
        __syncthreads();
        if (tid < 128) { const int s = tid >> 1, hf = tid & 1; const v4u yv = *(const LAS v4u*)(lds + SC_YB + (s * 16 + 8 * hf) * 2);
            *(GAS v4u*)(ysc + (size_t)tmap(ch * SC_CH + s) * 256 + 8 * hf) = yv; }
        if (ch + 1 < T / SC_CH) commit((ch + 1) & 1);
        __syncthreads();
    }
}

__device__ __forceinline__ void phase_rwkv_post(Frame& F, int l) {
    LAUNDER(F);
    const bf16* proj = (const bf16*)(F.ws + WS_PROJ); bf16* merged = (bf16*)(F.ws + WS_MERGED); const bf16* ysc = (const bf16*)(F.ws + WS_YSC);
    const int lane = F.lane, c4 = 4 * lane, hd = lane >> 4;
    LAS float* GUP = (LAS float*)F.lds;
    for (int q = F.tid; q < 32 * 256; q += NTHREADS) GUP[q] = INP(F, I_RGUP)[(size_t)l * 32 * 256 + q];
    __syncthreads();
    const f32x4 lw = *(const f32x4*)(INP(F, I_LNXW) + l * 256 + c4), lb = *(const f32x4*)(INP(F, I_LNXB) + l * 256 + c4), rk = *(const f32x4*)(INP(F, I_RRK) + l * 256 + c4);
    for (int m = F.vcu * NWAVES + F.wave; m < M; m += F.G * NWAVES) {
        const bf16* row = proj + (size_t)m * NPROJP;
        const v2u yf = *(const GAS v2u*)(ysc + (size_t)m * 256 + c4), yb = *(const GAS v2u*)(ysc + ((size_t)M + m) * 256 + c4);
        f32x4 y = (f32x4){bflo(yf.x) + bflo(yb.x), bfhi(yf.x) + bfhi(yb.x), bflo(yf.y) + bflo(yb.y), bfhi(yf.y) + bfhi(yb.y)};
        const float mu = row16_sum((y.x + y.y) + (y.z + y.w)) * (1.f / 64.f);
        y = y - mu;
        const float var = row16_sum((y.x * y.x + y.y * y.y) + (y.z * y.z + y.w * y.w)) * (1.f / 64.f);
        const float rstd = 1.f / sqrtf(var + GN_EPS);
        y = y * rstd * lw + lb;
        const v2u ru = *(const GAS v2u*)(row + C_R + c4), ku = *(const GAS v2u*)(row + C_K + c4), vu = *(const GAS v2u*)(row + C_V + c4);
        const f32x4 r = (f32x4){bflo(ru.x), bfhi(ru.x), bflo(ru.y), bfhi(ru.y)}, k = (f32x4){bflo(ku.x), bfhi(ku.x), bflo(ku.y), bfhi(ku.y)}, v = (f32x4){bflo(vu.x), bfhi(vu.x), bflo(vu.y), bfhi(vu.y)};
        const f32x4 rkk = r * k * rk;
        const float bsum = row16_sum((rkk.x + rkk.y) + (rkk.z + rkk.w));
        y = y + v * bsum;
        const float gd = sigmoidf_(bf2f(row[C_GDN + (lane & 31)]));
        f32x4 gt = (f32x4){0.f, 0.f, 0.f, 0.f};
#pragma unroll
        for (int j = 0; j < 32; ++j) { const float gj = __builtin_bit_cast(float, __builtin_amdgcn_readlane(__builtin_bit_cast(int, gd), j)); gt = gt + *(const LAS f32x4*)(GUP + j * 256 + c4) * gj; }
        y = y * gt;
        const float ss = wave_sum((y.x * y.x + y.y * y.y) + (y.z * y.z + y.w * y.w));
        const float sc = 1.f / sqrtf(ss * (1.f / 256.f) + NORM_EPS);
        v2u o; o.x = pk2(y.x * sc, y.y * sc); o.y = pk2(y.z * sc, y.w * sc);
        *(GAS v2u*)(merged + (size_t)m * DM + 256 + c4) = o;
    }
    (void)hd;
}

__device__ __forceinline__ void phase_residual(Frame& F, const float* xi, float* xo, const float* gain, bool next) {
    LAUNDER(F);
    const float* y = (const float*)(F.ws + WS_Y); const float* part = (const float*)(F.ws + WS_PART);
    bf16* xb = (bf16*)(F.ws + WS_XB); float* rs = (float*)(F.ws + WS_RS);
    const int lane = F.lane;
    f32x4 gv[4];
#pragma unroll
    for (int j = 0; j < 4; ++j) gv[j] = *((const f32x4*)gain + lane + 64 * j);
    for (int m = F.vcu * NWAVES + F.wave; m < M; m += F.G * NWAVES) {
        const f32x4* pp = (const f32x4*)(part + (size_t)m * 16);
        const f32x4 p0 = *(const GAS f32x4*)(pp), p1 = *(const GAS f32x4*)(pp + 1), p2 = *(const GAS f32x4*)(pp + 2), p3 = *(const GAS f32x4*)(pp + 3);
        const float tot = ((p0.x + p0.y) + (p0.z + p0.w)) + ((p1.x + p1.y) + (p1.z + p1.w)) + ((p2.x + p2.y) + (p2.z + p2.w)) + ((p3.x + p3.y) + (p3.z + p3.w));
        const float sc = 1.f / sqrtf(tot * (1.f / DM) + NORM_EPS);
        const GAS f32x4* yr = (const GAS f32x4*)(y + (size_t)m * DM) + lane; const GAS f32x4* xr = (const GAS f32x4*)(xi + (size_t)m * DM) + lane;
        GAS f32x4* orow = (GAS f32x4*)(xo + (size_t)m * DM) + lane;
        f32x4 v[4]; float s = 0.f;
#pragma unroll
        for (int j = 0; j < 4; ++j) { v[j] = xr[64 * j] + yr[64 * j] * sc * gv[j]; s += (v[j].x * v[j].x + v[j].y * v[j].y) + (v[j].z * v[j].z + v[j].w * v[j].w); }
#pragma unroll
        for (int j = 0; j < 4; ++j) {
#ifdef DBG_SANITIZE
            for (int q = 0; q < 4; ++q) if (!(fabsf(v[j][q]) < 1e30f)) v[j][q] = 777.f;
#endif
            orow[64 * j] = v[j]; }
        if (next) {
            s = wave_sum(s);
            GAS v2u* o8 = (GAS v2u*)(xb + (size_t)m * DM) + lane;
#pragma unroll
            for (int j = 0; j < 4; ++j) { v2u o; o.x = pk2(v[j].x, v[j].y); o.y = pk2(v[j].z, v[j].w); o8[64 * j] = o; }
            if (lane == 0) rs[m] = 1.f / sqrtf(s * (1.f / DM) + NORM_EPS);
        }
    }
}
__device__ __forceinline__ void phase_ffn_conv(Frame& F, int l) {
    LAUNDER(F);
    const bf16* G = (const bf16*)(F.ws + WS_G); bf16* L = (bf16*)(F.ws + WS_L);
    const float* cw = INP(F, I_FCONV) + (size_t)l * 3 * DFF;
    constexpr int CPR = DFF / 8, STRIP = 16;
    const int nitems = (M / STRIP) * CPR;
    for (int it = F.vcu * NTHREADS + F.tid; it < nitems; it += F.G * NTHREADS) {
        const int ck = it % CPR, strip = it / CPR, m0 = strip * STRIP, t0 = m0 % T, c8 = 8 * ck;
        float w0[8], w1[8], w2[8];
#pragma unroll
        for (int j = 0; j < 8; ++j) { w0[j] = cw[c8 + j]; w1[j] = cw[DFF + c8 + j]; w2[j] = cw[2 * DFF + c8 + j]; }
        auto gload = [&](int t, int m) -> v4u { if (t < 0 || t >= T) return (v4u){0u, 0u, 0u, 0u}; return *(const GAS v4u*)(G + (size_t)m * DFF + c8); };
        v4u gp = gload(t0 - 1, m0 - 1), gc = gload(t0, m0);
#pragma unroll 4
        for (int i = 0; i < STRIP; ++i) {
            const v4u gn = gload(t0 + i + 1, m0 + i + 1);
            const v4u lv = *(const GAS v4u*)(L + (size_t)(m0 + i) * DFF + c8);
            v4u o;
#pragma unroll
            for (int q = 0; q < 4; ++q) {
                const float a0 = w0[2 * q] * bflo(gp[q]) + w1[2 * q] * bflo(gc[q]) + w2[2 * q] * bflo(gn[q]);
                const float a1 = w0[2 * q + 1] * bfhi(gp[q]) + w1[2 * q + 1] * bfhi(gc[q]) + w2[2 * q + 1] * bfhi(gn[q]);
                o[q] = pk2(gelu_tanh(a0) * bflo(lv[q]), gelu_tanh(a1) * bfhi(lv[q])); }
            *(GAS v4u*)(L + (size_t)(m0 + i) * DFF + c8) = o;
            gp = gc; gc = gn; }
    }
}

#ifndef MK_N_LAUNCHES
#define MK_N_LAUNCHES 1
#endif
constexpr int NPH = 1 + 10 * DEPTH;
struct Args { const float* in[26]; float* out; unsigned char* ws; int ph_lo, ph_hi; };
__global__ void __launch_bounds__(NTHREADS, 2) enc_fwd(Args args) {
    extern __shared__ __attribute__((aligned(16))) unsigned char lds_raw[];
    Frame F;
    F.lds = (LAS unsigned char*)lds_raw;
    F.MISC = (volatile LAS unsigned*)(F.lds + MISC_OFF);
    F.tid = threadIdx.x; F.lane = F.tid & 63; F.wave = __builtin_amdgcn_readfirstlane(F.tid >> 6);
    F.G = gridDim.x; { const int bx = blockIdx.x; F.vcu = (F.G % 8 == 0) ? (bx % 8) * (F.G / 8) + bx / 8 : bx; }
    F.ws = args.ws; F.out = args.out; F.ctl = (gu32*)(args.ws + WS_CTL);
    F.karg = (kq_t*)__builtin_amdgcn_kernarg_segment_ptr();
    for (int u = F.tid; u < (LDS_BYTES - LDSCTL_OFF) / 4; u += NTHREADS) ((LAS unsigned*)(F.lds + LDSCTL_OFF))[u] = 0u;
    __syncthreads();
    const int lo = args.ph_lo, hi = args.ph_hi;
    XcdBarrier bar; bar.bar = (unsigned*)(F.ctl + CW_BAR); bar.x = 0; bar.st = nullptr;
    if (hi - lo > 1) bar = xcd_barrier_post((unsigned*)(F.ctl + CW_BAR), F.MISC + 8);
#ifndef PH_ENABLE
#define PH_ENABLE 0x7ff
#endif
#define IN(k) (lo <= (k) && (k) < hi)
#define EN(t) (((PH_ENABLE) >> (t)) & 1)
#pragma unroll 1
    for (int ph = lo; ph < hi; ++ph) {
        LAUNDER(F);
        const int l = ph == 0 ? 0 : (ph - 1) / 10, t = ph == 0 ? 0 : 1 + (ph - 1) % 10;
        unsigned char* wl = F.ws + WS_W + (size_t)l * W_LAYER;
        if (t == 1 || t == 5 || t == 7 || t == 9) {
            pg8::Gemm g; pg8::EpiUni E; E.mode = (t == 1 || t == 7) ? 0 : 1;
            E.e0.rs = (const float*)(F.ws + WS_RS); E.e1.C = (float*)(F.ws + WS_Y); E.e1.ldc = DM; E.e1.part = (float*)(F.ws + WS_PART);
            g.M = M;
            if (t == 1)      { g.A = (const bf16*)(F.ws + WS_XB);     g.Bt = (const bf16*)(wl + W_IN);  g.N = NPROJP; g.K = DM;  E.e0.O = (bf16*)(F.ws + WS_PROJ); E.e0.ldc = NPROJP; E.e0.split_cols = 0; E.e0.split_stride = 0; }
            else if (t == 5) { g.A = (const bf16*)(F.ws + WS_MERGED); g.Bt = (const bf16*)(wl + W_OUT); g.N = DM;     g.K = DM;  E.e0.O = nullptr; E.e0.ldc = 0; E.e0.split_cols = 0; E.e0.split_stride = 0; }
            else if (t == 7) { g.A = (const bf16*)(F.ws + WS_XB);     g.Bt = (const bf16*)(wl + W_UP);  g.N = NUP;    g.K = DM;  E.e0.O = (bf16*)(F.ws + WS_G); E.e0.ldc = DFF; E.e0.split_cols = DFF; E.e0.split_stride = (size_t)(WS_L - WS_G) / 2; }
            else             { g.A = (const bf16*)(F.ws + WS_L);      g.Bt = (const bf16*)(wl + W_DN);  g.N = DM;     g.K = DFF; E.e0.O = nullptr; E.e0.ldc = 0; E.e0.split_cols = 0; E.e0.split_stride = 0; }
            pg8::StaticOrder S; S.init(M, g.N, F.G, (int)blockIdx.x);
            pg8::gemm_phase<pg8::EpiUni, pg8::StaticOrder, true, true>(F.lds, g, S, E);
        }
        else if (t == 0) p0_prologue(F);
        else if (t == 2) phase_mixers(F, l);
        else if (t == 3) phase_scan(F);
        else if (t == 4) phase_rwkv_post(F, l);
        else if (t == 6) phase_residual(F, (l == 0) ? INP(F, I_X) : F.out, F.out, INP(F, I_NMPOST) + l * DM, true);
        else if (t == 8) phase_ffn_conv(F, l);
        else             phase_residual(F, F.out, F.out, INP(F, I_NFPOST) + l * DM, l + 1 < DEPTH);
        if (ph + 1 < hi) xcd_barrier(bar);
    }
}


#ifdef DBG_CHECK
__global__ void dbg_check(const void* buf, size_t n, int kind, int code, unsigned* flag) {
    bool bad = false;
    for (size_t i = (size_t)blockIdx.x * blockDim.x + threadIdx.x; i < n; i += (size_t)gridDim.x * blockDim.x) {
        float v;
        if (kind == 0) v = bf2f(((const unsigned short*)buf)[i]);
        else if (kind == 1) v = ((const float*)buf)[i];
        else v = (float)((const _Float16*)buf)[i];
        if (!(fabsf(v) < 1e30f)) bad = true;
    }
    if (bad) atomicMax(flag, (unsigned)(1000000 - code));
}
__global__ void dbg_report(float* out, const unsigned* flag) { if (threadIdx.x == 0 && blockIdx.x == 0) { const unsigned f = *flag; if (f) out[0] = 100000.f * (float)(10 + 1000000 - (int)f); } }
#endif
extern "C" void kernel_launch(void* const* d_in, const int* in_sizes, int n_in, void* d_out, int out_size, void* d_ws, size_t ws_size, hipStream_t stream) {
    static int grid = 0;
    if (grid == 0) {
        if (n_in != 26 || in_sizes[0] != M * DM || out_size != M * DM || ws_size < WS_END) { fprintf(stderr, "kernel_launch: unexpected shapes: n_in %d in0 %d out %d ws %zu (need >= %zu)\n", n_in, n_in > 0 ? in_sizes[0] : -1, out_size, ws_size, (size_t)WS_END); grid = -1; return; }
        int dev = 0, cus = 0, per_cu = 0;
        if (hipGetDevice(&dev) != hipSuccess || hipDeviceGetAttribute(&cus, hipDeviceAttributeMultiprocessorCount, dev) != hipSuccess) { grid = -1; return; }
        if (hipFuncSetAttribute((const void*)enc_fwd, hipFuncAttributeMaxDynamicSharedMemorySize, LDS_BYTES) != hipSuccess) { fprintf(stderr, "kernel_launch: hipFuncSetAttribute failed\n"); grid = -1; return; }
        if (hipOccupancyMaxActiveBlocksPerMultiprocessor(&per_cu, (const void*)enc_fwd, NTHREADS, LDS_BYTES) != hipSuccess || per_cu < 1) { fprintf(stderr, "kernel_launch: occupancy query says %d blocks per CU\n", per_cu); }
        (void)hipGetLastError();
        grid = cus;
        if (grid != 256) fprintf(stderr, "kernel_launch: %d CUs (built for 256)\n", grid);
    }
    if (grid < 0) return;
    (void)hipMemsetAsync((char*)d_ws + WS_CTL, 0, CTL_ZERO_BYTES, stream);
    Args a{};
    for (int i = 0; i < 26; ++i) a.in[i] = (const float*)d_in[i];
    a.out = (float*)d_out; a.ws = (unsigned char*)d_ws;
#if MK_N_LAUNCHES == 1
    a.ph_lo = 0; a.ph_hi = NPH;
    hipLaunchKernelGGL(enc_fwd, dim3(grid), dim3(NTHREADS), LDS_BYTES, stream, a);
#else
    for (int p = 0; p < NPH; ++p) { a.ph_lo = p; a.ph_hi = p + 1; hipLaunchKernelGGL(enc_fwd, dim3(grid), dim3(NTHREADS), LDS_BYTES, stream, a);
#ifdef DBG_CHECK
        unsigned* flag = (unsigned*)((char*)d_ws + 512 * 1024); char* ws = (char*)d_ws; const int t = p == 0 ? 0 : 1 + (p - 1) % 10;
#define CHK(ptr, n, kind, sub) hipLaunchKernelGGL(dbg_check, dim3(2048), dim3(256), 0, stream, (const void*)(ptr), (size_t)(n), kind, p * 4 + sub, flag)
        if (t == 0) { CHK(ws + WS_W, 2 * W_LAYER / 2, 0, 0); CHK(ws + WS_XB, (size_t)M * DM, 0, 1); CHK(ws + WS_RS, M, 1, 2); }
        if (t == 1) { CHK(ws + WS_PROJ, (size_t)M * NPROJP, 0, 0); }
        if (t == 2) { CHK(ws + WS_PREP, (size_t)64 * MiB, 2, 1); }
        if (t == 3) { CHK(ws + WS_YSC, (size_t)2 * M * 256, 0, 0); }
        if (t == 4) { CHK(ws + WS_MERGED, (size_t)M * DM, 0, 0); }
        if (t == 5 || t == 9) { CHK(ws + WS_Y, (size_t)M * DM, 1, 0); CHK(ws + WS_PART, (size_t)M * 16, 1, 1); }
        if (t == 6 || t == 10) { CHK(d_out, (size_t)M * DM, 1, 0); CHK(ws + WS_XB, (size_t)M * DM, 0, 1); CHK(ws + WS_RS, M, 1, 2); }
        if (t == 7) { CHK(ws + WS_G, (size_t)M * DFF, 0, 0); CHK(ws + WS_L, (size_t)M * DFF, 0, 1); }
        if (t == 8) { CHK(ws + WS_L, (size_t)M * DFF, 0, 0); }
        if (p == NPH - 1) hipLaunchKernelGGL(dbg_report, dim3(1), dim3(64), 0, stream, (float*)d_out, (const unsigned*)flag);
#endif
    }
#endif
}
```

```cpp
#include <hip/hip_runtime.h>
#include <cstdio>
#include <cstdint>
namespace pg8 {
#define PG8_LAS __attribute__((address_space(3)))
typedef unsigned short bf16_t;
typedef short bf16x8 __attribute__((ext_vector_type(8)));
typedef float f32x4 __attribute__((ext_vector_type(4)));
typedef unsigned u32x4 __attribute__((ext_vector_type(4)));
constexpr int BM = 256, BK = 64, HALF = 128, HTB = HALF * BK * 2  , STAGE_BYTES = 8 * HTB, NXCD = 8, WGM = 8;

__host__ __device__ __forceinline__ int lds_byte(int r, int c) { const int st = (r >> 4) * 2 + (c >> 5), rr = r & 15, cc = c & 31, ob = rr * 64 + cc * 2; return st * 1024 + (ob ^ (((ob >> 9) & 1) << 5)); }
__host__ __device__ __forceinline__ void stage_rc(int b, int& R, int& C) { const int st = b / 1024, sb = b % 1024, swz = sb ^ (((sb >> 9) & 1) << 5); R = (st >> 1) * 16 + swz / 64; C = (st & 1) * 32 + (swz % 64) / 2; }
__host__ __device__ __forceinline__ int perm32(int rho) { const int n = rho >> 4, i = rho & 15; return 8 * (i >> 2) + 4 * n + (i & 3); }

struct Unit { int pm, pn; };
struct Gemm { const bf16_t* A; const bf16_t* Bt; int M, N, K; };

struct StaticOrder {
    int nM, nN, nwg, G, c;
    __host__ __device__ void init(int M, int N, int G_, int c_) { nM = M / BM; nN = N / BM; nwg = nM * nN; G = G_; c = c_; }
    __host__ __device__ bool next(int i, Unit& u) const {
        const long L = (long)i * G + c; if (L >= nwg) return false;
        int wgid = (int)L; { const int q = nwg / NXCD, r = nwg % NXCD, xcd = wgid % NXCD, off = wgid / NXCD; wgid = (xcd < r ? xcd * (q + 1) : r * (q + 1) + (xcd - r) * q) + off; }
        const int nig = WGM * nN, gid = wgid / nig, fm = gid * WGM, gsz = (nM - fm) < WGM ? (nM - fm) : WGM;
        u.pm = fm + ((wgid % nig) % gsz); u.pn = (wgid % nig) / gsz; return true;
    }
    __device__ __forceinline__ void a_ready(const Unit&) const {}
    __device__ __forceinline__ void done(const Unit&) const {}
};
__device__ __forceinline__ unsigned cvt_pk_bf16(float lo, float hi) { unsigned r; asm volatile("v_cvt_pk_bf16_f32 %0, %1, %2" : "=v"(r) : "v"(lo), "v"(hi)); return r; }
struct EpiUni {
    static constexpr bool AFTER_DRAIN = false;
    bf16_t* O; int ldc; const float* rs; int split_cols; size_t split_stride; float* part;
    __device__ __forceinline__ bool perm() const { return true; }
    __device__ __forceinline__ void operator()(const f32x4 (&acc)[2][2][4][2], const Unit& u, int wr, int wc, int fr, int fq) const {
        const int row0 = u.pm * BM + wr * 64 + fr; int colt = u.pn * BM; bf16_t* base = O;
        if (split_cols) { const int t = colt / split_cols; base += (size_t)t * split_stride; colt -= t * split_cols; }
        const int col0 = colt + wc * 32 + 8 * fq;
        if (part == nullptr) {
#pragma unroll
            for (int ai = 0; ai < 2; ++ai)
#pragma unroll
                for (int m = 0; m < 4; ++m) { const int row = row0 + ai * HALF + m * 16; const float s = rs[row]; bf16_t* rowp = base + (size_t)row * ldc + col0;
#pragma unroll
                    for (int bj = 0; bj < 2; ++bj) { const f32x4 v0 = acc[ai][bj][m][0] * s, v1 = acc[ai][bj][m][1] * s;
                        u32x4 w; w.x = cvt_pk_bf16(v0[0], v0[1]); w.y = cvt_pk_bf16(v0[2], v0[3]); w.z = cvt_pk_bf16(v1[0], v1[1]); w.w = cvt_pk_bf16(v1[2], v1[3]);
                        *(u32x4*)(rowp + bj * HALF) = w; } }
        } else {
#pragma unroll
            for (int ai = 0; ai < 2; ++ai)
#pragma unroll
                for (int m = 0; m < 4; ++m) { const int row = row0 + ai * HALF + m * 16; bf16_t* rowp = base + (size_t)row * ldc + col0; float ss = 0.f;
#pragma unroll
                    for (int bj = 0; bj < 2; ++bj) { const f32x4 v0 = acc[ai][bj][m][0], v1 = acc[ai][bj][m][1];
                        ss += ((v0[0] * v0[0] + v0[1] * v0[1]) + (v0[2] * v0[2] + v0[3] * v0[3])) + ((v1[0] * v1[0] + v1[1] * v1[1]) + (v1[2] * v1[2] + v1[3] * v1[3]));
                        u32x4 w; w.x = cvt_pk_bf16(v0[0], v0[1]); w.y = cvt_pk_bf16(v0[2], v0[3]); w.z = cvt_pk_bf16(v1[0], v1[1]); w.w = cvt_pk_bf16(v1[2], v1[3]);
                        *(u32x4*)(rowp + bj * HALF) = w; }
                    ss += __shfl_xor(ss, 16); ss += __shfl_xor(ss, 32); if (fq == 0) part[(size_t)row * 16 + u.pn * 4 + wc] = ss; }
        }
    }
};
template <class Epi, class Sched, bool ALIGN_EPI = false, bool SP2 = false>
__device__ __forceinline__ void gemm_phase(PG8_LAS unsigned char* lds, const Gemm g, const Sched& S, const Epi& E) {
    int tid_ = threadIdx.x; asm volatile("" : "+v"(tid_));
    const int tid = tid_, wid = __builtin_amdgcn_readfirstlane(tid >> 6), lane = tid & 63, wr = wid >> 2, wc = wid & 3, fr = lane & 15, fq = lane >> 4;
    const int K = g.K, nt = K / BK;
    unsigned voffA[2], voffB[2];
#pragma unroll
    for (int i = 0; i < 2; ++i) { int R, C; stage_rc(tid * 16 + i * 8192, R, C); const int Rb = E.perm() ? ((R & ~31) + perm32(R & 31)) : R;
        voffA[i] = (unsigned)(R * K + C) * 2u; voffB[i] = (unsigned)(Rb * K + C) * 2u; }
    const size_t kstep = (size_t)(BK * 2);
    const size_t hstep = (size_t)HALF * K * 2;
    const size_t tstep = 2 * hstep;
    const unsigned ldsw = (unsigned)wid * 1024u;
    const int aoff = lds_byte(wr * 64 + fr, fq * 8), boff = lds_byte(wc * 32 + fr, fq * 8);
#define PG8_SA(b, h) (((b) * 2 + (h)) * HTB)
#define PG8_SB(b, h) ((4 + (b) * 2 + (h)) * HTB)
#define PG8_STAGE(bufoff, gbase, voff) do { _Pragma("unroll") for (int _i = 0; _i < 2; ++_i) \
        __builtin_amdgcn_global_load_lds((const unsigned*)((const char*)(gbase) + (voff)[_i]), (PG8_LAS unsigned*)(lds + (bufoff) + ldsw + _i * 8192), 16, 0, 0); } while (0)
#define PG8_LDA(dst, b, h) do { _Pragma("unroll") for (int m = 0; m < 4; ++m) _Pragma("unroll") for (int k = 0; k < 2; ++k) dst[m][k] = *(const PG8_LAS bf16x8*)(lds + PG8_SA(b, h) + aoff + m * 2048 + k * 1024); } while (0)
#define PG8_LDB(dst, b, h) do { _Pragma("unroll") for (int n = 0; n < 2; ++n) _Pragma("unroll") for (int k = 0; k < 2; ++k) dst[n][k] = *(const PG8_LAS bf16x8*)(lds + PG8_SB(b, h) + boff + n * 2048 + k * 1024); } while (0)
#define PG8_MMA(ai, bj, At, Bt) do { __builtin_amdgcn_s_setprio(1); _Pragma("unroll") for (int m = 0; m < 4; ++m) _Pragma("unroll") for (int n = 0; n < 2; ++n) _Pragma("unroll") for (int k = 0; k < 2; ++k) \
        acc[ai][bj][m][n] = __builtin_amdgcn_mfma_f32_16x16x32_bf16(Bt[n][k], At[m][k], acc[ai][bj][m][n], 0, 0, 0); __builtin_amdgcn_s_setprio(0); } while (0)
#define PG8_WAIT_V(n) asm volatile("s_waitcnt vmcnt(" #n ")" ::: "memory")
#define PG8_WAIT_L(n) asm volatile("s_waitcnt lgkmcnt(" #n ")" ::: "memory")
#define PG8_BAR __builtin_amdgcn_s_barrier()
#define PG8_SCHED __builtin_amdgcn_sched_barrier(0)
    Unit cur, nxt; int ui = 0;
    if (!S.next(0, cur)) return;
    f32x4 acc[2][2][4][2];
#pragma unroll
    for (int a = 0; a < 2; ++a)
#pragma unroll
        for (int b = 0; b < 2; ++b)
#pragma unroll
            for (int m = 0; m < 4; ++m)
#pragma unroll
                for (int n = 0; n < 2; ++n) acc[a][b][m][n] = (f32x4){0.f, 0.f, 0.f, 0.f};
    bf16x8 At[4][2], B0[2][2], B1[2][2];
    const char* cA = (const char*)g.A + (size_t)cur.pm * tstep; const char* cB = (const char*)g.Bt + (size_t)cur.pn * tstep;
    S.a_ready(cur);
    if constexpr (SP2) {
        PG8_STAGE(PG8_SB(0, 0), cB, voffB); PG8_STAGE(PG8_SB(0, 1), cB + hstep, voffB); PG8_STAGE(PG8_SA(0, 0), cA, voffA); PG8_STAGE(PG8_SA(0, 1), cA + hstep, voffA);
        if (wr == 1) PG8_BAR;
        PG8_WAIT_V(2); PG8_BAR;
        PG8_STAGE(PG8_SB(1, 0), cB + kstep, voffB); PG8_STAGE(PG8_SA(1, 0), cA + kstep, voffA); PG8_STAGE(PG8_SB(1, 1), cB + hstep + kstep, voffB);
        PG8_WAIT_V(6); PG8_BAR;
    } else {
        PG8_STAGE(PG8_SB(0, 0), cB, voffB); PG8_STAGE(PG8_SA(0, 0), cA, voffA); PG8_STAGE(PG8_SB(0, 1), cB + hstep, voffB); PG8_STAGE(PG8_SA(0, 1), cA + hstep, voffA);
        if (wr == 1) PG8_BAR;
        PG8_WAIT_V(4); PG8_BAR;
        PG8_STAGE(PG8_SB(1, 0), cB + kstep, voffB); PG8_STAGE(PG8_SA(1, 0), cA + kstep, voffA); PG8_STAGE(PG8_SB(1, 1), cB + hstep + kstep, voffB);
        PG8_WAIT_V(6); PG8_BAR;
    }
    for (;;) {
        const bool has_next = S.next(ui + 1, nxt);
        const char* nA = has_next ? (const char*)g.A + (size_t)nxt.pm * tstep : cA; const char* nB = has_next ? (const char*)g.Bt + (size_t)nxt.pn * tstep : cB;
        for (int t = 0; t < nt; t += 2) {
            const bool last = (t == nt - 2);
            const char* a1 = cA + (size_t)(t + 1) * kstep;
            const char* a2 = last ? nA : cA + (size_t)(t + 2) * kstep; const char* b2 = last ? nB : cB + (size_t)(t + 2) * kstep;
            const char* a3 = a2 + kstep; const char* b3 = b2 + kstep;
            if (last && has_next) S.a_ready(nxt);
            if constexpr (SP2) {
            PG8_LDB(B0, 0, 0); PG8_LDB(B1, 0, 1); PG8_SCHED; PG8_LDA(At, 0, 0); PG8_STAGE(PG8_SA(1, 1), a1 + hstep, voffA);
            PG8_WAIT_V(8); PG8_WAIT_L(0); PG8_BAR; PG8_MMA(0, 0, At, B0); PG8_MMA(0, 1, At, B1); PG8_BAR; PG8_SCHED;
            PG8_LDA(At, 0, 1); PG8_STAGE(PG8_SB(0, 0), b2, voffB); PG8_STAGE(PG8_SB(0, 1), b2 + hstep, voffB); PG8_STAGE(PG8_SA(0, 0), a2, voffA);
            PG8_WAIT_V(8); PG8_WAIT_L(0); PG8_BAR; PG8_MMA(1, 0, At, B0); PG8_MMA(1, 1, At, B1); PG8_BAR; PG8_SCHED;
            PG8_LDB(B0, 1, 0); PG8_LDB(B1, 1, 1); PG8_SCHED; PG8_LDA(At, 1, 0); PG8_STAGE(PG8_SA(0, 1), a2 + hstep, voffA);
            PG8_WAIT_V(8); PG8_WAIT_L(0); PG8_BAR; PG8_MMA(0, 0, At, B0); PG8_MMA(0, 1, At, B1); PG8_BAR; PG8_SCHED;
            PG8_LDA(At, 1, 1); PG8_STAGE(PG8_SB(1, 0), b3, voffB); PG8_STAGE(PG8_SB(1, 1), b3 + hstep, voffB); PG8_STAGE(PG8_SA(1, 0), a3, voffA);
            PG8_WAIT_V(8); PG8_WAIT_L(0); PG8_BAR; PG8_MMA(1, 0, At, B0); PG8_MMA(1, 1, At, B1); PG8_BAR; PG8_SCHED;
            } else {
            PG8_LDB(B0, 0, 0); PG8_SCHED; PG8_LDA(At, 0, 0); PG8_STAGE(PG8_SA(1, 1), a1 + hstep, voffA);
            PG8_WAIT_L(8); PG8_BAR; PG8_WAIT_L(0); PG8_MMA(0, 0, At, B0); PG8_BAR; PG8_SCHED;
            PG8_LDB(B1, 0, 1); PG8_STAGE(PG8_SB(0, 0), b2, voffB);
            PG8_BAR; PG8_WAIT_L(0); PG8_MMA(0, 1, At, B1); PG8_BAR;
            PG8_LDA(At, 0, 1); PG8_STAGE(PG8_SA(0, 0), a2, voffA);
            PG8_BAR; PG8_WAIT_L(0); PG8_MMA(1, 0, At, B0); PG8_BAR; PG8_SCHED;
            PG8_STAGE(PG8_SB(0, 1), b2 + hstep, voffB);
            PG8_WAIT_V(6); PG8_BAR; PG8_MMA(1, 1, At, B1); PG8_BAR;
            PG8_LDB(B0, 1, 0); PG8_SCHED; PG8_LDA(At, 1, 0); PG8_STAGE(PG8_SA(0, 1), a2 + hstep, voffA);
            PG8_WAIT_L(8); PG8_BAR; PG8_WAIT_L(0); PG8_MMA(0, 0, At, B0); PG8_BAR; PG8_SCHED;
            PG8_LDB(B1, 1, 1); PG8_STAGE(PG8_SB(1, 0), b3, voffB);
            PG8_BAR; PG8_WAIT_L(0); PG8_MMA(0, 1, At, B1); PG8_BAR;
            PG8_LDA(At, 1, 1); PG8_STAGE(PG8_SA(1, 0), a3, voffA);
            PG8_BAR; PG8_WAIT_L(0); PG8_MMA(1, 0, At, B0); PG8_BAR; PG8_SCHED;
            PG8_STAGE(PG8_SB(1, 1), b3 + hstep, voffB);
            PG8_WAIT_V(6); PG8_BAR; PG8_MMA(1, 1, At, B1); PG8_BAR;
            }
        }
        if constexpr (ALIGN_EPI) { if (wr == 0) PG8_BAR; }
        if constexpr (!Epi::AFTER_DRAIN) { E(acc, cur, wr, wc, fr, fq); S.done(cur); }
        if (!has_next) break;
#pragma unroll
        for (int a = 0; a < 2; ++a)
#pragma unroll
            for (int b = 0; b < 2; ++b)
#pragma unroll
                for (int m = 0; m < 4; ++m)
#pragma unroll
                    for (int n = 0; n < 2; ++n) acc[a][b][m][n] = (f32x4){0.f, 0.f, 0.f, 0.f};
        cur = nxt; cA = nA; cB = nB; ++ui;
        if constexpr (ALIGN_EPI) { if (wr == 1) PG8_BAR; }
    }
    PG8_WAIT_V(0);
    if constexpr (!ALIGN_EPI) { if (wr == 0) PG8_BAR; }
    PG8_BAR;
    if constexpr (Epi::AFTER_DRAIN) { E.fused(acc, cur, wr, wc, fr, fq, lds, wid, lane); S.done(cur); }
#undef PG8_SA
#undef PG8_SB
#undef PG8_STAGE
#undef PG8_LDA
#undef PG8_LDB
#undef PG8_MMA
#undef PG8_WAIT_V
#undef PG8_WAIT_L
#undef PG8_BAR
#undef PG8_SCHED
}
}

constexpr int NB = 8, T = 4096, DM = 1024, M = NB * T, DEPTH = 2;
constexpr int NPROJ = 2912, NPROJP = 3072, DFF = 2816, NUP = 2 * DFF;
constexpr int C_CH = 0, C_CB = 256, C_CC = 512, C_R = 768, C_K = 1024, C_V = 1280, C_DEC = 1536, C_GDN = 1600, C_NQ = 1632, C_NK = 1888, C_NV = 2144, C_SU = 2400, C_SV = 2656;
constexpr float NORM_EPS = 1e-6f, GN_EPS = 64e-5f, DECAY_SCALE = 0.60653065971263342f;
constexpr int NWAVES = 8, NTHREADS = 512;
constexpr size_t MiB = 1u << 20;
constexpr size_t WS_CTL = 0, CTL_ZERO_BYTES = 1 * MiB;
constexpr size_t WS_RS = 1 * MiB;
constexpr size_t WS_PART = 1 * MiB + 256 * 1024;
constexpr size_t WS_W = 4 * MiB, W_LAYER = 24 * MiB + 512 * 1024;
constexpr size_t W_IN = 0, W_OUT = 6 * MiB, W_UP = 8 * MiB, W_DN = 19 * MiB;
constexpr size_t WS_XB = 53 * MiB;
constexpr size_t WS_R = 117 * MiB;
constexpr size_t WS_PROJ = WS_R, WS_MERGED = WS_R + 192 * MiB, WS_PREP = WS_R + 256 * MiB;
constexpr size_t WS_Y = WS_R;
constexpr size_t WS_G = WS_R, WS_L = WS_R + 176 * MiB;
constexpr size_t WS_END = 501 * MiB;
static_assert(WS_W + 2 * W_LAYER <= WS_XB && WS_PREP + 128 * MiB <= WS_END && WS_L + 176 * MiB <= WS_END && WS_PART + (size_t)M * 64 <= WS_W, "ws map");
constexpr int CW_BAR = 4096;
constexpr int RING_BYTES = 131072, LDSCTL_OFF = RING_BYTES, MISC_OFF = LDSCTL_OFF + 320, LDS_BYTES = 147456;

#define GAS __attribute__((address_space(1)))
#define LAS __attribute__((address_space(3)))
typedef unsigned short bf16;
typedef unsigned v4u __attribute__((ext_vector_type(4)));
typedef unsigned v2u __attribute__((ext_vector_type(2)));
typedef float f32x4 __attribute__((ext_vector_type(4)));
typedef short bf16x8 __attribute__((ext_vector_type(8)));
typedef short s16x4 __attribute__((ext_vector_type(4)));
typedef _Float16 h2 __attribute__((ext_vector_type(2)));
typedef GAS unsigned gu32;
#define RLX_AGENT __ATOMIC_RELAXED, __HIP_MEMORY_SCOPE_AGENT
__device__ __forceinline__ unsigned f2bf(float f) { unsigned u = __builtin_bit_cast(unsigned, f); return (u + 0x7fffu + ((u >> 16) & 1u)) >> 16; }
__device__ __forceinline__ unsigned pk2(float lo, float hi) { return f2bf(lo) | (f2bf(hi) << 16); }
__device__ __forceinline__ float bflo(unsigned w) { return __builtin_bit_cast(float, w << 16); }
__device__ __forceinline__ float bfhi(unsigned w) { return __builtin_bit_cast(float, w & 0xffff0000u); }
__device__ __forceinline__ float bf2f(unsigned short b) { return __builtin_bit_cast(float, (unsigned)b << 16); }
__device__ __forceinline__ h2 as_h2(unsigned u) { return __builtin_bit_cast(h2, u); }
template <int CTRL> __device__ __forceinline__ float dppmov(float x) { return __builtin_bit_cast(float, __builtin_amdgcn_update_dpp(0, __builtin_bit_cast(int, x), CTRL, 0xF, 0xF, true)); }
__device__ __forceinline__ float row16_sum(float x) { x += dppmov<0xB1>(x); x += dppmov<0x4E>(x); x += dppmov<0x141>(x); x += dppmov<0x140>(x); return x; }
typedef unsigned u32x2_t __attribute__((ext_vector_type(2)));
__device__ __forceinline__ float xor16_sum(float x) { const u32x2_t r = __builtin_amdgcn_permlane16_swap(__builtin_bit_cast(unsigned, x), __builtin_bit_cast(unsigned, x), false, false);
    const unsigned a = r.x, b = r.y; return __builtin_bit_cast(float, a) + __builtin_bit_cast(float, b); }
__device__ __forceinline__ float xor32_sum(float x) { const u32x2_t r = __builtin_amdgcn_permlane32_swap(__builtin_bit_cast(unsigned, x), __builtin_bit_cast(unsigned, x), false, false);
    const unsigned a = r.x, b = r.y; return __builtin_bit_cast(float, a) + __builtin_bit_cast(float, b); }
__device__ __forceinline__ float wave_sum(float v) { return xor32_sum(xor16_sum(row16_sum(v))); }
__device__ __forceinline__ float row16_max(float x) { x = fmaxf(x, dppmov<0xB1>(x)); x = fmaxf(x, dppmov<0x4E>(x)); x = fmaxf(x, dppmov<0x141>(x)); x = fmaxf(x, dppmov<0x140>(x)); return x; }
__device__ __forceinline__ float sigmoidf_(float x) { return 1.f / (1.f + __expf(-x)); }
__device__ __forceinline__ float tanhf_(float x) { return 1.f - 2.f / (__expf(2.f * x) + 1.f); }
__device__ __forceinline__ float gelu_tanh(float x) { const float u = 1.5957691216057308f * x * (1.f + 0.044715f * x * x); return x / (1.f + __expf(-u)); }
#define XB_TMO      128
#define XB_XCNT(j)  (256  + 64 * (j))
#define XB_XSUB(j)  (1280 + 64 * (j))
#define XB_XGEN(j)  (2304 + 64 * (j))
#define XB_TOP      3328
#define XB_TOPGEN   3392
#define XCD_BAR_WORDS 3456
#define XB_SPIN_CAP (1u << 18)

__device__ __forceinline__ unsigned xb_ld(unsigned* p)              { return __hip_atomic_load(p, __ATOMIC_RELAXED, __HIP_MEMORY_SCOPE_AGENT); }
__device__ __forceinline__ unsigned xb_add(unsigned* p, unsigned v) { return __hip_atomic_fetch_add(p, v, __ATOMIC_RELAXED, __HIP_MEMORY_SCOPE_AGENT); }
__device__ __forceinline__ unsigned xb_xcc_id() { return (unsigned)__builtin_amdgcn_s_getreg((3 << 11) | 20) & 0xFu; }
#define XB_SPIN(cond, bar) do { unsigned _sp = 0; while (cond) { __builtin_amdgcn_s_sleep(1); \
    if ((++_sp & 255u) == 0u) { if (xb_ld(&(bar)[XB_TMO])) break; if (_sp > XB_SPIN_CAP) { atomicAdd(&(bar)[XB_TMO], 1u); break; } } } } while (0)

struct XcdBarrier {
    unsigned* bar; unsigned x;
    volatile LAS unsigned* st;
};

__device__ __forceinline__ XcdBarrier xcd_barrier_post(unsigned* bar, volatile LAS unsigned* st) {
    XcdBarrier b; b.bar = bar; b.x = xb_xcc_id(); b.st = st;
    if (threadIdx.x == 0) (void)xb_add(&bar[XB_XCNT(b.x)], 1u);
    return b;
}
__device__ __forceinline__ void xcd_barrier_complete(unsigned* bar, unsigned x, unsigned& nloc, unsigned& nx) {
    const unsigned G = gridDim.x * gridDim.y * gridDim.z;
    unsigned sum, cnt, mine, sp = 0u;
    for (;;) {
        sum = 0u; cnt = 0u; mine = 0u;
#pragma unroll
        for (unsigned j = 0; j < 16; ++j) { const unsigned c = xb_ld(&bar[XB_XCNT(j)]); sum += c; cnt += (c > 0u) ? 1u : 0u; mine = (j == x) ? c : mine; }
        if (sum == G) break;
        __builtin_amdgcn_s_sleep(1);
        if ((++sp & 255u) == 0u) { if (xb_ld(&bar[XB_TMO])) break; if (sp > XB_SPIN_CAP) { atomicAdd(&bar[XB_TMO], 1u); break; } }
    }
    nloc = mine > 0u ? mine : 1u; nx = cnt > 0u ? cnt : 1u;
}

__device__ __forceinline__ void xcd_barrier(const XcdBarrier& b) {
    asm volatile("s_waitcnt vmcnt(0)" ::: "memory");
    __syncthreads();
    if (threadIdx.x == 0) {
        unsigned* bar = b.bar;
        __builtin_amdgcn_s_waitcnt(0);
        unsigned nloc = b.st[0], nx = b.st[1];
        if (nloc == 0u) { xcd_barrier_complete(bar, b.x, nloc, nx); b.st[0] = nloc; b.st[1] = nx; }
        const unsigned old = xb_add(&bar[XB_XSUB(b.x)], 1u);
        const unsigned gen = old / nloc;
        if (old + 1u == (gen + 1u) * nloc) {
            __builtin_amdgcn_fence(__ATOMIC_RELEASE, "agent");
            asm volatile("s_waitcnt vmcnt(0)" ::: "memory");
            const unsigned og = xb_add(&bar[XB_TOP], 1u);
            const unsigned tg = og / nx;
            if (og + 1u == (tg + 1u) * nx) xb_add(&bar[XB_TOPGEN], 1u);
            else XB_SPIN(xb_ld(&bar[XB_TOPGEN]) == tg, bar);
            __builtin_amdgcn_fence(__ATOMIC_ACQUIRE, "agent");
            xb_add(&bar[XB_XGEN(b.x)], 1u);
            asm volatile("s_waitcnt vmcnt(0)" ::: "memory");
        } else {
            XB_SPIN(xb_ld(&bar[XB_XGEN(b.x)]) == gen, bar);
            __builtin_amdgcn_fence(__ATOMIC_ACQUIRE, "agent");
            asm volatile("s_waitcnt vmcnt(0)" ::: "memory");
        }
    }
    __syncthreads();
}

typedef __attribute__((address_space(4))) const unsigned long long kq_t;
struct Frame {
    LAS unsigned char* lds;
    volatile LAS unsigned* MISC;
    gu32* ctl;
    int tid, lane, wave, vcu, G;
    kq_t* karg; float* out; unsigned char* ws;
};
#define INP(F, i) ((const float*)(F).karg[(i)])
enum { I_X = 0, I_NMPRE, I_NMPOST, I_NFPRE, I_NFPOST, I_WIN, I_CONVW, I_RW0, I_RWUP, I_RA0, I_RAUP, I_RGUP, I_RKK, I_RKA, I_RRK, I_LNXW, I_LNXB, I_RPB, I_SGUN, I_SGUW, I_SGUB, I_MGAIN, I_WOUT, I_WUP, I_FCONV, I_WDN };
__device__ __forceinline__ int launder_u(int x) { asm volatile("" : "+v"(x)); return __builtin_amdgcn_readfirstlane(x); }
template <class P> __device__ __forceinline__ P launder_p(P p) { unsigned long long v = (unsigned long long)p; unsigned lo = (unsigned)v, hi = (unsigned)(v >> 32); asm volatile("" : "+v"(lo), "+v"(hi));
    lo = __builtin_amdgcn_readfirstlane(lo); hi = __builtin_amdgcn_readfirstlane(hi); return (P)(((unsigned long long)hi << 32) | lo); }
#define LAUNDER(F) do { asm volatile("" : "+v"((F).tid)); asm volatile("" : "+v"((F).lane)); (F).wave = launder_u((F).wave); (F).vcu = launder_u((F).vcu); (F).karg = launder_p((F).karg); (F).ws = launder_p((F).ws); (F).out = launder_p((F).out); } while (0)
#define LDS_WAIT() asm volatile("s_waitcnt lgkmcnt(0)" ::: "memory")
#define CFENCE() asm volatile("" ::: "memory")

__device__ __forceinline__ void p0_transpose_item(const float* W, const float* gain, int K, int N, bf16* WT, LAS float* scr, int item, int lane) {
    const int nblk = N / 32, kb = item / nblk, nb = item % nblk, k0 = 64 * kb, n0 = 32 * nb;
#pragma unroll 8
    for (int i = 0; i < 32; ++i) { const int kk = 2 * i + (lane >> 5); const float g = gain ? gain[k0 + kk] : 1.f; scr[kk * 33 + (lane & 31)] = W[(size_t)(k0 + kk) * N + n0 + (lane & 31)] * g; }
    LDS_WAIT(); CFENCE();
    const int c = lane & 7;
#pragma unroll
    for (int j = 0; j < 4; ++j) { const int n = (lane >> 3) + 8 * j; const LAS float* s = scr + (8 * c) * 33 + n;
        v4u o; o.x = pk2(s[0 * 33], s[1 * 33]); o.y = pk2(s[2 * 33], s[3 * 33]); o.z = pk2(s[4 * 33], s[5 * 33]); o.w = pk2(s[6 * 33], s[7 * 33]);
        *(GAS v4u*)(WT + (size_t)(n0 + n) * K + k0 + 8 * c) = o; }
    LDS_WAIT(); CFENCE();
}
__device__ __forceinline__ void row_to_bf16_rs(const float* xrow, bf16* orow, float* rs, int lane) {
    const GAS f32x4* xr = (const GAS f32x4*)xrow + lane;
    f32x4 v[4]; float s = 0.f;
#pragma unroll
    for (int j = 0; j < 4; ++j) { v[j] = xr[64 * j]; s += (v[j].x * v[j].x + v[j].y * v[j].y) + (v[j].z * v[j].z + v[j].w * v[j].w); }
    s = wave_sum(s);
    GAS v2u* o8 = (GAS v2u*)orow + lane;
#pragma unroll
    for (int j = 0; j < 4; ++j) { v2u o; o.x = pk2(v[j].x, v[j].y); o.y = pk2(v[j].z, v[j].w); o8[64 * j] = o; }
    if (lane == 0) *rs = 1.f / sqrtf(s * (1.f / DM) + NORM_EPS);
}
__device__ __forceinline__ void p0_prologue(Frame& F) {
    LAUNDER(F);
    LAS float* scr = (LAS float*)(F.lds + F.wave * 16384);
    const int gw = F.vcu * NWAVES + F.wave, NGW = F.G * NWAVES;
    constexpr int I_IN = (DM / 64) * (NPROJ / 32), I_OUT = (DM / 64) * (DM / 32), I_UP = (DM / 64) * (NUP / 32), I_DN = (DFF / 64) * (DM / 32), I_L = I_IN + I_OUT + I_UP + I_DN;
    for (int it = gw; it < DEPTH * I_L; it += NGW) {
        const int l = it / I_L; int r = it % I_L; unsigned char* wl = F.ws + WS_W + (size_t)l * W_LAYER;
        if (r < I_IN) { p0_transpose_item(INP(F, I_WIN) + (size_t)l * DM * NPROJ, INP(F, I_NMPRE) + l * DM, DM, NPROJ, (bf16*)(wl + W_IN), scr, r, F.lane); continue; } r -= I_IN;
        if (r < I_OUT) { p0_transpose_item(INP(F, I_WOUT) + (size_t)l * DM * DM, INP(F, I_MGAIN) + l * DM, DM, DM, (bf16*)(wl + W_OUT), scr, r, F.lane); continue; } r -= I_OUT;
        if (r < I_UP) { p0_transpose_item(INP(F, I_WUP) + (size_t)l * DM * NUP, INP(F, I_NFPRE) + l * DM, DM, NUP, (bf16*)(wl + W_UP), scr, r, F.lane); continue; } r -= I_UP;
        p0_transpose_item(INP(F, I_WDN) + (size_t)l * DFF * DM, nullptr, DFF, DM, (bf16*)(wl + W_DN), scr, r, F.lane);
    }
    unsigned zz = 0u; asm volatile("" : "+v"(zz));
    for (int i = F.vcu * NTHREADS + F.tid; i < DEPTH * 20480; i += F.G * NTHREADS) { const int l = i / 20480, r = i % 20480;
        *(GAS v4u*)(F.ws + WS_W + (size_t)l * W_LAYER + W_IN + (size_t)NPROJ * DM * 2 + (size_t)r * 16) = (v4u){zz, zz, zz, zz}; }
    for (int m = gw; m < M; m += NGW) row_to_bf16_rs(INP(F, I_X) + (size_t)m * DM, (bf16*)(F.ws + WS_XB) + (size_t)m * DM, (float*)(F.ws + WS_RS) + m, F.lane);
}

typedef float f32x16 __attribute__((ext_vector_type(16)));
__device__ __forceinline__ void mix_convprep_tile(Frame& F, int l, int tile) {
    LAUNDER(F);
    const bf16* proj = (const bf16*)(F.ws + WS_PROJ); bf16* merged = (bf16*)(F.ws + WS_MERGED);
    const int m0 = tile * 64, bb = m0 / T, t0 = m0 % T;
    const int lane = F.lane, w = F.wave;
    LAS float* INV = (LAS float*)F.lds;
    {
        const int c4 = 4 * lane; const float* cw = INP(F, I_CONVW) + l * 768;
        const f32x4 w0 = *(const f32x4*)(cw + c4), w1 = *(const f32x4*)(cw + 256 + c4), w2 = *(const f32x4*)(cw + 512 + c4);
        const f32x4 kkg = *(const f32x4*)(INP(F, I_RKK) + l * 256 + c4);
        const int ts = t0 + 8 * w;
        v2u hr[10], cr[10], br[8], kr[8];
#pragma unroll
        for (int j = 0; j < 10; ++j) { const int t = ts - 1 + j; const bool ok = (t >= 0 && t < T); const bf16* row = proj + (size_t)(bb * T + (ok ? t : ts)) * NPROJP;
            hr[j] = *(const GAS v2u*)(row + C_CH + c4); cr[j] = *(const GAS v2u*)(row + C_CC + c4); if (!ok) { hr[j] = (v2u){0u, 0u}; } }
#pragma unroll
        for (int j = 0; j < 8; ++j) { const bf16* row = proj + (size_t)(bb * T + ts + j) * NPROJP; br[j] = *(const GAS v2u*)(row + C_CB + c4); kr[j] = *(const GAS v2u*)(row + C_K + c4); }
#pragma unroll
        for (int i = 0; i < 8; ++i) { const int t = ts + i;
            f32x4 z[3];
#pragma unroll
            for (int q = 0; q < 3; ++q) { const v2u h = hr[i + q], c = cr[i + q]; z[q] = (f32x4){bflo(h.x) * bflo(c.x), bfhi(h.x) * bfhi(c.x), bflo(h.y) * bflo(c.y), bfhi(h.y) * bfhi(c.y)}; }
            const v2u b = br[i];
            const f32x4 bv = (f32x4){bflo(b.x), bfhi(b.x), bflo(b.y), bfhi(b.y)};
            const f32x4 y = bv * (w0 * z[0] + w1 * z[1] + w2 * z[2]);
            float ss = (y.x * y.x + y.y * y.y) + (y.z * y.z + y.w * y.w); ss = wave_sum(ss);
            const float sc = 1.f / sqrtf(ss * (1.f / 256.f) + NORM_EPS);
            v2u o; o.x = pk2(y.x * sc, y.y * sc); o.y = pk2(y.z * sc, y.w * sc);
            *(GAS v2u*)(merged + (size_t)(bb * T + t) * DM + 0 + c4) = o;
            const v2u ku = kr[i]; const f32x4 kq = (f32x4){bflo(ku.x), bfhi(ku.x), bflo(ku.y), bfhi(ku.y)} * kkg;
            const float ks = row16_sum((kq.x * kq.x + kq.y * kq.y) + (kq.z * kq.z + kq.w * kq.w));
            if ((lane & 15) == 0) INV[(8 * w + i) * 4 + (lane >> 4)] = 1.f / sqrtf(ks + 1e-12f); }
    }
    __syncthreads();
    {
        const int r = lane & 31, hh = lane >> 5, c = 32 * w + r, head = w >> 1;
        bf16x8 Bw[2], Ba[2]; float w0v[2], a0v[2];
#pragma unroll
        for (int d = 0; d < 2; ++d) { float xw[8], xa[8];
#pragma unroll
            for (int j = 0; j < 8; ++j) { xw[j] = INP(F, I_RWUP)[((size_t)(l * 2 + d) * 16 + 8 * hh + j) * 256 + c]; xa[j] = INP(F, I_RAUP)[((size_t)(l * 2 + d) * 16 + 8 * hh + j) * 256 + c]; }
            Bw[d] = __builtin_bit_cast(bf16x8, (v4u){pk2(xw[0], xw[1]), pk2(xw[2], xw[3]), pk2(xw[4], xw[5]), pk2(xw[6], xw[7])});
            Ba[d] = __builtin_bit_cast(bf16x8, (v4u){pk2(xa[0], xa[1]), pk2(xa[2], xa[3]), pk2(xa[4], xa[5]), pk2(xa[6], xa[7])});
            w0v[d] = INP(F, I_RW0)[(l * 2 + d) * 256 + c]; a0v[d] = INP(F, I_RA0)[(l * 2 + d) * 256 + c]; }
        const float kkg = INP(F, I_RKK)[l * 256 + c], kag = INP(F, I_RKA)[l * 256 + c];
#pragma unroll 1
        for (int th = 0; th < 2; ++th) {
            const bf16* arow = proj + (size_t)(m0 + 32 * th + r) * NPROJP + C_DEC + 8 * hh;
            f32x16 Dw[2], Da[2];
#pragma unroll
            for (int d = 0; d < 2; ++d) {
                const v4u dv = *(const GAS v4u*)(arow + 16 * d); const bf16x8 ia = *(const GAS bf16x8*)(arow + 32 + 16 * d);
                v4u tv;
#pragma unroll
                for (int q = 0; q < 4; ++q) tv[q] = pk2(tanhf_(bflo(dv[q])), tanhf_(bfhi(dv[q])));
                f32x16 z;
#pragma unroll
                for (int q = 0; q < 16; ++q) z[q] = 0.f;
                Dw[d] = __builtin_amdgcn_mfma_f32_32x32x16_bf16(__builtin_bit_cast(bf16x8, tv), Bw[d], z, 0, 0, 0);
                Da[d] = __builtin_amdgcn_mfma_f32_32x32x16_bf16(ia, Ba[d], z, 0, 0, 0); }
            unsigned short kraw[16];
#pragma unroll
            for (int q = 0; q < 16; ++q) { const int tok = 32 * th + (q & 3) + 8 * (q >> 2) + 4 * hh; kraw[q] = proj[(size_t)(m0 + tok) * NPROJP + C_K + c]; }
#pragma unroll
            for (int q = 0; q < 16; ++q) { const int tok = 32 * th + (q & 3) + 8 * (q >> 2) + 4 * hh;
                const float k = bf2f(kraw[q]); const float kk = k * kkg * INV[tok * 4 + head];
#pragma unroll
                for (int d = 0; d < 2; ++d) {
                    const float wv = __expf(-DECAY_SCALE * sigmoidf_(w0v[d] + Dw[d][q])), av = sigmoidf_(a0v[d] + Da[d][q]);
                    const float bv = kk * av, ke = k * (1.f + (av - 1.f) * kag);
                    const float wo = dppmov<0xB1>(wv), kko = dppmov<0xB1>(kk), bo = dppmov<0xB1>(bv), keo = dppmov<0xB1>(ke);
                    if ((lane & 1) == 0) {
                        h2 a = {(_Float16)wv, (_Float16)wo}, b = {(_Float16)kk, (_Float16)kko}, cc = {(_Float16)bv, (_Float16)bo}, dd = {(_Float16)ke, (_Float16)keo};
                        v4u o; o.x = __builtin_bit_cast(unsigned, a); o.y = __builtin_bit_cast(unsigned, b); o.z = __builtin_bit_cast(unsigned, cc); o.w = __builtin_bit_cast(unsigned, dd);
                        *(GAS v4u*)(F.ws + WS_PREP + ((size_t)((d * NB + bb) * 4 + head) * T + (t0 + tok)) * 512 + (size_t)((c & 63) >> 1) * 16) = o; } } }
        }
    }
    __syncthreads();
}

__device__ __forceinline__ void mix_na_item(Frame& F, int l, int item, LAS unsigned char* wl, const LAS float* RPB) {
    LAUNDER(F);
    const bf16* proj = (const bf16*)(F.ws + WS_PROJ); bf16* merged = (bf16*)(F.ws + WS_MERGED);
    const int lane = F.lane, i = lane & 15, g = lane >> 4;
    const int qg = item & 3, r = (item >> 2) & 63, bb = item >> 8;
    const int c0 = 16 * qg;
    int rs = r - 4; rs = rs < 0 ? 0 : (rs > 56 ? 56 : rs);
    int cs = c0 - 8; cs = cs < 0 ? 0 : (cs > 32 ? 32 : cs);
    LAS unsigned char* PL = wl; LAS unsigned char* VL = wl + 4096; LAS unsigned char* OL = wl + 8192;
    const size_t rowbase = (size_t)bb * T;
    float ssq[4] = {0.f, 0.f, 0.f, 0.f};
#pragma unroll 1
    for (int h = 0; h < 4; ++h) {
        bf16x8 qf[2];
        { const bf16* qrow = proj + (rowbase + r * 64 + c0 + i) * NPROJP + C_NQ + h * 64 + 8 * g;
          qf[0] = *(const GAS bf16x8*)(qrow); qf[1] = *(const GAS bf16x8*)(qrow + 32); }
        f32x4 s[16];
#pragma unroll
        for (int kt = 0; kt < 16; ++kt) { const int kr = kt >> 1, hf = kt & 1;
            const bf16* krow = proj + (rowbase + (rs + kr) * 64 + cs + 16 * hf + i) * NPROJP + C_NK + h * 64 + 8 * g;
            const bf16x8 k0 = *(const GAS bf16x8*)(krow), k1 = *(const GAS bf16x8*)(krow + 32);
            f32x4 a = (f32x4){0.f, 0.f, 0.f, 0.f};
            a = __builtin_amdgcn_mfma_f32_16x16x32_bf16(qf[0], k0, a, 0, 0, 0);
            a = __builtin_amdgcn_mfma_f32_16x16x32_bf16(qf[1], k1, a, 0, 0, 0);
            s[kt] = a; if ((kt & 3) == 3) __builtin_amdgcn_sched_barrier(0); }
        float mx[4] = {-3e38f, -3e38f, -3e38f, -3e38f};
#pragma unroll
        for (int kt = 0; kt < 16; ++kt) { const int kr = kt >> 1, hf = kt & 1; const int cw = cs + 16 * hf + i; const int dy = rs + kr - r + 7;
#pragma unroll
            for (int e = 0; e < 4; ++e) { const int cq = c0 + 4 * g + e; int st = cq - 8; st = st < 0 ? 0 : (st > 48 ? 48 : st);
                int dx = cw - cq; dx = dx < -15 ? -15 : (dx > 15 ? 15 : dx); dx += 15;
                const bool valid = (cw >= st) && (cw < st + 16);
                float v = s[kt][e] * 0.125f + RPB[h * 465 + dy * 31 + dx];
                v = valid ? v : -1e30f; s[kt][e] = v; mx[e] = fmaxf(mx[e], v); } }
        float sm[4];
#pragma unroll
        for (int e = 0; e < 4; ++e) { mx[e] = row16_max(mx[e]); sm[e] = 0.f; }
#pragma unroll
        for (int kt = 0; kt < 16; ++kt)
#pragma unroll
            for (int e = 0; e < 4; ++e) { const float p = __expf(s[kt][e] - mx[e]); s[kt][e] = p; sm[e] += p; }
#pragma unroll
        for (int e = 0; e < 4; ++e) sm[e] = 1.f / row16_sum(sm[e]);
        f32x4 oh[4];
#pragma unroll
        for (int dt = 0; dt < 4; ++dt) oh[dt] = (f32x4){0.f, 0.f, 0.f, 0.f};
#pragma unroll
        for (int half = 0; half < 2; ++half) {
            CFENCE();
#pragma unroll
            for (int k8 = 0; k8 < 8; ++k8) { const int kt = 8 * half + k8; v2u pw; pw.x = pk2(s[kt][0] * sm[0], s[kt][1] * sm[1]); pw.y = pk2(s[kt][2] * sm[2], s[kt][3] * sm[3]);
                *(LAS v2u*)(PL + (16 * k8 + i) * 32 + 8 * g) = pw; }
            CFENCE();
#pragma unroll 1
            for (int k4 = 0; k4 < 4; ++k4) { const int kr = 4 * half + k4;
                CFENCE();
#pragma unroll
                for (int q = 0; q < 4; ++q) { const int e = lane + 64 * q, key = e >> 3, ch = e & 7;
                    const v4u vv = *(const GAS v4u*)(proj + (rowbase + (rs + kr) * 64 + cs + key) * NPROJP + C_NV + h * 64 + 8 * ch);
                    *(LAS v4u*)(VL + key * 128 + ch * 16) = vv; }
                CFENCE();
                const LAS unsigned char* pa = PL + (32 * k4 + 8 * g + (i >> 2)) * 32 + 8 * (i & 3);
                const s16x4 plo = __builtin_bit_cast(s16x4, __builtin_amdgcn_ds_read_tr16_b64_v4i16((LAS s16x4*)(pa)));
                const s16x4 phi = __builtin_bit_cast(s16x4, __builtin_amdgcn_ds_read_tr16_b64_v4i16((LAS s16x4*)(pa + 128)));
                const bf16x8 pf = (bf16x8){plo[0], plo[1], plo[2], plo[3], phi[0], phi[1], phi[2], phi[3]};
#pragma unroll
                for (int dt = 0; dt < 4; ++dt) {
                    const LAS unsigned char* va = VL + (8 * g + (i >> 2)) * 128 + (16 * dt + 4 * (i & 3)) * 2;
                    const s16x4 vlo = __builtin_bit_cast(s16x4, __builtin_amdgcn_ds_read_tr16_b64_v4i16((LAS s16x4*)(va)));
                    const s16x4 vhi = __builtin_bit_cast(s16x4, __builtin_amdgcn_ds_read_tr16_b64_v4i16((LAS s16x4*)(va + 512)));
                    const bf16x8 vf = (bf16x8){vlo[0], vlo[1], vlo[2], vlo[3], vhi[0], vhi[1], vhi[2], vhi[3]};
                    oh[dt] = __builtin_amdgcn_mfma_f32_16x16x32_bf16(pf, vf, oh[dt], 0, 0, 0); }
            }
        }
        CFENCE();
#pragma unroll
        for (int dt = 0; dt < 4; ++dt)
#pragma unroll
            for (int e = 0; e < 4; ++e) { ssq[e] += oh[dt][e] * oh[dt][e]; *(LAS unsigned short*)(OL + (4 * g + e) * 512 + (h * 64 + 16 * dt + i) * 2) = (unsigned short)f2bf(oh[dt][e]); }
        CFENCE();
    }
    LAS float* SCL = (LAS float*)VL;
    CFENCE();
#pragma unroll
    for (int e = 0; e < 4; ++e) { const float sc = 1.f / sqrtf(row16_sum(ssq[e]) * (1.f / 256.f) + NORM_EPS); if (i == 0) SCL[4 * g + e] = sc; }
    CFENCE();
#pragma unroll
    for (int q = 0; q < 8; ++q) { const int e = lane + 64 * q, row = e >> 5, ch = e & 31;
        const v4u v = *(const LAS v4u*)(OL + row * 512 + ch * 16); const float sc = SCL[row];
        v4u o;
#pragma unroll
        for (int t = 0; t < 4; ++t) o[t] = pk2(bflo(v[t]) * sc, bfhi(v[t]) * sc);
        *(GAS v4u*)(merged + (rowbase + r * 64 + c0 + row) * DM + 512 + 8 * ch) = o; }
    CFENCE();
}

constexpr int SG_PITCH = 528;
__device__ __forceinline__ void mix_sgu_item(Frame& F, int l, int item) {
    LAUNDER(F);
    const bf16* proj = (const bf16*)(F.ws + WS_PROJ); bf16* merged = (bf16*)(F.ws + WS_MERGED);
    const int lane = F.lane, w = F.wave, tid = F.tid, i = lane & 15, g = lane >> 4;
    const size_t m0 = (size_t)item * 128;
    LAS unsigned char* VI = F.lds; LAS float* SS = (LAS float*)(F.lds + 128 * SG_PITCH);
    { const int c4 = 4 * lane; const f32x4 gn = *(const f32x4*)(INP(F, I_SGUN) + l * 256 + c4);
      for (int q = 16 * w; q < 16 * w + 16; ++q) {
          const v2u x = *(const GAS v2u*)(proj + (m0 + q) * NPROJP + C_SV + c4);
          f32x4 v = (f32x4){gelu_tanh(bflo(x.x)), gelu_tanh(bfhi(x.x)), gelu_tanh(bflo(x.y)), gelu_tanh(bfhi(x.y))};
          const float mu = wave_sum((v.x + v.y) + (v.z + v.w)) * (1.f / 256.f);
          v = v - mu;
          const float var = wave_sum((v.x * v.x + v.y * v.y) + (v.z * v.z + v.w * v.w)) * (1.f / 256.f);
          const float rstd = 1.f / sqrtf(var + NORM_EPS);
          v2u o; o.x = pk2(v.x * rstd * gn.x, v.y * rstd * gn.y); o.y = pk2(v.z * rstd * gn.z, v.w * rstd * gn.w);
          *(LAS v2u*)(VI + q * SG_PITCH + c4 * 2) = o; } }
    __syncthreads();
    const int hh = w >> 1, ph = w & 1;
    f32x4 acc[4][4];
#pragma unroll
    for (int a = 0; a < 4; ++a)
#pragma unroll
        for (int b = 0; b < 4; ++b) acc[a][b] = (f32x4){0.f, 0.f, 0.f, 0.f};
    const float* ws_ = INP(F, I_SGUW) + ((size_t)(l * 4 + hh) * 128) * 128;
#pragma unroll 1
    for (int ks = 0; ks < 4; ++ks) {
        bf16x8 af[4], bfr[4];
#pragma unroll
        for (int pt = 0; pt < 4; ++pt) { const float* ap = ws_ + (size_t)(64 * ph + 16 * pt + i) * 128 + 32 * ks + 8 * g;
            const f32x4 x0 = *(const f32x4*)ap, x1 = *(const f32x4*)(ap + 4);
            const unsigned u0 = pk2(x0.x, x0.y), u1 = pk2(x0.z, x0.w), u2 = pk2(x1.x, x1.y), u3 = pk2(x1.z, x1.w);
            af[pt] = __builtin_bit_cast(bf16x8, (v4u){u0, u1, u2, u3}); }
#pragma unroll
        for (int dt = 0; dt < 4; ++dt) { const LAS unsigned char* va = VI + (32 * ks + 8 * g + (i >> 2)) * SG_PITCH + (hh * 64 + 16 * dt + 4 * (i & 3)) * 2;
            const s16x4 lo = __builtin_bit_cast(s16x4, __builtin_amdgcn_ds_read_tr16_b64_v4i16((LAS s16x4*)(va)));
            const s16x4 hi = __builtin_bit_cast(s16x4, __builtin_amdgcn_ds_read_tr16_b64_v4i16((LAS s16x4*)(va + 4 * SG_PITCH)));
            bfr[dt] = (bf16x8){lo[0], lo[1], lo[2], lo[3], hi[0], hi[1], hi[2], hi[3]}; }
#pragma unroll
        for (int pt = 0; pt < 4; ++pt)
#pragma unroll
            for (int dt = 0; dt < 4; ++dt) acc[pt][dt] = __builtin_amdgcn_mfma_f32_16x16x32_bf16(af[pt], bfr[dt], acc[pt][dt], 0, 0, 0);
    }
#pragma unroll
    for (int pt = 0; pt < 4; ++pt)
#pragma unroll
        for (int e = 0; e < 4; ++e) { const int p = 64 * ph + 16 * pt + 4 * g + e; const float bs = INP(F, I_SGUB)[(l * 4 + hh) * 128 + p]; float ss = 0.f;
#pragma unroll
            for (int dt = 0; dt < 4; ++dt) { const float u = gelu_tanh(bf2f(proj[(m0 + p) * NPROJP + C_SU + hh * 64 + 16 * dt + i]));
                const float v = u * (acc[pt][dt][e] + bs); acc[pt][dt][e] = v; ss += v * v; }
            ss = row16_sum(ss); if (i == 0) SS[p * 4 + hh] = ss; }
    __syncthreads();
#pragma unroll
    for (int pt = 0; pt < 4; ++pt)
#pragma unroll
        for (int e = 0; e < 4; ++e) { const int p = 64 * ph + 16 * pt + 4 * g + e; const f32x4 s4 = *(const LAS f32x4*)(SS + p * 4);
            const float sc = 1.f / sqrtf(((s4.x + s4.y) + (s4.z + s4.w)) * (1.f / 256.f) + NORM_EPS);
#pragma unroll
            for (int dt = 0; dt < 4; ++dt) *(LAS unsigned short*)(VI + p * SG_PITCH + (hh * 64 + 16 * dt + i) * 2) = (unsigned short)f2bf(acc[pt][dt][e] * sc); }
    __syncthreads();
#pragma unroll
    for (int q = 0; q < 8; ++q) { const int e = tid + 512 * q, row = e >> 5, ch = e & 31;
        const v4u v = *(const LAS v4u*)(VI + row * SG_PITCH + ch * 16);
        *(GAS v4u*)(merged + (m0 + row) * DM + 768 + 8 * ch) = v; }
    __syncthreads();
}

__device__ __forceinline__ void phase_mixers(Frame& F, int l) {
    LAUNDER(F);
#ifndef NO_CP
    for (int tile = F.vcu; tile < M / 64; tile += F.G) mix_convprep_tile(F, l, tile);
#endif
#ifdef REP_CP
    for (int tile = F.vcu; tile < M / 64; tile += F.G) mix_convprep_tile(F, l, tile);
#endif
    LAS float* RPB = (LAS float*)(F.lds + RING_BYTES + 1024);
    for (int q = F.tid; q < 4 * 465; q += NTHREADS) RPB[q] = INP(F, I_RPB)[l * 4 * 465 + q];
    __syncthreads();
#ifndef NO_NA
    for (int it = F.vcu * NWAVES + F.wave; it < NB * 64 * 4; it += F.G * NWAVES) mix_na_item(F, l, it, F.lds + F.wave * 16384, RPB);
#endif
#ifdef REP_NA
    for (int it = F.vcu * NWAVES + F.wave; it < NB * 64 * 4; it += F.G * NWAVES) mix_na_item(F, l, it, F.lds + F.wave * 16384, RPB);
#endif
    __syncthreads();
#ifndef NO_SGU
    for (int it = F.vcu; it < NB * 32; it += F.G) mix_sgu_item(F, l, it);
#endif
#ifdef REP_SGU
    for (int it = F.vcu; it < NB * 32; it += F.G) mix_sgu_item(F, l, it);
#endif
}

constexpr int SC_CH = 32, SC_STEP = 1280, SC_VV = SC_CH * SC_STEP, SC_BUF = SC_VV + SC_CH * 64, SC_YB = 2 * SC_BUF, SC_YBB = SC_CH * 32;
typedef float f32x2 __attribute__((ext_vector_type(2)));
__device__ __forceinline__ void phase_scan(Frame& F) {
    LAUNDER(F);
    const bf16* proj = (const bf16*)(F.ws + WS_PROJ);
    const int tid = F.tid, lane = F.lane, w = F.wave;
    const int ci = F.vcu >> 2, qt = F.vcu & 3, dir = ci >> 5, bb = (ci >> 2) & 7, h = ci & 3;
    LAS unsigned char* lds = F.lds;
    constexpr int NCH = T / SC_CH;
    if (w >= 4) {
        const int lt = tid - 256;
        const unsigned char* prep = F.ws + WS_PREP + ((size_t)((dir * NB + bb) * 4 + h) * T) * 512;
        const bf16* rbase = proj + (size_t)bb * T * NPROJP + C_R + h * 64;
        const bf16* vbase = proj + (size_t)bb * T * NPROJP + C_V + h * 64 + 16 * qt;
        bf16* ysc = (bf16*)(F.out) + ((size_t)dir * M + (size_t)bb * T) * 256 + h * 64 + 16 * qt;
#define SC_LOAD(R_, RR_, VV_, chv) do { _Pragma("unroll") for (int i = 0; i < 4; ++i) { const int pi = lt + 256 * i, s = pi >> 5, c = pi & 31; const int gs = (chv) * SC_CH + s, t = dir ? (T - 1 - gs) : gs; \
            R_[i] = *(const GAS v4u*)(prep + (size_t)t * 512 + c * 16); } \
        { const int s = lt >> 3, c8 = lt & 7; const int gs = (chv) * SC_CH + s, t = dir ? (T - 1 - gs) : gs; RR_ = *(const GAS v4u*)(rbase + (size_t)t * NPROJP + 8 * c8); } \
        _Pragma("unroll") for (int i = 0; i < 2; ++i) { const int e = lt + 256 * i, s = e >> 4, r = e & 15; const int gs = (chv) * SC_CH + s, t = dir ? (T - 1 - gs) : gs; VV_[i] = vbase[(size_t)t * NPROJP + r]; } } while (0)
        v4u prec[4], nrec[4]; v4u prr, nrr; unsigned short pvv[2], nvv[2];
        SC_LOAD(prec, prr, pvv, 0);
        for (int ch = 0; ch <= NCH; ++ch) {
            if (ch + 1 < NCH) SC_LOAD(nrec, nrr, nvv, ch + 1);
            if (ch < NCH) {
                LAS unsigned char* B = lds + (ch & 1) * SC_BUF;
#pragma unroll
                for (int i = 0; i < 4; ++i) { const int pi = lt + 256 * i, s = pi >> 5, c = pi & 31; LAS unsigned char* p = B + s * SC_STEP + c * 8;
                    const h2 a = as_h2(prec[i].x), b = as_h2(prec[i].y), cc = as_h2(prec[i].z), d = as_h2(prec[i].w);
                    *(LAS f32x2*)(p) = (f32x2){(float)a.x, (float)a.y}; *(LAS f32x2*)(p + 256) = (f32x2){(float)b.x, (float)b.y};
                    *(LAS f32x2*)(p + 512) = (f32x2){(float)cc.x, (float)cc.y}; *(LAS f32x2*)(p + 768) = (f32x2){(float)d.x, (float)d.y}; }
                { const int s = lt >> 3, c8 = lt & 7; LAS unsigned char* p = B + s * SC_STEP + 1024 + c8 * 32;
                  *(LAS f32x4*)(p) = (f32x4){bflo(prr.x), bfhi(prr.x), bflo(prr.y), bfhi(prr.y)}; *(LAS f32x4*)(p + 16) = (f32x4){bflo(prr.z), bfhi(prr.z), bflo(prr.w), bfhi(prr.w)}; }
#pragma unroll
                for (int i = 0; i < 2; ++i) { const int e = lt + 256 * i, s = e >> 4, r = e & 15; *(LAS float*)(B + SC_VV + s * 64 + r * 4) = bf2f(pvv[i]); }
            }
            if (ch >= 3 && lt < 64) {
                const int cy = ch - 3; const int s = lt >> 1, hf = lt & 1; const int gs = cy * SC_CH + s, t = dir ? (T - 1 - gs) : gs;
                const v4u yv = *(const LAS v4u*)(lds + SC_YB + (cy & 3) * SC_YBB + (s * 16 + 8 * hf) * 2);
                *(GAS v4u*)(ysc + (size_t)t * 256 + 8 * hf) = yv; }
            __syncthreads();
#pragma unroll
            for (int i = 0; i < 4; ++i) prec[i] = nrec[i];
            prr = nrr; pvv[0] = nvv[0]; pvv[1] = nvv[1];
        }
#undef SC_LOAD
        __syncthreads();
        if (lt < 128) { const int cy = NCH - 2 + (lt >> 6); const int l6 = lt & 63, s = l6 >> 1, hf = l6 & 1; const int gs = cy * SC_CH + s, t = dir ? (T - 1 - gs) : gs;
            const v4u yv = *(const LAS v4u*)(lds + SC_YB + (cy & 3) * SC_YBB + (s * 16 + 8 * hf) * 2);
            *(GAS v4u*)(ysc + (size_t)t * 256 + 8 * hf) = yv; }
    } else {
        const int cg = lane & 15, row16 = 4 * w + (lane >> 4);
        f32x4 S = (f32x4){0.f, 0.f, 0.f, 0.f}, rprev = (f32x4){0.f, 0.f, 0.f, 0.f}; float ybuf = 0.f;
#define SC_DOT(a, b) ({ f32x2 t_ = (f32x2){(a).x, (a).y} * (f32x2){(b).x, (b).y}; t_ = __builtin_elementwise_fma((f32x2){(a).z, (a).w}, (f32x2){(b).z, (b).w}, t_); t_.x + t_.y; })
#define SC_RED2(a, b) do { a += dppmov<0xB1>(a); b += dppmov<0xB1>(b); a += dppmov<0x4E>(a); b += dppmov<0x4E>(b); a += dppmov<0x141>(a); b += dppmov<0x141>(b); a += dppmov<0x140>(a); b += dppmov<0x140>(b); } while (0)
        f32x4 Wv[4], Kv[4], Bv[4], Ev[4], Rv[4]; float Vv[4];
#pragma unroll
        for (int i = 0; i < 4; ++i) { Wv[i] = Kv[i] = Bv[i] = Ev[i] = Rv[i] = (f32x4){0.f, 0.f, 0.f, 0.f}; Vv[i] = 0.f; }
#define SC_LD(i, s) asm volatile("ds_read_b128 %0, %6 offset:%8\n\tds_read_b128 %1, %6 offset:%9\n\tds_read_b128 %2, %6 offset:%10\n\tds_read_b128 %3, %6 offset:%11\n\tds_read_b128 %4, %6 offset:%12\n\tds_read_b32 %5, %7 offset:%13" \
            : "=v"(Wv[i]), "=v"(Kv[i]), "=v"(Bv[i]), "=v"(Ev[i]), "=v"(Rv[i]), "=v"(Vv[i]) : "v"(Ba), "v"(Va), "i"((s) * SC_STEP), "i"((s) * SC_STEP + 256), "i"((s) * SC_STEP + 512), "i"((s) * SC_STEP + 768), "i"((s) * SC_STEP + 1024), "i"((s) * 64) : "memory")
#define SC_WAIT(i, n) asm volatile("s_waitcnt lgkmcnt(%6)" : "+v"(Wv[i]), "+v"(Kv[i]), "+v"(Bv[i]), "+v"(Ev[i]), "+v"(Rv[i]), "+v"(Vv[i]) : "i"(n) : "memory")
        __syncthreads();
        for (int ch = 0; ch < NCH; ++ch) {
            const unsigned Ba = (unsigned)(size_t)(lds + (ch & 1) * SC_BUF + cg * 16), Va = (unsigned)(size_t)(lds + (ch & 1) * SC_BUF + SC_VV + row16 * 4);
            SC_LD(0, 0); SC_LD(1, 1);
#pragma unroll
            for (int s = 0; s < SC_CH; ++s) {
                constexpr int dummy = 0; (void)dummy;
                if (s + 2 < SC_CH) { SC_LD((s + 2) & 3, s + 2); SC_WAIT(s & 3, 12); }
                else if (s + 1 < SC_CH) { SC_WAIT(s & 3, 6); }
                else { SC_WAIT(s & 3, 0); }
                const f32x4 kc = Kv[s & 3], rp = (s == 0) ? rprev : Rv[(s + 3) & 3];
                float pa = SC_DOT(S, kc), py = SC_DOT(S, rp);
                SC_RED2(pa, py);
                ybuf = (cg == ((s + 15) & 15)) ? py : ybuf;
                if (s == 0) { if (ch > 0) *(LAS unsigned short*)(lds + SC_YB + ((ch - 1) & 3) * SC_YBB + ((16 + cg) * 16 + row16) * 2) = (unsigned short)f2bf(ybuf); }
                if (s == 16) *(LAS unsigned short*)(lds + SC_YB + (ch & 3) * SC_YBB + (cg * 16 + row16) * 2) = (unsigned short)f2bf(ybuf);
                S = S * Wv[s & 3] + (Ev[s & 3] * Vv[s & 3] - Bv[s & 3] * pa);
            }
            rprev = Rv[(SC_CH - 1) & 3];
            __syncthreads();
        }
#undef SC_LD
#undef SC_WAIT
        { float pa = 0.f, py = SC_DOT(S, rprev); SC_RED2(pa, py); ybuf = (cg == 15) ? py : ybuf;
          *(LAS unsigned short*)(lds + SC_YB + ((NCH - 1) & 3) * SC_YBB + ((16 + cg) * 16 + row16) * 2) = (unsigned short)f2bf(ybuf); }
        __syncthreads();
#undef SC_DOT
#undef SC_RED2
    }
    __syncthreads();
}

__device__ __forceinline__ void phase_rwkv_post(Frame& F, int l) {
    LAUNDER(F);
    const bf16* proj = (const bf16*)(F.ws + WS_PROJ); bf16* merged = (bf16*)(F.ws + WS_MERGED); const bf16* ysc = (const bf16*)(F.out);
    const int lane = F.lane, c4 = 4 * lane, hd = lane >> 4;
    LAS float* GUP = (LAS float*)F.lds;
    for (int q = F.tid; q < 32 * 256; q += NTHREADS) GUP[q] = INP(F, I_RGUP)[(size_t)l * 32 * 256 + q];
    __syncthreads();
    const f32x4 lw = *(const f32x4*)(INP(F, I_LNXW) + l * 256 + c4), lb = *(const f32x4*)(INP(F, I_LNXB) + l * 256 + c4), rk = *(const f32x4*)(INP(F, I_RRK) + l * 256 + c4);
    for (int m = F.vcu * NWAVES + F.wave; m < M; m += F.G * NWAVES) {
        const bf16* row = proj + (size_t)m * NPROJP;
        const v2u yf = *(const GAS v2u*)(ysc + (size_t)m * 256 + c4), yb = *(const GAS v2u*)(ysc + ((size_t)M + m) * 256 + c4);
        f32x4 y = (f32x4){bflo(yf.x) + bflo(yb.x), bfhi(yf.x) + bfhi(yb.x), bflo(yf.y) + bflo(yb.y), bfhi(yf.y) + bfhi(yb.y)};
        const float mu = row16_sum((y.x + y.y) + (y.z + y.w)) * (1.f / 64.f);
        y = y - mu;
        const float var = row16_sum((y.x * y.x + y.y * y.y) + (y.z * y.z + y.w * y.w)) * (1.f / 64.f);
        const float rstd = 1.f / sqrtf(var + GN_EPS);
        y = y * rstd * lw + lb;
        const v2u ru = *(const GAS v2u*)(row + C_R + c4), ku = *(const GAS v2u*)(row + C_K + c4), vu = *(const GAS v2u*)(row + C_V + c4);
        const f32x4 r = (f32x4){bflo(ru.x), bfhi(ru.x), bflo(ru.y), bfhi(ru.y)}, k = (f32x4){bflo(ku.x), bfhi(ku.x), bflo(ku.y), bfhi(ku.y)}, v = (f32x4){bflo(vu.x), bfhi(vu.x), bflo(vu.y), bfhi(vu.y)};
        const f32x4 rkk = r * k * rk;
        const float bsum = row16_sum((rkk.x + rkk.y) + (rkk.z + rkk.w));
        y = y + v * bsum;
        const float gd = sigmoidf_(bf2f(row[C_GDN + (lane & 31)]));
        f32x4 gt = (f32x4){0.f, 0.f, 0.f, 0.f};
#pragma unroll
        for (int j = 0; j < 32; ++j) { const float gj = __builtin_bit_cast(float, __builtin_amdgcn_readlane(__builtin_bit_cast(int, gd), j)); gt = gt + *(const LAS f32x4*)(GUP + j * 256 + c4) * gj; }
        y = y * gt;
        const float ss = wave_sum((y.x * y.x + y.y * y.y) + (y.z * y.z + y.w * y.w));
        const float sc = 1.f / sqrtf(ss * (1.f / 256.f) + NORM_EPS);
        v2u o; o.x = pk2(y.x * sc, y.y * sc); o.y = pk2(y.z * sc, y.w * sc);
        *(GAS v2u*)(merged + (size_t)m * DM + 256 + c4) = o;
    }
    (void)hd;
}

__device__ __forceinline__ void phase_residual(Frame& F, const float* gain, const bool IN_F32, const bool LAST) {
    LAUNDER(F);
    const bf16* y = (const bf16*)(F.ws + WS_Y); const float* part = (const float*)(F.ws + WS_PART);
    bf16* xb = (bf16*)(F.ws + WS_XB); float* rs = (float*)(F.ws + WS_RS); const float* xin = INP(F, I_X);
    const int lane = F.lane;
    f32x4 gv[4];
#pragma unroll
    for (int j = 0; j < 4; ++j) gv[j] = *((const f32x4*)gain + lane + 64 * j);
    for (int m = F.vcu * NWAVES + F.wave; m < M; m += F.G * NWAVES) {
        const f32x4* pp = (const f32x4*)(part + (size_t)m * 16);
        const f32x4 p0 = *(const GAS f32x4*)(pp), p1 = *(const GAS f32x4*)(pp + 1), p2 = *(const GAS f32x4*)(pp + 2), p3 = *(const GAS f32x4*)(pp + 3);
        const float tot = ((p0.x + p0.y) + (p0.z + p0.w)) + ((p1.x + p1.y) + (p1.z + p1.w)) + ((p2.x + p2.y) + (p2.z + p2.w)) + ((p3.x + p3.y) + (p3.z + p3.w));
        const float sc = 1.f / sqrtf(tot * (1.f / DM) + NORM_EPS);
        const GAS v2u* yr = (const GAS v2u*)(y + (size_t)m * DM) + lane;
        f32x4 v[4]; float s = 0.f;
#pragma unroll
        for (int j = 0; j < 4; ++j) { const v2u yu = yr[64 * j]; const f32x4 yv = (f32x4){bflo(yu.x), bfhi(yu.x), bflo(yu.y), bfhi(yu.y)};
            f32x4 xv;
            if (IN_F32) xv = ((const GAS f32x4*)(xin + (size_t)m * DM) + lane)[64 * j];
            else { const v2u xu = ((const GAS v2u*)(xb + (size_t)m * DM) + lane)[64 * j]; xv = (f32x4){bflo(xu.x), bfhi(xu.x), bflo(xu.y), bfhi(xu.y)}; }
            v[j] = xv + yv * sc * gv[j]; s += (v[j].x * v[j].x + v[j].y * v[j].y) + (v[j].z * v[j].z + v[j].w * v[j].w); }
        if (LAST) {
            GAS f32x4* orow = (GAS f32x4*)(F.out + (size_t)m * DM) + lane;
#pragma unroll
            for (int j = 0; j < 4; ++j) orow[64 * j] = v[j];
        } else {
            s = wave_sum(s);
            GAS v2u* o8 = (GAS v2u*)(xb + (size_t)m * DM) + lane;
#pragma unroll
            for (int j = 0; j < 4; ++j) { v2u o; o.x = pk2(v[j].x, v[j].y); o.y = pk2(v[j].z, v[j].w); o8[64 * j] = o; }
            if (lane == 0) rs[m] = 1.f / sqrtf(s * (1.f / DM) + NORM_EPS);
        }
    }
}
__device__ __forceinline__ void phase_ffn_conv(Frame& F, int l) {
    LAUNDER(F);
    const bf16* G = (const bf16*)(F.ws + WS_G); bf16* L = (bf16*)(F.ws + WS_L);
    const float* cw = INP(F, I_FCONV) + (size_t)l * 3 * DFF;
    constexpr int CPR = DFF / 8, STRIP = 16;
    const int nitems = (M / STRIP) * CPR;
    for (int it = F.vcu * NTHREADS + F.tid; it < nitems; it += F.G * NTHREADS) {
        const int ck = it % CPR, strip = it / CPR, m0 = strip * STRIP, t0 = m0 % T, c8 = 8 * ck;
        float w0[8], w1[8], w2[8];
#pragma unroll
        for (int j = 0; j < 8; ++j) { w0[j] = cw[c8 + j]; w1[j] = cw[DFF + c8 + j]; w2[j] = cw[2 * DFF + c8 + j]; }
        auto gload = [&](int t, int m) -> v4u { if (t < 0 || t >= T) return (v4u){0u, 0u, 0u, 0u}; return *(const GAS v4u*)(G + (size_t)m * DFF + c8); };
        v4u gp = gload(t0 - 1, m0 - 1), gc = gload(t0, m0);
#pragma unroll 4
        for (int i = 0; i < STRIP; ++i) {
            const v4u gn = gload(t0 + i + 1, m0 + i + 1);
            const v4u lv = *(const GAS v4u*)(L + (size_t)(m0 + i) * DFF + c8);
            v4u o;
#pragma unroll
            for (int q = 0; q < 4; ++q) {
                const float a0 = w0[2 * q] * bflo(gp[q]) + w1[2 * q] * bflo(gc[q]) + w2[2 * q] * bflo(gn[q]);
                const float a1 = w0[2 * q + 1] * bfhi(gp[q]) + w1[2 * q + 1] * bfhi(gc[q]) + w2[2 * q + 1] * bfhi(gn[q]);
                o[q] = pk2(gelu_tanh(a0) * bflo(lv[q]), gelu_tanh(a1) * bfhi(lv[q])); }
            *(GAS v4u*)(L + (size_t)(m0 + i) * DFF + c8) = o;
            gp = gc; gc = gn; }
    }
}

#ifndef MK_N_LAUNCHES
#define MK_N_LAUNCHES 1
#endif
constexpr int NPH = 1 + 10 * DEPTH;
struct Args { const float* in[26]; float* out; unsigned char* ws; int ph_lo, ph_hi; };
__global__ void __launch_bounds__(NTHREADS, 2) enc_fwd(Args args) {
    extern __shared__ __attribute__((aligned(16))) unsigned char lds_raw[];
    Frame F;
    F.lds = (LAS unsigned char*)lds_raw;
    F.MISC = (volatile LAS unsigned*)(F.lds + MISC_OFF);
    F.tid = threadIdx.x; F.lane = F.tid & 63; F.wave = __builtin_amdgcn_readfirstlane(F.tid >> 6);
    F.G = gridDim.x; { const int bx = blockIdx.x; F.vcu = (F.G % 8 == 0) ? (bx % 8) * (F.G / 8) + bx / 8 : bx; }
    F.ws = args.ws; F.out = args.out; F.ctl = (gu32*)(args.ws + WS_CTL);
    F.karg = (kq_t*)__builtin_amdgcn_kernarg_segment_ptr();
    for (int u = F.tid; u < (LDS_BYTES - LDSCTL_OFF) / 4; u += NTHREADS) ((LAS unsigned*)(F.lds + LDSCTL_OFF))[u] = 0u;
    __syncthreads();
    const int lo = args.ph_lo, hi = args.ph_hi;
    XcdBarrier bar; bar.bar = (unsigned*)(F.ctl + CW_BAR); bar.x = 0; bar.st = nullptr;
    if (hi - lo > 1) bar = xcd_barrier_post((unsigned*)(F.ctl + CW_BAR), F.MISC + 8);
#ifndef PH_ENABLE
#define PH_ENABLE 0x7ff
#endif
#define IN(k) (lo <= (k) && (k) < hi)
#define EN(t) (((PH_ENABLE) >> (t)) & 1)
#pragma unroll 1
#ifdef REPEAT_T
    for (int step = lo; step < hi; ++step) {
        const int p1 = REPEAT_T, p2 = REPEAT_T + 10;
        const int ph = step - (step > p1 ? 1 : 0) - ((step > p2 + 1 && REPEAT_T != 6) ? 1 : 0);
#else
    for (int ph = lo; ph < hi; ++ph) {
#endif
        LAUNDER(F);
        const int l = ph == 0 ? 0 : (ph - 1) / 10, t = ph == 0 ? 0 : 1 + (ph - 1) % 10;
        unsigned char* wl = F.ws + WS_W + (size_t)l * W_LAYER;
      {
        if (t == 1 || t == 5 || t == 7 || t == 9) {
            pg8::Gemm g; pg8::EpiUni E;
            g.M = M; E.split_cols = 0; E.split_stride = 0;
            if (t == 1)      { g.A = (const bf16*)(F.ws + WS_XB);     g.Bt = (const bf16*)(wl + W_IN);  g.N = NPROJP; g.K = DM;  E.O = (bf16*)(F.ws + WS_PROJ); E.ldc = NPROJP; E.rs = (const float*)(F.ws + WS_RS); E.part = nullptr; }
            else if (t == 5) { g.A = (const bf16*)(F.ws + WS_MERGED); g.Bt = (const bf16*)(wl + W_OUT); g.N = DM;     g.K = DM;  E.O = (bf16*)(F.ws + WS_Y); E.ldc = DM; E.rs = nullptr; E.part = (float*)(F.ws + WS_PART); }
            else if (t == 7) { g.A = (const bf16*)(F.ws + WS_XB);     g.Bt = (const bf16*)(wl + W_UP);  g.N = NUP;    g.K = DM;  E.O = (bf16*)(F.ws + WS_G); E.ldc = DFF; E.rs = (const float*)(F.ws + WS_RS); E.part = nullptr; E.split_cols = DFF; E.split_stride = (size_t)(WS_L - WS_G) / 2; }
            else             { g.A = (const bf16*)(F.ws + WS_L);      g.Bt = (const bf16*)(wl + W_DN);  g.N = DM;     g.K = DFF; E.O = (bf16*)(F.ws + WS_Y); E.ldc = DM; E.rs = nullptr; E.part = (float*)(F.ws + WS_PART); }
            pg8::StaticOrder S; S.init(M, g.N, F.G, (int)blockIdx.x);
            pg8::gemm_phase<pg8::EpiUni, pg8::StaticOrder, true, true>(F.lds, g, S, E);
        }
        else if (t == 0) p0_prologue(F);
        else if (t == 2) phase_mixers(F, l);
        else if (t == 3) phase_scan(F);
        else if (t == 4) phase_rwkv_post(F, l);
        else if (t == 6 || t == 10) phase_residual(F, INP(F, t == 6 ? I_NMPOST : I_NFPOST) + l * DM, t == 6 && l == 0, t == 10 && l + 1 == DEPTH);
        else if (t == 8) phase_ffn_conv(F, l);
      }
#ifdef REPEAT_T
        if (step + 1 < hi) xcd_barrier(bar);
#else
        if (ph + 1 < hi) xcd_barrier(bar);
#endif
    }
}


#ifdef DBG_CHECK
__global__ void dbg_check(const void* buf, size_t n, int kind, int code, unsigned* flag) {
    bool bad = false;
    for (size_t i = (size_t)blockIdx.x * blockDim.x + threadIdx.x; i < n; i += (size_t)gridDim.x * blockDim.x) {
        float v;
        if (kind == 0) v = bf2f(((const unsigned short*)buf)[i]);
        else if (kind == 1) v = ((const float*)buf)[i];
        else v = (float)((const _Float16*)buf)[i];
        if (!(fabsf(v) < 1e30f)) bad = true;
    }
    if (bad) atomicMax(flag, (unsigned)(1000000 - code));
}
__global__ void dbg_report(float* out, const unsigned* flag) { if (threadIdx.x == 0 && blockIdx.x == 0) { const unsigned f = *flag; if (f) out[0] = 100000.f * (float)(10 + 1000000 - (int)f); } }
#endif
extern "C" void kernel_launch(void* const* d_in, const int* in_sizes, int n_in, void* d_out, int out_size, void* d_ws, size_t ws_size, hipStream_t stream) {
    static int grid = 0;
    if (grid == 0) {
        if (n_in != 26 || in_sizes[0] != M * DM || out_size != M * DM || ws_size < WS_END) { fprintf(stderr, "kernel_launch: unexpected shapes: n_in %d in0 %d out %d ws %zu (need >= %zu)\n", n_in, n_in > 0 ? in_sizes[0] : -1, out_size, ws_size, (size_t)WS_END); grid = -1; return; }
        int dev = 0, cus = 0, per_cu = 0;
        if (hipGetDevice(&dev) != hipSuccess || hipDeviceGetAttribute(&cus, hipDeviceAttributeMultiprocessorCount, dev) != hipSuccess) { grid = -1; return; }
        if (hipFuncSetAttribute((const void*)enc_fwd, hipFuncAttributeMaxDynamicSharedMemorySize, LDS_BYTES) != hipSuccess) { fprintf(stderr, "kernel_launch: hipFuncSetAttribute failed\n"); grid = -1; return; }
        if (hipOccupancyMaxActiveBlocksPerMultiprocessor(&per_cu, (const void*)enc_fwd, NTHREADS, LDS_BYTES) != hipSuccess || per_cu < 1) { fprintf(stderr, "kernel_launch: occupancy query says %d blocks per CU\n", per_cu); }
        (void)hipGetLastError();
        grid = cus;
        if (grid != 256) fprintf(stderr, "kernel_launch: %d CUs (built for 256)\n", grid);
    }
    if (grid < 0) return;
    (void)hipMemsetAsync((char*)d_ws + WS_CTL, 0, CTL_ZERO_BYTES, stream);
    Args a{};
    for (int i = 0; i < 26; ++i) a.in[i] = (const float*)d_in[i];
    a.out = (float*)d_out; a.ws = (unsigned char*)d_ws;
#if MK_N_LAUNCHES == 1
#ifdef REPEAT_T
    a.ph_lo = 0; a.ph_hi = NPH + (REPEAT_T == 6 ? 1 : 2);
#else
    a.ph_lo = 0; a.ph_hi = NPH;
#endif
    hipLaunchKernelGGL(enc_fwd, dim3(grid), dim3(NTHREADS), LDS_BYTES, stream, a);
#else
    for (int p = 0; p < NPH; ++p) { a.ph_lo = p; a.ph_hi = p + 1; hipLaunchKernelGGL(enc_fwd, dim3(grid), dim3(NTHREADS), LDS_BYTES, stream, a);
#ifdef DBG_CHECK
        unsigned* flag = (unsigned*)((char*)d_ws + 512 * 1024); char* ws = (char*)d_ws; const int t = p == 0 ? 0 : 1 + (p - 1) % 10;
#define CHK(ptr, n, kind, sub) hipLaunchKernelGGL(dbg_check, dim3(2048), dim3(256), 0, stream, (const void*)(ptr), (size_t)(n), kind, p * 4 + sub, flag)
        if (t == 0) { CHK(ws + WS_W, 2 * W_LAYER / 2, 0, 0); CHK(ws + WS_XB, (size_t)M * DM, 0, 1); CHK(ws + WS_RS, M, 1, 2); }
        if (t == 1) { CHK(ws + WS_PROJ, (size_t)M * NPROJP, 0, 0); }
        if (t == 2) { CHK(ws + WS_PREP, (size_t)64 * MiB, 2, 1); }
        if (t == 3) { CHK(d_out, (size_t)2 * M * 256, 0, 0); }
        if (t == 4) { CHK(ws + WS_MERGED, (size_t)M * DM, 0, 0); }
        if (t == 5 || t == 9) { CHK(ws + WS_Y, (size_t)M * DM, 1, 0); CHK(ws + WS_PART, (size_t)M * 16, 1, 1); }
        if (t == 6 || t == 10) { CHK(d_out, (size_t)M * DM, 1, 0); CHK(ws + WS_XB, (size_t)M * DM, 0, 1); CHK(ws + WS_RS, M, 1, 2); }
        if (t == 7) { CHK(ws + WS_G, (size_t)M * DFF, 0, 0); CHK(ws + WS_L, (size_t)M * DFF, 0, 1); }
        if (t == 8) { CHK(ws + WS_L, (size_t)M * DFF, 0, 0); }
        if (p == NPH - 1) hipLaunchKernelGGL(dbg_report, dim3(1), dim3(64), 0, stream, (float*)d_out, (const unsigned*)flag);
#endif
    }
#endif
}
```

```cpp
#include <hip/hip_runtime.h>
#include <cstdio>
#include <cstdint>
namespace pg8 {
#define PG8_LAS __attribute__((address_space(3)))
#define PG8_GAS __attribute__((address_space(1)))
typedef unsigned short bf16_t;
typedef short bf16x8 __attribute__((ext_vector_type(8)));
typedef float f32x4 __attribute__((ext_vector_type(4)));
typedef unsigned u32x4 __attribute__((ext_vector_type(4)));
constexpr int BM = 256, BK = 64, HALF = 128, HTB = HALF * BK * 2  , STAGE_BYTES = 8 * HTB, NXCD = 8, WGM = 8;

__host__ __device__ __forceinline__ int lds_byte(int r, int c) { const int st = (r >> 4) * 2 + (c >> 5), rr = r & 15, cc = c & 31, ob = rr * 64 + cc * 2; return st * 1024 + (ob ^ (((ob >> 9) & 1) << 5)); }
__host__ __device__ __forceinline__ void stage_rc(int b, int& R, int& C) { const int st = b / 1024, sb = b % 1024, swz = sb ^ (((sb >> 9) & 1) << 5); R = (st >> 1) * 16 + swz / 64; C = (st & 1) * 32 + (swz % 64) / 2; }
__host__ __device__ __forceinline__ int perm32(int rho) { const int n = rho >> 4, i = rho & 15; return 8 * (i >> 2) + 4 * n + (i & 3); }

struct Unit { int pm, pn; };
struct Gemm { const PG8_GAS bf16_t* A; const PG8_GAS bf16_t* Bt; int M, N, K; };

struct StaticOrder {
    int nM, nN, nwg, G, c;
    __host__ __device__ void init(int M, int N, int G_, int c_) { nM = M / BM; nN = N / BM; nwg = nM * nN; G = G_; c = c_; }
    __host__ __device__ bool next(int i, Unit& u) const {
        const long L = (long)i * G + c; if (L >= nwg) return false;
        int wgid = (int)L; { const int q = nwg / NXCD, r = nwg % NXCD, xcd = wgid % NXCD, off = wgid / NXCD; wgid = (xcd < r ? xcd * (q + 1) : r * (q + 1) + (xcd - r) * q) + off; }
        const int nig = WGM * nN, gid = wgid / nig, fm = gid * WGM, gsz = (nM - fm) < WGM ? (nM - fm) : WGM;
        u.pm = fm + ((wgid % nig) % gsz); u.pn = (wgid % nig) / gsz; return true;
    }
    __device__ __forceinline__ void a_ready(const Unit&) const {}
    __device__ __forceinline__ void done(const Unit&) const {}
};
typedef float f32x2c __attribute__((ext_vector_type(2)));
typedef __bf16 bf16x2c __attribute__((ext_vector_type(2)));
__device__ __forceinline__ unsigned cvt_pk_bf16(float lo, float hi) { const f32x2c v = {lo, hi}; return __builtin_bit_cast(unsigned, __builtin_convertvector(v, bf16x2c)); }
struct EpiUni {
    static constexpr bool AFTER_DRAIN = false;
    PG8_GAS bf16_t* O; int ldc; const PG8_GAS float* rs; int split_cols; size_t split_stride; PG8_GAS float* part;
    __device__ __forceinline__ bool perm() const { return true; }
    __device__ __forceinline__ void operator()(const f32x4 (&acc)[2][2][4][2], const Unit& u, int wr, int wc, int fr, int fq) const {
        const int row0 = u.pm * BM + wr * 64 + fr; int colt = u.pn * BM; PG8_GAS bf16_t* base = O;
        if (split_cols) { const int t = colt / split_cols; base += (size_t)t * split_stride; colt -= t * split_cols; }
        const int col0 = colt + wc * 32 + 8 * fq;
        if (part == nullptr) {
#pragma unroll
            for (int ai = 0; ai < 2; ++ai)
#pragma unroll
                for (int m = 0; m < 4; ++m) { const int row = row0 + ai * HALF + m * 16; const float s = rs[row]; PG8_GAS bf16_t* rowp = base + (size_t)row * ldc + col0;
#pragma unroll
                    for (int bj = 0; bj < 2; ++bj) { const f32x4 v0 = acc[ai][bj][m][0] * s, v1 = acc[ai][bj][m][1] * s;
                        u32x4 w; w.x = cvt_pk_bf16(v0[0], v0[1]); w.y = cvt_pk_bf16(v0[2], v0[3]); w.z = cvt_pk_bf16(v1[0], v1[1]); w.w = cvt_pk_bf16(v1[2], v1[3]);
                        *(PG8_GAS u32x4*)(rowp + bj * HALF) = w; } }
        } else {
#pragma unroll
            for (int ai = 0; ai < 2; ++ai)
#pragma unroll
                for (int m = 0; m < 4; ++m) { const int row = row0 + ai * HALF + m * 16; PG8_GAS bf16_t* rowp = base + (size_t)row * ldc + col0; float ss = 0.f;
#pragma unroll
                    for (int bj = 0; bj < 2; ++bj) { const f32x4 v0 = acc[ai][bj][m][0], v1 = acc[ai][bj][m][1];
                        ss += ((v0[0] * v0[0] + v0[1] * v0[1]) + (v0[2] * v0[2] + v0[3] * v0[3])) + ((v1[0] * v1[0] + v1[1] * v1[1]) + (v1[2] * v1[2] + v1[3] * v1[3]));
                        u32x4 w; w.x = cvt_pk_bf16(v0[0], v0[1]); w.y = cvt_pk_bf16(v0[2], v0[3]); w.z = cvt_pk_bf16(v1[0], v1[1]); w.w = cvt_pk_bf16(v1[2], v1[3]);
                        *(PG8_GAS u32x4*)(rowp + bj * HALF) = w; }
                    ss += __shfl_xor(ss, 16); ss += __shfl_xor(ss, 32); if (fq == 0) part[(size_t)row * 16 + u.pn * 4 + wc] = ss; }
        }
    }
};
template <class Epi, class Sched, bool ALIGN_EPI = false, bool SP2 = false>
__device__ __forceinline__ void gemm_phase(PG8_LAS unsigned char* lds, const Gemm g, const Sched& S, const Epi& E) {
    int tid_ = threadIdx.x; asm volatile("" : "+v"(tid_));
    const int tid = tid_, wid = __builtin_amdgcn_readfirstlane(tid >> 6), lane = tid & 63, wr = wid >> 2, wc = wid & 3, fr = lane & 15, fq = lane >> 4;
    const int K = g.K, nt = K / BK;
    unsigned voffA[2], voffB[2];
#pragma unroll
    for (int i = 0; i < 2; ++i) { int R, C; stage_rc(tid * 16 + i * 8192, R, C); const int Rb = E.perm() ? ((R & ~31) + perm32(R & 31)) : R;
        voffA[i] = (unsigned)(R * K + C) * 2u; voffB[i] = (unsigned)(Rb * K + C) * 2u; }
    const size_t kstep = (size_t)(BK * 2);
    const size_t hstep = (size_t)HALF * K * 2;
    const size_t tstep = 2 * hstep;
    const unsigned ldsw = (unsigned)wid * 1024u;
    const int aoff = lds_byte(wr * 64 + fr, fq * 8), boff = lds_byte(wc * 32 + fr, fq * 8);
#define PG8_SA(b, h) (((b) * 2 + (h)) * HTB)
#define PG8_SB(b, h) ((4 + (b) * 2 + (h)) * HTB)
#define PG8_STAGE(bufoff, gbase, voff) do { _Pragma("unroll") for (int _i = 0; _i < 2; ++_i) \
        __builtin_amdgcn_global_load_lds((const PG8_GAS unsigned*)((const PG8_GAS char*)(gbase) + (voff)[_i]), (PG8_LAS unsigned*)(lds + (bufoff) + ldsw + _i * 8192), 16, 0, 0); } while (0)
#define PG8_LDA(dst, b, h) do { _Pragma("unroll") for (int m = 0; m < 4; ++m) _Pragma("unroll") for (int k = 0; k < 2; ++k) dst[m][k] = *(const PG8_LAS bf16x8*)(lds + PG8_SA(b, h) + aoff + m * 2048 + k * 1024); } while (0)
#define PG8_LDB(dst, b, h) do { _Pragma("unroll") for (int n = 0; n < 2; ++n) _Pragma("unroll") for (int k = 0; k < 2; ++k) dst[n][k] = *(const PG8_LAS bf16x8*)(lds + PG8_SB(b, h) + boff + n * 2048 + k * 1024); } while (0)
#define PG8_MMA(ai, bj, At, Bt) do { __builtin_amdgcn_s_setprio(1); _Pragma("unroll") for (int m = 0; m < 4; ++m) _Pragma("unroll") for (int n = 0; n < 2; ++n) _Pragma("unroll") for (int k = 0; k < 2; ++k) \
        acc[ai][bj][m][n] = __builtin_amdgcn_mfma_f32_16x16x32_bf16(Bt[n][k], At[m][k], acc[ai][bj][m][n], 0, 0, 0); __builtin_amdgcn_s_setprio(0); } while (0)
#define PG8_WAIT_V(n) asm volatile("s_waitcnt vmcnt(" #n ")" ::: "memory")
#define PG8_WAIT_L(n) asm volatile("s_waitcnt lgkmcnt(" #n ")" ::: "memory")
#define PG8_BAR __builtin_amdgcn_s_barrier()
#define PG8_SCHED __builtin_amdgcn_sched_barrier(0)
    Unit cur, nxt; int ui = 0;
    if (!S.next(0, cur)) return;
    f32x4 acc[2][2][4][2];
#pragma unroll
    for (int a = 0; a < 2; ++a)
#pragma unroll
        for (int b = 0; b < 2; ++b)
#pragma unroll
            for (int m = 0; m < 4; ++m)
#pragma unroll
                for (int n = 0; n < 2; ++n) acc[a][b][m][n] = (f32x4){0.f, 0.f, 0.f, 0.f};
    bf16x8 At[4][2], B0[2][2], B1[2][2];
    const PG8_GAS char* cA = (const PG8_GAS char*)g.A + (size_t)cur.pm * tstep; const PG8_GAS char* cB = (const PG8_GAS char*)g.Bt + (size_t)cur.pn * tstep;
    S.a_ready(cur);
    if constexpr (SP2) {
        PG8_STAGE(PG8_SB(0, 0), cB, voffB); PG8_STAGE(PG8_SB(0, 1), cB + hstep, voffB); PG8_STAGE(PG8_SA(0, 0), cA, voffA); PG8_STAGE(PG8_SA(0, 1), cA + hstep, voffA);
        if (wr == 1) PG8_BAR;
        PG8_WAIT_V(2); PG8_BAR;
        PG8_STAGE(PG8_SB(1, 0), cB + kstep, voffB); PG8_STAGE(PG8_SA(1, 0), cA + kstep, voffA); PG8_STAGE(PG8_SB(1, 1), cB + hstep + kstep, voffB);
        PG8_WAIT_V(6); PG8_BAR;
    } else {
        PG8_STAGE(PG8_SB(0, 0), cB, voffB); PG8_STAGE(PG8_SA(0, 0), cA, voffA); PG8_STAGE(PG8_SB(0, 1), cB + hstep, voffB); PG8_STAGE(PG8_SA(0, 1), cA + hstep, voffA);
        if (wr == 1) PG8_BAR;
        PG8_WAIT_V(4); PG8_BAR;
        PG8_STAGE(PG8_SB(1, 0), cB + kstep, voffB); PG8_STAGE(PG8_SA(1, 0), cA + kstep, voffA); PG8_STAGE(PG8_SB(1, 1), cB + hstep + kstep, voffB);
        PG8_WAIT_V(6); PG8_BAR;
    }
    for (;;) {
        const bool has_next = S.next(ui + 1, nxt);
        const PG8_GAS char* nA = has_next ? (const PG8_GAS char*)g.A + (size_t)nxt.pm * tstep : cA; const PG8_GAS char* nB = has_next ? (const PG8_GAS char*)g.Bt + (size_t)nxt.pn * tstep : cB;
        for (int t = 0; t < nt; t += 2) {
            const bool last = (t == nt - 2);
            const PG8_GAS char* a1 = cA + (size_t)(t + 1) * kstep;
            const PG8_GAS char* a2 = last ? nA : cA + (size_t)(t + 2) * kstep; const PG8_GAS char* b2 = last ? nB : cB + (size_t)(t + 2) * kstep;
            const PG8_GAS char* a3 = a2 + kstep; const PG8_GAS char* b3 = b2 + kstep;
            if (last && has_next) S.a_ready(nxt);
            if constexpr (SP2) {
            PG8_LDB(B0, 0, 0); PG8_LDB(B1, 0, 1); PG8_SCHED; PG8_LDA(At, 0, 0); PG8_STAGE(PG8_SA(1, 1), a1 + hstep, voffA);
            PG8_WAIT_V(8); PG8_WAIT_L(0); PG8_BAR; PG8_MMA(0, 0, At, B0); PG8_MMA(0, 1, At, B1); PG8_BAR; PG8_SCHED;
            PG8_LDA(At, 0, 1); PG8_STAGE(PG8_SB(0, 0), b2, voffB); PG8_STAGE(PG8_SB(0, 1), b2 + hstep, voffB); PG8_STAGE(PG8_SA(0, 0), a2, voffA);
            PG8_WAIT_V(8); PG8_WAIT_L(0); PG8_BAR; PG8_MMA(1, 0, At, B0); PG8_MMA(1, 1, At, B1); PG8_BAR; PG8_SCHED;
            PG8_LDB(B0, 1, 0); PG8_LDB(B1, 1, 1); PG8_SCHED; PG8_LDA(At, 1, 0); PG8_STAGE(PG8_SA(0, 1), a2 + hstep, voffA);
            PG8_WAIT_V(8); PG8_WAIT_L(0); PG8_BAR; PG8_MMA(0, 0, At, B0); PG8_MMA(0, 1, At, B1); PG8_BAR; PG8_SCHED;
            PG8_LDA(At, 1, 1); PG8_STAGE(PG8_SB(1, 0), b3, voffB); PG8_STAGE(PG8_SB(1, 1), b3 + hstep, voffB); PG8_STAGE(PG8_SA(1, 0), a3, voffA);
            PG8_WAIT_V(8); PG8_WAIT_L(0); PG8_BAR; PG8_MMA(1, 0, At, B0); PG8_MMA(1, 1, At, B1); PG8_BAR; PG8_SCHED;
            } else {
            PG8_LDB(B0, 0, 0); PG8_SCHED; PG8_LDA(At, 0, 0); PG8_STAGE(PG8_SA(1, 1), a1 + hstep, voffA);
            PG8_WAIT_L(8); PG8_BAR; PG8_WAIT_L(0); PG8_MMA(0, 0, At, B0); PG8_BAR; PG8_SCHED;
            PG8_LDB(B1, 0, 1); PG8_STAGE(PG8_SB(0, 0), b2, voffB);
            PG8_BAR; PG8_WAIT_L(0); PG8_MMA(0, 1, At, B1); PG8_BAR;
            PG8_LDA(At, 0, 1); PG8_STAGE(PG8_SA(0, 0), a2, voffA);
            PG8_BAR; PG8_WAIT_L(0); PG8_MMA(1, 0, At, B0); PG8_BAR; PG8_SCHED;
            PG8_STAGE(PG8_SB(0, 1), b2 + hstep, voffB);
            PG8_WAIT_V(6); PG8_BAR; PG8_MMA(1, 1, At, B1); PG8_BAR;
            PG8_LDB(B0, 1, 0); PG8_SCHED; PG8_LDA(At, 1, 0); PG8_STAGE(PG8_SA(0, 1), a2 + hstep, voffA);
            PG8_WAIT_L(8); PG8_BAR; PG8_WAIT_L(0); PG8_MMA(0, 0, At, B0); PG8_BAR; PG8_SCHED;
            PG8_LDB(B1, 1, 1); PG8_STAGE(PG8_SB(1, 0), b3, voffB);
            PG8_BAR; PG8_WAIT_L(0); PG8_MMA(0, 1, At, B1); PG8_BAR;
            PG8_LDA(At, 1, 1); PG8_STAGE(PG8_SA(1, 0), a3, voffA);
            PG8_BAR; PG8_WAIT_L(0); PG8_MMA(1, 0, At, B0); PG8_BAR; PG8_SCHED;
            PG8_STAGE(PG8_SB(1, 1), b3 + hstep, voffB);
            PG8_WAIT_V(6); PG8_BAR; PG8_MMA(1, 1, At, B1); PG8_BAR;
            }
        }
        if constexpr (ALIGN_EPI) { if (wr == 0) PG8_BAR; }
        if constexpr (!Epi::AFTER_DRAIN) { E(acc, cur, wr, wc, fr, fq); S.done(cur); }
        if (!has_next) break;
#pragma unroll
        for (int a = 0; a < 2; ++a)
#pragma unroll
            for (int b = 0; b < 2; ++b)
#pragma unroll
                for (int m = 0; m < 4; ++m)
#pragma unroll
                    for (int n = 0; n < 2; ++n) acc[a][b][m][n] = (f32x4){0.f, 0.f, 0.f, 0.f};
        cur = nxt; cA = nA; cB = nB; ++ui;
        if constexpr (ALIGN_EPI) { if (wr == 1) PG8_BAR; }
    }
    PG8_WAIT_V(0);
    if constexpr (!ALIGN_EPI) { if (wr == 0) PG8_BAR; }
    PG8_BAR;
    if constexpr (Epi::AFTER_DRAIN) { E.fused(acc, cur, wr, wc, fr, fq, lds, wid, lane); S.done(cur); }
#undef PG8_SA
#undef PG8_SB
#undef PG8_STAGE
#undef PG8_LDA
#undef PG8_LDB
#undef PG8_MMA
#undef PG8_WAIT_V
#undef PG8_WAIT_L
#undef PG8_BAR
#undef PG8_SCHED
}
}

constexpr int NB = 8, T = 4096, DM = 1024, M = NB * T, DEPTH = 2;
constexpr int NPROJ = 2912, NPROJP = 3072, DFF = 2816, NUP = 2 * DFF;
constexpr int C_CH = 0, C_CB = 256, C_CC = 512, C_R = 768, C_K = 1024, C_V = 1280, C_DEC = 1536, C_GDN = 1600, C_NQ = 1632, C_NK = 1888, C_NV = 2144, C_SU = 2400, C_SV = 2656;
constexpr float NORM_EPS = 1e-6f, GN_EPS = 64e-5f, DECAY_SCALE = 0.60653065971263342f;
constexpr int NWAVES = 8, NTHREADS = 512;
constexpr size_t MiB = 1u << 20;
constexpr size_t WS_CTL = 0, CTL_ZERO_BYTES = 1 * MiB;
constexpr size_t WS_RS = 1 * MiB;
constexpr size_t WS_PART = 1 * MiB + 256 * 1024;
constexpr size_t WS_W = 4 * MiB, W_LAYER = 24 * MiB + 512 * 1024;
constexpr size_t W_IN = 0, W_OUT = 6 * MiB, W_UP = 8 * MiB, W_DN = 19 * MiB;
constexpr size_t WS_XB = 53 * MiB;
constexpr size_t WS_R = 117 * MiB;
constexpr size_t WS_PROJ = WS_R, WS_MERGED = WS_R + 192 * MiB, WS_PREP = WS_R + 256 * MiB;
constexpr size_t GT_CHUNK = 12800, GT_DIR = (size_t)NB * 4 * 256 * GT_CHUNK;
constexpr size_t WS_GT0 = WS_PREP, WS_YSC0 = WS_PREP + 100 * MiB;
static_assert(GT_DIR == 100 * MiB, "GT size");
constexpr size_t WS_Y = WS_R;
constexpr size_t WS_G = WS_R, WS_L = WS_R + 176 * MiB;
constexpr size_t WS_END = 501 * MiB;
static_assert(WS_W + 2 * W_LAYER <= WS_XB && WS_PREP + 128 * MiB <= WS_END && WS_L + 176 * MiB <= WS_END && WS_PART + (size_t)M * 64 <= WS_W, "ws map");
constexpr int CW_BAR = 4096;
constexpr int RING_BYTES = 131072, LDSCTL_OFF = RING_BYTES, MISC_OFF = LDSCTL_OFF + 320, LDS_BYTES = 147456;

#define GAS __attribute__((address_space(1)))
#define LAS __attribute__((address_space(3)))
typedef unsigned short bf16;
typedef unsigned v4u __attribute__((ext_vector_type(4)));
typedef unsigned v2u __attribute__((ext_vector_type(2)));
typedef float f32x4 __attribute__((ext_vector_type(4)));
typedef short bf16x8 __attribute__((ext_vector_type(8)));
typedef short s16x4 __attribute__((ext_vector_type(4)));
typedef _Float16 h2 __attribute__((ext_vector_type(2)));
typedef GAS unsigned gu32;
#define RLX_AGENT __ATOMIC_RELAXED, __HIP_MEMORY_SCOPE_AGENT
__device__ __forceinline__ unsigned pk2(float lo, float hi) { return pg8::cvt_pk_bf16(lo, hi); }
__device__ __forceinline__ unsigned f2bf(float f) { return (unsigned)__builtin_bit_cast(unsigned short, (__bf16)f); }
__device__ __forceinline__ float bflo(unsigned w) { return __builtin_bit_cast(float, w << 16); }
__device__ __forceinline__ float bfhi(unsigned w) { return __builtin_bit_cast(float, w & 0xffff0000u); }
__device__ __forceinline__ float bf2f(unsigned short b) { return __builtin_bit_cast(float, (unsigned)b << 16); }
__device__ __forceinline__ h2 as_h2(unsigned u) { return __builtin_bit_cast(h2, u); }
template <int CTRL> __device__ __forceinline__ float dppmov(float x) { return __builtin_bit_cast(float, __builtin_amdgcn_update_dpp(0, __builtin_bit_cast(int, x), CTRL, 0xF, 0xF, true)); }
__device__ __forceinline__ float row16_sum(float x) { x += dppmov<0xB1>(x); x += dppmov<0x4E>(x); x += dppmov<0x141>(x); x += dppmov<0x140>(x); return x; }
typedef unsigned u32x2_t __attribute__((ext_vector_type(2)));
__device__ __forceinline__ float xor16_sum(float x) { const u32x2_t r = __builtin_amdgcn_permlane16_swap(__builtin_bit_cast(unsigned, x), __builtin_bit_cast(unsigned, x), false, false);
    const unsigned a = r.x, b = r.y; return __builtin_bit_cast(float, a) + __builtin_bit_cast(float, b); }
__device__ __forceinline__ float xor32_sum(float x) { const u32x2_t r = __builtin_amdgcn_permlane32_swap(__builtin_bit_cast(unsigned, x), __builtin_bit_cast(unsigned, x), false, false);
    const unsigned a = r.x, b = r.y; return __builtin_bit_cast(float, a) + __builtin_bit_cast(float, b); }
__device__ __forceinline__ float wave_sum(float v) { return xor32_sum(xor16_sum(row16_sum(v))); }
__device__ __forceinline__ float row16_max(float x) { x = fmaxf(x, dppmov<0xB1>(x)); x = fmaxf(x, dppmov<0x4E>(x)); x = fmaxf(x, dppmov<0x141>(x)); x = fmaxf(x, dppmov<0x140>(x)); return x; }
__device__ __forceinline__ float rcpf_(float x) { return __builtin_amdgcn_rcpf(x); }
__device__ __forceinline__ float rsqf_(float x) { return __builtin_amdgcn_rsqf(x); }
__device__ __forceinline__ float sigmoidf_(float x) { return rcpf_(1.f + __expf(-x)); }
__device__ __forceinline__ float tanhf_(float x) { return 1.f - 2.f * rcpf_(__expf(2.f * x) + 1.f); }
__device__ __forceinline__ float gelu_tanh(float x) { const float u = 1.5957691216057308f * x * (1.f + 0.044715f * x * x); return x * rcpf_(1.f + __expf(-u)); }
#define XB_TMO      128
#define XB_XCNT(j)  (256  + 64 * (j))
#define XB_XSUB(j)  (1280 + 64 * (j))
#define XB_XGEN(j)  (2304 + 64 * (j))
#define XB_TOP      3328
#define XB_TOPGEN   3392
#define XCD_BAR_WORDS 3456
#define XB_SPIN_CAP (1u << 18)

__device__ __forceinline__ unsigned xb_ld(unsigned* p)              { return __hip_atomic_load(p, __ATOMIC_RELAXED, __HIP_MEMORY_SCOPE_AGENT); }
__device__ __forceinline__ unsigned xb_add(unsigned* p, unsigned v) { return __hip_atomic_fetch_add(p, v, __ATOMIC_RELAXED, __HIP_MEMORY_SCOPE_AGENT); }
__device__ __forceinline__ unsigned xb_xcc_id() { return (unsigned)__builtin_amdgcn_s_getreg((3 << 11) | 20) & 0xFu; }
#define XB_SPIN(cond, bar) do { unsigned _sp = 0; while (cond) { __builtin_amdgcn_s_sleep(1); \
    if ((++_sp & 255u) == 0u) { if (xb_ld(&(bar)[XB_TMO])) break; if (_sp > XB_SPIN_CAP) { atomicAdd(&(bar)[XB_TMO], 1u); break; } } } } while (0)

struct XcdBarrier {
    unsigned* bar; unsigned x;
    volatile LAS unsigned* st;
};

__device__ __forceinline__ XcdBarrier xcd_barrier_post(unsigned* bar, volatile LAS unsigned* st) {
    XcdBarrier b; b.bar = bar; b.x = xb_xcc_id(); b.st = st;
    if (threadIdx.x == 0) (void)xb_add(&bar[XB_XCNT(b.x)], 1u);
    return b;
}
__device__ __forceinline__ void xcd_barrier_complete(unsigned* bar, unsigned x, unsigned& nloc, unsigned& nx) {
    const unsigned G = gridDim.x * gridDim.y * gridDim.z;
    unsigned sum, cnt, mine, sp = 0u;
    for (;;) {
        sum = 0u; cnt = 0u; mine = 0u;
#pragma unroll
        for (unsigned j = 0; j < 16; ++j) { const unsigned c = xb_ld(&bar[XB_XCNT(j)]); sum += c; cnt += (c > 0u) ? 1u : 0u; mine = (j == x) ? c : mine; }
        if (sum == G) break;
        __builtin_amdgcn_s_sleep(1);
        if ((++sp & 255u) == 0u) { if (xb_ld(&bar[XB_TMO])) break; if (sp > XB_SPIN_CAP) { atomicAdd(&bar[XB_TMO], 1u); break; } }
    }
    nloc = mine > 0u ? mine : 1u; nx = cnt > 0u ? cnt : 1u;
}

__device__ __forceinline__ void xcd_barrier(const XcdBarrier& b) {
    asm volatile("s_waitcnt vmcnt(0)" ::: "memory");
    __syncthreads();
    if (threadIdx.x == 0) {
        unsigned* bar = b.bar;
        __builtin_amdgcn_s_waitcnt(0);
        unsigned nloc = b.st[0], nx = b.st[1];
        if (nloc == 0u) { xcd_barrier_complete(bar, b.x, nloc, nx); b.st[0] = nloc; b.st[1] = nx; }
        const unsigned old = xb_add(&bar[XB_XSUB(b.x)], 1u);
        const unsigned gen = old / nloc;
        if (old + 1u == (gen + 1u) * nloc) {
            __builtin_amdgcn_fence(__ATOMIC_RELEASE, "agent");
            asm volatile("s_waitcnt vmcnt(0)" ::: "memory");
            const unsigned og = xb_add(&bar[XB_TOP], 1u);
            const unsigned tg = og / nx;
            if (og + 1u == (tg + 1u) * nx) xb_add(&bar[XB_TOPGEN], 1u);
            else XB_SPIN(xb_ld(&bar[XB_TOPGEN]) == tg, bar);
            __builtin_amdgcn_fence(__ATOMIC_ACQUIRE, "agent");
            xb_add(&bar[XB_XGEN(b.x)], 1u);
            asm volatile("s_waitcnt vmcnt(0)" ::: "memory");
        } else {
            XB_SPIN(xb_ld(&bar[XB_XGEN(b.x)]) == gen, bar);
            __builtin_amdgcn_fence(__ATOMIC_ACQUIRE, "agent");
            asm volatile("s_waitcnt vmcnt(0)" ::: "memory");
        }
    }
    __syncthreads();
}

typedef __attribute__((address_space(4))) const unsigned long long kq_t;
struct Frame {
    LAS unsigned char* lds;
    volatile LAS unsigned* MISC;
    gu32* ctl;
    int tid, lane, wave, vcu, G;
    kq_t* karg; GAS float* out; GAS unsigned char* ws;
};
#define INP(F, i) ((const GAS float*)(F).karg[(i)])
enum { I_X = 0, I_NMPRE, I_NMPOST, I_NFPRE, I_NFPOST, I_WIN, I_CONVW, I_RW0, I_RWUP, I_RA0, I_RAUP, I_RGUP, I_RKK, I_RKA, I_RRK, I_LNXW, I_LNXB, I_RPB, I_SGUN, I_SGUW, I_SGUB, I_MGAIN, I_WOUT, I_WUP, I_FCONV, I_WDN };
__device__ __forceinline__ int launder_u(int x) { asm volatile("" : "+v"(x)); return __builtin_amdgcn_readfirstlane(x); }
template <class P> __device__ __forceinline__ P launder_p(P p) { unsigned long long v = (unsigned long long)p; unsigned lo = (unsigned)v, hi = (unsigned)(v >> 32); asm volatile("" : "+v"(lo), "+v"(hi));
    lo = __builtin_amdgcn_readfirstlane(lo); hi = __builtin_amdgcn_readfirstlane(hi); return (P)(((unsigned long long)hi << 32) | lo); }
#define LAUNDER(F) do { asm volatile("" : "+v"((F).tid)); asm volatile("" : "+v"((F).lane)); (F).wave = launder_u((F).wave); (F).vcu = launder_u((F).vcu); (F).karg = launder_p((F).karg); (F).ws = launder_p((F).ws); (F).out = launder_p((F).out); } while (0)
#define LDS_WAIT() asm volatile("s_waitcnt lgkmcnt(0)" ::: "memory")
#define CFENCE() asm volatile("" ::: "memory")

__device__ __forceinline__ void p0_transpose_item(const GAS float* W, const GAS float* gain, int K, int N, GAS bf16* WT, LAS float* scr, int item, int lane) {
    const int nblk = N / 32, kb = item / nblk, nb = item % nblk, k0 = 64 * kb, n0 = 32 * nb;
#pragma unroll 8
    for (int i = 0; i < 32; ++i) { const int kk = 2 * i + (lane >> 5); const float g = gain ? gain[k0 + kk] : 1.f; scr[kk * 33 + (lane & 31)] = W[(size_t)(k0 + kk) * N + n0 + (lane & 31)] * g; }
    LDS_WAIT(); CFENCE();
    const int c = lane & 7;
#pragma unroll
    for (int j = 0; j < 4; ++j) { const int n = (lane >> 3) + 8 * j; const LAS float* s = scr + (8 * c) * 33 + n;
        v4u o; o.x = pk2(s[0 * 33], s[1 * 33]); o.y = pk2(s[2 * 33], s[3 * 33]); o.z = pk2(s[4 * 33], s[5 * 33]); o.w = pk2(s[6 * 33], s[7 * 33]);
        *(GAS v4u*)(WT + (size_t)(n0 + n) * K + k0 + 8 * c) = o; }
    LDS_WAIT(); CFENCE();
}
__device__ __forceinline__ void row_to_bf16_rs(const GAS float* xrow, GAS bf16* orow, GAS float* rs, int lane) {
    const GAS f32x4* xr = (const GAS f32x4*)xrow + lane;
    f32x4 v[4]; float s = 0.f;
#pragma unroll
    for (int j = 0; j < 4; ++j) { v[j] = xr[64 * j]; s += (v[j].x * v[j].x + v[j].y * v[j].y) + (v[j].z * v[j].z + v[j].w * v[j].w); }
    s = wave_sum(s);
    GAS v2u* o8 = (GAS v2u*)orow + lane;
#pragma unroll
    for (int j = 0; j < 4; ++j) { v2u o; o.x = pk2(v[j].x, v[j].y); o.y = pk2(v[j].z, v[j].w); o8[64 * j] = o; }
    if (lane == 0) *rs = rsqf_(s * (1.f / DM) + NORM_EPS);
}
__device__ __forceinline__ void p0_prologue(Frame& F) {
    LAUNDER(F);
    LAS float* scr = (LAS float*)(F.lds + F.wave * 16384);
    const int gw = F.vcu * NWAVES + F.wave, NGW = F.G * NWAVES;
    constexpr int I_IN = (DM / 64) * (NPROJ / 32), I_OUT = (DM / 64) * (DM / 32), I_UP = (DM / 64) * (NUP / 32), I_DN = (DFF / 64) * (DM / 32), I_L = I_IN + I_OUT + I_UP + I_DN;
    for (int it = gw; it < DEPTH * I_L; it += NGW) {
        const int l = it / I_L; int r = it % I_L; GAS unsigned char* wl = F.ws + WS_W + (size_t)l * W_LAYER;
        if (r < I_IN) { p0_transpose_item(INP(F, I_WIN) + (size_t)l * DM * NPROJ, INP(F, I_NMPRE) + l * DM, DM, NPROJ, (GAS bf16*)(wl + W_IN), scr, r, F.lane); continue; } r -= I_IN;
        if (r < I_OUT) { p0_transpose_item(INP(F, I_WOUT) + (size_t)l * DM * DM, INP(F, I_MGAIN) + l * DM, DM, DM, (GAS bf16*)(wl + W_OUT), scr, r, F.lane); continue; } r -= I_OUT;
        if (r < I_UP) { p0_transpose_item(INP(F, I_WUP) + (size_t)l * DM * NUP, INP(F, I_NFPRE) + l * DM, DM, NUP, (GAS bf16*)(wl + W_UP), scr, r, F.lane); continue; } r -= I_UP;
        p0_transpose_item(INP(F, I_WDN) + (size_t)l * DFF * DM, nullptr, DFF, DM, (GAS bf16*)(wl + W_DN), scr, r, F.lane);
    }
    unsigned zz = 0u; asm volatile("" : "+v"(zz));
    for (int i = F.vcu * NTHREADS + F.tid; i < DEPTH * 20480; i += F.G * NTHREADS) { const int l = i / 20480, r = i % 20480;
        *(GAS v4u*)(F.ws + WS_W + (size_t)l * W_LAYER + W_IN + (size_t)NPROJ * DM * 2 + (size_t)r * 16) = (v4u){zz, zz, zz, zz}; }
    for (int m = gw; m < M; m += NGW) row_to_bf16_rs(INP(F, I_X) + (size_t)m * DM, (GAS bf16*)(F.ws + WS_XB) + (size_t)m * DM, (GAS float*)(F.ws + WS_RS) + m, F.lane);
}

typedef float f32x16 __attribute__((ext_vector_type(16)));
__device__ __forceinline__ void mix_convprep_tile(Frame& F, int l, int tile) {
    LAUNDER(F);
    const GAS bf16* proj = (const GAS bf16*)(F.ws + WS_PROJ); GAS bf16* merged = (GAS bf16*)(F.ws + WS_MERGED);
    const int m0 = tile * 64, bb = m0 / T, t0 = m0 % T;
    const int lane = F.lane, w = F.wave;
    {
        const int c4 = 4 * lane; const GAS float* cw = INP(F, I_CONVW) + l * 768;
        const f32x4 w0 = *(const f32x4*)(cw + c4), w1 = *(const f32x4*)(cw + 256 + c4), w2 = *(const f32x4*)(cw + 512 + c4);
        const int ts = t0 + 8 * w;
        v2u hr[10], cr[10], br[8];
#pragma unroll
        for (int j = 0; j < 10; ++j) { const int t = ts - 1 + j; const bool ok = (t >= 0 && t < T); const GAS bf16* row = proj + (size_t)(bb * T + (ok ? t : ts)) * NPROJP;
            hr[j] = *(const GAS v2u*)(row + C_CH + c4); cr[j] = *(const GAS v2u*)(row + C_CC + c4); if (!ok) { hr[j] = (v2u){0u, 0u}; } }
#pragma unroll
        for (int j = 0; j < 8; ++j) { const GAS bf16* row = proj + (size_t)(bb * T + ts + j) * NPROJP; br[j] = *(const GAS v2u*)(row + C_CB + c4); }
#pragma unroll
        for (int i = 0; i < 8; ++i) { const int t = ts + i;
            f32x4 z[3];
#pragma unroll
            for (int q = 0; q < 3; ++q) { const v2u h = hr[i + q], c = cr[i + q]; z[q] = (f32x4){bflo(h.x) * bflo(c.x), bfhi(h.x) * bfhi(c.x), bflo(h.y) * bflo(c.y), bfhi(h.y) * bfhi(c.y)}; }
            const v2u b = br[i];
            const f32x4 bv = (f32x4){bflo(b.x), bfhi(b.x), bflo(b.y), bfhi(b.y)};
            const f32x4 y = bv * (w0 * z[0] + w1 * z[1] + w2 * z[2]);
            float ss = (y.x * y.x + y.y * y.y) + (y.z * y.z + y.w * y.w); ss = wave_sum(ss);
            const float sc = rsqf_(ss * (1.f / 256.f) + NORM_EPS);
            v2u o; o.x = pk2(y.x * sc, y.y * sc); o.y = pk2(y.z * sc, y.w * sc);
            *(GAS v2u*)(merged + (size_t)(bb * T + t) * DM + 0 + c4) = o;
}
    }
}

__device__ __forceinline__ void mix_na_item(Frame& F, int l, int item, LAS unsigned char* wl, const LAS float* RPB) {
    LAUNDER(F);
    const GAS bf16* proj = (const GAS bf16*)(F.ws + WS_PROJ); GAS bf16* merged = (GAS bf16*)(F.ws + WS_MERGED);
    const int lane = F.lane, i = lane & 15, g = lane >> 4;
    const int qg = item & 3, r = (item >> 2) & 63, bb = item >> 8;
    const int c0 = 16 * qg;
    int rs = r - 4; rs = rs < 0 ? 0 : (rs > 56 ? 56 : rs);
    int cs = c0 - 8; cs = cs < 0 ? 0 : (cs > 32 ? 32 : cs);
    LAS unsigned char* PL = wl; LAS unsigned char* VL = wl + 4096; LAS unsigned char* OL = wl + 8192;
    const size_t rowbase = (size_t)bb * T;
    float ssq[4] = {0.f, 0.f, 0.f, 0.f};
#pragma unroll 1
    for (int h = 0; h < 4; ++h) {
        bf16x8 qf[2];
        { const GAS bf16* qrow = proj + (rowbase + r * 64 + c0 + i) * NPROJP + C_NQ + h * 64 + 8 * g;
          qf[0] = *(const GAS bf16x8*)(qrow); qf[1] = *(const GAS bf16x8*)(qrow + 32); }
        f32x4 s[16];
#pragma unroll
        for (int kt = 0; kt < 16; ++kt) { const int kr = kt >> 1, hf = kt & 1;
            const GAS bf16* krow = proj + (rowbase + (rs + kr) * 64 + cs + 16 * hf + i) * NPROJP + C_NK + h * 64 + 8 * g;
            const bf16x8 k0 = *(const GAS bf16x8*)(krow), k1 = *(const GAS bf16x8*)(krow + 32);
            f32x4 a = (f32x4){0.f, 0.f, 0.f, 0.f};
            a = __builtin_amdgcn_mfma_f32_16x16x32_bf16(qf[0], k0, a, 0, 0, 0);
            a = __builtin_amdgcn_mfma_f32_16x16x32_bf16(qf[1], k1, a, 0, 0, 0);
            s[kt] = a; }
        float mx[4] = {-3e38f, -3e38f, -3e38f, -3e38f};
#pragma unroll
        for (int kt = 0; kt < 16; ++kt) { const int kr = kt >> 1, hf = kt & 1; const int cw = cs + 16 * hf + i; const int dy = rs + kr - r + 7;
#pragma unroll
            for (int e = 0; e < 4; ++e) { const int cq = c0 + 4 * g + e; int st = cq - 8; st = st < 0 ? 0 : (st > 48 ? 48 : st);
                int dx = cw - cq; dx = dx < -15 ? -15 : (dx > 15 ? 15 : dx); dx += 15;
                const bool valid = (cw >= st) && (cw < st + 16);
                float v = s[kt][e] * 0.125f + RPB[h * 465 + dy * 31 + dx];
                v = valid ? v : -1e30f; s[kt][e] = v; mx[e] = fmaxf(mx[e], v); } }
        float sm[4];
#pragma unroll
        for (int e = 0; e < 4; ++e) { mx[e] = row16_max(mx[e]); sm[e] = 0.f; }
#pragma unroll
        for (int kt = 0; kt < 16; ++kt)
#pragma unroll
            for (int e = 0; e < 4; ++e) { const float p = __expf(s[kt][e] - mx[e]); s[kt][e] = p; sm[e] += p; }
#pragma unroll
        for (int e = 0; e < 4; ++e) sm[e] = rcpf_(row16_sum(sm[e]));
        f32x4 oh[4];
#pragma unroll
        for (int dt = 0; dt < 4; ++dt) oh[dt] = (f32x4){0.f, 0.f, 0.f, 0.f};
        const GAS bf16* vsrc = proj + (rowbase + rs * 64 + cs + (lane >> 3)) * NPROJP + C_NV + h * 64 + 8 * (lane & 7);
        v4u vreg[4];
#pragma unroll
        for (int q = 0; q < 4; ++q) vreg[q] = *(const GAS v4u*)(vsrc + (size_t)(8 * q) * NPROJP);
#pragma unroll
        for (int half = 0; half < 2; ++half) {
            CFENCE();
#pragma unroll
            for (int k8 = 0; k8 < 8; ++k8) { const int kt = 8 * half + k8; v2u pw; pw.x = pk2(s[kt][0] * sm[0], s[kt][1] * sm[1]); pw.y = pk2(s[kt][2] * sm[2], s[kt][3] * sm[3]);
                *(LAS v2u*)(PL + (16 * k8 + i) * 32 + 8 * g) = pw; }
            CFENCE();
#pragma unroll
            for (int k4 = 0; k4 < 4; ++k4) { const int kr = 4 * half + k4;
                CFENCE();
#pragma unroll
                for (int q = 0; q < 4; ++q) *(LAS v4u*)(VL + ((lane >> 3) + 8 * q) * 128 + (lane & 7) * 16) = vreg[q];
                if (kr < 7) {
#pragma unroll
                    for (int q = 0; q < 4; ++q) vreg[q] = *(const GAS v4u*)(vsrc + (size_t)((kr + 1) * 64 + 8 * q) * NPROJP); }
                CFENCE();
                const LAS unsigned char* pa = PL + (32 * k4 + 8 * g + (i >> 2)) * 32 + 8 * (i & 3);
                const s16x4 plo = __builtin_bit_cast(s16x4, __builtin_amdgcn_ds_read_tr16_b64_v4i16((LAS s16x4*)(pa)));
                const s16x4 phi = __builtin_bit_cast(s16x4, __builtin_amdgcn_ds_read_tr16_b64_v4i16((LAS s16x4*)(pa + 128)));
                const bf16x8 pf = (bf16x8){plo[0], plo[1], plo[2], plo[3], phi[0], phi[1], phi[2], phi[3]};
#pragma unroll
                for (int dt = 0; dt < 4; ++dt) {
                    const LAS unsigned char* va = VL + (8 * g + (i >> 2)) * 128 + (16 * dt + 4 * (i & 3)) * 2;
                    const s16x4 vlo = __builtin_bit_cast(s16x4, __builtin_amdgcn_ds_read_tr16_b64_v4i16((LAS s16x4*)(va)));
                    const s16x4 vhi = __builtin_bit_cast(s16x4, __builtin_amdgcn_ds_read_tr16_b64_v4i16((LAS s16x4*)(va + 512)));
                    const bf16x8 vf = (bf16x8){vlo[0], vlo[1], vlo[2], vlo[3], vhi[0], vhi[1], vhi[2], vhi[3]};
                    oh[dt] = __builtin_amdgcn_mfma_f32_16x16x32_bf16(pf, vf, oh[dt], 0, 0, 0); }
            }
        }
        CFENCE();
#pragma unroll
        for (int dt = 0; dt < 4; ++dt)
#pragma unroll
            for (int e = 0; e < 4; ++e) { ssq[e] += oh[dt][e] * oh[dt][e]; *(LAS unsigned short*)(OL + (4 * g + e) * 512 + (h * 64 + 16 * dt + i) * 2) = (unsigned short)f2bf(oh[dt][e]); }
        CFENCE();
    }
    LAS float* SCL = (LAS float*)VL;
    CFENCE();
#pragma unroll
    for (int e = 0; e < 4; ++e) { const float sc = rsqf_(row16_sum(ssq[e]) * (1.f / 256.f) + NORM_EPS); if (i == 0) SCL[4 * g + e] = sc; }
    CFENCE();
#pragma unroll
    for (int q = 0; q < 8; ++q) { const int e = lane + 64 * q, row = e >> 5, ch = e & 31;
        const v4u v = *(const LAS v4u*)(OL + row * 512 + ch * 16); const float sc = SCL[row];
        v4u o;
#pragma unroll
        for (int t = 0; t < 4; ++t) o[t] = pk2(bflo(v[t]) * sc, bfhi(v[t]) * sc);
        *(GAS v4u*)(merged + (rowbase + r * 64 + c0 + row) * DM + 512 + 8 * ch) = o; }
    CFENCE();
}

constexpr int SG_PITCH = 528;
__device__ __forceinline__ void mix_sgu_item(Frame& F, int l, int item) {
    LAUNDER(F);
    const GAS bf16* proj = (const GAS bf16*)(F.ws + WS_PROJ); GAS bf16* merged = (GAS bf16*)(F.ws + WS_MERGED);
    const int lane = F.lane, w = F.wave, tid = F.tid, i = lane & 15, g = lane >> 4;
    const size_t m0 = (size_t)item * 128;
    LAS unsigned char* VI = F.lds; LAS float* SS = (LAS float*)(F.lds + 128 * SG_PITCH);
    { const int c4 = 4 * lane; const f32x4 gn = *(const f32x4*)(INP(F, I_SGUN) + l * 256 + c4);
      v2u xr[16];
#pragma unroll
      for (int j = 0; j < 16; ++j) xr[j] = *(const GAS v2u*)(proj + (m0 + 16 * w + j) * NPROJP + C_SV + c4);
#pragma unroll
      for (int j = 0; j < 16; ++j) { const int q = 16 * w + j; const v2u x = xr[j];
          f32x4 v = (f32x4){gelu_tanh(bflo(x.x)), gelu_tanh(bfhi(x.x)), gelu_tanh(bflo(x.y)), gelu_tanh(bfhi(x.y))};
          const float mu = wave_sum((v.x + v.y) + (v.z + v.w)) * (1.f / 256.f);
          v = v - mu;
          const float var = wave_sum((v.x * v.x + v.y * v.y) + (v.z * v.z + v.w * v.w)) * (1.f / 256.f);
          const float rstd = rsqf_(var + NORM_EPS);
          v2u o; o.x = pk2(v.x * rstd * gn.x, v.y * rstd * gn.y); o.y = pk2(v.z * rstd * gn.z, v.w * rstd * gn.w);
          *(LAS v2u*)(VI + q * SG_PITCH + c4 * 2) = o; } }
    __syncthreads();
    const int hh = w >> 1, ph = w & 1;
    f32x4 acc[4][4];
#pragma unroll
    for (int a = 0; a < 4; ++a)
#pragma unroll
        for (int b = 0; b < 4; ++b) acc[a][b] = (f32x4){0.f, 0.f, 0.f, 0.f};
    const GAS float* ws_ = INP(F, I_SGUW) + ((size_t)(l * 4 + hh) * 128) * 128;
#pragma unroll
    for (int ks = 0; ks < 4; ++ks) {
        bf16x8 af[4], bfr[4];
#pragma unroll
        for (int pt = 0; pt < 4; ++pt) { const GAS float* ap = ws_ + (size_t)(64 * ph + 16 * pt + i) * 128 + 32 * ks + 8 * g;
            const f32x4 x0 = *(const f32x4*)ap, x1 = *(const f32x4*)(ap + 4);
            const unsigned u0 = pk2(x0.x, x0.y), u1 = pk2(x0.z, x0.w), u2 = pk2(x1.x, x1.y), u3 = pk2(x1.z, x1.w);
            af[pt] = __builtin_bit_cast(bf16x8, (v4u){u0, u1, u2, u3}); }
#pragma unroll
        for (int dt = 0; dt < 4; ++dt) { const LAS unsigned char* va = VI + (32 * ks + 8 * g + (i >> 2)) * SG_PITCH + (hh * 64 + 16 * dt + 4 * (i & 3)) * 2;
            const s16x4 lo = __builtin_bit_cast(s16x4, __builtin_amdgcn_ds_read_tr16_b64_v4i16((LAS s16x4*)(va)));
            const s16x4 hi = __builtin_bit_cast(s16x4, __builtin_amdgcn_ds_read_tr16_b64_v4i16((LAS s16x4*)(va + 4 * SG_PITCH)));
            bfr[dt] = (bf16x8){lo[0], lo[1], lo[2], lo[3], hi[0], hi[1], hi[2], hi[3]}; }
#pragma unroll
        for (int pt = 0; pt < 4; ++pt)
#pragma unroll
            for (int dt = 0; dt < 4; ++dt) acc[pt][dt] = __builtin_amdgcn_mfma_f32_16x16x32_bf16(af[pt], bfr[dt], acc[pt][dt], 0, 0, 0);
    }
#pragma unroll
    for (int pt = 0; pt < 4; ++pt) {
        unsigned short ur[4][4];
#pragma unroll
        for (int e = 0; e < 4; ++e)
#pragma unroll
            for (int dt = 0; dt < 4; ++dt) ur[e][dt] = proj[(m0 + 64 * ph + 16 * pt + 4 * g + e) * NPROJP + C_SU + hh * 64 + 16 * dt + i];
#pragma unroll
        for (int e = 0; e < 4; ++e) { const int p = 64 * ph + 16 * pt + 4 * g + e; const float bs = INP(F, I_SGUB)[(l * 4 + hh) * 128 + p]; float ss = 0.f;
#pragma unroll
            for (int dt = 0; dt < 4; ++dt) { const float u = gelu_tanh(bf2f(ur[e][dt]));
                const float v = u * (acc[pt][dt][e] + bs); acc[pt][dt][e] = v; ss += v * v; }
            ss = row16_sum(ss); if (i == 0) SS[p * 4 + hh] = ss; } }
    __syncthreads();
#pragma unroll
    for (int pt = 0; pt < 4; ++pt)
#pragma unroll
        for (int e = 0; e < 4; ++e) { const int p = 64 * ph + 16 * pt + 4 * g + e; const f32x4 s4 = *(const LAS f32x4*)(SS + p * 4);
            const float sc = rsqf_(((s4.x + s4.y) + (s4.z + s4.w)) * (1.f / 256.f) + NORM_EPS);
#pragma unroll
            for (int dt = 0; dt < 4; ++dt) *(LAS unsigned short*)(VI + p * SG_PITCH + (hh * 64 + 16 * dt + i) * 2) = (unsigned short)f2bf(acc[pt][dt][e] * sc); }
    __syncthreads();
#pragma unroll
    for (int q = 0; q < 8; ++q) { const int e = tid + 512 * q, row = e >> 5, ch = e & 31;
        const v4u v = *(const LAS v4u*)(VI + row * SG_PITCH + ch * 16);
        *(GAS v4u*)(merged + (m0 + row) * DM + 768 + 8 * ch) = v; }
    __syncthreads();
}

__device__ __forceinline__ void phase_mix_na(Frame& F, int l, int bidx, int nblk) {
    LAUNDER(F);
    LAS float* RPB = (LAS float*)(F.lds + RING_BYTES + 1024);
    for (int q = F.tid; q < 4 * 465; q += NTHREADS) RPB[q] = INP(F, I_RPB)[l * 4 * 465 + q];
    __syncthreads();
    for (int it = bidx * NWAVES + F.wave; it < NB * 64 * 4; it += nblk * NWAVES) mix_na_item(F, l, it, F.lds + F.wave * 16384, RPB);
    __syncthreads();
#ifdef SGU_IN_C2
    for (int it = bidx; it < NB * 32; it += nblk) mix_sgu_item(F, l, it);
#endif
}
__device__ __forceinline__ void phase_mixers(Frame& F, int l) {
    LAUNDER(F);
    for (int tile = F.vcu; tile < M / 64; tile += F.G) mix_convprep_tile(F, l, tile);
    __syncthreads();
#ifndef SGU_IN_C2
    for (int it = F.vcu; it < NB * 32; it += F.G) mix_sgu_item(F, l, it);
#endif
}

constexpr int C1_VEC = 0, C1_VEC_D = 20480, C1_RES = 40960, C1_RES_D = 17664;
constexpr int C1_U = 0, C1_ZT = 4096, C1_ET = 8192, C1_QT = 12288, C1_CT = 16384, C1_DA = 17408;
typedef float f32x2 __attribute__((ext_vector_type(2)));
#define CK_DOT(a, b) ({ f32x2 t_ = (f32x2){(a).x, (a).y} * (f32x2){(b).x, (b).y}; t_ = __builtin_elementwise_fma((f32x2){(a).z, (a).w}, (f32x2){(b).z, (b).w}, t_); t_.x + t_.y; })
#define CK_RED2(a, b) do { a += dppmov<0xB1>(a); b += dppmov<0xB1>(b); a += dppmov<0x4E>(a); b += dppmov<0x4E>(b); a += dppmov<0x141>(a); b += dppmov<0x141>(b); a += dppmov<0x140>(a); b += dppmov<0x140>(b); } while (0)
__device__ __forceinline__ bf16x8 pack8(f32x4 lo, f32x4 hi) { return __builtin_bit_cast(bf16x8, (v4u){pg8::cvt_pk_bf16(lo.x, lo.y), pg8::cvt_pk_bf16(lo.z, lo.w), pg8::cvt_pk_bf16(hi.x, hi.y), pg8::cvt_pk_bf16(hi.z, hi.w)}); }
template <int MODE>
__device__ __forceinline__ void phase_scan_c1(Frame& F, int l) {
    LAUNDER(F);
    const GAS bf16* proj = (const GAS bf16*)(F.ws + WS_PROJ);
    const int lane = F.lane, w = F.wave, i = lane & 15, g = lane >> 4;
    const int d = w >> 2, wa = w & 3;
    const int bh = F.vcu >> 3, bb = bh >> 2, h = bh & 3;
    LAS unsigned char* lds = F.lds;
    bf16x8 Bw, Ba;
    { f32x4 xw0 = (f32x4){0.f, 0.f, 0.f, 0.f}, xw1 = xw0, xa0 = xw0, xa1 = xw0;
      if (g < 2) { const GAS float* pw = INP(F, I_RWUP) + ((size_t)(l * 2 + d) * 16 + 8 * g) * 256 + h * 64 + 16 * wa + i; const GAS float* pa = INP(F, I_RAUP) + ((size_t)(l * 2 + d) * 16 + 8 * g) * 256 + h * 64 + 16 * wa + i;
          xw0 = (f32x4){pw[0], pw[256], pw[512], pw[768]}; xw1 = (f32x4){pw[1024], pw[1280], pw[1536], pw[1792]};
          xa0 = (f32x4){pa[0], pa[256], pa[512], pa[768]}; xa1 = (f32x4){pa[1024], pa[1280], pa[1536], pa[1792]}; }
      Bw = pack8(xw0, xw1); Ba = pack8(xa0, xa1); }
    const float w0c = INP(F, I_RW0)[(l * 2 + d) * 256 + h * 64 + 16 * wa + i], a0c = INP(F, I_RA0)[(l * 2 + d) * 256 + h * 64 + 16 * wa + i], kag = INP(F, I_RKA)[l * 256 + h * 64 + 16 * wa + i];
    float kkg[4];
#pragma unroll
    for (int t = 0; t < 4; ++t) kkg[t] = INP(F, I_RKK)[l * 256 + h * 64 + 16 * t + i];
    const float kkgw = INP(F, I_RKK)[l * 256 + h * 64 + 16 * wa + i];
    const int cg = i, sel = g;
#define C1_BAR() do { asm volatile("s_waitcnt lgkmcnt(0)" ::: "memory"); __builtin_amdgcn_s_barrier(); asm volatile("" ::: "memory"); } while (0)
    unsigned short kq[4][4], kown[4], rq[4]; v4u dvr, ivr;
#define C1_LOAD(B_) do { const size_t m0_ = (size_t)bb * T + 16 * (B_); \
        _Pragma("unroll") for (int e_ = 0; e_ < 4; ++e_) { const GAS bf16* row_ = proj + (m0_ + 4 * g + e_) * NPROJP; \
            _Pragma("unroll") for (int t_ = 0; t_ < 4; ++t_) kq[t_][e_] = row_[C_K + h * 64 + 16 * t_ + i]; \
            rq[e_] = row_[C_R + h * 64 + 16 * wa + i]; kown[e_] = row_[C_K + h * 64 + 16 * wa + i]; } \
        { const GAS bf16* arow_ = proj + (m0_ + i) * NPROJP + C_DEC + 16 * d + 8 * (g & 1); dvr = *(const GAS v4u*)(arow_); ivr = *(const GAS v4u*)(arow_ + 32); } } while (0)
    C1_LOAD((F.vcu & 7) * 32);
    for (int it = 0; it < 32; ++it) {
        const int B = (F.vcu & 7) * 32 + it;
        if (MODE != 3) {
            v4u dv = (v4u){0u, 0u, 0u, 0u}, iv = dv;
            if (g < 2) { iv = ivr;
#pragma unroll
                for (int q = 0; q < 4; ++q) dv[q] = pk2(tanhf_(bflo(dvr[q])), tanhf_(bfhi(dvr[q]))); }
            const f32x4 z4 = (f32x4){0.f, 0.f, 0.f, 0.f};
            const f32x4 Dw = __builtin_amdgcn_mfma_f32_16x16x32_bf16(__builtin_bit_cast(bf16x8, dv), Bw, z4, 0, 0, 0);
            const f32x4 Da = __builtin_amdgcn_mfma_f32_16x16x32_bf16(__builtin_bit_cast(bf16x8, iv), Ba, z4, 0, 0, 0);
#pragma unroll
            for (int e = 0; e < 4; ++e) {
                float ss = 0.f;
#pragma unroll
                for (int t = 0; t < 4; ++t) { const float x = bf2f(kq[t][e]) * kkg[t]; ss += x * x; }
                ss = row16_sum(ss);
                const float k = bf2f(kown[e]); const float kk = k * kkgw * rsqf_(ss + 1e-12f);
                const float wv = __expf(-DECAY_SCALE * sigmoidf_(w0c + Dw[e])), av = sigmoidf_(a0c + Da[e]);
                const int tok = 4 * g + e, s = d ? 15 - tok : tok;
                LAS float* vp = (LAS float*)(lds + C1_VEC + d * C1_VEC_D + s * 1280) + 16 * wa + i;
                vp[0] = wv; vp[64] = kk; vp[128] = kk * av; vp[192] = k * (1.f + (av - 1.f) * kag); vp[256] = bf2f(rq[e]); }
        }
        if (it + 1 < 32) C1_LOAD(B + 1);
        C1_BAR();
        if (MODE != 1 && MODE != 4) {
            const LAS unsigned char* V = lds + C1_VEC + d * C1_VEC_D + cg * 16;
            LAS unsigned char* R = lds + C1_RES + d * C1_RES_D;
#define VLD(s_, vec_) (*(const LAS f32x4*)(V + (s_) * 1280 + (vec_) * 256))
            const unsigned Va = (unsigned)(size_t)V;
#define LD4(X, s_) asm volatile("ds_read_b128 %0, %4\n\tds_read_b128 %1, %4 offset:256\n\tds_read_b128 %2, %4 offset:512\n\tds_read_b128 %3, %4 offset:768" \
                : "=v"(X[0]), "=v"(X[1]), "=v"(X[2]), "=v"(X[3]) : "v"(Va + (unsigned)(s_) * 1280u) : "memory")
#define WT4(X, n_) asm volatile("s_waitcnt lgkmcnt(" #n_ ")" : "+v"(X[0]), "+v"(X[1]), "+v"(X[2]), "+v"(X[3]) :: "memory")
#define LD3(X, s_) asm volatile("ds_read_b128 %0, %3\n\tds_read_b128 %1, %3 offset:256\n\tds_read_b128 %2, %3 offset:512" \
                : "=v"(X[0]), "=v"(X[1]), "=v"(X[2]) : "v"(Va + (unsigned)(s_) * 1280u) : "memory")
#define WT3(X, n_) asm volatile("s_waitcnt lgkmcnt(" #n_ ")" : "+v"(X[0]), "+v"(X[1]), "+v"(X[2]) :: "memory")
            {
                const int s = 4 * wa + sel; f32x4 q = VLD(s, 4); float creg = 0.f;
                f32x4 A0[4], A1[4], A2[4];
#define QBODY_R(X) do { float d1 = CK_DOT(X[3], q), d2 = CK_DOT(X[2], q); CK_RED2(d1, d2); const bool act = j <= s; creg = (act && cg == j) ? d1 : creg; \
                    const f32x4 qn = X[0] * q - X[1] * d2; q = act ? qn : q; } while (0)
#define QBODY(X) do { float d1 = CK_DOT(X[3], q), d2 = CK_DOT(X[2], q); CK_RED2(d1, d2); creg = (cg == j) ? d1 : creg; q = X[0] * q - X[1] * d2; } while (0)
                int j = 4 * wa + 3;
                LD4(A0, j); LD4(A1, j - 1);
                LD4(A2, j - 2); WT4(A0, 8); QBODY_R(A0); --j;
                LD4(A0, j >= 2 ? j - 2 : 0); WT4(A1, 8); QBODY_R(A1); --j;
                LD4(A1, j >= 2 ? j - 2 : 0); WT4(A2, 8); QBODY_R(A2); --j;
                for (;;) {
                    LD4(A2, j >= 2 ? j - 2 : 0); WT4(A0, 8); QBODY(A0); if (--j < 0) break;
                    LD4(A0, j >= 2 ? j - 2 : 0); WT4(A1, 8); QBODY(A1); if (--j < 0) break;
                    LD4(A1, j >= 2 ? j - 2 : 0); WT4(A2, 8); QBODY(A2); if (--j < 0) break;
                }
                WT4(A0, 0); WT4(A1, 0); WT4(A2, 0);
#undef QBODY
#undef QBODY_R
                *(LAS f32x4*)(R + C1_QT + s * 256 + cg * 16) = q; *(LAS float*)(R + C1_CT + s * 64 + cg * 4) = creg;
            }
            {
                const int ga = 3 - wa, s = 4 * ga + sel; f32x4 u = VLD(s, 1);
                const int j0 = 4 * wa + sel; f32x4 x = VLD(j0, 3); f32x4 wz = (f32x4){1.f, 1.f, 1.f, 1.f};
                f32x4 U0[3], U1[3], U2[3], E0[3], E1[3], E2[3];
#define UBODY_R(X, Y) do { float d2 = CK_DOT(X[2], u), d3 = CK_DOT(x, Y[1]); CK_RED2(d2, d3); \
                    const f32x4 un = X[0] * u - X[1] * d2; u = (j < s) ? un : u; const bool act = ii > j0; \
                    const f32x4 xn = x * Y[0] - Y[2] * d3; x = act ? xn : x; wz = act ? wz * Y[0] : wz; } while (0)
#define UBODY(X, Y) do { float d2 = CK_DOT(X[2], u), d3 = CK_DOT(x, Y[1]); CK_RED2(d2, d3); u = X[0] * u - X[1] * d2; x = x * Y[0] - Y[2] * d3; wz = wz * Y[0]; } while (0)
                int j = 4 * ga + 2, ii = 4 * wa + 1;
                LD3(U0, j); LD3(E0, ii); LD3(U1, j >= 1 ? j - 1 : 0); LD3(E1, ii < 15 ? ii + 1 : 15);
                LD3(U2, j >= 2 ? j - 2 : 0); LD3(E2, ii < 14 ? ii + 2 : 15); WT3(U0, 12); WT3(E0, 12); UBODY_R(U0, E0); ++ii; --j;
                LD3(U0, j >= 2 ? j - 2 : 0); LD3(E0, ii < 14 ? ii + 2 : 15); WT3(U1, 12); WT3(E1, 12); UBODY_R(U1, E1); ++ii; --j;
                LD3(U1, j >= 2 ? j - 2 : 0); LD3(E1, ii < 14 ? ii + 2 : 15); WT3(U2, 12); WT3(E2, 12); UBODY_R(U2, E2); ++ii; --j;
                if (j >= 0) for (;;) {
                    LD3(U2, j >= 2 ? j - 2 : 0); LD3(E2, ii < 14 ? ii + 2 : 15); WT3(U0, 12); WT3(E0, 12); UBODY(U0, E0); ++ii; if (--j < 0) break;
                    LD3(U0, j >= 2 ? j - 2 : 0); LD3(E0, ii < 14 ? ii + 2 : 15); WT3(U1, 12); WT3(E1, 12); UBODY(U1, E1); ++ii; if (--j < 0) break;
                    LD3(U1, j >= 2 ? j - 2 : 0); LD3(E1, ii < 14 ? ii + 2 : 15); WT3(U2, 12); WT3(E2, 12); UBODY(U2, E2); ++ii; if (--j < 0) break;
                }
                WT3(U0, 0); WT3(U1, 0); WT3(U2, 0); WT3(E0, 0); WT3(E1, 0); WT3(E2, 0);
#undef UBODY
#undef UBODY_R
                LAS float* up = (LAS float*)(R + C1_U) + (4 * cg) * 16 + s; up[0] = u.x; up[16] = u.y; up[32] = u.z; up[48] = u.w;
                const f32x4 zb = VLD(j0, 2) * wz;
                LAS float* ep = (LAS float*)(R + C1_ET) + (4 * cg) * 16 + j0; ep[0] = x.x; ep[16] = x.y; ep[32] = x.z; ep[48] = x.w;
                LAS float* zp = (LAS float*)(R + C1_ZT) + (4 * cg) * 16 + j0; zp[0] = zb.x; zp[16] = zb.y; zp[32] = zb.z; zp[48] = zb.w;
                if (wa == 0 && sel == 0) *(LAS f32x4*)(R + C1_DA + cg * 16) = VLD(0, 0) * wz;
            }
#undef LD4
#undef WT4
#undef LD3
#undef WT3
#undef VLD
        }
        C1_BAR();
        if (MODE != 2 && MODE != 4) {
            const LAS unsigned char* R = lds + C1_RES + d * C1_RES_D;
            const int n = d ? 255 - B : B;
            GAS unsigned char* gt = (d ? (GAS unsigned char*)F.out : F.ws + WS_GT0) + ((size_t)(bb * 4 + h) * 256 + n) * GT_CHUNK;
            const int nt = wa;
            bf16x8 zf = (bf16x8){0, 0, 0, 0, 0, 0, 0, 0};
            if (g < 2) { const LAS f32x4* zp = (const LAS f32x4*)(R + C1_ZT + (16 * nt + i) * 64 + 32 * g); zf = pack8(zp[0], zp[1]); }
            f32x4 pp[4];
#pragma unroll
            for (int ct = 0; ct < 4; ++ct) {
                bf16x8 uf = (bf16x8){0, 0, 0, 0, 0, 0, 0, 0};
                if (g < 2) { const LAS f32x4* up = (const LAS f32x4*)(R + C1_U + (16 * ct + i) * 64 + 32 * g); uf = pack8(up[0], up[1]); }
                const f32x4 dd = __builtin_amdgcn_mfma_f32_16x16x32_bf16(uf, zf, (f32x4){0.f, 0.f, 0.f, 0.f}, 0, 0, 0);
                f32x4 pv = -dd;
                if (ct == nt) { const f32x4 da = *(const LAS f32x4*)(R + C1_DA + (16 * ct + 4 * g) * 4);
#pragma unroll
                    for (int e = 0; e < 4; ++e) if (4 * g + e == i) pv[e] += da[e]; }
                pp[ct] = pv; }
#define C1_ST(p_, v_) do { const bf16x8 v__ = (v_); if (MODE == 0) *(GAS bf16x8*)(p_) = v__; else asm volatile("" :: "v"(v__)); } while (0)
            C1_ST(gt + (nt * 2 + 0) * 1024 + lane * 16, pack8(pp[0], pp[1]));
            C1_ST(gt + (nt * 2 + 1) * 1024 + lane * 16, pack8(pp[2], pp[3]));
            if (g < 2) { const LAS f32x4* ep = (const LAS f32x4*)(R + C1_ET + (16 * nt + i) * 64 + 32 * g); C1_ST(gt + 10240 + nt * 512 + lane * 16, pack8(ep[0], ep[1])); }
            if (wa == 0) {
#pragma unroll
                for (int ks = 0; ks < 2; ++ks) { const LAS f32x4* qp = (const LAS f32x4*)(R + C1_QT + i * 256 + (32 * ks + 4 * g) * 4);
                    C1_ST(gt + (8 + ks) * 1024 + lane * 16, pack8(qp[0], qp[4])); }
                if (g < 2) { const LAS f32x4* cp = (const LAS f32x4*)(R + C1_CT + i * 64 + 32 * g); C1_ST(gt + 10240 + 4 * 512 + lane * 16, pack8(cp[0], cp[1])); }
            }
        }
    }
#undef C1_LOAD
#undef C1_BAR
    __syncthreads();
}
#define C2_BAR() do { asm volatile("s_waitcnt lgkmcnt(0)" ::: "memory"); __builtin_amdgcn_s_barrier(); asm volatile("" ::: "memory"); } while (0)
constexpr int C2_SLOT = 16384, C2_YOFF = 4 * C2_SLOT;
template <int MODE>
__device__ __forceinline__ void phase_scan_c2(Frame& F, int l) {
    LAUNDER(F);
    if (F.vcu >= 128) { if (MODE == 0) phase_mix_na(F, l, F.vcu - 128, 128); return; }
    const GAS bf16* proj = (const GAS bf16*)(F.ws + WS_PROJ);
    const int lane = F.lane, i = lane & 15, g = lane >> 4;
    LAS unsigned char* lds = F.lds;
    if (F.vcu < 128) {
    const int ci = F.vcu >> 1, tp = F.vcu & 1, d = ci >> 5, bb = (ci >> 2) & 7, h = ci & 3;
    for (int q = F.tid; q < 4 * 5 * 32; q += NTHREADS) { const int sl = q / 160, r = q % 160; *(LAS v4u*)(lds + sl * C2_SLOT + 10240 + (r >> 5) * 1024 + 512 + (r & 31) * 16) = (v4u){0u, 0u, 0u, 0u}; }
    __syncthreads();
    if (F.wave < 2) {
        const int cw = F.wave;
        f32x4 st[4];
#pragma unroll
        for (int t = 0; t < 4; ++t) st[t] = (f32x4){0.f, 0.f, 0.f, 0.f};
        v4u af[15], vf, nf[15], nvf;
#define C2_RD(AF, VF, c_) do { const LAS unsigned char* p_ = lds + ((c_) & 3) * C2_SLOT + lane * 16; \
            _Pragma("unroll") for (int f_ = 0; f_ < 15; ++f_) AF[f_] = *(const LAS v4u*)(p_ + f_ * 1024); \
            VF = *(const LAS v4u*)(lds + ((c_) & 3) * C2_SLOT + 15360 + cw * 512 + i * 32 + (g & 1) * 16); } while (0)
#define C2_STEP(AF, VF, NF, NVF, n_) do { \
            if ((n_) + 1 < 256) C2_RD(NF, NVF, (n_) + 1); \
            const bf16x8 b0_ = pack8(st[0], st[1]), b1_ = pack8(st[2], st[3]); const v4u vz_ = (g < 2) ? VF : (v4u){0u, 0u, 0u, 0u}; const bf16x8 bv_ = __builtin_bit_cast(bf16x8, vz_); \
            f32x4 o_[5]; \
            _Pragma("unroll") for (int nt = 0; nt < 5; ++nt) { if (MODE >= 2) { o_[nt] = __builtin_bit_cast(f32x4, AF[nt]) + __builtin_bit_cast(f32x4, AF[10 + nt]) * st[nt & 3]; continue; } \
                f32x4 a_ = __builtin_amdgcn_mfma_f32_16x16x32_bf16(__builtin_bit_cast(bf16x8, AF[nt * 2]), b0_, (f32x4){0.f, 0.f, 0.f, 0.f}, 0, 0, 0); \
                a_ = __builtin_amdgcn_mfma_f32_16x16x32_bf16(__builtin_bit_cast(bf16x8, AF[nt * 2 + 1]), b1_, a_, 0, 0, 0); \
                o_[nt] = __builtin_amdgcn_mfma_f32_16x16x32_bf16(__builtin_bit_cast(bf16x8, AF[10 + nt]), bv_, a_, 0, 0, 0); } \
            _Pragma("unroll") for (int t = 0; t < 4; ++t) st[t] = o_[t]; \
            { v2u yw_; yw_.x = pk2(o_[4].x, o_[4].y); yw_.y = pk2(o_[4].z, o_[4].w); \
              *(LAS v2u*)(lds + C2_YOFF + (cw * 8 + ((n_) & 7)) * 512 + i * 32 + g * 8) = yw_; }     \
            } while (0)
        C2_BAR();
        C2_RD(af, vf, 0);
        for (int n = 0; n < 256; n += 2) { C2_STEP(af, vf, nf, nvf, n); C2_STEP(nf, nvf, af, vf, n + 1); C2_BAR(); }
        C2_BAR();
#undef C2_STEP
#undef C2_RD
    } else {
        const int hl = F.tid - 128;
        const GAS unsigned char* gt = (d ? (const GAS unsigned char*)F.out : F.ws + WS_GT0) + ((size_t)(bb * 4 + h) * 256) * GT_CHUNK;
        GAS bf16* ysc = (GAS bf16*)(d ? (GAS unsigned char*)F.out + GT_DIR : F.ws + WS_YSC0) + (size_t)bb * T * 256 + h * 64 + 32 * tp;
        const int p0 = hl, p1 = hl + 384, p2 = hl + 768; const bool has2 = p2 < 800;
#define C2_OFF(p_) ((p_) < 640 ? (p_) * 16 : 10240 + (((p_) - 640) >> 5) * 1024 + (((p_) - 640) & 31) * 16)
        const int o0 = C2_OFF(p0), o1 = C2_OFF(p1), o2 = C2_OFF(has2 ? p2 : 799);
        const int e0 = hl, e1 = hl + 384; const bool hasv1 = e1 < 512;
        const GAS bf16* vs0 = proj + (size_t)bb * T * NPROJP + C_V + h * 64 + 32 * tp + 16 * (e0 >> 8) + (e0 & 15);
        const GAS bf16* vs1 = proj + (size_t)bb * T * NPROJP + C_V + h * 64 + 32 * tp + 16 * ((hasv1 ? e1 : 0) >> 8) + (e1 & 15);
        const int vt0 = (e0 >> 4) & 15, vt1 = (e1 >> 4) & 15;
        const int vo0 = 15360 + (e0 >> 8) * 512 + (e0 & 15) * 32 + vt0 * 2, vo1 = 15360 + ((hasv1 ? e1 : 0) >> 8) * 512 + (e1 & 15) * 32 + vt1 * 2;
        constexpr int RD = 12;
        v4u r0[RD], r1[RD], r2[RD]; unsigned short rv0[RD], rv1[RD];
        if (MODE == 1 || MODE == 3) {
#pragma unroll
            for (int k = 0; k < RD; ++k) { r0[k] = (v4u){1u, 2u, 3u, 4u}; r1[k] = r0[k]; r2[k] = r0[k]; rv0[k] = 0; rv1[k] = 0; } }
#define C2_GLD(k_, n_) do { if (MODE == 1 || MODE == 3) break; const GAS unsigned char* c_ = gt + (size_t)(n_) * GT_CHUNK; r0[k_] = *(const GAS v4u*)(c_ + p0 * 16); r1[k_] = *(const GAS v4u*)(c_ + p1 * 16); \
            if (has2) r2[k_] = *(const GAS v4u*)(c_ + p2 * 16); \
            { const int gs_ = 16 * (n_) + vt0, t_ = d ? (T - 1 - gs_) : gs_; rv0[k_] = vs0[(size_t)t_ * NPROJP]; } \
            if (hasv1) { const int gs_ = 16 * (n_) + vt1, t_ = d ? (T - 1 - gs_) : gs_; rv1[k_] = vs1[(size_t)t_ * NPROJP]; } } while (0)
#define C2_WR(k_, n_) do { LAS unsigned char* p_ = lds + ((n_) & 3) * C2_SLOT; *(LAS v4u*)(p_ + o0) = r0[k_]; *(LAS v4u*)(p_ + o1) = r1[k_]; if (has2) *(LAS v4u*)(p_ + o2) = r2[k_]; \
            *(LAS unsigned short*)(p_ + vo0) = rv0[k_]; if (hasv1) *(LAS unsigned short*)(p_ + vo1) = rv1[k_]; } while (0)
#define C2_YST(m_) do { if (hl < 64) { const int cw_ = hl >> 5, s_ = (hl >> 1) & 15, hf_ = hl & 1; const LAS unsigned short* yp_ = (const LAS unsigned short*)(lds + C2_YOFF + (cw_ * 8 + ((m_) & 7)) * 512) + s_; \
            v4u w_; _Pragma("unroll") for (int e_ = 0; e_ < 4; ++e_) w_[e_] = (unsigned)yp_[(8 * hf_ + 2 * e_) * 16] | ((unsigned)yp_[(8 * hf_ + 2 * e_ + 1) * 16] << 16); \
            const int gs_ = 16 * (m_) + s_, t_ = d ? (T - 1 - gs_) : gs_; if (MODE == 0) *(GAS v4u*)(ysc + (size_t)t_ * 256 + 16 * cw_ + 8 * hf_) = w_; else asm volatile("" :: "v"(w_)); } } while (0)
#pragma unroll
        for (int k = 0; k < RD; ++k) C2_GLD(k, k);
        C2_WR(0, 0); C2_GLD(0, RD); C2_WR(1, 1); C2_GLD(1, RD + 1); C2_WR(2, 2); C2_GLD(2, RD + 2);
        C2_BAR();
        for (int m6 = 0; m6 < 128; m6 += RD / 2) {
#pragma unroll
            for (int k = 0; k < RD / 2; ++k) { const int m = m6 + k;
                if (m < 128) {
                    const int ca = 2 * m + 3, cb = 2 * m + 4, ka = (2 * k + 3) % RD, kb = (2 * k + 4) % RD;
                    if (ca < 256) { C2_WR(ka, ca); if (ca + RD < 256) C2_GLD(ka, ca + RD); }
                    if (cb < 256) { C2_WR(kb, cb); if (cb + RD < 256) C2_GLD(kb, cb + RD); }
                    if (m > 0) { C2_YST(2 * m - 2); C2_YST(2 * m - 1); }
                    C2_BAR(); } }
        }
        C2_YST(254); C2_YST(255);
        C2_BAR();
#undef C2_GLD
#undef C2_WR
#undef C2_YST
#undef C2_OFF
    }
    }
    __syncthreads();
}
#undef C2_BAR
#undef CK_DOT
#undef CK_RED2

__device__ __forceinline__ void phase_rwkv_post(Frame& F, int l) {
    LAUNDER(F);
    const GAS bf16* proj = (const GAS bf16*)(F.ws + WS_PROJ); GAS bf16* merged = (GAS bf16*)(F.ws + WS_MERGED); const GAS bf16* ysc0 = (const GAS bf16*)(F.ws + WS_YSC0); const GAS bf16* ysc1 = (const GAS bf16*)((const GAS unsigned char*)F.out + GT_DIR);
    const int lane = F.lane, c4 = 4 * lane, hd = lane >> 4;
    LAS float* GUP = (LAS float*)F.lds;
    for (int q = F.tid; q < 32 * 256; q += NTHREADS) GUP[q] = INP(F, I_RGUP)[(size_t)l * 32 * 256 + q];
    __syncthreads();
    const f32x4 lw = *(const f32x4*)(INP(F, I_LNXW) + l * 256 + c4), lb = *(const f32x4*)(INP(F, I_LNXB) + l * 256 + c4), rk = *(const f32x4*)(INP(F, I_RRK) + l * 256 + c4);
    const int mstep = F.G * NWAVES; int m = F.vcu * NWAVES + F.wave;
    v2u n_yf, n_yb, n_r, n_k, n_v; unsigned short n_g;
#define POST_LOAD(mm) do { const GAS bf16* row_ = proj + (size_t)(mm) * NPROJP; n_yf = *(const GAS v2u*)(ysc0 + (size_t)(mm) * 256 + c4); n_yb = *(const GAS v2u*)(ysc1 + (size_t)(mm) * 256 + c4); \
        n_r = *(const GAS v2u*)(row_ + C_R + c4); n_k = *(const GAS v2u*)(row_ + C_K + c4); n_v = *(const GAS v2u*)(row_ + C_V + c4); n_g = row_[C_GDN + (lane & 31)]; } while (0)
    POST_LOAD(m);
    for (; m < M; m += mstep) {
        const v2u yf = n_yf, yb = n_yb, ru = n_r, ku = n_k, vu = n_v; const unsigned short gu = n_g;
        if (m + mstep < M) POST_LOAD(m + mstep);
        f32x4 y = (f32x4){bflo(yf.x) + bflo(yb.x), bfhi(yf.x) + bfhi(yb.x), bflo(yf.y) + bflo(yb.y), bfhi(yf.y) + bfhi(yb.y)};
        const float mu = row16_sum((y.x + y.y) + (y.z + y.w)) * (1.f / 64.f);
        y = y - mu;
        const float var = row16_sum((y.x * y.x + y.y * y.y) + (y.z * y.z + y.w * y.w)) * (1.f / 64.f);
        const float rstd = rsqf_(var + GN_EPS);
        y = y * rstd * lw + lb;
        const f32x4 r = (f32x4){bflo(ru.x), bfhi(ru.x), bflo(ru.y), bfhi(ru.y)}, k = (f32x4){bflo(ku.x), bfhi(ku.x), bflo(ku.y), bfhi(ku.y)}, v = (f32x4){bflo(vu.x), bfhi(vu.x), bflo(vu.y), bfhi(vu.y)};
        const f32x4 rkk = r * k * rk;
        const float bsum = row16_sum((rkk.x + rkk.y) + (rkk.z + rkk.w));
        y = y + v * bsum;
        const float gd = sigmoidf_(bf2f(gu));
        f32x4 gt = (f32x4){0.f, 0.f, 0.f, 0.f};
#pragma unroll
        for (int j = 0; j < 32; ++j) { const float gj = __builtin_bit_cast(float, __builtin_amdgcn_readlane(__builtin_bit_cast(int, gd), j)); gt = gt + *(const LAS f32x4*)(GUP + j * 256 + c4) * gj; }
        y = y * gt;
        const float ss = wave_sum((y.x * y.x + y.y * y.y) + (y.z * y.z + y.w * y.w));
        const float sc = rsqf_(ss * (1.f / 256.f) + NORM_EPS);
        v2u o; o.x = pk2(y.x * sc, y.y * sc); o.y = pk2(y.z * sc, y.w * sc);
        *(GAS v2u*)(merged + (size_t)m * DM + 256 + c4) = o;
    }
#undef POST_LOAD
    (void)hd;
}

__device__ __forceinline__ void phase_residual(Frame& F, const GAS float* gain, const bool IN_F32, const bool LAST) {
    LAUNDER(F);
    const GAS bf16* y = (const GAS bf16*)(F.ws + WS_Y); const GAS float* part = (const GAS float*)(F.ws + WS_PART);
    GAS bf16* xb = (GAS bf16*)(F.ws + WS_XB); GAS float* rs = (GAS float*)(F.ws + WS_RS); const GAS float* xin = INP(F, I_X);
    const int lane = F.lane;
    f32x4 gv[4];
#pragma unroll
    for (int j = 0; j < 4; ++j) gv[j] = *((const f32x4*)gain + lane + 64 * j);
    for (int m = F.vcu * NWAVES + F.wave; m < M; m += F.G * NWAVES) {
        const f32x4* pp = (const f32x4*)(part + (size_t)m * 16);
        const f32x4 p0 = *(const GAS f32x4*)(pp), p1 = *(const GAS f32x4*)(pp + 1), p2 = *(const GAS f32x4*)(pp + 2), p3 = *(const GAS f32x4*)(pp + 3);
        const float tot = ((p0.x + p0.y) + (p0.z + p0.w)) + ((p1.x + p1.y) + (p1.z + p1.w)) + ((p2.x + p2.y) + (p2.z + p2.w)) + ((p3.x + p3.y) + (p3.z + p3.w));
        const float sc = rsqf_(tot * (1.f / DM) + NORM_EPS);
        const GAS v2u* yr = (const GAS v2u*)(y + (size_t)m * DM) + lane;
        f32x4 v[4]; float s = 0.f;
#pragma unroll
        for (int j = 0; j < 4; ++j) { const v2u yu = yr[64 * j]; const f32x4 yv = (f32x4){bflo(yu.x), bfhi(yu.x), bflo(yu.y), bfhi(yu.y)};
            f32x4 xv;
            if (IN_F32) xv = ((const GAS f32x4*)(xin + (size_t)m * DM) + lane)[64 * j];
            else { const v2u xu = ((const GAS v2u*)(xb + (size_t)m * DM) + lane)[64 * j]; xv = (f32x4){bflo(xu.x), bfhi(xu.x), bflo(xu.y), bfhi(xu.y)}; }
            v[j] = xv + yv * sc * gv[j]; s += (v[j].x * v[j].x + v[j].y * v[j].y) + (v[j].z * v[j].z + v[j].w * v[j].w); }
        if (LAST) {
            GAS f32x4* orow = (GAS f32x4*)(F.out + (size_t)m * DM) + lane;
#pragma unroll
            for (int j = 0; j < 4; ++j) orow[64 * j] = v[j];
        } else {
            s = wave_sum(s);
            GAS v2u* o8 = (GAS v2u*)(xb + (size_t)m * DM) + lane;
#pragma unroll
            for (int j = 0; j < 4; ++j) { v2u o; o.x = pk2(v[j].x, v[j].y); o.y = pk2(v[j].z, v[j].w); o8[64 * j] = o; }
            if (lane == 0) rs[m] = rsqf_(s * (1.f / DM) + NORM_EPS);
        }
    }
}
__device__ __forceinline__ void phase_ffn_conv(Frame& F, int l) {
    LAUNDER(F);
    const GAS bf16* G = (const GAS bf16*)(F.ws + WS_G); GAS bf16* L = (GAS bf16*)(F.ws + WS_L);
    const GAS float* cw = INP(F, I_FCONV) + (size_t)l * 3 * DFF;
    constexpr int CPR = DFF / 8, STRIP = 16;
    const int nitems = (M / STRIP) * CPR;
    for (int it = F.vcu * NTHREADS + F.tid; it < nitems; it += F.G * NTHREADS) {
        const int ck = it % CPR, strip = it / CPR, m0 = strip * STRIP, t0 = m0 % T, c8 = 8 * ck;
        float w0[8], w1[8], w2[8];
#pragma unroll
        for (int j = 0; j < 8; ++j) { w0[j] = cw[c8 + j]; w1[j] = cw[DFF + c8 + j]; w2[j] = cw[2 * DFF + c8 + j]; }
        auto gload = [&](int t, int m) -> v4u { if (t < 0 || t >= T) return (v4u){0u, 0u, 0u, 0u}; return *(const GAS v4u*)(G + (size_t)m * DFF + c8); };
        v4u gp = gload(t0 - 1, m0 - 1), gc = gload(t0, m0);
#pragma unroll 4
        for (int i = 0; i < STRIP; ++i) {
            const v4u gn = gload(t0 + i + 1, m0 + i + 1);
            const v4u lv = *(const GAS v4u*)(L + (size_t)(m0 + i) * DFF + c8);
            v4u o;
#pragma unroll
            for (int q = 0; q < 4; ++q) {
                const float a0 = w0[2 * q] * bflo(gp[q]) + w1[2 * q] * bflo(gc[q]) + w2[2 * q] * bflo(gn[q]);
                const float a1 = w0[2 * q + 1] * bfhi(gp[q]) + w1[2 * q + 1] * bfhi(gc[q]) + w2[2 * q + 1] * bfhi(gn[q]);
                o[q] = pk2(gelu_tanh(a0) * bflo(lv[q]), gelu_tanh(a1) * bfhi(lv[q])); }
            *(GAS v4u*)(L + (size_t)(m0 + i) * DFF + c8) = o;
            gp = gc; gc = gn; }
    }
}

#ifndef MK_N_LAUNCHES
#define MK_N_LAUNCHES 1
#endif
constexpr int NPH = 1 + 10 * DEPTH;
struct Args { const float* in[26]; float* out; unsigned char* ws; int ph_lo, ph_hi; };
__global__ void __launch_bounds__(NTHREADS, 2) enc_fwd(Args args) {
    extern __shared__ __attribute__((aligned(16))) unsigned char lds_raw[];
    Frame F;
    F.lds = (LAS unsigned char*)lds_raw;
    F.MISC = (volatile LAS unsigned*)(F.lds + MISC_OFF);
    F.tid = threadIdx.x; F.lane = F.tid & 63; F.wave = __builtin_amdgcn_readfirstlane(F.tid >> 6);
    F.G = gridDim.x; { const int bx = blockIdx.x; F.vcu = (F.G % 8 == 0) ? (bx % 8) * (F.G / 8) + bx / 8 : bx; }
    F.ws = (GAS unsigned char*)args.ws; F.out = (GAS float*)args.out; F.ctl = (gu32*)(F.ws + WS_CTL);
    F.karg = (kq_t*)__builtin_amdgcn_kernarg_segment_ptr();
    for (int u = F.tid; u < (LDS_BYTES - LDSCTL_OFF) / 4; u += NTHREADS) ((LAS unsigned*)(F.lds + LDSCTL_OFF))[u] = 0u;
    __syncthreads();
    const int lo = args.ph_lo, hi = args.ph_hi;
    XcdBarrier bar; bar.bar = (unsigned*)(F.ctl + CW_BAR); bar.x = 0; bar.st = nullptr;
    if (hi - lo > 1) bar = xcd_barrier_post((unsigned*)(F.ctl + CW_BAR), F.MISC + 8);
#ifndef PH_ENABLE
#define PH_ENABLE 0x7ff
#endif
#define IN(k) (lo <= (k) && (k) < hi)
#define EN(t) (((PH_ENABLE) >> (t)) & 1)
#pragma unroll 1
#ifdef REPEAT_T
    for (int step = lo; step < hi; ++step) {
        const int p1 = REPEAT_T, p2 = REPEAT_T + 10;
        const int ph = step - (step > p1 ? 1 : 0) - ((step > p2 + 1 && REPEAT_T != 7) ? 1 : 0);
#else
    for (int ph = lo; ph < hi; ++ph) {
#endif
        LAUNDER(F);
        const int l = ph == 0 ? 0 : (ph - 1) / 10, tt = ph == 0 ? 0 : 1 + (ph - 1) % 10, t = tt >= 2 ? tt + 1 : tt;
        GAS unsigned char* wl = F.ws + WS_W + (size_t)l * W_LAYER;
      {
        if (t == 1 || t == 6 || t == 8 || t == 10) {
            pg8::Gemm g; pg8::EpiUni E;
            g.M = M; E.split_cols = 0; E.split_stride = 0;
            if (t == 1)      { g.A = (const GAS bf16*)(F.ws + WS_XB);     g.Bt = (const GAS bf16*)(wl + W_IN);  g.N = NPROJP; g.K = DM;  E.O = (GAS bf16*)(F.ws + WS_PROJ); E.ldc = NPROJP; E.rs = (const GAS float*)(F.ws + WS_RS); E.part = nullptr; }
            else if (t == 6) { g.A = (const GAS bf16*)(F.ws + WS_MERGED); g.Bt = (const GAS bf16*)(wl + W_OUT); g.N = DM;     g.K = DM;  E.O = (GAS bf16*)(F.ws + WS_Y); E.ldc = DM; E.rs = nullptr; E.part = (GAS float*)(F.ws + WS_PART); }
            else if (t == 8) { g.A = (const GAS bf16*)(F.ws + WS_XB);     g.Bt = (const GAS bf16*)(wl + W_UP);  g.N = NUP;    g.K = DM;  E.O = (GAS bf16*)(F.ws + WS_G); E.ldc = DFF; E.rs = (const GAS float*)(F.ws + WS_RS); E.part = nullptr; E.split_cols = DFF; E.split_stride = (size_t)(WS_L - WS_G) / 2; }
            else             { g.A = (const GAS bf16*)(F.ws + WS_L);      g.Bt = (const GAS bf16*)(wl + W_DN);  g.N = DM;     g.K = DFF; E.O = (GAS bf16*)(F.ws + WS_Y); E.ldc = DM; E.rs = nullptr; E.part = (GAS float*)(F.ws + WS_PART); }
            pg8::StaticOrder S; S.init(M, g.N, F.G, (int)blockIdx.x);
            pg8::gemm_phase<pg8::EpiUni, pg8::StaticOrder, true, true>(F.lds, g, S, E);
        }
        else if (t == 0) p0_prologue(F);
#ifdef C1_EXP
        else if (t == 3) { phase_mixers(F, l); phase_scan_c1<0>(F, l); phase_scan_c1<C1_EXP>(F, l); }
#else
        else if (t == 3) { phase_mixers(F, l); phase_scan_c1<0>(F, l); }
#endif
#ifdef C2_EXP
        else if (t == 4) { phase_scan_c2<0>(F, l); phase_scan_c2<C2_EXP>(F, l); }
#else
        else if (t == 4) phase_scan_c2<0>(F, l);
#endif
        else if (t == 5) phase_rwkv_post(F, l);
        else if (t == 7 || t == 11) phase_residual(F, INP(F, t == 7 ? I_NMPOST : I_NFPOST) + l * DM, t == 7 && l == 0, t == 11 && l + 1 == DEPTH);
        else if (t == 9) phase_ffn_conv(F, l);
      }
#ifdef REPEAT_T
        if (step + 1 < hi) xcd_barrier(bar);
#else
        if (ph + 1 < hi) xcd_barrier(bar);
#endif
    }
}


#ifdef DBG_CHECK
__global__ void dbg_check(const void* buf, size_t n, int kind, int code, unsigned* flag) {
    bool bad = false;
    for (size_t i = (size_t)blockIdx.x * blockDim.x + threadIdx.x; i < n; i += (size_t)gridDim.x * blockDim.x) {
        float v;
        if (kind == 0) v = bf2f(((const unsigned short*)buf)[i]);
        else if (kind == 1) v = ((const float*)buf)[i];
        else v = (float)((const _Float16*)buf)[i];
        if (!(fabsf(v) < 1e30f)) bad = true;
    }
    if (bad) atomicMax(flag, (unsigned)(1000000 - code));
}
__global__ void dbg_report(float* out, const unsigned* flag) { if (threadIdx.x == 0 && blockIdx.x == 0) { const unsigned f = *flag; if (f) out[0] = 100000.f * (float)(10 + 1000000 - (int)f); } }
#endif
extern "C" void kernel_launch(void* const* d_in, const int* in_sizes, int n_in, void* d_out, int out_size, void* d_ws, size_t ws_size, hipStream_t stream) {
    static int grid = 0;
    if (grid == 0) {
        if (n_in != 26 || in_sizes[0] != M * DM || out_size != M * DM || ws_size < WS_END) { fprintf(stderr, "kernel_launch: unexpected shapes: n_in %d in0 %d out %d ws %zu (need >= %zu)\n", n_in, n_in > 0 ? in_sizes[0] : -1, out_size, ws_size, (size_t)WS_END); grid = -1; return; }
        int dev = 0, cus = 0, per_cu = 0;
        if (hipGetDevice(&dev) != hipSuccess || hipDeviceGetAttribute(&cus, hipDeviceAttributeMultiprocessorCount, dev) != hipSuccess) { grid = -1; return; }
        if (hipFuncSetAttribute((const void*)enc_fwd, hipFuncAttributeMaxDynamicSharedMemorySize, LDS_BYTES) != hipSuccess) { fprintf(stderr, "kernel_launch: hipFuncSetAttribute failed\n"); grid = -1; return; }
        if (hipOccupancyMaxActiveBlocksPerMultiprocessor(&per_cu, (const void*)enc_fwd, NTHREADS, LDS_BYTES) != hipSuccess || per_cu < 1) { fprintf(stderr, "kernel_launch: occupancy query says %d blocks per CU\n", per_cu); }
        (void)hipGetLastError();
        grid = cus;
        if (grid != 256) fprintf(stderr, "kernel_launch: %d CUs (built for 256)\n", grid);
    }
    if (grid < 0) return;
    (void)hipMemsetAsync((char*)d_ws + WS_CTL, 0, CTL_ZERO_BYTES, stream);
    Args a{};
    for (int i = 0; i < 26; ++i) a.in[i] = (const float*)d_in[i];
    a.out = (float*)d_out; a.ws = (unsigned char*)d_ws;
#if MK_N_LAUNCHES == 1
#ifdef REPEAT_T
    a.ph_lo = 0; a.ph_hi = NPH + (REPEAT_T == 7 ? 1 : 2);
#else
    a.ph_lo = 0; a.ph_hi = NPH;
#endif
    hipLaunchKernelGGL(enc_fwd, dim3(grid), dim3(NTHREADS), LDS_BYTES, stream, a);
#else
    for (int p = 0; p < NPH; ++p) { a.ph_lo = p; a.ph_hi = p + 1; hipLaunchKernelGGL(enc_fwd, dim3(grid), dim3(NTHREADS), LDS_BYTES, stream, a);
#ifdef DBG_CHECK
        unsigned* flag = (unsigned*)((char*)d_ws + 512 * 1024); char* ws = (char*)d_ws; const int t = p == 0 ? 0 : 1 + (p - 1) % 10;
#define CHK(ptr, n, kind, sub) hipLaunchKernelGGL(dbg_check, dim3(2048), dim3(256), 0, stream, (const void*)(ptr), (size_t)(n), kind, p * 4 + sub, flag)
        if (t == 0) { CHK(ws + WS_W, 2 * W_LAYER / 2, 0, 0); CHK(ws + WS_XB, (size_t)M * DM, 0, 1); CHK(ws + WS_RS, M, 1, 2); }
        if (t == 1) { CHK(ws + WS_PROJ, (size_t)M * NPROJP, 0, 0); }
        if (t == 2) { CHK(ws + WS_PREP, (size_t)64 * MiB, 2, 1); }
        if (t == 3) { CHK(d_out, (size_t)2 * M * 256, 0, 0); }
        if (t == 4) { CHK(ws + WS_MERGED, (size_t)M * DM, 0, 0); }
        if (t == 5 || t == 9) { CHK(ws + WS_Y, (size_t)M * DM, 1, 0); CHK(ws + WS_PART, (size_t)M * 16, 1, 1); }
        if (t == 6 || t == 10) { CHK(d_out, (size_t)M * DM, 1, 0); CHK(ws + WS_XB, (size_t)M * DM, 0, 1); CHK(ws + WS_RS, M, 1, 2); }
        if (t == 7) { CHK(ws + WS_G, (size_t)M * DFF, 0, 0); CHK(ws + WS_L, (size_t)M * DFF, 0, 1); }
        if (t == 8) { CHK(ws + WS_L, (size_t)M * DFF, 0, 0); }
        if (p == NPH - 1) hipLaunchKernelGGL(dbg_report, dim3(1), dim3(64), 0, stream, (float*)d_out, (const unsigned*)flag);
#endif
    }
#endif
}
```

```cpp
#include <hip/hip_runtime.h>
#include <cstdio>
#include <cstdint>
namespace pg8 {
#define PG8_LAS __attribute__((address_space(3)))
#define PG8_GAS __attribute__((address_space(1)))
typedef PG8_LAS unsigned char PG8_LAS_T;
typedef unsigned short bf16_t;
typedef short bf16x8 __attribute__((ext_vector_type(8)));
typedef float f32x4 __attribute__((ext_vector_type(4)));
typedef unsigned u32x4 __attribute__((ext_vector_type(4)));
constexpr int BM = 256, BK = 64, HALF = 128, HTB = HALF * BK * 2  , STAGE_BYTES = 8 * HTB, NXCD = 8, WGM = 8;

__host__ __device__ __forceinline__ int lds_byte(int r, int c) { const int st = (r >> 4) * 2 + (c >> 5), rr = r & 15, cc = c & 31, ob = rr * 64 + cc * 2; return st * 1024 + (ob ^ (((ob >> 9) & 1) << 5)); }
__host__ __device__ __forceinline__ void stage_rc(int b, int& R, int& C) { const int st = b / 1024, sb = b % 1024, swz = sb ^ (((sb >> 9) & 1) << 5); R = (st >> 1) * 16 + swz / 64; C = (st & 1) * 32 + (swz % 64) / 2; }
__host__ __device__ __forceinline__ int perm32(int rho) { const int n = rho >> 4, i = rho & 15; return 8 * (i >> 2) + 4 * n + (i & 3); }

struct Unit { int pm, pn; };
struct Gemm { const PG8_GAS bf16_t* A; const PG8_GAS bf16_t* Bt; int M, N, K; };

struct StaticOrder {
    int nM, nN, nwg, G, c;
    __host__ __device__ void init(int M, int N, int G_, int c_) { nM = M / BM; nN = N / BM; nwg = nM * nN; G = G_; c = c_; }
    __host__ __device__ bool next(int i, Unit& u) const {
        const long L = (long)i * G + c; if (L >= nwg) return false;
        int wgid = (int)L; { const int q = nwg / NXCD, r = nwg % NXCD, xcd = wgid % NXCD, off = wgid / NXCD; wgid = (xcd < r ? xcd * (q + 1) : r * (q + 1) + (xcd - r) * q) + off; }
        const int nig = WGM * nN, gid = wgid / nig, fm = gid * WGM, gsz = (nM - fm) < WGM ? (nM - fm) : WGM;
        u.pm = fm + ((wgid % nig) % gsz); u.pn = (wgid % nig) / gsz; return true;
    }
    __device__ __forceinline__ void a_ready(const Unit&) const {}
    __device__ __forceinline__ void done(const Unit&) const {}
};
typedef float f32x2c __attribute__((ext_vector_type(2)));
typedef __bf16 bf16x2c __attribute__((ext_vector_type(2)));
__device__ __forceinline__ unsigned cvt_pk_bf16(float lo, float hi) { const f32x2c v = {lo, hi}; return __builtin_bit_cast(unsigned, __builtin_convertvector(v, bf16x2c)); }
struct EpiUni {
    static constexpr bool AFTER_DRAIN = false;
    PG8_GAS bf16_t* O; int ldc; const PG8_GAS float* rs; int split_cols; size_t split_stride; PG8_GAS float* part;
    const PG8_GAS float* convw; PG8_GAS bf16_t* G; PG8_LAS unsigned char* xl;
    __device__ __forceinline__ bool perm() const { return true; }
    template <int CTRL> static __device__ __forceinline__ float dppo(float old, float x) { return __builtin_bit_cast(float, __builtin_amdgcn_update_dpp(__builtin_bit_cast(int, old), __builtin_bit_cast(int, x), CTRL, 0xF, 0xF, false)); }
    static __device__ __forceinline__ float gelu_t(float x) { const float u = 1.5957691216057308f * x * (1.f + 0.044715f * x * x); return x * __builtin_amdgcn_rcpf(1.f + __expf(-u)); }
    __device__ __forceinline__ void conv_epi(const f32x4 (&acc_)[2][2][4][2], const Unit& u, int wr, int wc, int fr, int fq) const {
        f32x4 (&acc)[2][2][4][2] = const_cast<f32x4 (&)[2][2][4][2]>(acc_);
        const int hcol = u.pn * HALF + wc * 32 + 8 * fq;
        const PG8_GAS float* rsp = rs + u.pm * BM + wr * 64 + fr;
        constexpr int LDH = 2816;
        const unsigned lane_off = (unsigned)((wr * 64 + fr) * LDH + hcol) * 2u;
        PG8_GAS char* Ob = (PG8_GAS char*)(O + (size_t)u.pm * BM * LDH); PG8_GAS char* Gb = (PG8_GAS char*)(G + (size_t)u.pm * BM * LDH);
        unsigned lp[2][4][2][2];
#pragma unroll
        for (int ai = 0; ai < 2; ++ai)
#pragma unroll
            for (int m = 0; m < 4; ++m) { const float r = rsp[ai * HALF + m * 16];
#pragma unroll
                for (int n = 0; n < 2; ++n) { const f32x4 l4 = acc[ai][1][m][n] * r; lp[ai][m][n][0] = cvt_pk_bf16(l4[0], l4[1]); lp[ai][m][n][1] = cvt_pk_bf16(l4[2], l4[3]); } }
#pragma unroll
        for (int ai = 0; ai < 2; ++ai) { const int k = 2 * ai + wr;
            if (fr == 0)  { const float r = rsp[ai * HALF]; PG8_LAS f32x4* p = (PG8_LAS f32x4*)(xl + ((k * 2 + 0) * 4 + wc) * 128 + fq * 32); p[0] = acc[ai][0][0][0] * r; p[1] = acc[ai][0][0][1] * r; }
            if (fr == 15) { const float r = rsp[ai * HALF + 48]; PG8_LAS f32x4* p = (PG8_LAS f32x4*)(xl + ((k * 2 + 1) * 4 + wc) * 128 + fq * 32); p[0] = acc[ai][0][3][0] * r; p[1] = acc[ai][0][3][1] * r; } }
        asm volatile("s_waitcnt lgkmcnt(0)" ::: "memory"); __builtin_amdgcn_s_barrier(); asm volatile("" ::: "memory");
#pragma unroll
        for (int ai = 0; ai < 2; ++ai) { const int k = 2 * ai + wr;
            float rsv[4];
#pragma unroll
            for (int m = 0; m < 4; ++m) { rsv[m] = rsp[ai * HALF + m * 16];
#pragma unroll
                for (int n = 0; n < 2; ++n) acc[ai][0][m][n] = acc[ai][0][m][n] * rsv[m]; }
            const int ku = k > 0 ? k - 1 : 0, kd = k < 3 ? k + 1 : 3;
#pragma unroll
            for (int n = 0; n < 2; ++n) {
                float w0[4], w1[4], w2[4];
#pragma unroll
                for (int j = 0; j < 4; ++j) { w0[j] = convw[hcol + 4 * n + j]; w1[j] = convw[LDH + hcol + 4 * n + j]; w2[j] = convw[2 * LDH + hcol + 4 * n + j]; }
                const f32x4 xt = *(const PG8_LAS f32x4*)(xl + ((ku * 2 + 1) * 4 + wc) * 128 + fq * 32 + n * 16), xb = *(const PG8_LAS f32x4*)(xl + ((kd * 2 + 0) * 4 + wc) * 128 + fq * 32 + n * 16);
#pragma unroll
                for (int m = 0; m < 4; ++m) { const int tr = 64 * k + 16 * m + fr; const unsigned coff = (unsigned)((ai * HALF + 16 * m) * LDH * 2 + 8 * n);
                    float hv[4];
#pragma unroll
                    for (int e = 0; e < 4; ++e) { const float cur = acc[ai][0][m][n][e];
                        const float upx = (m > 0) ? dppo<0x121>(0.f, acc[ai][0][m > 0 ? m - 1 : 0][n][e]) : xt[e];
                        const float dnx = (m < 3) ? dppo<0x12F>(0.f, acc[ai][0][m < 3 ? m + 1 : 3][n][e]) : xb[e];
                        const float up = dppo<0x111>(upx, cur), dn = dppo<0x101>(dnx, cur);
                        const float a = w0[e] * up + w1[e] * cur + w2[e] * dn;
                        const unsigned lw = lp[ai][m][n][e >> 1]; const float lv = (e & 1) ? __builtin_bit_cast(float, lw & 0xffff0000u) : __builtin_bit_cast(float, lw << 16);
                        hv[e] = (tr == 0 || tr == 255) ? lv : gelu_t(a) * lv; }
                    typedef unsigned u32x2_ __attribute__((ext_vector_type(2)));
                    u32x2_ w; w.x = cvt_pk_bf16(hv[0], hv[1]); w.y = cvt_pk_bf16(hv[2], hv[3]);
                    *(PG8_GAS u32x2_*)(Ob + coff + lane_off) = w;
                    if (tr <= 1 || tr >= 254) { u32x2_ gw; gw.x = cvt_pk_bf16(acc[ai][0][m][n][0], acc[ai][0][m][n][1]); gw.y = cvt_pk_bf16(acc[ai][0][m][n][2], acc[ai][0][m][n][3]);
                        *(PG8_GAS u32x2_*)(Gb + coff + lane_off) = gw; }
                    __builtin_amdgcn_sched_barrier(0); }
                asm volatile("" ::: "memory");
            }
        }
    }
    __device__ __forceinline__ void operator()(const f32x4 (&acc)[2][2][4][2], const Unit& u, int wr, int wc, int fr, int fq) const {
        if (convw != nullptr) { conv_epi(acc, u, wr, wc, fr, fq); return; }
        const int row0 = u.pm * BM + wr * 64 + fr; int colt = u.pn * BM; PG8_GAS bf16_t* base = O;
        if (split_cols) { const int t = colt / split_cols; base += (size_t)t * split_stride; colt -= t * split_cols; }
        const int col0 = colt + wc * 32 + 8 * fq;
        if (part == nullptr) {
#pragma unroll
            for (int ai = 0; ai < 2; ++ai)
#pragma unroll
                for (int m = 0; m < 4; ++m) { const int row = row0 + ai * HALF + m * 16; const float s = rs[row]; PG8_GAS bf16_t* rowp = base + (size_t)row * ldc + col0;
#pragma unroll
                    for (int bj = 0; bj < 2; ++bj) { const f32x4 v0 = acc[ai][bj][m][0] * s, v1 = acc[ai][bj][m][1] * s;
                        u32x4 w; w.x = cvt_pk_bf16(v0[0], v0[1]); w.y = cvt_pk_bf16(v0[2], v0[3]); w.z = cvt_pk_bf16(v1[0], v1[1]); w.w = cvt_pk_bf16(v1[2], v1[3]);
                        *(PG8_GAS u32x4*)(rowp + bj * HALF) = w; } }
        } else {
#pragma unroll
            for (int ai = 0; ai < 2; ++ai)
#pragma unroll
                for (int m = 0; m < 4; ++m) { const int row = row0 + ai * HALF + m * 16; PG8_GAS bf16_t* rowp = base + (size_t)row * ldc + col0; float ss = 0.f;
#pragma unroll
                    for (int bj = 0; bj < 2; ++bj) { const f32x4 v0 = acc[ai][bj][m][0], v1 = acc[ai][bj][m][1];
                        ss += ((v0[0] * v0[0] + v0[1] * v0[1]) + (v0[2] * v0[2] + v0[3] * v0[3])) + ((v1[0] * v1[0] + v1[1] * v1[1]) + (v1[2] * v1[2] + v1[3] * v1[3]));
                        u32x4 w; w.x = cvt_pk_bf16(v0[0], v0[1]); w.y = cvt_pk_bf16(v0[2], v0[3]); w.z = cvt_pk_bf16(v1[0], v1[1]); w.w = cvt_pk_bf16(v1[2], v1[3]);
                        *(PG8_GAS u32x4*)(rowp + bj * HALF) = w; }
                    ss += __shfl_xor(ss, 16); ss += __shfl_xor(ss, 32); if (fq == 0) part[(size_t)row * 16 + u.pn * 4 + wc] = ss; }
        }
    }
};
template <class Epi, class Sched, bool ALIGN_EPI = false, bool SP2 = false>
__device__ __forceinline__ void gemm_phase(PG8_LAS unsigned char* lds, const Gemm g, const Sched& S, const Epi& E) {
    int tid_ = threadIdx.x; asm volatile("" : "+v"(tid_));
    const int tid = tid_, wid = __builtin_amdgcn_readfirstlane(tid >> 6), lane = tid & 63, wr = wid >> 2, wc = wid & 3, fr = lane & 15, fq = lane >> 4;
    const int K = g.K, nt = K / BK;
    unsigned voffA[2], voffB[2];
#pragma unroll
    for (int i = 0; i < 2; ++i) { int R, C; stage_rc(tid * 16 + i * 8192, R, C); const int Rb = E.perm() ? ((R & ~31) + perm32(R & 31)) : R;
        voffA[i] = (unsigned)(R * K + C) * 2u; voffB[i] = (unsigned)(Rb * K + C) * 2u; }
    const size_t kstep = (size_t)(BK * 2);
    const size_t hstep = (size_t)HALF * K * 2;
    const size_t tstep = 2 * hstep;
    const unsigned ldsw = (unsigned)wid * 1024u;
    const int aoff = lds_byte(wr * 64 + fr, fq * 8), boff = lds_byte(wc * 32 + fr, fq * 8);
#define PG8_SA(b, h) (((b) * 2 + (h)) * HTB)
#define PG8_SB(b, h) ((4 + (b) * 2 + (h)) * HTB)
#define PG8_STAGE(bufoff, gbase, voff) do { _Pragma("unroll") for (int _i = 0; _i < 2; ++_i) \
        __builtin_amdgcn_global_load_lds((const PG8_GAS unsigned*)((const PG8_GAS char*)(gbase) + (voff)[_i]), (PG8_LAS unsigned*)(lds + (bufoff) + ldsw + _i * 8192), 16, 0, 0); } while (0)
#define PG8_LDA(dst, b, h) do { _Pragma("unroll") for (int m = 0; m < 4; ++m) _Pragma("unroll") for (int k = 0; k < 2; ++k) dst[m][k] = *(const PG8_LAS bf16x8*)(lds + PG8_SA(b, h) + aoff + m * 2048 + k * 1024); } while (0)
#define PG8_LDB(dst, b, h) do { _Pragma("unroll") for (int n = 0; n < 2; ++n) _Pragma("unroll") for (int k = 0; k < 2; ++k) dst[n][k] = *(const PG8_LAS bf16x8*)(lds + PG8_SB(b, h) + boff + n * 2048 + k * 1024); } while (0)
#define PG8_MMA(ai, bj, At, Bt) do { __builtin_amdgcn_s_setprio(1); _Pragma("unroll") for (int m = 0; m < 4; ++m) _Pragma("unroll") for (int n = 0; n < 2; ++n) _Pragma("unroll") for (int k = 0; k < 2; ++k) \
        acc[ai][bj][m][n] = __builtin_amdgcn_mfma_f32_16x16x32_bf16(Bt[n][k], At[m][k], acc[ai][bj][m][n], 0, 0, 0); __builtin_amdgcn_s_setprio(0); } while (0)
#define PG8_WAIT_V(n) asm volatile("s_waitcnt vmcnt(" #n ")" ::: "memory")
#define PG8_WAIT_L(n) asm volatile("s_waitcnt lgkmcnt(" #n ")" ::: "memory")
#define PG8_BAR __builtin_amdgcn_s_barrier()
#define PG8_SCHED __builtin_amdgcn_sched_barrier(0)
    Unit cur, nxt; int ui = 0;
    if (!S.next(0, cur)) return;
    f32x4 acc[2][2][4][2];
#pragma unroll
    for (int a = 0; a < 2; ++a)
#pragma unroll
        for (int b = 0; b < 2; ++b)
#pragma unroll
            for (int m = 0; m < 4; ++m)
#pragma unroll
                for (int n = 0; n < 2; ++n) acc[a][b][m][n] = (f32x4){0.f, 0.f, 0.f, 0.f};
    bf16x8 At[4][2], B0[2][2], B1[2][2];
    const PG8_GAS char* cA = (const PG8_GAS char*)g.A + (size_t)cur.pm * tstep; const PG8_GAS char* cB = (const PG8_GAS char*)g.Bt + (size_t)cur.pn * tstep;
    S.a_ready(cur);
    if constexpr (SP2) {
        PG8_STAGE(PG8_SB(0, 0), cB, voffB); PG8_STAGE(PG8_SB(0, 1), cB + hstep, voffB); PG8_STAGE(PG8_SA(0, 0), cA, voffA); PG8_STAGE(PG8_SA(0, 1), cA + hstep, voffA);
        if (wr == 1) PG8_BAR;
        PG8_WAIT_V(2); PG8_BAR;
        PG8_STAGE(PG8_SB(1, 0), cB + kstep, voffB); PG8_STAGE(PG8_SA(1, 0), cA + kstep, voffA); PG8_STAGE(PG8_SB(1, 1), cB + hstep + kstep, voffB);
        PG8_WAIT_V(6); PG8_BAR;
    } else {
        PG8_STAGE(PG8_SB(0, 0), cB, voffB); PG8_STAGE(PG8_SA(0, 0), cA, voffA); PG8_STAGE(PG8_SB(0, 1), cB + hstep, voffB); PG8_STAGE(PG8_SA(0, 1), cA + hstep, voffA);
        if (wr == 1) PG8_BAR;
        PG8_WAIT_V(4); PG8_BAR;
        PG8_STAGE(PG8_SB(1, 0), cB + kstep, voffB); PG8_STAGE(PG8_SA(1, 0), cA + kstep, voffA); PG8_STAGE(PG8_SB(1, 1), cB + hstep + kstep, voffB);
        PG8_WAIT_V(6); PG8_BAR;
    }
    for (;;) {
        const bool has_next = S.next(ui + 1, nxt);
        const PG8_GAS char* nA = has_next ? (const PG8_GAS char*)g.A + (size_t)nxt.pm * tstep : cA; const PG8_GAS char* nB = has_next ? (const PG8_GAS char*)g.Bt + (size_t)nxt.pn * tstep : cB;
        for (int t = 0; t < nt; t += 2) {
            const bool last = (t == nt - 2);
            const PG8_GAS char* a1 = cA + (size_t)(t + 1) * kstep;
            const PG8_GAS char* a2 = last ? nA : cA + (size_t)(t + 2) * kstep; const PG8_GAS char* b2 = last ? nB : cB + (size_t)(t + 2) * kstep;
            const PG8_GAS char* a3 = a2 + kstep; const PG8_GAS char* b3 = b2 + kstep;
            if (last && has_next) S.a_ready(nxt);
            if constexpr (SP2) {
            PG8_LDB(B0, 0, 0); PG8_LDB(B1, 0, 1); PG8_SCHED; PG8_LDA(At, 0, 0); PG8_STAGE(PG8_SA(1, 1), a1 + hstep, voffA);
            PG8_WAIT_V(8); PG8_WAIT_L(0); PG8_BAR; PG8_MMA(0, 0, At, B0); PG8_MMA(0, 1, At, B1); PG8_BAR; PG8_SCHED;
            PG8_LDA(At, 0, 1); PG8_STAGE(PG8_SB(0, 0), b2, voffB); PG8_STAGE(PG8_SB(0, 1), b2 + hstep, voffB); PG8_STAGE(PG8_SA(0, 0), a2, voffA);
            PG8_WAIT_V(8); PG8_WAIT_L(0); PG8_BAR; PG8_MMA(1, 0, At, B0); PG8_MMA(1, 1, At, B1); PG8_BAR; PG8_SCHED;
            PG8_LDB(B0, 1, 0); PG8_LDB(B1, 1, 1); PG8_SCHED; PG8_LDA(At, 1, 0); PG8_STAGE(PG8_SA(0, 1), a2 + hstep, voffA);
            PG8_WAIT_V(8); PG8_WAIT_L(0); PG8_BAR; PG8_MMA(0, 0, At, B0); PG8_MMA(0, 1, At, B1); PG8_BAR; PG8_SCHED;
            PG8_LDA(At, 1, 1); PG8_STAGE(PG8_SB(1, 0), b3, voffB); PG8_STAGE(PG8_SB(1, 1), b3 + hstep, voffB); PG8_STAGE(PG8_SA(1, 0), a3, voffA);
            PG8_WAIT_V(8); PG8_WAIT_L(0); PG8_BAR; PG8_MMA(1, 0, At, B0); PG8_MMA(1, 1, At, B1); PG8_BAR; PG8_SCHED;
            } else {
            PG8_LDB(B0, 0, 0); PG8_SCHED; PG8_LDA(At, 0, 0); PG8_STAGE(PG8_SA(1, 1), a1 + hstep, voffA);
            PG8_WAIT_L(8); PG8_BAR; PG8_WAIT_L(0); PG8_MMA(0, 0, At, B0); PG8_BAR; PG8_SCHED;
            PG8_LDB(B1, 0, 1); PG8_STAGE(PG8_SB(0, 0), b2, voffB);
            PG8_BAR; PG8_WAIT_L(0); PG8_MMA(0, 1, At, B1); PG8_BAR;
            PG8_LDA(At, 0, 1); PG8_STAGE(PG8_SA(0, 0), a2, voffA);
            PG8_BAR; PG8_WAIT_L(0); PG8_MMA(1, 0, At, B0); PG8_BAR; PG8_SCHED;
            PG8_STAGE(PG8_SB(0, 1), b2 + hstep, voffB);
            PG8_WAIT_V(6); PG8_BAR; PG8_MMA(1, 1, At, B1); PG8_BAR;
            PG8_LDB(B0, 1, 0); PG8_SCHED; PG8_LDA(At, 1, 0); PG8_STAGE(PG8_SA(0, 1), a2 + hstep, voffA);
            PG8_WAIT_L(8); PG8_BAR; PG8_WAIT_L(0); PG8_MMA(0, 0, At, B0); PG8_BAR; PG8_SCHED;
            PG8_LDB(B1, 1, 1); PG8_STAGE(PG8_SB(1, 0), b3, voffB);
            PG8_BAR; PG8_WAIT_L(0); PG8_MMA(0, 1, At, B1); PG8_BAR;
            PG8_LDA(At, 1, 1); PG8_STAGE(PG8_SA(1, 0), a3, voffA);
            PG8_BAR; PG8_WAIT_L(0); PG8_MMA(1, 0, At, B0); PG8_BAR; PG8_SCHED;
            PG8_STAGE(PG8_SB(1, 1), b3 + hstep, voffB);
            PG8_WAIT_V(6); PG8_BAR; PG8_MMA(1, 1, At, B1); PG8_BAR;
            }
        }
        if constexpr (ALIGN_EPI) { if (wr == 0) PG8_BAR; }
        if constexpr (!Epi::AFTER_DRAIN) { E(acc, cur, wr, wc, fr, fq); S.done(cur); }
        if (!has_next) break;
#pragma unroll
        for (int a = 0; a < 2; ++a)
#pragma unroll
            for (int b = 0; b < 2; ++b)
#pragma unroll
                for (int m = 0; m < 4; ++m)
#pragma unroll
                    for (int n = 0; n < 2; ++n) acc[a][b][m][n] = (f32x4){0.f, 0.f, 0.f, 0.f};
        cur = nxt; cA = nA; cB = nB; ++ui;
        if constexpr (ALIGN_EPI) { if (wr == 1) PG8_BAR; }
    }
    PG8_WAIT_V(0);
    if constexpr (!ALIGN_EPI) { if (wr == 0) PG8_BAR; }
    PG8_BAR;
    if constexpr (Epi::AFTER_DRAIN) { E.fused(acc, cur, wr, wc, fr, fq, lds, wid, lane); S.done(cur); }
#undef PG8_SA
#undef PG8_SB
#undef PG8_STAGE
#undef PG8_LDA
#undef PG8_LDB
#undef PG8_MMA
#undef PG8_WAIT_V
#undef PG8_WAIT_L
#undef PG8_BAR
#undef PG8_SCHED
}
}

constexpr int NB = 8, T = 4096, DM = 1024, M = NB * T, DEPTH = 2;
constexpr int NPROJ = 2912, NPROJP = 3072, DFF = 2816, NUP = 2 * DFF;
constexpr int C_CH = 0, C_CB = 256, C_CC = 512, C_R = 768, C_K = 1024, C_V = 1280, C_DEC = 1536, C_GDN = 1600, C_NQ = 1632, C_NK = 1888, C_NV = 2144, C_SU = 2400, C_SV = 2656;
constexpr float NORM_EPS = 1e-6f, GN_EPS = 64e-5f, DECAY_SCALE = 0.60653065971263342f;
constexpr int NWAVES = 8, NTHREADS = 512;
constexpr size_t MiB = 1u << 20;
constexpr size_t WS_CTL = 0, CTL_ZERO_BYTES = 1 * MiB;
constexpr size_t WS_RS = 1 * MiB;
constexpr size_t WS_PART = 1 * MiB + 256 * 1024;
constexpr size_t WS_W = 4 * MiB, W_LAYER = 24 * MiB + 512 * 1024;
constexpr size_t W_IN = 0, W_OUT = 6 * MiB, W_UP = 8 * MiB, W_DN = 19 * MiB;
constexpr size_t WS_XB = 53 * MiB;
constexpr size_t WS_R = 117 * MiB;
constexpr size_t WS_PROJ = WS_R, WS_MERGED = WS_R + 192 * MiB, WS_PREP = WS_R + 256 * MiB;
constexpr size_t GT_CHUNK = 12800, GT_DIR = (size_t)NB * 4 * 256 * GT_CHUNK;
constexpr size_t WS_GT0 = WS_PREP, WS_YSC0 = WS_PREP + 100 * MiB;
static_assert(GT_DIR == 100 * MiB, "GT size");
constexpr size_t WS_Y = WS_R;
constexpr size_t WS_G = WS_R, WS_L = WS_R + 176 * MiB;
constexpr size_t WS_END = 501 * MiB;
static_assert(WS_W + 2 * W_LAYER <= WS_XB && WS_PREP + 128 * MiB <= WS_END && WS_L + 176 * MiB <= WS_END && WS_PART + (size_t)M * 64 <= WS_W, "ws map");
constexpr int CW_BAR = 4096;
constexpr int RING_BYTES = 131072, LDSCTL_OFF = RING_BYTES, MISC_OFF = LDSCTL_OFF + 320, LDS_BYTES = 147456;

#define GAS __attribute__((address_space(1)))
#define LAS __attribute__((address_space(3)))
typedef unsigned short bf16;
typedef unsigned v4u __attribute__((ext_vector_type(4)));
typedef unsigned v2u __attribute__((ext_vector_type(2)));
typedef float f32x4 __attribute__((ext_vector_type(4)));
typedef short bf16x8 __attribute__((ext_vector_type(8)));
typedef short s16x4 __attribute__((ext_vector_type(4)));
typedef _Float16 h2 __attribute__((ext_vector_type(2)));
typedef GAS unsigned gu32;
#define RLX_AGENT __ATOMIC_RELAXED, __HIP_MEMORY_SCOPE_AGENT
__device__ __forceinline__ unsigned pk2(float lo, float hi) { return pg8::cvt_pk_bf16(lo, hi); }
__device__ __forceinline__ unsigned f2bf(float f) { return (unsigned)__builtin_bit_cast(unsigned short, (__bf16)f); }
__device__ __forceinline__ float bflo(unsigned w) { return __builtin_bit_cast(float, w << 16); }
__device__ __forceinline__ float bfhi(unsigned w) { return __builtin_bit_cast(float, w & 0xffff0000u); }
__device__ __forceinline__ float bf2f(unsigned short b) { return __builtin_bit_cast(float, (unsigned)b << 16); }
__device__ __forceinline__ h2 as_h2(unsigned u) { return __builtin_bit_cast(h2, u); }
template <int CTRL> __device__ __forceinline__ float dppmov(float x) { return __builtin_bit_cast(float, __builtin_amdgcn_update_dpp(0, __builtin_bit_cast(int, x), CTRL, 0xF, 0xF, true)); }
__device__ __forceinline__ float row16_sum(float x) { x += dppmov<0xB1>(x); x += dppmov<0x4E>(x); x += dppmov<0x141>(x); x += dppmov<0x140>(x); return x; }
typedef unsigned u32x2_t __attribute__((ext_vector_type(2)));
__device__ __forceinline__ float xor16_sum(float x) { const u32x2_t r = __builtin_amdgcn_permlane16_swap(__builtin_bit_cast(unsigned, x), __builtin_bit_cast(unsigned, x), false, false);
    const unsigned a = r.x, b = r.y; return __builtin_bit_cast(float, a) + __builtin_bit_cast(float, b); }
__device__ __forceinline__ float xor32_sum(float x) { const u32x2_t r = __builtin_amdgcn_permlane32_swap(__builtin_bit_cast(unsigned, x), __builtin_bit_cast(unsigned, x), false, false);
    const unsigned a = r.x, b = r.y; return __builtin_bit_cast(float, a) + __builtin_bit_cast(float, b); }
__device__ __forceinline__ float wave_sum(float v) { return xor32_sum(xor16_sum(row16_sum(v))); }
__device__ __forceinline__ float row16_max(float x) { x = fmaxf(x, dppmov<0xB1>(x)); x = fmaxf(x, dppmov<0x4E>(x)); x = fmaxf(x, dppmov<0x141>(x)); x = fmaxf(x, dppmov<0x140>(x)); return x; }
__device__ __forceinline__ float rcpf_(float x) { return __builtin_amdgcn_rcpf(x); }
__device__ __forceinline__ float rsqf_(float x) { return __builtin_amdgcn_rsqf(x); }
__device__ __forceinline__ float sigmoidf_(float x) { return rcpf_(1.f + __expf(-x)); }
__device__ __forceinline__ float tanhf_(float x) { return 1.f - 2.f * rcpf_(__expf(2.f * x) + 1.f); }
__device__ __forceinline__ float gelu_tanh(float x) { const float u = 1.5957691216057308f * x * (1.f + 0.044715f * x * x); return x * rcpf_(1.f + __expf(-u)); }
#define XB_TMO      128
#define XB_XCNT(j)  (256  + 64 * (j))
#define XB_XSUB(j)  (1280 + 64 * (j))
#define XB_XGEN(j)  (2304 + 64 * (j))
#define XB_TOP      3328
#define XB_TOPGEN   3392
#define XCD_BAR_WORDS 3456
#define XB_SPIN_CAP (1u << 18)

__device__ __forceinline__ unsigned xb_ld(unsigned* p)              { return __hip_atomic_load(p, __ATOMIC_RELAXED, __HIP_MEMORY_SCOPE_AGENT); }
__device__ __forceinline__ unsigned xb_add(unsigned* p, unsigned v) { return __hip_atomic_fetch_add(p, v, __ATOMIC_RELAXED, __HIP_MEMORY_SCOPE_AGENT); }
__device__ __forceinline__ unsigned xb_xcc_id() { return (unsigned)__builtin_amdgcn_s_getreg((3 << 11) | 20) & 0xFu; }
#define XB_SPIN(cond, bar) do { unsigned _sp = 0; while (cond) { __builtin_amdgcn_s_sleep(1); \
    if ((++_sp & 255u) == 0u) { if (xb_ld(&(bar)[XB_TMO])) break; if (_sp > XB_SPIN_CAP) { atomicAdd(&(bar)[XB_TMO], 1u); break; } } } } while (0)

struct XcdBarrier {
    unsigned* bar; unsigned x;
    volatile LAS unsigned* st;
};

__device__ __forceinline__ XcdBarrier xcd_barrier_post(unsigned* bar, volatile LAS unsigned* st) {
    XcdBarrier b; b.bar = bar; b.x = xb_xcc_id(); b.st = st;
    if (threadIdx.x == 0) (void)xb_add(&bar[XB_XCNT(b.x)], 1u);
    return b;
}
__device__ __forceinline__ void xcd_barrier_complete(unsigned* bar, unsigned x, unsigned& nloc, unsigned& nx) {
    const unsigned G = gridDim.x * gridDim.y * gridDim.z;
    unsigned sum, cnt, mine, sp = 0u;
    for (;;) {
        sum = 0u; cnt = 0u; mine = 0u;
#pragma unroll
        for (unsigned j = 0; j < 16; ++j) { const unsigned c = xb_ld(&bar[XB_XCNT(j)]); sum += c; cnt += (c > 0u) ? 1u : 0u; mine = (j == x) ? c : mine; }
        if (sum == G) break;
        __builtin_amdgcn_s_sleep(1);
        if ((++sp & 255u) == 0u) { if (xb_ld(&bar[XB_TMO])) break; if (sp > XB_SPIN_CAP) { atomicAdd(&bar[XB_TMO], 1u); break; } }
    }
    nloc = mine > 0u ? mine : 1u; nx = cnt > 0u ? cnt : 1u;
}

__device__ __forceinline__ void xcd_barrier(const XcdBarrier& b) {
    asm volatile("s_waitcnt vmcnt(0)" ::: "memory");
    __syncthreads();
    if (threadIdx.x == 0) {
        unsigned* bar = b.bar;
        __builtin_amdgcn_s_waitcnt(0);
        unsigned nloc = b.st[0], nx = b.st[1];
        if (nloc == 0u) { xcd_barrier_complete(bar, b.x, nloc, nx); b.st[0] = nloc; b.st[1] = nx; }
        const unsigned old = xb_add(&bar[XB_XSUB(b.x)], 1u);
        const unsigned gen = old / nloc;
        if (old + 1u == (gen + 1u) * nloc) {
            __builtin_amdgcn_fence(__ATOMIC_RELEASE, "agent");
            asm volatile("s_waitcnt vmcnt(0)" ::: "memory");
            const unsigned og = xb_add(&bar[XB_TOP], 1u);
            const unsigned tg = og / nx;
            if (og + 1u == (tg + 1u) * nx) xb_add(&bar[XB_TOPGEN], 1u);
            else XB_SPIN(xb_ld(&bar[XB_TOPGEN]) == tg, bar);
            __builtin_amdgcn_fence(__ATOMIC_ACQUIRE, "agent");
            xb_add(&bar[XB_XGEN(b.x)], 1u);
            asm volatile("s_waitcnt vmcnt(0)" ::: "memory");
        } else {
            XB_SPIN(xb_ld(&bar[XB_XGEN(b.x)]) == gen, bar);
            __builtin_amdgcn_fence(__ATOMIC_ACQUIRE, "agent");
            asm volatile("s_waitcnt vmcnt(0)" ::: "memory");
        }
    }
    __syncthreads();
}

typedef __attribute__((address_space(4))) const unsigned long long kq_t;
struct Frame {
    LAS unsigned char* lds;
    volatile LAS unsigned* MISC;
    gu32* ctl;
    int tid, lane, wave, vcu, G;
    kq_t* karg; GAS float* out; GAS unsigned char* ws;
};
#define INP(F, i) ((const GAS float*)(F).karg[(i)])
enum { I_X = 0, I_NMPRE, I_NMPOST, I_NFPRE, I_NFPOST, I_WIN, I_CONVW, I_RW0, I_RWUP, I_RA0, I_RAUP, I_RGUP, I_RKK, I_RKA, I_RRK, I_LNXW, I_LNXB, I_RPB, I_SGUN, I_SGUW, I_SGUB, I_MGAIN, I_WOUT, I_WUP, I_FCONV, I_WDN };
__device__ __forceinline__ int launder_u(int x) { asm volatile("" : "+v"(x)); return __builtin_amdgcn_readfirstlane(x); }
template <class P> __device__ __forceinline__ P launder_p(P p) { unsigned long long v = (unsigned long long)p; unsigned lo = (unsigned)v, hi = (unsigned)(v >> 32); asm volatile("" : "+v"(lo), "+v"(hi));
    lo = __builtin_amdgcn_readfirstlane(lo); hi = __builtin_amdgcn_readfirstlane(hi); return (P)(((unsigned long long)hi << 32) | lo); }
#define LAUNDER(F) do { asm volatile("" : "+v"((F).tid)); asm volatile("" : "+v"((F).lane)); (F).wave = launder_u((F).wave); (F).vcu = launder_u((F).vcu); (F).karg = launder_p((F).karg); (F).ws = launder_p((F).ws); (F).out = launder_p((F).out); } while (0)
#define LDS_WAIT() asm volatile("s_waitcnt lgkmcnt(0)" ::: "memory")
#define CFENCE() asm volatile("" ::: "memory")

__device__ __forceinline__ void p0_transpose_item(const GAS float* W, const GAS float* gain, int K, int N, GAS bf16* WT, LAS float* scr, int item, int lane, bool glmap = false) {
    const int nblk = N / 32, kb = item / nblk, nb = item % nblk, k0 = 64 * kb, n0 = 32 * nb;
    const int r0 = !glmap ? n0 : (n0 < N / 2 ? 256 * (n0 >> 7) + (n0 & 127) : 256 * ((n0 - N / 2) >> 7) + 128 + ((n0 - N / 2) & 127));
#pragma unroll 8
    for (int i = 0; i < 32; ++i) { const int kk = 2 * i + (lane >> 5); const float g = gain ? gain[k0 + kk] : 1.f; scr[kk * 33 + (lane & 31)] = W[(size_t)(k0 + kk) * N + n0 + (lane & 31)] * g; }
    LDS_WAIT(); CFENCE();
    const int c = lane & 7;
#pragma unroll
    for (int j = 0; j < 4; ++j) { const int n = (lane >> 3) + 8 * j; const LAS float* s = scr + (8 * c) * 33 + n;
        v4u o; o.x = pk2(s[0 * 33], s[1 * 33]); o.y = pk2(s[2 * 33], s[3 * 33]); o.z = pk2(s[4 * 33], s[5 * 33]); o.w = pk2(s[6 * 33], s[7 * 33]);
        *(GAS v4u*)(WT + (size_t)(r0 + n) * K + k0 + 8 * c) = o; }
    LDS_WAIT(); CFENCE();
}
__device__ __forceinline__ void row_to_bf16_rs(const GAS float* xrow, GAS bf16* orow, GAS float* rs, int lane) {
    const GAS f32x4* xr = (const GAS f32x4*)xrow + lane;
    f32x4 v[4]; float s = 0.f;
#pragma unroll
    for (int j = 0; j < 4; ++j) { v[j] = xr[64 * j]; s += (v[j].x * v[j].x + v[j].y * v[j].y) + (v[j].z * v[j].z + v[j].w * v[j].w); }
    s = wave_sum(s);
    GAS v2u* o8 = (GAS v2u*)orow + lane;
#pragma unroll
    for (int j = 0; j < 4; ++j) { v2u o; o.x = pk2(v[j].x, v[j].y); o.y = pk2(v[j].z, v[j].w); o8[64 * j] = o; }
    if (lane == 0) *rs = rsqf_(s * (1.f / DM) + NORM_EPS);
}
__device__ __forceinline__ void p0_prologue(Frame& F) {
    LAUNDER(F);
    LAS float* scr = (LAS float*)(F.lds + F.wave * 16384);
    const int gw = F.vcu * NWAVES + F.wave, NGW = F.G * NWAVES;
    constexpr int I_IN = (DM / 64) * (NPROJ / 32), I_OUT = (DM / 64) * (DM / 32), I_UP = (DM / 64) * (NUP / 32), I_DN = (DFF / 64) * (DM / 32), I_L = I_IN + I_OUT + I_UP + I_DN;
    for (int it = gw; it < DEPTH * I_L; it += NGW) {
        const int l = it / I_L; int r = it % I_L; GAS unsigned char* wl = F.ws + WS_W + (size_t)l * W_LAYER;
        if (r < I_IN) { p0_transpose_item(INP(F, I_WIN) + (size_t)l * DM * NPROJ, INP(F, I_NMPRE) + l * DM, DM, NPROJ, (GAS bf16*)(wl + W_IN), scr, r, F.lane); continue; } r -= I_IN;
        if (r < I_OUT) { p0_transpose_item(INP(F, I_WOUT) + (size_t)l * DM * DM, INP(F, I_MGAIN) + l * DM, DM, DM, (GAS bf16*)(wl + W_OUT), scr, r, F.lane); continue; } r -= I_OUT;
        if (r < I_UP) { p0_transpose_item(INP(F, I_WUP) + (size_t)l * DM * NUP, INP(F, I_NFPRE) + l * DM, DM, NUP, (GAS bf16*)(wl + W_UP), scr, r, F.lane, true); continue; } r -= I_UP;
        p0_transpose_item(INP(F, I_WDN) + (size_t)l * DFF * DM, nullptr, DFF, DM, (GAS bf16*)(wl + W_DN), scr, r, F.lane);
    }
    unsigned zz = 0u; asm volatile("" : "+v"(zz));
    for (int i = F.vcu * NTHREADS + F.tid; i < DEPTH * 20480; i += F.G * NTHREADS) { const int l = i / 20480, r = i % 20480;
        *(GAS v4u*)(F.ws + WS_W + (size_t)l * W_LAYER + W_IN + (size_t)NPROJ * DM * 2 + (size_t)r * 16) = (v4u){zz, zz, zz, zz}; }
    for (int m = gw; m < M; m += NGW) row_to_bf16_rs(INP(F, I_X) + (size_t)m * DM, (GAS bf16*)(F.ws + WS_XB) + (size_t)m * DM, (GAS float*)(F.ws + WS_RS) + m, F.lane);
}

typedef float f32x16 __attribute__((ext_vector_type(16)));
__device__ __forceinline__ void mix_convprep_tile(Frame& F, int l, int tile) {
    LAUNDER(F);
    const GAS bf16* proj = (const GAS bf16*)(F.ws + WS_PROJ); GAS bf16* merged = (GAS bf16*)(F.ws + WS_MERGED);
    const int m0 = tile * 64, bb = m0 / T, t0 = m0 % T;
    const int lane = F.lane, w = F.wave;
    {
        const int c4 = 4 * lane; const GAS float* cw = INP(F, I_CONVW) + l * 768;
        const f32x4 w0 = *(const f32x4*)(cw + c4), w1 = *(const f32x4*)(cw + 256 + c4), w2 = *(const f32x4*)(cw + 512 + c4);
        const int ts = t0 + 8 * w;
        v2u hr[10], cr[10], br[8];
#pragma unroll
        for (int j = 0; j < 10; ++j) { const int t = ts - 1 + j; const bool ok = (t >= 0 && t < T); const GAS bf16* row = proj + (size_t)(bb * T + (ok ? t : ts)) * NPROJP;
            hr[j] = *(const GAS v2u*)(row + C_CH + c4); cr[j] = *(const GAS v2u*)(row + C_CC + c4); if (!ok) { hr[j] = (v2u){0u, 0u}; } }
#pragma unroll
        for (int j = 0; j < 8; ++j) { const GAS bf16* row = proj + (size_t)(bb * T + ts + j) * NPROJP; br[j] = *(const GAS v2u*)(row + C_CB + c4); }
#pragma unroll
        for (int i = 0; i < 8; ++i) { const int t = ts + i;
            f32x4 z[3];
#pragma unroll
            for (int q = 0; q < 3; ++q) { const v2u h = hr[i + q], c = cr[i + q]; z[q] = (f32x4){bflo(h.x) * bflo(c.x), bfhi(h.x) * bfhi(c.x), bflo(h.y) * bflo(c.y), bfhi(h.y) * bfhi(c.y)}; }
            const v2u b = br[i];
            const f32x4 bv = (f32x4){bflo(b.x), bfhi(b.x), bflo(b.y), bfhi(b.y)};
            const f32x4 y = bv * (w0 * z[0] + w1 * z[1] + w2 * z[2]);
            float ss = (y.x * y.x + y.y * y.y) + (y.z * y.z + y.w * y.w); ss = wave_sum(ss);
            const float sc = rsqf_(ss * (1.f / 256.f) + NORM_EPS);
            v2u o; o.x = pk2(y.x * sc, y.y * sc); o.y = pk2(y.z * sc, y.w * sc);
            *(GAS v2u*)(merged + (size_t)(bb * T + t) * DM + 0 + c4) = o;
}
    }
}

__device__ __forceinline__ void mix_na_item(Frame& F, int l, int item, LAS unsigned char* wl, const LAS float* RPB) {
    LAUNDER(F);
    const GAS bf16* proj = (const GAS bf16*)(F.ws + WS_PROJ); GAS bf16* merged = (GAS bf16*)(F.ws + WS_MERGED);
    const int lane = F.lane, i = lane & 15, g = lane >> 4;
    const int qg = item & 3, r = (item >> 2) & 63, bb = item >> 8;
    const int c0 = 16 * qg;
    int rs = r - 4; rs = rs < 0 ? 0 : (rs > 56 ? 56 : rs);
    int cs = c0 - 8; cs = cs < 0 ? 0 : (cs > 32 ? 32 : cs);
    LAS unsigned char* PL = wl; LAS unsigned char* VL = wl + 4096; LAS unsigned char* OL = wl + 8192;
    const size_t rowbase = (size_t)bb * T;
    float ssq[4] = {0.f, 0.f, 0.f, 0.f};
#pragma unroll 1
    for (int h = 0; h < 4; ++h) {
        bf16x8 qf[2];
        { const GAS bf16* qrow = proj + (rowbase + r * 64 + c0 + i) * NPROJP + C_NQ + h * 64 + 8 * g;
          qf[0] = *(const GAS bf16x8*)(qrow); qf[1] = *(const GAS bf16x8*)(qrow + 32); }
        f32x4 s[16];
#pragma unroll
        for (int kt = 0; kt < 16; ++kt) { const int kr = kt >> 1, hf = kt & 1;
            const GAS bf16* krow = proj + (rowbase + (rs + kr) * 64 + cs + 16 * hf + i) * NPROJP + C_NK + h * 64 + 8 * g;
            const bf16x8 k0 = *(const GAS bf16x8*)(krow), k1 = *(const GAS bf16x8*)(krow + 32);
            f32x4 a = (f32x4){0.f, 0.f, 0.f, 0.f};
            a = __builtin_amdgcn_mfma_f32_16x16x32_bf16(qf[0], k0, a, 0, 0, 0);
            a = __builtin_amdgcn_mfma_f32_16x16x32_bf16(qf[1], k1, a, 0, 0, 0);
            s[kt] = a; }
        float mx[4] = {-3e38f, -3e38f, -3e38f, -3e38f};
#pragma unroll
        for (int kt = 0; kt < 16; ++kt) { const int kr = kt >> 1, hf = kt & 1; const int cw = cs + 16 * hf + i; const int dy = rs + kr - r + 7;
#pragma unroll
            for (int e = 0; e < 4; ++e) { const int cq = c0 + 4 * g + e; int st = cq - 8; st = st < 0 ? 0 : (st > 48 ? 48 : st);
                int dx = cw - cq; dx = dx < -15 ? -15 : (dx > 15 ? 15 : dx); dx += 15;
                const bool valid = (cw >= st) && (cw < st + 16);
                float v = s[kt][e] * 0.125f + RPB[h * 465 + dy * 31 + dx];
                v = valid ? v : -1e30f; s[kt][e] = v; mx[e] = fmaxf(mx[e], v); } }
        float sm[4];
#pragma unroll
        for (int e = 0; e < 4; ++e) { mx[e] = row16_max(mx[e]); sm[e] = 0.f; }
#pragma unroll
        for (int kt = 0; kt < 16; ++kt)
#pragma unroll
            for (int e = 0; e < 4; ++e) { const float p = __expf(s[kt][e] - mx[e]); s[kt][e] = p; sm[e] += p; }
#pragma unroll
        for (int e = 0; e < 4; ++e) sm[e] = rcpf_(row16_sum(sm[e]));
        f32x4 oh[4];
#pragma unroll
        for (int dt = 0; dt < 4; ++dt) oh[dt] = (f32x4){0.f, 0.f, 0.f, 0.f};
        const GAS bf16* vsrc = proj + (rowbase + rs * 64 + cs + (lane >> 3)) * NPROJP + C_NV + h * 64 + 8 * (lane & 7);
        v4u vreg[4];
#pragma unroll
        for (int q = 0; q < 4; ++q) vreg[q] = *(const GAS v4u*)(vsrc + (size_t)(8 * q) * NPROJP);
#pragma unroll
        for (int half = 0; half < 2; ++half) {
            CFENCE();
#pragma unroll
            for (int k8 = 0; k8 < 8; ++k8) { const int kt = 8 * half + k8; v2u pw; pw.x = pk2(s[kt][0] * sm[0], s[kt][1] * sm[1]); pw.y = pk2(s[kt][2] * sm[2], s[kt][3] * sm[3]);
                *(LAS v2u*)(PL + (16 * k8 + i) * 32 + 8 * g) = pw; }
            CFENCE();
#pragma unroll
            for (int k4 = 0; k4 < 4; ++k4) { const int kr = 4 * half + k4;
                CFENCE();
#pragma unroll
                for (int q = 0; q < 4; ++q) *(LAS v4u*)(VL + ((lane >> 3) + 8 * q) * 128 + (lane & 7) * 16) = vreg[q];
                if (kr < 7) {
#pragma unroll
                    for (int q = 0; q < 4; ++q) vreg[q] = *(const GAS v4u*)(vsrc + (size_t)((kr + 1) * 64 + 8 * q) * NPROJP); }
                CFENCE();
                const LAS unsigned char* pa = PL + (32 * k4 + 8 * g + (i >> 2)) * 32 + 8 * (i & 3);
                const s16x4 plo = __builtin_bit_cast(s16x4, __builtin_amdgcn_ds_read_tr16_b64_v4i16((LAS s16x4*)(pa)));
                const s16x4 phi = __builtin_bit_cast(s16x4, __builtin_amdgcn_ds_read_tr16_b64_v4i16((LAS s16x4*)(pa + 128)));
                const bf16x8 pf = (bf16x8){plo[0], plo[1], plo[2], plo[3], phi[0], phi[1], phi[2], phi[3]};
#pragma unroll
                for (int dt = 0; dt < 4; ++dt) {
                    const LAS unsigned char* va = VL + (8 * g + (i >> 2)) * 128 + (16 * dt + 4 * (i & 3)) * 2;
                    const s16x4 vlo = __builtin_bit_cast(s16x4, __builtin_amdgcn_ds_read_tr16_b64_v4i16((LAS s16x4*)(va)));
                    const s16x4 vhi = __builtin_bit_cast(s16x4, __builtin_amdgcn_ds_read_tr16_b64_v4i16((LAS s16x4*)(va + 512)));
                    const bf16x8 vf = (bf16x8){vlo[0], vlo[1], vlo[2], vlo[3], vhi[0], vhi[1], vhi[2], vhi[3]};
                    oh[dt] = __builtin_amdgcn_mfma_f32_16x16x32_bf16(pf, vf, oh[dt], 0, 0, 0); }
            }
        }
        CFENCE();
#pragma unroll
        for (int dt = 0; dt < 4; ++dt)
#pragma unroll
            for (int e = 0; e < 4; ++e) { ssq[e] += oh[dt][e] * oh[dt][e]; *(LAS unsigned short*)(OL + (4 * g + e) * 512 + (h * 64 + 16 * dt + i) * 2) = (unsigned short)f2bf(oh[dt][e]); }
        CFENCE();
    }
    LAS float* SCL = (LAS float*)VL;
    CFENCE();
#pragma unroll
    for (int e = 0; e < 4; ++e) { const float sc = rsqf_(row16_sum(ssq[e]) * (1.f / 256.f) + NORM_EPS); if (i == 0) SCL[4 * g + e] = sc; }
    CFENCE();
#pragma unroll
    for (int q = 0; q < 8; ++q) { const int e = lane + 64 * q, row = e >> 5, ch = e & 31;
        const v4u v = *(const LAS v4u*)(OL + row * 512 + ch * 16); const float sc = SCL[row];
        v4u o;
#pragma unroll
        for (int t = 0; t < 4; ++t) o[t] = pk2(bflo(v[t]) * sc, bfhi(v[t]) * sc);
        *(GAS v4u*)(merged + (rowbase + r * 64 + c0 + row) * DM + 512 + 8 * ch) = o; }
    CFENCE();
}

constexpr int SG_PITCH = 528;
__device__ __forceinline__ void mix_sgu_item(Frame& F, int l, int item) {
    LAUNDER(F);
    const GAS bf16* proj = (const GAS bf16*)(F.ws + WS_PROJ); GAS bf16* merged = (GAS bf16*)(F.ws + WS_MERGED);
    const int lane = F.lane, w = F.wave, tid = F.tid, i = lane & 15, g = lane >> 4;
    const size_t m0 = (size_t)item * 128;
    LAS unsigned char* VI = F.lds; LAS float* SS = (LAS float*)(F.lds + 128 * SG_PITCH);
    { const int c4 = 4 * lane; const f32x4 gn = *(const f32x4*)(INP(F, I_SGUN) + l * 256 + c4);
      v2u xr[16];
#pragma unroll
      for (int j = 0; j < 16; ++j) xr[j] = *(const GAS v2u*)(proj + (m0 + 16 * w + j) * NPROJP + C_SV + c4);
#pragma unroll
      for (int j = 0; j < 16; ++j) { const int q = 16 * w + j; const v2u x = xr[j];
          f32x4 v = (f32x4){gelu_tanh(bflo(x.x)), gelu_tanh(bfhi(x.x)), gelu_tanh(bflo(x.y)), gelu_tanh(bfhi(x.y))};
          const float mu = wave_sum((v.x + v.y) + (v.z + v.w)) * (1.f / 256.f);
          v = v - mu;
          const float var = wave_sum((v.x * v.x + v.y * v.y) + (v.z * v.z + v.w * v.w)) * (1.f / 256.f);
          const float rstd = rsqf_(var + NORM_EPS);
          v2u o; o.x = pk2(v.x * rstd * gn.x, v.y * rstd * gn.y); o.y = pk2(v.z * rstd * gn.z, v.w * rstd * gn.w);
          *(LAS v2u*)(VI + q * SG_PITCH + c4 * 2) = o; } }
    __syncthreads();
    const int hh = w >> 1, ph = w & 1;
    f32x4 acc[4][4];
#pragma unroll
    for (int a = 0; a < 4; ++a)
#pragma unroll
        for (int b = 0; b < 4; ++b) acc[a][b] = (f32x4){0.f, 0.f, 0.f, 0.f};
    const GAS float* ws_ = INP(F, I_SGUW) + ((size_t)(l * 4 + hh) * 128) * 128;
#pragma unroll
    for (int ks = 0; ks < 4; ++ks) {
        bf16x8 af[4], bfr[4];
#pragma unroll
        for (int pt = 0; pt < 4; ++pt) { const GAS float* ap = ws_ + (size_t)(64 * ph + 16 * pt + i) * 128 + 32 * ks + 8 * g;
            const f32x4 x0 = *(const f32x4*)ap, x1 = *(const f32x4*)(ap + 4);
            const unsigned u0 = pk2(x0.x, x0.y), u1 = pk2(x0.z, x0.w), u2 = pk2(x1.x, x1.y), u3 = pk2(x1.z, x1.w);
            af[pt] = __builtin_bit_cast(bf16x8, (v4u){u0, u1, u2, u3}); }
#pragma unroll
        for (int dt = 0; dt < 4; ++dt) { const LAS unsigned char* va = VI + (32 * ks + 8 * g + (i >> 2)) * SG_PITCH + (hh * 64 + 16 * dt + 4 * (i & 3)) * 2;
            const s16x4 lo = __builtin_bit_cast(s16x4, __builtin_amdgcn_ds_read_tr16_b64_v4i16((LAS s16x4*)(va)));
            const s16x4 hi = __builtin_bit_cast(s16x4, __builtin_amdgcn_ds_read_tr16_b64_v4i16((LAS s16x4*)(va + 4 * SG_PITCH)));
            bfr[dt] = (bf16x8){lo[0], lo[1], lo[2], lo[3], hi[0], hi[1], hi[2], hi[3]}; }
#pragma unroll
        for (int pt = 0; pt < 4; ++pt)
#pragma unroll
            for (int dt = 0; dt < 4; ++dt) acc[pt][dt] = __builtin_amdgcn_mfma_f32_16x16x32_bf16(af[pt], bfr[dt], acc[pt][dt], 0, 0, 0);
    }
#pragma unroll
    for (int pt = 0; pt < 4; ++pt) {
        unsigned short ur[4][4];
#pragma unroll
        for (int e = 0; e < 4; ++e)
#pragma unroll
            for (int dt = 0; dt < 4; ++dt) ur[e][dt] = proj[(m0 + 64 * ph + 16 * pt + 4 * g + e) * NPROJP + C_SU + hh * 64 + 16 * dt + i];
#pragma unroll
        for (int e = 0; e < 4; ++e) { const int p = 64 * ph + 16 * pt + 4 * g + e; const float bs = INP(F, I_SGUB)[(l * 4 + hh) * 128 + p]; float ss = 0.f;
#pragma unroll
            for (int dt = 0; dt < 4; ++dt) { const float u = gelu_tanh(bf2f(ur[e][dt]));
                const float v = u * (acc[pt][dt][e] + bs); acc[pt][dt][e] = v; ss += v * v; }
            ss = row16_sum(ss); if (i == 0) SS[p * 4 + hh] = ss; } }
    __syncthreads();
#pragma unroll
    for (int pt = 0; pt < 4; ++pt)
#pragma unroll
        for (int e = 0; e < 4; ++e) { const int p = 64 * ph + 16 * pt + 4 * g + e; const f32x4 s4 = *(const LAS f32x4*)(SS + p * 4);
            const float sc = rsqf_(((s4.x + s4.y) + (s4.z + s4.w)) * (1.f / 256.f) + NORM_EPS);
#pragma unroll
            for (int dt = 0; dt < 4; ++dt) *(LAS unsigned short*)(VI + p * SG_PITCH + (hh * 64 + 16 * dt + i) * 2) = (unsigned short)f2bf(acc[pt][dt][e] * sc); }
    __syncthreads();
#pragma unroll
    for (int q = 0; q < 8; ++q) { const int e = tid + 512 * q, row = e >> 5, ch = e & 31;
        const v4u v = *(const LAS v4u*)(VI + row * SG_PITCH + ch * 16);
        *(GAS v4u*)(merged + (m0 + row) * DM + 768 + 8 * ch) = v; }
    __syncthreads();
}

__device__ __forceinline__ void phase_mix_na(Frame& F, int l, int bidx, int nblk) {
    LAUNDER(F);
    LAS float* RPB = (LAS float*)(F.lds + RING_BYTES + 1024);
    for (int q = F.tid; q < 4 * 465; q += NTHREADS) RPB[q] = INP(F, I_RPB)[l * 4 * 465 + q];
    __syncthreads();
    for (int it = bidx * NWAVES + F.wave; it < NB * 64 * 4; it += nblk * NWAVES) mix_na_item(F, l, it, F.lds + F.wave * 16384, RPB);
    __syncthreads();
#ifdef SGU_IN_C2
    for (int it = bidx; it < NB * 32; it += nblk) mix_sgu_item(F, l, it);
#endif
}
__device__ __forceinline__ void phase_mixers(Frame& F, int l) {
    LAUNDER(F);
    for (int tile = F.vcu; tile < M / 64; tile += F.G) mix_convprep_tile(F, l, tile);
    __syncthreads();
#ifndef SGU_IN_C2
    for (int it = F.vcu; it < NB * 32; it += F.G) mix_sgu_item(F, l, it);
#endif
}

constexpr int C1_VEC = 0, C1_VEC_D = 20480, C1_RES = 40960, C1_RES_D = 17664;
constexpr int C1_U = 0, C1_ZT = 4096, C1_ET = 8192, C1_QT = 12288, C1_CT = 16384, C1_DA = 17408;
typedef float f32x2 __attribute__((ext_vector_type(2)));
#define CK_DOT(a, b) ({ f32x2 t_ = (f32x2){(a).x, (a).y} * (f32x2){(b).x, (b).y}; t_ = __builtin_elementwise_fma((f32x2){(a).z, (a).w}, (f32x2){(b).z, (b).w}, t_); t_.x + t_.y; })
#define CK_RED2(a, b) do { a += dppmov<0xB1>(a); b += dppmov<0xB1>(b); a += dppmov<0x4E>(a); b += dppmov<0x4E>(b); a += dppmov<0x141>(a); b += dppmov<0x141>(b); a += dppmov<0x140>(a); b += dppmov<0x140>(b); } while (0)
__device__ __forceinline__ bf16x8 pack8(f32x4 lo, f32x4 hi) { return __builtin_bit_cast(bf16x8, (v4u){pg8::cvt_pk_bf16(lo.x, lo.y), pg8::cvt_pk_bf16(lo.z, lo.w), pg8::cvt_pk_bf16(hi.x, hi.y), pg8::cvt_pk_bf16(hi.z, hi.w)}); }
template <int MODE>
__device__ __forceinline__ void phase_scan_c1(Frame& F, int l) {
    LAUNDER(F);
    const GAS bf16* proj = (const GAS bf16*)(F.ws + WS_PROJ);
    const int lane = F.lane, w = F.wave, i = lane & 15, g = lane >> 4;
    const int d = w >> 2, wa = w & 3;
    const int bh = F.vcu >> 3, bb = bh >> 2, h = bh & 3;
    LAS unsigned char* lds = F.lds;
    bf16x8 Bw, Ba;
    { f32x4 xw0 = (f32x4){0.f, 0.f, 0.f, 0.f}, xw1 = xw0, xa0 = xw0, xa1 = xw0;
      if (g < 2) { const GAS float* pw = INP(F, I_RWUP) + ((size_t)(l * 2 + d) * 16 + 8 * g) * 256 + h * 64 + 16 * wa + i; const GAS float* pa = INP(F, I_RAUP) + ((size_t)(l * 2 + d) * 16 + 8 * g) * 256 + h * 64 + 16 * wa + i;
          xw0 = (f32x4){pw[0], pw[256], pw[512], pw[768]}; xw1 = (f32x4){pw[1024], pw[1280], pw[1536], pw[1792]};
          xa0 = (f32x4){pa[0], pa[256], pa[512], pa[768]}; xa1 = (f32x4){pa[1024], pa[1280], pa[1536], pa[1792]}; }
      Bw = pack8(xw0, xw1); Ba = pack8(xa0, xa1); }
    const float w0c = INP(F, I_RW0)[(l * 2 + d) * 256 + h * 64 + 16 * wa + i], a0c = INP(F, I_RA0)[(l * 2 + d) * 256 + h * 64 + 16 * wa + i], kag = INP(F, I_RKA)[l * 256 + h * 64 + 16 * wa + i];
    float kkg[4];
#pragma unroll
    for (int t = 0; t < 4; ++t) kkg[t] = INP(F, I_RKK)[l * 256 + h * 64 + 16 * t + i];
    const float kkgw = INP(F, I_RKK)[l * 256 + h * 64 + 16 * wa + i];
    const int cg = i, sel = g;
#define C1_BAR() do { asm volatile("s_waitcnt lgkmcnt(0)" ::: "memory"); __builtin_amdgcn_s_barrier(); asm volatile("" ::: "memory"); } while (0)
    unsigned short kq[4][4], kown[4], rq[4]; v4u dvr, ivr;
#define C1_LOAD(B_) do { const size_t m0_ = (size_t)bb * T + 16 * (B_); \
        _Pragma("unroll") for (int e_ = 0; e_ < 4; ++e_) { const GAS bf16* row_ = proj + (m0_ + 4 * g + e_) * NPROJP; \
            _Pragma("unroll") for (int t_ = 0; t_ < 4; ++t_) kq[t_][e_] = row_[C_K + h * 64 + 16 * t_ + i]; \
            rq[e_] = row_[C_R + h * 64 + 16 * wa + i]; kown[e_] = row_[C_K + h * 64 + 16 * wa + i]; } \
        { const GAS bf16* arow_ = proj + (m0_ + i) * NPROJP + C_DEC + 16 * d + 8 * (g & 1); dvr = *(const GAS v4u*)(arow_); ivr = *(const GAS v4u*)(arow_ + 32); } } while (0)
    C1_LOAD((F.vcu & 7) * 32);
    for (int it = 0; it < 32; ++it) {
        const int B = (F.vcu & 7) * 32 + it;
        if (MODE != 3) {
            v4u dv = (v4u){0u, 0u, 0u, 0u}, iv = dv;
            if (g < 2) { iv = ivr;
#pragma unroll
                for (int q = 0; q < 4; ++q) dv[q] = pk2(tanhf_(bflo(dvr[q])), tanhf_(bfhi(dvr[q]))); }
            const f32x4 z4 = (f32x4){0.f, 0.f, 0.f, 0.f};
            const f32x4 Dw = __builtin_amdgcn_mfma_f32_16x16x32_bf16(__builtin_bit_cast(bf16x8, dv), Bw, z4, 0, 0, 0);
            const f32x4 Da = __builtin_amdgcn_mfma_f32_16x16x32_bf16(__builtin_bit_cast(bf16x8, iv), Ba, z4, 0, 0, 0);
#pragma unroll
            for (int e = 0; e < 4; ++e) {
                float ss = 0.f;
#pragma unroll
                for (int t = 0; t < 4; ++t) { const float x = bf2f(kq[t][e]) * kkg[t]; ss += x * x; }
                ss = row16_sum(ss);
                const float k = bf2f(kown[e]); const float kk = k * kkgw * rsqf_(ss + 1e-12f);
                const float wv = __expf(-DECAY_SCALE * sigmoidf_(w0c + Dw[e])), av = sigmoidf_(a0c + Da[e]);
                const int tok = 4 * g + e, s = d ? 15 - tok : tok;
                LAS float* vp = (LAS float*)(lds + C1_VEC + d * C1_VEC_D + s * 1280) + 16 * wa + i;
                vp[0] = wv; vp[64] = kk; vp[128] = kk * av; vp[192] = k * (1.f + (av - 1.f) * kag); vp[256] = bf2f(rq[e]); }
        }
        if (it + 1 < 32) C1_LOAD(B + 1);
        C1_BAR();
        if (MODE != 1 && MODE != 4) {
            const LAS unsigned char* V = lds + C1_VEC + d * C1_VEC_D + cg * 16;
            LAS unsigned char* R = lds + C1_RES + d * C1_RES_D;
#define VLD(s_, vec_) (*(const LAS f32x4*)(V + (s_) * 1280 + (vec_) * 256))
            const unsigned Va = (unsigned)(size_t)V;
#define LD4(X, s_) asm volatile("ds_read_b128 %0, %4\n\tds_read_b128 %1, %4 offset:256\n\tds_read_b128 %2, %4 offset:512\n\tds_read_b128 %3, %4 offset:768" \
                : "=v"(X[0]), "=v"(X[1]), "=v"(X[2]), "=v"(X[3]) : "v"(Va + (unsigned)(s_) * 1280u) : "memory")
#define WT4(X, n_) asm volatile("s_waitcnt lgkmcnt(" #n_ ")" : "+v"(X[0]), "+v"(X[1]), "+v"(X[2]), "+v"(X[3]) :: "memory")
#define LD3(X, s_) asm volatile("ds_read_b128 %0, %3\n\tds_read_b128 %1, %3 offset:256\n\tds_read_b128 %2, %3 offset:512" \
                : "=v"(X[0]), "=v"(X[1]), "=v"(X[2]) : "v"(Va + (unsigned)(s_) * 1280u) : "memory")
#define WT3(X, n_) asm volatile("s_waitcnt lgkmcnt(" #n_ ")" : "+v"(X[0]), "+v"(X[1]), "+v"(X[2]) :: "memory")
            {
                const int s = 4 * wa + sel; f32x4 q = VLD(s, 4); float creg = 0.f;
                f32x4 A0[4], A1[4], A2[4];
#define QBODY_R(X) do { float d1 = CK_DOT(X[3], q), d2 = CK_DOT(X[2], q); CK_RED2(d1, d2); const bool act = j <= s; creg = (act && cg == j) ? d1 : creg; \
                    const f32x4 qn = X[0] * q - X[1] * d2; q = act ? qn : q; } while (0)
#define QBODY(X) do { float d1 = CK_DOT(X[3], q), d2 = CK_DOT(X[2], q); CK_RED2(d1, d2); creg = (cg == j) ? d1 : creg; q = X[0] * q - X[1] * d2; } while (0)
                int j = 4 * wa + 3;
                LD4(A0, j); LD4(A1, j - 1);
                LD4(A2, j - 2); WT4(A0, 8); QBODY_R(A0); --j;
                LD4(A0, j >= 2 ? j - 2 : 0); WT4(A1, 8); QBODY_R(A1); --j;
                LD4(A1, j >= 2 ? j - 2 : 0); WT4(A2, 8); QBODY_R(A2); --j;
                for (;;) {
                    LD4(A2, j >= 2 ? j - 2 : 0); WT4(A0, 8); QBODY(A0); if (--j < 0) break;
                    LD4(A0, j >= 2 ? j - 2 : 0); WT4(A1, 8); QBODY(A1); if (--j < 0) break;
                    LD4(A1, j >= 2 ? j - 2 : 0); WT4(A2, 8); QBODY(A2); if (--j < 0) break;
                }
                WT4(A0, 0); WT4(A1, 0); WT4(A2, 0);
#undef QBODY
#undef QBODY_R
                *(LAS f32x4*)(R + C1_QT + s * 256 + cg * 16) = q; *(LAS float*)(R + C1_CT + s * 64 + cg * 4) = creg;
            }
            {
                const int ga = 3 - wa, s = 4 * ga + sel; f32x4 u = VLD(s, 1);
                const int j0 = 4 * wa + sel; f32x4 x = VLD(j0, 3); f32x4 wz = (f32x4){1.f, 1.f, 1.f, 1.f};
                f32x4 U0[3], U1[3], U2[3], E0[3], E1[3], E2[3];
#define UBODY_R(X, Y) do { float d2 = CK_DOT(X[2], u), d3 = CK_DOT(x, Y[1]); CK_RED2(d2, d3); \
                    const f32x4 un = X[0] * u - X[1] * d2; u = (j < s) ? un : u; const bool act = ii > j0; \
                    const f32x4 xn = x * Y[0] - Y[2] * d3; x = act ? xn : x; wz = act ? wz * Y[0] : wz; } while (0)
#define UBODY(X, Y) do { float d2 = CK_DOT(X[2], u), d3 = CK_DOT(x, Y[1]); CK_RED2(d2, d3); u = X[0] * u - X[1] * d2; x = x * Y[0] - Y[2] * d3; wz = wz * Y[0]; } while (0)
                int j = 4 * ga + 2, ii = 4 * wa + 1;
                LD3(U0, j); LD3(E0, ii); LD3(U1, j >= 1 ? j - 1 : 0); LD3(E1, ii < 15 ? ii + 1 : 15);
                LD3(U2, j >= 2 ? j - 2 : 0); LD3(E2, ii < 14 ? ii + 2 : 15); WT3(U0, 12); WT3(E0, 12); UBODY_R(U0, E0); ++ii; --j;
                LD3(U0, j >= 2 ? j - 2 : 0); LD3(E0, ii < 14 ? ii + 2 : 15); WT3(U1, 12); WT3(E1, 12); UBODY_R(U1, E1); ++ii; --j;
                LD3(U1, j >= 2 ? j - 2 : 0); LD3(E1, ii < 14 ? ii + 2 : 15); WT3(U2, 12); WT3(E2, 12); UBODY_R(U2, E2); ++ii; --j;
                if (j >= 0) for (;;) {
                    LD3(U2, j >= 2 ? j - 2 : 0); LD3(E2, ii < 14 ? ii + 2 : 15); WT3(U0, 12); WT3(E0, 12); UBODY(U0, E0); ++ii; if (--j < 0) break;
                    LD3(U0, j >= 2 ? j - 2 : 0); LD3(E0, ii < 14 ? ii + 2 : 15); WT3(U1, 12); WT3(E1, 12); UBODY(U1, E1); ++ii; if (--j < 0) break;
                    LD3(U1, j >= 2 ? j - 2 : 0); LD3(E1, ii < 14 ? ii + 2 : 15); WT3(U2, 12); WT3(E2, 12); UBODY(U2, E2); ++ii; if (--j < 0) break;
                }
                WT3(U0, 0); WT3(U1, 0); WT3(U2, 0); WT3(E0, 0); WT3(E1, 0); WT3(E2, 0);
#undef UBODY
#undef UBODY_R
                LAS float* up = (LAS float*)(R + C1_U) + (4 * cg) * 16 + s; up[0] = u.x; up[16] = u.y; up[32] = u.z; up[48] = u.w;
                const f32x4 zb = VLD(j0, 2) * wz;
                LAS float* ep = (LAS float*)(R + C1_ET) + (4 * cg) * 16 + j0; ep[0] = x.x; ep[16] = x.y; ep[32] = x.z; ep[48] = x.w;
                LAS float* zp = (LAS float*)(R + C1_ZT) + (4 * cg) * 16 + j0; zp[0] = zb.x; zp[16] = zb.y; zp[32] = zb.z; zp[48] = zb.w;
                if (wa == 0 && sel == 0) *(LAS f32x4*)(R + C1_DA + cg * 16) = VLD(0, 0) * wz;
            }
#undef LD4
#undef WT4
#undef LD3
#undef WT3
#undef VLD
        }
        C1_BAR();
        if (MODE != 2 && MODE != 4) {
            const LAS unsigned char* R = lds + C1_RES + d * C1_RES_D;
            const int n = d ? 255 - B : B;
            GAS unsigned char* gt = (d ? (GAS unsigned char*)F.out : F.ws + WS_GT0) + ((size_t)(bb * 4 + h) * 256 + n) * GT_CHUNK;
            const int nt = wa;
            bf16x8 zf = (bf16x8){0, 0, 0, 0, 0, 0, 0, 0};
            if (g < 2) { const LAS f32x4* zp = (const LAS f32x4*)(R + C1_ZT + (16 * nt + i) * 64 + 32 * g); zf = pack8(zp[0], zp[1]); }
            f32x4 pp[4];
#pragma unroll
            for (int ct = 0; ct < 4; ++ct) {
                bf16x8 uf = (bf16x8){0, 0, 0, 0, 0, 0, 0, 0};
                if (g < 2) { const LAS f32x4* up = (const LAS f32x4*)(R + C1_U + (16 * ct + i) * 64 + 32 * g); uf = pack8(up[0], up[1]); }
                const f32x4 dd = __builtin_amdgcn_mfma_f32_16x16x32_bf16(uf, zf, (f32x4){0.f, 0.f, 0.f, 0.f}, 0, 0, 0);
                f32x4 pv = -dd;
                if (ct == nt) { const f32x4 da = *(const LAS f32x4*)(R + C1_DA + (16 * ct + 4 * g) * 4);
#pragma unroll
                    for (int e = 0; e < 4; ++e) if (4 * g + e == i) pv[e] += da[e]; }
                pp[ct] = pv; }
#define C1_ST(p_, v_) do { const bf16x8 v__ = (v_); if (MODE == 0) *(GAS bf16x8*)(p_) = v__; else asm volatile("" :: "v"(v__)); } while (0)
            C1_ST(gt + (nt * 2 + 0) * 1024 + lane * 16, pack8(pp[0], pp[1]));
            C1_ST(gt + (nt * 2 + 1) * 1024 + lane * 16, pack8(pp[2], pp[3]));
            if (g < 2) { const LAS f32x4* ep = (const LAS f32x4*)(R + C1_ET + (16 * nt + i) * 64 + 32 * g); C1_ST(gt + 10240 + nt * 512 + lane * 16, pack8(ep[0], ep[1])); }
            if (wa == 0) {
#pragma unroll
                for (int ks = 0; ks < 2; ++ks) { const LAS f32x4* qp = (const LAS f32x4*)(R + C1_QT + i * 256 + (32 * ks + 4 * g) * 4);
                    C1_ST(gt + (8 + ks) * 1024 + lane * 16, pack8(qp[0], qp[4])); }
                if (g < 2) { const LAS f32x4* cp = (const LAS f32x4*)(R + C1_CT + i * 64 + 32 * g); C1_ST(gt + 10240 + 4 * 512 + lane * 16, pack8(cp[0], cp[1])); }
            }
        }
    }
#undef C1_LOAD
#undef C1_BAR
    __syncthreads();
}
#define C2_BAR() do { asm volatile("s_waitcnt lgkmcnt(0)" ::: "memory"); __builtin_amdgcn_s_barrier(); asm volatile("" ::: "memory"); } while (0)
constexpr int C2_SLOT = 16384, C2_YOFF = 4 * C2_SLOT;
template <int MODE>
__device__ __forceinline__ void phase_scan_c2(Frame& F, int l) {
    LAUNDER(F);
    if (F.vcu >= 128) { if (MODE == 0) phase_mix_na(F, l, F.vcu - 128, 128); return; }
    const GAS bf16* proj = (const GAS bf16*)(F.ws + WS_PROJ);
    const int lane = F.lane, i = lane & 15, g = lane >> 4;
    LAS unsigned char* lds = F.lds;
    if (F.vcu < 128) {
    const int ci = F.vcu >> 1, tp = F.vcu & 1, d = ci >> 5, bb = (ci >> 2) & 7, h = ci & 3;
    for (int q = F.tid; q < 4 * 5 * 32; q += NTHREADS) { const int sl = q / 160, r = q % 160; *(LAS v4u*)(lds + sl * C2_SLOT + 10240 + (r >> 5) * 1024 + 512 + (r & 31) * 16) = (v4u){0u, 0u, 0u, 0u}; }
    __syncthreads();
    if (F.wave < 2) {
        const int cw = F.wave;
        f32x4 st[4];
#pragma unroll
        for (int t = 0; t < 4; ++t) st[t] = (f32x4){0.f, 0.f, 0.f, 0.f};
        v4u af[15], vf, nf[15], nvf;
#define C2_RD(AF, VF, c_) do { const LAS unsigned char* p_ = lds + ((c_) & 3) * C2_SLOT + lane * 16; \
            _Pragma("unroll") for (int f_ = 0; f_ < 15; ++f_) AF[f_] = *(const LAS v4u*)(p_ + f_ * 1024); \
            VF = *(const LAS v4u*)(lds + ((c_) & 3) * C2_SLOT + 15360 + cw * 512 + i * 32 + (g & 1) * 16); } while (0)
#define C2_STEP(AF, VF, NF, NVF, n_) do { \
            if ((n_) + 1 < 256) C2_RD(NF, NVF, (n_) + 1); \
            const bf16x8 b0_ = pack8(st[0], st[1]), b1_ = pack8(st[2], st[3]); const v4u vz_ = (g < 2) ? VF : (v4u){0u, 0u, 0u, 0u}; const bf16x8 bv_ = __builtin_bit_cast(bf16x8, vz_); \
            f32x4 o_[5]; \
            _Pragma("unroll") for (int nt = 0; nt < 5; ++nt) { if (MODE >= 2) { o_[nt] = __builtin_bit_cast(f32x4, AF[nt]) + __builtin_bit_cast(f32x4, AF[10 + nt]) * st[nt & 3]; continue; } \
                f32x4 a_ = __builtin_amdgcn_mfma_f32_16x16x32_bf16(__builtin_bit_cast(bf16x8, AF[nt * 2]), b0_, (f32x4){0.f, 0.f, 0.f, 0.f}, 0, 0, 0); \
                a_ = __builtin_amdgcn_mfma_f32_16x16x32_bf16(__builtin_bit_cast(bf16x8, AF[nt * 2 + 1]), b1_, a_, 0, 0, 0); \
                o_[nt] = __builtin_amdgcn_mfma_f32_16x16x32_bf16(__builtin_bit_cast(bf16x8, AF[10 + nt]), bv_, a_, 0, 0, 0); } \
            _Pragma("unroll") for (int t = 0; t < 4; ++t) st[t] = o_[t]; \
            { v2u yw_; yw_.x = pk2(o_[4].x, o_[4].y); yw_.y = pk2(o_[4].z, o_[4].w); \
              *(LAS v2u*)(lds + C2_YOFF + (cw * 8 + ((n_) & 7)) * 512 + i * 32 + g * 8) = yw_; }     \
            } while (0)
        C2_BAR();
        C2_RD(af, vf, 0);
        for (int n = 0; n < 256; n += 2) { C2_STEP(af, vf, nf, nvf, n); C2_STEP(nf, nvf, af, vf, n + 1); C2_BAR(); }
        C2_BAR();
#undef C2_STEP
#undef C2_RD
    } else {
        const int hl = F.tid - 128;
        const GAS unsigned char* gt = (d ? (const GAS unsigned char*)F.out : F.ws + WS_GT0) + ((size_t)(bb * 4 + h) * 256) * GT_CHUNK;
        GAS bf16* ysc = (GAS bf16*)(d ? (GAS unsigned char*)F.out + GT_DIR : F.ws + WS_YSC0) + (size_t)bb * T * 256 + h * 64 + 32 * tp;
        const int p0 = hl, p1 = hl + 384, p2 = hl + 768; const bool has2 = p2 < 800;
#define C2_OFF(p_) ((p_) < 640 ? (p_) * 16 : 10240 + (((p_) - 640) >> 5) * 1024 + (((p_) - 640) & 31) * 16)
        const int o0 = C2_OFF(p0), o1 = C2_OFF(p1), o2 = C2_OFF(has2 ? p2 : 799);
        const int e0 = hl, e1 = hl + 384; const bool hasv1 = e1 < 512;
        const GAS bf16* vs0 = proj + (size_t)bb * T * NPROJP + C_V + h * 64 + 32 * tp + 16 * (e0 >> 8) + (e0 & 15);
        const GAS bf16* vs1 = proj + (size_t)bb * T * NPROJP + C_V + h * 64 + 32 * tp + 16 * ((hasv1 ? e1 : 0) >> 8) + (e1 & 15);
        const int vt0 = (e0 >> 4) & 15, vt1 = (e1 >> 4) & 15;
        const int vo0 = 15360 + (e0 >> 8) * 512 + (e0 & 15) * 32 + vt0 * 2, vo1 = 15360 + ((hasv1 ? e1 : 0) >> 8) * 512 + (e1 & 15) * 32 + vt1 * 2;
        constexpr int RD = 12;
        v4u r0[RD], r1[RD], r2[RD]; unsigned short rv0[RD], rv1[RD];
        if (MODE == 1 || MODE == 3) {
#pragma unroll
            for (int k = 0; k < RD; ++k) { r0[k] = (v4u){1u, 2u, 3u, 4u}; r1[k] = r0[k]; r2[k] = r0[k]; rv0[k] = 0; rv1[k] = 0; } }
#define C2_GLD(k_, n_) do { if (MODE == 1 || MODE == 3) break; const GAS unsigned char* c_ = gt + (size_t)(n_) * GT_CHUNK; r0[k_] = *(const GAS v4u*)(c_ + p0 * 16); r1[k_] = *(const GAS v4u*)(c_ + p1 * 16); \
            if (has2) r2[k_] = *(const GAS v4u*)(c_ + p2 * 16); \
            { const int gs_ = 16 * (n_) + vt0, t_ = d ? (T - 1 - gs_) : gs_; rv0[k_] = vs0[(size_t)t_ * NPROJP]; } \
            if (hasv1) { const int gs_ = 16 * (n_) + vt1, t_ = d ? (T - 1 - gs_) : gs_; rv1[k_] = vs1[(size_t)t_ * NPROJP]; } } while (0)
#define C2_WR(k_, n_) do { LAS unsigned char* p_ = lds + ((n_) & 3) * C2_SLOT; *(LAS v4u*)(p_ + o0) = r0[k_]; *(LAS v4u*)(p_ + o1) = r1[k_]; if (has2) *(LAS v4u*)(p_ + o2) = r2[k_]; \
            *(LAS unsigned short*)(p_ + vo0) = rv0[k_]; if (hasv1) *(LAS unsigned short*)(p_ + vo1) = rv1[k_]; } while (0)
#define C2_YST(m_) do { if (hl < 64) { const int cw_ = hl >> 5, s_ = (hl >> 1) & 15, hf_ = hl & 1; const LAS unsigned short* yp_ = (const LAS unsigned short*)(lds + C2_YOFF + (cw_ * 8 + ((m_) & 7)) * 512) + s_; \
            v4u w_; _Pragma("unroll") for (int e_ = 0; e_ < 4; ++e_) w_[e_] = (unsigned)yp_[(8 * hf_ + 2 * e_) * 16] | ((unsigned)yp_[(8 * hf_ + 2 * e_ + 1) * 16] << 16); \
            const int gs_ = 16 * (m_) + s_, t_ = d ? (T - 1 - gs_) : gs_; if (MODE == 0) *(GAS v4u*)(ysc + (size_t)t_ * 256 + 16 * cw_ + 8 * hf_) = w_; else asm volatile("" :: "v"(w_)); } } while (0)
#pragma unroll
        for (int k = 0; k < RD; ++k) C2_GLD(k, k);
        C2_WR(0, 0); C2_GLD(0, RD); C2_WR(1, 1); C2_GLD(1, RD + 1); C2_WR(2, 2); C2_GLD(2, RD + 2);
        C2_BAR();
        for (int m6 = 0; m6 < 128; m6 += RD / 2) {
#pragma unroll
            for (int k = 0; k < RD / 2; ++k) { const int m = m6 + k;
                if (m < 128) {
                    const int ca = 2 * m + 3, cb = 2 * m + 4, ka = (2 * k + 3) % RD, kb = (2 * k + 4) % RD;
                    if (ca < 256) { C2_WR(ka, ca); if (ca + RD < 256) C2_GLD(ka, ca + RD); }
                    if (cb < 256) { C2_WR(kb, cb); if (cb + RD < 256) C2_GLD(kb, cb + RD); }
                    if (m > 0) { C2_YST(2 * m - 2); C2_YST(2 * m - 1); }
                    C2_BAR(); } }
        }
        C2_YST(254); C2_YST(255);
        C2_BAR();
#undef C2_GLD
#undef C2_WR
#undef C2_YST
#undef C2_OFF
    }
    }
    __syncthreads();
}
#undef C2_BAR
#undef CK_DOT
#undef CK_RED2

__device__ __forceinline__ void phase_rwkv_post(Frame& F, int l) {
    LAUNDER(F);
    const GAS bf16* proj = (const GAS bf16*)(F.ws + WS_PROJ); GAS bf16* merged = (GAS bf16*)(F.ws + WS_MERGED); const GAS bf16* ysc0 = (const GAS bf16*)(F.ws + WS_YSC0); const GAS bf16* ysc1 = (const GAS bf16*)((const GAS unsigned char*)F.out + GT_DIR);
    const int lane = F.lane, c4 = 4 * lane, hd = lane >> 4;
    LAS float* GUP = (LAS float*)F.lds;
    for (int q = F.tid; q < 32 * 256; q += NTHREADS) GUP[q] = INP(F, I_RGUP)[(size_t)l * 32 * 256 + q];
    __syncthreads();
    const f32x4 lw = *(const f32x4*)(INP(F, I_LNXW) + l * 256 + c4), lb = *(const f32x4*)(INP(F, I_LNXB) + l * 256 + c4), rk = *(const f32x4*)(INP(F, I_RRK) + l * 256 + c4);
    const int mstep = F.G * NWAVES; int m = F.vcu * NWAVES + F.wave;
    v2u n_yf, n_yb, n_r, n_k, n_v; unsigned short n_g;
#define POST_LOAD(mm) do { const GAS bf16* row_ = proj + (size_t)(mm) * NPROJP; n_yf = *(const GAS v2u*)(ysc0 + (size_t)(mm) * 256 + c4); n_yb = *(const GAS v2u*)(ysc1 + (size_t)(mm) * 256 + c4); \
        n_r = *(const GAS v2u*)(row_ + C_R + c4); n_k = *(const GAS v2u*)(row_ + C_K + c4); n_v = *(const GAS v2u*)(row_ + C_V + c4); n_g = row_[C_GDN + (lane & 31)]; } while (0)
    POST_LOAD(m);
    for (; m < M; m += mstep) {
        const v2u yf = n_yf, yb = n_yb, ru = n_r, ku = n_k, vu = n_v; const unsigned short gu = n_g;
        if (m + mstep < M) POST_LOAD(m + mstep);
        f32x4 y = (f32x4){bflo(yf.x) + bflo(yb.x), bfhi(yf.x) + bfhi(yb.x), bflo(yf.y) + bflo(yb.y), bfhi(yf.y) + bfhi(yb.y)};
        const float mu = row16_sum((y.x + y.y) + (y.z + y.w)) * (1.f / 64.f);
        y = y - mu;
        const float var = row16_sum((y.x * y.x + y.y * y.y) + (y.z * y.z + y.w * y.w)) * (1.f / 64.f);
        const float rstd = rsqf_(var + GN_EPS);
        y = y * rstd * lw + lb;
        const f32x4 r = (f32x4){bflo(ru.x), bfhi(ru.x), bflo(ru.y), bfhi(ru.y)}, k = (f32x4){bflo(ku.x), bfhi(ku.x), bflo(ku.y), bfhi(ku.y)}, v = (f32x4){bflo(vu.x), bfhi(vu.x), bflo(vu.y), bfhi(vu.y)};
        const f32x4 rkk = r * k * rk;
        const float bsum = row16_sum((rkk.x + rkk.y) + (rkk.z + rkk.w));
        y = y + v * bsum;
        const float gd = sigmoidf_(bf2f(gu));
        f32x4 gt = (f32x4){0.f, 0.f, 0.f, 0.f};
#pragma unroll
        for (int j = 0; j < 32; ++j) { const float gj = __builtin_bit_cast(float, __builtin_amdgcn_readlane(__builtin_bit_cast(int, gd), j)); gt = gt + *(const LAS f32x4*)(GUP + j * 256 + c4) * gj; }
        y = y * gt;
        const float ss = wave_sum((y.x * y.x + y.y * y.y) + (y.z * y.z + y.w * y.w));
        const float sc = rsqf_(ss * (1.f / 256.f) + NORM_EPS);
        v2u o; o.x = pk2(y.x * sc, y.y * sc); o.y = pk2(y.z * sc, y.w * sc);
        *(GAS v2u*)(merged + (size_t)m * DM + 256 + c4) = o;
    }
#undef POST_LOAD
    (void)hd;
}

__device__ __forceinline__ void phase_residual(Frame& F, const GAS float* gain, const bool IN_F32, const bool LAST) {
    LAUNDER(F);
    const GAS bf16* y = (const GAS bf16*)(F.ws + WS_Y); const GAS float* part = (const GAS float*)(F.ws + WS_PART);
    GAS bf16* xb = (GAS bf16*)(F.ws + WS_XB); GAS float* rs = (GAS float*)(F.ws + WS_RS); const GAS float* xin = INP(F, I_X);
    const int lane = F.lane;
    f32x4 gv[4];
#pragma unroll
    for (int j = 0; j < 4; ++j) gv[j] = *((const f32x4*)gain + lane + 64 * j);
    for (int m = F.vcu * NWAVES + F.wave; m < M; m += F.G * NWAVES) {
        const f32x4* pp = (const f32x4*)(part + (size_t)m * 16);
        const f32x4 p0 = *(const GAS f32x4*)(pp), p1 = *(const GAS f32x4*)(pp + 1), p2 = *(const GAS f32x4*)(pp + 2), p3 = *(const GAS f32x4*)(pp + 3);
        const float tot = ((p0.x + p0.y) + (p0.z + p0.w)) + ((p1.x + p1.y) + (p1.z + p1.w)) + ((p2.x + p2.y) + (p2.z + p2.w)) + ((p3.x + p3.y) + (p3.z + p3.w));
        const float sc = rsqf_(tot * (1.f / DM) + NORM_EPS);
        const GAS v2u* yr = (const GAS v2u*)(y + (size_t)m * DM) + lane;
        f32x4 v[4]; float s = 0.f;
#pragma unroll
        for (int j = 0; j < 4; ++j) { const v2u yu = yr[64 * j]; const f32x4 yv = (f32x4){bflo(yu.x), bfhi(yu.x), bflo(yu.y), bfhi(yu.y)};
            f32x4 xv;
            if (IN_F32) xv = ((const GAS f32x4*)(xin + (size_t)m * DM) + lane)[64 * j];
            else { const v2u xu = ((const GAS v2u*)(xb + (size_t)m * DM) + lane)[64 * j]; xv = (f32x4){bflo(xu.x), bfhi(xu.x), bflo(xu.y), bfhi(xu.y)}; }
            v[j] = xv + yv * sc * gv[j]; s += (v[j].x * v[j].x + v[j].y * v[j].y) + (v[j].z * v[j].z + v[j].w * v[j].w); }
        if (LAST) {
            GAS f32x4* orow = (GAS f32x4*)(F.out + (size_t)m * DM) + lane;
#pragma unroll
            for (int j = 0; j < 4; ++j) orow[64 * j] = v[j];
        } else {
            s = wave_sum(s);
            GAS v2u* o8 = (GAS v2u*)(xb + (size_t)m * DM) + lane;
#pragma unroll
            for (int j = 0; j < 4; ++j) { v2u o; o.x = pk2(v[j].x, v[j].y); o.y = pk2(v[j].z, v[j].w); o8[64 * j] = o; }
            if (lane == 0) rs[m] = rsqf_(s * (1.f / DM) + NORM_EPS);
        }
    }
}
__device__ __forceinline__ void phase_ffn_conv(Frame& F, int l) {
    LAUNDER(F);
    const GAS bf16* G = (const GAS bf16*)(F.ws + WS_G); GAS bf16* L = (GAS bf16*)(F.ws + WS_L);
    const GAS float* cw = INP(F, I_FCONV) + (size_t)l * 3 * DFF;
    constexpr int CPR = DFF / 8;
    const int nitems = (M / 256) * 2 * CPR;
    for (int it = F.vcu * NTHREADS + F.tid; it < nitems; it += F.G * NTHREADS) {
        const int ck = it % CPR, rr = it / CPR, m = (rr >> 1) * 256 + ((rr & 1) ? 255 : 0), t = m % T, c8 = 8 * ck;
        float w0[8], w1[8], w2[8];
#pragma unroll
        for (int j = 0; j < 8; ++j) { w0[j] = cw[c8 + j]; w1[j] = cw[DFF + c8 + j]; w2[j] = cw[2 * DFF + c8 + j]; }
        const v4u z = (v4u){0u, 0u, 0u, 0u};
        const v4u gp = (t > 0) ? *(const GAS v4u*)(G + (size_t)(m - 1) * DFF + c8) : z, gc = *(const GAS v4u*)(G + (size_t)m * DFF + c8), gn = (t < T - 1) ? *(const GAS v4u*)(G + (size_t)(m + 1) * DFF + c8) : z;
        const v4u lv = *(const GAS v4u*)(L + (size_t)m * DFF + c8);
        v4u o;
#pragma unroll
        for (int q = 0; q < 4; ++q) {
            const float a0 = w0[2 * q] * bflo(gp[q]) + w1[2 * q] * bflo(gc[q]) + w2[2 * q] * bflo(gn[q]);
            const float a1 = w0[2 * q + 1] * bfhi(gp[q]) + w1[2 * q + 1] * bfhi(gc[q]) + w2[2 * q + 1] * bfhi(gn[q]);
            o[q] = pk2(gelu_tanh(a0) * bflo(lv[q]), gelu_tanh(a1) * bfhi(lv[q])); }
        *(GAS v4u*)(L + (size_t)m * DFF + c8) = o;
    }
}

#ifndef MK_N_LAUNCHES
#define MK_N_LAUNCHES 1
#endif
constexpr int NPH = 1 + 10 * DEPTH;
struct Args { const float* in[26]; float* out; unsigned char* ws; int ph_lo, ph_hi; };
__global__ void __launch_bounds__(NTHREADS, 2) enc_fwd(Args args) {
    extern __shared__ __attribute__((aligned(16))) unsigned char lds_raw[];
    Frame F;
    F.lds = (LAS unsigned char*)lds_raw;
    F.MISC = (volatile LAS unsigned*)(F.lds + MISC_OFF);
    F.tid = threadIdx.x; F.lane = F.tid & 63; F.wave = __builtin_amdgcn_readfirstlane(F.tid >> 6);
    F.G = gridDim.x; { const int bx = blockIdx.x; F.vcu = (F.G % 8 == 0) ? (bx % 8) * (F.G / 8) + bx / 8 : bx; }
    F.ws = (GAS unsigned char*)args.ws; F.out = (GAS float*)args.out; F.ctl = (gu32*)(F.ws + WS_CTL);
    F.karg = (kq_t*)__builtin_amdgcn_kernarg_segment_ptr();
    for (int u = F.tid; u < (LDS_BYTES - LDSCTL_OFF) / 4; u += NTHREADS) ((LAS unsigned*)(F.lds + LDSCTL_OFF))[u] = 0u;
    __syncthreads();
    const int lo = args.ph_lo, hi = args.ph_hi;
    if (hi - lo > 1) (void)xcd_barrier_post((unsigned*)(F.ctl + CW_BAR), F.MISC + 8);
#define GRID_BAR() do { XcdBarrier bar_; bar_.bar = (unsigned*)(F.ctl + CW_BAR); bar_.x = xb_xcc_id(); bar_.st = F.MISC + 8; xcd_barrier(bar_); } while (0)
#ifndef PH_ENABLE
#define PH_ENABLE 0x7ff
#endif
#define IN(k) (lo <= (k) && (k) < hi)
#define EN(t) (((PH_ENABLE) >> (t)) & 1)
#pragma unroll 1
#ifdef REPEAT_T
    for (int step = lo; step < hi; ++step) {
        const int p1 = REPEAT_T, p2 = REPEAT_T + 10;
        const int ph = step - (step > p1 ? 1 : 0) - ((step > p2 + 1 && REPEAT_T != 7) ? 1 : 0);
#else
    for (int ph = lo; ph < hi; ++ph) {
#endif
        LAUNDER(F);
        const int l = ph == 0 ? 0 : (ph - 1) / 10, tt = ph == 0 ? 0 : 1 + (ph - 1) % 10, t = tt >= 2 ? tt + 1 : tt;
        GAS unsigned char* wl = F.ws + WS_W + (size_t)l * W_LAYER;
      {
        if (t == 1 || t == 6 || t == 8 || t == 10) {
            pg8::Gemm g; pg8::EpiUni E;
            g.M = M; E.split_cols = 0; E.split_stride = 0; E.convw = nullptr; E.G = nullptr; E.xl = (pg8::PG8_LAS_T*)(F.lds + RING_BYTES + 1024);
            if (t == 1)      { g.A = (const GAS bf16*)(F.ws + WS_XB);     g.Bt = (const GAS bf16*)(wl + W_IN);  g.N = NPROJP; g.K = DM;  E.O = (GAS bf16*)(F.ws + WS_PROJ); E.ldc = NPROJP; E.rs = (const GAS float*)(F.ws + WS_RS); E.part = nullptr; }
            else if (t == 6) { g.A = (const GAS bf16*)(F.ws + WS_MERGED); g.Bt = (const GAS bf16*)(wl + W_OUT); g.N = DM;     g.K = DM;  E.O = (GAS bf16*)(F.ws + WS_Y); E.ldc = DM; E.rs = nullptr; E.part = (GAS float*)(F.ws + WS_PART); }
            else if (t == 8) { g.A = (const GAS bf16*)(F.ws + WS_XB);     g.Bt = (const GAS bf16*)(wl + W_UP);  g.N = NUP;    g.K = DM;  E.O = (GAS bf16*)(F.ws + WS_L); E.ldc = DFF; E.rs = (const GAS float*)(F.ws + WS_RS); E.part = nullptr; E.convw = INP(F, I_FCONV) + (size_t)l * 3 * DFF; E.G = (GAS bf16*)(F.ws + WS_G); }
            else             { g.A = (const GAS bf16*)(F.ws + WS_L);      g.Bt = (const GAS bf16*)(wl + W_DN);  g.N = DM;     g.K = DFF; E.O = (GAS bf16*)(F.ws + WS_Y); E.ldc = DM; E.rs = nullptr; E.part = (GAS float*)(F.ws + WS_PART); }
            g.A = launder_p(g.A); g.Bt = launder_p(g.Bt); E.O = launder_p(E.O); E.rs = launder_p(E.rs); E.part = launder_p(E.part); E.convw = launder_p(E.convw); E.G = launder_p(E.G);
            g.N = launder_u(g.N); g.K = launder_u(g.K); E.ldc = launder_u(E.ldc);
            pg8::StaticOrder S; S.init(M, g.N, F.G, (int)blockIdx.x);
            pg8::gemm_phase<pg8::EpiUni, pg8::StaticOrder, true, true>(F.lds, g, S, E);
        }
        else if (t == 0) p0_prologue(F);
#ifdef C1_EXP
        else if (t == 3) { phase_mixers(F, l); phase_scan_c1<0>(F, l); phase_scan_c1<C1_EXP>(F, l); }
#else
        else if (t == 3) { phase_mixers(F, l); phase_scan_c1<0>(F, l); }
#endif
#ifdef C2_EXP
        else if (t == 4) { phase_scan_c2<0>(F, l); phase_scan_c2<C2_EXP>(F, l); }
#else
        else if (t == 4) phase_scan_c2<0>(F, l);
#endif
        else if (t == 5) phase_rwkv_post(F, l);
        else if (t == 7 || t == 11) phase_residual(F, INP(F, t == 7 ? I_NMPOST : I_NFPOST) + l * DM, t == 7 && l == 0, t == 11 && l + 1 == DEPTH);
        else if (t == 9) phase_ffn_conv(F, l);
      }
#ifdef REPEAT_T
        if (step + 1 < hi) GRID_BAR();
#else
        if (ph + 1 < hi) GRID_BAR();
#endif
    }
}


#ifdef DBG_CHECK
__global__ void dbg_check(const void* buf, size_t n, int kind, int code, unsigned* flag) {
    bool bad = false;
    for (size_t i = (size_t)blockIdx.x * blockDim.x + threadIdx.x; i < n; i += (size_t)gridDim.x * blockDim.x) {
        float v;
        if (kind == 0) v = bf2f(((const unsigned short*)buf)[i]);
        else if (kind == 1) v = ((const float*)buf)[i];
        else v = (float)((const _Float16*)buf)[i];
        if (!(fabsf(v) < 1e30f)) bad = true;
    }
    if (bad) atomicMax(flag, (unsigned)(1000000 - code));
}
__global__ void dbg_report(float* out, const unsigned* flag) { if (threadIdx.x == 0 && blockIdx.x == 0) { const unsigned f = *flag; if (f) out[0] = 100000.f * (float)(10 + 1000000 - (int)f); } }
#endif
extern "C" void kernel_launch(void* const* d_in, const int* in_sizes, int n_in, void* d_out, int out_size, void* d_ws, size_t ws_size, hipStream_t stream) {
    static int grid = 0;
    if (grid == 0) {
        if (n_in != 26 || in_sizes[0] != M * DM || out_size != M * DM || ws_size < WS_END) { fprintf(stderr, "kernel_launch: unexpected shapes: n_in %d in0 %d out %d ws %zu (need >= %zu)\n", n_in, n_in > 0 ? in_sizes[0] : -1, out_size, ws_size, (size_t)WS_END); grid = -1; return; }
        int dev = 0, cus = 0, per_cu = 0;
        if (hipGetDevice(&dev) != hipSuccess || hipDeviceGetAttribute(&cus, hipDeviceAttributeMultiprocessorCount, dev) != hipSuccess) { grid = -1; return; }
        if (hipFuncSetAttribute((const void*)enc_fwd, hipFuncAttributeMaxDynamicSharedMemorySize, LDS_BYTES) != hipSuccess) { fprintf(stderr, "kernel_launch: hipFuncSetAttribute failed\n"); grid = -1; return; }
        if (hipOccupancyMaxActiveBlocksPerMultiprocessor(&per_cu, (const void*)enc_fwd, NTHREADS, LDS_BYTES) != hipSuccess || per_cu < 1) { fprintf(stderr, "kernel_launch: occupancy query says %d blocks per CU\n", per_cu); }
        (void)hipGetLastError();
        grid = cus;
        if (grid != 256) fprintf(stderr, "kernel_launch: %d CUs (built for 256)\n", grid);
    }
    if (grid < 0) return;
    (void)hipMemsetAsync((char*)d_ws + WS_CTL, 0, CTL_ZERO_BYTES, stream);
    Args a{};
    for (int i = 0; i < 26; ++i) a.in[i] = (const float*)d_in[i];
    a.out = (float*)d_out; a.ws = (unsigned char*)d_ws;
#if MK_N_LAUNCHES == 1
#ifdef REPEAT_T
    a.ph_lo = 0; a.ph_hi = NPH + (REPEAT_T == 7 ? 1 : 2);
#else
    a.ph_lo = 0; a.ph_hi = NPH;
#endif
    hipLaunchKernelGGL(enc_fwd, dim3(grid), dim3(NTHREADS), LDS_BYTES, stream, a);
#else
    for (int p = 0; p < NPH; ++p) { a.ph_lo = p; a.ph_hi = p + 1; hipLaunchKernelGGL(enc_fwd, dim3(grid), dim3(NTHREADS), LDS_BYTES, stream, a);
#ifdef DBG_CHECK
        unsigned* flag = (unsigned*)((char*)d_ws + 512 * 1024); char* ws = (char*)d_ws; const int t = p == 0 ? 0 : 1 + (p - 1) % 10;
#define CHK(ptr, n, kind, sub) hipLaunchKernelGGL(dbg_check, dim3(2048), dim3(256), 0, stream, (const void*)(ptr), (size_t)(n), kind, p * 4 + sub, flag)
        if (t == 0) { CHK(ws + WS_W, 2 * W_LAYER / 2, 0, 0); CHK(ws + WS_XB, (size_t)M * DM, 0, 1); CHK(ws + WS_RS, M, 1, 2); }
        if (t == 1) { CHK(ws + WS_PROJ, (size_t)M * NPROJP, 0, 0); }
        if (t == 2) { CHK(ws + WS_PREP, (size_t)64 * MiB, 2, 1); }
        if (t == 3) { CHK(d_out, (size_t)2 * M * 256, 0, 0); }
        if (t == 4) { CHK(ws + WS_MERGED, (size_t)M * DM, 0, 0); }
        if (t == 5 || t == 9) { CHK(ws + WS_Y, (size_t)M * DM, 1, 0); CHK(ws + WS_PART, (size_t)M * 16, 1, 1); }
        if (t == 6 || t == 10) { CHK(d_out, (size_t)M * DM, 1, 0); CHK(ws + WS_XB, (size_t)M * DM, 0, 1); CHK(ws + WS_RS, M, 1, 2); }
        if (t == 7) { CHK(ws + WS_G, (size_t)M * DFF, 0, 0); CHK(ws + WS_L, (size_t)M * DFF, 0, 1); }
        if (t == 8) { CHK(ws + WS_L, (size_t)M * DFF, 0, 0); }
        if (p == NPH - 1) hipLaunchKernelGGL(dbg_report, dim3(1), dim3(64), 0, stream, (float*)d_out, (const unsigned*)flag);
#endif
    }
#endif
}
```

```cpp
#include <hip/hip_runtime.h>
#include <cstdio>
#include <cstdint>
namespace pg8 {
#define PG8_LAS __attribute__((address_space(3)))
#define PG8_GAS __attribute__((address_space(1)))
typedef PG8_LAS unsigned char PG8_LAS_T;
typedef unsigned short bf16_t;
typedef short bf16x8 __attribute__((ext_vector_type(8)));
typedef float f32x4 __attribute__((ext_vector_type(4)));
typedef unsigned u32x4 __attribute__((ext_vector_type(4)));
constexpr int BM = 256, BK = 64, HALF = 128, HTB = HALF * BK * 2  , STAGE_BYTES = 8 * HTB, NXCD = 8, WGM = 8;

__host__ __device__ __forceinline__ int lds_byte(int r, int c) { const int st = (r >> 4) * 2 + (c >> 5), rr = r & 15, cc = c & 31, ob = rr * 64 + cc * 2; return st * 1024 + (ob ^ (((ob >> 9) & 1) << 5)); }
__host__ __device__ __forceinline__ void stage_rc(int b, int& R, int& C) { const int st = b / 1024, sb = b % 1024, swz = sb ^ (((sb >> 9) & 1) << 5); R = (st >> 1) * 16 + swz / 64; C = (st & 1) * 32 + (swz % 64) / 2; }
__host__ __device__ __forceinline__ int perm32(int rho) { const int n = rho >> 4, i = rho & 15; return 8 * (i >> 2) + 4 * n + (i & 3); }

struct Unit { int pm, pn; };
struct Gemm { const PG8_GAS bf16_t* A; const PG8_GAS bf16_t* Bt; int M, N, K; };

struct StaticOrder {
    int nM, nN, nwg, G, c;
    __host__ __device__ void init(int M, int N, int G_, int c_) { nM = M / BM; nN = N / BM; nwg = nM * nN; G = G_; c = c_; }
    __host__ __device__ bool next(int i, Unit& u) const {
        const long L = (long)i * G + c; if (L >= nwg) return false;
        int wgid = (int)L; { const int q = nwg / NXCD, r = nwg % NXCD, xcd = wgid % NXCD, off = wgid / NXCD; wgid = (xcd < r ? xcd * (q + 1) : r * (q + 1) + (xcd - r) * q) + off; }
        const int nig = WGM * nN, gid = wgid / nig, fm = gid * WGM, gsz = (nM - fm) < WGM ? (nM - fm) : WGM;
        u.pm = fm + ((wgid % nig) % gsz); u.pn = (wgid % nig) / gsz; return true;
    }
    __device__ __forceinline__ void a_ready(const Unit&) const {}
    __device__ __forceinline__ void done(const Unit&) const {}
};
typedef float f32x2c __attribute__((ext_vector_type(2)));
typedef __bf16 bf16x2c __attribute__((ext_vector_type(2)));
__device__ __forceinline__ unsigned cvt_pk_bf16(float lo, float hi) { const f32x2c v = {lo, hi}; return __builtin_bit_cast(unsigned, __builtin_convertvector(v, bf16x2c)); }
struct EpiUni {
    static constexpr bool AFTER_DRAIN = false;
    PG8_GAS bf16_t* O; int ldc; const PG8_GAS float* rs; int split_cols; size_t split_stride; PG8_GAS float* part;
    const PG8_GAS float* convw; PG8_GAS bf16_t* G; PG8_LAS unsigned char* xl;
    __device__ __forceinline__ bool perm() const { return true; }
    template <int CTRL> static __device__ __forceinline__ float dppo(float old, float x) { return __builtin_bit_cast(float, __builtin_amdgcn_update_dpp(__builtin_bit_cast(int, old), __builtin_bit_cast(int, x), CTRL, 0xF, 0xF, false)); }
    static __device__ __forceinline__ float gelu_t(float x) { const float u = 1.5957691216057308f * x * (1.f + 0.044715f * x * x); return x * __builtin_amdgcn_rcpf(1.f + __expf(-u)); }
    __device__ __forceinline__ void conv_epi(const f32x4 (&acc_)[2][2][4][2], const Unit& u, int wr, int wc, int fr, int fq) const {
        f32x4 (&acc)[2][2][4][2] = const_cast<f32x4 (&)[2][2][4][2]>(acc_);
        const int hcol = u.pn * HALF + wc * 32 + 8 * fq;
        const PG8_GAS float* rsp = rs + u.pm * BM + wr * 64 + fr;
        constexpr int LDH = 2816;
        const unsigned lane_off = (unsigned)((wr * 64 + fr) * LDH + hcol) * 2u;
        PG8_GAS char* Ob = (PG8_GAS char*)(O + (size_t)u.pm * BM * LDH); PG8_GAS char* Gb = (PG8_GAS char*)(G + (size_t)u.pm * BM * LDH);
        unsigned lp[2][4][2][2];
#pragma unroll
        for (int ai = 0; ai < 2; ++ai)
#pragma unroll
            for (int m = 0; m < 4; ++m) { const float r = rsp[ai * HALF + m * 16];
#pragma unroll
                for (int n = 0; n < 2; ++n) { const f32x4 l4 = acc[ai][1][m][n] * r; lp[ai][m][n][0] = cvt_pk_bf16(l4[0], l4[1]); lp[ai][m][n][1] = cvt_pk_bf16(l4[2], l4[3]); } }
#pragma unroll
        for (int ai = 0; ai < 2; ++ai) { const int k = 2 * ai + wr;
            if (fr == 0)  { const float r = rsp[ai * HALF]; PG8_LAS f32x4* p = (PG8_LAS f32x4*)(xl + ((k * 2 + 0) * 4 + wc) * 128 + fq * 32); p[0] = acc[ai][0][0][0] * r; p[1] = acc[ai][0][0][1] * r; }
            if (fr == 15) { const float r = rsp[ai * HALF + 48]; PG8_LAS f32x4* p = (PG8_LAS f32x4*)(xl + ((k * 2 + 1) * 4 + wc) * 128 + fq * 32); p[0] = acc[ai][0][3][0] * r; p[1] = acc[ai][0][3][1] * r; } }
        asm volatile("s_waitcnt lgkmcnt(0)" ::: "memory"); __builtin_amdgcn_s_barrier(); asm volatile("" ::: "memory");
#pragma unroll
        for (int ai = 0; ai < 2; ++ai) { const int k = 2 * ai + wr;
            float rsv[4];
#pragma unroll
            for (int m = 0; m < 4; ++m) { rsv[m] = rsp[ai * HALF + m * 16];
#pragma unroll
                for (int n = 0; n < 2; ++n) acc[ai][0][m][n] = acc[ai][0][m][n] * rsv[m]; }
            const int ku = k > 0 ? k - 1 : 0, kd = k < 3 ? k + 1 : 3;
#pragma unroll
            for (int n = 0; n < 2; ++n) {
                float w0[4], w1[4], w2[4];
#pragma unroll
                for (int j = 0; j < 4; ++j) { w0[j] = convw[hcol + 4 * n + j]; w1[j] = convw[LDH + hcol + 4 * n + j]; w2[j] = convw[2 * LDH + hcol + 4 * n + j]; }
                const f32x4 xt = *(const PG8_LAS f32x4*)(xl + ((ku * 2 + 1) * 4 + wc) * 128 + fq * 32 + n * 16), xb = *(const PG8_LAS f32x4*)(xl + ((kd * 2 + 0) * 4 + wc) * 128 + fq * 32 + n * 16);
#pragma unroll
                for (int m = 0; m < 4; ++m) { const int tr = 64 * k + 16 * m + fr; const unsigned coff = (unsigned)((ai * HALF + 16 * m) * LDH * 2 + 8 * n);
                    float hv[4];
#pragma unroll
                    for (int e = 0; e < 4; ++e) { const float cur = acc[ai][0][m][n][e];
                        const float upx = (m > 0) ? dppo<0x121>(0.f, acc[ai][0][m > 0 ? m - 1 : 0][n][e]) : xt[e];
                        const float dnx = (m < 3) ? dppo<0x12F>(0.f, acc[ai][0][m < 3 ? m + 1 : 3][n][e]) : xb[e];
                        const float up = dppo<0x111>(upx, cur), dn = dppo<0x101>(dnx, cur);
                        const float a = w0[e] * up + w1[e] * cur + w2[e] * dn;
                        const unsigned lw = lp[ai][m][n][e >> 1]; const float lv = (e & 1) ? __builtin_bit_cast(float, lw & 0xffff0000u) : __builtin_bit_cast(float, lw << 16);
                        hv[e] = (tr == 0 || tr == 255) ? lv : gelu_t(a) * lv; }
                    typedef unsigned u32x2_ __attribute__((ext_vector_type(2)));
                    u32x2_ w; w.x = cvt_pk_bf16(hv[0], hv[1]); w.y = cvt_pk_bf16(hv[2], hv[3]);
                    *(PG8_GAS u32x2_*)(Ob + coff + lane_off) = w;
                    if (tr <= 1 || tr >= 254) { u32x2_ gw; gw.x = cvt_pk_bf16(acc[ai][0][m][n][0], acc[ai][0][m][n][1]); gw.y = cvt_pk_bf16(acc[ai][0][m][n][2], acc[ai][0][m][n][3]);
                        *(PG8_GAS u32x2_*)(Gb + coff + lane_off) = gw; }
                    __builtin_amdgcn_sched_barrier(0); }
                asm volatile("" ::: "memory");
            }
        }
    }
    __device__ __forceinline__ void operator()(const f32x4 (&acc)[2][2][4][2], const Unit& u, int wr, int wc, int fr, int fq) const {
        if (convw != nullptr) { conv_epi(acc, u, wr, wc, fr, fq); return; }
        const int row0 = u.pm * BM + wr * 64 + fr; int colt = u.pn * BM; PG8_GAS bf16_t* base = O;
        if (split_cols) { const int t = colt / split_cols; base += (size_t)t * split_stride; colt -= t * split_cols; }
        const int col0 = colt + wc * 32 + 8 * fq;
        if (part == nullptr) {
#pragma unroll
            for (int ai = 0; ai < 2; ++ai)
#pragma unroll
                for (int m = 0; m < 4; ++m) { const int row = row0 + ai * HALF + m * 16; const float s = rs[row]; PG8_GAS bf16_t* rowp = base + (size_t)row * ldc + col0;
#pragma unroll
                    for (int bj = 0; bj < 2; ++bj) { const f32x4 v0 = acc[ai][bj][m][0] * s, v1 = acc[ai][bj][m][1] * s;
                        u32x4 w; w.x = cvt_pk_bf16(v0[0], v0[1]); w.y = cvt_pk_bf16(v0[2], v0[3]); w.z = cvt_pk_bf16(v1[0], v1[1]); w.w = cvt_pk_bf16(v1[2], v1[3]);
                        *(PG8_GAS u32x4*)(rowp + bj * HALF) = w; } }
        } else {
#pragma unroll
            for (int ai = 0; ai < 2; ++ai)
#pragma unroll
                for (int m = 0; m < 4; ++m) { const int row = row0 + ai * HALF + m * 16; PG8_GAS bf16_t* rowp = base + (size_t)row * ldc + col0; float ss = 0.f;
#pragma unroll
                    for (int bj = 0; bj < 2; ++bj) { const f32x4 v0 = acc[ai][bj][m][0], v1 = acc[ai][bj][m][1];
                        ss += ((v0[0] * v0[0] + v0[1] * v0[1]) + (v0[2] * v0[2] + v0[3] * v0[3])) + ((v1[0] * v1[0] + v1[1] * v1[1]) + (v1[2] * v1[2] + v1[3] * v1[3]));
                        u32x4 w; w.x = cvt_pk_bf16(v0[0], v0[1]); w.y = cvt_pk_bf16(v0[2], v0[3]); w.z = cvt_pk_bf16(v1[0], v1[1]); w.w = cvt_pk_bf16(v1[2], v1[3]);
                        *(PG8_GAS u32x4*)(rowp + bj * HALF) = w; }
                    ss += __shfl_xor(ss, 16); ss += __shfl_xor(ss, 32); if (fq == 0) part[(size_t)row * 16 + u.pn * 4 + wc] = ss; }
        }
    }
};
struct EpiResid {
    static constexpr bool AFTER_DRAIN = false;
    PG8_LAS unsigned char* xl;
    __device__ __forceinline__ bool perm() const { return true; }
    int resid; const PG8_GAS float* gain; PG8_GAS bf16_t* xb; PG8_GAS float* outf; PG8_GAS float* rsw; PG8_GAS float* xs; PG8_GAS unsigned* cnt;
    __device__ __forceinline__ void panel_sum(float (&ss)[2][4], const Unit& u, int wr, int wc, int fr, int fq, int which) const {
        PG8_LAS float* P = (PG8_LAS float*)xl; PG8_LAS float* S = (PG8_LAS float*)(xl + 4096);
        const int tid = threadIdx.x;
#pragma unroll
        for (int ai = 0; ai < 2; ++ai)
#pragma unroll
            for (int m = 0; m < 4; ++m) { float s = ss[ai][m]; s += __shfl_xor(s, 16); s += __shfl_xor(s, 32); if (fq == 0) P[(ai * HALF + wr * 64 + m * 16 + fr) * 4 + wc] = s; }
        asm volatile("s_waitcnt lgkmcnt(0)" ::: "memory"); __builtin_amdgcn_s_barrier(); asm volatile("" ::: "memory");
        PG8_GAS float* slot = xs + ((size_t)which * 32768 + (size_t)u.pm * BM) * 4;
        PG8_GAS unsigned* c = cnt + (which * 128 + u.pm) * 64;
        if (tid < 256) { const f32x4 p = *(const PG8_LAS f32x4*)(P + tid * 4); const float t4 = (p.x + p.y) + (p.z + p.w);
            __hip_atomic_store(slot + tid * 4 + u.pn, t4, __ATOMIC_RELAXED, __HIP_MEMORY_SCOPE_AGENT);
            asm volatile("s_waitcnt vmcnt(0)" ::: "memory");
            if ((tid & 63) == 0) __hip_atomic_fetch_add(c, 1u, __ATOMIC_RELAXED, __HIP_MEMORY_SCOPE_AGENT); }
        if (tid < 64) { unsigned spins = 0;
            while ((unsigned)__builtin_amdgcn_readfirstlane(__hip_atomic_load(c, __ATOMIC_RELAXED, __HIP_MEMORY_SCOPE_AGENT)) < 16u) { __builtin_amdgcn_s_sleep(2); if (++spins > (1u << 22)) break; }
            __builtin_amdgcn_fence(__ATOMIC_ACQUIRE, "agent"); asm volatile("s_waitcnt vmcnt(0)" ::: "memory"); }
        asm volatile("s_waitcnt lgkmcnt(0)" ::: "memory"); __builtin_amdgcn_s_barrier(); asm volatile("" ::: "memory");
        if (tid < 256) { float t = 0.f;
#pragma unroll
            for (int q = 0; q < 4; ++q) t += __hip_atomic_load(slot + tid * 4 + q, __ATOMIC_RELAXED, __HIP_MEMORY_SCOPE_AGENT);
            S[tid] = t; }
        asm volatile("s_waitcnt lgkmcnt(0)" ::: "memory"); __builtin_amdgcn_s_barrier(); asm volatile("" ::: "memory");
#pragma unroll
        for (int ai = 0; ai < 2; ++ai)
#pragma unroll
            for (int m = 0; m < 4; ++m) ss[ai][m] = S[ai * HALF + wr * 64 + m * 16 + fr];
        asm volatile("s_waitcnt lgkmcnt(0)" ::: "memory"); __builtin_amdgcn_s_barrier(); asm volatile("" ::: "memory");
    }
    static __device__ __forceinline__ f32x4 unlo(unsigned a, unsigned b) { return (f32x4){__builtin_bit_cast(float, a << 16), __builtin_bit_cast(float, a & 0xffff0000u), __builtin_bit_cast(float, b << 16), __builtin_bit_cast(float, b & 0xffff0000u)}; }
    __device__ __forceinline__ void resid_epi(const f32x4 (&acc_)[2][2][4][2], const Unit& u, int wr, int wc, int fr, int fq) const {
        f32x4 (&acc)[2][2][4][2] = const_cast<f32x4 (&)[2][2][4][2]>(acc_);
        const int col0 = u.pn * BM + wc * 32 + 8 * fq;
        const unsigned lane_e = (unsigned)((wr * 64 + fr) * 1024 + col0);
        PG8_GAS char* xbb = (PG8_GAS char*)(xb + (size_t)u.pm * BM * 1024); PG8_GAS char* outb = (PG8_GAS char*)(outf + (size_t)u.pm * BM * 1024);
        float ss[2][4];
#pragma unroll
        for (int ai = 0; ai < 2; ++ai)
#pragma unroll
            for (int m = 0; m < 4; ++m) { float s = 0.f;
#pragma unroll
                for (int bj = 0; bj < 2; ++bj) { const f32x4 v0 = acc[ai][bj][m][0], v1 = acc[ai][bj][m][1];
                    s += ((v0[0] * v0[0] + v0[1] * v0[1]) + (v0[2] * v0[2] + v0[3] * v0[3])) + ((v1[0] * v1[0] + v1[1] * v1[1]) + (v1[2] * v1[2] + v1[3] * v1[3]));
                    u32x4 p; p.x = cvt_pk_bf16(v0[0], v0[1]); p.y = cvt_pk_bf16(v0[2], v0[3]); p.z = cvt_pk_bf16(v1[0], v1[1]); p.w = cvt_pk_bf16(v1[2], v1[3]);
                    acc[ai][bj][m][0] = __builtin_bit_cast(f32x4, p); }
                ss[ai][m] = s; }
        panel_sum(ss, u, wr, wc, fr, fq, 0);
#pragma unroll
        for (int ai = 0; ai < 2; ++ai)
#pragma unroll
            for (int m = 0; m < 4; ++m) { const float sc = __builtin_amdgcn_rsqf(ss[ai][m] * (1.f / 1024.f) + 1e-6f); float s2 = 0.f;
                unsigned le = lane_e; asm volatile("" : "+v"(le));
#pragma unroll
                for (int bj = 0; bj < 2; ++bj) {
                    const unsigned ce = (unsigned)((ai * HALF + 16 * m) * 1024 + bj * HALF);
                    const u32x4 xw = *(const PG8_GAS u32x4*)(xbb + (size_t)(ce + le) * 2);
                    const u32x4 yw = __builtin_bit_cast(u32x4, acc[ai][bj][m][0]);
                    const f32x4 g0 = *(const PG8_GAS f32x4*)(gain + col0 + bj * HALF), g1 = *(const PG8_GAS f32x4*)(gain + col0 + bj * HALF + 4);
                    const f32x4 v0 = unlo(xw.x, xw.y) + unlo(yw.x, yw.y) * sc * g0, v1 = unlo(xw.z, xw.w) + unlo(yw.z, yw.w) * sc * g1;
                    s2 += ((v0[0] * v0[0] + v0[1] * v0[1]) + (v0[2] * v0[2] + v0[3] * v0[3])) + ((v1[0] * v1[0] + v1[1] * v1[1]) + (v1[2] * v1[2] + v1[3] * v1[3]));
                    if (resid == 2) { PG8_GAS f32x4* op = (PG8_GAS f32x4*)(outb + (size_t)(ce + le) * 4); op[0] = v0; op[1] = v1; }
                    else { u32x4 p; p.x = cvt_pk_bf16(v0[0], v0[1]); p.y = cvt_pk_bf16(v0[2], v0[3]); p.z = cvt_pk_bf16(v1[0], v1[1]); p.w = cvt_pk_bf16(v1[2], v1[3]); acc[ai][bj][m][0] = __builtin_bit_cast(f32x4, p); } }
                ss[ai][m] = s2; asm volatile("" ::: "memory"); }
        if (resid == 1) {
            panel_sum(ss, u, wr, wc, fr, fq, 1);
#pragma unroll
            for (int ai = 0; ai < 2; ++ai)
#pragma unroll
                for (int m = 0; m < 4; ++m) {
                    unsigned le = lane_e; asm volatile("" : "+v"(le)); unsigned rr = (unsigned)(wr * 64 + fr); asm volatile("" : "+v"(rr));
                    if (u.pn == 0 && wc == 0 && fq == 0) rsw[(size_t)u.pm * BM + ai * HALF + m * 16 + rr] = __builtin_amdgcn_rsqf(ss[ai][m] * (1.f / 1024.f) + 1e-6f);
#pragma unroll
                    for (int bj = 0; bj < 2; ++bj) { const unsigned ce = (unsigned)((ai * HALF + 16 * m) * 1024 + bj * HALF);
                        *(PG8_GAS u32x4*)(xbb + (size_t)(ce + le) * 2) = __builtin_bit_cast(u32x4, acc[ai][bj][m][0]); }
                    asm volatile("" ::: "memory"); }
        }
    }
    __device__ __forceinline__ void operator()(const f32x4 (&acc)[2][2][4][2], const Unit& u, int wr, int wc, int fr, int fq) const { resid_epi(acc, u, wr, wc, fr, fq); }
};
template <class Epi, class Sched, bool ALIGN_EPI = false, bool SP2 = false>
__device__ __forceinline__ void gemm_phase(PG8_LAS unsigned char* lds, const Gemm g, const Sched& S, const Epi& E) {
    int tid_ = threadIdx.x; asm volatile("" : "+v"(tid_));
    const int tid = tid_, wid = __builtin_amdgcn_readfirstlane(tid >> 6), lane = tid & 63, wr = wid >> 2, wc = wid & 3, fr = lane & 15, fq = lane >> 4;
    const int K = g.K, nt = K / BK;
    unsigned voffA[2], voffB[2];
#pragma unroll
    for (int i = 0; i < 2; ++i) { int R, C; stage_rc(tid * 16 + i * 8192, R, C); const int Rb = E.perm() ? ((R & ~31) + perm32(R & 31)) : R;
        voffA[i] = (unsigned)(R * K + C) * 2u; voffB[i] = (unsigned)(Rb * K + C) * 2u; }
    const size_t kstep = (size_t)(BK * 2);
    const size_t hstep = (size_t)HALF * K * 2;
    const size_t tstep = 2 * hstep;
    const unsigned ldsw = (unsigned)wid * 1024u;
    const int aoff = lds_byte(wr * 64 + fr, fq * 8), boff = lds_byte(wc * 32 + fr, fq * 8);
#define PG8_SA(b, h) (((b) * 2 + (h)) * HTB)
#define PG8_SB(b, h) ((4 + (b) * 2 + (h)) * HTB)
#define PG8_STAGE(bufoff, gbase, voff) do { _Pragma("unroll") for (int _i = 0; _i < 2; ++_i) \
        __builtin_amdgcn_global_load_lds((const PG8_GAS unsigned*)((const PG8_GAS char*)(gbase) + (voff)[_i]), (PG8_LAS unsigned*)(lds + (bufoff) + ldsw + _i * 8192), 16, 0, 0); } while (0)
#define PG8_LDA(dst, b, h) do { _Pragma("unroll") for (int m = 0; m < 4; ++m) _Pragma("unroll") for (int k = 0; k < 2; ++k) dst[m][k] = *(const PG8_LAS bf16x8*)(lds + PG8_SA(b, h) + aoff + m * 2048 + k * 1024); } while (0)
#define PG8_LDB(dst, b, h) do { _Pragma("unroll") for (int n = 0; n < 2; ++n) _Pragma("unroll") for (int k = 0; k < 2; ++k) dst[n][k] = *(const PG8_LAS bf16x8*)(lds + PG8_SB(b, h) + boff + n * 2048 + k * 1024); } while (0)
#define PG8_MMA(ai, bj, At, Bt) do { __builtin_amdgcn_s_setprio(1); _Pragma("unroll") for (int m = 0; m < 4; ++m) _Pragma("unroll") for (int n = 0; n < 2; ++n) _Pragma("unroll") for (int k = 0; k < 2; ++k) \
        acc[ai][bj][m][n] = __builtin_amdgcn_mfma_f32_16x16x32_bf16(Bt[n][k], At[m][k], acc[ai][bj][m][n], 0, 0, 0); __builtin_amdgcn_s_setprio(0); } while (0)
#define PG8_WAIT_V(n) asm volatile("s_waitcnt vmcnt(" #n ")" ::: "memory")
#define PG8_WAIT_L(n) asm volatile("s_waitcnt lgkmcnt(" #n ")" ::: "memory")
#define PG8_BAR __builtin_amdgcn_s_barrier()
#define PG8_SCHED __builtin_amdgcn_sched_barrier(0)
    Unit cur, nxt; int ui = 0;
    if (!S.next(0, cur)) return;
    f32x4 acc[2][2][4][2];
#pragma unroll
    for (int a = 0; a < 2; ++a)
#pragma unroll
        for (int b = 0; b < 2; ++b)
#pragma unroll
            for (int m = 0; m < 4; ++m)
#pragma unroll
                for (int n = 0; n < 2; ++n) acc[a][b][m][n] = (f32x4){0.f, 0.f, 0.f, 0.f};
    bf16x8 At[4][2], B0[2][2], B1[2][2];
    const PG8_GAS char* cA = (const PG8_GAS char*)g.A + (size_t)cur.pm * tstep; const PG8_GAS char* cB = (const PG8_GAS char*)g.Bt + (size_t)cur.pn * tstep;
    S.a_ready(cur);
    if constexpr (SP2) {
        PG8_STAGE(PG8_SB(0, 0), cB, voffB); PG8_STAGE(PG8_SB(0, 1), cB + hstep, voffB); PG8_STAGE(PG8_SA(0, 0), cA, voffA); PG8_STAGE(PG8_SA(0, 1), cA + hstep, voffA);
        if (wr == 1) PG8_BAR;
        PG8_WAIT_V(2); PG8_BAR;
        PG8_STAGE(PG8_SB(1, 0), cB + kstep, voffB); PG8_STAGE(PG8_SA(1, 0), cA + kstep, voffA); PG8_STAGE(PG8_SB(1, 1), cB + hstep + kstep, voffB);
        PG8_WAIT_V(6); PG8_BAR;
    } else {
        PG8_STAGE(PG8_SB(0, 0), cB, voffB); PG8_STAGE(PG8_SA(0, 0), cA, voffA); PG8_STAGE(PG8_SB(0, 1), cB + hstep, voffB); PG8_STAGE(PG8_SA(0, 1), cA + hstep, voffA);
        if (wr == 1) PG8_BAR;
        PG8_WAIT_V(4); PG8_BAR;
        PG8_STAGE(PG8_SB(1, 0), cB + kstep, voffB); PG8_STAGE(PG8_SA(1, 0), cA + kstep, voffA); PG8_STAGE(PG8_SB(1, 1), cB + hstep + kstep, voffB);
        PG8_WAIT_V(6); PG8_BAR;
    }
    for (;;) {
        const bool has_next = S.next(ui + 1, nxt);
        const PG8_GAS char* nA = has_next ? (const PG8_GAS char*)g.A + (size_t)nxt.pm * tstep : cA; const PG8_GAS char* nB = has_next ? (const PG8_GAS char*)g.Bt + (size_t)nxt.pn * tstep : cB;
        for (int t = 0; t < nt; t += 2) {
            const bool last = (t == nt - 2);
            const PG8_GAS char* a1 = cA + (size_t)(t + 1) * kstep;
            const PG8_GAS char* a2 = last ? nA : cA + (size_t)(t + 2) * kstep; const PG8_GAS char* b2 = last ? nB : cB + (size_t)(t + 2) * kstep;
            const PG8_GAS char* a3 = a2 + kstep; const PG8_GAS char* b3 = b2 + kstep;
            if (last && has_next) S.a_ready(nxt);
            if constexpr (SP2) {
            PG8_LDB(B0, 0, 0); PG8_LDB(B1, 0, 1); PG8_SCHED; PG8_LDA(At, 0, 0); PG8_STAGE(PG8_SA(1, 1), a1 + hstep, voffA);
            PG8_WAIT_V(8); PG8_WAIT_L(0); PG8_BAR; PG8_MMA(0, 0, At, B0); PG8_MMA(0, 1, At, B1); PG8_BAR; PG8_SCHED;
            PG8_LDA(At, 0, 1); PG8_STAGE(PG8_SB(0, 0), b2, voffB); PG8_STAGE(PG8_SB(0, 1), b2 + hstep, voffB); PG8_STAGE(PG8_SA(0, 0), a2, voffA);
            PG8_WAIT_V(8); PG8_WAIT_L(0); PG8_BAR; PG8_MMA(1, 0, At, B0); PG8_MMA(1, 1, At, B1); PG8_BAR; PG8_SCHED;
            PG8_LDB(B0, 1, 0); PG8_LDB(B1, 1, 1); PG8_SCHED; PG8_LDA(At, 1, 0); PG8_STAGE(PG8_SA(0, 1), a2 + hstep, voffA);
            PG8_WAIT_V(8); PG8_WAIT_L(0); PG8_BAR; PG8_MMA(0, 0, At, B0); PG8_MMA(0, 1, At, B1); PG8_BAR; PG8_SCHED;
            PG8_LDA(At, 1, 1); PG8_STAGE(PG8_SB(1, 0), b3, voffB); PG8_STAGE(PG8_SB(1, 1), b3 + hstep, voffB); PG8_STAGE(PG8_SA(1, 0), a3, voffA);
            PG8_WAIT_V(8); PG8_WAIT_L(0); PG8_BAR; PG8_MMA(1, 0, At, B0); PG8_MMA(1, 1, At, B1); PG8_BAR; PG8_SCHED;
            } else {
            PG8_LDB(B0, 0, 0); PG8_SCHED; PG8_LDA(At, 0, 0); PG8_STAGE(PG8_SA(1, 1), a1 + hstep, voffA);
            PG8_WAIT_L(8); PG8_BAR; PG8_WAIT_L(0); PG8_MMA(0, 0, At, B0); PG8_BAR; PG8_SCHED;
            PG8_LDB(B1, 0, 1); PG8_STAGE(PG8_SB(0, 0), b2, voffB);
            PG8_BAR; PG8_WAIT_L(0); PG8_MMA(0, 1, At, B1); PG8_BAR;
            PG8_LDA(At, 0, 1); PG8_STAGE(PG8_SA(0, 0), a2, voffA);
            PG8_BAR; PG8_WAIT_L(0); PG8_MMA(1, 0, At, B0); PG8_BAR; PG8_SCHED;
            PG8_STAGE(PG8_SB(0, 1), b2 + hstep, voffB);
            PG8_WAIT_V(6); PG8_BAR; PG8_MMA(1, 1, At, B1); PG8_BAR;
            PG8_LDB(B0, 1, 0); PG8_SCHED; PG8_LDA(At, 1, 0); PG8_STAGE(PG8_SA(0, 1), a2 + hstep, voffA);
            PG8_WAIT_L(8); PG8_BAR; PG8_WAIT_L(0); PG8_MMA(0, 0, At, B0); PG8_BAR; PG8_SCHED;
            PG8_LDB(B1, 1, 1); PG8_STAGE(PG8_SB(1, 0), b3, voffB);
            PG8_BAR; PG8_WAIT_L(0); PG8_MMA(0, 1, At, B1); PG8_BAR;
            PG8_LDA(At, 1, 1); PG8_STAGE(PG8_SA(1, 0), a3, voffA);
            PG8_BAR; PG8_WAIT_L(0); PG8_MMA(1, 0, At, B0); PG8_BAR; PG8_SCHED;
            PG8_STAGE(PG8_SB(1, 1), b3 + hstep, voffB);
            PG8_WAIT_V(6); PG8_BAR; PG8_MMA(1, 1, At, B1); PG8_BAR;
            }
        }
        if constexpr (ALIGN_EPI) { if (wr == 0) PG8_BAR; }
        if constexpr (!Epi::AFTER_DRAIN) { E(acc, cur, wr, wc, fr, fq); S.done(cur); }
        if (!has_next) break;
#pragma unroll
        for (int a = 0; a < 2; ++a)
#pragma unroll
            for (int b = 0; b < 2; ++b)
#pragma unroll
                for (int m = 0; m < 4; ++m)
#pragma unroll
                    for (int n = 0; n < 2; ++n) acc[a][b][m][n] = (f32x4){0.f, 0.f, 0.f, 0.f};
        cur = nxt; cA = nA; cB = nB; ++ui;
        if constexpr (ALIGN_EPI) { if (wr == 1) PG8_BAR; }
    }
    PG8_WAIT_V(0);
    if constexpr (!ALIGN_EPI) { if (wr == 0) PG8_BAR; }
    PG8_BAR;
    if constexpr (Epi::AFTER_DRAIN) { E.fused(acc, cur, wr, wc, fr, fq, lds, wid, lane); S.done(cur); }
#undef PG8_SA
#undef PG8_SB
#undef PG8_STAGE
#undef PG8_LDA
#undef PG8_LDB
#undef PG8_MMA
#undef PG8_WAIT_V
#undef PG8_WAIT_L
#undef PG8_BAR
#undef PG8_SCHED
}
}

constexpr int NB = 8, T = 4096, DM = 1024, M = NB * T, DEPTH = 2;
constexpr int NPROJ = 2912, NPROJP = 3072, DFF = 2816, NUP = 2 * DFF;
constexpr int C_CH = 0, C_CB = 256, C_CC = 512, C_R = 768, C_K = 1024, C_V = 1280, C_DEC = 1536, C_GDN = 1600, C_NQ = 1632, C_NK = 1888, C_NV = 2144, C_SU = 2400, C_SV = 2656;
constexpr float NORM_EPS = 1e-6f, GN_EPS = 64e-5f, DECAY_SCALE = 0.60653065971263342f;
constexpr int NWAVES = 8, NTHREADS = 512;
constexpr size_t MiB = 1u << 20;
constexpr size_t WS_CTL = 0, CTL_ZERO_BYTES = 1 * MiB;
constexpr size_t WS_RS = 1 * MiB;
constexpr size_t WS_PART = 1 * MiB + 256 * 1024;
constexpr size_t WS_W = 4 * MiB, W_LAYER = 24 * MiB + 512 * 1024;
constexpr size_t W_IN = 0, W_OUT = 6 * MiB, W_UP = 8 * MiB, W_DN = 19 * MiB;
constexpr size_t WS_XB = 53 * MiB;
constexpr size_t WS_R = 117 * MiB;
constexpr size_t WS_PROJ = WS_R, WS_MERGED = WS_R + 192 * MiB, WS_PREP = WS_R + 256 * MiB;
constexpr size_t GT_CHUNK = 12800, GT_DIR = (size_t)NB * 4 * 256 * GT_CHUNK;
constexpr size_t WS_GT0 = WS_PREP, WS_YSC0 = WS_PREP + 100 * MiB;
static_assert(GT_DIR == 100 * MiB, "GT size");
constexpr size_t WS_Y = WS_R;
constexpr size_t WS_G = WS_R, WS_L = WS_R + 176 * MiB;
constexpr size_t WS_END = 501 * MiB;
static_assert(WS_W + 2 * W_LAYER <= WS_XB && WS_PREP + 128 * MiB <= WS_END && WS_L + 176 * MiB <= WS_END && WS_PART + (size_t)M * 64 <= WS_W, "ws map");
constexpr int CW_BAR = 4096;
constexpr int CW_PANEL = 16384;
constexpr size_t WS_XS = WS_PART;
constexpr int RING_BYTES = 131072, LDSCTL_OFF = RING_BYTES, MISC_OFF = LDSCTL_OFF + 320, LDS_BYTES = 147456;

#define GAS __attribute__((address_space(1)))
#define LAS __attribute__((address_space(3)))
typedef unsigned short bf16;
typedef unsigned v4u __attribute__((ext_vector_type(4)));
typedef unsigned v2u __attribute__((ext_vector_type(2)));
typedef float f32x4 __attribute__((ext_vector_type(4)));
typedef short bf16x8 __attribute__((ext_vector_type(8)));
typedef short s16x4 __attribute__((ext_vector_type(4)));
typedef _Float16 h2 __attribute__((ext_vector_type(2)));
typedef GAS unsigned gu32;
#define RLX_AGENT __ATOMIC_RELAXED, __HIP_MEMORY_SCOPE_AGENT
__device__ __forceinline__ unsigned pk2(float lo, float hi) { return pg8::cvt_pk_bf16(lo, hi); }
__device__ __forceinline__ unsigned f2bf(float f) { return (unsigned)__builtin_bit_cast(unsigned short, (__bf16)f); }
__device__ __forceinline__ float bflo(unsigned w) { return __builtin_bit_cast(float, w << 16); }
__device__ __forceinline__ float bfhi(unsigned w) { return __builtin_bit_cast(float, w & 0xffff0000u); }
__device__ __forceinline__ float bf2f(unsigned short b) { return __builtin_bit_cast(float, (unsigned)b << 16); }
__device__ __forceinline__ h2 as_h2(unsigned u) { return __builtin_bit_cast(h2, u); }
template <int CTRL> __device__ __forceinline__ float dppmov(float x) { return __builtin_bit_cast(float, __builtin_amdgcn_update_dpp(0, __builtin_bit_cast(int, x), CTRL, 0xF, 0xF, true)); }
__device__ __forceinline__ float row16_sum(float x) { x += dppmov<0xB1>(x); x += dppmov<0x4E>(x); x += dppmov<0x141>(x); x += dppmov<0x140>(x); return x; }
typedef unsigned u32x2_t __attribute__((ext_vector_type(2)));
__device__ __forceinline__ float xor16_sum(float x) { const u32x2_t r = __builtin_amdgcn_permlane16_swap(__builtin_bit_cast(unsigned, x), __builtin_bit_cast(unsigned, x), false, false);
    const unsigned a = r.x, b = r.y; return __builtin_bit_cast(float, a) + __builtin_bit_cast(float, b); }
__device__ __forceinline__ float xor32_sum(float x) { const u32x2_t r = __builtin_amdgcn_permlane32_swap(__builtin_bit_cast(unsigned, x), __builtin_bit_cast(unsigned, x), false, false);
    const unsigned a = r.x, b = r.y; return __builtin_bit_cast(float, a) + __builtin_bit_cast(float, b); }
__device__ __forceinline__ float wave_sum(float v) { return xor32_sum(xor16_sum(row16_sum(v))); }
__device__ __forceinline__ float row16_max(float x) { x = fmaxf(x, dppmov<0xB1>(x)); x = fmaxf(x, dppmov<0x4E>(x)); x = fmaxf(x, dppmov<0x141>(x)); x = fmaxf(x, dppmov<0x140>(x)); return x; }
__device__ __forceinline__ float rcpf_(float x) { return __builtin_amdgcn_rcpf(x); }
__device__ __forceinline__ float rsqf_(float x) { return __builtin_amdgcn_rsqf(x); }
__device__ __forceinline__ float sigmoidf_(float x) { return rcpf_(1.f + __expf(-x)); }
__device__ __forceinline__ float tanhf_(float x) { return 1.f - 2.f * rcpf_(__expf(2.f * x) + 1.f); }
__device__ __forceinline__ float gelu_tanh(float x) { const float u = 1.5957691216057308f * x * (1.f + 0.044715f * x * x); return x * rcpf_(1.f + __expf(-u)); }
#define XB_TMO      128
#define XB_XCNT(j)  (256  + 64 * (j))
#define XB_XSUB(j)  (1280 + 64 * (j))
#define XB_XGEN(j)  (2304 + 64 * (j))
#define XB_TOP      3328
#define XB_TOPGEN   3392
#define XCD_BAR_WORDS 3456
#define XB_SPIN_CAP (1u << 18)

__device__ __forceinline__ unsigned xb_ld(unsigned* p)              { return __hip_atomic_load(p, __ATOMIC_RELAXED, __HIP_MEMORY_SCOPE_AGENT); }
__device__ __forceinline__ unsigned xb_add(unsigned* p, unsigned v) { return __hip_atomic_fetch_add(p, v, __ATOMIC_RELAXED, __HIP_MEMORY_SCOPE_AGENT); }
__device__ __forceinline__ unsigned xb_xcc_id() { return (unsigned)__builtin_amdgcn_s_getreg((3 << 11) | 20) & 0xFu; }
#define XB_SPIN(cond, bar) do { unsigned _sp = 0; while (cond) { __builtin_amdgcn_s_sleep(1); \
    if ((++_sp & 255u) == 0u) { if (xb_ld(&(bar)[XB_TMO])) break; if (_sp > XB_SPIN_CAP) { atomicAdd(&(bar)[XB_TMO], 1u); break; } } } } while (0)

struct XcdBarrier {
    unsigned* bar; unsigned x;
    volatile LAS unsigned* st;
};

__device__ __forceinline__ XcdBarrier xcd_barrier_post(unsigned* bar, volatile LAS unsigned* st) {
    XcdBarrier b; b.bar = bar; b.x = xb_xcc_id(); b.st = st;
    if (threadIdx.x == 0) (void)xb_add(&bar[XB_XCNT(b.x)], 1u);
    return b;
}
__device__ __forceinline__ void xcd_barrier_complete(unsigned* bar, unsigned x, unsigned& nloc, unsigned& nx) {
    const unsigned G = gridDim.x * gridDim.y * gridDim.z;
    unsigned sum, cnt, mine, sp = 0u;
    for (;;) {
        sum = 0u; cnt = 0u; mine = 0u;
#pragma unroll
        for (unsigned j = 0; j < 16; ++j) { const unsigned c = xb_ld(&bar[XB_XCNT(j)]); sum += c; cnt += (c > 0u) ? 1u : 0u; mine = (j == x) ? c : mine; }
        if (sum == G) break;
        __builtin_amdgcn_s_sleep(1);
        if ((++sp & 255u) == 0u) { if (xb_ld(&bar[XB_TMO])) break; if (sp > XB_SPIN_CAP) { atomicAdd(&bar[XB_TMO], 1u); break; } }
    }
    nloc = mine > 0u ? mine : 1u; nx = cnt > 0u ? cnt : 1u;
}

__device__ __forceinline__ void xcd_barrier(const XcdBarrier& b) {
    asm volatile("s_waitcnt vmcnt(0)" ::: "memory");
    __syncthreads();
    if (threadIdx.x == 0) {
        unsigned* bar = b.bar;
        __builtin_amdgcn_s_waitcnt(0);
        unsigned nloc = b.st[0], nx = b.st[1];
        if (nloc == 0u) { xcd_barrier_complete(bar, b.x, nloc, nx); b.st[0] = nloc; b.st[1] = nx; }
        const unsigned old = xb_add(&bar[XB_XSUB(b.x)], 1u);
        const unsigned gen = old / nloc;
        if (old + 1u == (gen + 1u) * nloc) {
            __builtin_amdgcn_fence(__ATOMIC_RELEASE, "agent");
            asm volatile("s_waitcnt vmcnt(0)" ::: "memory");
            const unsigned og = xb_add(&bar[XB_TOP], 1u);
            const unsigned tg = og / nx;
            if (og + 1u == (tg + 1u) * nx) xb_add(&bar[XB_TOPGEN], 1u);
            else XB_SPIN(xb_ld(&bar[XB_TOPGEN]) == tg, bar);
            __builtin_amdgcn_fence(__ATOMIC_ACQUIRE, "agent");
            xb_add(&bar[XB_XGEN(b.x)], 1u);
            asm volatile("s_waitcnt vmcnt(0)" ::: "memory");
        } else {
            XB_SPIN(xb_ld(&bar[XB_XGEN(b.x)]) == gen, bar);
            __builtin_amdgcn_fence(__ATOMIC_ACQUIRE, "agent");
            asm volatile("s_waitcnt vmcnt(0)" ::: "memory");
        }
    }
    __syncthreads();
}

typedef __attribute__((address_space(4))) const unsigned long long kq_t;
struct Frame {
    LAS unsigned char* lds;
    volatile LAS unsigned* MISC;
    gu32* ctl;
    int tid, lane, wave, vcu, G;
    kq_t* karg; GAS float* out; GAS unsigned char* ws;
};
#define INP(F, i) ((const GAS float*)(F).karg[(i)])
enum { I_X = 0, I_NMPRE, I_NMPOST, I_NFPRE, I_NFPOST, I_WIN, I_CONVW, I_RW0, I_RWUP, I_RA0, I_RAUP, I_RGUP, I_RKK, I_RKA, I_RRK, I_LNXW, I_LNXB, I_RPB, I_SGUN, I_SGUW, I_SGUB, I_MGAIN, I_WOUT, I_WUP, I_FCONV, I_WDN };
__device__ __forceinline__ int launder_u(int x) { asm volatile("" : "+v"(x)); return __builtin_amdgcn_readfirstlane(x); }
template <class P> __device__ __forceinline__ P launder_p(P p) { unsigned long long v = (unsigned long long)p; unsigned lo = (unsigned)v, hi = (unsigned)(v >> 32); asm volatile("" : "+v"(lo), "+v"(hi));
    lo = __builtin_amdgcn_readfirstlane(lo); hi = __builtin_amdgcn_readfirstlane(hi); return (P)(((unsigned long long)hi << 32) | lo); }
#define LAUNDER(F) do { asm volatile("" : "+v"((F).tid)); asm volatile("" : "+v"((F).lane)); (F).wave = launder_u((F).wave); (F).vcu = launder_u((F).vcu); (F).karg = launder_p((F).karg); (F).ws = launder_p((F).ws); (F).out = launder_p((F).out); } while (0)
#define LDS_WAIT() asm volatile("s_waitcnt lgkmcnt(0)" ::: "memory")
#define CFENCE() asm volatile("" ::: "memory")

__device__ __forceinline__ void p0_transpose_item(const GAS float* W, const GAS float* gain, int K, int N, GAS bf16* WT, LAS float* scr, int item, int lane, bool glmap = false) {
    const int nblk = N / 32, kb = item / nblk, nb = item % nblk, k0 = 64 * kb, n0 = 32 * nb;
    const int r0 = !glmap ? n0 : (n0 < N / 2 ? 256 * (n0 >> 7) + (n0 & 127) : 256 * ((n0 - N / 2) >> 7) + 128 + ((n0 - N / 2) & 127));
#pragma unroll 8
    for (int i = 0; i < 32; ++i) { const int kk = 2 * i + (lane >> 5); const float g = gain ? gain[k0 + kk] : 1.f; scr[kk * 33 + (lane & 31)] = W[(size_t)(k0 + kk) * N + n0 + (lane & 31)] * g; }
    LDS_WAIT(); CFENCE();
    const int c = lane & 7;
#pragma unroll
    for (int j = 0; j < 4; ++j) { const int n = (lane >> 3) + 8 * j; const LAS float* s = scr + (8 * c) * 33 + n;
        v4u o; o.x = pk2(s[0 * 33], s[1 * 33]); o.y = pk2(s[2 * 33], s[3 * 33]); o.z = pk2(s[4 * 33], s[5 * 33]); o.w = pk2(s[6 * 33], s[7 * 33]);
        *(GAS v4u*)(WT + (size_t)(r0 + n) * K + k0 + 8 * c) = o; }
    LDS_WAIT(); CFENCE();
}
__device__ __forceinline__ void row_to_bf16_rs(const GAS float* xrow, GAS bf16* orow, GAS float* rs, int lane) {
    const GAS f32x4* xr = (const GAS f32x4*)xrow + lane;
    f32x4 v[4]; float s = 0.f;
#pragma unroll
    for (int j = 0; j < 4; ++j) { v[j] = xr[64 * j]; s += (v[j].x * v[j].x + v[j].y * v[j].y) + (v[j].z * v[j].z + v[j].w * v[j].w); }
    s = wave_sum(s);
    GAS v2u* o8 = (GAS v2u*)orow + lane;
#pragma unroll
    for (int j = 0; j < 4; ++j) { v2u o; o.x = pk2(v[j].x, v[j].y); o.y = pk2(v[j].z, v[j].w); o8[64 * j] = o; }
    if (lane == 0) *rs = rsqf_(s * (1.f / DM) + NORM_EPS);
}
__device__ __forceinline__ void p0_prologue(Frame& F) {
    LAUNDER(F);
    LAS float* scr = (LAS float*)(F.lds + F.wave * 16384);
    const int gw = F.vcu * NWAVES + F.wave, NGW = F.G * NWAVES;
    constexpr int I_IN = (DM / 64) * (NPROJ / 32), I_OUT = (DM / 64) * (DM / 32), I_UP = (DM / 64) * (NUP / 32), I_DN = (DFF / 64) * (DM / 32), I_L = I_IN + I_OUT + I_UP + I_DN;
    for (int it = gw; it < DEPTH * I_L; it += NGW) {
        const int l = it / I_L; int r = it % I_L; GAS unsigned char* wl = F.ws + WS_W + (size_t)l * W_LAYER;
        if (r < I_IN) { p0_transpose_item(INP(F, I_WIN) + (size_t)l * DM * NPROJ, INP(F, I_NMPRE) + l * DM, DM, NPROJ, (GAS bf16*)(wl + W_IN), scr, r, F.lane); continue; } r -= I_IN;
        if (r < I_OUT) { p0_transpose_item(INP(F, I_WOUT) + (size_t)l * DM * DM, INP(F, I_MGAIN) + l * DM, DM, DM, (GAS bf16*)(wl + W_OUT), scr, r, F.lane); continue; } r -= I_OUT;
        if (r < I_UP) { p0_transpose_item(INP(F, I_WUP) + (size_t)l * DM * NUP, INP(F, I_NFPRE) + l * DM, DM, NUP, (GAS bf16*)(wl + W_UP), scr, r, F.lane, true); continue; } r -= I_UP;
        p0_transpose_item(INP(F, I_WDN) + (size_t)l * DFF * DM, nullptr, DFF, DM, (GAS bf16*)(wl + W_DN), scr, r, F.lane);
    }
    unsigned zz = 0u; asm volatile("" : "+v"(zz));
    for (int i = F.vcu * NTHREADS + F.tid; i < DEPTH * 20480; i += F.G * NTHREADS) { const int l = i / 20480, r = i % 20480;
        *(GAS v4u*)(F.ws + WS_W + (size_t)l * W_LAYER + W_IN + (size_t)NPROJ * DM * 2 + (size_t)r * 16) = (v4u){zz, zz, zz, zz}; }
    for (int m = gw; m < M; m += NGW) row_to_bf16_rs(INP(F, I_X) + (size_t)m * DM, (GAS bf16*)(F.ws + WS_XB) + (size_t)m * DM, (GAS float*)(F.ws + WS_RS) + m, F.lane);
}

typedef float f32x16 __attribute__((ext_vector_type(16)));
__device__ __forceinline__ void mix_convprep_tile(Frame& F, int l, int tile) {
    LAUNDER(F);
    const GAS bf16* proj = (const GAS bf16*)(F.ws + WS_PROJ); GAS bf16* merged = (GAS bf16*)(F.ws + WS_MERGED);
    const int m0 = tile * 64, bb = m0 / T, t0 = m0 % T;
    const int lane = F.lane, w = F.wave;
    {
        const int c4 = 4 * lane; const GAS float* cw = INP(F, I_CONVW) + l * 768;
        const f32x4 w0 = *(const f32x4*)(cw + c4), w1 = *(const f32x4*)(cw + 256 + c4), w2 = *(const f32x4*)(cw + 512 + c4);
        const int ts = t0 + 8 * w;
        v2u hr[10], cr[10], br[8];
#pragma unroll
        for (int j = 0; j < 10; ++j) { const int t = ts - 1 + j; const bool ok = (t >= 0 && t < T); const GAS bf16* row = proj + (size_t)(bb * T + (ok ? t : ts)) * NPROJP;
            hr[j] = *(const GAS v2u*)(row + C_CH + c4); cr[j] = *(const GAS v2u*)(row + C_CC + c4); if (!ok) { hr[j] = (v2u){0u, 0u}; } }
#pragma unroll
        for (int j = 0; j < 8; ++j) { const GAS bf16* row = proj + (size_t)(bb * T + ts + j) * NPROJP; br[j] = *(const GAS v2u*)(row + C_CB + c4); }
#pragma unroll
        for (int i = 0; i < 8; ++i) { const int t = ts + i;
            f32x4 z[3];
#pragma unroll
            for (int q = 0; q < 3; ++q) { const v2u h = hr[i + q], c = cr[i + q]; z[q] = (f32x4){bflo(h.x) * bflo(c.x), bfhi(h.x) * bfhi(c.x), bflo(h.y) * bflo(c.y), bfhi(h.y) * bfhi(c.y)}; }
            const v2u b = br[i];
            const f32x4 bv = (f32x4){bflo(b.x), bfhi(b.x), bflo(b.y), bfhi(b.y)};
            const f32x4 y = bv * (w0 * z[0] + w1 * z[1] + w2 * z[2]);
            float ss = (y.x * y.x + y.y * y.y) + (y.z * y.z + y.w * y.w); ss = wave_sum(ss);
            const float sc = rsqf_(ss * (1.f / 256.f) + NORM_EPS);
            v2u o; o.x = pk2(y.x * sc, y.y * sc); o.y = pk2(y.z * sc, y.w * sc);
            *(GAS v2u*)(merged + (size_t)(bb * T + t) * DM + 0 + c4) = o;
}
    }
}

__device__ __forceinline__ void mix_na_item(Frame& F, int l, int item, LAS unsigned char* wl, const LAS float* RPB) {
    LAUNDER(F);
    const GAS bf16* proj = (const GAS bf16*)(F.ws + WS_PROJ); GAS bf16* merged = (GAS bf16*)(F.ws + WS_MERGED);
    const int lane = F.lane, i = lane & 15, g = lane >> 4;
    const int qg = item & 3, r = (item >> 2) & 63, bb = item >> 8;
    const int c0 = 16 * qg;
    int rs = r - 4; rs = rs < 0 ? 0 : (rs > 56 ? 56 : rs);
    int cs = c0 - 8; cs = cs < 0 ? 0 : (cs > 32 ? 32 : cs);
    LAS unsigned char* PL = wl; LAS unsigned char* VL = wl + 4096; LAS unsigned char* OL = wl + 8192;
    const size_t rowbase = (size_t)bb * T;
    float ssq[4] = {0.f, 0.f, 0.f, 0.f};
#pragma unroll 1
    for (int h = 0; h < 4; ++h) {
        bf16x8 qf[2];
        { const GAS bf16* qrow = proj + (rowbase + r * 64 + c0 + i) * NPROJP + C_NQ + h * 64 + 8 * g;
          qf[0] = *(const GAS bf16x8*)(qrow); qf[1] = *(const GAS bf16x8*)(qrow + 32); }
        f32x4 s[16];
#pragma unroll
        for (int kt = 0; kt < 16; ++kt) { const int kr = kt >> 1, hf = kt & 1;
            const GAS bf16* krow = proj + (rowbase + (rs + kr) * 64 + cs + 16 * hf + i) * NPROJP + C_NK + h * 64 + 8 * g;
            const bf16x8 k0 = *(const GAS bf16x8*)(krow), k1 = *(const GAS bf16x8*)(krow + 32);
            f32x4 a = (f32x4){0.f, 0.f, 0.f, 0.f};
            a = __builtin_amdgcn_mfma_f32_16x16x32_bf16(qf[0], k0, a, 0, 0, 0);
            a = __builtin_amdgcn_mfma_f32_16x16x32_bf16(qf[1], k1, a, 0, 0, 0);
            s[kt] = a; }
        float mx[4] = {-3e38f, -3e38f, -3e38f, -3e38f};
#pragma unroll
        for (int kt = 0; kt < 16; ++kt) { const int kr = kt >> 1, hf = kt & 1; const int cw = cs + 16 * hf + i; const int dy = rs + kr - r + 7;
#pragma unroll
            for (int e = 0; e < 4; ++e) { const int cq = c0 + 4 * g + e; int st = cq - 8; st = st < 0 ? 0 : (st > 48 ? 48 : st);
                int dx = cw - cq; dx = dx < -15 ? -15 : (dx > 15 ? 15 : dx); dx += 15;
                const bool valid = (cw >= st) && (cw < st + 16);
                float v = s[kt][e] * 0.125f + RPB[h * 465 + dy * 31 + dx];
                v = valid ? v : -1e30f; s[kt][e] = v; mx[e] = fmaxf(mx[e], v); } }
        float sm[4];
#pragma unroll
        for (int e = 0; e < 4; ++e) { mx[e] = row16_max(mx[e]); sm[e] = 0.f; }
#pragma unroll
        for (int kt = 0; kt < 16; ++kt)
#pragma unroll
            for (int e = 0; e < 4; ++e) { const float p = __expf(s[kt][e] - mx[e]); s[kt][e] = p; sm[e] += p; }
#pragma unroll
        for (int e = 0; e < 4; ++e) sm[e] = rcpf_(row16_sum(sm[e]));
        f32x4 oh[4];
#pragma unroll
        for (int dt = 0; dt < 4; ++dt) oh[dt] = (f32x4){0.f, 0.f, 0.f, 0.f};
        const GAS bf16* vsrc = proj + (rowbase + rs * 64 + cs + (lane >> 3)) * NPROJP + C_NV + h * 64 + 8 * (lane & 7);
        v4u vreg[4];
#pragma unroll
        for (int q = 0; q < 4; ++q) vreg[q] = *(const GAS v4u*)(vsrc + (size_t)(8 * q) * NPROJP);
#pragma unroll
        for (int half = 0; half < 2; ++half) {
            CFENCE();
#pragma unroll
            for (int k8 = 0; k8 < 8; ++k8) { const int kt = 8 * half + k8; v2u pw; pw.x = pk2(s[kt][0] * sm[0], s[kt][1] * sm[1]); pw.y = pk2(s[kt][2] * sm[2], s[kt][3] * sm[3]);
                *(LAS v2u*)(PL + (16 * k8 + i) * 32 + 8 * g) = pw; }
            CFENCE();
#pragma unroll
            for (int k4 = 0; k4 < 4; ++k4) { const int kr = 4 * half + k4;
                CFENCE();
#pragma unroll
                for (int q = 0; q < 4; ++q) *(LAS v4u*)(VL + ((lane >> 3) + 8 * q) * 128 + (lane & 7) * 16) = vreg[q];
                if (kr < 7) {
#pragma unroll
                    for (int q = 0; q < 4; ++q) vreg[q] = *(const GAS v4u*)(vsrc + (size_t)((kr + 1) * 64 + 8 * q) * NPROJP); }
                CFENCE();
                const LAS unsigned char* pa = PL + (32 * k4 + 8 * g + (i >> 2)) * 32 + 8 * (i & 3);
                const s16x4 plo = __builtin_bit_cast(s16x4, __builtin_amdgcn_ds_read_tr16_b64_v4i16((LAS s16x4*)(pa)));
                const s16x4 phi = __builtin_bit_cast(s16x4, __builtin_amdgcn_ds_read_tr16_b64_v4i16((LAS s16x4*)(pa + 128)));
                const bf16x8 pf = (bf16x8){plo[0], plo[1], plo[2], plo[3], phi[0], phi[1], phi[2], phi[3]};
#pragma unroll
                for (int dt = 0; dt < 4; ++dt) {
                    const LAS unsigned char* va = VL + (8 * g + (i >> 2)) * 128 + (16 * dt + 4 * (i & 3)) * 2;
                    const s16x4 vlo = __builtin_bit_cast(s16x4, __builtin_amdgcn_ds_read_tr16_b64_v4i16((LAS s16x4*)(va)));
                    const s16x4 vhi = __builtin_bit_cast(s16x4, __builtin_amdgcn_ds_read_tr16_b64_v4i16((LAS s16x4*)(va + 512)));
                    const bf16x8 vf = (bf16x8){vlo[0], vlo[1], vlo[2], vlo[3], vhi[0], vhi[1], vhi[2], vhi[3]};
                    oh[dt] = __builtin_amdgcn_mfma_f32_16x16x32_bf16(pf, vf, oh[dt], 0, 0, 0); }
            }
        }
        CFENCE();
#pragma unroll
        for (int dt = 0; dt < 4; ++dt)
#pragma unroll
            for (int e = 0; e < 4; ++e) { ssq[e] += oh[dt][e] * oh[dt][e]; *(LAS unsigned short*)(OL + (4 * g + e) * 512 + (h * 64 + 16 * dt + i) * 2) = (unsigned short)f2bf(oh[dt][e]); }
        CFENCE();
    }
    LAS float* SCL = (LAS float*)VL;
    CFENCE();
#pragma unroll
    for (int e = 0; e < 4; ++e) { const float sc = rsqf_(row16_sum(ssq[e]) * (1.f / 256.f) + NORM_EPS); if (i == 0) SCL[4 * g + e] = sc; }
    CFENCE();
#pragma unroll
    for (int q = 0; q < 8; ++q) { const int e = lane + 64 * q, row = e >> 5, ch = e & 31;
        const v4u v = *(const LAS v4u*)(OL + row * 512 + ch * 16); const float sc = SCL[row];
        v4u o;
#pragma unroll
        for (int t = 0; t < 4; ++t) o[t] = pk2(bflo(v[t]) * sc, bfhi(v[t]) * sc);
        *(GAS v4u*)(merged + (rowbase + r * 64 + c0 + row) * DM + 512 + 8 * ch) = o; }
    CFENCE();
}

constexpr int SG_PITCH = 528;
__device__ __forceinline__ void mix_sgu_item(Frame& F, int l, int item) {
    LAUNDER(F);
    const GAS bf16* proj = (const GAS bf16*)(F.ws + WS_PROJ); GAS bf16* merged = (GAS bf16*)(F.ws + WS_MERGED);
    const int lane = F.lane, w = F.wave, tid = F.tid, i = lane & 15, g = lane >> 4;
    const size_t m0 = (size_t)item * 128;
    LAS unsigned char* VI = F.lds; LAS float* SS = (LAS float*)(F.lds + 128 * SG_PITCH);
    { const int c4 = 4 * lane; const f32x4 gn = *(const f32x4*)(INP(F, I_SGUN) + l * 256 + c4);
      v2u xr[16];
#pragma unroll
      for (int j = 0; j < 16; ++j) xr[j] = *(const GAS v2u*)(proj + (m0 + 16 * w + j) * NPROJP + C_SV + c4);
#pragma unroll
      for (int j = 0; j < 16; ++j) { const int q = 16 * w + j; const v2u x = xr[j];
          f32x4 v = (f32x4){gelu_tanh(bflo(x.x)), gelu_tanh(bfhi(x.x)), gelu_tanh(bflo(x.y)), gelu_tanh(bfhi(x.y))};
          const float mu = wave_sum((v.x + v.y) + (v.z + v.w)) * (1.f / 256.f);
          v = v - mu;
          const float var = wave_sum((v.x * v.x + v.y * v.y) + (v.z * v.z + v.w * v.w)) * (1.f / 256.f);
          const float rstd = rsqf_(var + NORM_EPS);
          v2u o; o.x = pk2(v.x * rstd * gn.x, v.y * rstd * gn.y); o.y = pk2(v.z * rstd * gn.z, v.w * rstd * gn.w);
          *(LAS v2u*)(VI + q * SG_PITCH + c4 * 2) = o; } }
    __syncthreads();
    const int hh = w >> 1, ph = w & 1;
    f32x4 acc[4][4];
#pragma unroll
    for (int a = 0; a < 4; ++a)
#pragma unroll
        for (int b = 0; b < 4; ++b) acc[a][b] = (f32x4){0.f, 0.f, 0.f, 0.f};
    const GAS float* ws_ = INP(F, I_SGUW) + ((size_t)(l * 4 + hh) * 128) * 128;
#pragma unroll
    for (int ks = 0; ks < 4; ++ks) {
        bf16x8 af[4], bfr[4];
#pragma unroll
        for (int pt = 0; pt < 4; ++pt) { const GAS float* ap = ws_ + (size_t)(64 * ph + 16 * pt + i) * 128 + 32 * ks + 8 * g;
            const f32x4 x0 = *(const f32x4*)ap, x1 = *(const f32x4*)(ap + 4);
            const unsigned u0 = pk2(x0.x, x0.y), u1 = pk2(x0.z, x0.w), u2 = pk2(x1.x, x1.y), u3 = pk2(x1.z, x1.w);
            af[pt] = __builtin_bit_cast(bf16x8, (v4u){u0, u1, u2, u3}); }
#pragma unroll
        for (int dt = 0; dt < 4; ++dt) { const LAS unsigned char* va = VI + (32 * ks + 8 * g + (i >> 2)) * SG_PITCH + (hh * 64 + 16 * dt + 4 * (i & 3)) * 2;
            const s16x4 lo = __builtin_bit_cast(s16x4, __builtin_amdgcn_ds_read_tr16_b64_v4i16((LAS s16x4*)(va)));
            const s16x4 hi = __builtin_bit_cast(s16x4, __builtin_amdgcn_ds_read_tr16_b64_v4i16((LAS s16x4*)(va + 4 * SG_PITCH)));
            bfr[dt] = (bf16x8){lo[0], lo[1], lo[2], lo[3], hi[0], hi[1], hi[2], hi[3]}; }
#pragma unroll
        for (int pt = 0; pt < 4; ++pt)
#pragma unroll
            for (int dt = 0; dt < 4; ++dt) acc[pt][dt] = __builtin_amdgcn_mfma_f32_16x16x32_bf16(af[pt], bfr[dt], acc[pt][dt], 0, 0, 0);
    }
#pragma unroll
    for (int pt = 0; pt < 4; ++pt) {
        unsigned short ur[4][4];
#pragma unroll
        for (int e = 0; e < 4; ++e)
#pragma unroll
            for (int dt = 0; dt < 4; ++dt) ur[e][dt] = proj[(m0 + 64 * ph + 16 * pt + 4 * g + e) * NPROJP + C_SU + hh * 64 + 16 * dt + i];
#pragma unroll
        for (int e = 0; e < 4; ++e) { const int p = 64 * ph + 16 * pt + 4 * g + e; const float bs = INP(F, I_SGUB)[(l * 4 + hh) * 128 + p]; float ss = 0.f;
#pragma unroll
            for (int dt = 0; dt < 4; ++dt) { const float u = gelu_tanh(bf2f(ur[e][dt]));
                const float v = u * (acc[pt][dt][e] + bs); acc[pt][dt][e] = v; ss += v * v; }
            ss = row16_sum(ss); if (i == 0) SS[p * 4 + hh] = ss; } }
    __syncthreads();
#pragma unroll
    for (int pt = 0; pt < 4; ++pt)
#pragma unroll
        for (int e = 0; e < 4; ++e) { const int p = 64 * ph + 16 * pt + 4 * g + e; const f32x4 s4 = *(const LAS f32x4*)(SS + p * 4);
            const float sc = rsqf_(((s4.x + s4.y) + (s4.z + s4.w)) * (1.f / 256.f) + NORM_EPS);
#pragma unroll
            for (int dt = 0; dt < 4; ++dt) *(LAS unsigned short*)(VI + p * SG_PITCH + (hh * 64 + 16 * dt + i) * 2) = (unsigned short)f2bf(acc[pt][dt][e] * sc); }
    __syncthreads();
#pragma unroll
    for (int q = 0; q < 8; ++q) { const int e = tid + 512 * q, row = e >> 5, ch = e & 31;
        const v4u v = *(const LAS v4u*)(VI + row * SG_PITCH + ch * 16);
        *(GAS v4u*)(merged + (m0 + row) * DM + 768 + 8 * ch) = v; }
    __syncthreads();
}

__device__ __forceinline__ void phase_mix_na(Frame& F, int l, int bidx, int nblk) {
    LAUNDER(F);
    LAS float* RPB = (LAS float*)(F.lds + RING_BYTES + 1024);
    for (int q = F.tid; q < 4 * 465; q += NTHREADS) RPB[q] = INP(F, I_RPB)[l * 4 * 465 + q];
    __syncthreads();
    for (int it = bidx * NWAVES + F.wave; it < NB * 64 * 4; it += nblk * NWAVES) mix_na_item(F, l, it, F.lds + F.wave * 16384, RPB);
    __syncthreads();
#ifdef SGU_IN_C2
    for (int it = bidx; it < NB * 32; it += nblk) mix_sgu_item(F, l, it);
#endif
}
__device__ __forceinline__ void phase_mixers(Frame& F, int l) {
    LAUNDER(F);
    for (int tile = F.vcu; tile < M / 64; tile += F.G) mix_convprep_tile(F, l, tile);
    __syncthreads();
#ifndef SGU_IN_C2
    for (int it = F.vcu; it < NB * 32; it += F.G) mix_sgu_item(F, l, it);
#endif
}

constexpr int C1_VEC = 0, C1_VEC_D = 20480, C1_RES = 40960, C1_RES_D = 17664;
constexpr int C1_U = 0, C1_ZT = 4096, C1_ET = 8192, C1_QT = 12288, C1_CT = 16384, C1_DA = 17408;
typedef float f32x2 __attribute__((ext_vector_type(2)));
#define CK_DOT(a, b) ({ f32x2 t_ = (f32x2){(a).x, (a).y} * (f32x2){(b).x, (b).y}; t_ = __builtin_elementwise_fma((f32x2){(a).z, (a).w}, (f32x2){(b).z, (b).w}, t_); t_.x + t_.y; })
#define CK_RED2(a, b) do { a += dppmov<0xB1>(a); b += dppmov<0xB1>(b); a += dppmov<0x4E>(a); b += dppmov<0x4E>(b); a += dppmov<0x141>(a); b += dppmov<0x141>(b); a += dppmov<0x140>(a); b += dppmov<0x140>(b); } while (0)
__device__ __forceinline__ bf16x8 pack8(f32x4 lo, f32x4 hi) { return __builtin_bit_cast(bf16x8, (v4u){pg8::cvt_pk_bf16(lo.x, lo.y), pg8::cvt_pk_bf16(lo.z, lo.w), pg8::cvt_pk_bf16(hi.x, hi.y), pg8::cvt_pk_bf16(hi.z, hi.w)}); }
template <int MODE>
__device__ __forceinline__ void phase_scan_c1(Frame& F, int l) {
    LAUNDER(F);
    const GAS bf16* proj = (const GAS bf16*)(F.ws + WS_PROJ);
    const int lane = F.lane, w = F.wave, i = lane & 15, g = lane >> 4;
    const int d = w >> 2, wa = w & 3;
    const int bh = F.vcu >> 3, bb = bh >> 2, h = bh & 3;
    LAS unsigned char* lds = F.lds;
    bf16x8 Bw, Ba;
    { f32x4 xw0 = (f32x4){0.f, 0.f, 0.f, 0.f}, xw1 = xw0, xa0 = xw0, xa1 = xw0;
      if (g < 2) { const GAS float* pw = INP(F, I_RWUP) + ((size_t)(l * 2 + d) * 16 + 8 * g) * 256 + h * 64 + 16 * wa + i; const GAS float* pa = INP(F, I_RAUP) + ((size_t)(l * 2 + d) * 16 + 8 * g) * 256 + h * 64 + 16 * wa + i;
          xw0 = (f32x4){pw[0], pw[256], pw[512], pw[768]}; xw1 = (f32x4){pw[1024], pw[1280], pw[1536], pw[1792]};
          xa0 = (f32x4){pa[0], pa[256], pa[512], pa[768]}; xa1 = (f32x4){pa[1024], pa[1280], pa[1536], pa[1792]}; }
      Bw = pack8(xw0, xw1); Ba = pack8(xa0, xa1); }
    const float w0c = INP(F, I_RW0)[(l * 2 + d) * 256 + h * 64 + 16 * wa + i], a0c = INP(F, I_RA0)[(l * 2 + d) * 256 + h * 64 + 16 * wa + i], kag = INP(F, I_RKA)[l * 256 + h * 64 + 16 * wa + i];
    float kkg[4];
#pragma unroll
    for (int t = 0; t < 4; ++t) kkg[t] = INP(F, I_RKK)[l * 256 + h * 64 + 16 * t + i];
    const float kkgw = INP(F, I_RKK)[l * 256 + h * 64 + 16 * wa + i];
    const int cg = i, sel = g;
#define C1_BAR() do { asm volatile("s_waitcnt lgkmcnt(0)" ::: "memory"); __builtin_amdgcn_s_barrier(); asm volatile("" ::: "memory"); } while (0)
    unsigned short kq[4][4], kown[4], rq[4]; v4u dvr, ivr;
#define C1_LOAD(B_) do { const size_t m0_ = (size_t)bb * T + 16 * (B_); \
        _Pragma("unroll") for (int e_ = 0; e_ < 4; ++e_) { const GAS bf16* row_ = proj + (m0_ + 4 * g + e_) * NPROJP; \
            _Pragma("unroll") for (int t_ = 0; t_ < 4; ++t_) kq[t_][e_] = row_[C_K + h * 64 + 16 * t_ + i]; \
            rq[e_] = row_[C_R + h * 64 + 16 * wa + i]; kown[e_] = row_[C_K + h * 64 + 16 * wa + i]; } \
        { const GAS bf16* arow_ = proj + (m0_ + i) * NPROJP + C_DEC + 16 * d + 8 * (g & 1); dvr = *(const GAS v4u*)(arow_); ivr = *(const GAS v4u*)(arow_ + 32); } } while (0)
    C1_LOAD((F.vcu & 7) * 32);
    for (int it = 0; it < 32; ++it) {
        const int B = (F.vcu & 7) * 32 + it;
        if (MODE != 3) {
            v4u dv = (v4u){0u, 0u, 0u, 0u}, iv = dv;
            if (g < 2) { iv = ivr;
#pragma unroll
                for (int q = 0; q < 4; ++q) dv[q] = pk2(tanhf_(bflo(dvr[q])), tanhf_(bfhi(dvr[q]))); }
            const f32x4 z4 = (f32x4){0.f, 0.f, 0.f, 0.f};
            const f32x4 Dw = __builtin_amdgcn_mfma_f32_16x16x32_bf16(__builtin_bit_cast(bf16x8, dv), Bw, z4, 0, 0, 0);
            const f32x4 Da = __builtin_amdgcn_mfma_f32_16x16x32_bf16(__builtin_bit_cast(bf16x8, iv), Ba, z4, 0, 0, 0);
#pragma unroll
            for (int e = 0; e < 4; ++e) {
                float ss = 0.f;
#pragma unroll
                for (int t = 0; t < 4; ++t) { const float x = bf2f(kq[t][e]) * kkg[t]; ss += x * x; }
                ss = row16_sum(ss);
                const float k = bf2f(kown[e]); const float kk = k * kkgw * rsqf_(ss + 1e-12f);
                const float wv = __expf(-DECAY_SCALE * sigmoidf_(w0c + Dw[e])), av = sigmoidf_(a0c + Da[e]);
                const int tok = 4 * g + e, s = d ? 15 - tok : tok;
                LAS float* vp = (LAS float*)(lds + C1_VEC + d * C1_VEC_D + s * 1280) + 16 * wa + i;
                vp[0] = wv; vp[64] = kk; vp[128] = kk * av; vp[192] = k * (1.f + (av - 1.f) * kag); vp[256] = bf2f(rq[e]); }
        }
        if (it + 1 < 32) C1_LOAD(B + 1);
        C1_BAR();
        if (MODE != 1 && MODE != 4) {
            const LAS unsigned char* V = lds + C1_VEC + d * C1_VEC_D + cg * 16;
            LAS unsigned char* R = lds + C1_RES + d * C1_RES_D;
#define VLD(s_, vec_) (*(const LAS f32x4*)(V + (s_) * 1280 + (vec_) * 256))
            const unsigned Va = (unsigned)(size_t)V;
#define LD4(X, s_) asm volatile("ds_read_b128 %0, %4\n\tds_read_b128 %1, %4 offset:256\n\tds_read_b128 %2, %4 offset:512\n\tds_read_b128 %3, %4 offset:768" \
                : "=v"(X[0]), "=v"(X[1]), "=v"(X[2]), "=v"(X[3]) : "v"(Va + (unsigned)(s_) * 1280u) : "memory")
#define WT4(X, n_) asm volatile("s_waitcnt lgkmcnt(" #n_ ")" : "+v"(X[0]), "+v"(X[1]), "+v"(X[2]), "+v"(X[3]) :: "memory")
#define LD3(X, s_) asm volatile("ds_read_b128 %0, %3\n\tds_read_b128 %1, %3 offset:256\n\tds_read_b128 %2, %3 offset:512" \
                : "=v"(X[0]), "=v"(X[1]), "=v"(X[2]) : "v"(Va + (unsigned)(s_) * 1280u) : "memory")
#define WT3(X, n_) asm volatile("s_waitcnt lgkmcnt(" #n_ ")" : "+v"(X[0]), "+v"(X[1]), "+v"(X[2]) :: "memory")
            {
                const int s = 4 * wa + sel; f32x4 q = VLD(s, 4); float creg = 0.f;
                f32x4 A0[4], A1[4], A2[4];
#define QBODY_R(X) do { float d1 = CK_DOT(X[3], q), d2 = CK_DOT(X[2], q); CK_RED2(d1, d2); const bool act = j <= s; creg = (act && cg == j) ? d1 : creg; \
                    const f32x4 qn = X[0] * q - X[1] * d2; q = act ? qn : q; } while (0)
#define QBODY(X) do { float d1 = CK_DOT(X[3], q), d2 = CK_DOT(X[2], q); CK_RED2(d1, d2); creg = (cg == j) ? d1 : creg; q = X[0] * q - X[1] * d2; } while (0)
                int j = 4 * wa + 3;
                LD4(A0, j); LD4(A1, j - 1);
                LD4(A2, j - 2); WT4(A0, 8); QBODY_R(A0); --j;
                LD4(A0, j >= 2 ? j - 2 : 0); WT4(A1, 8); QBODY_R(A1); --j;
                LD4(A1, j >= 2 ? j - 2 : 0); WT4(A2, 8); QBODY_R(A2); --j;
                for (;;) {
                    LD4(A2, j >= 2 ? j - 2 : 0); WT4(A0, 8); QBODY(A0); if (--j < 0) break;
                    LD4(A0, j >= 2 ? j - 2 : 0); WT4(A1, 8); QBODY(A1); if (--j < 0) break;
                    LD4(A1, j >= 2 ? j - 2 : 0); WT4(A2, 8); QBODY(A2); if (--j < 0) break;
                }
                WT4(A0, 0); WT4(A1, 0); WT4(A2, 0);
#undef QBODY
#undef QBODY_R
                *(LAS f32x4*)(R + C1_QT + s * 256 + cg * 16) = q; *(LAS float*)(R + C1_CT + s * 64 + cg * 4) = creg;
            }
            {
                const int ga = 3 - wa, s = 4 * ga + sel; f32x4 u = VLD(s, 1);
                const int j0 = 4 * wa + sel; f32x4 x = VLD(j0, 3); f32x4 wz = (f32x4){1.f, 1.f, 1.f, 1.f};
                f32x4 U0[3], U1[3], U2[3], E0[3], E1[3], E2[3];
#define UBODY_R(X, Y) do { float d2 = CK_DOT(X[2], u), d3 = CK_DOT(x, Y[1]); CK_RED2(d2, d3); \
                    const f32x4 un = X[0] * u - X[1] * d2; u = (j < s) ? un : u; const bool act = ii > j0; \
                    const f32x4 xn = x * Y[0] - Y[2] * d3; x = act ? xn : x; wz = act ? wz * Y[0] : wz; } while (0)
#define UBODY(X, Y) do { float d2 = CK_DOT(X[2], u), d3 = CK_DOT(x, Y[1]); CK_RED2(d2, d3); u = X[0] * u - X[1] * d2; x = x * Y[0] - Y[2] * d3; wz = wz * Y[0]; } while (0)
                int j = 4 * ga + 2, ii = 4 * wa + 1;
                LD3(U0, j); LD3(E0, ii); LD3(U1, j >= 1 ? j - 1 : 0); LD3(E1, ii < 15 ? ii + 1 : 15);
                LD3(U2, j >= 2 ? j - 2 : 0); LD3(E2, ii < 14 ? ii + 2 : 15); WT3(U0, 12); WT3(E0, 12); UBODY_R(U0, E0); ++ii; --j;
                LD3(U0, j >= 2 ? j - 2 : 0); LD3(E0, ii < 14 ? ii + 2 : 15); WT3(U1, 12); WT3(E1, 12); UBODY_R(U1, E1); ++ii; --j;
                LD3(U1, j >= 2 ? j - 2 : 0); LD3(E1, ii < 14 ? ii + 2 : 15); WT3(U2, 12); WT3(E2, 12); UBODY_R(U2, E2); ++ii; --j;
                if (j >= 0) for (;;) {
                    LD3(U2, j >= 2 ? j - 2 : 0); LD3(E2, ii < 14 ? ii + 2 : 15); WT3(U0, 12); WT3(E0, 12); UBODY(U0, E0); ++ii; if (--j < 0) break;
                    LD3(U0, j >= 2 ? j - 2 : 0); LD3(E0, ii < 14 ? ii + 2 : 15); WT3(U1, 12); WT3(E1, 12); UBODY(U1, E1); ++ii; if (--j < 0) break;
                    LD3(U1, j >= 2 ? j - 2 : 0); LD3(E1, ii < 14 ? ii + 2 : 15); WT3(U2, 12); WT3(E2, 12); UBODY(U2, E2); ++ii; if (--j < 0) break;
                }
                WT3(U0, 0); WT3(U1, 0); WT3(U2, 0); WT3(E0, 0); WT3(E1, 0); WT3(E2, 0);
#undef UBODY
#undef UBODY_R
                LAS float* up = (LAS float*)(R + C1_U) + (4 * cg) * 16 + s; up[0] = u.x; up[16] = u.y; up[32] = u.z; up[48] = u.w;
                const f32x4 zb = VLD(j0, 2) * wz;
                LAS float* ep = (LAS float*)(R + C1_ET) + (4 * cg) * 16 + j0; ep[0] = x.x; ep[16] = x.y; ep[32] = x.z; ep[48] = x.w;
                LAS float* zp = (LAS float*)(R + C1_ZT) + (4 * cg) * 16 + j0; zp[0] = zb.x; zp[16] = zb.y; zp[32] = zb.z; zp[48] = zb.w;
                if (wa == 0 && sel == 0) *(LAS f32x4*)(R + C1_DA + cg * 16) = VLD(0, 0) * wz;
            }
#undef LD4
#undef WT4
#undef LD3
#undef WT3
#undef VLD
        }
        C1_BAR();
        if (MODE != 2 && MODE != 4) {
            const LAS unsigned char* R = lds + C1_RES + d * C1_RES_D;
            const int n = d ? 255 - B : B;
            GAS unsigned char* gt = (d ? (GAS unsigned char*)F.out : F.ws + WS_GT0) + ((size_t)(bb * 4 + h) * 256 + n) * GT_CHUNK;
            const int nt = wa;
            bf16x8 zf = (bf16x8){0, 0, 0, 0, 0, 0, 0, 0};
            if (g < 2) { const LAS f32x4* zp = (const LAS f32x4*)(R + C1_ZT + (16 * nt + i) * 64 + 32 * g); zf = pack8(zp[0], zp[1]); }
            f32x4 pp[4];
#pragma unroll
            for (int ct = 0; ct < 4; ++ct) {
                bf16x8 uf = (bf16x8){0, 0, 0, 0, 0, 0, 0, 0};
                if (g < 2) { const LAS f32x4* up = (const LAS f32x4*)(R + C1_U + (16 * ct + i) * 64 + 32 * g); uf = pack8(up[0], up[1]); }
                const f32x4 dd = __builtin_amdgcn_mfma_f32_16x16x32_bf16(uf, zf, (f32x4){0.f, 0.f, 0.f, 0.f}, 0, 0, 0);
                f32x4 pv = -dd;
                if (ct == nt) { const f32x4 da = *(const LAS f32x4*)(R + C1_DA + (16 * ct + 4 * g) * 4);
#pragma unroll
                    for (int e = 0; e < 4; ++e) if (4 * g + e == i) pv[e] += da[e]; }
                pp[ct] = pv; }
#define C1_ST(p_, v_) do { const bf16x8 v__ = (v_); if (MODE == 0) *(GAS bf16x8*)(p_) = v__; else asm volatile("" :: "v"(v__)); } while (0)
            C1_ST(gt + (nt * 2 + 0) * 1024 + lane * 16, pack8(pp[0], pp[1]));
            C1_ST(gt + (nt * 2 + 1) * 1024 + lane * 16, pack8(pp[2], pp[3]));
            if (g < 2) { const LAS f32x4* ep = (const LAS f32x4*)(R + C1_ET + (16 * nt + i) * 64 + 32 * g); C1_ST(gt + 10240 + nt * 512 + lane * 16, pack8(ep[0], ep[1])); }
            if (wa == 0) {
#pragma unroll
                for (int ks = 0; ks < 2; ++ks) { const LAS f32x4* qp = (const LAS f32x4*)(R + C1_QT + i * 256 + (32 * ks + 4 * g) * 4);
                    C1_ST(gt + (8 + ks) * 1024 + lane * 16, pack8(qp[0], qp[4])); }
                if (g < 2) { const LAS f32x4* cp = (const LAS f32x4*)(R + C1_CT + i * 64 + 32 * g); C1_ST(gt + 10240 + 4 * 512 + lane * 16, pack8(cp[0], cp[1])); }
            }
        }
    }
#undef C1_LOAD
#undef C1_BAR
    __syncthreads();
}
#define C2_BAR() do { asm volatile("s_waitcnt lgkmcnt(0)" ::: "memory"); __builtin_amdgcn_s_barrier(); asm volatile("" ::: "memory"); } while (0)
constexpr int C2_SLOT = 16384, C2_YOFF = 4 * C2_SLOT;
template <int MODE>
__device__ __forceinline__ void phase_scan_c2(Frame& F, int l) {
    LAUNDER(F);
    if (F.vcu >= 128) { if (MODE == 0) phase_mix_na(F, l, F.vcu - 128, 128); return; }
    const GAS bf16* proj = (const GAS bf16*)(F.ws + WS_PROJ);
    const int lane = F.lane, i = lane & 15, g = lane >> 4;
    LAS unsigned char* lds = F.lds;
    if (F.vcu < 128) {
    const int ci = F.vcu >> 1, tp = F.vcu & 1, d = ci >> 5, bb = (ci >> 2) & 7, h = ci & 3;
    for (int q = F.tid; q < 4 * 5 * 32; q += NTHREADS) { const int sl = q / 160, r = q % 160; *(LAS v4u*)(lds + sl * C2_SLOT + 10240 + (r >> 5) * 1024 + 512 + (r & 31) * 16) = (v4u){0u, 0u, 0u, 0u}; }
    __syncthreads();
    if (F.wave < 2) {
        const int cw = F.wave;
        f32x4 st[4];
#pragma unroll
        for (int t = 0; t < 4; ++t) st[t] = (f32x4){0.f, 0.f, 0.f, 0.f};
        v4u af[15], vf, nf[15], nvf;
#define C2_RD(AF, VF, c_) do { const LAS unsigned char* p_ = lds + ((c_) & 3) * C2_SLOT + lane * 16; \
            _Pragma("unroll") for (int f_ = 0; f_ < 15; ++f_) AF[f_] = *(const LAS v4u*)(p_ + f_ * 1024); \
            VF = *(const LAS v4u*)(lds + ((c_) & 3) * C2_SLOT + 15360 + cw * 512 + i * 32 + (g & 1) * 16); } while (0)
#define C2_STEP(AF, VF, NF, NVF, n_) do { \
            if ((n_) + 1 < 256) C2_RD(NF, NVF, (n_) + 1); \
            const bf16x8 b0_ = pack8(st[0], st[1]), b1_ = pack8(st[2], st[3]); const v4u vz_ = (g < 2) ? VF : (v4u){0u, 0u, 0u, 0u}; const bf16x8 bv_ = __builtin_bit_cast(bf16x8, vz_); \
            f32x4 o_[5]; \
            _Pragma("unroll") for (int nt = 0; nt < 5; ++nt) { if (MODE >= 2) { o_[nt] = __builtin_bit_cast(f32x4, AF[nt]) + __builtin_bit_cast(f32x4, AF[10 + nt]) * st[nt & 3]; continue; } \
                f32x4 a_ = __builtin_amdgcn_mfma_f32_16x16x32_bf16(__builtin_bit_cast(bf16x8, AF[nt * 2]), b0_, (f32x4){0.f, 0.f, 0.f, 0.f}, 0, 0, 0); \
                a_ = __builtin_amdgcn_mfma_f32_16x16x32_bf16(__builtin_bit_cast(bf16x8, AF[nt * 2 + 1]), b1_, a_, 0, 0, 0); \
                o_[nt] = __builtin_amdgcn_mfma_f32_16x16x32_bf16(__builtin_bit_cast(bf16x8, AF[10 + nt]), bv_, a_, 0, 0, 0); } \
            _Pragma("unroll") for (int t = 0; t < 4; ++t) st[t] = o_[t]; \
            { v2u yw_; yw_.x = pk2(o_[4].x, o_[4].y); yw_.y = pk2(o_[4].z, o_[4].w); \
              *(LAS v2u*)(lds + C2_YOFF + (cw * 8 + ((n_) & 7)) * 512 + i * 32 + g * 8) = yw_; }     \
            } while (0)
        C2_BAR();
        C2_RD(af, vf, 0);
        for (int n = 0; n < 256; n += 2) { C2_STEP(af, vf, nf, nvf, n); C2_STEP(nf, nvf, af, vf, n + 1); C2_BAR(); }
        C2_BAR();
#undef C2_STEP
#undef C2_RD
    } else {
        const int hl = F.tid - 128;
        const GAS unsigned char* gt = (d ? (const GAS unsigned char*)F.out : F.ws + WS_GT0) + ((size_t)(bb * 4 + h) * 256) * GT_CHUNK;
        GAS bf16* ysc = (GAS bf16*)(d ? (GAS unsigned char*)F.out + GT_DIR : F.ws + WS_YSC0) + (size_t)bb * T * 256 + h * 64 + 32 * tp;
        const int p0 = hl, p1 = hl + 384, p2 = hl + 768; const bool has2 = p2 < 800;
#define C2_OFF(p_) ((p_) < 640 ? (p_) * 16 : 10240 + (((p_) - 640) >> 5) * 1024 + (((p_) - 640) & 31) * 16)
        const int o0 = C2_OFF(p0), o1 = C2_OFF(p1), o2 = C2_OFF(has2 ? p2 : 799);
        const int e0 = hl, e1 = hl + 384; const bool hasv1 = e1 < 512;
        const GAS bf16* vs0 = proj + (size_t)bb * T * NPROJP + C_V + h * 64 + 32 * tp + 16 * (e0 >> 8) + (e0 & 15);
        const GAS bf16* vs1 = proj + (size_t)bb * T * NPROJP + C_V + h * 64 + 32 * tp + 16 * ((hasv1 ? e1 : 0) >> 8) + (e1 & 15);
        const int vt0 = (e0 >> 4) & 15, vt1 = (e1 >> 4) & 15;
        const int vo0 = 15360 + (e0 >> 8) * 512 + (e0 & 15) * 32 + vt0 * 2, vo1 = 15360 + ((hasv1 ? e1 : 0) >> 8) * 512 + (e1 & 15) * 32 + vt1 * 2;
        constexpr int RD = 12;
        v4u r0[RD], r1[RD], r2[RD]; unsigned short rv0[RD], rv1[RD];
        if (MODE == 1 || MODE == 3) {
#pragma unroll
            for (int k = 0; k < RD; ++k) { r0[k] = (v4u){1u, 2u, 3u, 4u}; r1[k] = r0[k]; r2[k] = r0[k]; rv0[k] = 0; rv1[k] = 0; } }
#define C2_GLD(k_, n_) do { if (MODE == 1 || MODE == 3) break; const GAS unsigned char* c_ = gt + (size_t)(n_) * GT_CHUNK; r0[k_] = *(const GAS v4u*)(c_ + p0 * 16); r1[k_] = *(const GAS v4u*)(c_ + p1 * 16); \
            if (has2) r2[k_] = *(const GAS v4u*)(c_ + p2 * 16); \
            { const int gs_ = 16 * (n_) + vt0, t_ = d ? (T - 1 - gs_) : gs_; rv0[k_] = vs0[(size_t)t_ * NPROJP]; } \
            if (hasv1) { const int gs_ = 16 * (n_) + vt1, t_ = d ? (T - 1 - gs_) : gs_; rv1[k_] = vs1[(size_t)t_ * NPROJP]; } } while (0)
#define C2_WR(k_, n_) do { LAS unsigned char* p_ = lds + ((n_) & 3) * C2_SLOT; *(LAS v4u*)(p_ + o0) = r0[k_]; *(LAS v4u*)(p_ + o1) = r1[k_]; if (has2) *(LAS v4u*)(p_ + o2) = r2[k_]; \
            *(LAS unsigned short*)(p_ + vo0) = rv0[k_]; if (hasv1) *(LAS unsigned short*)(p_ + vo1) = rv1[k_]; } while (0)
#define C2_YST(m_) do { if (hl < 64) { const int cw_ = hl >> 5, s_ = (hl >> 1) & 15, hf_ = hl & 1; const LAS unsigned short* yp_ = (const LAS unsigned short*)(lds + C2_YOFF + (cw_ * 8 + ((m_) & 7)) * 512) + s_; \
            v4u w_; _Pragma("unroll") for (int e_ = 0; e_ < 4; ++e_) w_[e_] = (unsigned)yp_[(8 * hf_ + 2 * e_) * 16] | ((unsigned)yp_[(8 * hf_ + 2 * e_ + 1) * 16] << 16); \
            const int gs_ = 16 * (m_) + s_, t_ = d ? (T - 1 - gs_) : gs_; if (MODE == 0) *(GAS v4u*)(ysc + (size_t)t_ * 256 + 16 * cw_ + 8 * hf_) = w_; else asm volatile("" :: "v"(w_)); } } while (0)
#pragma unroll
        for (int k = 0; k < RD; ++k) C2_GLD(k, k);
        C2_WR(0, 0); C2_GLD(0, RD); C2_WR(1, 1); C2_GLD(1, RD + 1); C2_WR(2, 2); C2_GLD(2, RD + 2);
        C2_BAR();
        for (int m6 = 0; m6 < 128; m6 += RD / 2) {
#pragma unroll
            for (int k = 0; k < RD / 2; ++k) { const int m = m6 + k;
                if (m < 128) {
                    const int ca = 2 * m + 3, cb = 2 * m + 4, ka = (2 * k + 3) % RD, kb = (2 * k + 4) % RD;
                    if (ca < 256) { C2_WR(ka, ca); if (ca + RD < 256) C2_GLD(ka, ca + RD); }
                    if (cb < 256) { C2_WR(kb, cb); if (cb + RD < 256) C2_GLD(kb, cb + RD); }
                    if (m > 0) { C2_YST(2 * m - 2); C2_YST(2 * m - 1); }
                    C2_BAR(); } }
        }
        C2_YST(254); C2_YST(255);
        C2_BAR();
#undef C2_GLD
#undef C2_WR
#undef C2_YST
#undef C2_OFF
    }
    }
    __syncthreads();
}
#undef C2_BAR
#undef CK_DOT
#undef CK_RED2

__device__ __forceinline__ void phase_rwkv_post(Frame& F, int l) {
    LAUNDER(F);
    const GAS bf16* proj = (const GAS bf16*)(F.ws + WS_PROJ); GAS bf16* merged = (GAS bf16*)(F.ws + WS_MERGED); const GAS bf16* ysc0 = (const GAS bf16*)(F.ws + WS_YSC0); const GAS bf16* ysc1 = (const GAS bf16*)((const GAS unsigned char*)F.out + GT_DIR);
    const int lane = F.lane, c4 = 4 * lane, hd = lane >> 4;
    LAS float* GUP = (LAS float*)F.lds;
    for (int q = F.tid; q < 32 * 256; q += NTHREADS) GUP[q] = INP(F, I_RGUP)[(size_t)l * 32 * 256 + q];
    __syncthreads();
    const f32x4 lw = *(const f32x4*)(INP(F, I_LNXW) + l * 256 + c4), lb = *(const f32x4*)(INP(F, I_LNXB) + l * 256 + c4), rk = *(const f32x4*)(INP(F, I_RRK) + l * 256 + c4);
    const int mstep = F.G * NWAVES; int m = F.vcu * NWAVES + F.wave;
    v2u n_yf, n_yb, n_r, n_k, n_v; unsigned short n_g;
#define POST_LOAD(mm) do { const GAS bf16* row_ = proj + (size_t)(mm) * NPROJP; n_yf = *(const GAS v2u*)(ysc0 + (size_t)(mm) * 256 + c4); n_yb = *(const GAS v2u*)(ysc1 + (size_t)(mm) * 256 + c4); \
        n_r = *(const GAS v2u*)(row_ + C_R + c4); n_k = *(const GAS v2u*)(row_ + C_K + c4); n_v = *(const GAS v2u*)(row_ + C_V + c4); n_g = row_[C_GDN + (lane & 31)]; } while (0)
    POST_LOAD(m);
    for (; m < M; m += mstep) {
        const v2u yf = n_yf, yb = n_yb, ru = n_r, ku = n_k, vu = n_v; const unsigned short gu = n_g;
        if (m + mstep < M) POST_LOAD(m + mstep);
        f32x4 y = (f32x4){bflo(yf.x) + bflo(yb.x), bfhi(yf.x) + bfhi(yb.x), bflo(yf.y) + bflo(yb.y), bfhi(yf.y) + bfhi(yb.y)};
        const float mu = row16_sum((y.x + y.y) + (y.z + y.w)) * (1.f / 64.f);
        y = y - mu;
        const float var = row16_sum((y.x * y.x + y.y * y.y) + (y.z * y.z + y.w * y.w)) * (1.f / 64.f);
        const float rstd = rsqf_(var + GN_EPS);
        y = y * rstd * lw + lb;
        const f32x4 r = (f32x4){bflo(ru.x), bfhi(ru.x), bflo(ru.y), bfhi(ru.y)}, k = (f32x4){bflo(ku.x), bfhi(ku.x), bflo(ku.y), bfhi(ku.y)}, v = (f32x4){bflo(vu.x), bfhi(vu.x), bflo(vu.y), bfhi(vu.y)};
        const f32x4 rkk = r * k * rk;
        const float bsum = row16_sum((rkk.x + rkk.y) + (rkk.z + rkk.w));
        y = y + v * bsum;
        const float gd = sigmoidf_(bf2f(gu));
        f32x4 gt = (f32x4){0.f, 0.f, 0.f, 0.f};
#pragma unroll
        for (int j = 0; j < 32; ++j) { const float gj = __builtin_bit_cast(float, __builtin_amdgcn_readlane(__builtin_bit_cast(int, gd), j)); gt = gt + *(const LAS f32x4*)(GUP + j * 256 + c4) * gj; }
        y = y * gt;
        const float ss = wave_sum((y.x * y.x + y.y * y.y) + (y.z * y.z + y.w * y.w));
        const float sc = rsqf_(ss * (1.f / 256.f) + NORM_EPS);
        v2u o; o.x = pk2(y.x * sc, y.y * sc); o.y = pk2(y.z * sc, y.w * sc);
        *(GAS v2u*)(merged + (size_t)m * DM + 256 + c4) = o;
    }
#undef POST_LOAD
    (void)hd;
}

__device__ __forceinline__ void phase_residual(Frame& F, const GAS float* gain, const bool IN_F32, const bool LAST) {
    LAUNDER(F);
    const GAS bf16* y = (const GAS bf16*)(F.ws + WS_Y); const GAS float* part = (const GAS float*)(F.ws + WS_PART);
    GAS bf16* xb = (GAS bf16*)(F.ws + WS_XB); GAS float* rs = (GAS float*)(F.ws + WS_RS); const GAS float* xin = INP(F, I_X);
    const int lane = F.lane;
    f32x4 gv[4];
#pragma unroll
    for (int j = 0; j < 4; ++j) gv[j] = *((const f32x4*)gain + lane + 64 * j);
    for (int m = F.vcu * NWAVES + F.wave; m < M; m += F.G * NWAVES) {
        const f32x4* pp = (const f32x4*)(part + (size_t)m * 16);
        const f32x4 p0 = *(const GAS f32x4*)(pp), p1 = *(const GAS f32x4*)(pp + 1), p2 = *(const GAS f32x4*)(pp + 2), p3 = *(const GAS f32x4*)(pp + 3);
        const float tot = ((p0.x + p0.y) + (p0.z + p0.w)) + ((p1.x + p1.y) + (p1.z + p1.w)) + ((p2.x + p2.y) + (p2.z + p2.w)) + ((p3.x + p3.y) + (p3.z + p3.w));
        const float sc = rsqf_(tot * (1.f / DM) + NORM_EPS);
        const GAS v2u* yr = (const GAS v2u*)(y + (size_t)m * DM) + lane;
        f32x4 v[4]; float s = 0.f;
#pragma unroll
        for (int j = 0; j < 4; ++j) { const v2u yu = yr[64 * j]; const f32x4 yv = (f32x4){bflo(yu.x), bfhi(yu.x), bflo(yu.y), bfhi(yu.y)};
            f32x4 xv;
            if (IN_F32) xv = ((const GAS f32x4*)(xin + (size_t)m * DM) + lane)[64 * j];
            else { const v2u xu = ((const GAS v2u*)(xb + (size_t)m * DM) + lane)[64 * j]; xv = (f32x4){bflo(xu.x), bfhi(xu.x), bflo(xu.y), bfhi(xu.y)}; }
            v[j] = xv + yv * sc * gv[j]; s += (v[j].x * v[j].x + v[j].y * v[j].y) + (v[j].z * v[j].z + v[j].w * v[j].w); }
        if (LAST) {
            GAS f32x4* orow = (GAS f32x4*)(F.out + (size_t)m * DM) + lane;
#pragma unroll
            for (int j = 0; j < 4; ++j) orow[64 * j] = v[j];
        } else {
            s = wave_sum(s);
            GAS v2u* o8 = (GAS v2u*)(xb + (size_t)m * DM) + lane;
#pragma unroll
            for (int j = 0; j < 4; ++j) { v2u o; o.x = pk2(v[j].x, v[j].y); o.y = pk2(v[j].z, v[j].w); o8[64 * j] = o; }
            if (lane == 0) rs[m] = rsqf_(s * (1.f / DM) + NORM_EPS);
        }
    }
}
__device__ __forceinline__ void phase_ffn_conv(Frame& F, int l) {
    LAUNDER(F);
    const GAS bf16* G = (const GAS bf16*)(F.ws + WS_G); GAS bf16* L = (GAS bf16*)(F.ws + WS_L);
    const GAS float* cw = INP(F, I_FCONV) + (size_t)l * 3 * DFF;
    constexpr int CPR = DFF / 8;
    const int nitems = (M / 256) * 2 * CPR;
    for (int it = F.vcu * NTHREADS + F.tid; it < nitems; it += F.G * NTHREADS) {
        const int ck = it % CPR, rr = it / CPR, m = (rr >> 1) * 256 + ((rr & 1) ? 255 : 0), t = m % T, c8 = 8 * ck;
        float w0[8], w1[8], w2[8];
#pragma unroll
        for (int j = 0; j < 8; ++j) { w0[j] = cw[c8 + j]; w1[j] = cw[DFF + c8 + j]; w2[j] = cw[2 * DFF + c8 + j]; }
        const v4u z = (v4u){0u, 0u, 0u, 0u};
        const v4u gp = (t > 0) ? *(const GAS v4u*)(G + (size_t)(m - 1) * DFF + c8) : z, gc = *(const GAS v4u*)(G + (size_t)m * DFF + c8), gn = (t < T - 1) ? *(const GAS v4u*)(G + (size_t)(m + 1) * DFF + c8) : z;
        const v4u lv = *(const GAS v4u*)(L + (size_t)m * DFF + c8);
        v4u o;
#pragma unroll
        for (int q = 0; q < 4; ++q) {
            const float a0 = w0[2 * q] * bflo(gp[q]) + w1[2 * q] * bflo(gc[q]) + w2[2 * q] * bflo(gn[q]);
            const float a1 = w0[2 * q + 1] * bfhi(gp[q]) + w1[2 * q + 1] * bfhi(gc[q]) + w2[2 * q + 1] * bfhi(gn[q]);
            o[q] = pk2(gelu_tanh(a0) * bflo(lv[q]), gelu_tanh(a1) * bfhi(lv[q])); }
        *(GAS v4u*)(L + (size_t)m * DFF + c8) = o;
    }
}

#ifndef MK_N_LAUNCHES
#define MK_N_LAUNCHES 1
#endif
constexpr int NPH = 1 + 8 * DEPTH;
struct Args { const float* in[26]; float* out; unsigned char* ws; int ph_lo, ph_hi; };
__global__ void __launch_bounds__(NTHREADS, 2) enc_fwd(Args args) {
    extern __shared__ __attribute__((aligned(16))) unsigned char lds_raw[];
    Frame F;
    F.lds = (LAS unsigned char*)lds_raw;
    F.MISC = (volatile LAS unsigned*)(F.lds + MISC_OFF);
    F.tid = threadIdx.x; F.lane = F.tid & 63; F.wave = __builtin_amdgcn_readfirstlane(F.tid >> 6);
    F.G = gridDim.x; { const int bx = blockIdx.x; F.vcu = (F.G % 8 == 0) ? (bx % 8) * (F.G / 8) + bx / 8 : bx; }
    F.ws = (GAS unsigned char*)args.ws; F.out = (GAS float*)args.out; F.ctl = (gu32*)(F.ws + WS_CTL);
    F.karg = (kq_t*)__builtin_amdgcn_kernarg_segment_ptr();
    for (int u = F.tid; u < (LDS_BYTES - LDSCTL_OFF) / 4; u += NTHREADS) ((LAS unsigned*)(F.lds + LDSCTL_OFF))[u] = 0u;
    __syncthreads();
    const int lo = args.ph_lo, hi = args.ph_hi;
    if (hi - lo > 1) (void)xcd_barrier_post((unsigned*)(F.ctl + CW_BAR), F.MISC + 8);
#define GRID_BAR() do { XcdBarrier bar_; bar_.bar = (unsigned*)(F.ctl + CW_BAR); bar_.x = xb_xcc_id(); bar_.st = F.MISC + 8; xcd_barrier(bar_); } while (0)
#ifndef PH_ENABLE
#define PH_ENABLE 0x7ff
#endif
#define IN(k) (lo <= (k) && (k) < hi)
#define EN(t) (((PH_ENABLE) >> (t)) & 1)
#pragma unroll 1
#ifdef REPEAT_T
    for (int step = lo; step < hi; ++step) {
        const int p1 = REPEAT_T, p2 = REPEAT_T + 8;
        const int ph = step - (step > p1 ? 1 : 0) - ((step > p2 + 1 && REPEAT_T != 7) ? 1 : 0);
#else
    for (int ph = lo; ph < hi; ++ph) {
#endif
        LAUNDER(F);
        const int l = ph == 0 ? 0 : (ph - 1) / 8, tt = ph == 0 ? 0 : 1 + (ph - 1) % 8;
        const int t = tt == 0 ? 0 : (tt == 1 ? 1 : (tt <= 5 ? tt + 1 : tt + 2));
        GAS unsigned char* wl = F.ws + WS_W + (size_t)l * W_LAYER;
      {
        if (t == 1 || t == 8) {
            pg8::Gemm g; pg8::EpiUni E;
            g.M = M; E.split_cols = 0; E.split_stride = 0; E.convw = nullptr; E.G = nullptr; E.xl = (pg8::PG8_LAS_T*)(F.lds + RING_BYTES + 1024); E.part = nullptr; E.rs = (const GAS float*)(F.ws + WS_RS);
            g.A = (const GAS bf16*)(F.ws + WS_XB); g.K = DM;
            if (t == 1) { g.Bt = (const GAS bf16*)(wl + W_IN); g.N = NPROJP; E.O = (GAS bf16*)(F.ws + WS_PROJ); E.ldc = NPROJP; }
            else        { g.Bt = (const GAS bf16*)(wl + W_UP); g.N = NUP;    E.O = (GAS bf16*)(F.ws + WS_L); E.ldc = DFF; E.convw = INP(F, I_FCONV) + (size_t)l * 3 * DFF; E.G = (GAS bf16*)(F.ws + WS_G); }
            g.Bt = launder_p(g.Bt); E.O = launder_p(E.O); E.convw = launder_p(E.convw); E.G = launder_p(E.G); g.N = launder_u(g.N); E.ldc = launder_u(E.ldc);
            g.A = launder_p(g.A); E.rs = launder_p(E.rs);
            pg8::StaticOrder S; S.init(M, g.N, F.G, (int)blockIdx.x);
            pg8::gemm_phase<pg8::EpiUni, pg8::StaticOrder, true, true>(F.lds, g, S, E);
        }
        else if (t == 6 || t == 10) {
            pg8::Gemm g; pg8::EpiResid E;
            g.M = M; g.N = DM; E.xl = (pg8::PG8_LAS_T*)(F.lds + RING_BYTES + 1024);
            E.xb = (GAS bf16*)(F.ws + WS_XB); E.outf = F.out; E.rsw = (GAS float*)(F.ws + WS_RS); E.xs = (GAS float*)(F.ws + WS_XS); E.resid = 1;
            if (t == 6) { g.A = (const GAS bf16*)(F.ws + WS_MERGED); g.Bt = (const GAS bf16*)(wl + W_OUT); g.K = DM;  E.gain = INP(F, I_NMPOST) + l * DM; E.cnt = (GAS unsigned*)(F.ctl + CW_PANEL) + (size_t)(l * 2 + 0) * 2 * 128 * 64; }
            else        { g.A = (const GAS bf16*)(F.ws + WS_L);      g.Bt = (const GAS bf16*)(wl + W_DN);  g.K = DFF; E.gain = INP(F, I_NFPOST) + l * DM; if (l + 1 == DEPTH) E.resid = 2; E.cnt = (GAS unsigned*)(F.ctl + CW_PANEL) + (size_t)(l * 2 + 1) * 2 * 128 * 64; }
            g.A = launder_p(g.A); g.Bt = launder_p(g.Bt); g.K = launder_u(g.K); E.gain = launder_p(E.gain); E.cnt = launder_p(E.cnt); E.resid = launder_u(E.resid);
            E.xb = launder_p(E.xb); E.outf = launder_p(E.outf); E.rsw = launder_p(E.rsw); E.xs = launder_p(E.xs);
            pg8::StaticOrder S; S.init(M, g.N, F.G, (int)blockIdx.x);
            pg8::gemm_phase<pg8::EpiResid, pg8::StaticOrder, true, true>(F.lds, g, S, E);
        }
        else if (t == 0) p0_prologue(F);
#ifdef C1_EXP
        else if (t == 3) { phase_mixers(F, l); phase_scan_c1<0>(F, l); phase_scan_c1<C1_EXP>(F, l); }
#else
        else if (t == 3) { phase_mixers(F, l); phase_scan_c1<0>(F, l); }
#endif
#ifdef C2_EXP
        else if (t == 4) { phase_scan_c2<0>(F, l); phase_scan_c2<C2_EXP>(F, l); }
#else
        else if (t == 4) phase_scan_c2<0>(F, l);
#endif
        else if (t == 5) phase_rwkv_post(F, l);
        else if (t == 9) phase_ffn_conv(F, l);
      }
#ifdef REPEAT_T
        if (step + 1 < hi) GRID_BAR();
#else
        if (ph + 1 < hi) GRID_BAR();
#endif
    }
}


#ifdef DBG_CHECK
__global__ void dbg_check(const void* buf, size_t n, int kind, int code, unsigned* flag) {
    bool bad = false;
    for (size_t i = (size_t)blockIdx.x * blockDim.x + threadIdx.x; i < n; i += (size_t)gridDim.x * blockDim.x) {
        float v;
        if (kind == 0) v = bf2f(((const unsigned short*)buf)[i]);
        else if (kind == 1) v = ((const float*)buf)[i];
        else v = (float)((const _Float16*)buf)[i];
        if (!(fabsf(v) < 1e30f)) bad = true;
    }
    if (bad) atomicMax(flag, (unsigned)(1000000 - code));
}
__global__ void dbg_report(float* out, const unsigned* flag) { if (threadIdx.x == 0 && blockIdx.x == 0) { const unsigned f = *flag; if (f) out[0] = 100000.f * (float)(10 + 1000000 - (int)f); } }
#endif
extern "C" void kernel_launch(void* const* d_in, const int* in_sizes, int n_in, void* d_out, int out_size, void* d_ws, size_t ws_size, hipStream_t stream) {
    static int grid = 0;
    if (grid == 0) {
        if (n_in != 26 || in_sizes[0] != M * DM || out_size != M * DM || ws_size < WS_END) { fprintf(stderr, "kernel_launch: unexpected shapes: n_in %d in0 %d out %d ws %zu (need >= %zu)\n", n_in, n_in > 0 ? in_sizes[0] : -1, out_size, ws_size, (size_t)WS_END); grid = -1; return; }
        int dev = 0, cus = 0, per_cu = 0;
        if (hipGetDevice(&dev) != hipSuccess || hipDeviceGetAttribute(&cus, hipDeviceAttributeMultiprocessorCount, dev) != hipSuccess) { grid = -1; return; }
        if (hipFuncSetAttribute((const void*)enc_fwd, hipFuncAttributeMaxDynamicSharedMemorySize, LDS_BYTES) != hipSuccess) { fprintf(stderr, "kernel_launch: hipFuncSetAttribute failed\n"); grid = -1; return; }
        if (hipOccupancyMaxActiveBlocksPerMultiprocessor(&per_cu, (const void*)enc_fwd, NTHREADS, LDS_BYTES) != hipSuccess || per_cu < 1) { fprintf(stderr, "kernel_launch: occupancy query says %d blocks per CU\n", per_cu); }
        (void)hipGetLastError();
        grid = cus;
        if (grid != 256) fprintf(stderr, "kernel_launch: %d CUs (built for 256)\n", grid);
    }
    if (grid < 0) return;
    (void)hipMemsetAsync((char*)d_ws + WS_CTL, 0, CTL_ZERO_BYTES, stream);
    Args a{};
    for (int i = 0; i < 26; ++i) a.in[i] = (const float*)d_in[i];
    a.out = (float*)d_out; a.ws = (unsigned char*)d_ws;
#if MK_N_LAUNCHES == 1
#ifdef REPEAT_T
    a.ph_lo = 0; a.ph_hi = NPH + (REPEAT_T == 7 ? 1 : 2);
#else
    a.ph_lo = 0; a.ph_hi = NPH;
#endif
    hipLaunchKernelGGL(enc_fwd, dim3(grid), dim3(NTHREADS), LDS_BYTES, stream, a);
#else
    for (int p = 0; p < NPH; ++p) { a.ph_lo = p; a.ph_hi = p + 1; hipLaunchKernelGGL(enc_fwd, dim3(grid), dim3(NTHREADS), LDS_BYTES, stream, a);
#ifdef DBG_CHECK
        unsigned* flag = (unsigned*)((char*)d_ws + 512 * 1024); char* ws = (char*)d_ws; const int t = p == 0 ? 0 : 1 + (p - 1) % 10;
#define CHK(ptr, n, kind, sub) hipLaunchKernelGGL(dbg_check, dim3(2048), dim3(256), 0, stream, (const void*)(ptr), (size_t)(n), kind, p * 4 + sub, flag)
        if (t == 0) { CHK(ws + WS_W, 2 * W_LAYER / 2, 0, 0); CHK(ws + WS_XB, (size_t)M * DM, 0, 1); CHK(ws + WS_RS, M, 1, 2); }
        if (t == 1) { CHK(ws + WS_PROJ, (size_t)M * NPROJP, 0, 0); }
        if (t == 2) { CHK(ws + WS_PREP, (size_t)64 * MiB, 2, 1); }
        if (t == 3) { CHK(d_out, (size_t)2 * M * 256, 0, 0); }
        if (t == 4) { CHK(ws + WS_MERGED, (size_t)M * DM, 0, 0); }
        if (t == 5 || t == 9) { CHK(ws + WS_Y, (size_t)M * DM, 1, 0); CHK(ws + WS_PART, (size_t)M * 16, 1, 1); }
        if (t == 6 || t == 10) { CHK(d_out, (size_t)M * DM, 1, 0); CHK(ws + WS_XB, (size_t)M * DM, 0, 1); CHK(ws + WS_RS, M, 1, 2); }
        if (t == 7) { CHK(ws + WS_G, (size_t)M * DFF, 0, 0); CHK(ws + WS_L, (size_t)M * DFF, 0, 1); }
        if (t == 8) { CHK(ws + WS_L, (size_t)M * DFF, 0, 0); }
        if (p == NPH - 1) hipLaunchKernelGGL(dbg_report, dim3(1), dim3(64), 0, stream, (float*)d_out, (const unsigned*)flag);
#endif
    }
#endif
}
```

```cpp
#include <hip/hip_runtime.h>
#include <cstdio>
#include <cstdint>
namespace pg8 {
#define PG8_LAS __attribute__((address_space(3)))
#define PG8_GAS __attribute__((address_space(1)))
typedef PG8_LAS unsigned char PG8_LAS_T;
typedef unsigned short bf16_t;
typedef short bf16x8 __attribute__((ext_vector_type(8)));
typedef float f32x4 __attribute__((ext_vector_type(4)));
typedef unsigned u32x4 __attribute__((ext_vector_type(4)));
constexpr int BM = 256, BK = 64, HALF = 128, HTB = HALF * BK * 2  , STAGE_BYTES = 8 * HTB, NXCD = 8, WGM = 4;

__host__ __device__ __forceinline__ int lds_byte(int r, int c) { const int st = (r >> 4) * 2 + (c >> 5), rr = r & 15, cc = c & 31, ob = rr * 64 + cc * 2; return st * 1024 + (ob ^ (((ob >> 9) & 1) << 5)); }
__host__ __device__ __forceinline__ void stage_rc(int b, int& R, int& C) { const int st = b / 1024, sb = b % 1024, swz = sb ^ (((sb >> 9) & 1) << 5); R = (st >> 1) * 16 + swz / 64; C = (st & 1) * 32 + (swz % 64) / 2; }
__host__ __device__ __forceinline__ int perm32(int rho) { const int n = rho >> 4, i = rho & 15; return 8 * (i >> 2) + 4 * n + (i & 3); }

struct Unit { int pm, pn; };
struct Gemm { const PG8_GAS bf16_t* A; const PG8_GAS bf16_t* Bt; int M, N, K; };

struct StaticOrder {
    int nM, nN, nwg, G, c;
    __host__ __device__ void init(int M, int N, int G_, int c_) { nM = M / BM; nN = N / BM; nwg = nM * nN; G = G_; c = c_; }
    __host__ __device__ bool next(int i, Unit& u) const {
        const long L = (long)i * G + c; if (L >= nwg) return false;
        int wgid = (int)L; { const int q = nwg / NXCD, r = nwg % NXCD, xcd = wgid % NXCD, off = wgid / NXCD; wgid = (xcd < r ? xcd * (q + 1) : r * (q + 1) + (xcd - r) * q) + off; }
        const int nig = WGM * nN, gid = wgid / nig, fm = gid * WGM, gsz = (nM - fm) < WGM ? (nM - fm) : WGM;
        u.pm = fm + ((wgid % nig) % gsz); u.pn = (wgid % nig) / gsz; return true;
    }
    __device__ __forceinline__ void a_ready(const Unit&) const {}
    __device__ __forceinline__ void done(const Unit&) const {}
};
typedef float f32x2c __attribute__((ext_vector_type(2)));
typedef __bf16 bf16x2c __attribute__((ext_vector_type(2)));
__device__ __forceinline__ unsigned cvt_pk_bf16(float lo, float hi) { const f32x2c v = {lo, hi}; return __builtin_bit_cast(unsigned, __builtin_convertvector(v, bf16x2c)); }
struct EpiUni {
    static constexpr bool AFTER_DRAIN = false;
    PG8_GAS bf16_t* O; int ldc; const PG8_GAS float* rs; int split_cols; size_t split_stride; PG8_GAS float* part;
    const PG8_GAS float* convw; PG8_GAS bf16_t* G; PG8_LAS unsigned char* xl;
    __device__ __forceinline__ bool perm() const { return true; }
    template <int CTRL> static __device__ __forceinline__ float dppo(float old, float x) { return __builtin_bit_cast(float, __builtin_amdgcn_update_dpp(__builtin_bit_cast(int, old), __builtin_bit_cast(int, x), CTRL, 0xF, 0xF, false)); }
    static __device__ __forceinline__ float gelu_t(float x) { const float u = 1.5957691216057308f * x * (1.f + 0.044715f * x * x); return x * __builtin_amdgcn_rcpf(1.f + __expf(-u)); }
    __device__ __forceinline__ void conv_epi(const f32x4 (&acc_)[2][2][4][2], const Unit& u, int wr, int wc, int fr, int fq) const {
        f32x4 (&acc)[2][2][4][2] = const_cast<f32x4 (&)[2][2][4][2]>(acc_);
        const int hcol = u.pn * HALF + wc * 32 + 8 * fq;
        const PG8_GAS float* rsp = rs + u.pm * BM + wr * 64 + fr;
        constexpr int LDH = 2816;
        const unsigned lane_off = (unsigned)((wr * 64 + fr) * LDH + hcol) * 2u;
        PG8_GAS char* Ob = (PG8_GAS char*)(O + (size_t)u.pm * BM * LDH); PG8_GAS char* Gb = (PG8_GAS char*)(G + (size_t)u.pm * BM * LDH);
        unsigned lp[2][4][2][2];
#pragma unroll
        for (int ai = 0; ai < 2; ++ai)
#pragma unroll
            for (int m = 0; m < 4; ++m) { const float r = rsp[ai * HALF + m * 16];
#pragma unroll
                for (int n = 0; n < 2; ++n) { const f32x4 l4 = acc[ai][1][m][n] * r; lp[ai][m][n][0] = cvt_pk_bf16(l4[0], l4[1]); lp[ai][m][n][1] = cvt_pk_bf16(l4[2], l4[3]); } }
#pragma unroll
        for (int ai = 0; ai < 2; ++ai) { const int k = 2 * ai + wr;
            if (fr == 0)  { const float r = rsp[ai * HALF]; PG8_LAS f32x4* p = (PG8_LAS f32x4*)(xl + ((k * 2 + 0) * 4 + wc) * 128 + fq * 32); p[0] = acc[ai][0][0][0] * r; p[1] = acc[ai][0][0][1] * r; }
            if (fr == 15) { const float r = rsp[ai * HALF + 48]; PG8_LAS f32x4* p = (PG8_LAS f32x4*)(xl + ((k * 2 + 1) * 4 + wc) * 128 + fq * 32); p[0] = acc[ai][0][3][0] * r; p[1] = acc[ai][0][3][1] * r; } }
        asm volatile("s_waitcnt lgkmcnt(0)" ::: "memory"); __builtin_amdgcn_s_barrier(); asm volatile("" ::: "memory");
#pragma unroll
        for (int ai = 0; ai < 2; ++ai) { const int k = 2 * ai + wr;
            float rsv[4];
#pragma unroll
            for (int m = 0; m < 4; ++m) { rsv[m] = rsp[ai * HALF + m * 16];
#pragma unroll
                for (int n = 0; n < 2; ++n) acc[ai][0][m][n] = acc[ai][0][m][n] * rsv[m]; }
            const int ku = k > 0 ? k - 1 : 0, kd = k < 3 ? k + 1 : 3;
#pragma unroll
            for (int n = 0; n < 2; ++n) {
                float w0[4], w1[4], w2[4];
#pragma unroll
                for (int j = 0; j < 4; ++j) { w0[j] = convw[hcol + 4 * n + j]; w1[j] = convw[LDH + hcol + 4 * n + j]; w2[j] = convw[2 * LDH + hcol + 4 * n + j]; }
                const f32x4 xt = *(const PG8_LAS f32x4*)(xl + ((ku * 2 + 1) * 4 + wc) * 128 + fq * 32 + n * 16), xb = *(const PG8_LAS f32x4*)(xl + ((kd * 2 + 0) * 4 + wc) * 128 + fq * 32 + n * 16);
#pragma unroll
                for (int m = 0; m < 4; ++m) { const int tr = 64 * k + 16 * m + fr; const unsigned coff = (unsigned)((ai * HALF + 16 * m) * LDH * 2 + 8 * n);
                    float hv[4];
#pragma unroll
                    for (int e = 0; e < 4; ++e) { const float cur = acc[ai][0][m][n][e];
                        const float upx = (m > 0) ? dppo<0x121>(0.f, acc[ai][0][m > 0 ? m - 1 : 0][n][e]) : xt[e];
                        const float dnx = (m < 3) ? dppo<0x12F>(0.f, acc[ai][0][m < 3 ? m + 1 : 3][n][e]) : xb[e];
                        const float up = dppo<0x111>(upx, cur), dn = dppo<0x101>(dnx, cur);
                        const float a = w0[e] * up + w1[e] * cur + w2[e] * dn;
                        const unsigned lw = lp[ai][m][n][e >> 1]; const float lv = (e & 1) ? __builtin_bit_cast(float, lw & 0xffff0000u) : __builtin_bit_cast(float, lw << 16);
                        hv[e] = (tr == 0 || tr == 255) ? lv : gelu_t(a) * lv; }
                    typedef unsigned u32x2_ __attribute__((ext_vector_type(2)));
                    u32x2_ w; w.x = cvt_pk_bf16(hv[0], hv[1]); w.y = cvt_pk_bf16(hv[2], hv[3]);
                    *(PG8_GAS u32x2_*)(Ob + coff + lane_off) = w;
                    if (tr <= 1 || tr >= 254) { u32x2_ gw; gw.x = cvt_pk_bf16(acc[ai][0][m][n][0], acc[ai][0][m][n][1]); gw.y = cvt_pk_bf16(acc[ai][0][m][n][2], acc[ai][0][m][n][3]);
                        *(PG8_GAS u32x2_*)(Gb + coff + lane_off) = gw; }
                    __builtin_amdgcn_sched_barrier(0); }
                asm volatile("" ::: "memory");
            }
        }
    }
    __device__ __forceinline__ void operator()(const f32x4 (&acc)[2][2][4][2], const Unit& u, int wr, int wc, int fr, int fq) const {
        if (convw != nullptr) { conv_epi(acc, u, wr, wc, fr, fq); return; }
        const int row0 = u.pm * BM + wr * 64 + fr; int colt = u.pn * BM; PG8_GAS bf16_t* base = O;
        if (split_cols) { const int t = colt / split_cols; base += (size_t)t * split_stride; colt -= t * split_cols; }
        const int col0 = colt + wc * 32 + 8 * fq;
        if (part == nullptr) {
#pragma unroll
            for (int ai = 0; ai < 2; ++ai)
#pragma unroll
                for (int m = 0; m < 4; ++m) { const int row = row0 + ai * HALF + m * 16; const float s = rs[row]; PG8_GAS bf16_t* rowp = base + (size_t)row * ldc + col0;
#pragma unroll
                    for (int bj = 0; bj < 2; ++bj) { const f32x4 v0 = acc[ai][bj][m][0] * s, v1 = acc[ai][bj][m][1] * s;
                        u32x4 w; w.x = cvt_pk_bf16(v0[0], v0[1]); w.y = cvt_pk_bf16(v0[2], v0[3]); w.z = cvt_pk_bf16(v1[0], v1[1]); w.w = cvt_pk_bf16(v1[2], v1[3]);
                        *(PG8_GAS u32x4*)(rowp + bj * HALF) = w; } }
        } else {
#pragma unroll
            for (int ai = 0; ai < 2; ++ai)
#pragma unroll
                for (int m = 0; m < 4; ++m) { const int row = row0 + ai * HALF + m * 16; PG8_GAS bf16_t* rowp = base + (size_t)row * ldc + col0; float ss = 0.f;
#pragma unroll
                    for (int bj = 0; bj < 2; ++bj) { const f32x4 v0 = acc[ai][bj][m][0], v1 = acc[ai][bj][m][1];
                        ss += ((v0[0] * v0[0] + v0[1] * v0[1]) + (v0[2] * v0[2] + v0[3] * v0[3])) + ((v1[0] * v1[0] + v1[1] * v1[1]) + (v1[2] * v1[2] + v1[3] * v1[3]));
                        u32x4 w; w.x = cvt_pk_bf16(v0[0], v0[1]); w.y = cvt_pk_bf16(v0[2], v0[3]); w.z = cvt_pk_bf16(v1[0], v1[1]); w.w = cvt_pk_bf16(v1[2], v1[3]);
                        *(PG8_GAS u32x4*)(rowp + bj * HALF) = w; }
                    ss += __shfl_xor(ss, 16); ss += __shfl_xor(ss, 32); if (fq == 0) part[(size_t)row * 16 + u.pn * 4 + wc] = ss; }
        }
    }
};
struct EpiResid {
    static constexpr bool AFTER_DRAIN = false;
    PG8_LAS unsigned char* xl;
    __device__ __forceinline__ bool perm() const { return true; }
    int resid; const PG8_GAS float* gain; PG8_GAS bf16_t* xb; PG8_GAS float* outf; PG8_GAS float* rsw; PG8_GAS float* xs; PG8_GAS unsigned* cnt;
    __device__ __forceinline__ void panel_sum(float (&ss)[2][4], const Unit& u, int wr, int wc, int fr, int fq, int which) const {
        PG8_LAS float* P = (PG8_LAS float*)xl; PG8_LAS float* S = (PG8_LAS float*)(xl + 4096);
        const int tid = threadIdx.x;
#pragma unroll
        for (int ai = 0; ai < 2; ++ai)
#pragma unroll
            for (int m = 0; m < 4; ++m) { float s = ss[ai][m]; s += __shfl_xor(s, 16); s += __shfl_xor(s, 32); if (fq == 0) P[(ai * HALF + wr * 64 + m * 16 + fr) * 4 + wc] = s; }
        asm volatile("s_waitcnt lgkmcnt(0)" ::: "memory"); __builtin_amdgcn_s_barrier(); asm volatile("" ::: "memory");
        PG8_GAS float* slot = xs + ((size_t)which * 32768 + (size_t)u.pm * BM) * 4;
        PG8_GAS unsigned* c = cnt + (which * 128 + u.pm) * 64;
        if (tid < 256) { const f32x4 p = *(const PG8_LAS f32x4*)(P + tid * 4); const float t4 = (p.x + p.y) + (p.z + p.w);
            __hip_atomic_store(slot + tid * 4 + u.pn, t4, __ATOMIC_RELAXED, __HIP_MEMORY_SCOPE_AGENT);
            asm volatile("s_waitcnt vmcnt(0)" ::: "memory");
            if ((tid & 63) == 0) __hip_atomic_fetch_add(c, 1u, __ATOMIC_RELAXED, __HIP_MEMORY_SCOPE_AGENT); }
        if (tid < 64) { unsigned spins = 0;
            while ((unsigned)__builtin_amdgcn_readfirstlane(__hip_atomic_load(c, __ATOMIC_RELAXED, __HIP_MEMORY_SCOPE_AGENT)) < 16u) { __builtin_amdgcn_s_sleep(2); if (++spins > (1u << 22)) break; }
            __builtin_amdgcn_fence(__ATOMIC_ACQUIRE, "agent"); asm volatile("s_waitcnt vmcnt(0)" ::: "memory"); }
        asm volatile("s_waitcnt lgkmcnt(0)" ::: "memory"); __builtin_amdgcn_s_barrier(); asm volatile("" ::: "memory");
        if (tid < 256) { float t = 0.f;
#pragma unroll
            for (int q = 0; q < 4; ++q) t += __hip_atomic_load(slot + tid * 4 + q, __ATOMIC_RELAXED, __HIP_MEMORY_SCOPE_AGENT);
            S[tid] = t; }
        asm volatile("s_waitcnt lgkmcnt(0)" ::: "memory"); __builtin_amdgcn_s_barrier(); asm volatile("" ::: "memory");
#pragma unroll
        for (int ai = 0; ai < 2; ++ai)
#pragma unroll
            for (int m = 0; m < 4; ++m) ss[ai][m] = S[ai * HALF + wr * 64 + m * 16 + fr];
        asm volatile("s_waitcnt lgkmcnt(0)" ::: "memory"); __builtin_amdgcn_s_barrier(); asm volatile("" ::: "memory");
    }
    static __device__ __forceinline__ f32x4 unlo(unsigned a, unsigned b) { return (f32x4){__builtin_bit_cast(float, a << 16), __builtin_bit_cast(float, a & 0xffff0000u), __builtin_bit_cast(float, b << 16), __builtin_bit_cast(float, b & 0xffff0000u)}; }
    __device__ __forceinline__ void resid_epi(const f32x4 (&acc_)[2][2][4][2], const Unit& u, int wr, int wc, int fr, int fq) const {
        f32x4 (&acc)[2][2][4][2] = const_cast<f32x4 (&)[2][2][4][2]>(acc_);
        const int col0 = u.pn * BM + wc * 32 + 8 * fq;
        const unsigned lane_e = (unsigned)((wr * 64 + fr) * 1024 + col0);
        PG8_GAS char* xbb = (PG8_GAS char*)(xb + (size_t)u.pm * BM * 1024); PG8_GAS char* outb = (PG8_GAS char*)(outf + (size_t)u.pm * BM * 1024);
        float ss[2][4];
#pragma unroll
        for (int ai = 0; ai < 2; ++ai)
#pragma unroll
            for (int m = 0; m < 4; ++m) { float s = 0.f;
#pragma unroll
                for (int bj = 0; bj < 2; ++bj) { const f32x4 v0 = acc[ai][bj][m][0], v1 = acc[ai][bj][m][1];
                    s += ((v0[0] * v0[0] + v0[1] * v0[1]) + (v0[2] * v0[2] + v0[3] * v0[3])) + ((v1[0] * v1[0] + v1[1] * v1[1]) + (v1[2] * v1[2] + v1[3] * v1[3]));
                    u32x4 p; p.x = cvt_pk_bf16(v0[0], v0[1]); p.y = cvt_pk_bf16(v0[2], v0[3]); p.z = cvt_pk_bf16(v1[0], v1[1]); p.w = cvt_pk_bf16(v1[2], v1[3]);
                    acc[ai][bj][m][0] = __builtin_bit_cast(f32x4, p); }
                ss[ai][m] = s; }
        panel_sum(ss, u, wr, wc, fr, fq, 0);
#pragma unroll
        for (int ai = 0; ai < 2; ++ai)
#pragma unroll
            for (int m = 0; m < 4; ++m) { const float sc = __builtin_amdgcn_rsqf(ss[ai][m] * (1.f / 1024.f) + 1e-6f); float s2 = 0.f;
                unsigned le = lane_e; asm volatile("" : "+v"(le));
#pragma unroll
                for (int bj = 0; bj < 2; ++bj) {
                    const unsigned ce = (unsigned)((ai * HALF + 16 * m) * 1024 + bj * HALF);
                    const u32x4 xw = *(const PG8_GAS u32x4*)(xbb + (size_t)(ce + le) * 2);
                    const u32x4 yw = __builtin_bit_cast(u32x4, acc[ai][bj][m][0]);
                    const f32x4 g0 = *(const PG8_GAS f32x4*)(gain + col0 + bj * HALF), g1 = *(const PG8_GAS f32x4*)(gain + col0 + bj * HALF + 4);
                    const f32x4 v0 = unlo(xw.x, xw.y) + unlo(yw.x, yw.y) * sc * g0, v1 = unlo(xw.z, xw.w) + unlo(yw.z, yw.w) * sc * g1;
                    s2 += ((v0[0] * v0[0] + v0[1] * v0[1]) + (v0[2] * v0[2] + v0[3] * v0[3])) + ((v1[0] * v1[0] + v1[1] * v1[1]) + (v1[2] * v1[2] + v1[3] * v1[3]));
                    if (resid == 2) { PG8_GAS f32x4* op = (PG8_GAS f32x4*)(outb + (size_t)(ce + le) * 4); op[0] = v0; op[1] = v1; }
                    else { u32x4 p; p.x = cvt_pk_bf16(v0[0], v0[1]); p.y = cvt_pk_bf16(v0[2], v0[3]); p.z = cvt_pk_bf16(v1[0], v1[1]); p.w = cvt_pk_bf16(v1[2], v1[3]); acc[ai][bj][m][0] = __builtin_bit_cast(f32x4, p); } }
                ss[ai][m] = s2; asm volatile("" ::: "memory"); }
        if (resid == 1) {
            panel_sum(ss, u, wr, wc, fr, fq, 1);
#pragma unroll
            for (int ai = 0; ai < 2; ++ai)
#pragma unroll
                for (int m = 0; m < 4; ++m) {
                    unsigned le = lane_e; asm volatile("" : "+v"(le)); unsigned rr = (unsigned)(wr * 64 + fr); asm volatile("" : "+v"(rr));
                    if (u.pn == 0 && wc == 0 && fq == 0) rsw[(size_t)u.pm * BM + ai * HALF + m * 16 + rr] = __builtin_amdgcn_rsqf(ss[ai][m] * (1.f / 1024.f) + 1e-6f);
#pragma unroll
                    for (int bj = 0; bj < 2; ++bj) { const unsigned ce = (unsigned)((ai * HALF + 16 * m) * 1024 + bj * HALF);
                        *(PG8_GAS u32x4*)(xbb + (size_t)(ce + le) * 2) = __builtin_bit_cast(u32x4, acc[ai][bj][m][0]); }
                    asm volatile("" ::: "memory"); }
        }
    }
    __device__ __forceinline__ void operator()(const f32x4 (&acc)[2][2][4][2], const Unit& u, int wr, int wc, int fr, int fq) const { resid_epi(acc, u, wr, wc, fr, fq); }
};
template <class Epi, class Sched, bool ALIGN_EPI = false, bool SP2 = false>
__device__ __forceinline__ void gemm_phase(PG8_LAS unsigned char* lds, const Gemm g, const Sched& S, const Epi& E) {
    int tid_ = threadIdx.x; asm volatile("" : "+v"(tid_));
    const int tid = tid_, wid = __builtin_amdgcn_readfirstlane(tid >> 6), lane = tid & 63, wr = wid >> 2, wc = wid & 3, fr = lane & 15, fq = lane >> 4;
    const int K = g.K, nt = K / BK;
    unsigned voffA[2], voffB[2];
#pragma unroll
    for (int i = 0; i < 2; ++i) { int R, C; stage_rc(tid * 16 + i * 8192, R, C); const int Rb = E.perm() ? ((R & ~31) + perm32(R & 31)) : R;
        voffA[i] = (unsigned)(R * K + C) * 2u; voffB[i] = (unsigned)(Rb * K + C) * 2u; }
    const size_t kstep = (size_t)(BK * 2);
    const size_t hstep = (size_t)HALF * K * 2;
    const size_t tstep = 2 * hstep;
    const unsigned ldsw = (unsigned)wid * 1024u;
    const int aoff = lds_byte(wr * 64 + fr, fq * 8), boff = lds_byte(wc * 32 + fr, fq * 8);
#define PG8_SA(b, h) (((b) * 2 + (h)) * HTB)
#define PG8_SB(b, h) ((4 + (b) * 2 + (h)) * HTB)
#define PG8_STAGE(bufoff, gbase, voff) do { _Pragma("unroll") for (int _i = 0; _i < 2; ++_i) \
        __builtin_amdgcn_global_load_lds((const PG8_GAS unsigned*)((const PG8_GAS char*)(gbase) + (voff)[_i]), (PG8_LAS unsigned*)(lds + (bufoff) + ldsw + _i * 8192), 16, 0, 0); } while (0)
#define PG8_LDA(dst, b, h) do { _Pragma("unroll") for (int m = 0; m < 4; ++m) _Pragma("unroll") for (int k = 0; k < 2; ++k) dst[m][k] = *(const PG8_LAS bf16x8*)(lds + PG8_SA(b, h) + aoff + m * 2048 + k * 1024); } while (0)
#define PG8_LDB(dst, b, h) do { _Pragma("unroll") for (int n = 0; n < 2; ++n) _Pragma("unroll") for (int k = 0; k < 2; ++k) dst[n][k] = *(const PG8_LAS bf16x8*)(lds + PG8_SB(b, h) + boff + n * 2048 + k * 1024); } while (0)
#define PG8_MMA(ai, bj, At, Bt) do { __builtin_amdgcn_s_setprio(1); _Pragma("unroll") for (int m = 0; m < 4; ++m) _Pragma("unroll") for (int n = 0; n < 2; ++n) _Pragma("unroll") for (int k = 0; k < 2; ++k) \
        acc[ai][bj][m][n] = __builtin_amdgcn_mfma_f32_16x16x32_bf16(Bt[n][k], At[m][k], acc[ai][bj][m][n], 0, 0, 0); __builtin_amdgcn_s_setprio(0); } while (0)
#define PG8_WAIT_V(n) asm volatile("s_waitcnt vmcnt(" #n ")" ::: "memory")
#define PG8_WAIT_L(n) asm volatile("s_waitcnt lgkmcnt(" #n ")" ::: "memory")
#define PG8_BAR __builtin_amdgcn_s_barrier()
#define PG8_SCHED __builtin_amdgcn_sched_barrier(0)
    Unit cur, nxt; int ui = 0;
    if (!S.next(0, cur)) return;
    f32x4 acc[2][2][4][2];
#pragma unroll
    for (int a = 0; a < 2; ++a)
#pragma unroll
        for (int b = 0; b < 2; ++b)
#pragma unroll
            for (int m = 0; m < 4; ++m)
#pragma unroll
                for (int n = 0; n < 2; ++n) acc[a][b][m][n] = (f32x4){0.f, 0.f, 0.f, 0.f};
    bf16x8 At[4][2], B0[2][2], B1[2][2];
    const PG8_GAS char* cA = (const PG8_GAS char*)g.A + (size_t)cur.pm * tstep; const PG8_GAS char* cB = (const PG8_GAS char*)g.Bt + (size_t)cur.pn * tstep;
    S.a_ready(cur);
    if constexpr (SP2) {
        PG8_STAGE(PG8_SB(0, 0), cB, voffB); PG8_STAGE(PG8_SB(0, 1), cB + hstep, voffB); PG8_STAGE(PG8_SA(0, 0), cA, voffA); PG8_STAGE(PG8_SA(0, 1), cA + hstep, voffA);
        if (wr == 1) PG8_BAR;
        PG8_WAIT_V(2); PG8_BAR;
        PG8_STAGE(PG8_SB(1, 0), cB + kstep, voffB); PG8_STAGE(PG8_SA(1, 0), cA + kstep, voffA); PG8_STAGE(PG8_SB(1, 1), cB + hstep + kstep, voffB);
        PG8_WAIT_V(6); PG8_BAR;
    } else {
        PG8_STAGE(PG8_SB(0, 0), cB, voffB); PG8_STAGE(PG8_SA(0, 0), cA, voffA); PG8_STAGE(PG8_SB(0, 1), cB + hstep, voffB); PG8_STAGE(PG8_SA(0, 1), cA + hstep, voffA);
        if (wr == 1) PG8_BAR;
        PG8_WAIT_V(4); PG8_BAR;
        PG8_STAGE(PG8_SB(1, 0), cB + kstep, voffB); PG8_STAGE(PG8_SA(1, 0), cA + kstep, voffA); PG8_STAGE(PG8_SB(1, 1), cB + hstep + kstep, voffB);
        PG8_WAIT_V(6); PG8_BAR;
    }
    for (;;) {
        const bool has_next = S.next(ui + 1, nxt);
        const PG8_GAS char* nA = has_next ? (const PG8_GAS char*)g.A + (size_t)nxt.pm * tstep : cA; const PG8_GAS char* nB = has_next ? (const PG8_GAS char*)g.Bt + (size_t)nxt.pn * tstep : cB;
        for (int t = 0; t < nt; t += 2) {
            const bool last = (t == nt - 2);
            const PG8_GAS char* a1 = cA + (size_t)(t + 1) * kstep;
            const PG8_GAS char* a2 = last ? nA : cA + (size_t)(t + 2) * kstep; const PG8_GAS char* b2 = last ? nB : cB + (size_t)(t + 2) * kstep;
            const PG8_GAS char* a3 = a2 + kstep; const PG8_GAS char* b3 = b2 + kstep;
            if (last && has_next) S.a_ready(nxt);
            if constexpr (SP2) {
            PG8_LDB(B0, 0, 0); PG8_LDB(B1, 0, 1); PG8_SCHED; PG8_LDA(At, 0, 0); PG8_STAGE(PG8_SA(1, 1), a1 + hstep, voffA);
            PG8_WAIT_V(8); PG8_WAIT_L(0); PG8_BAR; PG8_MMA(0, 0, At, B0); PG8_MMA(0, 1, At, B1); PG8_BAR; PG8_SCHED;
            PG8_LDA(At, 0, 1); PG8_STAGE(PG8_SB(0, 0), b2, voffB); PG8_STAGE(PG8_SB(0, 1), b2 + hstep, voffB); PG8_STAGE(PG8_SA(0, 0), a2, voffA);
            PG8_WAIT_V(8); PG8_WAIT_L(0); PG8_BAR; PG8_MMA(1, 0, At, B0); PG8_MMA(1, 1, At, B1); PG8_BAR; PG8_SCHED;
            PG8_LDB(B0, 1, 0); PG8_LDB(B1, 1, 1); PG8_SCHED; PG8_LDA(At, 1, 0); PG8_STAGE(PG8_SA(0, 1), a2 + hstep, voffA);
            PG8_WAIT_V(8); PG8_WAIT_L(0); PG8_BAR; PG8_MMA(0, 0, At, B0); PG8_MMA(0, 1, At, B1); PG8_BAR; PG8_SCHED;
            PG8_LDA(At, 1, 1); PG8_STAGE(PG8_SB(1, 0), b3, voffB); PG8_STAGE(PG8_SB(1, 1), b3 + hstep, voffB); PG8_STAGE(PG8_SA(1, 0), a3, voffA);
            PG8_WAIT_V(8); PG8_WAIT_L(0); PG8_BAR; PG8_MMA(1, 0, At, B0); PG8_MMA(1, 1, At, B1); PG8_BAR; PG8_SCHED;
            } else {
            PG8_LDB(B0, 0, 0); PG8_SCHED; PG8_LDA(At, 0, 0); PG8_STAGE(PG8_SA(1, 1), a1 + hstep, voffA);
            PG8_WAIT_L(8); PG8_BAR; PG8_WAIT_L(0); PG8_MMA(0, 0, At, B0); PG8_BAR; PG8_SCHED;
            PG8_LDB(B1, 0, 1); PG8_STAGE(PG8_SB(0, 0), b2, voffB);
            PG8_BAR; PG8_WAIT_L(0); PG8_MMA(0, 1, At, B1); PG8_BAR;
            PG8_LDA(At, 0, 1); PG8_STAGE(PG8_SA(0, 0), a2, voffA);
            PG8_BAR; PG8_WAIT_L(0); PG8_MMA(1, 0, At, B0); PG8_BAR; PG8_SCHED;
            PG8_STAGE(PG8_SB(0, 1), b2 + hstep, voffB);
            PG8_WAIT_V(6); PG8_BAR; PG8_MMA(1, 1, At, B1); PG8_BAR;
            PG8_LDB(B0, 1, 0); PG8_SCHED; PG8_LDA(At, 1, 0); PG8_STAGE(PG8_SA(0, 1), a2 + hstep, voffA);
            PG8_WAIT_L(8); PG8_BAR; PG8_WAIT_L(0); PG8_MMA(0, 0, At, B0); PG8_BAR; PG8_SCHED;
            PG8_LDB(B1, 1, 1); PG8_STAGE(PG8_SB(1, 0), b3, voffB);
            PG8_BAR; PG8_WAIT_L(0); PG8_MMA(0, 1, At, B1); PG8_BAR;
            PG8_LDA(At, 1, 1); PG8_STAGE(PG8_SA(1, 0), a3, voffA);
            PG8_BAR; PG8_WAIT_L(0); PG8_MMA(1, 0, At, B0); PG8_BAR; PG8_SCHED;
            PG8_STAGE(PG8_SB(1, 1), b3 + hstep, voffB);
            PG8_WAIT_V(6); PG8_BAR; PG8_MMA(1, 1, At, B1); PG8_BAR;
            }
        }
        if constexpr (ALIGN_EPI) { if (wr == 0) PG8_BAR; }
        if constexpr (!Epi::AFTER_DRAIN) { E(acc, cur, wr, wc, fr, fq); S.done(cur); }
        if (!has_next) break;
#pragma unroll
        for (int a = 0; a < 2; ++a)
#pragma unroll
            for (int b = 0; b < 2; ++b)
#pragma unroll
                for (int m = 0; m < 4; ++m)
#pragma unroll
                    for (int n = 0; n < 2; ++n) acc[a][b][m][n] = (f32x4){0.f, 0.f, 0.f, 0.f};
        cur = nxt; cA = nA; cB = nB; ++ui;
        if constexpr (ALIGN_EPI) { if (wr == 1) PG8_BAR; }
    }
    PG8_WAIT_V(0);
    if constexpr (!ALIGN_EPI) { if (wr == 0) PG8_BAR; }
    PG8_BAR;
    if constexpr (Epi::AFTER_DRAIN) { E.fused(acc, cur, wr, wc, fr, fq, lds, wid, lane); S.done(cur); }
#undef PG8_SA
#undef PG8_SB
#undef PG8_STAGE
#undef PG8_LDA
#undef PG8_LDB
#undef PG8_MMA
#undef PG8_WAIT_V
#undef PG8_WAIT_L
#undef PG8_BAR
#undef PG8_SCHED
}
}

constexpr int NB = 8, T = 4096, DM = 1024, M = NB * T, DEPTH = 2;
constexpr int NPROJ = 2912, NPROJP = 3072, DFF = 2816, NUP = 2 * DFF;
constexpr int C_CH = 0, C_CB = 256, C_CC = 512, C_R = 768, C_K = 1024, C_V = 1280, C_DEC = 1536, C_GDN = 1600, C_NQ = 1632, C_NK = 1888, C_NV = 2144, C_SU = 2400, C_SV = 2656;
constexpr float NORM_EPS = 1e-6f, GN_EPS = 64e-5f, DECAY_SCALE = 0.60653065971263342f;
constexpr int NWAVES = 8, NTHREADS = 512;
constexpr size_t MiB = 1u << 20;
constexpr size_t WS_CTL = 0, CTL_ZERO_BYTES = 1 * MiB;
constexpr size_t WS_RS = 1 * MiB;
constexpr size_t WS_PART = 1 * MiB + 256 * 1024;
constexpr size_t WS_W = 4 * MiB, W_LAYER = 24 * MiB + 512 * 1024;
constexpr size_t W_IN = 0, W_OUT = 6 * MiB, W_UP = 8 * MiB, W_DN = 19 * MiB;
constexpr size_t WS_XB = 53 * MiB;
constexpr size_t WS_R = 117 * MiB;
constexpr size_t WS_PROJ = WS_R, WS_MERGED = WS_R + 192 * MiB, WS_PREP = WS_R + 256 * MiB;
constexpr size_t GT_CHUNK = 12800, GT_DIR = (size_t)NB * 4 * 256 * GT_CHUNK;
constexpr size_t WS_GT0 = WS_PREP, WS_YSC0 = WS_PREP + 100 * MiB;
static_assert(GT_DIR == 100 * MiB, "GT size");
constexpr size_t WS_Y = WS_R;
constexpr size_t WS_G = WS_R, WS_L = WS_R + 176 * MiB;
constexpr size_t WS_END = 501 * MiB;
static_assert(WS_W + 2 * W_LAYER <= WS_XB && WS_PREP + 128 * MiB <= WS_END && WS_L + 176 * MiB <= WS_END && WS_PART + (size_t)M * 64 <= WS_W, "ws map");
constexpr int CW_BAR = 4096;
constexpr int CW_PANEL = 16384;
constexpr size_t WS_XS = WS_PART;
constexpr int RING_BYTES = 131072, LDSCTL_OFF = RING_BYTES, MISC_OFF = LDSCTL_OFF + 320, LDS_BYTES = 147456;

#define GAS __attribute__((address_space(1)))
#define LAS __attribute__((address_space(3)))
typedef unsigned short bf16;
typedef unsigned v4u __attribute__((ext_vector_type(4)));
typedef unsigned v2u __attribute__((ext_vector_type(2)));
typedef float f32x4 __attribute__((ext_vector_type(4)));
typedef short bf16x8 __attribute__((ext_vector_type(8)));
typedef short s16x4 __attribute__((ext_vector_type(4)));
typedef _Float16 h2 __attribute__((ext_vector_type(2)));
typedef GAS unsigned gu32;
#define RLX_AGENT __ATOMIC_RELAXED, __HIP_MEMORY_SCOPE_AGENT
__device__ __forceinline__ unsigned pk2(float lo, float hi) { return pg8::cvt_pk_bf16(lo, hi); }
__device__ __forceinline__ unsigned f2bf(float f) { return (unsigned)__builtin_bit_cast(unsigned short, (__bf16)f); }
__device__ __forceinline__ float bflo(unsigned w) { return __builtin_bit_cast(float, w << 16); }
__device__ __forceinline__ float bfhi(unsigned w) { return __builtin_bit_cast(float, w & 0xffff0000u); }
__device__ __forceinline__ float bf2f(unsigned short b) { return __builtin_bit_cast(float, (unsigned)b << 16); }
__device__ __forceinline__ h2 as_h2(unsigned u) { return __builtin_bit_cast(h2, u); }
template <int CTRL> __device__ __forceinline__ float dppmov(float x) { return __builtin_bit_cast(float, __builtin_amdgcn_update_dpp(0, __builtin_bit_cast(int, x), CTRL, 0xF, 0xF, true)); }
__device__ __forceinline__ float row16_sum(float x) { x += dppmov<0xB1>(x); x += dppmov<0x4E>(x); x += dppmov<0x141>(x); x += dppmov<0x140>(x); return x; }
typedef unsigned u32x2_t __attribute__((ext_vector_type(2)));
__device__ __forceinline__ float xor16_sum(float x) { const u32x2_t r = __builtin_amdgcn_permlane16_swap(__builtin_bit_cast(unsigned, x), __builtin_bit_cast(unsigned, x), false, false);
    const unsigned a = r.x, b = r.y; return __builtin_bit_cast(float, a) + __builtin_bit_cast(float, b); }
__device__ __forceinline__ float xor32_sum(float x) { const u32x2_t r = __builtin_amdgcn_permlane32_swap(__builtin_bit_cast(unsigned, x), __builtin_bit_cast(unsigned, x), false, false);
    const unsigned a = r.x, b = r.y; return __builtin_bit_cast(float, a) + __builtin_bit_cast(float, b); }
__device__ __forceinline__ float wave_sum(float v) { return xor32_sum(xor16_sum(row16_sum(v))); }
__device__ __forceinline__ float row16_max(float x) { x = fmaxf(x, dppmov<0xB1>(x)); x = fmaxf(x, dppmov<0x4E>(x)); x = fmaxf(x, dppmov<0x141>(x)); x = fmaxf(x, dppmov<0x140>(x)); return x; }
__device__ __forceinline__ float rcpf_(float x) { return __builtin_amdgcn_rcpf(x); }
__device__ __forceinline__ float rsqf_(float x) { return __builtin_amdgcn_rsqf(x); }
__device__ __forceinline__ float sigmoidf_(float x) { return rcpf_(1.f + __expf(-x)); }
__device__ __forceinline__ float tanhf_(float x) { return 1.f - 2.f * rcpf_(__expf(2.f * x) + 1.f); }
__device__ __forceinline__ float gelu_tanh(float x) { const float u = 1.5957691216057308f * x * (1.f + 0.044715f * x * x); return x * rcpf_(1.f + __expf(-u)); }
#define XB_TMO      128
#define XB_XCNT(j)  (256  + 64 * (j))
#define XB_XSUB(j)  (1280 + 64 * (j))
#define XB_XGEN(j)  (2304 + 64 * (j))
#define XB_TOP      3328
#define XB_TOPGEN   3392
#define XCD_BAR_WORDS 3456
#define XB_SPIN_CAP (1u << 18)

__device__ __forceinline__ unsigned xb_ld(unsigned* p)              { return __hip_atomic_load(p, __ATOMIC_RELAXED, __HIP_MEMORY_SCOPE_AGENT); }
__device__ __forceinline__ unsigned xb_add(unsigned* p, unsigned v) { return __hip_atomic_fetch_add(p, v, __ATOMIC_RELAXED, __HIP_MEMORY_SCOPE_AGENT); }
__device__ __forceinline__ unsigned xb_xcc_id() { return (unsigned)__builtin_amdgcn_s_getreg((3 << 11) | 20) & 0xFu; }
#define XB_SPIN(cond, bar) do { unsigned _sp = 0; while (cond) { __builtin_amdgcn_s_sleep(1); \
    if ((++_sp & 255u) == 0u) { if (xb_ld(&(bar)[XB_TMO])) break; if (_sp > XB_SPIN_CAP) { atomicAdd(&(bar)[XB_TMO], 1u); break; } } } } while (0)

struct XcdBarrier {
    unsigned* bar; unsigned x;
    volatile LAS unsigned* st;
};

__device__ __forceinline__ XcdBarrier xcd_barrier_post(unsigned* bar, volatile LAS unsigned* st) {
    XcdBarrier b; b.bar = bar; b.x = xb_xcc_id(); b.st = st;
    if (threadIdx.x == 0) (void)xb_add(&bar[XB_XCNT(b.x)], 1u);
    return b;
}
__device__ __forceinline__ void xcd_barrier_complete(unsigned* bar, unsigned x, unsigned& nloc, unsigned& nx) {
    const unsigned G = gridDim.x * gridDim.y * gridDim.z;
    unsigned sum, cnt, mine, sp = 0u;
    for (;;) {
        sum = 0u; cnt = 0u; mine = 0u;
#pragma unroll
        for (unsigned j = 0; j < 16; ++j) { const unsigned c = xb_ld(&bar[XB_XCNT(j)]); sum += c; cnt += (c > 0u) ? 1u : 0u; mine = (j == x) ? c : mine; }
        if (sum == G) break;
        __builtin_amdgcn_s_sleep(1);
        if ((++sp & 255u) == 0u) { if (xb_ld(&bar[XB_TMO])) break; if (sp > XB_SPIN_CAP) { atomicAdd(&bar[XB_TMO], 1u); break; } }
    }
    nloc = mine > 0u ? mine : 1u; nx = cnt > 0u ? cnt : 1u;
}

__device__ __forceinline__ void xcd_barrier(const XcdBarrier& b) {
    asm volatile("s_waitcnt vmcnt(0)" ::: "memory");
    __syncthreads();
    if (threadIdx.x == 0) {
        unsigned* bar = b.bar;
        __builtin_amdgcn_s_waitcnt(0);
        unsigned nloc = b.st[0], nx = b.st[1];
        if (nloc == 0u) { xcd_barrier_complete(bar, b.x, nloc, nx); b.st[0] = nloc; b.st[1] = nx; }
        const unsigned old = xb_add(&bar[XB_XSUB(b.x)], 1u);
        const unsigned gen = old / nloc;
        if (old + 1u == (gen + 1u) * nloc) {
            __builtin_amdgcn_fence(__ATOMIC_RELEASE, "agent");
            asm volatile("s_waitcnt vmcnt(0)" ::: "memory");
            const unsigned og = xb_add(&bar[XB_TOP], 1u);
            const unsigned tg = og / nx;
            if (og + 1u == (tg + 1u) * nx) xb_add(&bar[XB_TOPGEN], 1u);
            else XB_SPIN(xb_ld(&bar[XB_TOPGEN]) == tg, bar);
            __builtin_amdgcn_fence(__ATOMIC_ACQUIRE, "agent");
            xb_add(&bar[XB_XGEN(b.x)], 1u);
            asm volatile("s_waitcnt vmcnt(0)" ::: "memory");
        } else {
            XB_SPIN(xb_ld(&bar[XB_XGEN(b.x)]) == gen, bar);
            __builtin_amdgcn_fence(__ATOMIC_ACQUIRE, "agent");
            asm volatile("s_waitcnt vmcnt(0)" ::: "memory");
        }
    }
    __syncthreads();
}

typedef __attribute__((address_space(4))) const unsigned long long kq_t;
struct Frame {
    LAS unsigned char* lds;
    volatile LAS unsigned* MISC;
    gu32* ctl;
    int tid, lane, wave, vcu, G;
    kq_t* karg; GAS float* out; GAS unsigned char* ws;
};
#define INP(F, i) ((const GAS float*)(F).karg[(i)])
enum { I_X = 0, I_NMPRE, I_NMPOST, I_NFPRE, I_NFPOST, I_WIN, I_CONVW, I_RW0, I_RWUP, I_RA0, I_RAUP, I_RGUP, I_RKK, I_RKA, I_RRK, I_LNXW, I_LNXB, I_RPB, I_SGUN, I_SGUW, I_SGUB, I_MGAIN, I_WOUT, I_WUP, I_FCONV, I_WDN };
__device__ __forceinline__ int launder_u(int x) { asm volatile("" : "+v"(x)); return __builtin_amdgcn_readfirstlane(x); }
template <class P> __device__ __forceinline__ P launder_p(P p) { unsigned long long v = (unsigned long long)p; unsigned lo = (unsigned)v, hi = (unsigned)(v >> 32); asm volatile("" : "+v"(lo), "+v"(hi));
    lo = __builtin_amdgcn_readfirstlane(lo); hi = __builtin_amdgcn_readfirstlane(hi); return (P)(((unsigned long long)hi << 32) | lo); }
#define LAUNDER(F) do { asm volatile("" : "+v"((F).tid)); asm volatile("" : "+v"((F).lane)); (F).wave = launder_u((F).wave); (F).vcu = launder_u((F).vcu); (F).karg = launder_p((F).karg); (F).ws = launder_p((F).ws); (F).out = launder_p((F).out); } while (0)
#define LDS_WAIT() asm volatile("s_waitcnt lgkmcnt(0)" ::: "memory")
#define CFENCE() asm volatile("" ::: "memory")

__device__ __forceinline__ void p0_transpose_item(const GAS float* W, const GAS float* gain, int K, int N, GAS bf16* WT, LAS float* scr, int item, int lane, bool glmap = false) {
    const int nblk = N / 32, kb = item / nblk, nb = item % nblk, k0 = 64 * kb, n0 = 32 * nb;
    const int r0 = !glmap ? n0 : (n0 < N / 2 ? 256 * (n0 >> 7) + (n0 & 127) : 256 * ((n0 - N / 2) >> 7) + 128 + ((n0 - N / 2) & 127));
#pragma unroll 8
    for (int i = 0; i < 32; ++i) { const int kk = 2 * i + (lane >> 5); const float g = gain ? gain[k0 + kk] : 1.f; scr[kk * 33 + (lane & 31)] = W[(size_t)(k0 + kk) * N + n0 + (lane & 31)] * g; }
    LDS_WAIT(); CFENCE();
    const int c = lane & 7;
#pragma unroll
    for (int j = 0; j < 4; ++j) { const int n = (lane >> 3) + 8 * j; const LAS float* s = scr + (8 * c) * 33 + n;
        v4u o; o.x = pk2(s[0 * 33], s[1 * 33]); o.y = pk2(s[2 * 33], s[3 * 33]); o.z = pk2(s[4 * 33], s[5 * 33]); o.w = pk2(s[6 * 33], s[7 * 33]);
        *(GAS v4u*)(WT + (size_t)(r0 + n) * K + k0 + 8 * c) = o; }
    LDS_WAIT(); CFENCE();
}
__device__ __forceinline__ void row_to_bf16_rs(const GAS float* xrow, GAS bf16* orow, GAS float* rs, int lane) {
    const GAS f32x4* xr = (const GAS f32x4*)xrow + lane;
    f32x4 v[4]; float s = 0.f;
#pragma unroll
    for (int j = 0; j < 4; ++j) { v[j] = xr[64 * j]; s += (v[j].x * v[j].x + v[j].y * v[j].y) + (v[j].z * v[j].z + v[j].w * v[j].w); }
    s = wave_sum(s);
    GAS v2u* o8 = (GAS v2u*)orow + lane;
#pragma unroll
    for (int j = 0; j < 4; ++j) { v2u o; o.x = pk2(v[j].x, v[j].y); o.y = pk2(v[j].z, v[j].w); o8[64 * j] = o; }
    if (lane == 0) *rs = rsqf_(s * (1.f / DM) + NORM_EPS);
}
__device__ __forceinline__ void p0_prologue(Frame& F) {
    LAUNDER(F);
    LAS float* scr = (LAS float*)(F.lds + F.wave * 16384);
    const int gw = F.vcu * NWAVES + F.wave, NGW = F.G * NWAVES;
    constexpr int I_IN = (DM / 64) * (NPROJ / 32), I_OUT = (DM / 64) * (DM / 32), I_UP = (DM / 64) * (NUP / 32), I_DN = (DFF / 64) * (DM / 32), I_L = I_IN + I_OUT + I_UP + I_DN;
    for (int it = gw; it < DEPTH * I_L; it += NGW) {
        const int l = it / I_L; int r = it % I_L; GAS unsigned char* wl = F.ws + WS_W + (size_t)l * W_LAYER;
        if (r < I_IN) { p0_transpose_item(INP(F, I_WIN) + (size_t)l * DM * NPROJ, INP(F, I_NMPRE) + l * DM, DM, NPROJ, (GAS bf16*)(wl + W_IN), scr, r, F.lane); continue; } r -= I_IN;
        if (r < I_OUT) { p0_transpose_item(INP(F, I_WOUT) + (size_t)l * DM * DM, INP(F, I_MGAIN) + l * DM, DM, DM, (GAS bf16*)(wl + W_OUT), scr, r, F.lane); continue; } r -= I_OUT;
        if (r < I_UP) { p0_transpose_item(INP(F, I_WUP) + (size_t)l * DM * NUP, INP(F, I_NFPRE) + l * DM, DM, NUP, (GAS bf16*)(wl + W_UP), scr, r, F.lane, true); continue; } r -= I_UP;
        p0_transpose_item(INP(F, I_WDN) + (size_t)l * DFF * DM, nullptr, DFF, DM, (GAS bf16*)(wl + W_DN), scr, r, F.lane);
    }
    unsigned zz = 0u; asm volatile("" : "+v"(zz));
    for (int i = F.vcu * NTHREADS + F.tid; i < DEPTH * 20480; i += F.G * NTHREADS) { const int l = i / 20480, r = i % 20480;
        *(GAS v4u*)(F.ws + WS_W + (size_t)l * W_LAYER + W_IN + (size_t)NPROJ * DM * 2 + (size_t)r * 16) = (v4u){zz, zz, zz, zz}; }
    for (int m = gw; m < M; m += NGW) row_to_bf16_rs(INP(F, I_X) + (size_t)m * DM, (GAS bf16*)(F.ws + WS_XB) + (size_t)m * DM, (GAS float*)(F.ws + WS_RS) + m, F.lane);
}

typedef float f32x16 __attribute__((ext_vector_type(16)));
__device__ __forceinline__ void mix_convprep_tile(Frame& F, int l, int tile) {
    LAUNDER(F);
    const GAS bf16* proj = (const GAS bf16*)(F.ws + WS_PROJ); GAS bf16* merged = (GAS bf16*)(F.ws + WS_MERGED);
    const int m0 = tile * 64, bb = m0 / T, t0 = m0 % T;
    const int lane = F.lane, w = F.wave;
    {
        const int c4 = 4 * lane; const GAS float* cw = INP(F, I_CONVW) + l * 768;
        const f32x4 w0 = *(const f32x4*)(cw + c4), w1 = *(const f32x4*)(cw + 256 + c4), w2 = *(const f32x4*)(cw + 512 + c4);
        const int ts = t0 + 8 * w;
        v2u hr[10], cr[10], br[8];
#pragma unroll
        for (int j = 0; j < 10; ++j) { const int t = ts - 1 + j; const bool ok = (t >= 0 && t < T); const GAS bf16* row = proj + (size_t)(bb * T + (ok ? t : ts)) * NPROJP;
            hr[j] = *(const GAS v2u*)(row + C_CH + c4); cr[j] = *(const GAS v2u*)(row + C_CC + c4); if (!ok) { hr[j] = (v2u){0u, 0u}; } }
#pragma unroll
        for (int j = 0; j < 8; ++j) { const GAS bf16* row = proj + (size_t)(bb * T + ts + j) * NPROJP; br[j] = *(const GAS v2u*)(row + C_CB + c4); }
#pragma unroll
        for (int i = 0; i < 8; ++i) { const int t = ts + i;
            f32x4 z[3];
#pragma unroll
            for (int q = 0; q < 3; ++q) { const v2u h = hr[i + q], c = cr[i + q]; z[q] = (f32x4){bflo(h.x) * bflo(c.x), bfhi(h.x) * bfhi(c.x), bflo(h.y) * bflo(c.y), bfhi(h.y) * bfhi(c.y)}; }
            const v2u b = br[i];
            const f32x4 bv = (f32x4){bflo(b.x), bfhi(b.x), bflo(b.y), bfhi(b.y)};
            const f32x4 y = bv * (w0 * z[0] + w1 * z[1] + w2 * z[2]);
            float ss = (y.x * y.x + y.y * y.y) + (y.z * y.z + y.w * y.w); ss = wave_sum(ss);
            const float sc = rsqf_(ss * (1.f / 256.f) + NORM_EPS);
            v2u o; o.x = pk2(y.x * sc, y.y * sc); o.y = pk2(y.z * sc, y.w * sc);
            *(GAS v2u*)(merged + (size_t)(bb * T + t) * DM + 0 + c4) = o;
}
    }
}

__device__ __forceinline__ void mix_na_item(Frame& F, int l, int item, LAS unsigned char* wl, const LAS float* RPB) {
    LAUNDER(F);
    const GAS bf16* proj = (const GAS bf16*)(F.ws + WS_PROJ); GAS bf16* merged = (GAS bf16*)(F.ws + WS_MERGED);
    const int lane = F.lane, i = lane & 15, g = lane >> 4;
    const int qg = item & 3, r = (item >> 2) & 63, bb = item >> 8;
    const int c0 = 16 * qg;
    int rs = r - 4; rs = rs < 0 ? 0 : (rs > 56 ? 56 : rs);
    int cs = c0 - 8; cs = cs < 0 ? 0 : (cs > 32 ? 32 : cs);
    LAS unsigned char* PL = wl; LAS unsigned char* VL = wl + 4096; LAS unsigned char* OL = wl + 8192;
    const size_t rowbase = (size_t)bb * T;
    float ssq[4] = {0.f, 0.f, 0.f, 0.f};
#pragma unroll 1
    for (int h = 0; h < 4; ++h) {
        bf16x8 qf[2];
        { const GAS bf16* qrow = proj + (rowbase + r * 64 + c0 + i) * NPROJP + C_NQ + h * 64 + 8 * g;
          qf[0] = *(const GAS bf16x8*)(qrow); qf[1] = *(const GAS bf16x8*)(qrow + 32); }
        f32x4 s[16];
#pragma unroll
        for (int kt = 0; kt < 16; ++kt) { const int kr = kt >> 1, hf = kt & 1;
            const GAS bf16* krow = proj + (rowbase + (rs + kr) * 64 + cs + 16 * hf + i) * NPROJP + C_NK + h * 64 + 8 * g;
            const bf16x8 k0 = *(const GAS bf16x8*)(krow), k1 = *(const GAS bf16x8*)(krow + 32);
            f32x4 a = (f32x4){0.f, 0.f, 0.f, 0.f};
            a = __builtin_amdgcn_mfma_f32_16x16x32_bf16(qf[0], k0, a, 0, 0, 0);
            a = __builtin_amdgcn_mfma_f32_16x16x32_bf16(qf[1], k1, a, 0, 0, 0);
            s[kt] = a; }
        const GAS bf16* vsrc = proj + (rowbase + rs * 64 + cs + (lane >> 3)) * NPROJP + C_NV + h * 64 + 8 * (lane & 7);
        v4u vreg[4][4];
#pragma unroll
        for (int k4 = 0; k4 < 4; ++k4)
#pragma unroll
            for (int q = 0; q < 4; ++q) vreg[k4][q] = *(const GAS v4u*)(vsrc + (size_t)(k4 * 64 + 8 * q) * NPROJP);
        float mx[4] = {-3e38f, -3e38f, -3e38f, -3e38f};
#pragma unroll
        for (int kt = 0; kt < 16; ++kt) { const int kr = kt >> 1, hf = kt & 1; const int cw = cs + 16 * hf + i; const int dy = rs + kr - r + 7;
#pragma unroll
            for (int e = 0; e < 4; ++e) { const int cq = c0 + 4 * g + e; int st = cq - 8; st = st < 0 ? 0 : (st > 48 ? 48 : st);
                int dx = cw - cq; dx = dx < -15 ? -15 : (dx > 15 ? 15 : dx); dx += 15;
                const bool valid = (cw >= st) && (cw < st + 16);
                float v = s[kt][e] * 0.125f + RPB[h * 465 + dy * 31 + dx];
                v = valid ? v : -1e30f; s[kt][e] = v; mx[e] = fmaxf(mx[e], v); } }
        float sm[4];
#pragma unroll
        for (int e = 0; e < 4; ++e) { mx[e] = row16_max(mx[e]); sm[e] = 0.f; }
#pragma unroll
        for (int kt = 0; kt < 16; ++kt)
#pragma unroll
            for (int e = 0; e < 4; ++e) { const float p = __expf(s[kt][e] - mx[e]); s[kt][e] = p; sm[e] += p; }
#pragma unroll
        for (int e = 0; e < 4; ++e) sm[e] = rcpf_(row16_sum(sm[e]));
        f32x4 oh[4];
#pragma unroll
        for (int dt = 0; dt < 4; ++dt) oh[dt] = (f32x4){0.f, 0.f, 0.f, 0.f};
#pragma unroll
        for (int half = 0; half < 2; ++half) {
            CFENCE();
#pragma unroll
            for (int k8 = 0; k8 < 8; ++k8) { const int kt = 8 * half + k8; v2u pw; pw.x = pk2(s[kt][0] * sm[0], s[kt][1] * sm[1]); pw.y = pk2(s[kt][2] * sm[2], s[kt][3] * sm[3]);
                *(LAS v2u*)(PL + (16 * k8 + i) * 32 + 8 * g) = pw; }
            CFENCE();
#pragma unroll
            for (int k4 = 0; k4 < 4; ++k4) { const int kr = 4 * half + k4;
                CFENCE();
#pragma unroll
                for (int q = 0; q < 4; ++q) *(LAS v4u*)(VL + ((lane >> 3) + 8 * q) * 128 + (lane & 7) * 16) = vreg[k4][q];
                if (half == 0) {
#pragma unroll
                    for (int q = 0; q < 4; ++q) vreg[k4][q] = *(const GAS v4u*)(vsrc + (size_t)((kr + 4) * 64 + 8 * q) * NPROJP); }
                CFENCE();
                const LAS unsigned char* pa = PL + (32 * k4 + 8 * g + (i >> 2)) * 32 + 8 * (i & 3);
                const s16x4 plo = __builtin_bit_cast(s16x4, __builtin_amdgcn_ds_read_tr16_b64_v4i16((LAS s16x4*)(pa)));
                const s16x4 phi = __builtin_bit_cast(s16x4, __builtin_amdgcn_ds_read_tr16_b64_v4i16((LAS s16x4*)(pa + 128)));
                const bf16x8 pf = (bf16x8){plo[0], plo[1], plo[2], plo[3], phi[0], phi[1], phi[2], phi[3]};
#pragma unroll
                for (int dt = 0; dt < 4; ++dt) {
                    const LAS unsigned char* va = VL + (8 * g + (i >> 2)) * 128 + (16 * dt + 4 * (i & 3)) * 2;
                    const s16x4 vlo = __builtin_bit_cast(s16x4, __builtin_amdgcn_ds_read_tr16_b64_v4i16((LAS s16x4*)(va)));
                    const s16x4 vhi = __builtin_bit_cast(s16x4, __builtin_amdgcn_ds_read_tr16_b64_v4i16((LAS s16x4*)(va + 512)));
                    const bf16x8 vf = (bf16x8){vlo[0], vlo[1], vlo[2], vlo[3], vhi[0], vhi[1], vhi[2], vhi[3]};
                    oh[dt] = __builtin_amdgcn_mfma_f32_16x16x32_bf16(pf, vf, oh[dt], 0, 0, 0); }
            }
        }
        CFENCE();
#pragma unroll
        for (int dt = 0; dt < 4; ++dt)
#pragma unroll
            for (int e = 0; e < 4; ++e) { ssq[e] += oh[dt][e] * oh[dt][e]; *(LAS unsigned short*)(OL + (4 * g + e) * 512 + (h * 64 + 16 * dt + i) * 2) = (unsigned short)f2bf(oh[dt][e]); }
        CFENCE();
    }
    LAS float* SCL = (LAS float*)VL;
    CFENCE();
#pragma unroll
    for (int e = 0; e < 4; ++e) { const float sc = rsqf_(row16_sum(ssq[e]) * (1.f / 256.f) + NORM_EPS); if (i == 0) SCL[4 * g + e] = sc; }
    CFENCE();
#pragma unroll
    for (int q = 0; q < 8; ++q) { const int e = lane + 64 * q, row = e >> 5, ch = e & 31;
        const v4u v = *(const LAS v4u*)(OL + row * 512 + ch * 16); const float sc = SCL[row];
        v4u o;
#pragma unroll
        for (int t = 0; t < 4; ++t) o[t] = pk2(bflo(v[t]) * sc, bfhi(v[t]) * sc);
        *(GAS v4u*)(merged + (rowbase + r * 64 + c0 + row) * DM + 512 + 8 * ch) = o; }
    CFENCE();
}

constexpr int SG_PITCH = 528;
__device__ __forceinline__ void mix_sgu_item(Frame& F, int l, int item) {
    LAUNDER(F);
    const GAS bf16* proj = (const GAS bf16*)(F.ws + WS_PROJ); GAS bf16* merged = (GAS bf16*)(F.ws + WS_MERGED);
    const int lane = F.lane, w = F.wave, tid = F.tid, i = lane & 15, g = lane >> 4;
    const size_t m0 = (size_t)item * 128;
    LAS unsigned char* VI = F.lds; LAS float* SS = (LAS float*)(F.lds + 128 * SG_PITCH);
    { const int c4 = 4 * lane; const f32x4 gn = *(const f32x4*)(INP(F, I_SGUN) + l * 256 + c4);
      v2u xr[16];
#pragma unroll
      for (int j = 0; j < 16; ++j) xr[j] = *(const GAS v2u*)(proj + (m0 + 16 * w + j) * NPROJP + C_SV + c4);
#pragma unroll
      for (int j = 0; j < 16; ++j) { const int q = 16 * w + j; const v2u x = xr[j];
          f32x4 v = (f32x4){gelu_tanh(bflo(x.x)), gelu_tanh(bfhi(x.x)), gelu_tanh(bflo(x.y)), gelu_tanh(bfhi(x.y))};
          const float mu = wave_sum((v.x + v.y) + (v.z + v.w)) * (1.f / 256.f);
          v = v - mu;
          const float var = wave_sum((v.x * v.x + v.y * v.y) + (v.z * v.z + v.w * v.w)) * (1.f / 256.f);
          const float rstd = rsqf_(var + NORM_EPS);
          v2u o; o.x = pk2(v.x * rstd * gn.x, v.y * rstd * gn.y); o.y = pk2(v.z * rstd * gn.z, v.w * rstd * gn.w);
          *(LAS v2u*)(VI + q * SG_PITCH + c4 * 2) = o; } }
    __syncthreads();
    const int hh = w >> 1, ph = w & 1;
    f32x4 acc[4][4];
#pragma unroll
    for (int a = 0; a < 4; ++a)
#pragma unroll
        for (int b = 0; b < 4; ++b) acc[a][b] = (f32x4){0.f, 0.f, 0.f, 0.f};
    const GAS float* ws_ = INP(F, I_SGUW) + ((size_t)(l * 4 + hh) * 128) * 128;
#pragma unroll
    for (int ks = 0; ks < 4; ++ks) {
        bf16x8 af[4], bfr[4];
#pragma unroll
        for (int pt = 0; pt < 4; ++pt) { const GAS float* ap = ws_ + (size_t)(64 * ph + 16 * pt + i) * 128 + 32 * ks + 8 * g;
            const f32x4 x0 = *(const f32x4*)ap, x1 = *(const f32x4*)(ap + 4);
            const unsigned u0 = pk2(x0.x, x0.y), u1 = pk2(x0.z, x0.w), u2 = pk2(x1.x, x1.y), u3 = pk2(x1.z, x1.w);
            af[pt] = __builtin_bit_cast(bf16x8, (v4u){u0, u1, u2, u3}); }
#pragma unroll
        for (int dt = 0; dt < 4; ++dt) { const LAS unsigned char* va = VI + (32 * ks + 8 * g + (i >> 2)) * SG_PITCH + (hh * 64 + 16 * dt + 4 * (i & 3)) * 2;
            const s16x4 lo = __builtin_bit_cast(s16x4, __builtin_amdgcn_ds_read_tr16_b64_v4i16((LAS s16x4*)(va)));
            const s16x4 hi = __builtin_bit_cast(s16x4, __builtin_amdgcn_ds_read_tr16_b64_v4i16((LAS s16x4*)(va + 4 * SG_PITCH)));
            bfr[dt] = (bf16x8){lo[0], lo[1], lo[2], lo[3], hi[0], hi[1], hi[2], hi[3]}; }
#pragma unroll
        for (int pt = 0; pt < 4; ++pt)
#pragma unroll
            for (int dt = 0; dt < 4; ++dt) acc[pt][dt] = __builtin_amdgcn_mfma_f32_16x16x32_bf16(af[pt], bfr[dt], acc[pt][dt], 0, 0, 0);
    }
#pragma unroll
    for (int pt = 0; pt < 4; ++pt) {
        unsigned short ur[4][4];
#pragma unroll
        for (int e = 0; e < 4; ++e)
#pragma unroll
            for (int dt = 0; dt < 4; ++dt) ur[e][dt] = proj[(m0 + 64 * ph + 16 * pt + 4 * g + e) * NPROJP + C_SU + hh * 64 + 16 * dt + i];
#pragma unroll
        for (int e = 0; e < 4; ++e) { const int p = 64 * ph + 16 * pt + 4 * g + e; const float bs = INP(F, I_SGUB)[(l * 4 + hh) * 128 + p]; float ss = 0.f;
#pragma unroll
            for (int dt = 0; dt < 4; ++dt) { const float u = gelu_tanh(bf2f(ur[e][dt]));
                const float v = u * (acc[pt][dt][e] + bs); acc[pt][dt][e] = v; ss += v * v; }
            ss = row16_sum(ss); if (i == 0) SS[p * 4 + hh] = ss; } }
    __syncthreads();
#pragma unroll
    for (int pt = 0; pt < 4; ++pt)
#pragma unroll
        for (int e = 0; e < 4; ++e) { const int p = 64 * ph + 16 * pt + 4 * g + e; const f32x4 s4 = *(const LAS f32x4*)(SS + p * 4);
            const float sc = rsqf_(((s4.x + s4.y) + (s4.z + s4.w)) * (1.f / 256.f) + NORM_EPS);
#pragma unroll
            for (int dt = 0; dt < 4; ++dt) *(LAS unsigned short*)(VI + p * SG_PITCH + (hh * 64 + 16 * dt + i) * 2) = (unsigned short)f2bf(acc[pt][dt][e] * sc); }
    __syncthreads();
#pragma unroll
    for (int q = 0; q < 8; ++q) { const int e = tid + 512 * q, row = e >> 5, ch = e & 31;
        const v4u v = *(const LAS v4u*)(VI + row * SG_PITCH + ch * 16);
        *(GAS v4u*)(merged + (m0 + row) * DM + 768 + 8 * ch) = v; }
    __syncthreads();
}

__device__ __forceinline__ void phase_mix_na(Frame& F, int l, int bidx, int nblk) {
    LAUNDER(F);
    LAS float* RPB = (LAS float*)(F.lds + RING_BYTES + 1024);
    for (int q = F.tid; q < 4 * 465; q += NTHREADS) RPB[q] = INP(F, I_RPB)[l * 4 * 465 + q];
    __syncthreads();
    for (int it = bidx * NWAVES + F.wave; it < NB * 64 * 4; it += nblk * NWAVES) mix_na_item(F, l, it, F.lds + F.wave * 16384, RPB);
    __syncthreads();
#ifdef SGU_IN_C2
    for (int it = bidx; it < NB * 32; it += nblk) mix_sgu_item(F, l, it);
#endif
}
__device__ __forceinline__ void phase_mixers(Frame& F, int l) {
    LAUNDER(F);
    for (int tile = F.vcu; tile < M / 64; tile += F.G) mix_convprep_tile(F, l, tile);
    __syncthreads();
#ifndef SGU_IN_C2
    for (int it = F.vcu; it < NB * 32; it += F.G) mix_sgu_item(F, l, it);
#endif
}

constexpr int C1_VEC = 0, C1_VST = 640, C1_VEC_D = 16 * C1_VST, C1_RES = 40960, C1_RES_D = 17664;
constexpr int C1_U = 0, C1_ZT = 4096, C1_ET = 8192, C1_QT = 12288, C1_CT = 16384, C1_DA = 17408;
typedef float f32x2 __attribute__((ext_vector_type(2)));
#define CK_DOT(a, b) ({ f32x2 t_ = (f32x2){(a).x, (a).y} * (f32x2){(b).x, (b).y}; t_ = __builtin_elementwise_fma((f32x2){(a).z, (a).w}, (f32x2){(b).z, (b).w}, t_); t_.x + t_.y; })
#define CK_RED2(a, b) do { a += dppmov<0xB1>(a); b += dppmov<0xB1>(b); a += dppmov<0x4E>(a); b += dppmov<0x4E>(b); a += dppmov<0x141>(a); b += dppmov<0x141>(b); a += dppmov<0x140>(a); b += dppmov<0x140>(b); } while (0)
__device__ __forceinline__ bf16x8 pack8(f32x4 lo, f32x4 hi) { return __builtin_bit_cast(bf16x8, (v4u){pg8::cvt_pk_bf16(lo.x, lo.y), pg8::cvt_pk_bf16(lo.z, lo.w), pg8::cvt_pk_bf16(hi.x, hi.y), pg8::cvt_pk_bf16(hi.z, hi.w)}); }
template <int MODE>
__device__ __forceinline__ void phase_scan_c1(Frame& F, int l) {
    LAUNDER(F);
    const GAS bf16* proj = (const GAS bf16*)(F.ws + WS_PROJ);
    const int lane = F.lane, w = F.wave, i = lane & 15, g = lane >> 4;
    const int d = w >> 2, wa = w & 3;
    const int bh = F.vcu >> 3, bb = bh >> 2, h = bh & 3;
    LAS unsigned char* lds = F.lds;
    bf16x8 Bw, Ba;
    { f32x4 xw0 = (f32x4){0.f, 0.f, 0.f, 0.f}, xw1 = xw0, xa0 = xw0, xa1 = xw0;
      if (g < 2) { const GAS float* pw = INP(F, I_RWUP) + ((size_t)(l * 2 + d) * 16 + 8 * g) * 256 + h * 64 + 16 * wa + i; const GAS float* pa = INP(F, I_RAUP) + ((size_t)(l * 2 + d) * 16 + 8 * g) * 256 + h * 64 + 16 * wa + i;
          xw0 = (f32x4){pw[0], pw[256], pw[512], pw[768]}; xw1 = (f32x4){pw[1024], pw[1280], pw[1536], pw[1792]};
          xa0 = (f32x4){pa[0], pa[256], pa[512], pa[768]}; xa1 = (f32x4){pa[1024], pa[1280], pa[1536], pa[1792]}; }
      Bw = pack8(xw0, xw1); Ba = pack8(xa0, xa1); }
    const float w0c = INP(F, I_RW0)[(l * 2 + d) * 256 + h * 64 + 16 * wa + i], a0c = INP(F, I_RA0)[(l * 2 + d) * 256 + h * 64 + 16 * wa + i], kag = INP(F, I_RKA)[l * 256 + h * 64 + 16 * wa + i];
    float kkg[4];
#pragma unroll
    for (int t = 0; t < 4; ++t) kkg[t] = INP(F, I_RKK)[l * 256 + h * 64 + 16 * t + i];
    const float kkgw = INP(F, I_RKK)[l * 256 + h * 64 + 16 * wa + i];
    const int cg = i, sel = g;
#define C1_BAR() do { asm volatile("s_waitcnt lgkmcnt(0)" ::: "memory"); __builtin_amdgcn_s_barrier(); asm volatile("" ::: "memory"); } while (0)
    unsigned short kq[4][4], kown[4], rq[4]; v4u dvr, ivr;
#define C1_LOAD(B_) do { const size_t m0_ = (size_t)bb * T + 16 * (B_); \
        _Pragma("unroll") for (int e_ = 0; e_ < 4; ++e_) { const GAS bf16* row_ = proj + (m0_ + 4 * g + e_) * NPROJP; \
            _Pragma("unroll") for (int t_ = 0; t_ < 4; ++t_) kq[t_][e_] = row_[C_K + h * 64 + 16 * t_ + i]; \
            rq[e_] = row_[C_R + h * 64 + 16 * wa + i]; kown[e_] = row_[C_K + h * 64 + 16 * wa + i]; } \
        { const GAS bf16* arow_ = proj + (m0_ + i) * NPROJP + C_DEC + 16 * d + 8 * (g & 1); dvr = *(const GAS v4u*)(arow_); ivr = *(const GAS v4u*)(arow_ + 32); } } while (0)
    C1_LOAD((F.vcu & 7) * 32);
    for (int it = 0; it < 32; ++it) {
        const int B = (F.vcu & 7) * 32 + it;
        if (MODE != 3) {
            v4u dv = (v4u){0u, 0u, 0u, 0u}, iv = dv;
            if (g < 2) { iv = ivr;
#pragma unroll
                for (int q = 0; q < 4; ++q) dv[q] = pk2(tanhf_(bflo(dvr[q])), tanhf_(bfhi(dvr[q]))); }
            const f32x4 z4 = (f32x4){0.f, 0.f, 0.f, 0.f};
            const f32x4 Dw = __builtin_amdgcn_mfma_f32_16x16x32_bf16(__builtin_bit_cast(bf16x8, dv), Bw, z4, 0, 0, 0);
            const f32x4 Da = __builtin_amdgcn_mfma_f32_16x16x32_bf16(__builtin_bit_cast(bf16x8, iv), Ba, z4, 0, 0, 0);
#pragma unroll
            for (int e = 0; e < 4; ++e) {
                float ss = 0.f;
#pragma unroll
                for (int t = 0; t < 4; ++t) { const float x = bf2f(kq[t][e]) * kkg[t]; ss += x * x; }
                ss = row16_sum(ss);
                const float k = bf2f(kown[e]); const float kk = k * kkgw * rsqf_(ss + 1e-12f);
                const float wv = __expf(-DECAY_SCALE * sigmoidf_(w0c + Dw[e])), av = sigmoidf_(a0c + Da[e]);
                const int tok = 4 * g + e, s = d ? 15 - tok : tok;
                LAS _Float16* vp = (LAS _Float16*)(lds + C1_VEC + d * C1_VEC_D + s * C1_VST) + 16 * wa + i;
                vp[0] = (_Float16)wv; vp[64] = (_Float16)kk; vp[128] = (_Float16)(kk * av); vp[192] = (_Float16)(k * (1.f + (av - 1.f) * kag)); vp[256] = (_Float16)bf2f(rq[e]); }
        }
        if (it + 1 < 32) C1_LOAD(B + 1);
        C1_BAR();
        if (MODE != 1 && MODE != 4) {
            typedef _Float16 h4 __attribute__((ext_vector_type(4)));
            const LAS unsigned char* V = lds + C1_VEC + d * C1_VEC_D + cg * 8;
            LAS unsigned char* R = lds + C1_RES + d * C1_RES_D;
#define VLD(s_, vec_) (*(const LAS h4*)(V + (s_) * C1_VST + (vec_) * 128))
#define HDOT(a, b) __builtin_amdgcn_fdot2((h2){(a).x, (a).y}, (h2){(b).x, (b).y}, __builtin_amdgcn_fdot2((h2){(a).z, (a).w}, (h2){(b).z, (b).w}, 0.f, false), false)
#define H4F(v_) __builtin_convertvector((v_), f32x4)
            const unsigned Va = (unsigned)(size_t)V;
#define LD4(X, s_) asm volatile("ds_read_b64 %0, %4\n\tds_read_b64 %1, %4 offset:128\n\tds_read_b64 %2, %4 offset:256\n\tds_read_b64 %3, %4 offset:384" \
                : "=v"(X[0]), "=v"(X[1]), "=v"(X[2]), "=v"(X[3]) : "v"(Va + (unsigned)(s_) * (unsigned)C1_VST) : "memory")
#define WT4(X, n_) asm volatile("s_waitcnt lgkmcnt(" #n_ ")" : "+v"(X[0]), "+v"(X[1]), "+v"(X[2]), "+v"(X[3]) :: "memory")
#define LD3(X, s_) asm volatile("ds_read_b64 %0, %3\n\tds_read_b64 %1, %3 offset:128\n\tds_read_b64 %2, %3 offset:256" \
                : "=v"(X[0]), "=v"(X[1]), "=v"(X[2]) : "v"(Va + (unsigned)(s_) * (unsigned)C1_VST) : "memory")
#define WT3(X, n_) asm volatile("s_waitcnt lgkmcnt(" #n_ ")" : "+v"(X[0]), "+v"(X[1]), "+v"(X[2]) :: "memory")
            {
                const int s = 4 * wa + sel; h4 q = VLD(s, 4); float creg = 0.f;
                h4 A0[4], A1[4], A2[4];
#define QBODY_R(X) do { float d1 = HDOT(X[3], q), d2 = HDOT(X[2], q); CK_RED2(d1, d2); const bool act = j <= s; creg = (act && cg == j) ? d1 : creg; \
                    const _Float16 hd = (_Float16)d2; const h4 qn = X[0] * q - X[1] * (h4){hd, hd, hd, hd}; q = act ? qn : q; } while (0)
#define QBODY(X) do { float d1 = HDOT(X[3], q), d2 = HDOT(X[2], q); CK_RED2(d1, d2); creg = (cg == j) ? d1 : creg; const _Float16 hd = (_Float16)d2; q = X[0] * q - X[1] * (h4){hd, hd, hd, hd}; } while (0)
                int j = 4 * wa + 3;
                LD4(A0, j); LD4(A1, j - 1);
                LD4(A2, j - 2); WT4(A0, 8); QBODY_R(A0); --j;
                LD4(A0, j >= 2 ? j - 2 : 0); WT4(A1, 8); QBODY_R(A1); --j;
                LD4(A1, j >= 2 ? j - 2 : 0); WT4(A2, 8); QBODY_R(A2); --j;
                for (;;) {
                    LD4(A2, j >= 2 ? j - 2 : 0); WT4(A0, 8); QBODY(A0); if (--j < 0) break;
                    LD4(A0, j >= 2 ? j - 2 : 0); WT4(A1, 8); QBODY(A1); if (--j < 0) break;
                    LD4(A1, j >= 2 ? j - 2 : 0); WT4(A2, 8); QBODY(A2); if (--j < 0) break;
                }
                WT4(A0, 0); WT4(A1, 0); WT4(A2, 0);
#undef QBODY
#undef QBODY_R
                *(LAS f32x4*)(R + C1_QT + s * 256 + cg * 16) = H4F(q); *(LAS float*)(R + C1_CT + s * 64 + cg * 4) = creg;
            }
            {
                const int ga = 3 - wa, s = 4 * ga + sel; h4 u = VLD(s, 1);
                const int j0 = 4 * wa + sel; h4 x = VLD(j0, 3); h4 wz = (h4){(_Float16)1.f, (_Float16)1.f, (_Float16)1.f, (_Float16)1.f};
                h4 U0[3], U1[3], U2[3], E0[3], E1[3], E2[3];
#define UBODY_R(X, Y) do { float d2 = HDOT(X[2], u), d3 = HDOT(x, Y[1]); CK_RED2(d2, d3); const _Float16 h2_ = (_Float16)d2, h3_ = (_Float16)d3; \
                    const h4 un = X[0] * u - X[1] * (h4){h2_, h2_, h2_, h2_}; u = (j < s) ? un : u; const bool act = ii > j0; \
                    const h4 xn = x * Y[0] - Y[2] * (h4){h3_, h3_, h3_, h3_}; x = act ? xn : x; wz = act ? wz * Y[0] : wz; } while (0)
#define UBODY(X, Y) do { float d2 = HDOT(X[2], u), d3 = HDOT(x, Y[1]); CK_RED2(d2, d3); const _Float16 h2_ = (_Float16)d2, h3_ = (_Float16)d3; \
                    u = X[0] * u - X[1] * (h4){h2_, h2_, h2_, h2_}; x = x * Y[0] - Y[2] * (h4){h3_, h3_, h3_, h3_}; wz = wz * Y[0]; } while (0)
                int j = 4 * ga + 2, ii = 4 * wa + 1;
                LD3(U0, j); LD3(E0, ii); LD3(U1, j >= 1 ? j - 1 : 0); LD3(E1, ii < 15 ? ii + 1 : 15);
                LD3(U2, j >= 2 ? j - 2 : 0); LD3(E2, ii < 14 ? ii + 2 : 15); WT3(U0, 12); WT3(E0, 12); UBODY_R(U0, E0); ++ii; --j;
                LD3(U0, j >= 2 ? j - 2 : 0); LD3(E0, ii < 14 ? ii + 2 : 15); WT3(U1, 12); WT3(E1, 12); UBODY_R(U1, E1); ++ii; --j;
                LD3(U1, j >= 2 ? j - 2 : 0); LD3(E1, ii < 14 ? ii + 2 : 15); WT3(U2, 12); WT3(E2, 12); UBODY_R(U2, E2); ++ii; --j;
                if (j >= 0) for (;;) {
                    LD3(U2, j >= 2 ? j - 2 : 0); LD3(E2, ii < 14 ? ii + 2 : 15); WT3(U0, 12); WT3(E0, 12); UBODY(U0, E0); ++ii; if (--j < 0) break;
                    LD3(U0, j >= 2 ? j - 2 : 0); LD3(E0, ii < 14 ? ii + 2 : 15); WT3(U1, 12); WT3(E1, 12); UBODY(U1, E1); ++ii; if (--j < 0) break;
                    LD3(U1, j >= 2 ? j - 2 : 0); LD3(E1, ii < 14 ? ii + 2 : 15); WT3(U2, 12); WT3(E2, 12); UBODY(U2, E2); ++ii; if (--j < 0) break;
                }
                WT3(U0, 0); WT3(U1, 0); WT3(U2, 0); WT3(E0, 0); WT3(E1, 0); WT3(E2, 0);
#undef UBODY
#undef UBODY_R
                const f32x4 uf = H4F(u), xf = H4F(x), wzf = H4F(wz);
                LAS float* up = (LAS float*)(R + C1_U) + (4 * cg) * 16 + s; up[0] = uf.x; up[16] = uf.y; up[32] = uf.z; up[48] = uf.w;
                const f32x4 zb = H4F(VLD(j0, 2)) * wzf;
                LAS float* ep = (LAS float*)(R + C1_ET) + (4 * cg) * 16 + j0; ep[0] = xf.x; ep[16] = xf.y; ep[32] = xf.z; ep[48] = xf.w;
                LAS float* zp = (LAS float*)(R + C1_ZT) + (4 * cg) * 16 + j0; zp[0] = zb.x; zp[16] = zb.y; zp[32] = zb.z; zp[48] = zb.w;
                if (wa == 0 && sel == 0) *(LAS f32x4*)(R + C1_DA + cg * 16) = H4F(VLD(0, 0)) * wzf;
            }
#undef HDOT
#undef H4F
#undef LD4
#undef WT4
#undef LD3
#undef WT3
#undef VLD
        }
        C1_BAR();
        if (MODE != 2 && MODE != 4) {
            const LAS unsigned char* R = lds + C1_RES + d * C1_RES_D;
            const int n = d ? 255 - B : B;
            GAS unsigned char* gt = (d ? (GAS unsigned char*)F.out : F.ws + WS_GT0) + ((size_t)(bb * 4 + h) * 256 + n) * GT_CHUNK;
            const int nt = wa;
            bf16x8 zf = (bf16x8){0, 0, 0, 0, 0, 0, 0, 0};
            if (g < 2) { const LAS f32x4* zp = (const LAS f32x4*)(R + C1_ZT + (16 * nt + i) * 64 + 32 * g); zf = pack8(zp[0], zp[1]); }
            f32x4 pp[4];
#pragma unroll
            for (int ct = 0; ct < 4; ++ct) {
                bf16x8 uf = (bf16x8){0, 0, 0, 0, 0, 0, 0, 0};
                if (g < 2) { const LAS f32x4* up = (const LAS f32x4*)(R + C1_U + (16 * ct + i) * 64 + 32 * g); uf = pack8(up[0], up[1]); }
                const f32x4 dd = __builtin_amdgcn_mfma_f32_16x16x32_bf16(uf, zf, (f32x4){0.f, 0.f, 0.f, 0.f}, 0, 0, 0);
                f32x4 pv = -dd;
                if (ct == nt) { const f32x4 da = *(const LAS f32x4*)(R + C1_DA + (16 * ct + 4 * g) * 4);
#pragma unroll
                    for (int e = 0; e < 4; ++e) if (4 * g + e == i) pv[e] += da[e]; }
                pp[ct] = pv; }
#define C1_ST(p_, v_) do { const bf16x8 v__ = (v_); if (MODE == 0) *(GAS bf16x8*)(p_) = v__; else asm volatile("" :: "v"(v__)); } while (0)
            C1_ST(gt + (nt * 2 + 0) * 1024 + lane * 16, pack8(pp[0], pp[1]));
            C1_ST(gt + (nt * 2 + 1) * 1024 + lane * 16, pack8(pp[2], pp[3]));
            if (g < 2) { const LAS f32x4* ep = (const LAS f32x4*)(R + C1_ET + (16 * nt + i) * 64 + 32 * g); C1_ST(gt + 10240 + nt * 512 + lane * 16, pack8(ep[0], ep[1])); }
            if (wa == 0) {
#pragma unroll
                for (int ks = 0; ks < 2; ++ks) { const LAS f32x4* qp = (const LAS f32x4*)(R + C1_QT + i * 256 + (32 * ks + 4 * g) * 4);
                    C1_ST(gt + (8 + ks) * 1024 + lane * 16, pack8(qp[0], qp[4])); }
                if (g < 2) { const LAS f32x4* cp = (const LAS f32x4*)(R + C1_CT + i * 64 + 32 * g); C1_ST(gt + 10240 + 4 * 512 + lane * 16, pack8(cp[0], cp[1])); }
            }
        }
    }
#undef C1_LOAD
#undef C1_BAR
    __syncthreads();
}
#define C2_BAR() do { asm volatile("s_waitcnt lgkmcnt(0)" ::: "memory"); __builtin_amdgcn_s_barrier(); asm volatile("" ::: "memory"); } while (0)
constexpr int C2_SLOT = 16384, C2_YOFF = 4 * C2_SLOT;
template <int MODE>
__device__ __forceinline__ void phase_scan_c2(Frame& F, int l) {
    LAUNDER(F);
    if (F.vcu >= 128) { if (MODE == 0) phase_mix_na(F, l, F.vcu - 128, 128); return; }
    const GAS bf16* proj = (const GAS bf16*)(F.ws + WS_PROJ);
    const int lane = F.lane, i = lane & 15, g = lane >> 4;
    LAS unsigned char* lds = F.lds;
    if (F.vcu < 128) {
    const int ci = F.vcu >> 1, tp = F.vcu & 1, d = ci >> 5, bb = (ci >> 2) & 7, h = ci & 3;
    for (int q = F.tid; q < 4 * 5 * 32; q += NTHREADS) { const int sl = q / 160, r = q % 160; *(LAS v4u*)(lds + sl * C2_SLOT + 10240 + (r >> 5) * 1024 + 512 + (r & 31) * 16) = (v4u){0u, 0u, 0u, 0u}; }
    __syncthreads();
    if (F.wave < 2) {
        const int cw = F.wave;
        f32x4 st[4];
#pragma unroll
        for (int t = 0; t < 4; ++t) st[t] = (f32x4){0.f, 0.f, 0.f, 0.f};
        v4u af[15], vf, nf[15], nvf;
#define C2_RD(AF, VF, c_) do { const LAS unsigned char* p_ = lds + ((c_) & 3) * C2_SLOT + lane * 16; \
            _Pragma("unroll") for (int f_ = 0; f_ < 15; ++f_) AF[f_] = *(const LAS v4u*)(p_ + f_ * 1024); \
            VF = *(const LAS v4u*)(lds + ((c_) & 3) * C2_SLOT + 15360 + cw * 512 + i * 32 + (g & 1) * 16); } while (0)
#define C2_STEP(AF, VF, NF, NVF, n_) do { \
            if ((n_) + 1 < 256) C2_RD(NF, NVF, (n_) + 1); \
            const bf16x8 b0_ = pack8(st[0], st[1]), b1_ = pack8(st[2], st[3]); const v4u vz_ = (g < 2) ? VF : (v4u){0u, 0u, 0u, 0u}; const bf16x8 bv_ = __builtin_bit_cast(bf16x8, vz_); \
            f32x4 o_[5]; \
            _Pragma("unroll") for (int nt = 0; nt < 5; ++nt) { if (MODE >= 2) { o_[nt] = __builtin_bit_cast(f32x4, AF[nt]) + __builtin_bit_cast(f32x4, AF[10 + nt]) * st[nt & 3]; continue; } \
                f32x4 a_ = __builtin_amdgcn_mfma_f32_16x16x32_bf16(__builtin_bit_cast(bf16x8, AF[nt * 2]), b0_, (f32x4){0.f, 0.f, 0.f, 0.f}, 0, 0, 0); \
                a_ = __builtin_amdgcn_mfma_f32_16x16x32_bf16(__builtin_bit_cast(bf16x8, AF[nt * 2 + 1]), b1_, a_, 0, 0, 0); \
                o_[nt] = __builtin_amdgcn_mfma_f32_16x16x32_bf16(__builtin_bit_cast(bf16x8, AF[10 + nt]), bv_, a_, 0, 0, 0); } \
            _Pragma("unroll") for (int t = 0; t < 4; ++t) st[t] = o_[t]; \
            { v2u yw_; yw_.x = pk2(o_[4].x, o_[4].y); yw_.y = pk2(o_[4].z, o_[4].w); \
              *(LAS v2u*)(lds + C2_YOFF + (cw * 8 + ((n_) & 7)) * 512 + i * 32 + g * 8) = yw_; }     \
            } while (0)
        C2_BAR();
        C2_RD(af, vf, 0);
        for (int n = 0; n < 256; n += 2) { C2_STEP(af, vf, nf, nvf, n); C2_STEP(nf, nvf, af, vf, n + 1); C2_BAR(); }
        C2_BAR();
#undef C2_STEP
#undef C2_RD
    } else {
        const int hl = F.tid - 128;
        const GAS unsigned char* gt = (d ? (const GAS unsigned char*)F.out : F.ws + WS_GT0) + ((size_t)(bb * 4 + h) * 256) * GT_CHUNK;
        GAS bf16* ysc = (GAS bf16*)(d ? (GAS unsigned char*)F.out + GT_DIR : F.ws + WS_YSC0) + (size_t)bb * T * 256 + h * 64 + 32 * tp;
        const int p0 = hl, p1 = hl + 384, p2 = hl + 768; const bool has2 = p2 < 800;
#define C2_OFF(p_) ((p_) < 640 ? (p_) * 16 : 10240 + (((p_) - 640) >> 5) * 1024 + (((p_) - 640) & 31) * 16)
        const int o0 = C2_OFF(p0), o1 = C2_OFF(p1), o2 = C2_OFF(has2 ? p2 : 799);
        const int e0 = hl, e1 = hl + 384; const bool hasv1 = e1 < 512;
        const GAS bf16* vs0 = proj + (size_t)bb * T * NPROJP + C_V + h * 64 + 32 * tp + 16 * (e0 >> 8) + (e0 & 15);
        const GAS bf16* vs1 = proj + (size_t)bb * T * NPROJP + C_V + h * 64 + 32 * tp + 16 * ((hasv1 ? e1 : 0) >> 8) + (e1 & 15);
        const int vt0 = (e0 >> 4) & 15, vt1 = (e1 >> 4) & 15;
        const int vo0 = 15360 + (e0 >> 8) * 512 + (e0 & 15) * 32 + vt0 * 2, vo1 = 15360 + ((hasv1 ? e1 : 0) >> 8) * 512 + (e1 & 15) * 32 + vt1 * 2;
        constexpr int RD = 12;
        v4u r0[RD], r1[RD], r2[RD]; unsigned short rv0[RD], rv1[RD];
        if (MODE == 1 || MODE == 3) {
#pragma unroll
            for (int k = 0; k < RD; ++k) { r0[k] = (v4u){1u, 2u, 3u, 4u}; r1[k] = r0[k]; r2[k] = r0[k]; rv0[k] = 0; rv1[k] = 0; } }
#define C2_GLD(k_, n_) do { if (MODE == 1 || MODE == 3) break; const GAS unsigned char* c_ = gt + (size_t)(n_) * GT_CHUNK; r0[k_] = *(const GAS v4u*)(c_ + p0 * 16); r1[k_] = *(const GAS v4u*)(c_ + p1 * 16); \
            if (has2) r2[k_] = *(const GAS v4u*)(c_ + p2 * 16); \
            { const int gs_ = 16 * (n_) + vt0, t_ = d ? (T - 1 - gs_) : gs_; rv0[k_] = vs0[(size_t)t_ * NPROJP]; } \
            if (hasv1) { const int gs_ = 16 * (n_) + vt1, t_ = d ? (T - 1 - gs_) : gs_; rv1[k_] = vs1[(size_t)t_ * NPROJP]; } } while (0)
#define C2_WR(k_, n_) do { LAS unsigned char* p_ = lds + ((n_) & 3) * C2_SLOT; *(LAS v4u*)(p_ + o0) = r0[k_]; *(LAS v4u*)(p_ + o1) = r1[k_]; if (has2) *(LAS v4u*)(p_ + o2) = r2[k_]; \
            *(LAS unsigned short*)(p_ + vo0) = rv0[k_]; if (hasv1) *(LAS unsigned short*)(p_ + vo1) = rv1[k_]; } while (0)
#define C2_YST(m_) do { if (hl < 64) { const int cw_ = hl >> 5, s_ = (hl >> 1) & 15, hf_ = hl & 1; const LAS unsigned short* yp_ = (const LAS unsigned short*)(lds + C2_YOFF + (cw_ * 8 + ((m_) & 7)) * 512) + s_; \
            v4u w_; _Pragma("unroll") for (int e_ = 0; e_ < 4; ++e_) w_[e_] = (unsigned)yp_[(8 * hf_ + 2 * e_) * 16] | ((unsigned)yp_[(8 * hf_ + 2 * e_ + 1) * 16] << 16); \
            const int gs_ = 16 * (m_) + s_, t_ = d ? (T - 1 - gs_) : gs_; if (MODE == 0) *(GAS v4u*)(ysc + (size_t)t_ * 256 + 16 * cw_ + 8 * hf_) = w_; else asm volatile("" :: "v"(w_)); } } while (0)
#pragma unroll
        for (int k = 0; k < RD; ++k) C2_GLD(k, k);
        C2_WR(0, 0); C2_GLD(0, RD); C2_WR(1, 1); C2_GLD(1, RD + 1); C2_WR(2, 2); C2_GLD(2, RD + 2);
        C2_BAR();
        for (int m6 = 0; m6 < 128; m6 += RD / 2) {
#pragma unroll
            for (int k = 0; k < RD / 2; ++k) { const int m = m6 + k;
                if (m < 128) {
                    const int ca = 2 * m + 3, cb = 2 * m + 4, ka = (2 * k + 3) % RD, kb = (2 * k + 4) % RD;
                    if (ca < 256) { C2_WR(ka, ca); if (ca + RD < 256) C2_GLD(ka, ca + RD); }
                    if (cb < 256) { C2_WR(kb, cb); if (cb + RD < 256) C2_GLD(kb, cb + RD); }
                    if (m > 0) { C2_YST(2 * m - 2); C2_YST(2 * m - 1); }
                    C2_BAR(); } }
        }
        C2_YST(254); C2_YST(255);
        C2_BAR();
#undef C2_GLD
#undef C2_WR
#undef C2_YST
#undef C2_OFF
    }
    }
    __syncthreads();
}
#undef C2_BAR
#undef CK_DOT
#undef CK_RED2

__device__ __forceinline__ void phase_rwkv_post(Frame& F, int l) {
    LAUNDER(F);
    const GAS bf16* proj = (const GAS bf16*)(F.ws + WS_PROJ); GAS bf16* merged = (GAS bf16*)(F.ws + WS_MERGED); const GAS bf16* ysc0 = (const GAS bf16*)(F.ws + WS_YSC0); const GAS bf16* ysc1 = (const GAS bf16*)((const GAS unsigned char*)F.out + GT_DIR);
    const int lane = F.lane, c4 = 4 * lane, hd = lane >> 4;
    LAS float* GUP = (LAS float*)F.lds;
    for (int q = F.tid; q < 32 * 256; q += NTHREADS) GUP[q] = INP(F, I_RGUP)[(size_t)l * 32 * 256 + q];
    __syncthreads();
    const f32x4 lw = *(const f32x4*)(INP(F, I_LNXW) + l * 256 + c4), lb = *(const f32x4*)(INP(F, I_LNXB) + l * 256 + c4), rk = *(const f32x4*)(INP(F, I_RRK) + l * 256 + c4);
    const int mstep = F.G * NWAVES; int m = F.vcu * NWAVES + F.wave;
    v2u n_yf, n_yb, n_r, n_k, n_v; unsigned short n_g;
#define POST_LOAD(mm) do { const GAS bf16* row_ = proj + (size_t)(mm) * NPROJP; n_yf = *(const GAS v2u*)(ysc0 + (size_t)(mm) * 256 + c4); n_yb = *(const GAS v2u*)(ysc1 + (size_t)(mm) * 256 + c4); \
        n_r = *(const GAS v2u*)(row_ + C_R + c4); n_k = *(const GAS v2u*)(row_ + C_K + c4); n_v = *(const GAS v2u*)(row_ + C_V + c4); n_g = row_[C_GDN + (lane & 31)]; } while (0)
    POST_LOAD(m);
    for (; m < M; m += mstep) {
        const v2u yf = n_yf, yb = n_yb, ru = n_r, ku = n_k, vu = n_v; const unsigned short gu = n_g;
        if (m + mstep < M) POST_LOAD(m + mstep);
        f32x4 y = (f32x4){bflo(yf.x) + bflo(yb.x), bfhi(yf.x) + bfhi(yb.x), bflo(yf.y) + bflo(yb.y), bfhi(yf.y) + bfhi(yb.y)};
        const float mu = row16_sum((y.x + y.y) + (y.z + y.w)) * (1.f / 64.f);
        y = y - mu;
        const float var = row16_sum((y.x * y.x + y.y * y.y) + (y.z * y.z + y.w * y.w)) * (1.f / 64.f);
        const float rstd = rsqf_(var + GN_EPS);
        y = y * rstd * lw + lb;
        const f32x4 r = (f32x4){bflo(ru.x), bfhi(ru.x), bflo(ru.y), bfhi(ru.y)}, k = (f32x4){bflo(ku.x), bfhi(ku.x), bflo(ku.y), bfhi(ku.y)}, v = (f32x4){bflo(vu.x), bfhi(vu.x), bflo(vu.y), bfhi(vu.y)};
        const f32x4 rkk = r * k * rk;
        const float bsum = row16_sum((rkk.x + rkk.y) + (rkk.z + rkk.w));
        y = y + v * bsum;
        const float gd = sigmoidf_(bf2f(gu));
        f32x4 gt = (f32x4){0.f, 0.f, 0.f, 0.f};
#pragma unroll
        for (int j = 0; j < 32; ++j) { const float gj = __builtin_bit_cast(float, __builtin_amdgcn_readlane(__builtin_bit_cast(int, gd), j)); gt = gt + *(const LAS f32x4*)(GUP + j * 256 + c4) * gj; }
        y = y * gt;
        const float ss = wave_sum((y.x * y.x + y.y * y.y) + (y.z * y.z + y.w * y.w));
        const float sc = rsqf_(ss * (1.f / 256.f) + NORM_EPS);
        v2u o; o.x = pk2(y.x * sc, y.y * sc); o.y = pk2(y.z * sc, y.w * sc);
        *(GAS v2u*)(merged + (size_t)m * DM + 256 + c4) = o;
    }
#undef POST_LOAD
    (void)hd;
}

__device__ __forceinline__ void phase_residual(Frame& F, const GAS float* gain, const bool IN_F32, const bool LAST) {
    LAUNDER(F);
    const GAS bf16* y = (const GAS bf16*)(F.ws + WS_Y); const GAS float* part = (const GAS float*)(F.ws + WS_PART);
    GAS bf16* xb = (GAS bf16*)(F.ws + WS_XB); GAS float* rs = (GAS float*)(F.ws + WS_RS); const GAS float* xin = INP(F, I_X);
    const int lane = F.lane;
    f32x4 gv[4];
#pragma unroll
    for (int j = 0; j < 4; ++j) gv[j] = *((const f32x4*)gain + lane + 64 * j);
    for (int m = F.vcu * NWAVES + F.wave; m < M; m += F.G * NWAVES) {
        const f32x4* pp = (const f32x4*)(part + (size_t)m * 16);
        const f32x4 p0 = *(const GAS f32x4*)(pp), p1 = *(const GAS f32x4*)(pp + 1), p2 = *(const GAS f32x4*)(pp + 2), p3 = *(const GAS f32x4*)(pp + 3);
        const float tot = ((p0.x + p0.y) + (p0.z + p0.w)) + ((p1.x + p1.y) + (p1.z + p1.w)) + ((p2.x + p2.y) + (p2.z + p2.w)) + ((p3.x + p3.y) + (p3.z + p3.w));
        const float sc = rsqf_(tot * (1.f / DM) + NORM_EPS);
        const GAS v2u* yr = (const GAS v2u*)(y + (size_t)m * DM) + lane;
        f32x4 v[4]; float s = 0.f;
#pragma unroll
        for (int j = 0; j < 4; ++j) { const v2u yu = yr[64 * j]; const f32x4 yv = (f32x4){bflo(yu.x), bfhi(yu.x), bflo(yu.y), bfhi(yu.y)};
            f32x4 xv;
            if (IN_F32) xv = ((const GAS f32x4*)(xin + (size_t)m * DM) + lane)[64 * j];
            else { const v2u xu = ((const GAS v2u*)(xb + (size_t)m * DM) + lane)[64 * j]; xv = (f32x4){bflo(xu.x), bfhi(xu.x), bflo(xu.y), bfhi(xu.y)}; }
            v[j] = xv + yv * sc * gv[j]; s += (v[j].x * v[j].x + v[j].y * v[j].y) + (v[j].z * v[j].z + v[j].w * v[j].w); }
        if (LAST) {
            GAS f32x4* orow = (GAS f32x4*)(F.out + (size_t)m * DM) + lane;
#pragma unroll
            for (int j = 0; j < 4; ++j) orow[64 * j] = v[j];
        } else {
            s = wave_sum(s);
            GAS v2u* o8 = (GAS v2u*)(xb + (size_t)m * DM) + lane;
#pragma unroll
            for (int j = 0; j < 4; ++j) { v2u o; o.x = pk2(v[j].x, v[j].y); o.y = pk2(v[j].z, v[j].w); o8[64 * j] = o; }
            if (lane == 0) rs[m] = rsqf_(s * (1.f / DM) + NORM_EPS);
        }
    }
}
__device__ __forceinline__ void phase_ffn_conv(Frame& F, int l) {
    LAUNDER(F);
    const GAS bf16* G = (const GAS bf16*)(F.ws + WS_G); GAS bf16* L = (GAS bf16*)(F.ws + WS_L);
    const GAS float* cw = INP(F, I_FCONV) + (size_t)l * 3 * DFF;
    constexpr int CPR = DFF / 8;
    const int nitems = (M / 256) * 2 * CPR;
    for (int it = F.vcu * NTHREADS + F.tid; it < nitems; it += F.G * NTHREADS) {
        const int ck = it % CPR, rr = it / CPR, m = (rr >> 1) * 256 + ((rr & 1) ? 255 : 0), t = m % T, c8 = 8 * ck;
        float w0[8], w1[8], w2[8];
#pragma unroll
        for (int j = 0; j < 8; ++j) { w0[j] = cw[c8 + j]; w1[j] = cw[DFF + c8 + j]; w2[j] = cw[2 * DFF + c8 + j]; }
        const v4u z = (v4u){0u, 0u, 0u, 0u};
        const v4u gp = (t > 0) ? *(const GAS v4u*)(G + (size_t)(m - 1) * DFF + c8) : z, gc = *(const GAS v4u*)(G + (size_t)m * DFF + c8), gn = (t < T - 1) ? *(const GAS v4u*)(G + (size_t)(m + 1) * DFF + c8) : z;
        const v4u lv = *(const GAS v4u*)(L + (size_t)m * DFF + c8);
        v4u o;
#pragma unroll
        for (int q = 0; q < 4; ++q) {
            const float a0 = w0[2 * q] * bflo(gp[q]) + w1[2 * q] * bflo(gc[q]) + w2[2 * q] * bflo(gn[q]);
            const float a1 = w0[2 * q + 1] * bfhi(gp[q]) + w1[2 * q + 1] * bfhi(gc[q]) + w2[2 * q + 1] * bfhi(gn[q]);
            o[q] = pk2(gelu_tanh(a0) * bflo(lv[q]), gelu_tanh(a1) * bfhi(lv[q])); }
        *(GAS v4u*)(L + (size_t)m * DFF + c8) = o;
    }
}

#ifndef MK_N_LAUNCHES
#define MK_N_LAUNCHES 1
#endif
constexpr int NPH = 1 + 8 * DEPTH;
struct Args { const float* in[26]; float* out; unsigned char* ws; int ph_lo, ph_hi; };
__global__ void __launch_bounds__(NTHREADS, 2) enc_fwd(Args args) {
    extern __shared__ __attribute__((aligned(16))) unsigned char lds_raw[];
    Frame F;
    F.lds = (LAS unsigned char*)lds_raw;
    F.MISC = (volatile LAS unsigned*)(F.lds + MISC_OFF);
    F.tid = threadIdx.x; F.lane = F.tid & 63; F.wave = __builtin_amdgcn_readfirstlane(F.tid >> 6);
    F.G = gridDim.x; { const int bx = blockIdx.x; F.vcu = (F.G % 8 == 0) ? (bx % 8) * (F.G / 8) + bx / 8 : bx; }
    F.ws = (GAS unsigned char*)args.ws; F.out = (GAS float*)args.out; F.ctl = (gu32*)(F.ws + WS_CTL);
    F.karg = (kq_t*)__builtin_amdgcn_kernarg_segment_ptr();
    for (int u = F.tid; u < (LDS_BYTES - LDSCTL_OFF) / 4; u += NTHREADS) ((LAS unsigned*)(F.lds + LDSCTL_OFF))[u] = 0u;
    __syncthreads();
    const int lo = args.ph_lo, hi = args.ph_hi;
    if (hi - lo > 1) (void)xcd_barrier_post((unsigned*)(F.ctl + CW_BAR), F.MISC + 8);
#define GRID_BAR() do { XcdBarrier bar_; bar_.bar = (unsigned*)(F.ctl + CW_BAR); bar_.x = xb_xcc_id(); bar_.st = F.MISC + 8; xcd_barrier(bar_); } while (0)
#ifndef PH_ENABLE
#define PH_ENABLE 0x7ff
#endif
#define IN(k) (lo <= (k) && (k) < hi)
#define EN(t) (((PH_ENABLE) >> (t)) & 1)
#pragma unroll 1
#ifdef REPEAT_T
    for (int step = lo; step < hi; ++step) {
        const int p1 = REPEAT_T, p2 = REPEAT_T + 8;
        const int ph = step - (step > p1 ? 1 : 0) - ((step > p2 + 1 && REPEAT_T != 7) ? 1 : 0);
#else
    for (int ph = lo; ph < hi; ++ph) {
#endif
        LAUNDER(F);
        const int l = ph == 0 ? 0 : (ph - 1) / 8, tt = ph == 0 ? 0 : 1 + (ph - 1) % 8;
        const int t = tt == 0 ? 0 : (tt == 1 ? 1 : (tt <= 5 ? tt + 1 : tt + 2));
        GAS unsigned char* wl = F.ws + WS_W + (size_t)l * W_LAYER;
      {
        if (t == 1 || t == 8) {
            pg8::Gemm g; pg8::EpiUni E;
            g.M = M; E.split_cols = 0; E.split_stride = 0; E.convw = nullptr; E.G = nullptr; E.xl = (pg8::PG8_LAS_T*)(F.lds + RING_BYTES + 1024); E.part = nullptr; E.rs = (const GAS float*)(F.ws + WS_RS);
            g.A = (const GAS bf16*)(F.ws + WS_XB); g.K = DM;
            if (t == 1) { g.Bt = (const GAS bf16*)(wl + W_IN); g.N = NPROJP; E.O = (GAS bf16*)(F.ws + WS_PROJ); E.ldc = NPROJP; }
            else        { g.Bt = (const GAS bf16*)(wl + W_UP); g.N = NUP;    E.O = (GAS bf16*)(F.ws + WS_L); E.ldc = DFF; E.convw = INP(F, I_FCONV) + (size_t)l * 3 * DFF; E.G = (GAS bf16*)(F.ws + WS_G); }
            g.Bt = launder_p(g.Bt); E.O = launder_p(E.O); E.convw = launder_p(E.convw); E.G = launder_p(E.G); g.N = launder_u(g.N); E.ldc = launder_u(E.ldc);
            g.A = launder_p(g.A); E.rs = launder_p(E.rs);
            pg8::StaticOrder S; S.init(M, g.N, F.G, (int)blockIdx.x);
            pg8::gemm_phase<pg8::EpiUni, pg8::StaticOrder, true, true>(F.lds, g, S, E);
        }
        else if (t == 6 || t == 10) {
            pg8::Gemm g; pg8::EpiResid E;
            g.M = M; g.N = DM; E.xl = (pg8::PG8_LAS_T*)(F.lds + RING_BYTES + 1024);
            E.xb = (GAS bf16*)(F.ws + WS_XB); E.outf = F.out; E.rsw = (GAS float*)(F.ws + WS_RS); E.xs = (GAS float*)(F.ws + WS_XS); E.resid = 1;
            if (t == 6) { g.A = (const GAS bf16*)(F.ws + WS_MERGED); g.Bt = (const GAS bf16*)(wl + W_OUT); g.K = DM;  E.gain = INP(F, I_NMPOST) + l * DM; E.cnt = (GAS unsigned*)(F.ctl + CW_PANEL) + (size_t)(l * 2 + 0) * 2 * 128 * 64; }
            else        { g.A = (const GAS bf16*)(F.ws + WS_L);      g.Bt = (const GAS bf16*)(wl + W_DN);  g.K = DFF; E.gain = INP(F, I_NFPOST) + l * DM; if (l + 1 == DEPTH) E.resid = 2; E.cnt = (GAS unsigned*)(F.ctl + CW_PANEL) + (size_t)(l * 2 + 1) * 2 * 128 * 64; }
            g.A = launder_p(g.A); g.Bt = launder_p(g.Bt); g.K = launder_u(g.K); E.gain = launder_p(E.gain); E.cnt = launder_p(E.cnt); E.resid = launder_u(E.resid);
            E.xb = launder_p(E.xb); E.outf = launder_p(E.outf); E.rsw = launder_p(E.rsw); E.xs = launder_p(E.xs);
            pg8::StaticOrder S; S.init(M, g.N, F.G, (int)blockIdx.x);
            pg8::gemm_phase<pg8::EpiResid, pg8::StaticOrder, true, true>(F.lds, g, S, E);
        }
        else if (t == 0) p0_prologue(F);
#ifdef C1_EXP
        else if (t == 3) { phase_mixers(F, l); phase_scan_c1<0>(F, l); phase_scan_c1<C1_EXP>(F, l); }
#else
        else if (t == 3) { phase_mixers(F, l); phase_scan_c1<0>(F, l); }
#endif
#ifdef C2_EXP
        else if (t == 4) { phase_scan_c2<0>(F, l); phase_scan_c2<C2_EXP>(F, l); }
#else
        else if (t == 4) phase_scan_c2<0>(F, l);
#endif
        else if (t == 5) phase_rwkv_post(F, l);
        else if (t == 9) phase_ffn_conv(F, l);
      }
#ifdef REPEAT_T
        if (step + 1 < hi) GRID_BAR();
#else
        if (ph + 1 < hi) GRID_BAR();
#endif
    }
}


#ifdef DBG_CHECK
__global__ void dbg_check(const void* buf, size_t n, int kind, int code, unsigned* flag) {
    bool bad = false;
    for (size_t i = (size_t)blockIdx.x * blockDim.x + threadIdx.x; i < n; i += (size_t)gridDim.x * blockDim.x) {
        float v;
        if (kind == 0) v = bf2f(((const unsigned short*)buf)[i]);
        else if (kind == 1) v = ((const float*)buf)[i];
        else v = (float)((const _Float16*)buf)[i];
        if (!(fabsf(v) < 1e30f)) bad = true;
    }
    if (bad) atomicMax(flag, (unsigned)(1000000 - code));
}
__global__ void dbg_report(float* out, const unsigned* flag) { if (threadIdx.x == 0 && blockIdx.x == 0) { const unsigned f = *flag; if (f) out[0] = 100000.f * (float)(10 + 1000000 - (int)f); } }
#endif
extern "C" void kernel_launch(void* const* d_in, const int* in_sizes, int n_in, void* d_out, int out_size, void* d_ws, size_t ws_size, hipStream_t stream) {
    static int grid = 0;
    if (grid == 0) {
        if (n_in != 26 || in_sizes[0] != M * DM || out_size != M * DM || ws_size < WS_END) { fprintf(stderr, "kernel_launch: unexpected shapes: n_in %d in0 %d out %d ws %zu (need >= %zu)\n", n_in, n_in > 0 ? in_sizes[0] : -1, out_size, ws_size, (size_t)WS_END); grid = -1; return; }
        int dev = 0, cus = 0, per_cu = 0;
        if (hipGetDevice(&dev) != hipSuccess || hipDeviceGetAttribute(&cus, hipDeviceAttributeMultiprocessorCount, dev) != hipSuccess) { grid = -1; return; }
        if (hipFuncSetAttribute((const void*)enc_fwd, hipFuncAttributeMaxDynamicSharedMemorySize, LDS_BYTES) != hipSuccess) { fprintf(stderr, "kernel_launch: hipFuncSetAttribute failed\n"); grid = -1; return; }
        if (hipOccupancyMaxActiveBlocksPerMultiprocessor(&per_cu, (const void*)enc_fwd, NTHREADS, LDS_BYTES) != hipSuccess || per_cu < 1) { fprintf(stderr, "kernel_launch: occupancy query says %d blocks per CU\n", per_cu); }
        (void)hipGetLastError();
        grid = cus;
        if (grid != 256) fprintf(stderr, "kernel_launch: %d CUs (built for 256)\n", grid);
    }
    if (grid < 0) return;
    (void)hipMemsetAsync((char*)d_ws + WS_CTL, 0, CTL_ZERO_BYTES, stream);
    Args a{};
    for (int i = 0; i < 26; ++i) a.in[i] = (const float*)d_in[i];
    a.out = (float*)d_out; a.ws = (unsigned char*)d_ws;
#if MK_N_LAUNCHES == 1
#ifdef REPEAT_T
    a.ph_lo = 0; a.ph_hi = NPH + (REPEAT_T == 7 ? 1 : 2);
#else
    a.ph_lo = 0; a.ph_hi = NPH;
#endif
    hipLaunchKernelGGL(enc_fwd, dim3(grid), dim3(NTHREADS), LDS_BYTES, stream, a);
#else
    for (int p = 0; p < NPH; ++p) { a.ph_lo = p; a.ph_hi = p + 1; hipLaunchKernelGGL(enc_fwd, dim3(grid), dim3(NTHREADS), LDS_BYTES, stream, a);
#ifdef DBG_CHECK
        unsigned* flag = (unsigned*)((char*)d_ws + 512 * 1024); char* ws = (char*)d_ws; const int t = p == 0 ? 0 : 1 + (p - 1) % 10;
#define CHK(ptr, n, kind, sub) hipLaunchKernelGGL(dbg_check, dim3(2048), dim3(256), 0, stream, (const void*)(ptr), (size_t)(n), kind, p * 4 + sub, flag)
        if (t == 0) { CHK(ws + WS_W, 2 * W_LAYER / 2, 0, 0); CHK(ws + WS_XB, (size_t)M * DM, 0, 1); CHK(ws + WS_RS, M, 1, 2); }
        if (t == 1) { CHK(ws + WS_PROJ, (size_t)M * NPROJP, 0, 0); }
        if (t == 2) { CHK(ws + WS_PREP, (size_t)64 * MiB, 2, 1); }
        if (t == 3) { CHK(d_out, (size_t)2 * M * 256, 0, 0); }
        if (t == 4) { CHK(ws + WS_MERGED, (size_t)M * DM, 0, 0); }
        if (t == 5 || t == 9) { CHK(ws + WS_Y, (size_t)M * DM, 1, 0); CHK(ws + WS_PART, (size_t)M * 16, 1, 1); }
        if (t == 6 || t == 10) { CHK(d_out, (size_t)M * DM, 1, 0); CHK(ws + WS_XB, (size_t)M * DM, 0, 1); CHK(ws + WS_RS, M, 1, 2); }
        if (t == 7) { CHK(ws + WS_G, (size_t)M * DFF, 0, 0); CHK(ws + WS_L, (size_t)M * DFF, 0, 1); }
        if (t == 8) { CHK(ws + WS_L, (size_t)M * DFF, 0, 0); }
        if (p == NPH - 1) hipLaunchKernelGGL(dbg_report, dim3(1), dim3(64), 0, stream, (float*)d_out, (const unsigned*)flag);
#endif
    }
#endif
}
```

```cpp
#include <hip/hip_runtime.h>
#include <cstdio>
#include <cstdint>
namespace pg8 {
#define PG8_LAS __attribute__((address_space(3)))
#define PG8_GAS __attribute__((address_space(1)))
typedef PG8_LAS unsigned char PG8_LAS_T;
typedef unsigned short bf16_t;
typedef short bf16x8 __attribute__((ext_vector_type(8)));
typedef float f32x4 __attribute__((ext_vector_type(4)));
typedef unsigned u32x4 __attribute__((ext_vector_type(4)));
constexpr int BM = 256, BK = 64, HALF = 128, HTB = HALF * BK * 2  , STAGE_BYTES = 8 * HTB, NXCD = 8, WGM = 4;

__host__ __device__ __forceinline__ int lds_byte(int r, int c) { const int st = (r >> 4) * 2 + (c >> 5), rr = r & 15, cc = c & 31, ob = rr * 64 + cc * 2; return st * 1024 + (ob ^ (((ob >> 9) & 1) << 5)); }
__host__ __device__ __forceinline__ void stage_rc(int b, int& R, int& C) { const int st = b / 1024, sb = b % 1024, swz = sb ^ (((sb >> 9) & 1) << 5); R = (st >> 1) * 16 + swz / 64; C = (st & 1) * 32 + (swz % 64) / 2; }
__host__ __device__ __forceinline__ int perm32(int rho) { const int n = rho >> 4, i = rho & 15; return 8 * (i >> 2) + 4 * n + (i & 3); }

struct Unit { int pm, pn; };
struct Gemm { const PG8_GAS bf16_t* A; const PG8_GAS bf16_t* Bt; int M, N, K; };

struct StaticOrder {
    int nM, nN, nwg, G, c;
    __host__ __device__ void init(int M, int N, int G_, int c_) { nM = M / BM; nN = N / BM; nwg = nM * nN; G = G_; c = c_; }
    __host__ __device__ bool next(int i, Unit& u) const {
        const long L = (long)i * G + c; if (L >= nwg) return false;
        int wgid = (int)L; { const int q = nwg / NXCD, r = nwg % NXCD, xcd = wgid % NXCD, off = wgid / NXCD; wgid = (xcd < r ? xcd * (q + 1) : r * (q + 1) + (xcd - r) * q) + off; }
        const int nig = WGM * nN, gid = wgid / nig, fm = gid * WGM, gsz = (nM - fm) < WGM ? (nM - fm) : WGM;
        u.pm = fm + ((wgid % nig) % gsz); u.pn = (wgid % nig) / gsz; return true;
    }
    __device__ __forceinline__ void a_ready(const Unit&) const {}
    __device__ __forceinline__ void done(const Unit&) const {}
};
typedef float f32x2c __attribute__((ext_vector_type(2)));
typedef __bf16 bf16x2c __attribute__((ext_vector_type(2)));
__device__ __forceinline__ unsigned cvt_pk_bf16(float lo, float hi) { const f32x2c v = {lo, hi}; return __builtin_bit_cast(unsigned, __builtin_convertvector(v, bf16x2c)); }
struct EpiUni {
    static constexpr bool AFTER_DRAIN = false;
    PG8_GAS bf16_t* O; int ldc; const PG8_GAS float* rs; int split_cols; size_t split_stride; PG8_GAS float* part;
    const PG8_GAS float* convw; PG8_GAS bf16_t* G; PG8_LAS unsigned char* xl;
    __device__ __forceinline__ bool perm() const { return true; }
    template <int CTRL> static __device__ __forceinline__ float dppo(float old, float x) { return __builtin_bit_cast(float, __builtin_amdgcn_update_dpp(__builtin_bit_cast(int, old), __builtin_bit_cast(int, x), CTRL, 0xF, 0xF, false)); }
    static __device__ __forceinline__ float gelu_t(float x) { const float u = 1.5957691216057308f * x * (1.f + 0.044715f * x * x); return x * __builtin_amdgcn_rcpf(1.f + __expf(-u)); }
    __device__ __forceinline__ void conv_epi(const f32x4 (&acc_)[2][2][4][2], const Unit& u, int wr, int wc, int fr, int fq) const {
        f32x4 (&acc)[2][2][4][2] = const_cast<f32x4 (&)[2][2][4][2]>(acc_);
        const int hcol = u.pn * HALF + wc * 32 + 8 * fq;
        const PG8_GAS float* rsp = rs + u.pm * BM + wr * 64 + fr;
        constexpr int LDH = 2816;
        const unsigned lane_off = (unsigned)((wr * 64 + fr) * LDH + hcol) * 2u;
        PG8_GAS char* Ob = (PG8_GAS char*)(O + (size_t)u.pm * BM * LDH); PG8_GAS char* Gb = (PG8_GAS char*)(G + (size_t)u.pm * BM * LDH);
        unsigned lp[2][4][2][2];
#pragma unroll
        for (int ai = 0; ai < 2; ++ai)
#pragma unroll
            for (int m = 0; m < 4; ++m) { const float r = rsp[ai * HALF + m * 16];
#pragma unroll
                for (int n = 0; n < 2; ++n) { const f32x4 l4 = acc[ai][1][m][n] * r; lp[ai][m][n][0] = cvt_pk_bf16(l4[0], l4[1]); lp[ai][m][n][1] = cvt_pk_bf16(l4[2], l4[3]); } }
#pragma unroll
        for (int ai = 0; ai < 2; ++ai) { const int k = 2 * ai + wr;
            if (fr == 0)  { const float r = rsp[ai * HALF]; PG8_LAS f32x4* p = (PG8_LAS f32x4*)(xl + ((k * 2 + 0) * 4 + wc) * 128 + fq * 32); p[0] = acc[ai][0][0][0] * r; p[1] = acc[ai][0][0][1] * r; }
            if (fr == 15) { const float r = rsp[ai * HALF + 48]; PG8_LAS f32x4* p = (PG8_LAS f32x4*)(xl + ((k * 2 + 1) * 4 + wc) * 128 + fq * 32); p[0] = acc[ai][0][3][0] * r; p[1] = acc[ai][0][3][1] * r; } }
        asm volatile("s_waitcnt lgkmcnt(0)" ::: "memory"); __builtin_amdgcn_s_barrier(); asm volatile("" ::: "memory");
#pragma unroll
        for (int ai = 0; ai < 2; ++ai) { const int k = 2 * ai + wr;
            float rsv[4];
#pragma unroll
            for (int m = 0; m < 4; ++m) { rsv[m] = rsp[ai * HALF + m * 16];
#pragma unroll
                for (int n = 0; n < 2; ++n) acc[ai][0][m][n] = acc[ai][0][m][n] * rsv[m]; }
            const int ku = k > 0 ? k - 1 : 0, kd = k < 3 ? k + 1 : 3;
#pragma unroll
            for (int n = 0; n < 2; ++n) {
                float w0[4], w1[4], w2[4];
#pragma unroll
                for (int j = 0; j < 4; ++j) { w0[j] = convw[hcol + 4 * n + j]; w1[j] = convw[LDH + hcol + 4 * n + j]; w2[j] = convw[2 * LDH + hcol + 4 * n + j]; }
                const f32x4 xt = *(const PG8_LAS f32x4*)(xl + ((ku * 2 + 1) * 4 + wc) * 128 + fq * 32 + n * 16), xb = *(const PG8_LAS f32x4*)(xl + ((kd * 2 + 0) * 4 + wc) * 128 + fq * 32 + n * 16);
#pragma unroll
                for (int m = 0; m < 4; ++m) { const int tr = 64 * k + 16 * m + fr; const unsigned coff = (unsigned)((ai * HALF + 16 * m) * LDH * 2 + 8 * n);
                    float hv[4];
#pragma unroll
                    for (int e = 0; e < 4; ++e) { const float cur = acc[ai][0][m][n][e];
                        const float upx = (m > 0) ? dppo<0x121>(0.f, acc[ai][0][m > 0 ? m - 1 : 0][n][e]) : xt[e];
                        const float dnx = (m < 3) ? dppo<0x12F>(0.f, acc[ai][0][m < 3 ? m + 1 : 3][n][e]) : xb[e];
                        const float up = dppo<0x111>(upx, cur), dn = dppo<0x101>(dnx, cur);
                        const float a = w0[e] * up + w1[e] * cur + w2[e] * dn;
                        const unsigned lw = lp[ai][m][n][e >> 1]; const float lv = (e & 1) ? __builtin_bit_cast(float, lw & 0xffff0000u) : __builtin_bit_cast(float, lw << 16);
                        hv[e] = (tr == 0 || tr == 255) ? lv : gelu_t(a) * lv; }
                    typedef unsigned u32x2_ __attribute__((ext_vector_type(2)));
                    u32x2_ w; w.x = cvt_pk_bf16(hv[0], hv[1]); w.y = cvt_pk_bf16(hv[2], hv[3]);
                    *(PG8_GAS u32x2_*)(Ob + coff + lane_off) = w;
                    if (tr <= 1 || tr >= 254) { u32x2_ gw; gw.x = cvt_pk_bf16(acc[ai][0][m][n][0], acc[ai][0][m][n][1]); gw.y = cvt_pk_bf16(acc[ai][0][m][n][2], acc[ai][0][m][n][3]);
                        *(PG8_GAS u32x2_*)(Gb + coff + lane_off) = gw; }
                    __builtin_amdgcn_sched_barrier(0); }
                asm volatile("" ::: "memory");
            }
        }
    }
    __device__ __forceinline__ void operator()(const f32x4 (&acc)[2][2][4][2], const Unit& u, int wr, int wc, int fr, int fq) const {
        if (convw != nullptr) { conv_epi(acc, u, wr, wc, fr, fq); return; }
        const int row0 = u.pm * BM + wr * 64 + fr; int colt = u.pn * BM; PG8_GAS bf16_t* base = O;
        if (split_cols) { const int t = colt / split_cols; base += (size_t)t * split_stride; colt -= t * split_cols; }
        const int col0 = colt + wc * 32 + 8 * fq;
        if (part == nullptr) {
#pragma unroll
            for (int ai = 0; ai < 2; ++ai)
#pragma unroll
                for (int m = 0; m < 4; ++m) { const int row = row0 + ai * HALF + m * 16; const float s = rs[row]; PG8_GAS bf16_t* rowp = base + (size_t)row * ldc + col0;
#pragma unroll
                    for (int bj = 0; bj < 2; ++bj) { const f32x4 v0 = acc[ai][bj][m][0] * s, v1 = acc[ai][bj][m][1] * s;
                        u32x4 w; w.x = cvt_pk_bf16(v0[0], v0[1]); w.y = cvt_pk_bf16(v0[2], v0[3]); w.z = cvt_pk_bf16(v1[0], v1[1]); w.w = cvt_pk_bf16(v1[2], v1[3]);
                        *(PG8_GAS u32x4*)(rowp + bj * HALF) = w; } }
        } else {
#pragma unroll
            for (int ai = 0; ai < 2; ++ai)
#pragma unroll
                for (int m = 0; m < 4; ++m) { const int row = row0 + ai * HALF + m * 16; PG8_GAS bf16_t* rowp = base + (size_t)row * ldc + col0; float ss = 0.f;
#pragma unroll
                    for (int bj = 0; bj < 2; ++bj) { const f32x4 v0 = acc[ai][bj][m][0], v1 = acc[ai][bj][m][1];
                        ss += ((v0[0] * v0[0] + v0[1] * v0[1]) + (v0[2] * v0[2] + v0[3] * v0[3])) + ((v1[0] * v1[0] + v1[1] * v1[1]) + (v1[2] * v1[2] + v1[3] * v1[3]));
                        u32x4 w; w.x = cvt_pk_bf16(v0[0], v0[1]); w.y = cvt_pk_bf16(v0[2], v0[3]); w.z = cvt_pk_bf16(v1[0], v1[1]); w.w = cvt_pk_bf16(v1[2], v1[3]);
                        *(PG8_GAS u32x4*)(rowp + bj * HALF) = w; }
                    ss += __shfl_xor(ss, 16); ss += __shfl_xor(ss, 32); if (fq == 0) part[(size_t)row * 16 + u.pn * 4 + wc] = ss; }
        }
    }
};
struct EpiResid {
    static constexpr bool AFTER_DRAIN = false;
    PG8_LAS unsigned char* xl;
    __device__ __forceinline__ bool perm() const { return true; }
    int resid; const PG8_GAS float* gain; PG8_GAS bf16_t* xb; PG8_GAS float* outf; PG8_GAS float* rsw; PG8_GAS float* xs; PG8_GAS unsigned* cnt;
    static __device__ __forceinline__ f32x4 unlo(unsigned a, unsigned b) { return (f32x4){__builtin_bit_cast(float, a << 16), __builtin_bit_cast(float, a & 0xffff0000u), __builtin_bit_cast(float, b << 16), __builtin_bit_cast(float, b & 0xffff0000u)}; }
    static __device__ __forceinline__ float hsum(const f32x4 v) { return (v[0] + v[1]) + (v[2] + v[3]); }
    __device__ __forceinline__ void resid_epi(const f32x4 (&acc_)[2][2][4][2], const Unit& u, int, int, int, int) const {
        f32x4 (&acc)[2][2][4][2] = const_cast<f32x4 (&)[2][2][4][2]>(acc_);
        int tid = threadIdx.x; asm volatile("" : "+v"(tid));
        const int wid = __builtin_amdgcn_readfirstlane(tid >> 6), wr = wid >> 2, wc = wid & 3, fr = tid & 15, fq = (tid >> 4) & 3;
        const int col0 = u.pn * BM + wc * 32 + 8 * fq;
        const unsigned lane_e = (unsigned)((wr * 64 + fr) * 1024 + col0);
        PG8_GAS char* xbb = (PG8_GAS char*)(xb + (size_t)u.pm * BM * 1024); PG8_GAS char* outb = (PG8_GAS char*)(outf + (size_t)u.pm * BM * 1024);
        PG8_LAS f32x4* P4 = (PG8_LAS f32x4*)xl; PG8_LAS float* S2 = (PG8_LAS float*)(xl + 16384);
        PG8_LAS float* GW = (PG8_LAS float*)(xl + 18432) + (wr * 4 + wc) * 64;
        { const int ln = fq * 16 + fr; GW[ln] = gain[u.pn * BM + (ln >> 5) * HALF + wc * 32 + (ln & 31)]; }
#pragma unroll
        for (int ai = 0; ai < 2; ++ai)
#pragma unroll
            for (int m = 0; m < 4; ++m) {
#pragma unroll
                for (int bj = 0; bj < 2; ++bj) { const f32x4 v0 = acc[ai][bj][m][0], v1 = acc[ai][bj][m][1];
                    u32x4 p; p.x = cvt_pk_bf16(v0[0], v0[1]); p.y = cvt_pk_bf16(v0[2], v0[3]); p.z = cvt_pk_bf16(v1[0], v1[1]); p.w = cvt_pk_bf16(v1[2], v1[3]);
                    acc[ai][bj][m][0] = __builtin_bit_cast(f32x4, p); }
                __builtin_amdgcn_sched_barrier(0); }
#define PG8_XLD(it_) do { unsigned le_ = lane_e; asm volatile("" : "+v"(le_)); _Pragma("unroll") for (int bj = 0; bj < 2; ++bj) \
            xq[(it_) % 3][bj] = *(const PG8_GAS u32x4*)(xbb + (size_t)((unsigned)(((((it_) >> 2) * HALF) + 16 * ((it_) & 3)) * 1024 + bj * HALF) + le_) * 2); } while (0)
        {   u32x4 xq[3][2];
            PG8_XLD(0); PG8_XLD(1);
#pragma unroll
            for (int it = 0; it < 8; ++it) { const int ai = it >> 2, m = it & 3;
                if (it + 2 < 8) PG8_XLD(it + 2);
                float sa = 0.f, sb = 0.f, sc = 0.f, sd = 0.f;
#pragma unroll
                for (int bj = 0; bj < 2; ++bj) { f32x4 py_ = acc[ai][bj][m][0]; asm volatile("" : "+v"(py_));
                    const u32x4 p = __builtin_bit_cast(u32x4, py_), xw = xq[it % 3][bj];
                    const f32x4 g0 = *(const PG8_LAS f32x4*)(GW + bj * 32 + 8 * fq), g1 = *(const PG8_LAS f32x4*)(GW + bj * 32 + 8 * fq + 4);
                    const f32x4 y0 = unlo(p.x, p.y), y1 = unlo(p.z, p.w), x0 = unlo(xw.x, xw.y), x1 = unlo(xw.z, xw.w), q0 = y0 * g0, q1 = y1 * g1;
                    sa += hsum(y0 * y0) + hsum(y1 * y1); sb += hsum(x0 * x0) + hsum(x1 * x1); sc += hsum(x0 * q0) + hsum(x1 * q1); sd += hsum(q0 * q0) + hsum(q1 * q1); }
                sa += __shfl_xor(sa, 16); sb += __shfl_xor(sb, 16); sc += __shfl_xor(sc, 16); sd += __shfl_xor(sd, 16);
                sa += __shfl_xor(sa, 32); sb += __shfl_xor(sb, 32); sc += __shfl_xor(sc, 32); sd += __shfl_xor(sd, 32);
                if (fq == 0) P4[(ai * HALF + wr * 64 + m * 16 + fr) * 4 + wc] = (f32x4){sa, sb, sc, sd};
                __builtin_amdgcn_sched_barrier(0); } }
        asm volatile("s_waitcnt lgkmcnt(0)" ::: "memory"); __builtin_amdgcn_s_barrier(); asm volatile("" ::: "memory");
        PG8_GAS float* slot = xs + (size_t)u.pm * BM * 16;
        PG8_GAS unsigned* c = cnt + u.pm * 64;
        if (tid < 256) { const f32x4 t4 = (P4[tid * 4 + 0] + P4[tid * 4 + 1]) + (P4[tid * 4 + 2] + P4[tid * 4 + 3]);
#pragma unroll
            for (int j = 0; j < 4; ++j) __hip_atomic_store(slot + tid * 16 + u.pn * 4 + j, t4[j], __ATOMIC_RELAXED, __HIP_MEMORY_SCOPE_AGENT);
            asm volatile("s_waitcnt vmcnt(0)" ::: "memory");
            if ((tid & 63) == 0) __hip_atomic_fetch_add(c, 1u, __ATOMIC_RELAXED, __HIP_MEMORY_SCOPE_AGENT); }
        if (tid < 64) { unsigned spins = 0;
            while ((unsigned)__builtin_amdgcn_readfirstlane(__hip_atomic_load(c, __ATOMIC_RELAXED, __HIP_MEMORY_SCOPE_AGENT)) < 16u) { __builtin_amdgcn_s_sleep(2); if (++spins > (1u << 22)) break; }
            __builtin_amdgcn_fence(__ATOMIC_ACQUIRE, "agent"); asm volatile("s_waitcnt vmcnt(0)" ::: "memory"); }
        asm volatile("s_waitcnt lgkmcnt(0)" ::: "memory"); __builtin_amdgcn_s_barrier(); asm volatile("" ::: "memory");
        if (tid < 256) { float t[4] = {0.f, 0.f, 0.f, 0.f};
#pragma unroll
            for (int q = 0; q < 4; ++q)
#pragma unroll
                for (int j = 0; j < 4; ++j) t[j] += __hip_atomic_load(slot + tid * 16 + q * 4 + j, __ATOMIC_RELAXED, __HIP_MEMORY_SCOPE_AGENT);
            const float ry = __builtin_amdgcn_rsqf(t[0] * (1.f / 1024.f) + 1e-6f);
            const float sx = t[1] + ry * (2.f * t[2] + ry * t[3]);
            const float rn = __builtin_amdgcn_rsqf(sx * (1.f / 1024.f) + 1e-6f);
            S2[tid * 2] = ry; S2[tid * 2 + 1] = rn;
            if (resid == 1 && u.pn == 0) rsw[(size_t)u.pm * BM + tid] = rn; }
        asm volatile("s_waitcnt lgkmcnt(0)" ::: "memory"); __builtin_amdgcn_s_barrier(); asm volatile("" ::: "memory");
        {   u32x4 xq[3][2];
            PG8_XLD(0); PG8_XLD(1);
#pragma unroll
            for (int it = 0; it < 8; ++it) { const int ai = it >> 2, m = it & 3;
                if (it + 2 < 8) PG8_XLD(it + 2);
                const float sc = S2[(ai * HALF + wr * 64 + m * 16 + fr) * 2];
                unsigned le = lane_e; asm volatile("" : "+v"(le));
#pragma unroll
                for (int bj = 0; bj < 2; ++bj) { const unsigned ce = (unsigned)((ai * HALF + 16 * m) * 1024 + bj * HALF);
                    f32x4 py_ = acc[ai][bj][m][0]; asm volatile("" : "+v"(py_));
                    const u32x4 p = __builtin_bit_cast(u32x4, py_), xw = xq[it % 3][bj];
                    const f32x4 g0 = *(const PG8_LAS f32x4*)(GW + bj * 32 + 8 * fq), g1 = *(const PG8_LAS f32x4*)(GW + bj * 32 + 8 * fq + 4);
                    const f32x4 v0 = unlo(xw.x, xw.y) + unlo(p.x, p.y) * sc * g0, v1 = unlo(xw.z, xw.w) + unlo(p.z, p.w) * sc * g1;
                    if (resid == 2) { PG8_GAS f32x4* op = (PG8_GAS f32x4*)(outb + (size_t)(ce + le) * 4); op[0] = v0; op[1] = v1; }
                    else { u32x4 w; w.x = cvt_pk_bf16(v0[0], v0[1]); w.y = cvt_pk_bf16(v0[2], v0[3]); w.z = cvt_pk_bf16(v1[0], v1[1]); w.w = cvt_pk_bf16(v1[2], v1[3]);
                        *(PG8_GAS u32x4*)(xbb + (size_t)(ce + le) * 2) = w; } }
                asm volatile("" ::: "memory"); __builtin_amdgcn_sched_barrier(0); } }
#undef PG8_XLD
    }
    __device__ __forceinline__ void operator()(const f32x4 (&acc)[2][2][4][2], const Unit& u, int wr, int wc, int fr, int fq) const { resid_epi(acc, u, wr, wc, fr, fq); }
};
template <class Epi, class Sched, bool ALIGN_EPI = false, bool SP2 = false>
__device__ __forceinline__ void gemm_phase(PG8_LAS unsigned char* lds, const Gemm g, const Sched& S, const Epi& E) {
    int tid_ = threadIdx.x; asm volatile("" : "+v"(tid_));
    const int tid = tid_, wid = __builtin_amdgcn_readfirstlane(tid >> 6), lane = tid & 63, wr = wid >> 2, wc = wid & 3, fr = lane & 15, fq = lane >> 4;
    const int K = g.K, nt = K / BK;
    unsigned voffA[2], voffB[2];
#pragma unroll
    for (int i = 0; i < 2; ++i) { int R, C; stage_rc(tid * 16 + i * 8192, R, C); const int Rb = E.perm() ? ((R & ~31) + perm32(R & 31)) : R;
        voffA[i] = (unsigned)(R * K + C) * 2u; voffB[i] = (unsigned)(Rb * K + C) * 2u; }
    const size_t kstep = (size_t)(BK * 2);
    const size_t hstep = (size_t)HALF * K * 2;
    const size_t tstep = 2 * hstep;
    const unsigned ldsw = (unsigned)wid * 1024u;
    const int aoff = lds_byte(wr * 64 + fr, fq * 8), boff = lds_byte(wc * 32 + fr, fq * 8);
#define PG8_SA(b, h) (((b) * 2 + (h)) * HTB)
#define PG8_SB(b, h) ((4 + (b) * 2 + (h)) * HTB)
#define PG8_STAGE(bufoff, gbase, voff) do { _Pragma("unroll") for (int _i = 0; _i < 2; ++_i) \
        __builtin_amdgcn_global_load_lds((const PG8_GAS unsigned*)((const PG8_GAS char*)(gbase) + (voff)[_i]), (PG8_LAS unsigned*)(lds + (bufoff) + ldsw + _i * 8192), 16, 0, 0); } while (0)
#define PG8_LDA(dst, b, h) do { _Pragma("unroll") for (int m = 0; m < 4; ++m) _Pragma("unroll") for (int k = 0; k < 2; ++k) dst[m][k] = *(const PG8_LAS bf16x8*)(lds + PG8_SA(b, h) + aoff + m * 2048 + k * 1024); } while (0)
#define PG8_LDB(dst, b, h) do { _Pragma("unroll") for (int n = 0; n < 2; ++n) _Pragma("unroll") for (int k = 0; k < 2; ++k) dst[n][k] = *(const PG8_LAS bf16x8*)(lds + PG8_SB(b, h) + boff + n * 2048 + k * 1024); } while (0)
#define PG8_MMA(ai, bj, At, Bt) do { __builtin_amdgcn_s_setprio(1); _Pragma("unroll") for (int m = 0; m < 4; ++m) _Pragma("unroll") for (int n = 0; n < 2; ++n) _Pragma("unroll") for (int k = 0; k < 2; ++k) \
        acc[ai][bj][m][n] = __builtin_amdgcn_mfma_f32_16x16x32_bf16(Bt[n][k], At[m][k], acc[ai][bj][m][n], 0, 0, 0); __builtin_amdgcn_s_setprio(0); } while (0)
#define PG8_WAIT_V(n) asm volatile("s_waitcnt vmcnt(" #n ")" ::: "memory")
#define PG8_WAIT_L(n) asm volatile("s_waitcnt lgkmcnt(" #n ")" ::: "memory")
#define PG8_BAR __builtin_amdgcn_s_barrier()
#define PG8_SCHED __builtin_amdgcn_sched_barrier(0)
    Unit cur, nxt; int ui = 0;
    if (!S.next(0, cur)) return;
    f32x4 acc[2][2][4][2];
#pragma unroll
    for (int a = 0; a < 2; ++a)
#pragma unroll
        for (int b = 0; b < 2; ++b)
#pragma unroll
            for (int m = 0; m < 4; ++m)
#pragma unroll
                for (int n = 0; n < 2; ++n) acc[a][b][m][n] = (f32x4){0.f, 0.f, 0.f, 0.f};
    bf16x8 At[4][2], B0[2][2], B1[2][2];
    const PG8_GAS char* cA = (const PG8_GAS char*)g.A + (size_t)cur.pm * tstep; const PG8_GAS char* cB = (const PG8_GAS char*)g.Bt + (size_t)cur.pn * tstep;
    S.a_ready(cur);
    if constexpr (SP2) {
        PG8_STAGE(PG8_SB(0, 0), cB, voffB); PG8_STAGE(PG8_SB(0, 1), cB + hstep, voffB); PG8_STAGE(PG8_SA(0, 0), cA, voffA); PG8_STAGE(PG8_SA(0, 1), cA + hstep, voffA);
        if (wr == 1) PG8_BAR;
        PG8_WAIT_V(2); PG8_BAR;
        PG8_STAGE(PG8_SB(1, 0), cB + kstep, voffB); PG8_STAGE(PG8_SA(1, 0), cA + kstep, voffA); PG8_STAGE(PG8_SB(1, 1), cB + hstep + kstep, voffB);
        PG8_WAIT_V(6); PG8_BAR;
    } else {
        PG8_STAGE(PG8_SB(0, 0), cB, voffB); PG8_STAGE(PG8_SA(0, 0), cA, voffA); PG8_STAGE(PG8_SB(0, 1), cB + hstep, voffB); PG8_STAGE(PG8_SA(0, 1), cA + hstep, voffA);
        if (wr == 1) PG8_BAR;
        PG8_WAIT_V(4); PG8_BAR;
        PG8_STAGE(PG8_SB(1, 0), cB + kstep, voffB); PG8_STAGE(PG8_SA(1, 0), cA + kstep, voffA); PG8_STAGE(PG8_SB(1, 1), cB + hstep + kstep, voffB);
        PG8_WAIT_V(6); PG8_BAR;
    }
    for (;;) {
        const bool has_next = S.next(ui + 1, nxt);
        const PG8_GAS char* nA = has_next ? (const PG8_GAS char*)g.A + (size_t)nxt.pm * tstep : cA; const PG8_GAS char* nB = has_next ? (const PG8_GAS char*)g.Bt + (size_t)nxt.pn * tstep : cB;
        for (int t = 0; t < nt; t += 2) {
            const bool last = (t == nt - 2);
            const PG8_GAS char* a1 = cA + (size_t)(t + 1) * kstep;
            const PG8_GAS char* a2 = last ? nA : cA + (size_t)(t + 2) * kstep; const PG8_GAS char* b2 = last ? nB : cB + (size_t)(t + 2) * kstep;
            const PG8_GAS char* a3 = a2 + kstep; const PG8_GAS char* b3 = b2 + kstep;
            if (last && has_next) S.a_ready(nxt);
            if constexpr (SP2) {
            PG8_LDB(B0, 0, 0); PG8_LDB(B1, 0, 1); PG8_SCHED; PG8_LDA(At, 0, 0); PG8_STAGE(PG8_SA(1, 1), a1 + hstep, voffA);
            PG8_WAIT_V(8); PG8_WAIT_L(0); PG8_BAR; PG8_MMA(0, 0, At, B0); PG8_MMA(0, 1, At, B1); PG8_BAR; PG8_SCHED;
            PG8_LDA(At, 0, 1); PG8_STAGE(PG8_SB(0, 0), b2, voffB); PG8_STAGE(PG8_SB(0, 1), b2 + hstep, voffB); PG8_STAGE(PG8_SA(0, 0), a2, voffA);
            PG8_WAIT_V(8); PG8_WAIT_L(0); PG8_BAR; PG8_MMA(1, 0, At, B0); PG8_MMA(1, 1, At, B1); PG8_BAR; PG8_SCHED;
            PG8_LDB(B0, 1, 0); PG8_LDB(B1, 1, 1); PG8_SCHED; PG8_LDA(At, 1, 0); PG8_STAGE(PG8_SA(0, 1), a2 + hstep, voffA);
            PG8_WAIT_V(8); PG8_WAIT_L(0); PG8_BAR; PG8_MMA(0, 0, At, B0); PG8_MMA(0, 1, At, B1); PG8_BAR; PG8_SCHED;
            PG8_LDA(At, 1, 1); PG8_STAGE(PG8_SB(1, 0), b3, voffB); PG8_STAGE(PG8_SB(1, 1), b3 + hstep, voffB); PG8_STAGE(PG8_SA(1, 0), a3, voffA);
            PG8_WAIT_V(8); PG8_WAIT_L(0); PG8_BAR; PG8_MMA(1, 0, At, B0); PG8_MMA(1, 1, At, B1); PG8_BAR; PG8_SCHED;
            } else {
            PG8_LDB(B0, 0, 0); PG8_SCHED; PG8_LDA(At, 0, 0); PG8_STAGE(PG8_SA(1, 1), a1 + hstep, voffA);
            PG8_WAIT_L(8); PG8_BAR; PG8_WAIT_L(0); PG8_MMA(0, 0, At, B0); PG8_BAR; PG8_SCHED;
            PG8_LDB(B1, 0, 1); PG8_STAGE(PG8_SB(0, 0), b2, voffB);
            PG8_BAR; PG8_WAIT_L(0); PG8_MMA(0, 1, At, B1); PG8_BAR;
            PG8_LDA(At, 0, 1); PG8_STAGE(PG8_SA(0, 0), a2, voffA);
            PG8_BAR; PG8_WAIT_L(0); PG8_MMA(1, 0, At, B0); PG8_BAR; PG8_SCHED;
            PG8_STAGE(PG8_SB(0, 1), b2 + hstep, voffB);
            PG8_WAIT_V(6); PG8_BAR; PG8_MMA(1, 1, At, B1); PG8_BAR;
            PG8_LDB(B0, 1, 0); PG8_SCHED; PG8_LDA(At, 1, 0); PG8_STAGE(PG8_SA(0, 1), a2 + hstep, voffA);
            PG8_WAIT_L(8); PG8_BAR; PG8_WAIT_L(0); PG8_MMA(0, 0, At, B0); PG8_BAR; PG8_SCHED;
            PG8_LDB(B1, 1, 1); PG8_STAGE(PG8_SB(1, 0), b3, voffB);
            PG8_BAR; PG8_WAIT_L(0); PG8_MMA(0, 1, At, B1); PG8_BAR;
            PG8_LDA(At, 1, 1); PG8_STAGE(PG8_SA(1, 0), a3, voffA);
            PG8_BAR; PG8_WAIT_L(0); PG8_MMA(1, 0, At, B0); PG8_BAR; PG8_SCHED;
            PG8_STAGE(PG8_SB(1, 1), b3 + hstep, voffB);
            PG8_WAIT_V(6); PG8_BAR; PG8_MMA(1, 1, At, B1); PG8_BAR;
            }
        }
        if constexpr (ALIGN_EPI) { if (wr == 0) PG8_BAR; }
        if constexpr (!Epi::AFTER_DRAIN) { E(acc, cur, wr, wc, fr, fq); S.done(cur); }
        if (!has_next) break;
#pragma unroll
        for (int a = 0; a < 2; ++a)
#pragma unroll
            for (int b = 0; b < 2; ++b)
#pragma unroll
                for (int m = 0; m < 4; ++m)
#pragma unroll
                    for (int n = 0; n < 2; ++n) acc[a][b][m][n] = (f32x4){0.f, 0.f, 0.f, 0.f};
        cur = nxt; cA = nA; cB = nB; ++ui;
        if constexpr (ALIGN_EPI) { if (wr == 1) PG8_BAR; }
    }
    PG8_WAIT_V(0);
    if constexpr (!ALIGN_EPI) { if (wr == 0) PG8_BAR; }
    PG8_BAR;
    if constexpr (Epi::AFTER_DRAIN) { E.fused(acc, cur, wr, wc, fr, fq, lds, wid, lane); S.done(cur); }
#undef PG8_SA
#undef PG8_SB
#undef PG8_STAGE
#undef PG8_LDA
#undef PG8_LDB
#undef PG8_MMA
#undef PG8_WAIT_V
#undef PG8_WAIT_L
#undef PG8_BAR
#undef PG8_SCHED
}
}

constexpr int NB = 8, T = 4096, DM = 1024, M = NB * T, DEPTH = 2;
constexpr int NPROJ = 2912, NPROJP = 3072, DFF = 2816, NUP = 2 * DFF;
constexpr int C_CH = 0, C_CB = 256, C_CC = 512, C_R = 768, C_K = 1024, C_V = 1280, C_DEC = 1536, C_GDN = 1600, C_NQ = 1632, C_NK = 1888, C_NV = 2144, C_SU = 2400, C_SV = 2656;
constexpr float NORM_EPS = 1e-6f, GN_EPS = 64e-5f, DECAY_SCALE = 0.60653065971263342f;
constexpr int NWAVES = 8, NTHREADS = 512;
constexpr size_t MiB = 1u << 20;
constexpr size_t WS_CTL = 0, CTL_ZERO_BYTES = 1 * MiB;
constexpr size_t WS_RS = 1 * MiB;
constexpr size_t WS_PART = 1 * MiB + 256 * 1024;
constexpr size_t WS_W = 4 * MiB, W_LAYER = 24 * MiB + 512 * 1024;
constexpr size_t W_IN = 0, W_OUT = 6 * MiB, W_UP = 8 * MiB, W_DN = 19 * MiB;
constexpr size_t WS_XB = 53 * MiB;
constexpr size_t WS_R = 117 * MiB;
constexpr size_t WS_PROJ = WS_R, WS_MERGED = WS_R + 192 * MiB, WS_PREP = WS_R + 256 * MiB;
constexpr size_t GT_CHUNK = 12800, GT_DIR = (size_t)NB * 4 * 256 * GT_CHUNK;
constexpr size_t WS_GT0 = WS_PREP, WS_YSC0 = WS_PREP + 100 * MiB;
static_assert(GT_DIR == 100 * MiB, "GT size");
constexpr size_t WS_Y = WS_R;
constexpr size_t WS_G = WS_R, WS_L = WS_R + 176 * MiB;
constexpr size_t WS_END = 501 * MiB;
static_assert(WS_W + 2 * W_LAYER <= WS_XB && WS_PREP + 128 * MiB <= WS_END && WS_L + 176 * MiB <= WS_END && WS_PART + (size_t)M * 64 <= WS_W, "ws map");
constexpr int CW_BAR = 4096;
constexpr int CW_PANEL = 16384;
constexpr size_t WS_XS = WS_PART;
constexpr int RING_BYTES = 131072, LDSCTL_OFF = RING_BYTES, MISC_OFF = LDSCTL_OFF + 320, LDS_BYTES = 152576;

#define GAS __attribute__((address_space(1)))
#define LAS __attribute__((address_space(3)))
typedef unsigned short bf16;
typedef unsigned v4u __attribute__((ext_vector_type(4)));
typedef unsigned v2u __attribute__((ext_vector_type(2)));
typedef float f32x4 __attribute__((ext_vector_type(4)));
typedef short bf16x8 __attribute__((ext_vector_type(8)));
typedef short s16x4 __attribute__((ext_vector_type(4)));
typedef _Float16 h2 __attribute__((ext_vector_type(2)));
typedef GAS unsigned gu32;
#define RLX_AGENT __ATOMIC_RELAXED, __HIP_MEMORY_SCOPE_AGENT
__device__ __forceinline__ unsigned pk2(float lo, float hi) { return pg8::cvt_pk_bf16(lo, hi); }
__device__ __forceinline__ unsigned f2bf(float f) { return (unsigned)__builtin_bit_cast(unsigned short, (__bf16)f); }
__device__ __forceinline__ float bflo(unsigned w) { return __builtin_bit_cast(float, w << 16); }
__device__ __forceinline__ float bfhi(unsigned w) { return __builtin_bit_cast(float, w & 0xffff0000u); }
__device__ __forceinline__ float bf2f(unsigned short b) { return __builtin_bit_cast(float, (unsigned)b << 16); }
__device__ __forceinline__ h2 as_h2(unsigned u) { return __builtin_bit_cast(h2, u); }
template <int CTRL> __device__ __forceinline__ float dppmov(float x) { return __builtin_bit_cast(float, __builtin_amdgcn_update_dpp(0, __builtin_bit_cast(int, x), CTRL, 0xF, 0xF, true)); }
__device__ __forceinline__ float row16_sum(float x) { x += dppmov<0xB1>(x); x += dppmov<0x4E>(x); x += dppmov<0x141>(x); x += dppmov<0x140>(x); return x; }
typedef unsigned u32x2_t __attribute__((ext_vector_type(2)));
__device__ __forceinline__ float xor16_sum(float x) { const u32x2_t r = __builtin_amdgcn_permlane16_swap(__builtin_bit_cast(unsigned, x), __builtin_bit_cast(unsigned, x), false, false);
    const unsigned a = r.x, b = r.y; return __builtin_bit_cast(float, a) + __builtin_bit_cast(float, b); }
__device__ __forceinline__ float xor32_sum(float x) { const u32x2_t r = __builtin_amdgcn_permlane32_swap(__builtin_bit_cast(unsigned, x), __builtin_bit_cast(unsigned, x), false, false);
    const unsigned a = r.x, b = r.y; return __builtin_bit_cast(float, a) + __builtin_bit_cast(float, b); }
__device__ __forceinline__ float wave_sum(float v) { return xor32_sum(xor16_sum(row16_sum(v))); }
__device__ __forceinline__ float row16_max(float x) { x = fmaxf(x, dppmov<0xB1>(x)); x = fmaxf(x, dppmov<0x4E>(x)); x = fmaxf(x, dppmov<0x141>(x)); x = fmaxf(x, dppmov<0x140>(x)); return x; }
__device__ __forceinline__ float rcpf_(float x) { return __builtin_amdgcn_rcpf(x); }
__device__ __forceinline__ float rsqf_(float x) { return __builtin_amdgcn_rsqf(x); }
__device__ __forceinline__ float sigmoidf_(float x) { return rcpf_(1.f + __expf(-x)); }
__device__ __forceinline__ float tanhf_(float x) { return 1.f - 2.f * rcpf_(__expf(2.f * x) + 1.f); }
__device__ __forceinline__ float gelu_tanh(float x) { const float u = 1.5957691216057308f * x * (1.f + 0.044715f * x * x); return x * rcpf_(1.f + __expf(-u)); }
#define XB_TMO      128
#define XB_XCNT(j)  (256  + 64 * (j))
#define XB_XSUB(j)  (1280 + 64 * (j))
#define XB_XGEN(j)  (2304 + 64 * (j))
#define XB_TOP      3328
#define XB_TOPGEN   3392
#define XCD_BAR_WORDS 3456
#define XB_SPIN_CAP (1u << 18)

__device__ __forceinline__ unsigned xb_ld(unsigned* p)              { return __hip_atomic_load(p, __ATOMIC_RELAXED, __HIP_MEMORY_SCOPE_AGENT); }
__device__ __forceinline__ unsigned xb_add(unsigned* p, unsigned v) { return __hip_atomic_fetch_add(p, v, __ATOMIC_RELAXED, __HIP_MEMORY_SCOPE_AGENT); }
__device__ __forceinline__ unsigned xb_xcc_id() { return (unsigned)__builtin_amdgcn_s_getreg((3 << 11) | 20) & 0xFu; }
#define XB_SPIN(cond, bar) do { unsigned _sp = 0; while (cond) { __builtin_amdgcn_s_sleep(1); \
    if ((++_sp & 255u) == 0u) { if (xb_ld(&(bar)[XB_TMO])) break; if (_sp > XB_SPIN_CAP) { atomicAdd(&(bar)[XB_TMO], 1u); break; } } } } while (0)

struct XcdBarrier {
    unsigned* bar; unsigned x;
    volatile LAS unsigned* st;
};

__device__ __forceinline__ XcdBarrier xcd_barrier_post(unsigned* bar, volatile LAS unsigned* st) {
    XcdBarrier b; b.bar = bar; b.x = xb_xcc_id(); b.st = st;
    if (threadIdx.x == 0) (void)xb_add(&bar[XB_XCNT(b.x)], 1u);
    return b;
}
__device__ __forceinline__ void xcd_barrier_complete(unsigned* bar, unsigned x, unsigned& nloc, unsigned& nx) {
    const unsigned G = gridDim.x * gridDim.y * gridDim.z;
    unsigned sum, cnt, mine, sp = 0u;
    for (;;) {
        sum = 0u; cnt = 0u; mine = 0u;
#pragma unroll
        for (unsigned j = 0; j < 16; ++j) { const unsigned c = xb_ld(&bar[XB_XCNT(j)]); sum += c; cnt += (c > 0u) ? 1u : 0u; mine = (j == x) ? c : mine; }
        if (sum == G) break;
        __builtin_amdgcn_s_sleep(1);
        if ((++sp & 255u) == 0u) { if (xb_ld(&bar[XB_TMO])) break; if (sp > XB_SPIN_CAP) { atomicAdd(&bar[XB_TMO], 1u); break; } }
    }
    nloc = mine > 0u ? mine : 1u; nx = cnt > 0u ? cnt : 1u;
}

__device__ __forceinline__ void xcd_barrier(const XcdBarrier& b) {
    asm volatile("s_waitcnt vmcnt(0)" ::: "memory");
    __syncthreads();
    if (threadIdx.x == 0) {
        unsigned* bar = b.bar;
        __builtin_amdgcn_s_waitcnt(0);
        unsigned nloc = b.st[0], nx = b.st[1];
        if (nloc == 0u) { xcd_barrier_complete(bar, b.x, nloc, nx); b.st[0] = nloc; b.st[1] = nx; }
        const unsigned old = xb_add(&bar[XB_XSUB(b.x)], 1u);
        const unsigned gen = old / nloc;
        if (old + 1u == (gen + 1u) * nloc) {
            __builtin_amdgcn_fence(__ATOMIC_RELEASE, "agent");
            asm volatile("s_waitcnt vmcnt(0)" ::: "memory");
            const unsigned og = xb_add(&bar[XB_TOP], 1u);
            const unsigned tg = og / nx;
            if (og + 1u == (tg + 1u) * nx) xb_add(&bar[XB_TOPGEN], 1u);
            else XB_SPIN(xb_ld(&bar[XB_TOPGEN]) == tg, bar);
            __builtin_amdgcn_fence(__ATOMIC_ACQUIRE, "agent");
            xb_add(&bar[XB_XGEN(b.x)], 1u);
            asm volatile("s_waitcnt vmcnt(0)" ::: "memory");
        } else {
            XB_SPIN(xb_ld(&bar[XB_XGEN(b.x)]) == gen, bar);
            __builtin_amdgcn_fence(__ATOMIC_ACQUIRE, "agent");
            asm volatile("s_waitcnt vmcnt(0)" ::: "memory");
        }
    }
    __syncthreads();
}

typedef __attribute__((address_space(4))) const unsigned long long kq_t;
struct Frame {
    LAS unsigned char* lds;
    volatile LAS unsigned* MISC;
    gu32* ctl;
    int tid, lane, wave, vcu, G;
    kq_t* karg; GAS float* out; GAS unsigned char* ws;
};
#define INP(F, i) ((const GAS float*)(F).karg[(i)])
enum { I_X = 0, I_NMPRE, I_NMPOST, I_NFPRE, I_NFPOST, I_WIN, I_CONVW, I_RW0, I_RWUP, I_RA0, I_RAUP, I_RGUP, I_RKK, I_RKA, I_RRK, I_LNXW, I_LNXB, I_RPB, I_SGUN, I_SGUW, I_SGUB, I_MGAIN, I_WOUT, I_WUP, I_FCONV, I_WDN };
__device__ __forceinline__ int launder_u(int x) { asm volatile("" : "+v"(x)); return __builtin_amdgcn_readfirstlane(x); }
template <class P> __device__ __forceinline__ P launder_p(P p) { unsigned long long v = (unsigned long long)p; unsigned lo = (unsigned)v, hi = (unsigned)(v >> 32); asm volatile("" : "+v"(lo), "+v"(hi));
    lo = __builtin_amdgcn_readfirstlane(lo); hi = __builtin_amdgcn_readfirstlane(hi); return (P)(((unsigned long long)hi << 32) | lo); }
#define LAUNDER(F) do { asm volatile("" : "+v"((F).tid)); asm volatile("" : "+v"((F).lane)); (F).wave = launder_u((F).wave); (F).vcu = launder_u((F).vcu); (F).karg = launder_p((F).karg); (F).ws = launder_p((F).ws); (F).out = launder_p((F).out); } while (0)
#define LDS_WAIT() asm volatile("s_waitcnt lgkmcnt(0)" ::: "memory")
#define CFENCE() asm volatile("" ::: "memory")

__device__ __forceinline__ void p0_transpose_item(const GAS float* W, const GAS float* gain, int K, int N, GAS bf16* WT, LAS float* scr, int item, int lane, bool glmap = false) {
    const int nblk = N / 32, kb = item / nblk, nb = item % nblk, k0 = 64 * kb, n0 = 32 * nb;
    const int r0 = !glmap ? n0 : (n0 < N / 2 ? 256 * (n0 >> 7) + (n0 & 127) : 256 * ((n0 - N / 2) >> 7) + 128 + ((n0 - N / 2) & 127));
#pragma unroll 8
    for (int i = 0; i < 32; ++i) { const int kk = 2 * i + (lane >> 5); const float g = gain ? gain[k0 + kk] : 1.f; scr[kk * 33 + (lane & 31)] = W[(size_t)(k0 + kk) * N + n0 + (lane & 31)] * g; }
    LDS_WAIT(); CFENCE();
    const int c = lane & 7;
#pragma unroll
    for (int j = 0; j < 4; ++j) { const int n = (lane >> 3) + 8 * j; const LAS float* s = scr + (8 * c) * 33 + n;
        v4u o; o.x = pk2(s[0 * 33], s[1 * 33]); o.y = pk2(s[2 * 33], s[3 * 33]); o.z = pk2(s[4 * 33], s[5 * 33]); o.w = pk2(s[6 * 33], s[7 * 33]);
        *(GAS v4u*)(WT + (size_t)(r0 + n) * K + k0 + 8 * c) = o; }
    LDS_WAIT(); CFENCE();
}
__device__ __forceinline__ void row_to_bf16_rs(const GAS float* xrow, GAS bf16* orow, GAS float* rs, int lane) {
    const GAS f32x4* xr = (const GAS f32x4*)xrow + lane;
    f32x4 v[4]; float s = 0.f;
#pragma unroll
    for (int j = 0; j < 4; ++j) { v[j] = xr[64 * j]; s += (v[j].x * v[j].x + v[j].y * v[j].y) + (v[j].z * v[j].z + v[j].w * v[j].w); }
    s = wave_sum(s);
    GAS v2u* o8 = (GAS v2u*)orow + lane;
#pragma unroll
    for (int j = 0; j < 4; ++j) { v2u o; o.x = pk2(v[j].x, v[j].y); o.y = pk2(v[j].z, v[j].w); o8[64 * j] = o; }
    if (lane == 0) *rs = rsqf_(s * (1.f / DM) + NORM_EPS);
}
__device__ __forceinline__ void p0_prologue(Frame& F) {
    LAUNDER(F);
    LAS float* scr = (LAS float*)(F.lds + F.wave * 16384);
    const int gw = F.vcu * NWAVES + F.wave, NGW = F.G * NWAVES;
    constexpr int I_IN = (DM / 64) * (NPROJ / 32), I_OUT = (DM / 64) * (DM / 32), I_UP = (DM / 64) * (NUP / 32), I_DN = (DFF / 64) * (DM / 32), I_L = I_IN + I_OUT + I_UP + I_DN;
    for (int it = gw; it < DEPTH * I_L; it += NGW) {
        const int l = it / I_L; int r = it % I_L; GAS unsigned char* wl = F.ws + WS_W + (size_t)l * W_LAYER;
        if (r < I_IN) { p0_transpose_item(INP(F, I_WIN) + (size_t)l * DM * NPROJ, INP(F, I_NMPRE) + l * DM, DM, NPROJ, (GAS bf16*)(wl + W_IN), scr, r, F.lane); continue; } r -= I_IN;
        if (r < I_OUT) { p0_transpose_item(INP(F, I_WOUT) + (size_t)l * DM * DM, INP(F, I_MGAIN) + l * DM, DM, DM, (GAS bf16*)(wl + W_OUT), scr, r, F.lane); continue; } r -= I_OUT;
        if (r < I_UP) { p0_transpose_item(INP(F, I_WUP) + (size_t)l * DM * NUP, INP(F, I_NFPRE) + l * DM, DM, NUP, (GAS bf16*)(wl + W_UP), scr, r, F.lane, true); continue; } r -= I_UP;
        p0_transpose_item(INP(F, I_WDN) + (size_t)l * DFF * DM, nullptr, DFF, DM, (GAS bf16*)(wl + W_DN), scr, r, F.lane);
    }
    unsigned zz = 0u; asm volatile("" : "+v"(zz));
    for (int i = F.vcu * NTHREADS + F.tid; i < DEPTH * 20480; i += F.G * NTHREADS) { const int l = i / 20480, r = i % 20480;
        *(GAS v4u*)(F.ws + WS_W + (size_t)l * W_LAYER + W_IN + (size_t)NPROJ * DM * 2 + (size_t)r * 16) = (v4u){zz, zz, zz, zz}; }
    for (int m = gw; m < M; m += NGW) row_to_bf16_rs(INP(F, I_X) + (size_t)m * DM, (GAS bf16*)(F.ws + WS_XB) + (size_t)m * DM, (GAS float*)(F.ws + WS_RS) + m, F.lane);
}

typedef float f32x16 __attribute__((ext_vector_type(16)));
__device__ __forceinline__ void mix_convprep_tile(Frame& F, int l, int tile) {
    LAUNDER(F);
    const GAS bf16* proj = (const GAS bf16*)(F.ws + WS_PROJ); GAS bf16* merged = (GAS bf16*)(F.ws + WS_MERGED);
    const int m0 = tile * 64, bb = m0 / T, t0 = m0 % T;
    const int lane = F.lane, w = F.wave;
    {
        const int c4 = 4 * lane; const GAS float* cw = INP(F, I_CONVW) + l * 768;
        const f32x4 w0 = *(const f32x4*)(cw + c4), w1 = *(const f32x4*)(cw + 256 + c4), w2 = *(const f32x4*)(cw + 512 + c4);
        const int ts = t0 + 8 * w;
        v2u hr[10], cr[10], br[8];
#pragma unroll
        for (int j = 0; j < 10; ++j) { const int t = ts - 1 + j; const bool ok = (t >= 0 && t < T); const GAS bf16* row = proj + (size_t)(bb * T + (ok ? t : ts)) * NPROJP;
            hr[j] = *(const GAS v2u*)(row + C_CH + c4); cr[j] = *(const GAS v2u*)(row + C_CC + c4); if (!ok) { hr[j] = (v2u){0u, 0u}; } }
#pragma unroll
        for (int j = 0; j < 8; ++j) { const GAS bf16* row = proj + (size_t)(bb * T + ts + j) * NPROJP; br[j] = *(const GAS v2u*)(row + C_CB + c4); }
#pragma unroll
        for (int i = 0; i < 8; ++i) { const int t = ts + i;
            f32x4 z[3];
#pragma unroll
            for (int q = 0; q < 3; ++q) { const v2u h = hr[i + q], c = cr[i + q]; z[q] = (f32x4){bflo(h.x) * bflo(c.x), bfhi(h.x) * bfhi(c.x), bflo(h.y) * bflo(c.y), bfhi(h.y) * bfhi(c.y)}; }
            const v2u b = br[i];
            const f32x4 bv = (f32x4){bflo(b.x), bfhi(b.x), bflo(b.y), bfhi(b.y)};
            const f32x4 y = bv * (w0 * z[0] + w1 * z[1] + w2 * z[2]);
            float ss = (y.x * y.x + y.y * y.y) + (y.z * y.z + y.w * y.w); ss = wave_sum(ss);
            const float sc = rsqf_(ss * (1.f / 256.f) + NORM_EPS);
            v2u o; o.x = pk2(y.x * sc, y.y * sc); o.y = pk2(y.z * sc, y.w * sc);
            *(GAS v2u*)(merged + (size_t)(bb * T + t) * DM + 0 + c4) = o;
}
    }
}

__device__ __forceinline__ void mix_na_item(Frame& F, int l, int item, LAS unsigned char* wl, const LAS float* RPB) {
    LAUNDER(F);
    const GAS bf16* proj = (const GAS bf16*)(F.ws + WS_PROJ); GAS bf16* merged = (GAS bf16*)(F.ws + WS_MERGED);
    const int lane = F.lane, i = lane & 15, g = lane >> 4;
    const int qg = item & 3, r = (item >> 2) & 63, bb = item >> 8;
    const int c0 = 16 * qg;
    int rs = r - 4; rs = rs < 0 ? 0 : (rs > 56 ? 56 : rs);
    int cs = c0 - 8; cs = cs < 0 ? 0 : (cs > 32 ? 32 : cs);
    LAS unsigned char* PL = wl; LAS unsigned char* VL = wl + 4096; LAS unsigned char* OL = wl + 8192;
    const size_t rowbase = (size_t)bb * T;
    float ssq[4] = {0.f, 0.f, 0.f, 0.f};
#pragma unroll 1
    for (int h = 0; h < 4; ++h) {
        bf16x8 qf[2];
        { const GAS bf16* qrow = proj + (rowbase + r * 64 + c0 + i) * NPROJP + C_NQ + h * 64 + 8 * g;
          qf[0] = *(const GAS bf16x8*)(qrow); qf[1] = *(const GAS bf16x8*)(qrow + 32); }
        f32x4 s[16];
#pragma unroll
        for (int kt = 0; kt < 16; ++kt) { const int kr = kt >> 1, hf = kt & 1;
            const GAS bf16* krow = proj + (rowbase + (rs + kr) * 64 + cs + 16 * hf + i) * NPROJP + C_NK + h * 64 + 8 * g;
            const bf16x8 k0 = *(const GAS bf16x8*)(krow), k1 = *(const GAS bf16x8*)(krow + 32);
            f32x4 a = (f32x4){0.f, 0.f, 0.f, 0.f};
            a = __builtin_amdgcn_mfma_f32_16x16x32_bf16(qf[0], k0, a, 0, 0, 0);
            a = __builtin_amdgcn_mfma_f32_16x16x32_bf16(qf[1], k1, a, 0, 0, 0);
            s[kt] = a; }
        const GAS bf16* vsrc = proj + (rowbase + rs * 64 + cs + (lane >> 3)) * NPROJP + C_NV + h * 64 + 8 * (lane & 7);
        v4u vreg[4][4];
#pragma unroll
        for (int k4 = 0; k4 < 4; ++k4)
#pragma unroll
            for (int q = 0; q < 4; ++q) vreg[k4][q] = *(const GAS v4u*)(vsrc + (size_t)(k4 * 64 + 8 * q) * NPROJP);
        float mx[4] = {-3e38f, -3e38f, -3e38f, -3e38f};
#pragma unroll
        for (int kt = 0; kt < 16; ++kt) { const int kr = kt >> 1, hf = kt & 1; const int cw = cs + 16 * hf + i; const int dy = rs + kr - r + 7;
#pragma unroll
            for (int e = 0; e < 4; ++e) { const int cq = c0 + 4 * g + e; int st = cq - 8; st = st < 0 ? 0 : (st > 48 ? 48 : st);
                int dx = cw - cq; dx = dx < -15 ? -15 : (dx > 15 ? 15 : dx); dx += 15;
                const bool valid = (cw >= st) && (cw < st + 16);
                float v = s[kt][e] * 0.125f + RPB[h * 465 + dy * 31 + dx];
                v = valid ? v : -1e30f; s[kt][e] = v; mx[e] = fmaxf(mx[e], v); } }
        float sm[4];
#pragma unroll
        for (int e = 0; e < 4; ++e) { mx[e] = row16_max(mx[e]); sm[e] = 0.f; }
#pragma unroll
        for (int kt = 0; kt < 16; ++kt)
#pragma unroll
            for (int e = 0; e < 4; ++e) { const float p = __expf(s[kt][e] - mx[e]); s[kt][e] = p; sm[e] += p; }
#pragma unroll
        for (int e = 0; e < 4; ++e) sm[e] = rcpf_(row16_sum(sm[e]));
        f32x4 oh[4];
#pragma unroll
        for (int dt = 0; dt < 4; ++dt) oh[dt] = (f32x4){0.f, 0.f, 0.f, 0.f};
#pragma unroll
        for (int half = 0; half < 2; ++half) {
            CFENCE();
#pragma unroll
            for (int k8 = 0; k8 < 8; ++k8) { const int kt = 8 * half + k8; v2u pw; pw.x = pk2(s[kt][0] * sm[0], s[kt][1] * sm[1]); pw.y = pk2(s[kt][2] * sm[2], s[kt][3] * sm[3]);
                *(LAS v2u*)(PL + (16 * k8 + i) * 32 + 8 * g) = pw; }
            CFENCE();
#pragma unroll
            for (int k4 = 0; k4 < 4; ++k4) { const int kr = 4 * half + k4;
                CFENCE();
#pragma unroll
                for (int q = 0; q < 4; ++q) *(LAS v4u*)(VL + ((lane >> 3) + 8 * q) * 128 + (lane & 7) * 16) = vreg[k4][q];
                if (half == 0) {
#pragma unroll
                    for (int q = 0; q < 4; ++q) vreg[k4][q] = *(const GAS v4u*)(vsrc + (size_t)((kr + 4) * 64 + 8 * q) * NPROJP); }
                CFENCE();
                const LAS unsigned char* pa = PL + (32 * k4 + 8 * g + (i >> 2)) * 32 + 8 * (i & 3);
                const s16x4 plo = __builtin_bit_cast(s16x4, __builtin_amdgcn_ds_read_tr16_b64_v4i16((LAS s16x4*)(pa)));
                const s16x4 phi = __builtin_bit_cast(s16x4, __builtin_amdgcn_ds_read_tr16_b64_v4i16((LAS s16x4*)(pa + 128)));
                const bf16x8 pf = (bf16x8){plo[0], plo[1], plo[2], plo[3], phi[0], phi[1], phi[2], phi[3]};
#pragma unroll
                for (int dt = 0; dt < 4; ++dt) {
                    const LAS unsigned char* va = VL + (8 * g + (i >> 2)) * 128 + (16 * dt + 4 * (i & 3)) * 2;
                    const s16x4 vlo = __builtin_bit_cast(s16x4, __builtin_amdgcn_ds_read_tr16_b64_v4i16((LAS s16x4*)(va)));
                    const s16x4 vhi = __builtin_bit_cast(s16x4, __builtin_amdgcn_ds_read_tr16_b64_v4i16((LAS s16x4*)(va + 512)));
                    const bf16x8 vf = (bf16x8){vlo[0], vlo[1], vlo[2], vlo[3], vhi[0], vhi[1], vhi[2], vhi[3]};
                    oh[dt] = __builtin_amdgcn_mfma_f32_16x16x32_bf16(pf, vf, oh[dt], 0, 0, 0); }
            }
        }
        CFENCE();
#pragma unroll
        for (int dt = 0; dt < 4; ++dt)
#pragma unroll
            for (int e = 0; e < 4; ++e) { ssq[e] += oh[dt][e] * oh[dt][e]; *(LAS unsigned short*)(OL + (4 * g + e) * 512 + (h * 64 + 16 * dt + i) * 2) = (unsigned short)f2bf(oh[dt][e]); }
        CFENCE();
    }
    LAS float* SCL = (LAS float*)VL;
    CFENCE();
#pragma unroll
    for (int e = 0; e < 4; ++e) { const float sc = rsqf_(row16_sum(ssq[e]) * (1.f / 256.f) + NORM_EPS); if (i == 0) SCL[4 * g + e] = sc; }
    CFENCE();
#pragma unroll
    for (int q = 0; q < 8; ++q) { const int e = lane + 64 * q, row = e >> 5, ch = e & 31;
        const v4u v = *(const LAS v4u*)(OL + row * 512 + ch * 16); const float sc = SCL[row];
        v4u o;
#pragma unroll
        for (int t = 0; t < 4; ++t) o[t] = pk2(bflo(v[t]) * sc, bfhi(v[t]) * sc);
        *(GAS v4u*)(merged + (rowbase + r * 64 + c0 + row) * DM + 512 + 8 * ch) = o; }
    CFENCE();
}

constexpr int SG_PITCH = 528;
__device__ __forceinline__ void mix_sgu_item(Frame& F, int l, int item) {
    LAUNDER(F);
    const GAS bf16* proj = (const GAS bf16*)(F.ws + WS_PROJ); GAS bf16* merged = (GAS bf16*)(F.ws + WS_MERGED);
    const int lane = F.lane, w = F.wave, tid = F.tid, i = lane & 15, g = lane >> 4;
    const size_t m0 = (size_t)item * 128;
    LAS unsigned char* VI = F.lds; LAS float* SS = (LAS float*)(F.lds + 128 * SG_PITCH);
    { const int c4 = 4 * lane; const f32x4 gn = *(const f32x4*)(INP(F, I_SGUN) + l * 256 + c4);
      v2u xr[16];
#pragma unroll
      for (int j = 0; j < 16; ++j) xr[j] = *(const GAS v2u*)(proj + (m0 + 16 * w + j) * NPROJP + C_SV + c4);
#pragma unroll
      for (int j = 0; j < 16; ++j) { const int q = 16 * w + j; const v2u x = xr[j];
          f32x4 v = (f32x4){gelu_tanh(bflo(x.x)), gelu_tanh(bfhi(x.x)), gelu_tanh(bflo(x.y)), gelu_tanh(bfhi(x.y))};
          const float mu = wave_sum((v.x + v.y) + (v.z + v.w)) * (1.f / 256.f);
          v = v - mu;
          const float var = wave_sum((v.x * v.x + v.y * v.y) + (v.z * v.z + v.w * v.w)) * (1.f / 256.f);
          const float rstd = rsqf_(var + NORM_EPS);
          v2u o; o.x = pk2(v.x * rstd * gn.x, v.y * rstd * gn.y); o.y = pk2(v.z * rstd * gn.z, v.w * rstd * gn.w);
          *(LAS v2u*)(VI + q * SG_PITCH + c4 * 2) = o; } }
    __syncthreads();
    const int hh = w >> 1, ph = w & 1;
    f32x4 acc[4][4];
#pragma unroll
    for (int a = 0; a < 4; ++a)
#pragma unroll
        for (int b = 0; b < 4; ++b) acc[a][b] = (f32x4){0.f, 0.f, 0.f, 0.f};
    const GAS float* ws_ = INP(F, I_SGUW) + ((size_t)(l * 4 + hh) * 128) * 128;
#pragma unroll
    for (int ks = 0; ks < 4; ++ks) {
        bf16x8 af[4], bfr[4];
#pragma unroll
        for (int pt = 0; pt < 4; ++pt) { const GAS float* ap = ws_ + (size_t)(64 * ph + 16 * pt + i) * 128 + 32 * ks + 8 * g;
            const f32x4 x0 = *(const f32x4*)ap, x1 = *(const f32x4*)(ap + 4);
            const unsigned u0 = pk2(x0.x, x0.y), u1 = pk2(x0.z, x0.w), u2 = pk2(x1.x, x1.y), u3 = pk2(x1.z, x1.w);
            af[pt] = __builtin_bit_cast(bf16x8, (v4u){u0, u1, u2, u3}); }
#pragma unroll
        for (int dt = 0; dt < 4; ++dt) { const LAS unsigned char* va = VI + (32 * ks + 8 * g + (i >> 2)) * SG_PITCH + (hh * 64 + 16 * dt + 4 * (i & 3)) * 2;
            const s16x4 lo = __builtin_bit_cast(s16x4, __builtin_amdgcn_ds_read_tr16_b64_v4i16((LAS s16x4*)(va)));
            const s16x4 hi = __builtin_bit_cast(s16x4, __builtin_amdgcn_ds_read_tr16_b64_v4i16((LAS s16x4*)(va + 4 * SG_PITCH)));
            bfr[dt] = (bf16x8){lo[0], lo[1], lo[2], lo[3], hi[0], hi[1], hi[2], hi[3]}; }
#pragma unroll
        for (int pt = 0; pt < 4; ++pt)
#pragma unroll
            for (int dt = 0; dt < 4; ++dt) acc[pt][dt] = __builtin_amdgcn_mfma_f32_16x16x32_bf16(af[pt], bfr[dt], acc[pt][dt], 0, 0, 0);
    }
#pragma unroll
    for (int pt = 0; pt < 4; ++pt) {
        unsigned short ur[4][4];
#pragma unroll
        for (int e = 0; e < 4; ++e)
#pragma unroll
            for (int dt = 0; dt < 4; ++dt) ur[e][dt] = proj[(m0 + 64 * ph + 16 * pt + 4 * g + e) * NPROJP + C_SU + hh * 64 + 16 * dt + i];
#pragma unroll
        for (int e = 0; e < 4; ++e) { const int p = 64 * ph + 16 * pt + 4 * g + e; const float bs = INP(F, I_SGUB)[(l * 4 + hh) * 128 + p]; float ss = 0.f;
#pragma unroll
            for (int dt = 0; dt < 4; ++dt) { const float u = gelu_tanh(bf2f(ur[e][dt]));
                const float v = u * (acc[pt][dt][e] + bs); acc[pt][dt][e] = v; ss += v * v; }
            ss = row16_sum(ss); if (i == 0) SS[p * 4 + hh] = ss; } }
    __syncthreads();
#pragma unroll
    for (int pt = 0; pt < 4; ++pt)
#pragma unroll
        for (int e = 0; e < 4; ++e) { const int p = 64 * ph + 16 * pt + 4 * g + e; const f32x4 s4 = *(const LAS f32x4*)(SS + p * 4);
            const float sc = rsqf_(((s4.x + s4.y) + (s4.z + s4.w)) * (1.f / 256.f) + NORM_EPS);
#pragma unroll
            for (int dt = 0; dt < 4; ++dt) *(LAS unsigned short*)(VI + p * SG_PITCH + (hh * 64 + 16 * dt + i) * 2) = (unsigned short)f2bf(acc[pt][dt][e] * sc); }
    __syncthreads();
#pragma unroll
    for (int q = 0; q < 8; ++q) { const int e = tid + 512 * q, row = e >> 5, ch = e & 31;
        const v4u v = *(const LAS v4u*)(VI + row * SG_PITCH + ch * 16);
        *(GAS v4u*)(merged + (m0 + row) * DM + 768 + 8 * ch) = v; }
    __syncthreads();
}

__device__ __forceinline__ void phase_mix_na(Frame& F, int l, int bidx, int nblk) {
    LAUNDER(F);
    LAS float* RPB = (LAS float*)(F.lds + RING_BYTES + 1024);
    for (int q = F.tid; q < 4 * 465; q += NTHREADS) RPB[q] = INP(F, I_RPB)[l * 4 * 465 + q];
    __syncthreads();
    for (int it = bidx * NWAVES + F.wave; it < NB * 64 * 4; it += nblk * NWAVES) mix_na_item(F, l, it, F.lds + F.wave * 16384, RPB);
    __syncthreads();
#ifdef SGU_IN_C2
    for (int it = bidx; it < NB * 32; it += nblk) mix_sgu_item(F, l, it);
#endif
}
__device__ __forceinline__ void phase_mixers(Frame& F, int l) {
    LAUNDER(F);
    for (int tile = F.vcu; tile < M / 64; tile += F.G) mix_convprep_tile(F, l, tile);
    __syncthreads();
#ifndef SGU_IN_C2
    for (int it = F.vcu; it < NB * 32; it += F.G) mix_sgu_item(F, l, it);
#endif
}

constexpr int C1_VEC = 0, C1_VST = 640, C1_VEC_D = 16 * C1_VST, C1_RES = 40960, C1_RES_D = 17664;
constexpr int C1_U = 0, C1_ZT = 4096, C1_ET = 8192, C1_QT = 12288, C1_CT = 16384, C1_DA = 17408;
typedef float f32x2 __attribute__((ext_vector_type(2)));
#define CK_DOT(a, b) ({ f32x2 t_ = (f32x2){(a).x, (a).y} * (f32x2){(b).x, (b).y}; t_ = __builtin_elementwise_fma((f32x2){(a).z, (a).w}, (f32x2){(b).z, (b).w}, t_); t_.x + t_.y; })
#define CK_RED2(a, b) do { a += dppmov<0xB1>(a); b += dppmov<0xB1>(b); a += dppmov<0x4E>(a); b += dppmov<0x4E>(b); a += dppmov<0x141>(a); b += dppmov<0x141>(b); a += dppmov<0x140>(a); b += dppmov<0x140>(b); } while (0)
__device__ __forceinline__ bf16x8 pack8(f32x4 lo, f32x4 hi) { return __builtin_bit_cast(bf16x8, (v4u){pg8::cvt_pk_bf16(lo.x, lo.y), pg8::cvt_pk_bf16(lo.z, lo.w), pg8::cvt_pk_bf16(hi.x, hi.y), pg8::cvt_pk_bf16(hi.z, hi.w)}); }
template <int MODE>
__device__ __forceinline__ void phase_scan_c1(Frame& F, int l) {
    LAUNDER(F);
    const GAS bf16* proj = (const GAS bf16*)(F.ws + WS_PROJ);
    const int lane = F.lane, w = F.wave, i = lane & 15, g = lane >> 4;
    const int d = w >> 2, wa = w & 3;
    const int bh = F.vcu >> 3, bb = bh >> 2, h = bh & 3;
    LAS unsigned char* lds = F.lds;
    bf16x8 Bw, Ba;
    { f32x4 xw0 = (f32x4){0.f, 0.f, 0.f, 0.f}, xw1 = xw0, xa0 = xw0, xa1 = xw0;
      if (g < 2) { const GAS float* pw = INP(F, I_RWUP) + ((size_t)(l * 2 + d) * 16 + 8 * g) * 256 + h * 64 + 16 * wa + i; const GAS float* pa = INP(F, I_RAUP) + ((size_t)(l * 2 + d) * 16 + 8 * g) * 256 + h * 64 + 16 * wa + i;
          xw0 = (f32x4){pw[0], pw[256], pw[512], pw[768]}; xw1 = (f32x4){pw[1024], pw[1280], pw[1536], pw[1792]};
          xa0 = (f32x4){pa[0], pa[256], pa[512], pa[768]}; xa1 = (f32x4){pa[1024], pa[1280], pa[1536], pa[1792]}; }
      Bw = pack8(xw0, xw1); Ba = pack8(xa0, xa1); }
    const float w0c = INP(F, I_RW0)[(l * 2 + d) * 256 + h * 64 + 16 * wa + i], a0c = INP(F, I_RA0)[(l * 2 + d) * 256 + h * 64 + 16 * wa + i], kag = INP(F, I_RKA)[l * 256 + h * 64 + 16 * wa + i];
    float kkg[4];
#pragma unroll
    for (int t = 0; t < 4; ++t) kkg[t] = INP(F, I_RKK)[l * 256 + h * 64 + 16 * t + i];
    const float kkgw = INP(F, I_RKK)[l * 256 + h * 64 + 16 * wa + i];
    const int cg = i, sel = g;
#define C1_BAR() do { asm volatile("s_waitcnt lgkmcnt(0)" ::: "memory"); __builtin_amdgcn_s_barrier(); asm volatile("" ::: "memory"); } while (0)
    unsigned short kq[4][4], kown[4], rq[4]; v4u dvr, ivr;
#define C1_LOAD(B_) do { const size_t m0_ = (size_t)bb * T + 16 * (B_); \
        _Pragma("unroll") for (int e_ = 0; e_ < 4; ++e_) { const GAS bf16* row_ = proj + (m0_ + 4 * g + e_) * NPROJP; \
            _Pragma("unroll") for (int t_ = 0; t_ < 4; ++t_) kq[t_][e_] = row_[C_K + h * 64 + 16 * t_ + i]; \
            rq[e_] = row_[C_R + h * 64 + 16 * wa + i]; kown[e_] = row_[C_K + h * 64 + 16 * wa + i]; } \
        { const GAS bf16* arow_ = proj + (m0_ + i) * NPROJP + C_DEC + 16 * d + 8 * (g & 1); dvr = *(const GAS v4u*)(arow_); ivr = *(const GAS v4u*)(arow_ + 32); } } while (0)
    C1_LOAD((F.vcu & 7) * 32);
    for (int it = 0; it < 32; ++it) {
        const int B = (F.vcu & 7) * 32 + it;
        if (MODE != 3) {
            v4u dv = (v4u){0u, 0u, 0u, 0u}, iv = dv;
            if (g < 2) { iv = ivr;
#pragma unroll
                for (int q = 0; q < 4; ++q) dv[q] = pk2(tanhf_(bflo(dvr[q])), tanhf_(bfhi(dvr[q]))); }
            const f32x4 z4 = (f32x4){0.f, 0.f, 0.f, 0.f};
            const f32x4 Dw = __builtin_amdgcn_mfma_f32_16x16x32_bf16(__builtin_bit_cast(bf16x8, dv), Bw, z4, 0, 0, 0);
            const f32x4 Da = __builtin_amdgcn_mfma_f32_16x16x32_bf16(__builtin_bit_cast(bf16x8, iv), Ba, z4, 0, 0, 0);
#pragma unroll
            for (int e = 0; e < 4; ++e) {
                float ss = 0.f;
#pragma unroll
                for (int t = 0; t < 4; ++t) { const float x = bf2f(kq[t][e]) * kkg[t]; ss += x * x; }
                ss = row16_sum(ss);
                const float k = bf2f(kown[e]); const float kk = k * kkgw * rsqf_(ss + 1e-12f);
                const float wv = __expf(-DECAY_SCALE * sigmoidf_(w0c + Dw[e])), av = sigmoidf_(a0c + Da[e]);
                const int tok = 4 * g + e, s = d ? 15 - tok : tok;
                LAS _Float16* vp = (LAS _Float16*)(lds + C1_VEC + d * C1_VEC_D + s * C1_VST) + 16 * wa + i;
                vp[0] = (_Float16)wv; vp[64] = (_Float16)kk; vp[128] = (_Float16)(kk * av); vp[192] = (_Float16)(k * (1.f + (av - 1.f) * kag)); vp[256] = (_Float16)bf2f(rq[e]); }
        }
        if (it + 1 < 32) C1_LOAD(B + 1);
        C1_BAR();
        if (MODE != 1 && MODE != 4) {
            typedef _Float16 h4 __attribute__((ext_vector_type(4)));
            const LAS unsigned char* V = lds + C1_VEC + d * C1_VEC_D + cg * 8;
            LAS unsigned char* R = lds + C1_RES + d * C1_RES_D;
#define VLD(s_, vec_) (*(const LAS h4*)(V + (s_) * C1_VST + (vec_) * 128))
#define HDOT(a, b) __builtin_amdgcn_fdot2((h2){(a).x, (a).y}, (h2){(b).x, (b).y}, __builtin_amdgcn_fdot2((h2){(a).z, (a).w}, (h2){(b).z, (b).w}, 0.f, false), false)
#define H4F(v_) __builtin_convertvector((v_), f32x4)
            const unsigned Va = (unsigned)(size_t)V;
#define LD4(X, s_) asm volatile("ds_read_b64 %0, %4\n\tds_read_b64 %1, %4 offset:128\n\tds_read_b64 %2, %4 offset:256\n\tds_read_b64 %3, %4 offset:384" \
                : "=v"(X[0]), "=v"(X[1]), "=v"(X[2]), "=v"(X[3]) : "v"(Va + (unsigned)(s_) * (unsigned)C1_VST) : "memory")
#define WT4(X, n_) asm volatile("s_waitcnt lgkmcnt(" #n_ ")" : "+v"(X[0]), "+v"(X[1]), "+v"(X[2]), "+v"(X[3]) :: "memory")
#define LD3(X, s_) asm volatile("ds_read_b64 %0, %3\n\tds_read_b64 %1, %3 offset:128\n\tds_read_b64 %2, %3 offset:256" \
                : "=v"(X[0]), "=v"(X[1]), "=v"(X[2]) : "v"(Va + (unsigned)(s_) * (unsigned)C1_VST) : "memory")
#define WT3(X, n_) asm volatile("s_waitcnt lgkmcnt(" #n_ ")" : "+v"(X[0]), "+v"(X[1]), "+v"(X[2]) :: "memory")
            {
                const int s = 4 * wa + sel; h4 q = VLD(s, 4); float creg = 0.f;
                h4 A0[4], A1[4], A2[4];
#define QBODY_R(X) do { float d1 = HDOT(X[3], q), d2 = HDOT(X[2], q); CK_RED2(d1, d2); const bool act = j <= s; creg = (act && cg == j) ? d1 : creg; \
                    const _Float16 hd = (_Float16)d2; const h4 qn = X[0] * q - X[1] * (h4){hd, hd, hd, hd}; q = act ? qn : q; } while (0)
#define QBODY(X) do { float d1 = HDOT(X[3], q), d2 = HDOT(X[2], q); CK_RED2(d1, d2); creg = (cg == j) ? d1 : creg; const _Float16 hd = (_Float16)d2; q = X[0] * q - X[1] * (h4){hd, hd, hd, hd}; } while (0)
                int j = 4 * wa + 3;
                LD4(A0, j); LD4(A1, j - 1);
                LD4(A2, j - 2); WT4(A0, 8); QBODY_R(A0); --j;
                LD4(A0, j >= 2 ? j - 2 : 0); WT4(A1, 8); QBODY_R(A1); --j;
                LD4(A1, j >= 2 ? j - 2 : 0); WT4(A2, 8); QBODY_R(A2); --j;
                for (;;) {
                    LD4(A2, j >= 2 ? j - 2 : 0); WT4(A0, 8); QBODY(A0); if (--j < 0) break;
                    LD4(A0, j >= 2 ? j - 2 : 0); WT4(A1, 8); QBODY(A1); if (--j < 0) break;
                    LD4(A1, j >= 2 ? j - 2 : 0); WT4(A2, 8); QBODY(A2); if (--j < 0) break;
                }
                WT4(A0, 0); WT4(A1, 0); WT4(A2, 0);
#undef QBODY
#undef QBODY_R
                *(LAS f32x4*)(R + C1_QT + s * 256 + cg * 16) = H4F(q); *(LAS float*)(R + C1_CT + s * 64 + cg * 4) = creg;
            }
            {
                const int ga = 3 - wa, s = 4 * ga + sel; h4 u = VLD(s, 1);
                const int j0 = 4 * wa + sel; h4 x = VLD(j0, 3); h4 wz = (h4){(_Float16)1.f, (_Float16)1.f, (_Float16)1.f, (_Float16)1.f};
                h4 U0[3], U1[3], U2[3], E0[3], E1[3], E2[3];
#define UBODY_R(X, Y) do { float d2 = HDOT(X[2], u), d3 = HDOT(x, Y[1]); CK_RED2(d2, d3); const _Float16 h2_ = (_Float16)d2, h3_ = (_Float16)d3; \
                    const h4 un = X[0] * u - X[1] * (h4){h2_, h2_, h2_, h2_}; u = (j < s) ? un : u; const bool act = ii > j0; \
                    const h4 xn = x * Y[0] - Y[2] * (h4){h3_, h3_, h3_, h3_}; x = act ? xn : x; wz = act ? wz * Y[0] : wz; } while (0)
#define UBODY(X, Y) do { float d2 = HDOT(X[2], u), d3 = HDOT(x, Y[1]); CK_RED2(d2, d3); const _Float16 h2_ = (_Float16)d2, h3_ = (_Float16)d3; \
                    u = X[0] * u - X[1] * (h4){h2_, h2_, h2_, h2_}; x = x * Y[0] - Y[2] * (h4){h3_, h3_, h3_, h3_}; wz = wz * Y[0]; } while (0)
                int j = 4 * ga + 2, ii = 4 * wa + 1;
                LD3(U0, j); LD3(E0, ii); LD3(U1, j >= 1 ? j - 1 : 0); LD3(E1, ii < 15 ? ii + 1 : 15);
                LD3(U2, j >= 2 ? j - 2 : 0); LD3(E2, ii < 14 ? ii + 2 : 15); WT3(U0, 12); WT3(E0, 12); UBODY_R(U0, E0); ++ii; --j;
                LD3(U0, j >= 2 ? j - 2 : 0); LD3(E0, ii < 14 ? ii + 2 : 15); WT3(U1, 12); WT3(E1, 12); UBODY_R(U1, E1); ++ii; --j;
                LD3(U1, j >= 2 ? j - 2 : 0); LD3(E1, ii < 14 ? ii + 2 : 15); WT3(U2, 12); WT3(E2, 12); UBODY_R(U2, E2); ++ii; --j;
                if (j >= 0) for (;;) {
                    LD3(U2, j >= 2 ? j - 2 : 0); LD3(E2, ii < 14 ? ii + 2 : 15); WT3(U0, 12); WT3(E0, 12); UBODY(U0, E0); ++ii; if (--j < 0) break;
                    LD3(U0, j >= 2 ? j - 2 : 0); LD3(E0, ii < 14 ? ii + 2 : 15); WT3(U1, 12); WT3(E1, 12); UBODY(U1, E1); ++ii; if (--j < 0) break;
                    LD3(U1, j >= 2 ? j - 2 : 0); LD3(E1, ii < 14 ? ii + 2 : 15); WT3(U2, 12); WT3(E2, 12); UBODY(U2, E2); ++ii; if (--j < 0) break;
                }
                WT3(U0, 0); WT3(U1, 0); WT3(U2, 0); WT3(E0, 0); WT3(E1, 0); WT3(E2, 0);
#undef UBODY
#undef UBODY_R
                const f32x4 uf = H4F(u), xf = H4F(x), wzf = H4F(wz);
                LAS float* up = (LAS float*)(R + C1_U) + (4 * cg) * 16 + s; up[0] = uf.x; up[16] = uf.y; up[32] = uf.z; up[48] = uf.w;
                const f32x4 zb = H4F(VLD(j0, 2)) * wzf;
                LAS float* ep = (LAS float*)(R + C1_ET) + (4 * cg) * 16 + j0; ep[0] = xf.x; ep[16] = xf.y; ep[32] = xf.z; ep[48] = xf.w;
                LAS float* zp = (LAS float*)(R + C1_ZT) + (4 * cg) * 16 + j0; zp[0] = zb.x; zp[16] = zb.y; zp[32] = zb.z; zp[48] = zb.w;
                if (wa == 0 && sel == 0) *(LAS f32x4*)(R + C1_DA + cg * 16) = H4F(VLD(0, 0)) * wzf;
            }
#undef HDOT
#undef H4F
#undef LD4
#undef WT4
#undef LD3
#undef WT3
#undef VLD
        }
        C1_BAR();
        if (MODE != 2 && MODE != 4) {
            const LAS unsigned char* R = lds + C1_RES + d * C1_RES_D;
            const int n = d ? 255 - B : B;
            GAS unsigned char* gt = (d ? (GAS unsigned char*)F.out : F.ws + WS_GT0) + ((size_t)(bb * 4 + h) * 256 + n) * GT_CHUNK;
            const int nt = wa;
            bf16x8 zf = (bf16x8){0, 0, 0, 0, 0, 0, 0, 0};
            if (g < 2) { const LAS f32x4* zp = (const LAS f32x4*)(R + C1_ZT + (16 * nt + i) * 64 + 32 * g); zf = pack8(zp[0], zp[1]); }
            f32x4 pp[4];
#pragma unroll
            for (int ct = 0; ct < 4; ++ct) {
                bf16x8 uf = (bf16x8){0, 0, 0, 0, 0, 0, 0, 0};
                if (g < 2) { const LAS f32x4* up = (const LAS f32x4*)(R + C1_U + (16 * ct + i) * 64 + 32 * g); uf = pack8(up[0], up[1]); }
                const f32x4 dd = __builtin_amdgcn_mfma_f32_16x16x32_bf16(uf, zf, (f32x4){0.f, 0.f, 0.f, 0.f}, 0, 0, 0);
                f32x4 pv = -dd;
                if (ct == nt) { const f32x4 da = *(const LAS f32x4*)(R + C1_DA + (16 * ct + 4 * g) * 4);
#pragma unroll
                    for (int e = 0; e < 4; ++e) if (4 * g + e == i) pv[e] += da[e]; }
                pp[ct] = pv; }
#define C1_ST(p_, v_) do { const bf16x8 v__ = (v_); if (MODE == 0) *(GAS bf16x8*)(p_) = v__; else asm volatile("" :: "v"(v__)); } while (0)
            C1_ST(gt + (nt * 2 + 0) * 1024 + lane * 16, pack8(pp[0], pp[1]));
            C1_ST(gt + (nt * 2 + 1) * 1024 + lane * 16, pack8(pp[2], pp[3]));
            if (g < 2) { const LAS f32x4* ep = (const LAS f32x4*)(R + C1_ET + (16 * nt + i) * 64 + 32 * g); C1_ST(gt + 10240 + nt * 512 + lane * 16, pack8(ep[0], ep[1])); }
            if (wa == 0) {
#pragma unroll
                for (int ks = 0; ks < 2; ++ks) { const LAS f32x4* qp = (const LAS f32x4*)(R + C1_QT + i * 256 + (32 * ks + 4 * g) * 4);
                    C1_ST(gt + (8 + ks) * 1024 + lane * 16, pack8(qp[0], qp[4])); }
                if (g < 2) { const LAS f32x4* cp = (const LAS f32x4*)(R + C1_CT + i * 64 + 32 * g); C1_ST(gt + 10240 + 4 * 512 + lane * 16, pack8(cp[0], cp[1])); }
            }
        }
    }
#undef C1_LOAD
#undef C1_BAR
    __syncthreads();
}
#define C2_BAR() do { asm volatile("s_waitcnt lgkmcnt(0)" ::: "memory"); __builtin_amdgcn_s_barrier(); asm volatile("" ::: "memory"); } while (0)
constexpr int C2_SLOT = 16384, C2_YOFF = 4 * C2_SLOT;
template <int MODE>
__device__ __forceinline__ void phase_scan_c2(Frame& F, int l) {
    LAUNDER(F);
    if (F.vcu >= 128) { if (MODE == 0) phase_mix_na(F, l, F.vcu - 128, 128); return; }
    const GAS bf16* proj = (const GAS bf16*)(F.ws + WS_PROJ);
    const int lane = F.lane, i = lane & 15, g = lane >> 4;
    LAS unsigned char* lds = F.lds;
    if (F.vcu < 128) {
    const int ci = F.vcu >> 1, tp = F.vcu & 1, d = ci >> 5, bb = (ci >> 2) & 7, h = ci & 3;
    for (int q = F.tid; q < 4 * 5 * 32; q += NTHREADS) { const int sl = q / 160, r = q % 160; *(LAS v4u*)(lds + sl * C2_SLOT + 10240 + (r >> 5) * 1024 + 512 + (r & 31) * 16) = (v4u){0u, 0u, 0u, 0u}; }
    __syncthreads();
    if (F.wave < 2) {
        const int cw = F.wave;
        f32x4 st[4];
#pragma unroll
        for (int t = 0; t < 4; ++t) st[t] = (f32x4){0.f, 0.f, 0.f, 0.f};
        v4u af[15], vf, nf[15], nvf;
#define C2_RD(AF, VF, c_) do { const LAS unsigned char* p_ = lds + ((c_) & 3) * C2_SLOT + lane * 16; \
            _Pragma("unroll") for (int f_ = 0; f_ < 15; ++f_) AF[f_] = *(const LAS v4u*)(p_ + f_ * 1024); \
            VF = *(const LAS v4u*)(lds + ((c_) & 3) * C2_SLOT + 15360 + cw * 512 + i * 32 + (g & 1) * 16); } while (0)
#define C2_STEP(AF, VF, NF, NVF, n_) do { \
            if ((n_) + 1 < 256) C2_RD(NF, NVF, (n_) + 1); \
            const bf16x8 b0_ = pack8(st[0], st[1]), b1_ = pack8(st[2], st[3]); const v4u vz_ = (g < 2) ? VF : (v4u){0u, 0u, 0u, 0u}; const bf16x8 bv_ = __builtin_bit_cast(bf16x8, vz_); \
            f32x4 o_[5]; \
            _Pragma("unroll") for (int nt = 0; nt < 5; ++nt) { if (MODE >= 2) { o_[nt] = __builtin_bit_cast(f32x4, AF[nt]) + __builtin_bit_cast(f32x4, AF[10 + nt]) * st[nt & 3]; continue; } \
                f32x4 a_ = __builtin_amdgcn_mfma_f32_16x16x32_bf16(__builtin_bit_cast(bf16x8, AF[nt * 2]), b0_, (f32x4){0.f, 0.f, 0.f, 0.f}, 0, 0, 0); \
                a_ = __builtin_amdgcn_mfma_f32_16x16x32_bf16(__builtin_bit_cast(bf16x8, AF[nt * 2 + 1]), b1_, a_, 0, 0, 0); \
                o_[nt] = __builtin_amdgcn_mfma_f32_16x16x32_bf16(__builtin_bit_cast(bf16x8, AF[10 + nt]), bv_, a_, 0, 0, 0); } \
            _Pragma("unroll") for (int t = 0; t < 4; ++t) st[t] = o_[t]; \
            { v2u yw_; yw_.x = pk2(o_[4].x, o_[4].y); yw_.y = pk2(o_[4].z, o_[4].w); \
              *(LAS v2u*)(lds + C2_YOFF + (cw * 8 + ((n_) & 7)) * 512 + i * 32 + g * 8) = yw_; }     \
            } while (0)
        C2_BAR();
        C2_RD(af, vf, 0);
        for (int n = 0; n < 256; n += 2) { C2_STEP(af, vf, nf, nvf, n); C2_STEP(nf, nvf, af, vf, n + 1); C2_BAR(); }
        C2_BAR();
#undef C2_STEP
#undef C2_RD
    } else {
        const int hl = F.tid - 128;
        const GAS unsigned char* gt = (d ? (const GAS unsigned char*)F.out : F.ws + WS_GT0) + ((size_t)(bb * 4 + h) * 256) * GT_CHUNK;
        GAS bf16* ysc = (GAS bf16*)(d ? (GAS unsigned char*)F.out + GT_DIR : F.ws + WS_YSC0) + (size_t)bb * T * 256 + h * 64 + 32 * tp;
        const int p0 = hl, p1 = hl + 384, p2 = hl + 768; const bool has2 = p2 < 800;
#define C2_OFF(p_) ((p_) < 640 ? (p_) * 16 : 10240 + (((p_) - 640) >> 5) * 1024 + (((p_) - 640) & 31) * 16)
        const int o0 = C2_OFF(p0), o1 = C2_OFF(p1), o2 = C2_OFF(has2 ? p2 : 799);
        const int e0 = hl, e1 = hl + 384; const bool hasv1 = e1 < 512;
        const GAS bf16* vs0 = proj + (size_t)bb * T * NPROJP + C_V + h * 64 + 32 * tp + 16 * (e0 >> 8) + (e0 & 15);
        const GAS bf16* vs1 = proj + (size_t)bb * T * NPROJP + C_V + h * 64 + 32 * tp + 16 * ((hasv1 ? e1 : 0) >> 8) + (e1 & 15);
        const int vt0 = (e0 >> 4) & 15, vt1 = (e1 >> 4) & 15;
        const int vo0 = 15360 + (e0 >> 8) * 512 + (e0 & 15) * 32 + vt0 * 2, vo1 = 15360 + ((hasv1 ? e1 : 0) >> 8) * 512 + (e1 & 15) * 32 + vt1 * 2;
        constexpr int RD = 12;
        v4u r0[RD], r1[RD], r2[RD]; unsigned short rv0[RD], rv1[RD];
        if (MODE == 1 || MODE == 3) {
#pragma unroll
            for (int k = 0; k < RD; ++k) { r0[k] = (v4u){1u, 2u, 3u, 4u}; r1[k] = r0[k]; r2[k] = r0[k]; rv0[k] = 0; rv1[k] = 0; } }
#define C2_GLD(k_, n_) do { if (MODE == 1 || MODE == 3) break; const GAS unsigned char* c_ = gt + (size_t)(n_) * GT_CHUNK; r0[k_] = *(const GAS v4u*)(c_ + p0 * 16); r1[k_] = *(const GAS v4u*)(c_ + p1 * 16); \
            if (has2) r2[k_] = *(const GAS v4u*)(c_ + p2 * 16); \
            { const int gs_ = 16 * (n_) + vt0, t_ = d ? (T - 1 - gs_) : gs_; rv0[k_] = vs0[(size_t)t_ * NPROJP]; } \
            if (hasv1) { const int gs_ = 16 * (n_) + vt1, t_ = d ? (T - 1 - gs_) : gs_; rv1[k_] = vs1[(size_t)t_ * NPROJP]; } } while (0)
#define C2_WR(k_, n_) do { LAS unsigned char* p_ = lds + ((n_) & 3) * C2_SLOT; *(LAS v4u*)(p_ + o0) = r0[k_]; *(LAS v4u*)(p_ + o1) = r1[k_]; if (has2) *(LAS v4u*)(p_ + o2) = r2[k_]; \
            *(LAS unsigned short*)(p_ + vo0) = rv0[k_]; if (hasv1) *(LAS unsigned short*)(p_ + vo1) = rv1[k_]; } while (0)
#define C2_YST(m_) do { if (hl < 64) { const int cw_ = hl >> 5, s_ = (hl >> 1) & 15, hf_ = hl & 1; const LAS unsigned short* yp_ = (const LAS unsigned short*)(lds + C2_YOFF + (cw_ * 8 + ((m_) & 7)) * 512) + s_; \
            v4u w_; _Pragma("unroll") for (int e_ = 0; e_ < 4; ++e_) w_[e_] = (unsigned)yp_[(8 * hf_ + 2 * e_) * 16] | ((unsigned)yp_[(8 * hf_ + 2 * e_ + 1) * 16] << 16); \
            const int gs_ = 16 * (m_) + s_, t_ = d ? (T - 1 - gs_) : gs_; if (MODE == 0) *(GAS v4u*)(ysc + (size_t)t_ * 256 + 16 * cw_ + 8 * hf_) = w_; else asm volatile("" :: "v"(w_)); } } while (0)
#pragma unroll
        for (int k = 0; k < RD; ++k) C2_GLD(k, k);
        C2_WR(0, 0); C2_GLD(0, RD); C2_WR(1, 1); C2_GLD(1, RD + 1); C2_WR(2, 2); C2_GLD(2, RD + 2);
        C2_BAR();
        for (int m6 = 0; m6 < 128; m6 += RD / 2) {
#pragma unroll
            for (int k = 0; k < RD / 2; ++k) { const int m = m6 + k;
                if (m < 128) {
                    const int ca = 2 * m + 3, cb = 2 * m + 4, ka = (2 * k + 3) % RD, kb = (2 * k + 4) % RD;
                    if (ca < 256) { C2_WR(ka, ca); if (ca + RD < 256) C2_GLD(ka, ca + RD); }
                    if (cb < 256) { C2_WR(kb, cb); if (cb + RD < 256) C2_GLD(kb, cb + RD); }
                    if (m > 0) { C2_YST(2 * m - 2); C2_YST(2 * m - 1); }
                    C2_BAR(); } }
        }
        C2_YST(254); C2_YST(255);
        C2_BAR();
#undef C2_GLD
#undef C2_WR
#undef C2_YST
#undef C2_OFF
    }
    }
    __syncthreads();
}
#undef C2_BAR
#undef CK_DOT
#undef CK_RED2

__device__ __forceinline__ void phase_rwkv_post(Frame& F, int l) {
    LAUNDER(F);
    const GAS bf16* proj = (const GAS bf16*)(F.ws + WS_PROJ); GAS bf16* merged = (GAS bf16*)(F.ws + WS_MERGED); const GAS bf16* ysc0 = (const GAS bf16*)(F.ws + WS_YSC0); const GAS bf16* ysc1 = (const GAS bf16*)((const GAS unsigned char*)F.out + GT_DIR);
    const int lane = F.lane, c4 = 4 * lane, hd = lane >> 4;
    LAS float* GUP = (LAS float*)F.lds;
    for (int q = F.tid; q < 32 * 256; q += NTHREADS) GUP[q] = INP(F, I_RGUP)[(size_t)l * 32 * 256 + q];
    __syncthreads();
    const f32x4 lw = *(const f32x4*)(INP(F, I_LNXW) + l * 256 + c4), lb = *(const f32x4*)(INP(F, I_LNXB) + l * 256 + c4), rk = *(const f32x4*)(INP(F, I_RRK) + l * 256 + c4);
    const int mstep = F.G * NWAVES; int m = F.vcu * NWAVES + F.wave;
    v2u n_yf, n_yb, n_r, n_k, n_v; unsigned short n_g;
#define POST_LOAD(mm) do { const GAS bf16* row_ = proj + (size_t)(mm) * NPROJP; n_yf = *(const GAS v2u*)(ysc0 + (size_t)(mm) * 256 + c4); n_yb = *(const GAS v2u*)(ysc1 + (size_t)(mm) * 256 + c4); \
        n_r = *(const GAS v2u*)(row_ + C_R + c4); n_k = *(const GAS v2u*)(row_ + C_K + c4); n_v = *(const GAS v2u*)(row_ + C_V + c4); n_g = row_[C_GDN + (lane & 31)]; } while (0)
    POST_LOAD(m);
    for (; m < M; m += mstep) {
        const v2u yf = n_yf, yb = n_yb, ru = n_r, ku = n_k, vu = n_v; const unsigned short gu = n_g;
        if (m + mstep < M) POST_LOAD(m + mstep);
        f32x4 y = (f32x4){bflo(yf.x) + bflo(yb.x), bfhi(yf.x) + bfhi(yb.x), bflo(yf.y) + bflo(yb.y), bfhi(yf.y) + bfhi(yb.y)};
        const float mu = row16_sum((y.x + y.y) + (y.z + y.w)) * (1.f / 64.f);
        y = y - mu;
        const float var = row16_sum((y.x * y.x + y.y * y.y) + (y.z * y.z + y.w * y.w)) * (1.f / 64.f);
        const float rstd = rsqf_(var + GN_EPS);
        y = y * rstd * lw + lb;
        const f32x4 r = (f32x4){bflo(ru.x), bfhi(ru.x), bflo(ru.y), bfhi(ru.y)}, k = (f32x4){bflo(ku.x), bfhi(ku.x), bflo(ku.y), bfhi(ku.y)}, v = (f32x4){bflo(vu.x), bfhi(vu.x), bflo(vu.y), bfhi(vu.y)};
        const f32x4 rkk = r * k * rk;
        const float bsum = row16_sum((rkk.x + rkk.y) + (rkk.z + rkk.w));
        y = y + v * bsum;
        const float gd = sigmoidf_(bf2f(gu));
        f32x4 gt = (f32x4){0.f, 0.f, 0.f, 0.f};
#pragma unroll
        for (int j = 0; j < 32; ++j) { const float gj = __builtin_bit_cast(float, __builtin_amdgcn_readlane(__builtin_bit_cast(int, gd), j)); gt = gt + *(const LAS f32x4*)(GUP + j * 256 + c4) * gj; }
        y = y * gt;
        const float ss = wave_sum((y.x * y.x + y.y * y.y) + (y.z * y.z + y.w * y.w));
        const float sc = rsqf_(ss * (1.f / 256.f) + NORM_EPS);
        v2u o; o.x = pk2(y.x * sc, y.y * sc); o.y = pk2(y.z * sc, y.w * sc);
        *(GAS v2u*)(merged + (size_t)m * DM + 256 + c4) = o;
    }
#undef POST_LOAD
    (void)hd;
}

__device__ __forceinline__ void phase_residual(Frame& F, const GAS float* gain, const bool IN_F32, const bool LAST) {
    LAUNDER(F);
    const GAS bf16* y = (const GAS bf16*)(F.ws + WS_Y); const GAS float* part = (const GAS float*)(F.ws + WS_PART);
    GAS bf16* xb = (GAS bf16*)(F.ws + WS_XB); GAS float* rs = (GAS float*)(F.ws + WS_RS); const GAS float* xin = INP(F, I_X);
    const int lane = F.lane;
    f32x4 gv[4];
#pragma unroll
    for (int j = 0; j < 4; ++j) gv[j] = *((const f32x4*)gain + lane + 64 * j);
    for (int m = F.vcu * NWAVES + F.wave; m < M; m += F.G * NWAVES) {
        const f32x4* pp = (const f32x4*)(part + (size_t)m * 16);
        const f32x4 p0 = *(const GAS f32x4*)(pp), p1 = *(const GAS f32x4*)(pp + 1), p2 = *(const GAS f32x4*)(pp + 2), p3 = *(const GAS f32x4*)(pp + 3);
        const float tot = ((p0.x + p0.y) + (p0.z + p0.w)) + ((p1.x + p1.y) + (p1.z + p1.w)) + ((p2.x + p2.y) + (p2.z + p2.w)) + ((p3.x + p3.y) + (p3.z + p3.w));
        const float sc = rsqf_(tot * (1.f / DM) + NORM_EPS);
        const GAS v2u* yr = (const GAS v2u*)(y + (size_t)m * DM) + lane;
        f32x4 v[4]; float s = 0.f;
#pragma unroll
        for (int j = 0; j < 4; ++j) { const v2u yu = yr[64 * j]; const f32x4 yv = (f32x4){bflo(yu.x), bfhi(yu.x), bflo(yu.y), bfhi(yu.y)};
            f32x4 xv;
            if (IN_F32) xv = ((const GAS f32x4*)(xin + (size_t)m * DM) + lane)[64 * j];
            else { const v2u xu = ((const GAS v2u*)(xb + (size_t)m * DM) + lane)[64 * j]; xv = (f32x4){bflo(xu.x), bfhi(xu.x), bflo(xu.y), bfhi(xu.y)}; }
            v[j] = xv + yv * sc * gv[j]; s += (v[j].x * v[j].x + v[j].y * v[j].y) + (v[j].z * v[j].z + v[j].w * v[j].w); }
        if (LAST) {
            GAS f32x4* orow = (GAS f32x4*)(F.out + (size_t)m * DM) + lane;
#pragma unroll
            for (int j = 0; j < 4; ++j) orow[64 * j] = v[j];
        } else {
            s = wave_sum(s);
            GAS v2u* o8 = (GAS v2u*)(xb + (size_t)m * DM) + lane;
#pragma unroll
            for (int j = 0; j < 4; ++j) { v2u o; o.x = pk2(v[j].x, v[j].y); o.y = pk2(v[j].z, v[j].w); o8[64 * j] = o; }
            if (lane == 0) rs[m] = rsqf_(s * (1.f / DM) + NORM_EPS);
        }
    }
}
__device__ __forceinline__ void phase_ffn_conv(Frame& F, int l) {
    LAUNDER(F);
    const GAS bf16* G = (const GAS bf16*)(F.ws + WS_G); GAS bf16* L = (GAS bf16*)(F.ws + WS_L);
    const GAS float* cw = INP(F, I_FCONV) + (size_t)l * 3 * DFF;
    constexpr int CPR = DFF / 8;
    const int nitems = (M / 256) * 2 * CPR;
    for (int it = F.vcu * NTHREADS + F.tid; it < nitems; it += F.G * NTHREADS) {
        const int ck = it % CPR, rr = it / CPR, m = (rr >> 1) * 256 + ((rr & 1) ? 255 : 0), t = m % T, c8 = 8 * ck;
        float w0[8], w1[8], w2[8];
#pragma unroll
        for (int j = 0; j < 8; ++j) { w0[j] = cw[c8 + j]; w1[j] = cw[DFF + c8 + j]; w2[j] = cw[2 * DFF + c8 + j]; }
        const v4u z = (v4u){0u, 0u, 0u, 0u};
        const v4u gp = (t > 0) ? *(const GAS v4u*)(G + (size_t)(m - 1) * DFF + c8) : z, gc = *(const GAS v4u*)(G + (size_t)m * DFF + c8), gn = (t < T - 1) ? *(const GAS v4u*)(G + (size_t)(m + 1) * DFF + c8) : z;
        const v4u lv = *(const GAS v4u*)(L + (size_t)m * DFF + c8);
        v4u o;
#pragma unroll
        for (int q = 0; q < 4; ++q) {
            const float a0 = w0[2 * q] * bflo(gp[q]) + w1[2 * q] * bflo(gc[q]) + w2[2 * q] * bflo(gn[q]);
            const float a1 = w0[2 * q + 1] * bfhi(gp[q]) + w1[2 * q + 1] * bfhi(gc[q]) + w2[2 * q + 1] * bfhi(gn[q]);
            o[q] = pk2(gelu_tanh(a0) * bflo(lv[q]), gelu_tanh(a1) * bfhi(lv[q])); }
        *(GAS v4u*)(L + (size_t)m * DFF + c8) = o;
    }
}

#ifndef MK_N_LAUNCHES
#define MK_N_LAUNCHES 1
#endif
constexpr int NPH = 1 + 8 * DEPTH;
struct Args { const float* in[26]; float* out; unsigned char* ws; int ph_lo, ph_hi; };
__global__ void __launch_bounds__(NTHREADS, 2) enc_fwd(Args args) {
    extern __shared__ __attribute__((aligned(16))) unsigned char lds_raw[];
    Frame F;
    F.lds = (LAS unsigned char*)lds_raw;
    F.MISC = (volatile LAS unsigned*)(F.lds + MISC_OFF);
    F.tid = threadIdx.x; F.lane = F.tid & 63; F.wave = __builtin_amdgcn_readfirstlane(F.tid >> 6);
    F.G = gridDim.x; { const int bx = blockIdx.x; F.vcu = (F.G % 8 == 0) ? (bx % 8) * (F.G / 8) + bx / 8 : bx; }
    F.ws = (GAS unsigned char*)args.ws; F.out = (GAS float*)args.out; F.ctl = (gu32*)(F.ws + WS_CTL);
    F.karg = (kq_t*)__builtin_amdgcn_kernarg_segment_ptr();
    for (int u = F.tid; u < LDS_BYTES / 16; u += NTHREADS) ((LAS v4u*)F.lds)[u] = (v4u){0u, 0u, 0u, 0u};
    __syncthreads();
    const int lo = args.ph_lo, hi = args.ph_hi;
    if (hi - lo > 1) (void)xcd_barrier_post((unsigned*)(F.ctl + CW_BAR), F.MISC + 8);
#define GRID_BAR() do { XcdBarrier bar_; bar_.bar = (unsigned*)(F.ctl + CW_BAR); bar_.x = xb_xcc_id(); bar_.st = F.MISC + 8; xcd_barrier(bar_); } while (0)
#ifndef PH_ENABLE
#define PH_ENABLE 0x7ff
#endif
#define IN(k) (lo <= (k) && (k) < hi)
#define EN(t) (((PH_ENABLE) >> (t)) & 1)
#pragma unroll 1
#ifdef REPEAT_T
    for (int step = lo; step < hi; ++step) {
        const int p1 = REPEAT_T, p2 = REPEAT_T + 8;
        const int ph = step - (step > p1 ? 1 : 0) - ((step > p2 + 1 && REPEAT_T != 7) ? 1 : 0);
#else
    for (int ph = lo; ph < hi; ++ph) {
#endif
        LAUNDER(F);
        const int l = ph == 0 ? 0 : (ph - 1) / 8, tt = ph == 0 ? 0 : 1 + (ph - 1) % 8;
        const int t = tt == 0 ? 0 : (tt == 1 ? 1 : (tt <= 5 ? tt + 1 : tt + 2));
        GAS unsigned char* wl = F.ws + WS_W + (size_t)l * W_LAYER;
      {
        if (t == 1 || t == 8) {
            pg8::Gemm g; pg8::EpiUni E;
            g.M = M; E.split_cols = 0; E.split_stride = 0; E.convw = nullptr; E.G = nullptr; E.xl = (pg8::PG8_LAS_T*)(F.lds + RING_BYTES + 1024); E.part = nullptr; E.rs = (const GAS float*)(F.ws + WS_RS);
            g.A = (const GAS bf16*)(F.ws + WS_XB); g.K = DM;
            if (t == 1) { g.Bt = (const GAS bf16*)(wl + W_IN); g.N = NPROJP; E.O = (GAS bf16*)(F.ws + WS_PROJ); E.ldc = NPROJP; }
            else        { g.Bt = (const GAS bf16*)(wl + W_UP); g.N = NUP;    E.O = (GAS bf16*)(F.ws + WS_L); E.ldc = DFF; E.convw = INP(F, I_FCONV) + (size_t)l * 3 * DFF; E.G = (GAS bf16*)(F.ws + WS_G); }
            g.Bt = launder_p(g.Bt); E.O = launder_p(E.O); E.convw = launder_p(E.convw); E.G = launder_p(E.G); g.N = launder_u(g.N); E.ldc = launder_u(E.ldc);
            g.A = launder_p(g.A); E.rs = launder_p(E.rs);
            pg8::StaticOrder S; S.init(M, g.N, F.G, (int)blockIdx.x);
            pg8::gemm_phase<pg8::EpiUni, pg8::StaticOrder, true, true>(F.lds, g, S, E);
        }
        else if (t == 6 || t == 10) {
            pg8::Gemm g; pg8::EpiResid E;
            g.M = M; g.N = DM; E.xl = (pg8::PG8_LAS_T*)(F.lds + RING_BYTES + 1024);
            E.xb = (GAS bf16*)(F.ws + WS_XB); E.outf = F.out; E.rsw = (GAS float*)(F.ws + WS_RS); E.xs = (GAS float*)(F.ws + WS_XS); E.resid = 1;
            if (t == 6) { g.A = (const GAS bf16*)(F.ws + WS_MERGED); g.Bt = (const GAS bf16*)(wl + W_OUT); g.K = DM;  E.gain = INP(F, I_NMPOST) + l * DM; E.cnt = (GAS unsigned*)(F.ctl + CW_PANEL) + (size_t)(l * 2 + 0) * 2 * 128 * 64; }
            else        { g.A = (const GAS bf16*)(F.ws + WS_L);      g.Bt = (const GAS bf16*)(wl + W_DN);  g.K = DFF; E.gain = INP(F, I_NFPOST) + l * DM; if (l + 1 == DEPTH) E.resid = 2; E.cnt = (GAS unsigned*)(F.ctl + CW_PANEL) + (size_t)(l * 2 + 1) * 2 * 128 * 64; }
            g.A = launder_p(g.A); g.Bt = launder_p(g.Bt); g.K = launder_u(g.K); E.gain = launder_p(E.gain); E.cnt = launder_p(E.cnt); E.resid = launder_u(E.resid);
            E.xb = launder_p(E.xb); E.outf = launder_p(E.outf); E.rsw = launder_p(E.rsw); E.xs = launder_p(E.xs);
            pg8::StaticOrder S; S.init(M, g.N, F.G, (int)blockIdx.x);
            pg8::gemm_phase<pg8::EpiResid, pg8::StaticOrder, true, true>(F.lds, g, S, E);
        }
        else if (t == 0) p0_prologue(F);
#ifdef C1_EXP
        else if (t == 3) { phase_mixers(F, l); phase_scan_c1<0>(F, l); phase_scan_c1<C1_EXP>(F, l); }
#else
        else if (t == 3) { phase_mixers(F, l); phase_scan_c1<0>(F, l); }
#endif
#ifdef C2_EXP
        else if (t == 4) { phase_scan_c2<0>(F, l); phase_scan_c2<C2_EXP>(F, l); }
#else
        else if (t == 4) phase_scan_c2<0>(F, l);
#endif
        else if (t == 5) phase_rwkv_post(F, l);
        else if (t == 9) phase_ffn_conv(F, l);
      }
#ifdef REPEAT_T
        if (step + 1 < hi) GRID_BAR();
#else
        if (ph + 1 < hi) GRID_BAR();
#endif
    }
    asm volatile("s_waitcnt vmcnt(0) lgkmcnt(0)" ::: "memory");
}


#ifdef DBG_CHECK
__global__ void dbg_check(const void* buf, size_t n, int kind, int code, unsigned* flag) {
    bool bad = false;
    for (size_t i = (size_t)blockIdx.x * blockDim.x + threadIdx.x; i < n; i += (size_t)gridDim.x * blockDim.x) {
        float v;
        if (kind == 0) v = bf2f(((const unsigned short*)buf)[i]);
        else if (kind == 1) v = ((const float*)buf)[i];
        else v = (float)((const _Float16*)buf)[i];
        if (!(fabsf(v) < 1e30f)) bad = true;
    }
    if (bad) atomicMax(flag, (unsigned)(1000000 - code));
}
__global__ void dbg_report(float* out, const unsigned* flag) { if (threadIdx.x == 0 && blockIdx.x == 0) { const unsigned f = *flag; if (f) out[0] = 100000.f * (float)(10 + 1000000 - (int)f); } }
#endif
extern "C" void kernel_launch(void* const* d_in, const int* in_sizes, int n_in, void* d_out, int out_size, void* d_ws, size_t ws_size, hipStream_t stream) {
    static int grid = 0;
    if (grid == 0) {
        if (n_in != 26 || in_sizes[0] != M * DM || out_size != M * DM || ws_size < WS_END) { fprintf(stderr, "kernel_launch: unexpected shapes: n_in %d in0 %d out %d ws %zu (need >= %zu)\n", n_in, n_in > 0 ? in_sizes[0] : -1, out_size, ws_size, (size_t)WS_END); grid = -1; return; }
        int dev = 0, cus = 0, per_cu = 0;
        if (hipGetDevice(&dev) != hipSuccess || hipDeviceGetAttribute(&cus, hipDeviceAttributeMultiprocessorCount, dev) != hipSuccess) { grid = -1; return; }
        if (hipFuncSetAttribute((const void*)enc_fwd, hipFuncAttributeMaxDynamicSharedMemorySize, LDS_BYTES) != hipSuccess) { fprintf(stderr, "kernel_launch: hipFuncSetAttribute failed\n"); grid = -1; return; }
        if (hipOccupancyMaxActiveBlocksPerMultiprocessor(&per_cu, (const void*)enc_fwd, NTHREADS, LDS_BYTES) != hipSuccess || per_cu < 1) { fprintf(stderr, "kernel_launch: occupancy query says %d blocks per CU\n", per_cu); }
        (void)hipGetLastError();
        grid = cus;
        if (grid != 256) fprintf(stderr, "kernel_launch: %d CUs (built for 256)\n", grid);
    }
    if (grid < 0) return;
    (void)hipMemsetAsync((char*)d_ws + WS_CTL, 0, CTL_ZERO_BYTES, stream);
    Args a{};
    for (int i = 0; i < 26; ++i) a.in[i] = (const float*)d_in[i];
    a.out = (float*)d_out; a.ws = (unsigned char*)d_ws;
#if MK_N_LAUNCHES == 1
#ifdef REPEAT_T
    a.ph_lo = 0; a.ph_hi = NPH + (REPEAT_T == 7 ? 1 : 2);
#else
    a.ph_lo = 0; a.ph_hi = NPH;
#endif
    hipLaunchKernelGGL(enc_fwd, dim3(grid), dim3(NTHREADS), LDS_BYTES, stream, a);
#else
    for (int p = 0; p < NPH; ++p) { a.ph_lo = p; a.ph_hi = p + 1; hipLaunchKernelGGL(enc_fwd, dim3(grid), dim3(NTHREADS), LDS_BYTES, stream, a);
#ifdef DBG_CHECK
        unsigned* flag = (unsigned*)((char*)d_ws + 512 * 1024); char* ws = (char*)d_ws; const int t = p == 0 ? 0 : 1 + (p - 1) % 10;
#define CHK(ptr, n, kind, sub) hipLaunchKernelGGL(dbg_check, dim3(2048), dim3(256), 0, stream, (const void*)(ptr), (size_t)(n), kind, p * 4 + sub, flag)
        if (t == 0) { CHK(ws + WS_W, 2 * W_LAYER / 2, 0, 0); CHK(ws + WS_XB, (size_t)M * DM, 0, 1); CHK(ws + WS_RS, M, 1, 2); }
        if (t == 1) { CHK(ws + WS_PROJ, (size_t)M * NPROJP, 0, 0); }
        if (t == 2) { CHK(ws + WS_PREP, (size_t)64 * MiB, 2, 1); }
        if (t == 3) { CHK(d_out, (size_t)2 * M * 256, 0, 0); }
        if (t == 4) { CHK(ws + WS_MERGED, (size_t)M * DM, 0, 0); }
        if (t == 5 || t == 9) { CHK(ws + WS_Y, (size_t)M * DM, 1, 0); CHK(ws + WS_PART, (size_t)M * 16, 1, 1); }
        if (t == 6 || t == 10) { CHK(d_out, (size_t)M * DM, 1, 0); CHK(ws + WS_XB, (size_t)M * DM, 0, 1); CHK(ws + WS_RS, M, 1, 2); }
        if (t == 7) { CHK(ws + WS_G, (size_t)M * DFF, 0, 0); CHK(ws + WS_L, (size_t)M * DFF, 0, 1); }
        if (t == 8) { CHK(ws + WS_L, (size_t)M * DFF, 0, 0); }
        if (p == NPH - 1) hipLaunchKernelGGL(dbg_report, dim3(1), dim3(64), 0, stream, (float*)d_out, (const unsigned*)flag);
#endif
    }
#endif
}
```

```cpp
#include <hip/hip_runtime.h>
#include <cstdio>
#include <cstdint>
namespace pg8 {
#define PG8_LAS __attribute__((address_space(3)))
#define PG8_GAS __attribute__((address_space(1)))
typedef PG8_LAS unsigned char PG8_LAS_T;
typedef unsigned short bf16_t;
typedef short bf16x8 __attribute__((ext_vector_type(8)));
typedef float f32x4 __attribute__((ext_vector_type(4)));
typedef unsigned u32x4 __attribute__((ext_vector_type(4)));
constexpr int BM = 256, BK = 64, HALF = 128, HTB = HALF * BK * 2  , STAGE_BYTES = 8 * HTB, NXCD = 8, WGM = 4;

__host__ __device__ __forceinline__ int lds_byte(int r, int c) { const int st = (r >> 4) * 2 + (c >> 5), rr = r & 15, cc = c & 31, ob = rr * 64 + cc * 2; return st * 1024 + (ob ^ (((ob >> 9) & 1) << 5)); }
__host__ __device__ __forceinline__ void stage_rc(int b, int& R, int& C) { const int st = b / 1024, sb = b % 1024, swz = sb ^ (((sb >> 9) & 1) << 5); R = (st >> 1) * 16 + swz / 64; C = (st & 1) * 32 + (swz % 64) / 2; }
__host__ __device__ __forceinline__ int perm32(int rho) { const int n = rho >> 4, i = rho & 15; return 8 * (i >> 2) + 4 * n + (i & 3); }

struct Unit { int pm, pn; };
struct Gemm { const PG8_GAS bf16_t* A; const PG8_GAS bf16_t* Bt; int M, N, K; };

struct StaticOrder {
    int nM, nN, nwg, G, c;
    __host__ __device__ void init(int M, int N, int G_, int c_) { nM = M / BM; nN = N / BM; nwg = nM * nN; G = G_; c = c_; }
    __host__ __device__ bool next(int i, Unit& u) const {
        const long L = (long)i * G + c; if (L >= nwg) return false;
        int wgid = (int)L; { const int q = nwg / NXCD, r = nwg % NXCD, xcd = wgid % NXCD, off = wgid / NXCD; wgid = (xcd < r ? xcd * (q + 1) : r * (q + 1) + (xcd - r) * q) + off; }
        const int nig = WGM * nN, gid = wgid / nig, fm = gid * WGM, gsz = (nM - fm) < WGM ? (nM - fm) : WGM;
        u.pm = fm + ((wgid % nig) % gsz); u.pn = (wgid % nig) / gsz; return true;
    }
    __device__ __forceinline__ void a_ready(const Unit&) const {}
    __device__ __forceinline__ void done(const Unit&) const {}
};
typedef float f32x2c __attribute__((ext_vector_type(2)));
typedef __bf16 bf16x2c __attribute__((ext_vector_type(2)));
__device__ __forceinline__ unsigned cvt_pk_bf16(float lo, float hi) { const f32x2c v = {lo, hi}; return __builtin_bit_cast(unsigned, __builtin_convertvector(v, bf16x2c)); }
struct EpiUni {
    static constexpr bool AFTER_DRAIN = false;
    PG8_GAS bf16_t* O; int ldc; const PG8_GAS float* rs; int split_cols; size_t split_stride; PG8_GAS float* part;
    const PG8_GAS float* convw; PG8_GAS bf16_t* G; PG8_LAS unsigned char* xl;
    __device__ __forceinline__ bool perm() const { return true; }
    template <int CTRL> static __device__ __forceinline__ float dppo(float old, float x) { return __builtin_bit_cast(float, __builtin_amdgcn_update_dpp(__builtin_bit_cast(int, old), __builtin_bit_cast(int, x), CTRL, 0xF, 0xF, false)); }
    static __device__ __forceinline__ float gelu_t(float x) { const float u = 1.5957691216057308f * x * (1.f + 0.044715f * x * x); return x * __builtin_amdgcn_rcpf(1.f + __expf(-u)); }
    __device__ __forceinline__ void conv_epi(const f32x4 (&acc_)[2][2][4][2], const Unit& u, int wr, int wc, int fr, int fq) const {
        f32x4 (&acc)[2][2][4][2] = const_cast<f32x4 (&)[2][2][4][2]>(acc_);
        const int hcol = u.pn * HALF + wc * 32 + 8 * fq;
        const PG8_GAS float* rsp = rs + u.pm * BM + wr * 64 + fr;
        constexpr int LDH = 2816;
        const unsigned lane_off = (unsigned)((wr * 64 + fr) * LDH + hcol) * 2u;
        PG8_GAS char* Ob = (PG8_GAS char*)(O + (size_t)u.pm * BM * LDH); PG8_GAS char* Gb = (PG8_GAS char*)(G + (size_t)u.pm * BM * LDH);
        unsigned lp[2][4][2][2];
#pragma unroll
        for (int ai = 0; ai < 2; ++ai)
#pragma unroll
            for (int m = 0; m < 4; ++m) { const float r = rsp[ai * HALF + m * 16];
#pragma unroll
                for (int n = 0; n < 2; ++n) { const f32x4 l4 = acc[ai][1][m][n] * r; lp[ai][m][n][0] = cvt_pk_bf16(l4[0], l4[1]); lp[ai][m][n][1] = cvt_pk_bf16(l4[2], l4[3]); } }
#pragma unroll
        for (int ai = 0; ai < 2; ++ai) { const int k = 2 * ai + wr;
            if (fr == 0)  { const float r = rsp[ai * HALF]; PG8_LAS f32x4* p = (PG8_LAS f32x4*)(xl + ((k * 2 + 0) * 4 + wc) * 128 + fq * 32); p[0] = acc[ai][0][0][0] * r; p[1] = acc[ai][0][0][1] * r; }
            if (fr == 15) { const float r = rsp[ai * HALF + 48]; PG8_LAS f32x4* p = (PG8_LAS f32x4*)(xl + ((k * 2 + 1) * 4 + wc) * 128 + fq * 32); p[0] = acc[ai][0][3][0] * r; p[1] = acc[ai][0][3][1] * r; } }
        asm volatile("s_waitcnt lgkmcnt(0)" ::: "memory"); __builtin_amdgcn_s_barrier(); asm volatile("" ::: "memory");
#pragma unroll
        for (int ai = 0; ai < 2; ++ai) { const int k = 2 * ai + wr;
            float rsv[4];
#pragma unroll
            for (int m = 0; m < 4; ++m) { rsv[m] = rsp[ai * HALF + m * 16];
#pragma unroll
                for (int n = 0; n < 2; ++n) acc[ai][0][m][n] = acc[ai][0][m][n] * rsv[m]; }
            const int ku = k > 0 ? k - 1 : 0, kd = k < 3 ? k + 1 : 3;
#pragma unroll
            for (int n = 0; n < 2; ++n) {
                float w0[4], w1[4], w2[4];
#pragma unroll
                for (int j = 0; j < 4; ++j) { w0[j] = convw[hcol + 4 * n + j]; w1[j] = convw[LDH + hcol + 4 * n + j]; w2[j] = convw[2 * LDH + hcol + 4 * n + j]; }
                const f32x4 xt = *(const PG8_LAS f32x4*)(xl + ((ku * 2 + 1) * 4 + wc) * 128 + fq * 32 + n * 16), xb = *(const PG8_LAS f32x4*)(xl + ((kd * 2 + 0) * 4 + wc) * 128 + fq * 32 + n * 16);
#pragma unroll
                for (int m = 0; m < 4; ++m) { const int tr = 64 * k + 16 * m + fr; const unsigned coff = (unsigned)((ai * HALF + 16 * m) * LDH * 2 + 8 * n);
                    float hv[4];
#pragma unroll
                    for (int e = 0; e < 4; ++e) { const float cur = acc[ai][0][m][n][e];
                        const float upx = (m > 0) ? dppo<0x121>(0.f, acc[ai][0][m > 0 ? m - 1 : 0][n][e]) : xt[e];
                        const float dnx = (m < 3) ? dppo<0x12F>(0.f, acc[ai][0][m < 3 ? m + 1 : 3][n][e]) : xb[e];
                        const float up = dppo<0x111>(upx, cur), dn = dppo<0x101>(dnx, cur);
                        const float a = w0[e] * up + w1[e] * cur + w2[e] * dn;
                        const unsigned lw = lp[ai][m][n][e >> 1]; const float lv = (e & 1) ? __builtin_bit_cast(float, lw & 0xffff0000u) : __builtin_bit_cast(float, lw << 16);
                        hv[e] = (tr == 0 || tr == 255) ? lv : gelu_t(a) * lv; }
                    typedef unsigned u32x2_ __attribute__((ext_vector_type(2)));
                    u32x2_ w; w.x = cvt_pk_bf16(hv[0], hv[1]); w.y = cvt_pk_bf16(hv[2], hv[3]);
                    *(PG8_GAS u32x2_*)(Ob + coff + lane_off) = w;
                    if (tr <= 1 || tr >= 254) { u32x2_ gw; gw.x = cvt_pk_bf16(acc[ai][0][m][n][0], acc[ai][0][m][n][1]); gw.y = cvt_pk_bf16(acc[ai][0][m][n][2], acc[ai][0][m][n][3]);
                        *(PG8_GAS u32x2_*)(Gb + coff + lane_off) = gw; }
                    __builtin_amdgcn_sched_barrier(0); }
                asm volatile("" ::: "memory");
            }
        }
    }
    __device__ __forceinline__ void operator()(const f32x4 (&acc)[2][2][4][2], const Unit& u, int wr, int wc, int fr, int fq) const {
        if (convw != nullptr) { conv_epi(acc, u, wr, wc, fr, fq); return; }
        const int row0 = u.pm * BM + wr * 64 + fr; int colt = u.pn * BM; PG8_GAS bf16_t* base = O;
        if (split_cols) { const int t = colt / split_cols; base += (size_t)t * split_stride; colt -= t * split_cols; }
        const int col0 = colt + wc * 32 + 8 * fq;
        if (part == nullptr) {
#pragma unroll
            for (int ai = 0; ai < 2; ++ai)
#pragma unroll
                for (int m = 0; m < 4; ++m) { const int row = row0 + ai * HALF + m * 16; const float s = rs[row]; PG8_GAS bf16_t* rowp = base + (size_t)row * ldc + col0;
#pragma unroll
                    for (int bj = 0; bj < 2; ++bj) { const f32x4 v0 = acc[ai][bj][m][0] * s, v1 = acc[ai][bj][m][1] * s;
                        u32x4 w; w.x = cvt_pk_bf16(v0[0], v0[1]); w.y = cvt_pk_bf16(v0[2], v0[3]); w.z = cvt_pk_bf16(v1[0], v1[1]); w.w = cvt_pk_bf16(v1[2], v1[3]);
                        *(PG8_GAS u32x4*)(rowp + bj * HALF) = w; } }
        } else {
#pragma unroll
            for (int ai = 0; ai < 2; ++ai)
#pragma unroll
                for (int m = 0; m < 4; ++m) { const int row = row0 + ai * HALF + m * 16; PG8_GAS bf16_t* rowp = base + (size_t)row * ldc + col0; float ss = 0.f;
#pragma unroll
                    for (int bj = 0; bj < 2; ++bj) { const f32x4 v0 = acc[ai][bj][m][0], v1 = acc[ai][bj][m][1];
                        ss += ((v0[0] * v0[0] + v0[1] * v0[1]) + (v0[2] * v0[2] + v0[3] * v0[3])) + ((v1[0] * v1[0] + v1[1] * v1[1]) + (v1[2] * v1[2] + v1[3] * v1[3]));
                        u32x4 w; w.x = cvt_pk_bf16(v0[0], v0[1]); w.y = cvt_pk_bf16(v0[2], v0[3]); w.z = cvt_pk_bf16(v1[0], v1[1]); w.w = cvt_pk_bf16(v1[2], v1[3]);
                        *(PG8_GAS u32x4*)(rowp + bj * HALF) = w; }
                    ss += __shfl_xor(ss, 16); ss += __shfl_xor(ss, 32); if (fq == 0) part[(size_t)row * 16 + u.pn * 4 + wc] = ss; }
        }
    }
};
struct EpiResid {
    static constexpr bool AFTER_DRAIN = false;
    PG8_LAS unsigned char* xl;
    __device__ __forceinline__ bool perm() const { return true; }
    int resid; const PG8_GAS float* gain; PG8_GAS bf16_t* xb; PG8_GAS float* outf; PG8_GAS float* rsw; PG8_GAS float* xs; PG8_GAS unsigned* cnt;
    static __device__ __forceinline__ f32x4 unlo(unsigned a, unsigned b) { return (f32x4){__builtin_bit_cast(float, a << 16), __builtin_bit_cast(float, a & 0xffff0000u), __builtin_bit_cast(float, b << 16), __builtin_bit_cast(float, b & 0xffff0000u)}; }
    static __device__ __forceinline__ float hsum(const f32x4 v) { return (v[0] + v[1]) + (v[2] + v[3]); }
    __device__ __forceinline__ void resid_epi(const f32x4 (&acc_)[2][2][4][2], const Unit& u, int, int, int, int) const {
        f32x4 (&acc)[2][2][4][2] = const_cast<f32x4 (&)[2][2][4][2]>(acc_);
        int tid = threadIdx.x; asm volatile("" : "+v"(tid));
        const int wid = __builtin_amdgcn_readfirstlane(tid >> 6), wr = wid >> 2, wc = wid & 3, fr = tid & 15, fq = (tid >> 4) & 3;
        const int col0 = u.pn * BM + wc * 32 + 8 * fq;
        const unsigned lane_e = (unsigned)((wr * 64 + fr) * 1024 + col0);
        PG8_GAS char* xbb = (PG8_GAS char*)(xb + (size_t)u.pm * BM * 1024); PG8_GAS char* outb = (PG8_GAS char*)(outf + (size_t)u.pm * BM * 1024);
        PG8_LAS f32x4* P4 = (PG8_LAS f32x4*)xl; PG8_LAS float* S2 = (PG8_LAS float*)(xl + 16384);
        PG8_LAS float* GW = (PG8_LAS float*)(xl + 18432) + (wr * 4 + wc) * 64;
        { const int ln = fq * 16 + fr; GW[ln] = gain[u.pn * BM + (ln >> 5) * HALF + wc * 32 + (ln & 31)]; }
#pragma unroll
        for (int ai = 0; ai < 2; ++ai)
#pragma unroll
            for (int m = 0; m < 4; ++m) {
#pragma unroll
                for (int bj = 0; bj < 2; ++bj) { const f32x4 v0 = acc[ai][bj][m][0], v1 = acc[ai][bj][m][1];
                    u32x4 p; p.x = cvt_pk_bf16(v0[0], v0[1]); p.y = cvt_pk_bf16(v0[2], v0[3]); p.z = cvt_pk_bf16(v1[0], v1[1]); p.w = cvt_pk_bf16(v1[2], v1[3]);
                    acc[ai][bj][m][0] = __builtin_bit_cast(f32x4, p); }
                __builtin_amdgcn_sched_barrier(0); }
#define PG8_XLD(it_) do { unsigned le_ = lane_e; asm volatile("" : "+v"(le_)); _Pragma("unroll") for (int bj = 0; bj < 2; ++bj) \
            xq[(it_) % 3][bj] = *(const PG8_GAS u32x4*)(xbb + (size_t)((unsigned)(((((it_) >> 2) * HALF) + 16 * ((it_) & 3)) * 1024 + bj * HALF) + le_) * 2); } while (0)
        {   u32x4 xq[3][2];
            PG8_XLD(0); PG8_XLD(1);
#pragma unroll
            for (int it = 0; it < 8; ++it) { const int ai = it >> 2, m = it & 3;
                if (it + 2 < 8) PG8_XLD(it + 2);
                float sa = 0.f, sb = 0.f, sc = 0.f, sd = 0.f;
#pragma unroll
                for (int bj = 0; bj < 2; ++bj) { f32x4 py_ = acc[ai][bj][m][0]; asm volatile("" : "+v"(py_));
                    const u32x4 p = __builtin_bit_cast(u32x4, py_), xw = xq[it % 3][bj];
                    const f32x4 g0 = *(const PG8_LAS f32x4*)(GW + bj * 32 + 8 * fq), g1 = *(const PG8_LAS f32x4*)(GW + bj * 32 + 8 * fq + 4);
                    const f32x4 y0 = unlo(p.x, p.y), y1 = unlo(p.z, p.w), x0 = unlo(xw.x, xw.y), x1 = unlo(xw.z, xw.w), q0 = y0 * g0, q1 = y1 * g1;
                    sa += hsum(y0 * y0) + hsum(y1 * y1); sb += hsum(x0 * x0) + hsum(x1 * x1); sc += hsum(x0 * q0) + hsum(x1 * q1); sd += hsum(q0 * q0) + hsum(q1 * q1); }
                sa += __shfl_xor(sa, 16); sb += __shfl_xor(sb, 16); sc += __shfl_xor(sc, 16); sd += __shfl_xor(sd, 16);
                sa += __shfl_xor(sa, 32); sb += __shfl_xor(sb, 32); sc += __shfl_xor(sc, 32); sd += __shfl_xor(sd, 32);
                if (fq == 0) P4[(ai * HALF + wr * 64 + m * 16 + fr) * 4 + wc] = (f32x4){sa, sb, sc, sd};
                __builtin_amdgcn_sched_barrier(0); } }
        asm volatile("s_waitcnt lgkmcnt(0)" ::: "memory"); __builtin_amdgcn_s_barrier(); asm volatile("" ::: "memory");
        PG8_GAS float* slot = xs + (size_t)u.pm * BM * 16;
        PG8_GAS unsigned* c = cnt + u.pm * 64;
        if (tid < 256) { const f32x4 t4 = (P4[tid * 4 + 0] + P4[tid * 4 + 1]) + (P4[tid * 4 + 2] + P4[tid * 4 + 3]);
#pragma unroll
            for (int j = 0; j < 4; ++j) __hip_atomic_store(slot + tid * 16 + u.pn * 4 + j, t4[j], __ATOMIC_RELAXED, __HIP_MEMORY_SCOPE_AGENT);
            asm volatile("s_waitcnt vmcnt(0)" ::: "memory");
            if ((tid & 63) == 0) __hip_atomic_fetch_add(c, 1u, __ATOMIC_RELAXED, __HIP_MEMORY_SCOPE_AGENT); }
        if (tid < 64) { unsigned spins = 0;
            while ((unsigned)__builtin_amdgcn_readfirstlane(__hip_atomic_load(c, __ATOMIC_RELAXED, __HIP_MEMORY_SCOPE_AGENT)) < 16u) { __builtin_amdgcn_s_sleep(2); if (++spins > (1u << 22)) break; }
            __builtin_amdgcn_fence(__ATOMIC_ACQUIRE, "agent"); asm volatile("s_waitcnt vmcnt(0)" ::: "memory"); }
        asm volatile("s_waitcnt lgkmcnt(0)" ::: "memory"); __builtin_amdgcn_s_barrier(); asm volatile("" ::: "memory");
        if (tid < 256) { float t[4] = {0.f, 0.f, 0.f, 0.f};
#pragma unroll
            for (int q = 0; q < 4; ++q)
#pragma unroll
                for (int j = 0; j < 4; ++j) t[j] += __hip_atomic_load(slot + tid * 16 + q * 4 + j, __ATOMIC_RELAXED, __HIP_MEMORY_SCOPE_AGENT);
            const float ry = __builtin_amdgcn_rsqf(t[0] * (1.f / 1024.f) + 1e-6f);
            const float sx = t[1] + ry * (2.f * t[2] + ry * t[3]);
            const float rn = __builtin_amdgcn_rsqf(sx * (1.f / 1024.f) + 1e-6f);
            S2[tid * 2] = ry; S2[tid * 2 + 1] = rn;
            if (resid == 1 && u.pn == 0) rsw[(size_t)u.pm * BM + tid] = rn; }
        asm volatile("s_waitcnt lgkmcnt(0)" ::: "memory"); __builtin_amdgcn_s_barrier(); asm volatile("" ::: "memory");
        {   u32x4 xq[3][2];
            PG8_XLD(0); PG8_XLD(1);
#pragma unroll
            for (int it = 0; it < 8; ++it) { const int ai = it >> 2, m = it & 3;
                if (it + 2 < 8) PG8_XLD(it + 2);
                const float sc = S2[(ai * HALF + wr * 64 + m * 16 + fr) * 2];
                unsigned le = lane_e; asm volatile("" : "+v"(le));
#pragma unroll
                for (int bj = 0; bj < 2; ++bj) { const unsigned ce = (unsigned)((ai * HALF + 16 * m) * 1024 + bj * HALF);
                    f32x4 py_ = acc[ai][bj][m][0]; asm volatile("" : "+v"(py_));
                    const u32x4 p = __builtin_bit_cast(u32x4, py_), xw = xq[it % 3][bj];
                    const f32x4 g0 = *(const PG8_LAS f32x4*)(GW + bj * 32 + 8 * fq), g1 = *(const PG8_LAS f32x4*)(GW + bj * 32 + 8 * fq + 4);
                    const f32x4 v0 = unlo(xw.x, xw.y) + unlo(p.x, p.y) * sc * g0, v1 = unlo(xw.z, xw.w) + unlo(p.z, p.w) * sc * g1;
                    if (resid == 2) { PG8_GAS f32x4* op = (PG8_GAS f32x4*)(outb + (size_t)(ce + le) * 4); op[0] = v0; op[1] = v1; }
                    else { u32x4 w; w.x = cvt_pk_bf16(v0[0], v0[1]); w.y = cvt_pk_bf16(v0[2], v0[3]); w.z = cvt_pk_bf16(v1[0], v1[1]); w.w = cvt_pk_bf16(v1[2], v1[3]);
                        *(PG8_GAS u32x4*)(xbb + (size_t)(ce + le) * 2) = w; } }
                asm volatile("" ::: "memory"); __builtin_amdgcn_sched_barrier(0); } }
#undef PG8_XLD
    }
    __device__ __forceinline__ void operator()(const f32x4 (&acc)[2][2][4][2], const Unit& u, int wr, int wc, int fr, int fq) const { resid_epi(acc, u, wr, wc, fr, fq); }
};
template <class Epi, class Sched, bool ALIGN_EPI = false, bool SP2 = false>
__device__ __forceinline__ void gemm_phase(PG8_LAS unsigned char* lds, const Gemm g, const Sched& S, const Epi& E) {
    int tid_ = threadIdx.x; asm volatile("" : "+v"(tid_));
    const int tid = tid_, wid = __builtin_amdgcn_readfirstlane(tid >> 6), lane = tid & 63, wr = wid >> 2, wc = wid & 3, fr = lane & 15, fq = lane >> 4;
    const int K = g.K, nt = K / BK;
    unsigned voffA[2], voffB[2];
#pragma unroll
    for (int i = 0; i < 2; ++i) { int R, C; stage_rc(tid * 16 + i * 8192, R, C); const int Rb = E.perm() ? ((R & ~31) + perm32(R & 31)) : R;
        voffA[i] = (unsigned)(R * K + C) * 2u; voffB[i] = (unsigned)(Rb * K + C) * 2u; }
    const size_t kstep = (size_t)(BK * 2);
    const size_t hstep = (size_t)HALF * K * 2;
    const size_t tstep = 2 * hstep;
    const unsigned ldsw = (unsigned)wid * 1024u;
    const int aoff = lds_byte(wr * 64 + fr, fq * 8), boff = lds_byte(wc * 32 + fr, fq * 8);
#define PG8_SA(b, h) (((b) * 2 + (h)) * HTB)
#define PG8_SB(b, h) ((4 + (b) * 2 + (h)) * HTB)
#define PG8_STAGE(bufoff, gbase, voff) do { _Pragma("unroll") for (int _i = 0; _i < 2; ++_i) \
        __builtin_amdgcn_global_load_lds((const PG8_GAS unsigned*)((const PG8_GAS char*)(gbase) + (voff)[_i]), (PG8_LAS unsigned*)(lds + (bufoff) + ldsw + _i * 8192), 16, 0, 0); } while (0)
#define PG8_LDA(dst, b, h) do { _Pragma("unroll") for (int m = 0; m < 4; ++m) _Pragma("unroll") for (int k = 0; k < 2; ++k) dst[m][k] = *(const PG8_LAS bf16x8*)(lds + PG8_SA(b, h) + aoff + m * 2048 + k * 1024); } while (0)
#define PG8_LDB(dst, b, h) do { _Pragma("unroll") for (int n = 0; n < 2; ++n) _Pragma("unroll") for (int k = 0; k < 2; ++k) dst[n][k] = *(const PG8_LAS bf16x8*)(lds + PG8_SB(b, h) + boff + n * 2048 + k * 1024); } while (0)
#define PG8_MMA(ai, bj, At, Bt) do { __builtin_amdgcn_s_setprio(1); _Pragma("unroll") for (int m = 0; m < 4; ++m) _Pragma("unroll") for (int n = 0; n < 2; ++n) _Pragma("unroll") for (int k = 0; k < 2; ++k) \
        acc[ai][bj][m][n] = __builtin_amdgcn_mfma_f32_16x16x32_bf16(Bt[n][k], At[m][k], acc[ai][bj][m][n], 0, 0, 0); __builtin_amdgcn_s_setprio(0); } while (0)
#define PG8_WAIT_V(n) asm volatile("s_waitcnt vmcnt(" #n ")" ::: "memory")
#define PG8_WAIT_L(n) asm volatile("s_waitcnt lgkmcnt(" #n ")" ::: "memory")
#define PG8_BAR __builtin_amdgcn_s_barrier()
#define PG8_SCHED __builtin_amdgcn_sched_barrier(0)
    Unit cur, nxt; int ui = 0;
    if (!S.next(0, cur)) return;
    f32x4 acc[2][2][4][2];
#pragma unroll
    for (int a = 0; a < 2; ++a)
#pragma unroll
        for (int b = 0; b < 2; ++b)
#pragma unroll
            for (int m = 0; m < 4; ++m)
#pragma unroll
                for (int n = 0; n < 2; ++n) acc[a][b][m][n] = (f32x4){0.f, 0.f, 0.f, 0.f};
    bf16x8 At[4][2], B0[2][2], B1[2][2];
    const PG8_GAS char* cA = (const PG8_GAS char*)g.A + (size_t)cur.pm * tstep; const PG8_GAS char* cB = (const PG8_GAS char*)g.Bt + (size_t)cur.pn * tstep;
    S.a_ready(cur);
    if constexpr (SP2) {
        PG8_STAGE(PG8_SB(0, 0), cB, voffB); PG8_STAGE(PG8_SB(0, 1), cB + hstep, voffB); PG8_STAGE(PG8_SA(0, 0), cA, voffA); PG8_STAGE(PG8_SA(0, 1), cA + hstep, voffA);
        if (wr == 1) PG8_BAR;
        PG8_WAIT_V(2); PG8_BAR;
        PG8_STAGE(PG8_SB(1, 0), cB + kstep, voffB); PG8_STAGE(PG8_SA(1, 0), cA + kstep, voffA); PG8_STAGE(PG8_SB(1, 1), cB + hstep + kstep, voffB);
        PG8_WAIT_V(6); PG8_BAR;
    } else {
        PG8_STAGE(PG8_SB(0, 0), cB, voffB); PG8_STAGE(PG8_SA(0, 0), cA, voffA); PG8_STAGE(PG8_SB(0, 1), cB + hstep, voffB); PG8_STAGE(PG8_SA(0, 1), cA + hstep, voffA);
        if (wr == 1) PG8_BAR;
        PG8_WAIT_V(4); PG8_BAR;
        PG8_STAGE(PG8_SB(1, 0), cB + kstep, voffB); PG8_STAGE(PG8_SA(1, 0), cA + kstep, voffA); PG8_STAGE(PG8_SB(1, 1), cB + hstep + kstep, voffB);
        PG8_WAIT_V(6); PG8_BAR;
    }
    for (;;) {
        const bool has_next = S.next(ui + 1, nxt);
        const PG8_GAS char* nA = has_next ? (const PG8_GAS char*)g.A + (size_t)nxt.pm * tstep : cA; const PG8_GAS char* nB = has_next ? (const PG8_GAS char*)g.Bt + (size_t)nxt.pn * tstep : cB;
        for (int t = 0; t < nt; t += 2) {
            const bool last = (t == nt - 2);
            const PG8_GAS char* a1 = cA + (size_t)(t + 1) * kstep;
            const PG8_GAS char* a2 = last ? nA : cA + (size_t)(t + 2) * kstep; const PG8_GAS char* b2 = last ? nB : cB + (size_t)(t + 2) * kstep;
            const PG8_GAS char* a3 = a2 + kstep; const PG8_GAS char* b3 = b2 + kstep;
            if (last && has_next) S.a_ready(nxt);
            if constexpr (SP2) {
            PG8_LDB(B0, 0, 0); PG8_LDB(B1, 0, 1); PG8_SCHED; PG8_LDA(At, 0, 0); PG8_STAGE(PG8_SA(1, 1), a1 + hstep, voffA);
            PG8_WAIT_V(8); PG8_WAIT_L(0); PG8_BAR; PG8_MMA(0, 0, At, B0); PG8_MMA(0, 1, At, B1); PG8_BAR; PG8_SCHED;
            PG8_LDA(At, 0, 1); PG8_STAGE(PG8_SB(0, 0), b2, voffB); PG8_STAGE(PG8_SB(0, 1), b2 + hstep, voffB); PG8_STAGE(PG8_SA(0, 0), a2, voffA);
            PG8_WAIT_V(8); PG8_WAIT_L(0); PG8_BAR; PG8_MMA(1, 0, At, B0); PG8_MMA(1, 1, At, B1); PG8_BAR; PG8_SCHED;
            PG8_LDB(B0, 1, 0); PG8_LDB(B1, 1, 1); PG8_SCHED; PG8_LDA(At, 1, 0); PG8_STAGE(PG8_SA(0, 1), a2 + hstep, voffA);
            PG8_WAIT_V(8); PG8_WAIT_L(0); PG8_BAR; PG8_MMA(0, 0, At, B0); PG8_MMA(0, 1, At, B1); PG8_BAR; PG8_SCHED;
            PG8_LDA(At, 1, 1); PG8_STAGE(PG8_SB(1, 0), b3, voffB); PG8_STAGE(PG8_SB(1, 1), b3 + hstep, voffB); PG8_STAGE(PG8_SA(1, 0), a3, voffA);
            PG8_WAIT_V(8); PG8_WAIT_L(0); PG8_BAR; PG8_MMA(1, 0, At, B0); PG8_MMA(1, 1, At, B1); PG8_BAR; PG8_SCHED;
            } else {
            PG8_LDB(B0, 0, 0); PG8_SCHED; PG8_LDA(At, 0, 0); PG8_STAGE(PG8_SA(1, 1), a1 + hstep, voffA);
            PG8_WAIT_L(8); PG8_BAR; PG8_WAIT_L(0); PG8_MMA(0, 0, At, B0); PG8_BAR; PG8_SCHED;
            PG8_LDB(B1, 0, 1); PG8_STAGE(PG8_SB(0, 0), b2, voffB);
            PG8_BAR; PG8_WAIT_L(0); PG8_MMA(0, 1, At, B1); PG8_BAR;
            PG8_LDA(At, 0, 1); PG8_STAGE(PG8_SA(0, 0), a2, voffA);
            PG8_BAR; PG8_WAIT_L(0); PG8_MMA(1, 0, At, B0); PG8_BAR; PG8_SCHED;
            PG8_STAGE(PG8_SB(0, 1), b2 + hstep, voffB);
            PG8_WAIT_V(6); PG8_BAR; PG8_MMA(1, 1, At, B1); PG8_BAR;
            PG8_LDB(B0, 1, 0); PG8_SCHED; PG8_LDA(At, 1, 0); PG8_STAGE(PG8_SA(0, 1), a2 + hstep, voffA);
            PG8_WAIT_L(8); PG8_BAR; PG8_WAIT_L(0); PG8_MMA(0, 0, At, B0); PG8_BAR; PG8_SCHED;
            PG8_LDB(B1, 1, 1); PG8_STAGE(PG8_SB(1, 0), b3, voffB);
            PG8_BAR; PG8_WAIT_L(0); PG8_MMA(0, 1, At, B1); PG8_BAR;
            PG8_LDA(At, 1, 1); PG8_STAGE(PG8_SA(1, 0), a3, voffA);
            PG8_BAR; PG8_WAIT_L(0); PG8_MMA(1, 0, At, B0); PG8_BAR; PG8_SCHED;
            PG8_STAGE(PG8_SB(1, 1), b3 + hstep, voffB);
            PG8_WAIT_V(6); PG8_BAR; PG8_MMA(1, 1, At, B1); PG8_BAR;
            }
        }
        if constexpr (ALIGN_EPI) { if (wr == 0) PG8_BAR; }
        if constexpr (!Epi::AFTER_DRAIN) { E(acc, cur, wr, wc, fr, fq); S.done(cur); }
        if (!has_next) break;
#pragma unroll
        for (int a = 0; a < 2; ++a)
#pragma unroll
            for (int b = 0; b < 2; ++b)
#pragma unroll
                for (int m = 0; m < 4; ++m)
#pragma unroll
                    for (int n = 0; n < 2; ++n) acc[a][b][m][n] = (f32x4){0.f, 0.f, 0.f, 0.f};
        cur = nxt; cA = nA; cB = nB; ++ui;
        if constexpr (ALIGN_EPI) { if (wr == 1) PG8_BAR; }
    }
    PG8_WAIT_V(0);
    if constexpr (!ALIGN_EPI) { if (wr == 0) PG8_BAR; }
    PG8_BAR;
    if constexpr (Epi::AFTER_DRAIN) { E.fused(acc, cur, wr, wc, fr, fq, lds, wid, lane); S.done(cur); }
#undef PG8_SA
#undef PG8_SB
#undef PG8_STAGE
#undef PG8_LDA
#undef PG8_LDB
#undef PG8_MMA
#undef PG8_WAIT_V
#undef PG8_WAIT_L
#undef PG8_BAR
#undef PG8_SCHED
}
}

constexpr int NB = 8, T = 4096, DM = 1024, M = NB * T, DEPTH = 2;
constexpr int NPROJ = 2912, NPROJP = 3072, DFF = 2816, NUP = 2 * DFF;
constexpr int C_CH = 0, C_CB = 256, C_CC = 512, C_R = 768, C_K = 1024, C_V = 1280, C_DEC = 1536, C_GDN = 1600, C_NQ = 1632, C_NK = 1888, C_NV = 2144, C_SU = 2400, C_SV = 2656;
constexpr float NORM_EPS = 1e-6f, GN_EPS = 64e-5f, DECAY_SCALE = 0.60653065971263342f;
constexpr int NWAVES = 8, NTHREADS = 512;
constexpr size_t MiB = 1u << 20;
constexpr size_t WS_CTL = 0, CTL_ZERO_BYTES = 1 * MiB;
constexpr size_t WS_RS = 1 * MiB;
constexpr size_t WS_PART = 1 * MiB + 256 * 1024;
constexpr size_t WS_W = 4 * MiB, W_LAYER = 24 * MiB + 512 * 1024;
constexpr size_t W_IN = 0, W_OUT = 6 * MiB, W_UP = 8 * MiB, W_DN = 19 * MiB;
constexpr size_t WS_XB = 53 * MiB;
constexpr size_t WS_R = 117 * MiB;
constexpr size_t WS_PROJ = WS_R, WS_MERGED = WS_R + 192 * MiB, WS_PREP = WS_R + 256 * MiB;
constexpr size_t GT_CHUNK = 12800, GT_DIR = (size_t)NB * 4 * 256 * GT_CHUNK;
constexpr size_t WS_GT0 = WS_PREP, WS_YSC0 = WS_PREP + 100 * MiB;
static_assert(GT_DIR == 100 * MiB, "GT size");
constexpr size_t WS_Y = WS_R;
constexpr size_t WS_G = WS_R, WS_L = WS_R + 176 * MiB;
constexpr size_t WS_END = 501 * MiB;
static_assert(WS_W + 2 * W_LAYER <= WS_XB && WS_PREP + 128 * MiB <= WS_END && WS_L + 176 * MiB <= WS_END && WS_PART + (size_t)M * 64 <= WS_W, "ws map");
constexpr int CW_BAR = 4096;
constexpr int CW_PANEL = 16384;
constexpr size_t WS_XS = WS_PART;
constexpr int RING_BYTES = 131072, LDSCTL_OFF = RING_BYTES, MISC_OFF = LDSCTL_OFF + 320, LDS_BYTES = 152576;

#define GAS __attribute__((address_space(1)))
#define LAS __attribute__((address_space(3)))
typedef unsigned short bf16;
typedef unsigned v4u __attribute__((ext_vector_type(4)));
typedef unsigned v2u __attribute__((ext_vector_type(2)));
typedef float f32x4 __attribute__((ext_vector_type(4)));
typedef short bf16x8 __attribute__((ext_vector_type(8)));
typedef short s16x4 __attribute__((ext_vector_type(4)));
typedef _Float16 h2 __attribute__((ext_vector_type(2)));
typedef GAS unsigned gu32;
#define RLX_AGENT __ATOMIC_RELAXED, __HIP_MEMORY_SCOPE_AGENT
__device__ __forceinline__ unsigned pk2(float lo, float hi) { return pg8::cvt_pk_bf16(lo, hi); }
__device__ __forceinline__ unsigned f2bf(float f) { return (unsigned)__builtin_bit_cast(unsigned short, (__bf16)f); }
__device__ __forceinline__ float bflo(unsigned w) { return __builtin_bit_cast(float, w << 16); }
__device__ __forceinline__ float bfhi(unsigned w) { return __builtin_bit_cast(float, w & 0xffff0000u); }
__device__ __forceinline__ float bf2f(unsigned short b) { return __builtin_bit_cast(float, (unsigned)b << 16); }
__device__ __forceinline__ h2 as_h2(unsigned u) { return __builtin_bit_cast(h2, u); }
template <int CTRL> __device__ __forceinline__ float dppmov(float x) { return __builtin_bit_cast(float, __builtin_amdgcn_update_dpp(0, __builtin_bit_cast(int, x), CTRL, 0xF, 0xF, true)); }
__device__ __forceinline__ float row16_sum(float x) { x += dppmov<0xB1>(x); x += dppmov<0x4E>(x); x += dppmov<0x141>(x); x += dppmov<0x140>(x); return x; }
typedef unsigned u32x2_t __attribute__((ext_vector_type(2)));
__device__ __forceinline__ float xor16_sum(float x) { const u32x2_t r = __builtin_amdgcn_permlane16_swap(__builtin_bit_cast(unsigned, x), __builtin_bit_cast(unsigned, x), false, false);
    const unsigned a = r.x, b = r.y; return __builtin_bit_cast(float, a) + __builtin_bit_cast(float, b); }
__device__ __forceinline__ float xor32_sum(float x) { const u32x2_t r = __builtin_amdgcn_permlane32_swap(__builtin_bit_cast(unsigned, x), __builtin_bit_cast(unsigned, x), false, false);
    const unsigned a = r.x, b = r.y; return __builtin_bit_cast(float, a) + __builtin_bit_cast(float, b); }
__device__ __forceinline__ float wave_sum(float v) { return xor32_sum(xor16_sum(row16_sum(v))); }
__device__ __forceinline__ float row16_max(float x) { x = fmaxf(x, dppmov<0xB1>(x)); x = fmaxf(x, dppmov<0x4E>(x)); x = fmaxf(x, dppmov<0x141>(x)); x = fmaxf(x, dppmov<0x140>(x)); return x; }
__device__ __forceinline__ float rcpf_(float x) { return __builtin_amdgcn_rcpf(x); }
__device__ __forceinline__ float rsqf_(float x) { return __builtin_amdgcn_rsqf(x); }
__device__ __forceinline__ float sigmoidf_(float x) { return rcpf_(1.f + __expf(-x)); }
__device__ __forceinline__ float tanhf_(float x) { return 1.f - 2.f * rcpf_(__expf(2.f * x) + 1.f); }
__device__ __forceinline__ float gelu_tanh(float x) { const float u = 1.5957691216057308f * x * (1.f + 0.044715f * x * x); return x * rcpf_(1.f + __expf(-u)); }
#define XB_TMO      128
#define XB_XCNT(j)  (256  + 64 * (j))
#define XB_XSUB(j)  (1280 + 64 * (j))
#define XB_XGEN(j)  (2304 + 64 * (j))
#define XB_TOP      3328
#define XB_TOPGEN   3392
#define XCD_BAR_WORDS 3456
#define XB_SPIN_CAP (1u << 18)

__device__ __forceinline__ unsigned xb_ld(unsigned* p)              { return __hip_atomic_load(p, __ATOMIC_RELAXED, __HIP_MEMORY_SCOPE_AGENT); }
__device__ __forceinline__ unsigned xb_add(unsigned* p, unsigned v) { return __hip_atomic_fetch_add(p, v, __ATOMIC_RELAXED, __HIP_MEMORY_SCOPE_AGENT); }
__device__ __forceinline__ unsigned xb_xcc_id() { return (unsigned)__builtin_amdgcn_s_getreg((3 << 11) | 20) & 0xFu; }
#define XB_SPIN(cond, bar) do { unsigned _sp = 0; while (cond) { __builtin_amdgcn_s_sleep(1); \
    if ((++_sp & 255u) == 0u) { if (xb_ld(&(bar)[XB_TMO])) break; if (_sp > XB_SPIN_CAP) { atomicAdd(&(bar)[XB_TMO], 1u); break; } } } } while (0)

struct XcdBarrier {
    unsigned* bar; unsigned x;
    volatile LAS unsigned* st;
};

__device__ __forceinline__ XcdBarrier xcd_barrier_post(unsigned* bar, volatile LAS unsigned* st) {
    XcdBarrier b; b.bar = bar; b.x = xb_xcc_id(); b.st = st;
    if (threadIdx.x == 0) (void)xb_add(&bar[XB_XCNT(b.x)], 1u);
    return b;
}
__device__ __forceinline__ void xcd_barrier_complete(unsigned* bar, unsigned x, unsigned& nloc, unsigned& nx) {
    const unsigned G = gridDim.x * gridDim.y * gridDim.z;
    unsigned sum, cnt, mine, sp = 0u;
    for (;;) {
        sum = 0u; cnt = 0u; mine = 0u;
#pragma unroll
        for (unsigned j = 0; j < 16; ++j) { const unsigned c = xb_ld(&bar[XB_XCNT(j)]); sum += c; cnt += (c > 0u) ? 1u : 0u; mine = (j == x) ? c : mine; }
        if (sum == G) break;
        __builtin_amdgcn_s_sleep(1);
        if ((++sp & 255u) == 0u) { if (xb_ld(&bar[XB_TMO])) break; if (sp > XB_SPIN_CAP) { atomicAdd(&bar[XB_TMO], 1u); break; } }
    }
    nloc = mine > 0u ? mine : 1u; nx = cnt > 0u ? cnt : 1u;
}

__device__ __forceinline__ void xcd_barrier(const XcdBarrier& b) {
    asm volatile("s_waitcnt vmcnt(0)" ::: "memory");
    __syncthreads();
    if (threadIdx.x == 0) {
        unsigned* bar = b.bar;
        __builtin_amdgcn_s_waitcnt(0);
        unsigned nloc = b.st[0], nx = b.st[1];
        if (nloc == 0u) { xcd_barrier_complete(bar, b.x, nloc, nx); b.st[0] = nloc; b.st[1] = nx; }
        const unsigned old = xb_add(&bar[XB_XSUB(b.x)], 1u);
        const unsigned gen = old / nloc;
        if (old + 1u == (gen + 1u) * nloc) {
            __builtin_amdgcn_fence(__ATOMIC_RELEASE, "agent");
            asm volatile("s_waitcnt vmcnt(0)" ::: "memory");
            const unsigned og = xb_add(&bar[XB_TOP], 1u);
            const unsigned tg = og / nx;
            if (og + 1u == (tg + 1u) * nx) xb_add(&bar[XB_TOPGEN], 1u);
            else XB_SPIN(xb_ld(&bar[XB_TOPGEN]) == tg, bar);
            __builtin_amdgcn_fence(__ATOMIC_ACQUIRE, "agent");
            xb_add(&bar[XB_XGEN(b.x)], 1u);
            asm volatile("s_waitcnt vmcnt(0)" ::: "memory");
        } else {
            XB_SPIN(xb_ld(&bar[XB_XGEN(b.x)]) == gen, bar);
            __builtin_amdgcn_fence(__ATOMIC_ACQUIRE, "agent");
            asm volatile("s_waitcnt vmcnt(0)" ::: "memory");
        }
    }
    __syncthreads();
}

typedef __attribute__((address_space(4))) const unsigned long long kq_t;
struct Frame {
    LAS unsigned char* lds;
    volatile LAS unsigned* MISC;
    gu32* ctl;
    int tid, lane, wave, vcu, G;
    kq_t* karg; GAS float* out; GAS unsigned char* ws;
};
#define INP(F, i) ((const GAS float*)(F).karg[(i)])
enum { I_X = 0, I_NMPRE, I_NMPOST, I_NFPRE, I_NFPOST, I_WIN, I_CONVW, I_RW0, I_RWUP, I_RA0, I_RAUP, I_RGUP, I_RKK, I_RKA, I_RRK, I_LNXW, I_LNXB, I_RPB, I_SGUN, I_SGUW, I_SGUB, I_MGAIN, I_WOUT, I_WUP, I_FCONV, I_WDN };
__device__ __forceinline__ int launder_u(int x) { asm volatile("" : "+v"(x)); return __builtin_amdgcn_readfirstlane(x); }
template <class P> __device__ __forceinline__ P launder_p(P p) { unsigned long long v = (unsigned long long)p; unsigned lo = (unsigned)v, hi = (unsigned)(v >> 32); asm volatile("" : "+v"(lo), "+v"(hi));
    lo = __builtin_amdgcn_readfirstlane(lo); hi = __builtin_amdgcn_readfirstlane(hi); return (P)(((unsigned long long)hi << 32) | lo); }
#define LAUNDER(F) do { asm volatile("" : "+v"((F).tid)); asm volatile("" : "+v"((F).lane)); (F).wave = launder_u((F).wave); (F).vcu = launder_u((F).vcu); (F).karg = launder_p((F).karg); (F).ws = launder_p((F).ws); (F).out = launder_p((F).out); } while (0)
#define LDS_WAIT() asm volatile("s_waitcnt lgkmcnt(0)" ::: "memory")
#define CFENCE() asm volatile("" ::: "memory")

__device__ __forceinline__ void p0_transpose_item(const GAS float* W, const GAS float* gain, int K, int N, GAS bf16* WT, LAS float* scr, int item, int lane, bool glmap = false) {
    const int nblk = N / 32, kb = item / nblk, nb = item % nblk, k0 = 64 * kb, n0 = 32 * nb;
    const int r0 = !glmap ? n0 : (n0 < N / 2 ? 256 * (n0 >> 7) + (n0 & 127) : 256 * ((n0 - N / 2) >> 7) + 128 + ((n0 - N / 2) & 127));
#pragma unroll 8
    for (int i = 0; i < 32; ++i) { const int kk = 2 * i + (lane >> 5); const float g = gain ? gain[k0 + kk] : 1.f; scr[kk * 33 + (lane & 31)] = W[(size_t)(k0 + kk) * N + n0 + (lane & 31)] * g; }
    LDS_WAIT(); CFENCE();
    const int c = lane & 7;
#pragma unroll
    for (int j = 0; j < 4; ++j) { const int n = (lane >> 3) + 8 * j; const LAS float* s = scr + (8 * c) * 33 + n;
        v4u o; o.x = pk2(s[0 * 33], s[1 * 33]); o.y = pk2(s[2 * 33], s[3 * 33]); o.z = pk2(s[4 * 33], s[5 * 33]); o.w = pk2(s[6 * 33], s[7 * 33]);
        *(GAS v4u*)(WT + (size_t)(r0 + n) * K + k0 + 8 * c) = o; }
    LDS_WAIT(); CFENCE();
}
__device__ __forceinline__ void row_to_bf16_rs(const GAS float* xrow, GAS bf16* orow, GAS float* rs, int lane) {
    const GAS f32x4* xr = (const GAS f32x4*)xrow + lane;
    f32x4 v[4]; float s = 0.f;
#pragma unroll
    for (int j = 0; j < 4; ++j) { v[j] = xr[64 * j]; s += (v[j].x * v[j].x + v[j].y * v[j].y) + (v[j].z * v[j].z + v[j].w * v[j].w); }
    s = wave_sum(s);
    GAS v2u* o8 = (GAS v2u*)orow + lane;
#pragma unroll
    for (int j = 0; j < 4; ++j) { v2u o; o.x = pk2(v[j].x, v[j].y); o.y = pk2(v[j].z, v[j].w); o8[64 * j] = o; }
    if (lane == 0) *rs = rsqf_(s * (1.f / DM) + NORM_EPS);
}
__device__ __forceinline__ void p0_prologue(Frame& F) {
    LAUNDER(F);
    LAS float* scr = (LAS float*)(F.lds + F.wave * 16384);
    const int gw = F.vcu * NWAVES + F.wave, NGW = F.G * NWAVES;
    constexpr int I_IN = (DM / 64) * (NPROJ / 32), I_OUT = (DM / 64) * (DM / 32), I_UP = (DM / 64) * (NUP / 32), I_DN = (DFF / 64) * (DM / 32), I_L = I_IN + I_OUT + I_UP + I_DN;
    for (int it = gw; it < DEPTH * I_L; it += NGW) {
        const int l = it / I_L; int r = it % I_L; GAS unsigned char* wl = F.ws + WS_W + (size_t)l * W_LAYER;
        if (r < I_IN) { p0_transpose_item(INP(F, I_WIN) + (size_t)l * DM * NPROJ, INP(F, I_NMPRE) + l * DM, DM, NPROJ, (GAS bf16*)(wl + W_IN), scr, r, F.lane); continue; } r -= I_IN;
        if (r < I_OUT) { p0_transpose_item(INP(F, I_WOUT) + (size_t)l * DM * DM, INP(F, I_MGAIN) + l * DM, DM, DM, (GAS bf16*)(wl + W_OUT), scr, r, F.lane); continue; } r -= I_OUT;
        if (r < I_UP) { p0_transpose_item(INP(F, I_WUP) + (size_t)l * DM * NUP, INP(F, I_NFPRE) + l * DM, DM, NUP, (GAS bf16*)(wl + W_UP), scr, r, F.lane, true); continue; } r -= I_UP;
        p0_transpose_item(INP(F, I_WDN) + (size_t)l * DFF * DM, nullptr, DFF, DM, (GAS bf16*)(wl + W_DN), scr, r, F.lane);
    }
    unsigned zz = 0u; asm volatile("" : "+v"(zz));
    for (int i = F.vcu * NTHREADS + F.tid; i < DEPTH * 20480; i += F.G * NTHREADS) { const int l = i / 20480, r = i % 20480;
        *(GAS v4u*)(F.ws + WS_W + (size_t)l * W_LAYER + W_IN + (size_t)NPROJ * DM * 2 + (size_t)r * 16) = (v4u){zz, zz, zz, zz}; }
    for (int m = gw; m < M; m += NGW) row_to_bf16_rs(INP(F, I_X) + (size_t)m * DM, (GAS bf16*)(F.ws + WS_XB) + (size_t)m * DM, (GAS float*)(F.ws + WS_RS) + m, F.lane);
}

typedef float f32x16 __attribute__((ext_vector_type(16)));
__device__ __forceinline__ void mix_convprep_tile(Frame& F, int l, int tile) {
    LAUNDER(F);
    const GAS bf16* proj = (const GAS bf16*)(F.ws + WS_PROJ); GAS bf16* merged = (GAS bf16*)(F.ws + WS_MERGED);
    const int m0 = tile * 64, bb = m0 / T, t0 = m0 % T;
    const int lane = F.lane, w = F.wave;
    {
        const int c4 = 4 * lane; const GAS float* cw = INP(F, I_CONVW) + l * 768;
        const f32x4 w0 = *(const f32x4*)(cw + c4), w1 = *(const f32x4*)(cw + 256 + c4), w2 = *(const f32x4*)(cw + 512 + c4);
        const int ts = t0 + 8 * w;
        v2u hr[10], cr[10], br[8];
#pragma unroll
        for (int j = 0; j < 10; ++j) { const int t = ts - 1 + j; const bool ok = (t >= 0 && t < T); const GAS bf16* row = proj + (size_t)(bb * T + (ok ? t : ts)) * NPROJP;
            hr[j] = *(const GAS v2u*)(row + C_CH + c4); cr[j] = *(const GAS v2u*)(row + C_CC + c4); if (!ok) { hr[j] = (v2u){0u, 0u}; } }
#pragma unroll
        for (int j = 0; j < 8; ++j) { const GAS bf16* row = proj + (size_t)(bb * T + ts + j) * NPROJP; br[j] = *(const GAS v2u*)(row + C_CB + c4); }
#pragma unroll
        for (int i = 0; i < 8; ++i) { const int t = ts + i;
            f32x4 z[3];
#pragma unroll
            for (int q = 0; q < 3; ++q) { const v2u h = hr[i + q], c = cr[i + q]; z[q] = (f32x4){bflo(h.x) * bflo(c.x), bfhi(h.x) * bfhi(c.x), bflo(h.y) * bflo(c.y), bfhi(h.y) * bfhi(c.y)}; }
            const v2u b = br[i];
            const f32x4 bv = (f32x4){bflo(b.x), bfhi(b.x), bflo(b.y), bfhi(b.y)};
            const f32x4 y = bv * (w0 * z[0] + w1 * z[1] + w2 * z[2]);
            float ss = (y.x * y.x + y.y * y.y) + (y.z * y.z + y.w * y.w); ss = wave_sum(ss);
            const float sc = rsqf_(ss * (1.f / 256.f) + NORM_EPS);
            v2u o; o.x = pk2(y.x * sc, y.y * sc); o.y = pk2(y.z * sc, y.w * sc);
            *(GAS v2u*)(merged + (size_t)(bb * T + t) * DM + 0 + c4) = o;
}
    }
}

__device__ __forceinline__ void mix_na_item(Frame& F, int l, int item, LAS unsigned char* wl, const LAS float* RPB) {
    LAUNDER(F);
    const GAS bf16* proj = (const GAS bf16*)(F.ws + WS_PROJ); GAS bf16* merged = (GAS bf16*)(F.ws + WS_MERGED);
    const int lane = F.lane, i = lane & 15, g = lane >> 4;
    const int qg = item & 3, r = (item >> 2) & 63, bb = item >> 8;
    const int c0 = 16 * qg;
    int rs = r - 4; rs = rs < 0 ? 0 : (rs > 56 ? 56 : rs);
    int cs = c0 - 8; cs = cs < 0 ? 0 : (cs > 32 ? 32 : cs);
    LAS unsigned char* PL = wl; LAS unsigned char* VL = wl + 4096; LAS unsigned char* OL = wl + 8192;
    const size_t rowbase = (size_t)bb * T;
    float ssq[4] = {0.f, 0.f, 0.f, 0.f};
#pragma unroll 1
    for (int h = 0; h < 4; ++h) {
        bf16x8 qf[2];
        { const GAS bf16* qrow = proj + (rowbase + r * 64 + c0 + i) * NPROJP + C_NQ + h * 64 + 8 * g;
          qf[0] = *(const GAS bf16x8*)(qrow); qf[1] = *(const GAS bf16x8*)(qrow + 32); }
        f32x4 s[16];
#pragma unroll
        for (int kt = 0; kt < 16; ++kt) { const int kr = kt >> 1, hf = kt & 1;
            const GAS bf16* krow = proj + (rowbase + (rs + kr) * 64 + cs + 16 * hf + i) * NPROJP + C_NK + h * 64 + 8 * g;
            const bf16x8 k0 = *(const GAS bf16x8*)(krow), k1 = *(const GAS bf16x8*)(krow + 32);
            f32x4 a = (f32x4){0.f, 0.f, 0.f, 0.f};
            a = __builtin_amdgcn_mfma_f32_16x16x32_bf16(qf[0], k0, a, 0, 0, 0);
            a = __builtin_amdgcn_mfma_f32_16x16x32_bf16(qf[1], k1, a, 0, 0, 0);
            s[kt] = a; }
        const GAS bf16* vsrc = proj + (rowbase + rs * 64 + cs + (lane >> 3)) * NPROJP + C_NV + h * 64 + 8 * (lane & 7);
        v4u vreg[4][4];
#pragma unroll
        for (int k4 = 0; k4 < 4; ++k4)
#pragma unroll
            for (int q = 0; q < 4; ++q) vreg[k4][q] = *(const GAS v4u*)(vsrc + (size_t)(k4 * 64 + 8 * q) * NPROJP);
        float mx[4] = {-3e38f, -3e38f, -3e38f, -3e38f};
#pragma unroll
        for (int kt = 0; kt < 16; ++kt) { const int kr = kt >> 1, hf = kt & 1; const int cw = cs + 16 * hf + i; const int dy = rs + kr - r + 7;
#pragma unroll
            for (int e = 0; e < 4; ++e) { const int cq = c0 + 4 * g + e; int st = cq - 8; st = st < 0 ? 0 : (st > 48 ? 48 : st);
                int dx = cw - cq; dx = dx < -15 ? -15 : (dx > 15 ? 15 : dx); dx += 15;
                const bool valid = (cw >= st) && (cw < st + 16);
                float v = s[kt][e] * 0.125f + RPB[h * 465 + dy * 31 + dx];
                v = valid ? v : -1e30f; s[kt][e] = v; mx[e] = fmaxf(mx[e], v); } }
        float sm[4];
#pragma unroll
        for (int e = 0; e < 4; ++e) { mx[e] = row16_max(mx[e]); sm[e] = 0.f; }
#pragma unroll
        for (int kt = 0; kt < 16; ++kt)
#pragma unroll
            for (int e = 0; e < 4; ++e) { const float p = __expf(s[kt][e] - mx[e]); s[kt][e] = p; sm[e] += p; }
#pragma unroll
        for (int e = 0; e < 4; ++e) sm[e] = rcpf_(row16_sum(sm[e]));
        f32x4 oh[4];
#pragma unroll
        for (int dt = 0; dt < 4; ++dt) oh[dt] = (f32x4){0.f, 0.f, 0.f, 0.f};
#pragma unroll
        for (int half = 0; half < 2; ++half) {
            CFENCE();
#pragma unroll
            for (int k8 = 0; k8 < 8; ++k8) { const int kt = 8 * half + k8; v2u pw; pw.x = pk2(s[kt][0] * sm[0], s[kt][1] * sm[1]); pw.y = pk2(s[kt][2] * sm[2], s[kt][3] * sm[3]);
                *(LAS v2u*)(PL + (16 * k8 + i) * 32 + 8 * g) = pw; }
            CFENCE();
#pragma unroll
            for (int k4 = 0; k4 < 4; ++k4) { const int kr = 4 * half + k4;
                CFENCE();
#pragma unroll
                for (int q = 0; q < 4; ++q) *(LAS v4u*)(VL + ((lane >> 3) + 8 * q) * 128 + (lane & 7) * 16) = vreg[k4][q];
                if (half == 0) {
#pragma unroll
                    for (int q = 0; q < 4; ++q) vreg[k4][q] = *(const GAS v4u*)(vsrc + (size_t)((kr + 4) * 64 + 8 * q) * NPROJP); }
                CFENCE();
                const LAS unsigned char* pa = PL + (32 * k4 + 8 * g + (i >> 2)) * 32 + 8 * (i & 3);
                const s16x4 plo = __builtin_bit_cast(s16x4, __builtin_amdgcn_ds_read_tr16_b64_v4i16((LAS s16x4*)(pa)));
                const s16x4 phi = __builtin_bit_cast(s16x4, __builtin_amdgcn_ds_read_tr16_b64_v4i16((LAS s16x4*)(pa + 128)));
                const bf16x8 pf = (bf16x8){plo[0], plo[1], plo[2], plo[3], phi[0], phi[1], phi[2], phi[3]};
#pragma unroll
                for (int dt = 0; dt < 4; ++dt) {
                    const LAS unsigned char* va = VL + (8 * g + (i >> 2)) * 128 + (16 * dt + 4 * (i & 3)) * 2;
                    const s16x4 vlo = __builtin_bit_cast(s16x4, __builtin_amdgcn_ds_read_tr16_b64_v4i16((LAS s16x4*)(va)));
                    const s16x4 vhi = __builtin_bit_cast(s16x4, __builtin_amdgcn_ds_read_tr16_b64_v4i16((LAS s16x4*)(va + 512)));
                    const bf16x8 vf = (bf16x8){vlo[0], vlo[1], vlo[2], vlo[3], vhi[0], vhi[1], vhi[2], vhi[3]};
                    oh[dt] = __builtin_amdgcn_mfma_f32_16x16x32_bf16(pf, vf, oh[dt], 0, 0, 0); }
            }
        }
        CFENCE();
#pragma unroll
        for (int dt = 0; dt < 4; ++dt)
#pragma unroll
            for (int e = 0; e < 4; ++e) { ssq[e] += oh[dt][e] * oh[dt][e]; *(LAS unsigned short*)(OL + (4 * g + e) * 512 + (h * 64 + 16 * dt + i) * 2) = (unsigned short)f2bf(oh[dt][e]); }
        CFENCE();
    }
    LAS float* SCL = (LAS float*)VL;
    CFENCE();
#pragma unroll
    for (int e = 0; e < 4; ++e) { const float sc = rsqf_(row16_sum(ssq[e]) * (1.f / 256.f) + NORM_EPS); if (i == 0) SCL[4 * g + e] = sc; }
    CFENCE();
#pragma unroll
    for (int q = 0; q < 8; ++q) { const int e = lane + 64 * q, row = e >> 5, ch = e & 31;
        const v4u v = *(const LAS v4u*)(OL + row * 512 + ch * 16); const float sc = SCL[row];
        v4u o;
#pragma unroll
        for (int t = 0; t < 4; ++t) o[t] = pk2(bflo(v[t]) * sc, bfhi(v[t]) * sc);
        *(GAS v4u*)(merged + (rowbase + r * 64 + c0 + row) * DM + 512 + 8 * ch) = o; }
    CFENCE();
}

constexpr int SG_PITCH = 528;
__device__ __forceinline__ void mix_sgu_item(Frame& F, int l, int item) {
    LAUNDER(F);
    const GAS bf16* proj = (const GAS bf16*)(F.ws + WS_PROJ); GAS bf16* merged = (GAS bf16*)(F.ws + WS_MERGED);
    const int lane = F.lane, w = F.wave, tid = F.tid, i = lane & 15, g = lane >> 4;
    const size_t m0 = (size_t)item * 128;
    LAS unsigned char* VI = F.lds; LAS float* SS = (LAS float*)(F.lds + 128 * SG_PITCH);
    { const int c4 = 4 * lane; const f32x4 gn = *(const f32x4*)(INP(F, I_SGUN) + l * 256 + c4);
      v2u xr[16];
#pragma unroll
      for (int j = 0; j < 16; ++j) xr[j] = *(const GAS v2u*)(proj + (m0 + 16 * w + j) * NPROJP + C_SV + c4);
#pragma unroll
      for (int j = 0; j < 16; ++j) { const int q = 16 * w + j; const v2u x = xr[j];
          f32x4 v = (f32x4){gelu_tanh(bflo(x.x)), gelu_tanh(bfhi(x.x)), gelu_tanh(bflo(x.y)), gelu_tanh(bfhi(x.y))};
          const float mu = wave_sum((v.x + v.y) + (v.z + v.w)) * (1.f / 256.f);
          v = v - mu;
          const float var = wave_sum((v.x * v.x + v.y * v.y) + (v.z * v.z + v.w * v.w)) * (1.f / 256.f);
          const float rstd = rsqf_(var + NORM_EPS);
          v2u o; o.x = pk2(v.x * rstd * gn.x, v.y * rstd * gn.y); o.y = pk2(v.z * rstd * gn.z, v.w * rstd * gn.w);
          *(LAS v2u*)(VI + q * SG_PITCH + c4 * 2) = o; } }
    __syncthreads();
    const int hh = w >> 1, ph = w & 1;
    f32x4 acc[4][4];
#pragma unroll
    for (int a = 0; a < 4; ++a)
#pragma unroll
        for (int b = 0; b < 4; ++b) acc[a][b] = (f32x4){0.f, 0.f, 0.f, 0.f};
    const GAS float* ws_ = INP(F, I_SGUW) + ((size_t)(l * 4 + hh) * 128) * 128;
#pragma unroll
    for (int ks = 0; ks < 4; ++ks) {
        bf16x8 af[4], bfr[4];
#pragma unroll
        for (int pt = 0; pt < 4; ++pt) { const GAS float* ap = ws_ + (size_t)(64 * ph + 16 * pt + i) * 128 + 32 * ks + 8 * g;
            const f32x4 x0 = *(const f32x4*)ap, x1 = *(const f32x4*)(ap + 4);
            const unsigned u0 = pk2(x0.x, x0.y), u1 = pk2(x0.z, x0.w), u2 = pk2(x1.x, x1.y), u3 = pk2(x1.z, x1.w);
            af[pt] = __builtin_bit_cast(bf16x8, (v4u){u0, u1, u2, u3}); }
#pragma unroll
        for (int dt = 0; dt < 4; ++dt) { const LAS unsigned char* va = VI + (32 * ks + 8 * g + (i >> 2)) * SG_PITCH + (hh * 64 + 16 * dt + 4 * (i & 3)) * 2;
            const s16x4 lo = __builtin_bit_cast(s16x4, __builtin_amdgcn_ds_read_tr16_b64_v4i16((LAS s16x4*)(va)));
            const s16x4 hi = __builtin_bit_cast(s16x4, __builtin_amdgcn_ds_read_tr16_b64_v4i16((LAS s16x4*)(va + 4 * SG_PITCH)));
            bfr[dt] = (bf16x8){lo[0], lo[1], lo[2], lo[3], hi[0], hi[1], hi[2], hi[3]}; }
#pragma unroll
        for (int pt = 0; pt < 4; ++pt)
#pragma unroll
            for (int dt = 0; dt < 4; ++dt) acc[pt][dt] = __builtin_amdgcn_mfma_f32_16x16x32_bf16(af[pt], bfr[dt], acc[pt][dt], 0, 0, 0);
    }
#pragma unroll
    for (int pt = 0; pt < 4; ++pt) {
        unsigned short ur[4][4];
#pragma unroll
        for (int e = 0; e < 4; ++e)
#pragma unroll
            for (int dt = 0; dt < 4; ++dt) ur[e][dt] = proj[(m0 + 64 * ph + 16 * pt + 4 * g + e) * NPROJP + C_SU + hh * 64 + 16 * dt + i];
#pragma unroll
        for (int e = 0; e < 4; ++e) { const int p = 64 * ph + 16 * pt + 4 * g + e; const float bs = INP(F, I_SGUB)[(l * 4 + hh) * 128 + p]; float ss = 0.f;
#pragma unroll
            for (int dt = 0; dt < 4; ++dt) { const float u = gelu_tanh(bf2f(ur[e][dt]));
                const float v = u * (acc[pt][dt][e] + bs); acc[pt][dt][e] = v; ss += v * v; }
            ss = row16_sum(ss); if (i == 0) SS[p * 4 + hh] = ss; } }
    __syncthreads();
#pragma unroll
    for (int pt = 0; pt < 4; ++pt)
#pragma unroll
        for (int e = 0; e < 4; ++e) { const int p = 64 * ph + 16 * pt + 4 * g + e; const f32x4 s4 = *(const LAS f32x4*)(SS + p * 4);
            const float sc = rsqf_(((s4.x + s4.y) + (s4.z + s4.w)) * (1.f / 256.f) + NORM_EPS);
#pragma unroll
            for (int dt = 0; dt < 4; ++dt) *(LAS unsigned short*)(VI + p * SG_PITCH + (hh * 64 + 16 * dt + i) * 2) = (unsigned short)f2bf(acc[pt][dt][e] * sc); }
    __syncthreads();
#pragma unroll
    for (int q = 0; q < 8; ++q) { const int e = tid + 512 * q, row = e >> 5, ch = e & 31;
        const v4u v = *(const LAS v4u*)(VI + row * SG_PITCH + ch * 16);
        *(GAS v4u*)(merged + (m0 + row) * DM + 768 + 8 * ch) = v; }
    __syncthreads();
}

__device__ __forceinline__ void phase_mix_na(Frame& F, int l, int bidx, int nblk) {
    LAUNDER(F);
    LAS float* RPB = (LAS float*)(F.lds + RING_BYTES + 1024);
    for (int q = F.tid; q < 4 * 465; q += NTHREADS) RPB[q] = INP(F, I_RPB)[l * 4 * 465 + q];
    __syncthreads();
    for (int it = bidx * NWAVES + F.wave; it < NB * 64 * 4; it += nblk * NWAVES) mix_na_item(F, l, it, F.lds + F.wave * 16384, RPB);
    __syncthreads();
#ifdef SGU_IN_C2
    for (int it = bidx; it < NB * 32; it += nblk) mix_sgu_item(F, l, it);
#endif
}
__device__ __forceinline__ void phase_mixers(Frame& F, int l) {
    LAUNDER(F);
    for (int tile = F.vcu; tile < M / 64; tile += F.G) mix_convprep_tile(F, l, tile);
    __syncthreads();
#ifndef SGU_IN_C2
    for (int it = F.vcu; it < NB * 32; it += F.G) mix_sgu_item(F, l, it);
#endif
}

constexpr int C1_RES = 40960, C1_RES_D = 17664;
constexpr int C1_U = 0, C1_ZT = 4096, C1_ET = 8192, C1_QT = 12288, C1_CT = 16384, C1_DA = 17408;
constexpr int C1_IMG = 81920, C1_IMG_D = 16384, C1_SC = 0, C1_SCST = 144, C1_CM = 9216, C1_DM = 15360, C1_DL = 15616;
typedef _Float16 h4 __attribute__((ext_vector_type(4)));
typedef _Float16 h8 __attribute__((ext_vector_type(8)));
__device__ __forceinline__ bf16x8 pack8(f32x4 lo, f32x4 hi) { return __builtin_bit_cast(bf16x8, (v4u){pg8::cvt_pk_bf16(lo.x, lo.y), pg8::cvt_pk_bf16(lo.z, lo.w), pg8::cvt_pk_bf16(hi.x, hi.y), pg8::cvt_pk_bf16(hi.z, hi.w)}); }
template <int MODE>
__device__ __forceinline__ void phase_scan_c1(Frame& F, int l) {
    LAUNDER(F);
    const GAS bf16* proj = (const GAS bf16*)(F.ws + WS_PROJ);
    const int lane = F.lane, w = F.wave, i = lane & 15, g = lane >> 4;
    const int d = w >> 2, wa = w & 3;
    const int bh = F.vcu >> 3, bb = bh >> 2, h = bh & 3;
    LAS unsigned char* lds = F.lds;
    bf16x8 Bw, Ba;
    { f32x4 xw0 = (f32x4){0.f, 0.f, 0.f, 0.f}, xw1 = xw0, xa0 = xw0, xa1 = xw0;
      if (g < 2) { const GAS float* pw = INP(F, I_RWUP) + ((size_t)(l * 2 + d) * 16 + 8 * g) * 256 + h * 64 + 16 * wa + i; const GAS float* pa = INP(F, I_RAUP) + ((size_t)(l * 2 + d) * 16 + 8 * g) * 256 + h * 64 + 16 * wa + i;
          xw0 = (f32x4){pw[0], pw[256], pw[512], pw[768]}; xw1 = (f32x4){pw[1024], pw[1280], pw[1536], pw[1792]};
          xa0 = (f32x4){pa[0], pa[256], pa[512], pa[768]}; xa1 = (f32x4){pa[1024], pa[1280], pa[1536], pa[1792]}; }
      Bw = pack8(xw0, xw1); Ba = pack8(xa0, xa1); }
    const float w0c = INP(F, I_RW0)[(l * 2 + d) * 256 + h * 64 + 16 * wa + i], a0c = INP(F, I_RA0)[(l * 2 + d) * 256 + h * 64 + 16 * wa + i], kag = INP(F, I_RKA)[l * 256 + h * 64 + 16 * wa + i];
    float kkg[4];
#pragma unroll
    for (int t = 0; t < 4; ++t) kkg[t] = INP(F, I_RKK)[l * 256 + h * 64 + 16 * t + i];
    const float kkgw = INP(F, I_RKK)[l * 256 + h * 64 + 16 * wa + i];
    const int c = 16 * wa + i;
    const int sq = d ? 3 - g : g;
#define C1_BAR() do { asm volatile("s_waitcnt lgkmcnt(0)" ::: "memory"); __builtin_amdgcn_s_barrier(); asm volatile("" ::: "memory"); } while (0)
    unsigned short kq[4][4], kown[4], rq[4]; v4u dvr, ivr;
#define C1_LOAD(B_) do { const size_t m0_ = (size_t)bb * T + 16 * (B_); \
        _Pragma("unroll") for (int e_ = 0; e_ < 4; ++e_) { const GAS bf16* row_ = proj + (m0_ + 4 * g + e_) * NPROJP; \
            _Pragma("unroll") for (int t_ = 0; t_ < 4; ++t_) kq[t_][e_] = row_[C_K + h * 64 + 16 * t_ + i]; \
            rq[e_] = row_[C_R + h * 64 + 16 * wa + i]; kown[e_] = row_[C_K + h * 64 + 16 * wa + i]; } \
        { const GAS bf16* arow_ = proj + (m0_ + i) * NPROJP + C_DEC + 16 * d + 8 * (g & 1); dvr = *(const GAS v4u*)(arow_); ivr = *(const GAS v4u*)(arow_ + 32); } } while (0)
    C1_LOAD((F.vcu & 7) * 32);
    for (int it = 0; it < 32; ++it) {
        const int B = (F.vcu & 7) * 32 + it;
        LAS unsigned char* IMG = lds + C1_IMG + d * C1_IMG_D;
        if (MODE != 3) {
            v4u dv = (v4u){0u, 0u, 0u, 0u}, iv = dv;
            if (g < 2) { iv = ivr;
#pragma unroll
                for (int q = 0; q < 4; ++q) dv[q] = pk2(tanhf_(bflo(dvr[q])), tanhf_(bfhi(dvr[q]))); }
            const f32x4 z4 = (f32x4){0.f, 0.f, 0.f, 0.f};
            const f32x4 Dw = __builtin_amdgcn_mfma_f32_16x16x32_bf16(__builtin_bit_cast(bf16x8, dv), Bw, z4, 0, 0, 0);
            const f32x4 Da = __builtin_amdgcn_mfma_f32_16x16x32_bf16(__builtin_bit_cast(bf16x8, iv), Ba, z4, 0, 0, 0);
            float vw[4], vk[4], vb[4], ve[4], vr[4];
#pragma unroll
            for (int e = 0; e < 4; ++e) {
                float ss = 0.f;
#pragma unroll
                for (int t = 0; t < 4; ++t) { const float x = bf2f(kq[t][e]) * kkg[t]; ss += x * x; }
                ss = row16_sum(ss);
                const float k = bf2f(kown[e]); const float kk = k * kkgw * rsqf_(ss + 1e-12f);
                const float wv = __expf(-DECAY_SCALE * sigmoidf_(w0c + Dw[e])), av = sigmoidf_(a0c + Da[e]);
                vw[e] = wv; vk[e] = kk; vb[e] = kk * av; ve[e] = k * (1.f + (av - 1.f) * kag); vr[e] = bf2f(rq[e]); }
            if (d) {
#define C1_SWAP(a_) do { float t0_ = a_[0], t1_ = a_[1]; a_[0] = a_[3]; a_[1] = a_[2]; a_[2] = t1_; a_[3] = t0_; } while (0)
                C1_SWAP(vw); C1_SWAP(vk); C1_SWAP(vb); C1_SWAP(ve); C1_SWAP(vr);
#undef C1_SWAP
            }
            float Dp[4], Dt[4];
            const float c1 = vw[0], c2 = c1 * vw[1], c3 = c2 * vw[2], c4 = c3 * vw[3];
            const float q0 = __shfl(c4, (d ? 48 : 0) + i), q1 = __shfl(c4, (d ? 32 : 16) + i), q2 = __shfl(c4, (d ? 16 : 32) + i);
            const float Dm = q0 * q1;
            const float off = sq == 0 ? 1.f : (sq == 1 ? q0 : (sq == 2 ? Dm : Dm * q2));
            Dp[0] = off; Dp[1] = off * c1; Dp[2] = off * c2; Dp[3] = off * c3;
            Dt[0] = Dp[1]; Dt[1] = Dp[2]; Dt[2] = Dp[3]; Dt[3] = off * c4;
            const float rDm = rcpf_(Dm);
            h4 hk, hb, he;
#pragma unroll
            for (int e = 0; e < 4; ++e) { const float rDt = rcpf_(Dt[e]);
                const float kap = vk[e] * Dp[e] * rDm, rr = vr[e] * Dt[e] * rDm, bq = vb[e] * Dm * rDt, eq = ve[e] * Dm * rDt;
                const int s = 4 * sq + e;
                ((LAS _Float16*)(IMG + C1_SC + (0 * 16 + s) * C1_SCST))[c] = (_Float16)kap; ((LAS _Float16*)(IMG + C1_SC + (1 * 16 + s) * C1_SCST))[c] = (_Float16)rr;
                ((LAS _Float16*)(IMG + C1_SC + (2 * 16 + s) * C1_SCST))[c] = (_Float16)bq;  ((LAS _Float16*)(IMG + C1_SC + (3 * 16 + s) * C1_SCST))[c] = (_Float16)eq;
                hk[e] = (_Float16)kap; hb[e] = (_Float16)bq; he[e] = (_Float16)eq; }
            *(LAS h4*)(IMG + C1_CM + c * 96 + 0 + sq * 8) = hk; *(LAS h4*)(IMG + C1_CM + c * 96 + 32 + sq * 8) = hb; *(LAS h4*)(IMG + C1_CM + c * 96 + 64 + sq * 8) = he;
            if (sq == 3) *(LAS float*)(IMG + C1_DL + c * 4) = Dt[3];
            if (sq == 0) *(LAS float*)(IMG + C1_DM + c * 4) = Dm;
        }
        if (it + 1 < 32) C1_LOAD(B + 1);
        C1_BAR();
        if (MODE != 1 && MODE != 4) {
            LAS unsigned char* R = lds + C1_RES + d * C1_RES_D;
            h8 fk[2], fr[2], fb[2], fe[2];
#pragma unroll
            for (int ks = 0; ks < 2; ++ks) { const LAS unsigned char* p = IMG + C1_SC + i * C1_SCST + (8 * g + 32 * ks) * 2;
                fk[ks] = *(const LAS h8*)(p); fr[ks] = *(const LAS h8*)(p + 16 * C1_SCST); fb[ks] = *(const LAS h8*)(p + 32 * C1_SCST); fe[ks] = *(const LAS h8*)(p + 48 * C1_SCST); }
            const f32x4 z4 = (f32x4){0.f, 0.f, 0.f, 0.f};
            f32x4 aN = z4, aNT = z4, aM = z4, aMT = z4, aNr = z4, aMr = z4;
#pragma unroll
            for (int ks = 0; ks < 2; ++ks) {
                aN  = __builtin_amdgcn_mfma_f32_16x16x32_f16(fb[ks], fk[ks], aN, 0, 0, 0);  aNT = __builtin_amdgcn_mfma_f32_16x16x32_f16(fk[ks], fb[ks], aNT, 0, 0, 0);
                aM  = __builtin_amdgcn_mfma_f32_16x16x32_f16(fe[ks], fk[ks], aM, 0, 0, 0);  aMT = __builtin_amdgcn_mfma_f32_16x16x32_f16(fk[ks], fe[ks], aMT, 0, 0, 0);
                aNr = __builtin_amdgcn_mfma_f32_16x16x32_f16(fb[ks], fr[ks], aNr, 0, 0, 0); aMr = __builtin_amdgcn_mfma_f32_16x16x32_f16(fe[ks], fr[ks], aMr, 0, 0, 0); }
#pragma unroll
            for (int e = 0; e < 4; ++e) { const int row = 4 * g + e;
                aN[e] = row < i ? -aN[e] : 0.f; aNT[e] = i < row ? -aNT[e] : 0.f; aM[e] = row < i ? aM[e] : 0.f; aMT[e] = i < row ? aMT[e] : 0.f;
                aNr[e] = row <= i ? aNr[e] : 0.f; aMr[e] = row <= i ? aMr[e] : 0.f; }
#define C1_H4(x_) __builtin_convertvector((x_), h4)
#define C1_MM(a_, b_, c_) __builtin_amdgcn_mfma_f32_16x16x16f16((a_), (b_), (c_), 0, 0, 0)
            f32x4 S = aN, ST = aNT;
#pragma unroll
            for (int e = 0; e < 4; ++e) if (4 * g + e == i) { S[e] += 1.f; ST[e] += 1.f; }
            const h4 hA = C1_H4(aN), hAT = C1_H4(aNT);
            const f32x4 P2 = C1_MM(hAT, hA, z4), P2T = C1_MM(hA, hAT, z4);
            const h4 hP2 = C1_H4(P2), hP2T = C1_H4(P2T);
            { const h4 hS = C1_H4(S); S = C1_MM(hP2T, hS, S); ST = C1_MM(hS, hP2T, ST); }
            const f32x4 P4 = C1_MM(hP2T, hP2, z4), P4T = C1_MM(hP2, hP2T, z4);
            const h4 hP4 = C1_H4(P4), hP4T = C1_H4(P4T);
            { const h4 hS = C1_H4(S); S = C1_MM(hP4T, hS, S); ST = C1_MM(hS, hP4T, ST); }
            const f32x4 P8T = C1_MM(hP4, hP4T, z4);
            const h4 hP8T = C1_H4(P8T);
            { const h4 hS = C1_H4(S); ST = C1_MM(hS, hP8T, ST); }
            const h4 hTT = C1_H4(ST), hMT = C1_H4(aMT);
            const f32x4 X1 = C1_MM(hTT, C1_H4(aNr), z4);
            const h4 hX1 = C1_H4(X1);
            const h4 bT = *(const LAS h4*)(IMG + C1_CM + c * 96 + 32 + g * 8);
            const f32x4 X2 = C1_MM(hTT, bT, z4);
            const float dl = *(const LAS float*)(IMG + C1_DL + c * 4), dm = *(const LAS float*)(IMG + C1_DM + c * 4);
            *(LAS f32x4*)(R + C1_ZT + c * 64 + 16 * g) = X2 * dl;
            const f32x4 Ea = C1_MM(hMT, C1_H4(X2), z4);
            const h4 kh = *(const LAS h4*)(IMG + C1_CM + c * 96 + 64 + g * 8);
            *(LAS f32x4*)(R + C1_ET + c * 64 + 16 * g) = (__builtin_convertvector(kh, f32x4) - Ea) * (dl * rcpf_(dm));
            const h4 kT = *(const LAS h4*)(IMG + C1_CM + c * 96 + g * 8);
            const f32x4 Qa = C1_MM(kT, hX1, z4);
            const h4 rh = *(const LAS h4*)(IMG + C1_SC + (16 + i) * C1_SCST + (16 * wa + 4 * g) * 2);
            const f32x4 dm4 = *(const LAS f32x4*)(IMG + C1_DM + (16 * wa + 4 * g) * 4);
            *(LAS f32x4*)(R + C1_QT + i * 256 + (16 * wa + 4 * g) * 4) = (__builtin_convertvector(rh, f32x4) - Qa) * dm4;
            if (wa == 0) { const f32x4 Ca = C1_MM(hMT, hX1, z4); *(LAS f32x4*)(R + C1_CT + i * 64 + 16 * g) = aMr - Ca; }
            *(LAS f32x4*)(R + C1_U + c * 64 + 16 * g) = __builtin_convertvector(kT, f32x4);
            if (g == 0) *(LAS float*)(R + C1_DA + c * 4) = dl;
#undef C1_H4
#undef C1_MM
        }
        C1_BAR();
        if (MODE != 2 && MODE != 4) {
            const LAS unsigned char* R = lds + C1_RES + d * C1_RES_D;
            const int n = d ? 255 - B : B;
            GAS unsigned char* gt = (d ? (GAS unsigned char*)F.out : F.ws + WS_GT0) + ((size_t)(bb * 4 + h) * 256 + n) * GT_CHUNK;
            const int nt = wa;
            bf16x8 zf = (bf16x8){0, 0, 0, 0, 0, 0, 0, 0};
            if (g < 2) { const LAS f32x4* zp = (const LAS f32x4*)(R + C1_ZT + (16 * nt + i) * 64 + 32 * g); zf = pack8(zp[0], zp[1]); }
            f32x4 pp[4];
#pragma unroll
            for (int ct = 0; ct < 4; ++ct) {
                bf16x8 uf = (bf16x8){0, 0, 0, 0, 0, 0, 0, 0};
                if (g < 2) { const LAS f32x4* up = (const LAS f32x4*)(R + C1_U + (16 * ct + i) * 64 + 32 * g); uf = pack8(up[0], up[1]); }
                const f32x4 dd = __builtin_amdgcn_mfma_f32_16x16x32_bf16(uf, zf, (f32x4){0.f, 0.f, 0.f, 0.f}, 0, 0, 0);
                f32x4 pv = -dd;
                if (ct == nt) { const f32x4 da = *(const LAS f32x4*)(R + C1_DA + (16 * ct + 4 * g) * 4);
#pragma unroll
                    for (int e = 0; e < 4; ++e) if (4 * g + e == i) pv[e] += da[e]; }
                pp[ct] = pv; }
#define C1_ST(p_, v_) do { const bf16x8 v__ = (v_); if (MODE == 0) *(GAS bf16x8*)(p_) = v__; else asm volatile("" :: "v"(v__)); } while (0)
            C1_ST(gt + (nt * 2 + 0) * 1024 + lane * 16, pack8(pp[0], pp[1]));
            C1_ST(gt + (nt * 2 + 1) * 1024 + lane * 16, pack8(pp[2], pp[3]));
            if (g < 2) { const LAS f32x4* ep = (const LAS f32x4*)(R + C1_ET + (16 * nt + i) * 64 + 32 * g); C1_ST(gt + 10240 + nt * 512 + lane * 16, pack8(ep[0], ep[1])); }
            if (wa == 0) {
#pragma unroll
                for (int ks = 0; ks < 2; ++ks) { const LAS f32x4* qp = (const LAS f32x4*)(R + C1_QT + i * 256 + (32 * ks + 4 * g) * 4);
                    C1_ST(gt + (8 + ks) * 1024 + lane * 16, pack8(qp[0], qp[4])); }
                if (g < 2) { const LAS f32x4* cp = (const LAS f32x4*)(R + C1_CT + i * 64 + 32 * g); C1_ST(gt + 10240 + 4 * 512 + lane * 16, pack8(cp[0], cp[1])); }
            }
        }
    }
#undef C1_LOAD
#undef C1_BAR
    __syncthreads();
}
#define C2_BAR() do { asm volatile("s_waitcnt lgkmcnt(0)" ::: "memory"); __builtin_amdgcn_s_barrier(); asm volatile("" ::: "memory"); } while (0)
constexpr int C2_SLOT = 16384, C2_YOFF = 4 * C2_SLOT;
template <int MODE>
__device__ __forceinline__ void phase_scan_c2(Frame& F, int l) {
    LAUNDER(F);
    if (F.vcu >= 128) { if (MODE == 0) phase_mix_na(F, l, F.vcu - 128, 128); return; }
    const GAS bf16* proj = (const GAS bf16*)(F.ws + WS_PROJ);
    const int lane = F.lane, i = lane & 15, g = lane >> 4;
    LAS unsigned char* lds = F.lds;
    if (F.vcu < 128) {
    const int ci = F.vcu >> 1, tp = F.vcu & 1, d = ci >> 5, bb = (ci >> 2) & 7, h = ci & 3;
    for (int q = F.tid; q < 4 * 5 * 32; q += NTHREADS) { const int sl = q / 160, r = q % 160; *(LAS v4u*)(lds + sl * C2_SLOT + 10240 + (r >> 5) * 1024 + 512 + (r & 31) * 16) = (v4u){0u, 0u, 0u, 0u}; }
    __syncthreads();
    if (F.wave < 2) {
        const int cw = F.wave;
        f32x4 st[4];
#pragma unroll
        for (int t = 0; t < 4; ++t) st[t] = (f32x4){0.f, 0.f, 0.f, 0.f};
        v4u af[15], vf, nf[15], nvf;
#define C2_RD(AF, VF, c_) do { const LAS unsigned char* p_ = lds + ((c_) & 3) * C2_SLOT + lane * 16; \
            _Pragma("unroll") for (int f_ = 0; f_ < 15; ++f_) AF[f_] = *(const LAS v4u*)(p_ + f_ * 1024); \
            VF = *(const LAS v4u*)(lds + ((c_) & 3) * C2_SLOT + 15360 + cw * 512 + i * 32 + (g & 1) * 16); } while (0)
#define C2_STEP(AF, VF, NF, NVF, n_) do { \
            if ((n_) + 1 < 256) C2_RD(NF, NVF, (n_) + 1); \
            const bf16x8 b0_ = pack8(st[0], st[1]), b1_ = pack8(st[2], st[3]); const v4u vz_ = (g < 2) ? VF : (v4u){0u, 0u, 0u, 0u}; const bf16x8 bv_ = __builtin_bit_cast(bf16x8, vz_); \
            f32x4 o_[5]; \
            _Pragma("unroll") for (int nt = 0; nt < 5; ++nt) { if (MODE >= 2) { o_[nt] = __builtin_bit_cast(f32x4, AF[nt]) + __builtin_bit_cast(f32x4, AF[10 + nt]) * st[nt & 3]; continue; } \
                f32x4 a_ = __builtin_amdgcn_mfma_f32_16x16x32_bf16(__builtin_bit_cast(bf16x8, AF[nt * 2]), b0_, (f32x4){0.f, 0.f, 0.f, 0.f}, 0, 0, 0); \
                a_ = __builtin_amdgcn_mfma_f32_16x16x32_bf16(__builtin_bit_cast(bf16x8, AF[nt * 2 + 1]), b1_, a_, 0, 0, 0); \
                o_[nt] = __builtin_amdgcn_mfma_f32_16x16x32_bf16(__builtin_bit_cast(bf16x8, AF[10 + nt]), bv_, a_, 0, 0, 0); } \
            _Pragma("unroll") for (int t = 0; t < 4; ++t) st[t] = o_[t]; \
            { v2u yw_; yw_.x = pk2(o_[4].x, o_[4].y); yw_.y = pk2(o_[4].z, o_[4].w); \
              *(LAS v2u*)(lds + C2_YOFF + (cw * 8 + ((n_) & 7)) * 512 + i * 32 + g * 8) = yw_; }     \
            } while (0)
        C2_BAR();
        C2_RD(af, vf, 0);
        for (int n = 0; n < 256; n += 2) { C2_STEP(af, vf, nf, nvf, n); C2_STEP(nf, nvf, af, vf, n + 1); C2_BAR(); }
        C2_BAR();
#undef C2_STEP
#undef C2_RD
    } else {
        const int hl = F.tid - 128;
        const GAS unsigned char* gt = (d ? (const GAS unsigned char*)F.out : F.ws + WS_GT0) + ((size_t)(bb * 4 + h) * 256) * GT_CHUNK;
        GAS bf16* ysc = (GAS bf16*)(d ? (GAS unsigned char*)F.out + GT_DIR : F.ws + WS_YSC0) + (size_t)bb * T * 256 + h * 64 + 32 * tp;
        const int p0 = hl, p1 = hl + 384, p2 = hl + 768; const bool has2 = p2 < 800;
#define C2_OFF(p_) ((p_) < 640 ? (p_) * 16 : 10240 + (((p_) - 640) >> 5) * 1024 + (((p_) - 640) & 31) * 16)
        const int o0 = C2_OFF(p0), o1 = C2_OFF(p1), o2 = C2_OFF(has2 ? p2 : 799);
        const int e0 = hl, e1 = hl + 384; const bool hasv1 = e1 < 512;
        const GAS bf16* vs0 = proj + (size_t)bb * T * NPROJP + C_V + h * 64 + 32 * tp + 16 * (e0 >> 8) + (e0 & 15);
        const GAS bf16* vs1 = proj + (size_t)bb * T * NPROJP + C_V + h * 64 + 32 * tp + 16 * ((hasv1 ? e1 : 0) >> 8) + (e1 & 15);
        const int vt0 = (e0 >> 4) & 15, vt1 = (e1 >> 4) & 15;
        const int vo0 = 15360 + (e0 >> 8) * 512 + (e0 & 15) * 32 + vt0 * 2, vo1 = 15360 + ((hasv1 ? e1 : 0) >> 8) * 512 + (e1 & 15) * 32 + vt1 * 2;
        constexpr int RD = 12;
        v4u r0[RD], r1[RD], r2[RD]; unsigned short rv0[RD], rv1[RD];
        if (MODE == 1 || MODE == 3) {
#pragma unroll
            for (int k = 0; k < RD; ++k) { r0[k] = (v4u){1u, 2u, 3u, 4u}; r1[k] = r0[k]; r2[k] = r0[k]; rv0[k] = 0; rv1[k] = 0; } }
#define C2_GLD(k_, n_) do { if (MODE == 1 || MODE == 3) break; const GAS unsigned char* c_ = gt + (size_t)(n_) * GT_CHUNK; r0[k_] = *(const GAS v4u*)(c_ + p0 * 16); r1[k_] = *(const GAS v4u*)(c_ + p1 * 16); \
            if (has2) r2[k_] = *(const GAS v4u*)(c_ + p2 * 16); \
            { const int gs_ = 16 * (n_) + vt0, t_ = d ? (T - 1 - gs_) : gs_; rv0[k_] = vs0[(size_t)t_ * NPROJP]; } \
            if (hasv1) { const int gs_ = 16 * (n_) + vt1, t_ = d ? (T - 1 - gs_) : gs_; rv1[k_] = vs1[(size_t)t_ * NPROJP]; } } while (0)
#define C2_WR(k_, n_) do { LAS unsigned char* p_ = lds + ((n_) & 3) * C2_SLOT; *(LAS v4u*)(p_ + o0) = r0[k_]; *(LAS v4u*)(p_ + o1) = r1[k_]; if (has2) *(LAS v4u*)(p_ + o2) = r2[k_]; \
            *(LAS unsigned short*)(p_ + vo0) = rv0[k_]; if (hasv1) *(LAS unsigned short*)(p_ + vo1) = rv1[k_]; } while (0)
#define C2_YST(m_) do { if (hl < 64) { const int cw_ = hl >> 5, s_ = (hl >> 1) & 15, hf_ = hl & 1; const LAS unsigned short* yp_ = (const LAS unsigned short*)(lds + C2_YOFF + (cw_ * 8 + ((m_) & 7)) * 512) + s_; \
            v4u w_; _Pragma("unroll") for (int e_ = 0; e_ < 4; ++e_) w_[e_] = (unsigned)yp_[(8 * hf_ + 2 * e_) * 16] | ((unsigned)yp_[(8 * hf_ + 2 * e_ + 1) * 16] << 16); \
            const int gs_ = 16 * (m_) + s_, t_ = d ? (T - 1 - gs_) : gs_; if (MODE == 0) *(GAS v4u*)(ysc + (size_t)t_ * 256 + 16 * cw_ + 8 * hf_) = w_; else asm volatile("" :: "v"(w_)); } } while (0)
#pragma unroll
        for (int k = 0; k < RD; ++k) C2_GLD(k, k);
        C2_WR(0, 0); C2_GLD(0, RD); C2_WR(1, 1); C2_GLD(1, RD + 1); C2_WR(2, 2); C2_GLD(2, RD + 2);
        C2_BAR();
        for (int m6 = 0; m6 < 128; m6 += RD / 2) {
#pragma unroll
            for (int k = 0; k < RD / 2; ++k) { const int m = m6 + k;
                if (m < 128) {
                    const int ca = 2 * m + 3, cb = 2 * m + 4, ka = (2 * k + 3) % RD, kb = (2 * k + 4) % RD;
                    if (ca < 256) { C2_WR(ka, ca); if (ca + RD < 256) C2_GLD(ka, ca + RD); }
                    if (cb < 256) { C2_WR(kb, cb); if (cb + RD < 256) C2_GLD(kb, cb + RD); }
                    if (m > 0) { C2_YST(2 * m - 2); C2_YST(2 * m - 1); }
                    C2_BAR(); } }
        }
        C2_YST(254); C2_YST(255);
        C2_BAR();
#undef C2_GLD
#undef C2_WR
#undef C2_YST
#undef C2_OFF
    }
    }
    __syncthreads();
}
#undef C2_BAR
#undef CK_DOT
#undef CK_RED2

__device__ __forceinline__ void phase_rwkv_post(Frame& F, int l) {
    LAUNDER(F);
    const GAS bf16* proj = (const GAS bf16*)(F.ws + WS_PROJ); GAS bf16* merged = (GAS bf16*)(F.ws + WS_MERGED); const GAS bf16* ysc0 = (const GAS bf16*)(F.ws + WS_YSC0); const GAS bf16* ysc1 = (const GAS bf16*)((const GAS unsigned char*)F.out + GT_DIR);
    const int lane = F.lane, c4 = 4 * lane, hd = lane >> 4;
    LAS float* GUP = (LAS float*)F.lds;
    for (int q = F.tid; q < 32 * 256; q += NTHREADS) GUP[q] = INP(F, I_RGUP)[(size_t)l * 32 * 256 + q];
    __syncthreads();
    const f32x4 lw = *(const f32x4*)(INP(F, I_LNXW) + l * 256 + c4), lb = *(const f32x4*)(INP(F, I_LNXB) + l * 256 + c4), rk = *(const f32x4*)(INP(F, I_RRK) + l * 256 + c4);
    const int mstep = F.G * NWAVES; int m = F.vcu * NWAVES + F.wave;
    v2u n_yf, n_yb, n_r, n_k, n_v; unsigned short n_g;
#define POST_LOAD(mm) do { const GAS bf16* row_ = proj + (size_t)(mm) * NPROJP; n_yf = *(const GAS v2u*)(ysc0 + (size_t)(mm) * 256 + c4); n_yb = *(const GAS v2u*)(ysc1 + (size_t)(mm) * 256 + c4); \
        n_r = *(const GAS v2u*)(row_ + C_R + c4); n_k = *(const GAS v2u*)(row_ + C_K + c4); n_v = *(const GAS v2u*)(row_ + C_V + c4); n_g = row_[C_GDN + (lane & 31)]; } while (0)
    POST_LOAD(m);
    for (; m < M; m += mstep) {
        const v2u yf = n_yf, yb = n_yb, ru = n_r, ku = n_k, vu = n_v; const unsigned short gu = n_g;
        if (m + mstep < M) POST_LOAD(m + mstep);
        f32x4 y = (f32x4){bflo(yf.x) + bflo(yb.x), bfhi(yf.x) + bfhi(yb.x), bflo(yf.y) + bflo(yb.y), bfhi(yf.y) + bfhi(yb.y)};
        const float mu = row16_sum((y.x + y.y) + (y.z + y.w)) * (1.f / 64.f);
        y = y - mu;
        const float var = row16_sum((y.x * y.x + y.y * y.y) + (y.z * y.z + y.w * y.w)) * (1.f / 64.f);
        const float rstd = rsqf_(var + GN_EPS);
        y = y * rstd * lw + lb;
        const f32x4 r = (f32x4){bflo(ru.x), bfhi(ru.x), bflo(ru.y), bfhi(ru.y)}, k = (f32x4){bflo(ku.x), bfhi(ku.x), bflo(ku.y), bfhi(ku.y)}, v = (f32x4){bflo(vu.x), bfhi(vu.x), bflo(vu.y), bfhi(vu.y)};
        const f32x4 rkk = r * k * rk;
        const float bsum = row16_sum((rkk.x + rkk.y) + (rkk.z + rkk.w));
        y = y + v * bsum;
        const float gd = sigmoidf_(bf2f(gu));
        f32x4 gt = (f32x4){0.f, 0.f, 0.f, 0.f};
#pragma unroll
        for (int j = 0; j < 32; ++j) { const float gj = __builtin_bit_cast(float, __builtin_amdgcn_readlane(__builtin_bit_cast(int, gd), j)); gt = gt + *(const LAS f32x4*)(GUP + j * 256 + c4) * gj; }
        y = y * gt;
        const float ss = wave_sum((y.x * y.x + y.y * y.y) + (y.z * y.z + y.w * y.w));
        const float sc = rsqf_(ss * (1.f / 256.f) + NORM_EPS);
        v2u o; o.x = pk2(y.x * sc, y.y * sc); o.y = pk2(y.z * sc, y.w * sc);
        *(GAS v2u*)(merged + (size_t)m * DM + 256 + c4) = o;
    }
#undef POST_LOAD
    (void)hd;
}

__device__ __forceinline__ void phase_residual(Frame& F, const GAS float* gain, const bool IN_F32, const bool LAST) {
    LAUNDER(F);
    const GAS bf16* y = (const GAS bf16*)(F.ws + WS_Y); const GAS float* part = (const GAS float*)(F.ws + WS_PART);
    GAS bf16* xb = (GAS bf16*)(F.ws + WS_XB); GAS float* rs = (GAS float*)(F.ws + WS_RS); const GAS float* xin = INP(F, I_X);
    const int lane = F.lane;
    f32x4 gv[4];
#pragma unroll
    for (int j = 0; j < 4; ++j) gv[j] = *((const f32x4*)gain + lane + 64 * j);
    for (int m = F.vcu * NWAVES + F.wave; m < M; m += F.G * NWAVES) {
        const f32x4* pp = (const f32x4*)(part + (size_t)m * 16);
        const f32x4 p0 = *(const GAS f32x4*)(pp), p1 = *(const GAS f32x4*)(pp + 1), p2 = *(const GAS f32x4*)(pp + 2), p3 = *(const GAS f32x4*)(pp + 3);
        const float tot = ((p0.x + p0.y) + (p0.z + p0.w)) + ((p1.x + p1.y) + (p1.z + p1.w)) + ((p2.x + p2.y) + (p2.z + p2.w)) + ((p3.x + p3.y) + (p3.z + p3.w));
        const float sc = rsqf_(tot * (1.f / DM) + NORM_EPS);
        const GAS v2u* yr = (const GAS v2u*)(y + (size_t)m * DM) + lane;
        f32x4 v[4]; float s = 0.f;
#pragma unroll
        for (int j = 0; j < 4; ++j) { const v2u yu = yr[64 * j]; const f32x4 yv = (f32x4){bflo(yu.x), bfhi(yu.x), bflo(yu.y), bfhi(yu.y)};
            f32x4 xv;
            if (IN_F32) xv = ((const GAS f32x4*)(xin + (size_t)m * DM) + lane)[64 * j];
            else { const v2u xu = ((const GAS v2u*)(xb + (size_t)m * DM) + lane)[64 * j]; xv = (f32x4){bflo(xu.x), bfhi(xu.x), bflo(xu.y), bfhi(xu.y)}; }
            v[j] = xv + yv * sc * gv[j]; s += (v[j].x * v[j].x + v[j].y * v[j].y) + (v[j].z * v[j].z + v[j].w * v[j].w); }
        if (LAST) {
            GAS f32x4* orow = (GAS f32x4*)(F.out + (size_t)m * DM) + lane;
#pragma unroll
            for (int j = 0; j < 4; ++j) orow[64 * j] = v[j];
        } else {
            s = wave_sum(s);
            GAS v2u* o8 = (GAS v2u*)(xb + (size_t)m * DM) + lane;
#pragma unroll
            for (int j = 0; j < 4; ++j) { v2u o; o.x = pk2(v[j].x, v[j].y); o.y = pk2(v[j].z, v[j].w); o8[64 * j] = o; }
            if (lane == 0) rs[m] = rsqf_(s * (1.f / DM) + NORM_EPS);
        }
    }
}
__device__ __forceinline__ void phase_ffn_conv(Frame& F, int l) {
    LAUNDER(F);
    const GAS bf16* G = (const GAS bf16*)(F.ws + WS_G); GAS bf16* L = (GAS bf16*)(F.ws + WS_L);
    const GAS float* cw = INP(F, I_FCONV) + (size_t)l * 3 * DFF;
    constexpr int CPR = DFF / 8;
    const int nitems = (M / 256) * 2 * CPR;
    for (int it = F.vcu * NTHREADS + F.tid; it < nitems; it += F.G * NTHREADS) {
        const int ck = it % CPR, rr = it / CPR, m = (rr >> 1) * 256 + ((rr & 1) ? 255 : 0), t = m % T, c8 = 8 * ck;
        float w0[8], w1[8], w2[8];
#pragma unroll
        for (int j = 0; j < 8; ++j) { w0[j] = cw[c8 + j]; w1[j] = cw[DFF + c8 + j]; w2[j] = cw[2 * DFF + c8 + j]; }
        const v4u z = (v4u){0u, 0u, 0u, 0u};
        const v4u gp = (t > 0) ? *(const GAS v4u*)(G + (size_t)(m - 1) * DFF + c8) : z, gc = *(const GAS v4u*)(G + (size_t)m * DFF + c8), gn = (t < T - 1) ? *(const GAS v4u*)(G + (size_t)(m + 1) * DFF + c8) : z;
        const v4u lv = *(const GAS v4u*)(L + (size_t)m * DFF + c8);
        v4u o;
#pragma unroll
        for (int q = 0; q < 4; ++q) {
            const float a0 = w0[2 * q] * bflo(gp[q]) + w1[2 * q] * bflo(gc[q]) + w2[2 * q] * bflo(gn[q]);
            const float a1 = w0[2 * q + 1] * bfhi(gp[q]) + w1[2 * q + 1] * bfhi(gc[q]) + w2[2 * q + 1] * bfhi(gn[q]);
            o[q] = pk2(gelu_tanh(a0) * bflo(lv[q]), gelu_tanh(a1) * bfhi(lv[q])); }
        *(GAS v4u*)(L + (size_t)m * DFF + c8) = o;
    }
}

#ifndef MK_N_LAUNCHES
#define MK_N_LAUNCHES 1
#endif
constexpr int NPH = 1 + 8 * DEPTH;
struct Args { const float* in[26]; float* out; unsigned char* ws; int ph_lo, ph_hi; };
__global__ void __launch_bounds__(NTHREADS, 2) enc_fwd(Args args) {
    extern __shared__ __attribute__((aligned(16))) unsigned char lds_raw[];
    Frame F;
    F.lds = (LAS unsigned char*)lds_raw;
    F.MISC = (volatile LAS unsigned*)(F.lds + MISC_OFF);
    F.tid = threadIdx.x; F.lane = F.tid & 63; F.wave = __builtin_amdgcn_readfirstlane(F.tid >> 6);
    F.G = gridDim.x; { const int bx = blockIdx.x; F.vcu = (F.G % 8 == 0) ? (bx % 8) * (F.G / 8) + bx / 8 : bx; }
    F.ws = (GAS unsigned char*)args.ws; F.out = (GAS float*)args.out; F.ctl = (gu32*)(F.ws + WS_CTL);
    F.karg = (kq_t*)__builtin_amdgcn_kernarg_segment_ptr();
    for (int u = F.tid; u < LDS_BYTES / 16; u += NTHREADS) ((LAS v4u*)F.lds)[u] = (v4u){0u, 0u, 0u, 0u};
    __syncthreads();
    const int lo = args.ph_lo, hi = args.ph_hi;
    if (hi - lo > 1) (void)xcd_barrier_post((unsigned*)(F.ctl + CW_BAR), F.MISC + 8);
#define GRID_BAR() do { XcdBarrier bar_; bar_.bar = (unsigned*)(F.ctl + CW_BAR); bar_.x = xb_xcc_id(); bar_.st = F.MISC + 8; xcd_barrier(bar_); } while (0)
#ifndef PH_ENABLE
#define PH_ENABLE 0x7ff
#endif
#define IN(k) (lo <= (k) && (k) < hi)
#define EN(t) (((PH_ENABLE) >> (t)) & 1)
#pragma unroll 1
#ifdef REPEAT_T
    for (int step = lo; step < hi; ++step) {
        const int p1 = REPEAT_T, p2 = REPEAT_T + 8;
        const int ph = step - (step > p1 ? 1 : 0) - ((step > p2 + 1 && REPEAT_T != 7) ? 1 : 0);
#else
    for (int ph = lo; ph < hi; ++ph) {
#endif
        LAUNDER(F);
        const int l = ph == 0 ? 0 : (ph - 1) / 8, tt = ph == 0 ? 0 : 1 + (ph - 1) % 8;
        const int t = tt == 0 ? 0 : (tt == 1 ? 1 : (tt <= 5 ? tt + 1 : tt + 2));
        GAS unsigned char* wl = F.ws + WS_W + (size_t)l * W_LAYER;
      {
        if (t == 1 || t == 8) {
            pg8::Gemm g; pg8::EpiUni E;
            g.M = M; E.split_cols = 0; E.split_stride = 0; E.convw = nullptr; E.G = nullptr; E.xl = (pg8::PG8_LAS_T*)(F.lds + RING_BYTES + 1024); E.part = nullptr; E.rs = (const GAS float*)(F.ws + WS_RS);
            g.A = (const GAS bf16*)(F.ws + WS_XB); g.K = DM;
            if (t == 1) { g.Bt = (const GAS bf16*)(wl + W_IN); g.N = NPROJP; E.O = (GAS bf16*)(F.ws + WS_PROJ); E.ldc = NPROJP; }
            else        { g.Bt = (const GAS bf16*)(wl + W_UP); g.N = NUP;    E.O = (GAS bf16*)(F.ws + WS_L); E.ldc = DFF; E.convw = INP(F, I_FCONV) + (size_t)l * 3 * DFF; E.G = (GAS bf16*)(F.ws + WS_G); }
            g.Bt = launder_p(g.Bt); E.O = launder_p(E.O); E.convw = launder_p(E.convw); E.G = launder_p(E.G); g.N = launder_u(g.N); E.ldc = launder_u(E.ldc);
            g.A = launder_p(g.A); E.rs = launder_p(E.rs);
            pg8::StaticOrder S; S.init(M, g.N, F.G, (int)blockIdx.x);
            pg8::gemm_phase<pg8::EpiUni, pg8::StaticOrder, true, true>(F.lds, g, S, E);
        }
        else if (t == 6 || t == 10) {
            pg8::Gemm g; pg8::EpiResid E;
            g.M = M; g.N = DM; E.xl = (pg8::PG8_LAS_T*)(F.lds + RING_BYTES + 1024);
            E.xb = (GAS bf16*)(F.ws + WS_XB); E.outf = F.out; E.rsw = (GAS float*)(F.ws + WS_RS); E.xs = (GAS float*)(F.ws + WS_XS); E.resid = 1;
            if (t == 6) { g.A = (const GAS bf16*)(F.ws + WS_MERGED); g.Bt = (const GAS bf16*)(wl + W_OUT); g.K = DM;  E.gain = INP(F, I_NMPOST) + l * DM; E.cnt = (GAS unsigned*)(F.ctl + CW_PANEL) + (size_t)(l * 2 + 0) * 2 * 128 * 64; }
            else        { g.A = (const GAS bf16*)(F.ws + WS_L);      g.Bt = (const GAS bf16*)(wl + W_DN);  g.K = DFF; E.gain = INP(F, I_NFPOST) + l * DM; if (l + 1 == DEPTH) E.resid = 2; E.cnt = (GAS unsigned*)(F.ctl + CW_PANEL) + (size_t)(l * 2 + 1) * 2 * 128 * 64; }
            g.A = launder_p(g.A); g.Bt = launder_p(g.Bt); g.K = launder_u(g.K); E.gain = launder_p(E.gain); E.cnt = launder_p(E.cnt); E.resid = launder_u(E.resid);
            E.xb = launder_p(E.xb); E.outf = launder_p(E.outf); E.rsw = launder_p(E.rsw); E.xs = launder_p(E.xs);
            pg8::StaticOrder S; S.init(M, g.N, F.G, (int)blockIdx.x);
            pg8::gemm_phase<pg8::EpiResid, pg8::StaticOrder, true, true>(F.lds, g, S, E);
        }
        else if (t == 0) p0_prologue(F);
#ifdef C1_EXP
        else if (t == 3) { phase_mixers(F, l); phase_scan_c1<0>(F, l); phase_scan_c1<C1_EXP>(F, l); }
#else
        else if (t == 3) { phase_mixers(F, l); phase_scan_c1<0>(F, l); }
#endif
#ifdef C2_EXP
        else if (t == 4) { phase_scan_c2<0>(F, l); phase_scan_c2<C2_EXP>(F, l); }
#else
        else if (t == 4) phase_scan_c2<0>(F, l);
#endif
        else if (t == 5) phase_rwkv_post(F, l);
        else if (t == 9) phase_ffn_conv(F, l);
      }
#ifdef REPEAT_T
        if (step + 1 < hi) GRID_BAR();
#else
        if (ph + 1 < hi) GRID_BAR();
#endif
    }
    asm volatile("s_waitcnt vmcnt(0) lgkmcnt(0)" ::: "memory");
}


#ifdef DBG_CHECK
__global__ void dbg_check(const void* buf, size_t n, int kind, int code, unsigned* flag) {
    bool bad = false;
    for (size_t i = (size_t)blockIdx.x * blockDim.x + threadIdx.x; i < n; i += (size_t)gridDim.x * blockDim.x) {
        float v;
        if (kind == 0) v = bf2f(((const unsigned short*)buf)[i]);
        else if (kind == 1) v = ((const float*)buf)[i];
        else v = (float)((const _Float16*)buf)[i];
        if (!(fabsf(v) < 1e30f)) bad = true;
    }
    if (bad) atomicMax(flag, (unsigned)(1000000 - code));
}
__global__ void dbg_report(float* out, const unsigned* flag) { if (threadIdx.x == 0 && blockIdx.x == 0) { const unsigned f = *flag; if (f) out[0] = 100000.f * (float)(10 + 1000000 - (int)f); } }
#endif
extern "C" void kernel_launch(void* const* d_in, const int* in_sizes, int n_in, void* d_out, int out_size, void* d_ws, size_t ws_size, hipStream_t stream) {
    static int grid = 0;
    if (grid == 0) {
        if (n_in != 26 || in_sizes[0] != M * DM || out_size != M * DM || ws_size < WS_END) { fprintf(stderr, "kernel_launch: unexpected shapes: n_in %d in0 %d out %d ws %zu (need >= %zu)\n", n_in, n_in > 0 ? in_sizes[0] : -1, out_size, ws_size, (size_t)WS_END); grid = -1; return; }
        int dev = 0, cus = 0, per_cu = 0;
        if (hipGetDevice(&dev) != hipSuccess || hipDeviceGetAttribute(&cus, hipDeviceAttributeMultiprocessorCount, dev) != hipSuccess) { grid = -1; return; }
        if (hipFuncSetAttribute((const void*)enc_fwd, hipFuncAttributeMaxDynamicSharedMemorySize, LDS_BYTES) != hipSuccess) { fprintf(stderr, "kernel_launch: hipFuncSetAttribute failed\n"); grid = -1; return; }
        if (hipOccupancyMaxActiveBlocksPerMultiprocessor(&per_cu, (const void*)enc_fwd, NTHREADS, LDS_BYTES) != hipSuccess || per_cu < 1) { fprintf(stderr, "kernel_launch: occupancy query says %d blocks per CU\n", per_cu); }
        (void)hipGetLastError();
        grid = cus;
        if (grid != 256) fprintf(stderr, "kernel_launch: %d CUs (built for 256)\n", grid);
    }
    if (grid < 0) return;
    (void)hipMemsetAsync((char*)d_ws + WS_CTL, 0, CTL_ZERO_BYTES, stream);
    Args a{};
    for (int i = 0; i < 26; ++i) a.in[i] = (const float*)d_in[i];
    a.out = (float*)d_out; a.ws = (unsigned char*)d_ws;
#if MK_N_LAUNCHES == 1
#ifdef REPEAT_T
    a.ph_lo = 0; a.ph_hi = NPH + (REPEAT_T == 7 ? 1 : 2);
#else
    a.ph_lo = 0; a.ph_hi = NPH;
#endif
    hipLaunchKernelGGL(enc_fwd, dim3(grid), dim3(NTHREADS), LDS_BYTES, stream, a);
#else
    for (int p = 0; p < NPH; ++p) { a.ph_lo = p; a.ph_hi = p + 1; hipLaunchKernelGGL(enc_fwd, dim3(grid), dim3(NTHREADS), LDS_BYTES, stream, a);
#ifdef DBG_CHECK
        unsigned* flag = (unsigned*)((char*)d_ws + 512 * 1024); char* ws = (char*)d_ws; const int t = p == 0 ? 0 : 1 + (p - 1) % 10;
#define CHK(ptr, n, kind, sub) hipLaunchKernelGGL(dbg_check, dim3(2048), dim3(256), 0, stream, (const void*)(ptr), (size_t)(n), kind, p * 4 + sub, flag)
        if (t == 0) { CHK(ws + WS_W, 2 * W_LAYER / 2, 0, 0); CHK(ws + WS_XB, (size_t)M * DM, 0, 1); CHK(ws + WS_RS, M, 1, 2); }
        if (t == 1) { CHK(ws + WS_PROJ, (size_t)M * NPROJP, 0, 0); }
        if (t == 2) { CHK(ws + WS_PREP, (size_t)64 * MiB, 2, 1); }
        if (t == 3) { CHK(d_out, (size_t)2 * M * 256, 0, 0); }
        if (t == 4) { CHK(ws + WS_MERGED, (size_t)M * DM, 0, 0); }
        if (t == 5 || t == 9) { CHK(ws + WS_Y, (size_t)M * DM, 1, 0); CHK(ws + WS_PART, (size_t)M * 16, 1, 1); }
        if (t == 6 || t == 10) { CHK(d_out, (size_t)M * DM, 1, 0); CHK(ws + WS_XB, (size_t)M * DM, 0, 1); CHK(ws + WS_RS, M, 1, 2); }
        if (t == 7) { CHK(ws + WS_G, (size_t)M * DFF, 0, 0); CHK(ws + WS_L, (size_t)M * DFF, 0, 1); }
        if (t == 8) { CHK(ws + WS_L, (size_t)M * DFF, 0, 0); }
        if (p == NPH - 1) hipLaunchKernelGGL(dbg_report, dim3(1), dim3(64), 0, stream, (float*)d_out, (const unsigned*)flag);
#endif
    }
#endif
}
```

```cpp
#include <hip/hip_runtime.h>
#include <cstdio>
#include <cstdint>
namespace pg8 {
#define PG8_LAS __attribute__((address_space(3)))
#define PG8_GAS __attribute__((address_space(1)))
typedef PG8_LAS unsigned char PG8_LAS_T;
typedef unsigned short bf16_t;
typedef short bf16x8 __attribute__((ext_vector_type(8)));
typedef float f32x4 __attribute__((ext_vector_type(4)));
typedef unsigned u32x4 __attribute__((ext_vector_type(4)));
constexpr int BM = 256, BK = 64, HALF = 128, HTB = HALF * BK * 2  , STAGE_BYTES = 8 * HTB, NXCD = 8, WGM = 4;

__host__ __device__ __forceinline__ int lds_byte(int r, int c) { const int st = (r >> 4) * 2 + (c >> 5), rr = r & 15, cc = c & 31, ob = rr * 64 + cc * 2; return st * 1024 + (ob ^ (((ob >> 9) & 1) << 5)); }
__host__ __device__ __forceinline__ void stage_rc(int b, int& R, int& C) { const int st = b / 1024, sb = b % 1024, swz = sb ^ (((sb >> 9) & 1) << 5); R = (st >> 1) * 16 + swz / 64; C = (st & 1) * 32 + (swz % 64) / 2; }
__host__ __device__ __forceinline__ int perm32(int rho) { const int n = rho >> 4, i = rho & 15; return 8 * (i >> 2) + 4 * n + (i & 3); }

struct Unit { int pm, pn; };
struct Gemm { const PG8_GAS bf16_t* A; const PG8_GAS bf16_t* Bt; int M, N, K; };

struct StaticOrder {
    int nM, nN, nwg, G, c;
    __host__ __device__ void init(int M, int N, int G_, int c_) { nM = M / BM; nN = N / BM; nwg = nM * nN; G = G_; c = c_; }
    __host__ __device__ bool next(int i, Unit& u) const {
        const long L = (long)i * G + c; if (L >= nwg) return false;
        int wgid = (int)L; { const int q = nwg / NXCD, r = nwg % NXCD, xcd = wgid % NXCD, off = wgid / NXCD; wgid = (xcd < r ? xcd * (q + 1) : r * (q + 1) + (xcd - r) * q) + off; }
        const int nig = WGM * nN, gid = wgid / nig, fm = gid * WGM, gsz = (nM - fm) < WGM ? (nM - fm) : WGM;
        u.pm = fm + ((wgid % nig) % gsz); u.pn = (wgid % nig) / gsz; return true;
    }
    __device__ __forceinline__ void a_ready(const Unit&) const {}
    __device__ __forceinline__ void done(const Unit&) const {}
};
typedef float f32x2c __attribute__((ext_vector_type(2)));
typedef __bf16 bf16x2c __attribute__((ext_vector_type(2)));
__device__ __forceinline__ unsigned cvt_pk_bf16(float lo, float hi) { const f32x2c v = {lo, hi}; return __builtin_bit_cast(unsigned, __builtin_convertvector(v, bf16x2c)); }
struct EpiUni {
    static constexpr bool AFTER_DRAIN = false;
    PG8_GAS bf16_t* O; int ldc; const PG8_GAS float* rs; int split_cols; size_t split_stride; PG8_GAS float* part;
    const PG8_GAS float* convw; PG8_GAS bf16_t* G; PG8_LAS unsigned char* xl;
    __device__ __forceinline__ bool perm() const { return true; }
    template <int CTRL> static __device__ __forceinline__ float dppo(float old, float x) { return __builtin_bit_cast(float, __builtin_amdgcn_update_dpp(__builtin_bit_cast(int, old), __builtin_bit_cast(int, x), CTRL, 0xF, 0xF, false)); }
    static __device__ __forceinline__ float gelu_t(float x) { const float u = 1.5957691216057308f * x * (1.f + 0.044715f * x * x); return x * __builtin_amdgcn_rcpf(1.f + __expf(-u)); }
    __device__ __forceinline__ void conv_epi(const f32x4 (&acc_)[2][2][4][2], const Unit& u, int wr, int wc, int fr, int fq) const {
        f32x4 (&acc)[2][2][4][2] = const_cast<f32x4 (&)[2][2][4][2]>(acc_);
        const int hcol = u.pn * HALF + wc * 32 + 8 * fq;
        const PG8_GAS float* rsp = rs + u.pm * BM + wr * 64 + fr;
        constexpr int LDH = 2816;
        const unsigned lane_off = (unsigned)((wr * 64 + fr) * LDH + hcol) * 2u;
        PG8_GAS char* Ob = (PG8_GAS char*)(O + (size_t)u.pm * BM * LDH); PG8_GAS char* Gb = (PG8_GAS char*)(G + (size_t)u.pm * BM * LDH);
        unsigned lp[2][4][2][2];
#pragma unroll
        for (int ai = 0; ai < 2; ++ai)
#pragma unroll
            for (int m = 0; m < 4; ++m) { const float r = rsp[ai * HALF + m * 16];
#pragma unroll
                for (int n = 0; n < 2; ++n) { const f32x4 l4 = acc[ai][1][m][n] * r; lp[ai][m][n][0] = cvt_pk_bf16(l4[0], l4[1]); lp[ai][m][n][1] = cvt_pk_bf16(l4[2], l4[3]); } }
#pragma unroll
        for (int ai = 0; ai < 2; ++ai) { const int k = 2 * ai + wr;
            if (fr == 0)  { const float r = rsp[ai * HALF]; PG8_LAS f32x4* p = (PG8_LAS f32x4*)(xl + ((k * 2 + 0) * 4 + wc) * 128 + fq * 32); p[0] = acc[ai][0][0][0] * r; p[1] = acc[ai][0][0][1] * r; }
            if (fr == 15) { const float r = rsp[ai * HALF + 48]; PG8_LAS f32x4* p = (PG8_LAS f32x4*)(xl + ((k * 2 + 1) * 4 + wc) * 128 + fq * 32); p[0] = acc[ai][0][3][0] * r; p[1] = acc[ai][0][3][1] * r; } }
        asm volatile("s_waitcnt lgkmcnt(0)" ::: "memory"); __builtin_amdgcn_s_barrier(); asm volatile("" ::: "memory");
#pragma unroll
        for (int ai = 0; ai < 2; ++ai) { const int k = 2 * ai + wr;
            float rsv[4];
#pragma unroll
            for (int m = 0; m < 4; ++m) { rsv[m] = rsp[ai * HALF + m * 16];
#pragma unroll
                for (int n = 0; n < 2; ++n) acc[ai][0][m][n] = acc[ai][0][m][n] * rsv[m]; }
            const int ku = k > 0 ? k - 1 : 0, kd = k < 3 ? k + 1 : 3;
#pragma unroll
            for (int n = 0; n < 2; ++n) {
                float w0[4], w1[4], w2[4];
#pragma unroll
                for (int j = 0; j < 4; ++j) { w0[j] = convw[hcol + 4 * n + j]; w1[j] = convw[LDH + hcol + 4 * n + j]; w2[j] = convw[2 * LDH + hcol + 4 * n + j]; }
                const f32x4 xt = *(const PG8_LAS f32x4*)(xl + ((ku * 2 + 1) * 4 + wc) * 128 + fq * 32 + n * 16), xb = *(const PG8_LAS f32x4*)(xl + ((kd * 2 + 0) * 4 + wc) * 128 + fq * 32 + n * 16);
#pragma unroll
                for (int m = 0; m < 4; ++m) { const int tr = 64 * k + 16 * m + fr; const unsigned coff = (unsigned)((ai * HALF + 16 * m) * LDH * 2 + 8 * n);
                    float hv[4];
#pragma unroll
                    for (int e = 0; e < 4; ++e) { const float cur = acc[ai][0][m][n][e];
                        const float upx = (m > 0) ? dppo<0x121>(0.f, acc[ai][0][m > 0 ? m - 1 : 0][n][e]) : xt[e];
                        const float dnx = (m < 3) ? dppo<0x12F>(0.f, acc[ai][0][m < 3 ? m + 1 : 3][n][e]) : xb[e];
                        const float up = dppo<0x111>(upx, cur), dn = dppo<0x101>(dnx, cur);
                        const float a = w0[e] * up + w1[e] * cur + w2[e] * dn;
                        const unsigned lw = lp[ai][m][n][e >> 1]; const float lv = (e & 1) ? __builtin_bit_cast(float, lw & 0xffff0000u) : __builtin_bit_cast(float, lw << 16);
                        hv[e] = (tr == 0 || tr == 255) ? lv : gelu_t(a) * lv; }
                    typedef unsigned u32x2_ __attribute__((ext_vector_type(2)));
                    u32x2_ w; w.x = cvt_pk_bf16(hv[0], hv[1]); w.y = cvt_pk_bf16(hv[2], hv[3]);
                    *(PG8_GAS u32x2_*)(Ob + coff + lane_off) = w;
                    if (tr <= 1 || tr >= 254) { u32x2_ gw; gw.x = cvt_pk_bf16(acc[ai][0][m][n][0], acc[ai][0][m][n][1]); gw.y = cvt_pk_bf16(acc[ai][0][m][n][2], acc[ai][0][m][n][3]);
                        *(PG8_GAS u32x2_*)(Gb + coff + lane_off) = gw; }
                    __builtin_amdgcn_sched_barrier(0); }
                asm volatile("" ::: "memory");
            }
        }
    }
    __device__ __forceinline__ void operator()(const f32x4 (&acc)[2][2][4][2], const Unit& u, int wr, int wc, int fr, int fq) const {
        if (convw != nullptr) { conv_epi(acc, u, wr, wc, fr, fq); return; }
        const int row0 = u.pm * BM + wr * 64 + fr; int colt = u.pn * BM; PG8_GAS bf16_t* base = O;
        if (split_cols) { const int t = colt / split_cols; base += (size_t)t * split_stride; colt -= t * split_cols; }
        const int col0 = colt + wc * 32 + 8 * fq;
        if (part == nullptr) {
#pragma unroll
            for (int ai = 0; ai < 2; ++ai)
#pragma unroll
                for (int m = 0; m < 4; ++m) { const int row = row0 + ai * HALF + m * 16; const float s = rs[row]; PG8_GAS bf16_t* rowp = base + (size_t)row * ldc + col0;
#pragma unroll
                    for (int bj = 0; bj < 2; ++bj) { const f32x4 v0 = acc[ai][bj][m][0] * s, v1 = acc[ai][bj][m][1] * s;
                        u32x4 w; w.x = cvt_pk_bf16(v0[0], v0[1]); w.y = cvt_pk_bf16(v0[2], v0[3]); w.z = cvt_pk_bf16(v1[0], v1[1]); w.w = cvt_pk_bf16(v1[2], v1[3]);
                        *(PG8_GAS u32x4*)(rowp + bj * HALF) = w; } }
        } else {
#pragma unroll
            for (int ai = 0; ai < 2; ++ai)
#pragma unroll
                for (int m = 0; m < 4; ++m) { const int row = row0 + ai * HALF + m * 16; PG8_GAS bf16_t* rowp = base + (size_t)row * ldc + col0; float ss = 0.f;
#pragma unroll
                    for (int bj = 0; bj < 2; ++bj) { const f32x4 v0 = acc[ai][bj][m][0], v1 = acc[ai][bj][m][1];
                        ss += ((v0[0] * v0[0] + v0[1] * v0[1]) + (v0[2] * v0[2] + v0[3] * v0[3])) + ((v1[0] * v1[0] + v1[1] * v1[1]) + (v1[2] * v1[2] + v1[3] * v1[3]));
                        u32x4 w; w.x = cvt_pk_bf16(v0[0], v0[1]); w.y = cvt_pk_bf16(v0[2], v0[3]); w.z = cvt_pk_bf16(v1[0], v1[1]); w.w = cvt_pk_bf16(v1[2], v1[3]);
                        *(PG8_GAS u32x4*)(rowp + bj * HALF) = w; }
                    ss += __shfl_xor(ss, 16); ss += __shfl_xor(ss, 32); if (fq == 0) part[(size_t)row * 16 + u.pn * 4 + wc] = ss; }
        }
    }
};
struct EpiResid {
    static constexpr bool AFTER_DRAIN = false;
    PG8_LAS unsigned char* xl;
    __device__ __forceinline__ bool perm() const { return true; }
    int resid; const PG8_GAS float* gain; PG8_GAS bf16_t* xb; PG8_GAS float* outf; PG8_GAS float* rsw; PG8_GAS float* xs; PG8_GAS unsigned* cnt;
    static __device__ __forceinline__ f32x4 unlo(unsigned a, unsigned b) { return (f32x4){__builtin_bit_cast(float, a << 16), __builtin_bit_cast(float, a & 0xffff0000u), __builtin_bit_cast(float, b << 16), __builtin_bit_cast(float, b & 0xffff0000u)}; }
    static __device__ __forceinline__ float hsum(const f32x4 v) { return (v[0] + v[1]) + (v[2] + v[3]); }
    __device__ __forceinline__ void resid_epi(const f32x4 (&acc_)[2][2][4][2], const Unit& u, int, int, int, int) const {
        f32x4 (&acc)[2][2][4][2] = const_cast<f32x4 (&)[2][2][4][2]>(acc_);
        int tid = threadIdx.x; asm volatile("" : "+v"(tid));
        const int wid = __builtin_amdgcn_readfirstlane(tid >> 6), wr = wid >> 2, wc = wid & 3, fr = tid & 15, fq = (tid >> 4) & 3;
        const int col0 = u.pn * BM + wc * 32 + 8 * fq;
        const unsigned lane_e = (unsigned)((wr * 64 + fr) * 1024 + col0);
        PG8_GAS char* xbb = (PG8_GAS char*)(xb + (size_t)u.pm * BM * 1024); PG8_GAS char* outb = (PG8_GAS char*)(outf + (size_t)u.pm * BM * 1024);
        PG8_LAS f32x4* P4 = (PG8_LAS f32x4*)xl; PG8_LAS float* S2 = (PG8_LAS float*)(xl + 16384);
        PG8_LAS float* GW = (PG8_LAS float*)(xl + 18432) + (wr * 4 + wc) * 64;
        { const int ln = fq * 16 + fr; GW[ln] = gain[u.pn * BM + (ln >> 5) * HALF + wc * 32 + (ln & 31)]; }
#pragma unroll
        for (int ai = 0; ai < 2; ++ai)
#pragma unroll
            for (int m = 0; m < 4; ++m) {
#pragma unroll
                for (int bj = 0; bj < 2; ++bj) { const f32x4 v0 = acc[ai][bj][m][0], v1 = acc[ai][bj][m][1];
                    u32x4 p; p.x = cvt_pk_bf16(v0[0], v0[1]); p.y = cvt_pk_bf16(v0[2], v0[3]); p.z = cvt_pk_bf16(v1[0], v1[1]); p.w = cvt_pk_bf16(v1[2], v1[3]);
                    acc[ai][bj][m][0] = __builtin_bit_cast(f32x4, p); }
                __builtin_amdgcn_sched_barrier(0); }
#define PG8_XLD(it_) do { unsigned le_ = lane_e; asm volatile("" : "+v"(le_)); _Pragma("unroll") for (int bj = 0; bj < 2; ++bj) \
            xq[(it_) % 3][bj] = *(const PG8_GAS u32x4*)(xbb + (size_t)((unsigned)(((((it_) >> 2) * HALF) + 16 * ((it_) & 3)) * 1024 + bj * HALF) + le_) * 2); } while (0)
        {   u32x4 xq[3][2];
            PG8_XLD(0); PG8_XLD(1);
#pragma unroll
            for (int it = 0; it < 8; ++it) { const int ai = it >> 2, m = it & 3;
                if (it + 2 < 8) PG8_XLD(it + 2);
                float sa = 0.f, sb = 0.f, sc = 0.f, sd = 0.f;
#pragma unroll
                for (int bj = 0; bj < 2; ++bj) { f32x4 py_ = acc[ai][bj][m][0]; asm volatile("" : "+v"(py_));
                    const u32x4 p = __builtin_bit_cast(u32x4, py_), xw = xq[it % 3][bj];
                    const f32x4 g0 = *(const PG8_LAS f32x4*)(GW + bj * 32 + 8 * fq), g1 = *(const PG8_LAS f32x4*)(GW + bj * 32 + 8 * fq + 4);
                    const f32x4 y0 = unlo(p.x, p.y), y1 = unlo(p.z, p.w), x0 = unlo(xw.x, xw.y), x1 = unlo(xw.z, xw.w), q0 = y0 * g0, q1 = y1 * g1;
                    sa += hsum(y0 * y0) + hsum(y1 * y1); sb += hsum(x0 * x0) + hsum(x1 * x1); sc += hsum(x0 * q0) + hsum(x1 * q1); sd += hsum(q0 * q0) + hsum(q1 * q1); }
                sa += __shfl_xor(sa, 16); sb += __shfl_xor(sb, 16); sc += __shfl_xor(sc, 16); sd += __shfl_xor(sd, 16);
                sa += __shfl_xor(sa, 32); sb += __shfl_xor(sb, 32); sc += __shfl_xor(sc, 32); sd += __shfl_xor(sd, 32);
                if (fq == 0) P4[(ai * HALF + wr * 64 + m * 16 + fr) * 4 + wc] = (f32x4){sa, sb, sc, sd};
                __builtin_amdgcn_sched_barrier(0); } }
        asm volatile("s_waitcnt lgkmcnt(0)" ::: "memory"); __builtin_amdgcn_s_barrier(); asm volatile("" ::: "memory");
        PG8_GAS float* slot = xs + (size_t)u.pm * BM * 16;
        PG8_GAS unsigned* c = cnt + u.pm * 64;
        if (tid < 256) { const f32x4 t4 = (P4[tid * 4 + 0] + P4[tid * 4 + 1]) + (P4[tid * 4 + 2] + P4[tid * 4 + 3]);
#pragma unroll
            for (int j = 0; j < 4; ++j) __hip_atomic_store(slot + tid * 16 + u.pn * 4 + j, t4[j], __ATOMIC_RELAXED, __HIP_MEMORY_SCOPE_AGENT);
            asm volatile("s_waitcnt vmcnt(0)" ::: "memory");
            if ((tid & 63) == 0) __hip_atomic_fetch_add(c, 1u, __ATOMIC_RELAXED, __HIP_MEMORY_SCOPE_AGENT); }
        if (tid < 64) { unsigned spins = 0;
            while ((unsigned)__builtin_amdgcn_readfirstlane(__hip_atomic_load(c, __ATOMIC_RELAXED, __HIP_MEMORY_SCOPE_AGENT)) < 16u) { __builtin_amdgcn_s_sleep(2); if (++spins > (1u << 22)) break; }
            __builtin_amdgcn_fence(__ATOMIC_ACQUIRE, "agent"); asm volatile("s_waitcnt vmcnt(0)" ::: "memory"); }
        asm volatile("s_waitcnt lgkmcnt(0)" ::: "memory"); __builtin_amdgcn_s_barrier(); asm volatile("" ::: "memory");
        if (tid < 256) { float t[4] = {0.f, 0.f, 0.f, 0.f};
#pragma unroll
            for (int q = 0; q < 4; ++q)
#pragma unroll
                for (int j = 0; j < 4; ++j) t[j] += __hip_atomic_load(slot + tid * 16 + q * 4 + j, __ATOMIC_RELAXED, __HIP_MEMORY_SCOPE_AGENT);
            const float ry = __builtin_amdgcn_rsqf(t[0] * (1.f / 1024.f) + 1e-6f);
            const float sx = t[1] + ry * (2.f * t[2] + ry * t[3]);
            const float rn = __builtin_amdgcn_rsqf(sx * (1.f / 1024.f) + 1e-6f);
            S2[tid * 2] = ry; S2[tid * 2 + 1] = rn;
            if (resid == 1 && u.pn == 0) rsw[(size_t)u.pm * BM + tid] = rn; }
        asm volatile("s_waitcnt lgkmcnt(0)" ::: "memory"); __builtin_amdgcn_s_barrier(); asm volatile("" ::: "memory");
        {   u32x4 xq[3][2];
            PG8_XLD(0); PG8_XLD(1);
#pragma unroll
            for (int it = 0; it < 8; ++it) { const int ai = it >> 2, m = it & 3;
                if (it + 2 < 8) PG8_XLD(it + 2);
                const float sc = S2[(ai * HALF + wr * 64 + m * 16 + fr) * 2];
                unsigned le = lane_e; asm volatile("" : "+v"(le));
#pragma unroll
                for (int bj = 0; bj < 2; ++bj) { const unsigned ce = (unsigned)((ai * HALF + 16 * m) * 1024 + bj * HALF);
                    f32x4 py_ = acc[ai][bj][m][0]; asm volatile("" : "+v"(py_));
                    const u32x4 p = __builtin_bit_cast(u32x4, py_), xw = xq[it % 3][bj];
                    const f32x4 g0 = *(const PG8_LAS f32x4*)(GW + bj * 32 + 8 * fq), g1 = *(const PG8_LAS f32x4*)(GW + bj * 32 + 8 * fq + 4);
                    const f32x4 v0 = unlo(xw.x, xw.y) + unlo(p.x, p.y) * sc * g0, v1 = unlo(xw.z, xw.w) + unlo(p.z, p.w) * sc * g1;
                    if (resid == 2) { PG8_GAS f32x4* op = (PG8_GAS f32x4*)(outb + (size_t)(ce + le) * 4); op[0] = v0; op[1] = v1; }
                    else { u32x4 w; w.x = cvt_pk_bf16(v0[0], v0[1]); w.y = cvt_pk_bf16(v0[2], v0[3]); w.z = cvt_pk_bf16(v1[0], v1[1]); w.w = cvt_pk_bf16(v1[2], v1[3]);
                        *(PG8_GAS u32x4*)(xbb + (size_t)(ce + le) * 2) = w; } }
                asm volatile("" ::: "memory"); __builtin_amdgcn_sched_barrier(0); } }
#undef PG8_XLD
    }
    __device__ __forceinline__ void operator()(const f32x4 (&acc)[2][2][4][2], const Unit& u, int wr, int wc, int fr, int fq) const { resid_epi(acc, u, wr, wc, fr, fq); }
};
template <class Epi, class Sched, bool ALIGN_EPI = false, bool SP2 = false>
__device__ __forceinline__ void gemm_phase(PG8_LAS unsigned char* lds, const Gemm g, const Sched& S, const Epi& E) {
    int tid_ = threadIdx.x; asm volatile("" : "+v"(tid_));
    const int tid = tid_, wid = __builtin_amdgcn_readfirstlane(tid >> 6), lane = tid & 63, wr = wid >> 2, wc = wid & 3, fr = lane & 15, fq = lane >> 4;
    const int K = g.K, nt = K / BK;
    unsigned voffA[2], voffB[2];
#pragma unroll
    for (int i = 0; i < 2; ++i) { int R, C; stage_rc(tid * 16 + i * 8192, R, C); const int Rb = E.perm() ? ((R & ~31) + perm32(R & 31)) : R;
        voffA[i] = (unsigned)(R * K + C) * 2u; voffB[i] = (unsigned)(Rb * K + C) * 2u; }
    const size_t kstep = (size_t)(BK * 2);
    const size_t hstep = (size_t)HALF * K * 2;
    const size_t tstep = 2 * hstep;
    const unsigned ldsw = (unsigned)wid * 1024u;
    const int aoff = lds_byte(wr * 64 + fr, fq * 8), boff = lds_byte(wc * 32 + fr, fq * 8);
#define PG8_SA(b, h) (((b) * 2 + (h)) * HTB)
#define PG8_SB(b, h) ((4 + (b) * 2 + (h)) * HTB)
#define PG8_STAGE(bufoff, gbase, voff) do { _Pragma("unroll") for (int _i = 0; _i < 2; ++_i) \
        __builtin_amdgcn_global_load_lds((const PG8_GAS unsigned*)((const PG8_GAS char*)(gbase) + (voff)[_i]), (PG8_LAS unsigned*)(lds + (bufoff) + ldsw + _i * 8192), 16, 0, 0); } while (0)
#define PG8_LDA(dst, b, h) do { _Pragma("unroll") for (int m = 0; m < 4; ++m) _Pragma("unroll") for (int k = 0; k < 2; ++k) dst[m][k] = *(const PG8_LAS bf16x8*)(lds + PG8_SA(b, h) + aoff + m * 2048 + k * 1024); } while (0)
#define PG8_LDB(dst, b, h) do { _Pragma("unroll") for (int n = 0; n < 2; ++n) _Pragma("unroll") for (int k = 0; k < 2; ++k) dst[n][k] = *(const PG8_LAS bf16x8*)(lds + PG8_SB(b, h) + boff + n * 2048 + k * 1024); } while (0)
#define PG8_MMA(ai, bj, At, Bt) do { __builtin_amdgcn_s_setprio(1); _Pragma("unroll") for (int m = 0; m < 4; ++m) _Pragma("unroll") for (int n = 0; n < 2; ++n) _Pragma("unroll") for (int k = 0; k < 2; ++k) \
        acc[ai][bj][m][n] = __builtin_amdgcn_mfma_f32_16x16x32_bf16(Bt[n][k], At[m][k], acc[ai][bj][m][n], 0, 0, 0); __builtin_amdgcn_s_setprio(0); } while (0)
#define PG8_WAIT_V(n) asm volatile("s_waitcnt vmcnt(" #n ")" ::: "memory")
#define PG8_WAIT_L(n) asm volatile("s_waitcnt lgkmcnt(" #n ")" ::: "memory")
#define PG8_BAR __builtin_amdgcn_s_barrier()
#define PG8_SCHED __builtin_amdgcn_sched_barrier(0)
    Unit cur, nxt; int ui = 0;
    if (!S.next(0, cur)) return;
    f32x4 acc[2][2][4][2];
#pragma unroll
    for (int a = 0; a < 2; ++a)
#pragma unroll
        for (int b = 0; b < 2; ++b)
#pragma unroll
            for (int m = 0; m < 4; ++m)
#pragma unroll
                for (int n = 0; n < 2; ++n) acc[a][b][m][n] = (f32x4){0.f, 0.f, 0.f, 0.f};
    bf16x8 At[4][2], B0[2][2], B1[2][2];
    const PG8_GAS char* cA = (const PG8_GAS char*)g.A + (size_t)cur.pm * tstep; const PG8_GAS char* cB = (const PG8_GAS char*)g.Bt + (size_t)cur.pn * tstep;
    S.a_ready(cur);
    if constexpr (SP2) {
        PG8_STAGE(PG8_SB(0, 0), cB, voffB); PG8_STAGE(PG8_SB(0, 1), cB + hstep, voffB); PG8_STAGE(PG8_SA(0, 0), cA, voffA); PG8_STAGE(PG8_SA(0, 1), cA + hstep, voffA);
        if (wr == 1) PG8_BAR;
        PG8_WAIT_V(2); PG8_BAR;
        PG8_STAGE(PG8_SB(1, 0), cB + kstep, voffB); PG8_STAGE(PG8_SA(1, 0), cA + kstep, voffA); PG8_STAGE(PG8_SB(1, 1), cB + hstep + kstep, voffB);
        PG8_WAIT_V(6); PG8_BAR;
    } else {
        PG8_STAGE(PG8_SB(0, 0), cB, voffB); PG8_STAGE(PG8_SA(0, 0), cA, voffA); PG8_STAGE(PG8_SB(0, 1), cB + hstep, voffB); PG8_STAGE(PG8_SA(0, 1), cA + hstep, voffA);
        if (wr == 1) PG8_BAR;
        PG8_WAIT_V(4); PG8_BAR;
        PG8_STAGE(PG8_SB(1, 0), cB + kstep, voffB); PG8_STAGE(PG8_SA(1, 0), cA + kstep, voffA); PG8_STAGE(PG8_SB(1, 1), cB + hstep + kstep, voffB);
        PG8_WAIT_V(6); PG8_BAR;
    }
    for (;;) {
        const bool has_next = S.next(ui + 1, nxt);
        const PG8_GAS char* nA = has_next ? (const PG8_GAS char*)g.A + (size_t)nxt.pm * tstep : cA; const PG8_GAS char* nB = has_next ? (const PG8_GAS char*)g.Bt + (size_t)nxt.pn * tstep : cB;
        for (int t = 0; t < nt; t += 2) {
            const bool last = (t == nt - 2);
            const PG8_GAS char* a1 = cA + (size_t)(t + 1) * kstep;
            const PG8_GAS char* a2 = last ? nA : cA + (size_t)(t + 2) * kstep; const PG8_GAS char* b2 = last ? nB : cB + (size_t)(t + 2) * kstep;
            const PG8_GAS char* a3 = a2 + kstep; const PG8_GAS char* b3 = b2 + kstep;
            if (last && has_next) S.a_ready(nxt);
            if constexpr (SP2) {
            PG8_LDB(B0, 0, 0); PG8_LDB(B1, 0, 1); PG8_SCHED; PG8_LDA(At, 0, 0); PG8_STAGE(PG8_SA(1, 1), a1 + hstep, voffA);
            PG8_WAIT_V(8); PG8_WAIT_L(0); PG8_BAR; PG8_MMA(0, 0, At, B0); PG8_MMA(0, 1, At, B1); PG8_BAR; PG8_SCHED;
            PG8_LDA(At, 0, 1); PG8_STAGE(PG8_SB(0, 0), b2, voffB); PG8_STAGE(PG8_SB(0, 1), b2 + hstep, voffB); PG8_STAGE(PG8_SA(0, 0), a2, voffA);
            PG8_WAIT_V(8); PG8_WAIT_L(0); PG8_BAR; PG8_MMA(1, 0, At, B0); PG8_MMA(1, 1, At, B1); PG8_BAR; PG8_SCHED;
            PG8_LDB(B0, 1, 0); PG8_LDB(B1, 1, 1); PG8_SCHED; PG8_LDA(At, 1, 0); PG8_STAGE(PG8_SA(0, 1), a2 + hstep, voffA);
            PG8_WAIT_V(8); PG8_WAIT_L(0); PG8_BAR; PG8_MMA(0, 0, At, B0); PG8_MMA(0, 1, At, B1); PG8_BAR; PG8_SCHED;
            PG8_LDA(At, 1, 1); PG8_STAGE(PG8_SB(1, 0), b3, voffB); PG8_STAGE(PG8_SB(1, 1), b3 + hstep, voffB); PG8_STAGE(PG8_SA(1, 0), a3, voffA);
            PG8_WAIT_V(8); PG8_WAIT_L(0); PG8_BAR; PG8_MMA(1, 0, At, B0); PG8_MMA(1, 1, At, B1); PG8_BAR; PG8_SCHED;
            } else {
            PG8_LDB(B0, 0, 0); PG8_SCHED; PG8_LDA(At, 0, 0); PG8_STAGE(PG8_SA(1, 1), a1 + hstep, voffA);
            PG8_WAIT_L(8); PG8_BAR; PG8_WAIT_L(0); PG8_MMA(0, 0, At, B0); PG8_BAR; PG8_SCHED;
            PG8_LDB(B1, 0, 1); PG8_STAGE(PG8_SB(0, 0), b2, voffB);
            PG8_BAR; PG8_WAIT_L(0); PG8_MMA(0, 1, At, B1); PG8_BAR;
            PG8_LDA(At, 0, 1); PG8_STAGE(PG8_SA(0, 0), a2, voffA);
            PG8_BAR; PG8_WAIT_L(0); PG8_MMA(1, 0, At, B0); PG8_BAR; PG8_SCHED;
            PG8_STAGE(PG8_SB(0, 1), b2 + hstep, voffB);
            PG8_WAIT_V(6); PG8_BAR; PG8_MMA(1, 1, At, B1); PG8_BAR;
            PG8_LDB(B0, 1, 0); PG8_SCHED; PG8_LDA(At, 1, 0); PG8_STAGE(PG8_SA(0, 1), a2 + hstep, voffA);
            PG8_WAIT_L(8); PG8_BAR; PG8_WAIT_L(0); PG8_MMA(0, 0, At, B0); PG8_BAR; PG8_SCHED;
            PG8_LDB(B1, 1, 1); PG8_STAGE(PG8_SB(1, 0), b3, voffB);
            PG8_BAR; PG8_WAIT_L(0); PG8_MMA(0, 1, At, B1); PG8_BAR;
            PG8_LDA(At, 1, 1); PG8_STAGE(PG8_SA(1, 0), a3, voffA);
            PG8_BAR; PG8_WAIT_L(0); PG8_MMA(1, 0, At, B0); PG8_BAR; PG8_SCHED;
            PG8_STAGE(PG8_SB(1, 1), b3 + hstep, voffB);
            PG8_WAIT_V(6); PG8_BAR; PG8_MMA(1, 1, At, B1); PG8_BAR;
            }
        }
        if constexpr (ALIGN_EPI) { if (wr == 0) PG8_BAR; }
        if constexpr (!Epi::AFTER_DRAIN) { E(acc, cur, wr, wc, fr, fq); S.done(cur); }
        if (!has_next) break;
#pragma unroll
        for (int a = 0; a < 2; ++a)
#pragma unroll
            for (int b = 0; b < 2; ++b)
#pragma unroll
                for (int m = 0; m < 4; ++m)
#pragma unroll
                    for (int n = 0; n < 2; ++n) acc[a][b][m][n] = (f32x4){0.f, 0.f, 0.f, 0.f};
        cur = nxt; cA = nA; cB = nB; ++ui;
        if constexpr (ALIGN_EPI) { if (wr == 1) PG8_BAR; }
    }
    PG8_WAIT_V(0);
    if constexpr (!ALIGN_EPI) { if (wr == 0) PG8_BAR; }
    PG8_BAR;
    if constexpr (Epi::AFTER_DRAIN) { E.fused(acc, cur, wr, wc, fr, fq, lds, wid, lane); S.done(cur); }
#undef PG8_SA
#undef PG8_SB
#undef PG8_STAGE
#undef PG8_LDA
#undef PG8_LDB
#undef PG8_MMA
#undef PG8_WAIT_V
#undef PG8_WAIT_L
#undef PG8_BAR
#undef PG8_SCHED
}
}

constexpr int NB = 8, T = 4096, DM = 1024, M = NB * T, DEPTH = 2;
constexpr int NPROJ = 2912, NPROJP = 3072, DFF = 2816, NUP = 2 * DFF;
constexpr int C_CH = 0, C_CB = 256, C_CC = 512, C_R = 768, C_K = 1024, C_V = 1280, C_DEC = 1536, C_GDN = 1600, C_NQ = 1632, C_NK = 1888, C_NV = 2144, C_SU = 2400, C_SV = 2656;
constexpr float NORM_EPS = 1e-6f, GN_EPS = 64e-5f, DECAY_SCALE = 0.60653065971263342f;
constexpr int NWAVES = 8, NTHREADS = 512;
constexpr size_t MiB = 1u << 20;
constexpr size_t WS_CTL = 0, CTL_ZERO_BYTES = 1 * MiB;
constexpr size_t WS_RS = 1 * MiB;
constexpr size_t WS_PART = 1 * MiB + 256 * 1024;
constexpr size_t WS_W = 4 * MiB, W_LAYER = 24 * MiB + 512 * 1024;
constexpr size_t W_IN = 0, W_OUT = 6 * MiB, W_UP = 8 * MiB, W_DN = 19 * MiB;
constexpr size_t WS_XB = 53 * MiB;
constexpr size_t WS_R = 117 * MiB;
constexpr size_t WS_PROJ = WS_R, WS_MERGED = WS_R + 192 * MiB, WS_PREP = WS_R + 256 * MiB;
constexpr size_t GT_CHUNK = 12800, GT_DIR = (size_t)NB * 4 * 256 * GT_CHUNK;
constexpr size_t WS_GT0 = WS_PREP, WS_YSC0 = WS_PREP + 100 * MiB;
static_assert(GT_DIR == 100 * MiB, "GT size");
constexpr size_t WS_Y = WS_R;
constexpr size_t WS_G = WS_R, WS_L = WS_R + 176 * MiB;
constexpr size_t WS_END = 501 * MiB;
static_assert(WS_W + 2 * W_LAYER <= WS_XB && WS_PREP + 128 * MiB <= WS_END && WS_L + 176 * MiB <= WS_END && WS_PART + (size_t)M * 64 <= WS_W, "ws map");
constexpr int CW_BAR = 4096;
constexpr int CW_PANEL = 16384;
constexpr size_t WS_XS = WS_PART;
constexpr int RING_BYTES = 131072, LDSCTL_OFF = RING_BYTES, MISC_OFF = LDSCTL_OFF + 320, LDS_BYTES = 152576;

#define GAS __attribute__((address_space(1)))
#define LAS __attribute__((address_space(3)))
typedef unsigned short bf16;
typedef unsigned v4u __attribute__((ext_vector_type(4)));
typedef unsigned v2u __attribute__((ext_vector_type(2)));
typedef float f32x4 __attribute__((ext_vector_type(4)));
typedef short bf16x8 __attribute__((ext_vector_type(8)));
typedef short s16x4 __attribute__((ext_vector_type(4)));
typedef _Float16 h2 __attribute__((ext_vector_type(2)));
typedef GAS unsigned gu32;
#define RLX_AGENT __ATOMIC_RELAXED, __HIP_MEMORY_SCOPE_AGENT
__device__ __forceinline__ unsigned pk2(float lo, float hi) { return pg8::cvt_pk_bf16(lo, hi); }
__device__ __forceinline__ unsigned f2bf(float f) { return (unsigned)__builtin_bit_cast(unsigned short, (__bf16)f); }
__device__ __forceinline__ float bflo(unsigned w) { return __builtin_bit_cast(float, w << 16); }
__device__ __forceinline__ float bfhi(unsigned w) { return __builtin_bit_cast(float, w & 0xffff0000u); }
__device__ __forceinline__ float bf2f(unsigned short b) { return __builtin_bit_cast(float, (unsigned)b << 16); }
__device__ __forceinline__ h2 as_h2(unsigned u) { return __builtin_bit_cast(h2, u); }
template <int CTRL> __device__ __forceinline__ float dppmov(float x) { return __builtin_bit_cast(float, __builtin_amdgcn_update_dpp(0, __builtin_bit_cast(int, x), CTRL, 0xF, 0xF, true)); }
__device__ __forceinline__ float row16_sum(float x) { x += dppmov<0xB1>(x); x += dppmov<0x4E>(x); x += dppmov<0x141>(x); x += dppmov<0x140>(x); return x; }
typedef unsigned u32x2_t __attribute__((ext_vector_type(2)));
__device__ __forceinline__ float xor16_sum(float x) { const u32x2_t r = __builtin_amdgcn_permlane16_swap(__builtin_bit_cast(unsigned, x), __builtin_bit_cast(unsigned, x), false, false);
    const unsigned a = r.x, b = r.y; return __builtin_bit_cast(float, a) + __builtin_bit_cast(float, b); }
__device__ __forceinline__ float xor32_sum(float x) { const u32x2_t r = __builtin_amdgcn_permlane32_swap(__builtin_bit_cast(unsigned, x), __builtin_bit_cast(unsigned, x), false, false);
    const unsigned a = r.x, b = r.y; return __builtin_bit_cast(float, a) + __builtin_bit_cast(float, b); }
__device__ __forceinline__ float wave_sum(float v) { return xor32_sum(xor16_sum(row16_sum(v))); }
__device__ __forceinline__ float row16_max(float x) { x = fmaxf(x, dppmov<0xB1>(x)); x = fmaxf(x, dppmov<0x4E>(x)); x = fmaxf(x, dppmov<0x141>(x)); x = fmaxf(x, dppmov<0x140>(x)); return x; }
__device__ __forceinline__ float rcpf_(float x) { return __builtin_amdgcn_rcpf(x); }
__device__ __forceinline__ float rsqf_(float x) { return __builtin_amdgcn_rsqf(x); }
__device__ __forceinline__ float sigmoidf_(float x) { return rcpf_(1.f + __expf(-x)); }
__device__ __forceinline__ float tanhf_(float x) { return 1.f - 2.f * rcpf_(__expf(2.f * x) + 1.f); }
__device__ __forceinline__ float gelu_tanh(float x) { const float u = 1.5957691216057308f * x * (1.f + 0.044715f * x * x); return x * rcpf_(1.f + __expf(-u)); }
#define XB_TMO      128
#define XB_XCNT(j)  (256  + 64 * (j))
#define XB_XSUB(j)  (1280 + 64 * (j))
#define XB_XGEN(j)  (2304 + 64 * (j))
#define XB_TOP      3328
#define XB_TOPGEN   3392
#define XCD_BAR_WORDS 3456
#define XB_SPIN_CAP (1u << 18)

__device__ __forceinline__ unsigned xb_ld(unsigned* p)              { return __hip_atomic_load(p, __ATOMIC_RELAXED, __HIP_MEMORY_SCOPE_AGENT); }
__device__ __forceinline__ unsigned xb_add(unsigned* p, unsigned v) { return __hip_atomic_fetch_add(p, v, __ATOMIC_RELAXED, __HIP_MEMORY_SCOPE_AGENT); }
__device__ __forceinline__ unsigned xb_xcc_id() { return (unsigned)__builtin_amdgcn_s_getreg((3 << 11) | 20) & 0xFu; }
#define XB_SPIN(cond, bar) do { unsigned _sp = 0; while (cond) { __builtin_amdgcn_s_sleep(1); \
    if ((++_sp & 255u) == 0u) { if (xb_ld(&(bar)[XB_TMO])) break; if (_sp > XB_SPIN_CAP) { atomicAdd(&(bar)[XB_TMO], 1u); break; } } } } while (0)

struct XcdBarrier {
    unsigned* bar; unsigned x;
    volatile LAS unsigned* st;
};

__device__ __forceinline__ XcdBarrier xcd_barrier_post(unsigned* bar, volatile LAS unsigned* st) {
    XcdBarrier b; b.bar = bar; b.x = xb_xcc_id(); b.st = st;
    if (threadIdx.x == 0) (void)xb_add(&bar[XB_XCNT(b.x)], 1u);
    return b;
}
__device__ __forceinline__ void xcd_barrier_complete(unsigned* bar, unsigned x, unsigned& nloc, unsigned& nx) {
    const unsigned G = gridDim.x * gridDim.y * gridDim.z;
    unsigned sum, cnt, mine, sp = 0u;
    for (;;) {
        sum = 0u; cnt = 0u; mine = 0u;
#pragma unroll
        for (unsigned j = 0; j < 16; ++j) { const unsigned c = xb_ld(&bar[XB_XCNT(j)]); sum += c; cnt += (c > 0u) ? 1u : 0u; mine = (j == x) ? c : mine; }
        if (sum == G) break;
        __builtin_amdgcn_s_sleep(1);
        if ((++sp & 255u) == 0u) { if (xb_ld(&bar[XB_TMO])) break; if (sp > XB_SPIN_CAP) { atomicAdd(&bar[XB_TMO], 1u); break; } }
    }
    nloc = mine > 0u ? mine : 1u; nx = cnt > 0u ? cnt : 1u;
}

__device__ __forceinline__ void xcd_barrier(const XcdBarrier& b) {
    asm volatile("s_waitcnt vmcnt(0)" ::: "memory");
    __syncthreads();
    if (threadIdx.x == 0) {
        unsigned* bar = b.bar;
        __builtin_amdgcn_s_waitcnt(0);
        unsigned nloc = b.st[0], nx = b.st[1];
        if (nloc == 0u) { xcd_barrier_complete(bar, b.x, nloc, nx); b.st[0] = nloc; b.st[1] = nx; }
        const unsigned old = xb_add(&bar[XB_XSUB(b.x)], 1u);
        const unsigned gen = old / nloc;
        if (old + 1u == (gen + 1u) * nloc) {
            __builtin_amdgcn_fence(__ATOMIC_RELEASE, "agent");
            asm volatile("s_waitcnt vmcnt(0)" ::: "memory");
            const unsigned og = xb_add(&bar[XB_TOP], 1u);
            const unsigned tg = og / nx;
            if (og + 1u == (tg + 1u) * nx) xb_add(&bar[XB_TOPGEN], 1u);
            else XB_SPIN(xb_ld(&bar[XB_TOPGEN]) == tg, bar);
            __builtin_amdgcn_fence(__ATOMIC_ACQUIRE, "agent");
            xb_add(&bar[XB_XGEN(b.x)], 1u);
            asm volatile("s_waitcnt vmcnt(0)" ::: "memory");
        } else {
            XB_SPIN(xb_ld(&bar[XB_XGEN(b.x)]) == gen, bar);
            __builtin_amdgcn_fence(__ATOMIC_ACQUIRE, "agent");
            asm volatile("s_waitcnt vmcnt(0)" ::: "memory");
        }
    }
    __syncthreads();
}

typedef __attribute__((address_space(4))) const unsigned long long kq_t;
struct Frame {
    LAS unsigned char* lds;
    volatile LAS unsigned* MISC;
    gu32* ctl;
    int tid, lane, wave, vcu, G;
    kq_t* karg; GAS float* out; GAS unsigned char* ws;
};
#define INP(F, i) ((const GAS float*)(F).karg[(i)])
enum { I_X = 0, I_NMPRE, I_NMPOST, I_NFPRE, I_NFPOST, I_WIN, I_CONVW, I_RW0, I_RWUP, I_RA0, I_RAUP, I_RGUP, I_RKK, I_RKA, I_RRK, I_LNXW, I_LNXB, I_RPB, I_SGUN, I_SGUW, I_SGUB, I_MGAIN, I_WOUT, I_WUP, I_FCONV, I_WDN };
__device__ __forceinline__ int launder_u(int x) { asm volatile("" : "+v"(x)); return __builtin_amdgcn_readfirstlane(x); }
template <class P> __device__ __forceinline__ P launder_p(P p) { unsigned long long v = (unsigned long long)p; unsigned lo = (unsigned)v, hi = (unsigned)(v >> 32); asm volatile("" : "+v"(lo), "+v"(hi));
    lo = __builtin_amdgcn_readfirstlane(lo); hi = __builtin_amdgcn_readfirstlane(hi); return (P)(((unsigned long long)hi << 32) | lo); }
#define LAUNDER(F) do { asm volatile("" : "+v"((F).tid)); asm volatile("" : "+v"((F).lane)); (F).wave = launder_u((F).wave); (F).vcu = launder_u((F).vcu); (F).karg = launder_p((F).karg); (F).ws = launder_p((F).ws); (F).out = launder_p((F).out); } while (0)
#define LDS_WAIT() asm volatile("s_waitcnt lgkmcnt(0)" ::: "memory")
#define CFENCE() asm volatile("" ::: "memory")

__device__ __forceinline__ void p0_transpose_item(const GAS float* W, const GAS float* gain, int K, int N, GAS bf16* WT, LAS float* scr, int item, int lane, bool glmap = false) {
    const int nblk = N / 32, kb = item / nblk, nb = item % nblk, k0 = 64 * kb, n0 = 32 * nb;
    const int r0 = !glmap ? n0 : (n0 < N / 2 ? 256 * (n0 >> 7) + (n0 & 127) : 256 * ((n0 - N / 2) >> 7) + 128 + ((n0 - N / 2) & 127));
#pragma unroll 8
    for (int i = 0; i < 32; ++i) { const int kk = 2 * i + (lane >> 5); const float g = gain ? gain[k0 + kk] : 1.f; scr[kk * 33 + (lane & 31)] = W[(size_t)(k0 + kk) * N + n0 + (lane & 31)] * g; }
    LDS_WAIT(); CFENCE();
    const int c = lane & 7;
#pragma unroll
    for (int j = 0; j < 4; ++j) { const int n = (lane >> 3) + 8 * j; const LAS float* s = scr + (8 * c) * 33 + n;
        v4u o; o.x = pk2(s[0 * 33], s[1 * 33]); o.y = pk2(s[2 * 33], s[3 * 33]); o.z = pk2(s[4 * 33], s[5 * 33]); o.w = pk2(s[6 * 33], s[7 * 33]);
        *(GAS v4u*)(WT + (size_t)(r0 + n) * K + k0 + 8 * c) = o; }
    LDS_WAIT(); CFENCE();
}
__device__ __forceinline__ void row_to_bf16_rs(const GAS float* xrow, GAS bf16* orow, GAS float* rs, int lane) {
    const GAS f32x4* xr = (const GAS f32x4*)xrow + lane;
    f32x4 v[4]; float s = 0.f;
#pragma unroll
    for (int j = 0; j < 4; ++j) { v[j] = xr[64 * j]; s += (v[j].x * v[j].x + v[j].y * v[j].y) + (v[j].z * v[j].z + v[j].w * v[j].w); }
    s = wave_sum(s);
    GAS v2u* o8 = (GAS v2u*)orow + lane;
#pragma unroll
    for (int j = 0; j < 4; ++j) { v2u o; o.x = pk2(v[j].x, v[j].y); o.y = pk2(v[j].z, v[j].w); o8[64 * j] = o; }
    if (lane == 0) *rs = rsqf_(s * (1.f / DM) + NORM_EPS);
}
__device__ __forceinline__ void p0_prologue(Frame& F) {
    LAUNDER(F);
    LAS float* scr = (LAS float*)(F.lds + F.wave * 16384);
    const int gw = F.vcu * NWAVES + F.wave, NGW = F.G * NWAVES;
    constexpr int I_IN = (DM / 64) * (NPROJ / 32), I_OUT = (DM / 64) * (DM / 32), I_UP = (DM / 64) * (NUP / 32), I_DN = (DFF / 64) * (DM / 32), I_L = I_IN + I_OUT + I_UP + I_DN;
    for (int it = gw; it < DEPTH * I_L; it += NGW) {
        const int l = it / I_L; int r = it % I_L; GAS unsigned char* wl = F.ws + WS_W + (size_t)l * W_LAYER;
        if (r < I_IN) { p0_transpose_item(INP(F, I_WIN) + (size_t)l * DM * NPROJ, INP(F, I_NMPRE) + l * DM, DM, NPROJ, (GAS bf16*)(wl + W_IN), scr, r, F.lane); continue; } r -= I_IN;
        if (r < I_OUT) { p0_transpose_item(INP(F, I_WOUT) + (size_t)l * DM * DM, INP(F, I_MGAIN) + l * DM, DM, DM, (GAS bf16*)(wl + W_OUT), scr, r, F.lane); continue; } r -= I_OUT;
        if (r < I_UP) { p0_transpose_item(INP(F, I_WUP) + (size_t)l * DM * NUP, INP(F, I_NFPRE) + l * DM, DM, NUP, (GAS bf16*)(wl + W_UP), scr, r, F.lane, true); continue; } r -= I_UP;
        p0_transpose_item(INP(F, I_WDN) + (size_t)l * DFF * DM, nullptr, DFF, DM, (GAS bf16*)(wl + W_DN), scr, r, F.lane);
    }
    unsigned zz = 0u; asm volatile("" : "+v"(zz));
    for (int i = F.vcu * NTHREADS + F.tid; i < DEPTH * 20480; i += F.G * NTHREADS) { const int l = i / 20480, r = i % 20480;
        *(GAS v4u*)(F.ws + WS_W + (size_t)l * W_LAYER + W_IN + (size_t)NPROJ * DM * 2 + (size_t)r * 16) = (v4u){zz, zz, zz, zz}; }
    for (int m = gw; m < M; m += NGW) row_to_bf16_rs(INP(F, I_X) + (size_t)m * DM, (GAS bf16*)(F.ws + WS_XB) + (size_t)m * DM, (GAS float*)(F.ws + WS_RS) + m, F.lane);
}

typedef float f32x16 __attribute__((ext_vector_type(16)));
__device__ __forceinline__ void mix_convprep_tile(Frame& F, int l, int tile) {
    LAUNDER(F);
    const GAS bf16* proj = (const GAS bf16*)(F.ws + WS_PROJ); GAS bf16* merged = (GAS bf16*)(F.ws + WS_MERGED);
    const int m0 = tile * 64, bb = m0 / T, t0 = m0 % T;
    const int lane = F.lane, w = F.wave;
    {
        const int c4 = 4 * lane; const GAS float* cw = INP(F, I_CONVW) + l * 768;
        const f32x4 w0 = *(const f32x4*)(cw + c4), w1 = *(const f32x4*)(cw + 256 + c4), w2 = *(const f32x4*)(cw + 512 + c4);
        const int ts = t0 + 8 * w;
        v2u hr[10], cr[10], br[8];
#pragma unroll
        for (int j = 0; j < 10; ++j) { const int t = ts - 1 + j; const bool ok = (t >= 0 && t < T); const GAS bf16* row = proj + (size_t)(bb * T + (ok ? t : ts)) * NPROJP;
            hr[j] = *(const GAS v2u*)(row + C_CH + c4); cr[j] = *(const GAS v2u*)(row + C_CC + c4); if (!ok) { hr[j] = (v2u){0u, 0u}; } }
#pragma unroll
        for (int j = 0; j < 8; ++j) { const GAS bf16* row = proj + (size_t)(bb * T + ts + j) * NPROJP; br[j] = *(const GAS v2u*)(row + C_CB + c4); }
#pragma unroll
        for (int i = 0; i < 8; ++i) { const int t = ts + i;
            f32x4 z[3];
#pragma unroll
            for (int q = 0; q < 3; ++q) { const v2u h = hr[i + q], c = cr[i + q]; z[q] = (f32x4){bflo(h.x) * bflo(c.x), bfhi(h.x) * bfhi(c.x), bflo(h.y) * bflo(c.y), bfhi(h.y) * bfhi(c.y)}; }
            const v2u b = br[i];
            const f32x4 bv = (f32x4){bflo(b.x), bfhi(b.x), bflo(b.y), bfhi(b.y)};
            const f32x4 y = bv * (w0 * z[0] + w1 * z[1] + w2 * z[2]);
            float ss = (y.x * y.x + y.y * y.y) + (y.z * y.z + y.w * y.w); ss = wave_sum(ss);
            const float sc = rsqf_(ss * (1.f / 256.f) + NORM_EPS);
            v2u o; o.x = pk2(y.x * sc, y.y * sc); o.y = pk2(y.z * sc, y.w * sc);
            *(GAS v2u*)(merged + (size_t)(bb * T + t) * DM + 0 + c4) = o;
}
    }
}

__device__ __forceinline__ void mix_na_item(Frame& F, int l, int item, LAS unsigned char* wl, const LAS float* RPB) {
    LAUNDER(F);
    const GAS bf16* proj = (const GAS bf16*)(F.ws + WS_PROJ); GAS bf16* merged = (GAS bf16*)(F.ws + WS_MERGED);
    const int lane = F.lane, i = lane & 15, g = lane >> 4;
    const int qg = item & 3, r = (item >> 2) & 63, bb = item >> 8;
    const int c0 = 16 * qg;
    int rs = r - 4; rs = rs < 0 ? 0 : (rs > 56 ? 56 : rs);
    int cs = c0 - 8; cs = cs < 0 ? 0 : (cs > 32 ? 32 : cs);
    LAS unsigned char* PL = wl; LAS unsigned char* VL = wl + 4096; LAS unsigned char* OL = wl + 8192;
    const size_t rowbase = (size_t)bb * T;
    float ssq[4] = {0.f, 0.f, 0.f, 0.f};
#pragma unroll 1
    for (int h = 0; h < 4; ++h) {
        bf16x8 qf[2];
        { const GAS bf16* qrow = proj + (rowbase + r * 64 + c0 + i) * NPROJP + C_NQ + h * 64 + 8 * g;
          qf[0] = *(const GAS bf16x8*)(qrow); qf[1] = *(const GAS bf16x8*)(qrow + 32); }
        f32x4 s[16];
#pragma unroll
        for (int kt = 0; kt < 16; ++kt) { const int kr = kt >> 1, hf = kt & 1;
            const GAS bf16* krow = proj + (rowbase + (rs + kr) * 64 + cs + 16 * hf + i) * NPROJP + C_NK + h * 64 + 8 * g;
            const bf16x8 k0 = *(const GAS bf16x8*)(krow), k1 = *(const GAS bf16x8*)(krow + 32);
            f32x4 a = (f32x4){0.f, 0.f, 0.f, 0.f};
            a = __builtin_amdgcn_mfma_f32_16x16x32_bf16(qf[0], k0, a, 0, 0, 0);
            a = __builtin_amdgcn_mfma_f32_16x16x32_bf16(qf[1], k1, a, 0, 0, 0);
            s[kt] = a; }
        const GAS bf16* vsrc = proj + (rowbase + rs * 64 + cs + (lane >> 3)) * NPROJP + C_NV + h * 64 + 8 * (lane & 7);
        v4u vreg[4][4];
#pragma unroll
        for (int k4 = 0; k4 < 4; ++k4)
#pragma unroll
            for (int q = 0; q < 4; ++q) vreg[k4][q] = *(const GAS v4u*)(vsrc + (size_t)(k4 * 64 + 8 * q) * NPROJP);
        float mx[4] = {-3e38f, -3e38f, -3e38f, -3e38f};
#pragma unroll
        for (int kt = 0; kt < 16; ++kt) { const int kr = kt >> 1, hf = kt & 1; const int cw = cs + 16 * hf + i; const int dy = rs + kr - r + 7;
#pragma unroll
            for (int e = 0; e < 4; ++e) { const int cq = c0 + 4 * g + e; int st = cq - 8; st = st < 0 ? 0 : (st > 48 ? 48 : st);
                int dx = cw - cq; dx = dx < -15 ? -15 : (dx > 15 ? 15 : dx); dx += 15;
                const bool valid = (cw >= st) && (cw < st + 16);
                float v = s[kt][e] * 0.125f + RPB[h * 465 + dy * 31 + dx];
                v = valid ? v : -1e30f; s[kt][e] = v; mx[e] = fmaxf(mx[e], v); } }
        float sm[4];
#pragma unroll
        for (int e = 0; e < 4; ++e) { mx[e] = row16_max(mx[e]); sm[e] = 0.f; }
#pragma unroll
        for (int kt = 0; kt < 16; ++kt)
#pragma unroll
            for (int e = 0; e < 4; ++e) { const float p = __expf(s[kt][e] - mx[e]); s[kt][e] = p; sm[e] += p; }
#pragma unroll
        for (int e = 0; e < 4; ++e) sm[e] = rcpf_(row16_sum(sm[e]));
        f32x4 oh[4];
#pragma unroll
        for (int dt = 0; dt < 4; ++dt) oh[dt] = (f32x4){0.f, 0.f, 0.f, 0.f};
#pragma unroll
        for (int half = 0; half < 2; ++half) {
            CFENCE();
#pragma unroll
            for (int k8 = 0; k8 < 8; ++k8) { const int kt = 8 * half + k8; v2u pw; pw.x = pk2(s[kt][0] * sm[0], s[kt][1] * sm[1]); pw.y = pk2(s[kt][2] * sm[2], s[kt][3] * sm[3]);
                *(LAS v2u*)(PL + (16 * k8 + i) * 32 + 8 * g) = pw; }
            CFENCE();
#pragma unroll
            for (int k4 = 0; k4 < 4; ++k4) { const int kr = 4 * half + k4;
                CFENCE();
#pragma unroll
                for (int q = 0; q < 4; ++q) *(LAS v4u*)(VL + ((lane >> 3) + 8 * q) * 128 + (lane & 7) * 16) = vreg[k4][q];
                if (half == 0) {
#pragma unroll
                    for (int q = 0; q < 4; ++q) vreg[k4][q] = *(const GAS v4u*)(vsrc + (size_t)((kr + 4) * 64 + 8 * q) * NPROJP); }
                CFENCE();
                const LAS unsigned char* pa = PL + (32 * k4 + 8 * g + (i >> 2)) * 32 + 8 * (i & 3);
                const s16x4 plo = __builtin_bit_cast(s16x4, __builtin_amdgcn_ds_read_tr16_b64_v4i16((LAS s16x4*)(pa)));
                const s16x4 phi = __builtin_bit_cast(s16x4, __builtin_amdgcn_ds_read_tr16_b64_v4i16((LAS s16x4*)(pa + 128)));
                const bf16x8 pf = (bf16x8){plo[0], plo[1], plo[2], plo[3], phi[0], phi[1], phi[2], phi[3]};
#pragma unroll
                for (int dt = 0; dt < 4; ++dt) {
                    const LAS unsigned char* va = VL + (8 * g + (i >> 2)) * 128 + (16 * dt + 4 * (i & 3)) * 2;
                    const s16x4 vlo = __builtin_bit_cast(s16x4, __builtin_amdgcn_ds_read_tr16_b64_v4i16((LAS s16x4*)(va)));
                    const s16x4 vhi = __builtin_bit_cast(s16x4, __builtin_amdgcn_ds_read_tr16_b64_v4i16((LAS s16x4*)(va + 512)));
                    const bf16x8 vf = (bf16x8){vlo[0], vlo[1], vlo[2], vlo[3], vhi[0], vhi[1], vhi[2], vhi[3]};
                    oh[dt] = __builtin_amdgcn_mfma_f32_16x16x32_bf16(pf, vf, oh[dt], 0, 0, 0); }
            }
        }
        CFENCE();
#pragma unroll
        for (int dt = 0; dt < 4; ++dt)
#pragma unroll
            for (int e = 0; e < 4; ++e) { ssq[e] += oh[dt][e] * oh[dt][e]; *(LAS unsigned short*)(OL + (4 * g + e) * 512 + (h * 64 + 16 * dt + i) * 2) = (unsigned short)f2bf(oh[dt][e]); }
        CFENCE();
    }
    LAS float* SCL = (LAS float*)VL;
    CFENCE();
#pragma unroll
    for (int e = 0; e < 4; ++e) { const float sc = rsqf_(row16_sum(ssq[e]) * (1.f / 256.f) + NORM_EPS); if (i == 0) SCL[4 * g + e] = sc; }
    CFENCE();
#pragma unroll
    for (int q = 0; q < 8; ++q) { const int e = lane + 64 * q, row = e >> 5, ch = e & 31;
        const v4u v = *(const LAS v4u*)(OL + row * 512 + ch * 16); const float sc = SCL[row];
        v4u o;
#pragma unroll
        for (int t = 0; t < 4; ++t) o[t] = pk2(bflo(v[t]) * sc, bfhi(v[t]) * sc);
        *(GAS v4u*)(merged + (rowbase + r * 64 + c0 + row) * DM + 512 + 8 * ch) = o; }
    CFENCE();
}

constexpr int SG_PITCH = 528;
__device__ __forceinline__ void mix_sgu_item(Frame& F, int l, int item) {
    LAUNDER(F);
    const GAS bf16* proj = (const GAS bf16*)(F.ws + WS_PROJ); GAS bf16* merged = (GAS bf16*)(F.ws + WS_MERGED);
    const int lane = F.lane, w = F.wave, tid = F.tid, i = lane & 15, g = lane >> 4;
    const size_t m0 = (size_t)item * 128;
    LAS unsigned char* VI = F.lds; LAS float* SS = (LAS float*)(F.lds + 128 * SG_PITCH);
    { const int c4 = 4 * lane; const f32x4 gn = *(const f32x4*)(INP(F, I_SGUN) + l * 256 + c4);
      v2u xr[16];
#pragma unroll
      for (int j = 0; j < 16; ++j) xr[j] = *(const GAS v2u*)(proj + (m0 + 16 * w + j) * NPROJP + C_SV + c4);
#pragma unroll
      for (int j = 0; j < 16; ++j) { const int q = 16 * w + j; const v2u x = xr[j];
          f32x4 v = (f32x4){gelu_tanh(bflo(x.x)), gelu_tanh(bfhi(x.x)), gelu_tanh(bflo(x.y)), gelu_tanh(bfhi(x.y))};
          const float mu = wave_sum((v.x + v.y) + (v.z + v.w)) * (1.f / 256.f);
          v = v - mu;
          const float var = wave_sum((v.x * v.x + v.y * v.y) + (v.z * v.z + v.w * v.w)) * (1.f / 256.f);
          const float rstd = rsqf_(var + NORM_EPS);
          v2u o; o.x = pk2(v.x * rstd * gn.x, v.y * rstd * gn.y); o.y = pk2(v.z * rstd * gn.z, v.w * rstd * gn.w);
          *(LAS v2u*)(VI + q * SG_PITCH + c4 * 2) = o; } }
    __syncthreads();
    const int hh = w >> 1, ph = w & 1;
    f32x4 acc[4][4];
#pragma unroll
    for (int a = 0; a < 4; ++a)
#pragma unroll
        for (int b = 0; b < 4; ++b) acc[a][b] = (f32x4){0.f, 0.f, 0.f, 0.f};
    const GAS float* ws_ = INP(F, I_SGUW) + ((size_t)(l * 4 + hh) * 128) * 128;
#pragma unroll
    for (int ks = 0; ks < 4; ++ks) {
        bf16x8 af[4], bfr[4];
#pragma unroll
        for (int pt = 0; pt < 4; ++pt) { const GAS float* ap = ws_ + (size_t)(64 * ph + 16 * pt + i) * 128 + 32 * ks + 8 * g;
            const f32x4 x0 = *(const f32x4*)ap, x1 = *(const f32x4*)(ap + 4);
            const unsigned u0 = pk2(x0.x, x0.y), u1 = pk2(x0.z, x0.w), u2 = pk2(x1.x, x1.y), u3 = pk2(x1.z, x1.w);
            af[pt] = __builtin_bit_cast(bf16x8, (v4u){u0, u1, u2, u3}); }
#pragma unroll
        for (int dt = 0; dt < 4; ++dt) { const LAS unsigned char* va = VI + (32 * ks + 8 * g + (i >> 2)) * SG_PITCH + (hh * 64 + 16 * dt + 4 * (i & 3)) * 2;
            const s16x4 lo = __builtin_bit_cast(s16x4, __builtin_amdgcn_ds_read_tr16_b64_v4i16((LAS s16x4*)(va)));
            const s16x4 hi = __builtin_bit_cast(s16x4, __builtin_amdgcn_ds_read_tr16_b64_v4i16((LAS s16x4*)(va + 4 * SG_PITCH)));
            bfr[dt] = (bf16x8){lo[0], lo[1], lo[2], lo[3], hi[0], hi[1], hi[2], hi[3]}; }
#pragma unroll
        for (int pt = 0; pt < 4; ++pt)
#pragma unroll
            for (int dt = 0; dt < 4; ++dt) acc[pt][dt] = __builtin_amdgcn_mfma_f32_16x16x32_bf16(af[pt], bfr[dt], acc[pt][dt], 0, 0, 0);
    }
#pragma unroll
    for (int pt = 0; pt < 4; ++pt) {
        unsigned short ur[4][4];
#pragma unroll
        for (int e = 0; e < 4; ++e)
#pragma unroll
            for (int dt = 0; dt < 4; ++dt) ur[e][dt] = proj[(m0 + 64 * ph + 16 * pt + 4 * g + e) * NPROJP + C_SU + hh * 64 + 16 * dt + i];
#pragma unroll
        for (int e = 0; e < 4; ++e) { const int p = 64 * ph + 16 * pt + 4 * g + e; const float bs = INP(F, I_SGUB)[(l * 4 + hh) * 128 + p]; float ss = 0.f;
#pragma unroll
            for (int dt = 0; dt < 4; ++dt) { const float u = gelu_tanh(bf2f(ur[e][dt]));
                const float v = u * (acc[pt][dt][e] + bs); acc[pt][dt][e] = v; ss += v * v; }
            ss = row16_sum(ss); if (i == 0) SS[p * 4 + hh] = ss; } }
    __syncthreads();
#pragma unroll
    for (int pt = 0; pt < 4; ++pt)
#pragma unroll
        for (int e = 0; e < 4; ++e) { const int p = 64 * ph + 16 * pt + 4 * g + e; const f32x4 s4 = *(const LAS f32x4*)(SS + p * 4);
            const float sc = rsqf_(((s4.x + s4.y) + (s4.z + s4.w)) * (1.f / 256.f) + NORM_EPS);
#pragma unroll
            for (int dt = 0; dt < 4; ++dt) *(LAS unsigned short*)(VI + p * SG_PITCH + (hh * 64 + 16 * dt + i) * 2) = (unsigned short)f2bf(acc[pt][dt][e] * sc); }
    __syncthreads();
#pragma unroll
    for (int q = 0; q < 8; ++q) { const int e = tid + 512 * q, row = e >> 5, ch = e & 31;
        const v4u v = *(const LAS v4u*)(VI + row * SG_PITCH + ch * 16);
        *(GAS v4u*)(merged + (m0 + row) * DM + 768 + 8 * ch) = v; }
    __syncthreads();
}

__device__ __forceinline__ void phase_mix_na(Frame& F, int l, int bidx, int nblk) {
    LAUNDER(F);
    LAS float* RPB = (LAS float*)(F.lds + RING_BYTES + 1024);
    for (int q = F.tid; q < 4 * 465; q += NTHREADS) RPB[q] = INP(F, I_RPB)[l * 4 * 465 + q];
    __syncthreads();
    for (int it = bidx * NWAVES + F.wave; it < NB * 64 * 4; it += nblk * NWAVES) mix_na_item(F, l, it, F.lds + F.wave * 16384, RPB);
    __syncthreads();
#ifdef SGU_IN_C2
    for (int it = bidx; it < NB * 32; it += nblk) mix_sgu_item(F, l, it);
#endif
}
__device__ __forceinline__ void phase_mixers(Frame& F, int l) {
    LAUNDER(F);
    for (int tile = F.vcu; tile < M / 64; tile += F.G) mix_convprep_tile(F, l, tile);
    __syncthreads();
#ifndef SGU_IN_C2
    for (int it = F.vcu; it < NB * 32; it += F.G) mix_sgu_item(F, l, it);
#endif
}

constexpr int C1_RES = 65536, C1_RES_D = 15616;
constexpr int C1_ZT = 0, C1_ET = 4096, C1_QT = 8192, C1_CT = 12288, C1_DA = 13312, C1_UH = 13568;
constexpr int C1_IMG = 0, C1_IMG_D = 16384, C1_SC = 0, C1_SCST = 144, C1_CM = 9216, C1_DM = 15360, C1_DL = 15616;
typedef _Float16 h4 __attribute__((ext_vector_type(4)));
typedef _Float16 h8 __attribute__((ext_vector_type(8)));
__device__ __forceinline__ bf16x8 pack8(f32x4 lo, f32x4 hi) { return __builtin_bit_cast(bf16x8, (v4u){pg8::cvt_pk_bf16(lo.x, lo.y), pg8::cvt_pk_bf16(lo.z, lo.w), pg8::cvt_pk_bf16(hi.x, hi.y), pg8::cvt_pk_bf16(hi.z, hi.w)}); }
template <int MODE>
__device__ __forceinline__ void phase_scan_c1(Frame& F, int l) {
    LAUNDER(F);
    const GAS bf16* proj = (const GAS bf16*)(F.ws + WS_PROJ);
    const int lane = F.lane, w = F.wave, i = lane & 15, g = lane >> 4;
    const int d = w >> 2, wa = w & 3;
    const int bh = F.vcu >> 3, bb = bh >> 2, h = bh & 3;
    LAS unsigned char* lds = F.lds;
    bf16x8 Bw, Ba;
    { f32x4 xw0 = (f32x4){0.f, 0.f, 0.f, 0.f}, xw1 = xw0, xa0 = xw0, xa1 = xw0;
      if (g < 2) { const GAS float* pw = INP(F, I_RWUP) + ((size_t)(l * 2 + d) * 16 + 8 * g) * 256 + h * 64 + 16 * wa + i; const GAS float* pa = INP(F, I_RAUP) + ((size_t)(l * 2 + d) * 16 + 8 * g) * 256 + h * 64 + 16 * wa + i;
          xw0 = (f32x4){pw[0], pw[256], pw[512], pw[768]}; xw1 = (f32x4){pw[1024], pw[1280], pw[1536], pw[1792]};
          xa0 = (f32x4){pa[0], pa[256], pa[512], pa[768]}; xa1 = (f32x4){pa[1024], pa[1280], pa[1536], pa[1792]}; }
      Bw = pack8(xw0, xw1); Ba = pack8(xa0, xa1); }
    const float w0c = INP(F, I_RW0)[(l * 2 + d) * 256 + h * 64 + 16 * wa + i], a0c = INP(F, I_RA0)[(l * 2 + d) * 256 + h * 64 + 16 * wa + i], kag = INP(F, I_RKA)[l * 256 + h * 64 + 16 * wa + i];
    float kkg[4];
#pragma unroll
    for (int t = 0; t < 4; ++t) kkg[t] = INP(F, I_RKK)[l * 256 + h * 64 + 16 * t + i];
    const float kkgw = INP(F, I_RKK)[l * 256 + h * 64 + 16 * wa + i];
    const int c = 16 * wa + i;
    const int sq = d ? 3 - g : g;
#define C1_BAR() do { asm volatile("s_waitcnt lgkmcnt(0)" ::: "memory"); __builtin_amdgcn_s_barrier(); asm volatile("" ::: "memory"); } while (0)
    unsigned short kq[4][4], kown[4], rq[4]; v4u dvr, ivr;
#define C1_LOAD(B_) do { const size_t m0_ = (size_t)bb * T + 16 * (B_); \
        _Pragma("unroll") for (int e_ = 0; e_ < 4; ++e_) { const GAS bf16* row_ = proj + (m0_ + 4 * g + e_) * NPROJP; \
            _Pragma("unroll") for (int t_ = 0; t_ < 4; ++t_) kq[t_][e_] = row_[C_K + h * 64 + 16 * t_ + i]; \
            rq[e_] = row_[C_R + h * 64 + 16 * wa + i]; kown[e_] = row_[C_K + h * 64 + 16 * wa + i]; } \
        { const GAS bf16* arow_ = proj + (m0_ + i) * NPROJP + C_DEC + 16 * d + 8 * (g & 1); dvr = *(const GAS v4u*)(arow_); ivr = *(const GAS v4u*)(arow_ + 32); } } while (0)
    const int B0 = (F.vcu & 7) * 32;
    C1_LOAD(B0);
    {
        const int it = 0;
        { const int B = B0 + it; LAS unsigned char* IMG = lds + C1_IMG + ((it & 1) * 2 + d) * C1_IMG_D; (void)B;
        if (MODE != 3) {
            v4u dv = (v4u){0u, 0u, 0u, 0u}, iv = dv;
            if (g < 2) { iv = ivr;
#pragma unroll
                for (int q = 0; q < 4; ++q) dv[q] = pk2(tanhf_(bflo(dvr[q])), tanhf_(bfhi(dvr[q]))); }
            const f32x4 z4 = (f32x4){0.f, 0.f, 0.f, 0.f};
            const f32x4 Dw = __builtin_amdgcn_mfma_f32_16x16x32_bf16(__builtin_bit_cast(bf16x8, dv), Bw, z4, 0, 0, 0);
            const f32x4 Da = __builtin_amdgcn_mfma_f32_16x16x32_bf16(__builtin_bit_cast(bf16x8, iv), Ba, z4, 0, 0, 0);
            float vw[4], vk[4], vb[4], ve[4], vr[4];
#pragma unroll
            for (int e = 0; e < 4; ++e) {
                float ss = 0.f;
#pragma unroll
                for (int t = 0; t < 4; ++t) { const float x = bf2f(kq[t][e]) * kkg[t]; ss += x * x; }
                ss = row16_sum(ss);
                const float k = bf2f(kown[e]); const float kk = k * kkgw * rsqf_(ss + 1e-12f);
                const float wv = __expf(-DECAY_SCALE * sigmoidf_(w0c + Dw[e])), av = sigmoidf_(a0c + Da[e]);
                vw[e] = wv; vk[e] = kk; vb[e] = kk * av; ve[e] = k * (1.f + (av - 1.f) * kag); vr[e] = bf2f(rq[e]); }
            if (d) {
#define C1_SWAP(a_) do { float t0_ = a_[0], t1_ = a_[1]; a_[0] = a_[3]; a_[1] = a_[2]; a_[2] = t1_; a_[3] = t0_; } while (0)
                C1_SWAP(vw); C1_SWAP(vk); C1_SWAP(vb); C1_SWAP(ve); C1_SWAP(vr);
#undef C1_SWAP
            }
            float Dp[4], Dt[4];
            const float c1 = vw[0], c2 = c1 * vw[1], c3 = c2 * vw[2], c4 = c3 * vw[3];
            const float q0 = __shfl(c4, (d ? 48 : 0) + i), q1 = __shfl(c4, (d ? 32 : 16) + i), q2 = __shfl(c4, (d ? 16 : 32) + i);
            const float Dm = q0 * q1;
            const float off = sq == 0 ? 1.f : (sq == 1 ? q0 : (sq == 2 ? Dm : Dm * q2));
            Dp[0] = off; Dp[1] = off * c1; Dp[2] = off * c2; Dp[3] = off * c3;
            Dt[0] = Dp[1]; Dt[1] = Dp[2]; Dt[2] = Dp[3]; Dt[3] = off * c4;
            const float rDm = rcpf_(Dm);
            h4 hk, hb, he;
#pragma unroll
            for (int e = 0; e < 4; ++e) { const float rDt = rcpf_(Dt[e]);
                const float kap = vk[e] * Dp[e] * rDm, rr = vr[e] * Dt[e] * rDm, bq = vb[e] * Dm * rDt, eq = ve[e] * Dm * rDt;
                const int s = 4 * sq + e;
                ((LAS _Float16*)(IMG + C1_SC + (0 * 16 + s) * C1_SCST))[c] = (_Float16)kap; ((LAS _Float16*)(IMG + C1_SC + (1 * 16 + s) * C1_SCST))[c] = (_Float16)rr;
                ((LAS _Float16*)(IMG + C1_SC + (2 * 16 + s) * C1_SCST))[c] = (_Float16)bq;  ((LAS _Float16*)(IMG + C1_SC + (3 * 16 + s) * C1_SCST))[c] = (_Float16)eq;
                hk[e] = (_Float16)kap; hb[e] = (_Float16)bq; he[e] = (_Float16)eq; }
            *(LAS h4*)(IMG + C1_CM + c * 96 + 0 + sq * 8) = hk; *(LAS h4*)(IMG + C1_CM + c * 96 + 32 + sq * 8) = hb; *(LAS h4*)(IMG + C1_CM + c * 96 + 64 + sq * 8) = he;
            if (sq == 3) *(LAS float*)(IMG + C1_DL + c * 4) = Dt[3];
            if (sq == 0) *(LAS float*)(IMG + C1_DM + c * 4) = Dm;
        }
        }
        if (it + 1 < 32) C1_LOAD(B0 + it + 1);
        C1_BAR();
    }
    {
        const int it = 1;
        { const int B = B0 + it; LAS unsigned char* IMG = lds + C1_IMG + ((it & 1) * 2 + d) * C1_IMG_D; (void)B;
        if (MODE != 3) {
            v4u dv = (v4u){0u, 0u, 0u, 0u}, iv = dv;
            if (g < 2) { iv = ivr;
#pragma unroll
                for (int q = 0; q < 4; ++q) dv[q] = pk2(tanhf_(bflo(dvr[q])), tanhf_(bfhi(dvr[q]))); }
            const f32x4 z4 = (f32x4){0.f, 0.f, 0.f, 0.f};
            const f32x4 Dw = __builtin_amdgcn_mfma_f32_16x16x32_bf16(__builtin_bit_cast(bf16x8, dv), Bw, z4, 0, 0, 0);
            const f32x4 Da = __builtin_amdgcn_mfma_f32_16x16x32_bf16(__builtin_bit_cast(bf16x8, iv), Ba, z4, 0, 0, 0);
            float vw[4], vk[4], vb[4], ve[4], vr[4];
#pragma unroll
            for (int e = 0; e < 4; ++e) {
                float ss = 0.f;
#pragma unroll
                for (int t = 0; t < 4; ++t) { const float x = bf2f(kq[t][e]) * kkg[t]; ss += x * x; }
                ss = row16_sum(ss);
                const float k = bf2f(kown[e]); const float kk = k * kkgw * rsqf_(ss + 1e-12f);
                const float wv = __expf(-DECAY_SCALE * sigmoidf_(w0c + Dw[e])), av = sigmoidf_(a0c + Da[e]);
                vw[e] = wv; vk[e] = kk; vb[e] = kk * av; ve[e] = k * (1.f + (av - 1.f) * kag); vr[e] = bf2f(rq[e]); }
            if (d) {
#define C1_SWAP(a_) do { float t0_ = a_[0], t1_ = a_[1]; a_[0] = a_[3]; a_[1] = a_[2]; a_[2] = t1_; a_[3] = t0_; } while (0)
                C1_SWAP(vw); C1_SWAP(vk); C1_SWAP(vb); C1_SWAP(ve); C1_SWAP(vr);
#undef C1_SWAP
            }
            float Dp[4], Dt[4];
            const float c1 = vw[0], c2 = c1 * vw[1], c3 = c2 * vw[2], c4 = c3 * vw[3];
            const float q0 = __shfl(c4, (d ? 48 : 0) + i), q1 = __shfl(c4, (d ? 32 : 16) + i), q2 = __shfl(c4, (d ? 16 : 32) + i);
            const float Dm = q0 * q1;
            const float off = sq == 0 ? 1.f : (sq == 1 ? q0 : (sq == 2 ? Dm : Dm * q2));
            Dp[0] = off; Dp[1] = off * c1; Dp[2] = off * c2; Dp[3] = off * c3;
            Dt[0] = Dp[1]; Dt[1] = Dp[2]; Dt[2] = Dp[3]; Dt[3] = off * c4;
            const float rDm = rcpf_(Dm);
            h4 hk, hb, he;
#pragma unroll
            for (int e = 0; e < 4; ++e) { const float rDt = rcpf_(Dt[e]);
                const float kap = vk[e] * Dp[e] * rDm, rr = vr[e] * Dt[e] * rDm, bq = vb[e] * Dm * rDt, eq = ve[e] * Dm * rDt;
                const int s = 4 * sq + e;
                ((LAS _Float16*)(IMG + C1_SC + (0 * 16 + s) * C1_SCST))[c] = (_Float16)kap; ((LAS _Float16*)(IMG + C1_SC + (1 * 16 + s) * C1_SCST))[c] = (_Float16)rr;
                ((LAS _Float16*)(IMG + C1_SC + (2 * 16 + s) * C1_SCST))[c] = (_Float16)bq;  ((LAS _Float16*)(IMG + C1_SC + (3 * 16 + s) * C1_SCST))[c] = (_Float16)eq;
                hk[e] = (_Float16)kap; hb[e] = (_Float16)bq; he[e] = (_Float16)eq; }
            *(LAS h4*)(IMG + C1_CM + c * 96 + 0 + sq * 8) = hk; *(LAS h4*)(IMG + C1_CM + c * 96 + 32 + sq * 8) = hb; *(LAS h4*)(IMG + C1_CM + c * 96 + 64 + sq * 8) = he;
            if (sq == 3) *(LAS float*)(IMG + C1_DL + c * 4) = Dt[3];
            if (sq == 0) *(LAS float*)(IMG + C1_DM + c * 4) = Dm;
        }
        }
        if (it + 1 < 32) C1_LOAD(B0 + it + 1);
        { const LAS unsigned char* IMG = lds + C1_IMG + (((it - 1) & 1) * 2 + d) * C1_IMG_D; LAS unsigned char* R = lds + C1_RES + (((it - 1) & 1) * 2 + d) * C1_RES_D;
        if (MODE != 1 && MODE != 4) {
            h8 fk[2], fr[2], fb[2], fe[2];
#pragma unroll
            for (int ks = 0; ks < 2; ++ks) { const LAS unsigned char* p = IMG + C1_SC + i * C1_SCST + (8 * g + 32 * ks) * 2;
                fk[ks] = *(const LAS h8*)(p); fr[ks] = *(const LAS h8*)(p + 16 * C1_SCST); fb[ks] = *(const LAS h8*)(p + 32 * C1_SCST); fe[ks] = *(const LAS h8*)(p + 48 * C1_SCST); }
            const f32x4 z4 = (f32x4){0.f, 0.f, 0.f, 0.f};
            f32x4 aN = z4, aNT = z4, aM = z4, aMT = z4, aNr = z4, aMr = z4;
#pragma unroll
            for (int ks = 0; ks < 2; ++ks) {
                aN  = __builtin_amdgcn_mfma_f32_16x16x32_f16(fb[ks], fk[ks], aN, 0, 0, 0);  aNT = __builtin_amdgcn_mfma_f32_16x16x32_f16(fk[ks], fb[ks], aNT, 0, 0, 0);
                aM  = __builtin_amdgcn_mfma_f32_16x16x32_f16(fe[ks], fk[ks], aM, 0, 0, 0);  aMT = __builtin_amdgcn_mfma_f32_16x16x32_f16(fk[ks], fe[ks], aMT, 0, 0, 0);
                aNr = __builtin_amdgcn_mfma_f32_16x16x32_f16(fb[ks], fr[ks], aNr, 0, 0, 0); aMr = __builtin_amdgcn_mfma_f32_16x16x32_f16(fe[ks], fr[ks], aMr, 0, 0, 0); }
#pragma unroll
            for (int e = 0; e < 4; ++e) { const int row = 4 * g + e;
                aN[e] = row < i ? -aN[e] : 0.f; aNT[e] = i < row ? -aNT[e] : 0.f; aM[e] = row < i ? aM[e] : 0.f; aMT[e] = i < row ? aMT[e] : 0.f;
                aNr[e] = row <= i ? aNr[e] : 0.f; aMr[e] = row <= i ? aMr[e] : 0.f; }
#define C1_H4(x_) __builtin_convertvector((x_), h4)
#define C1_MM(a_, b_, c_) __builtin_amdgcn_mfma_f32_16x16x16f16((a_), (b_), (c_), 0, 0, 0)
            f32x4 S = aN, ST = aNT;
#pragma unroll
            for (int e = 0; e < 4; ++e) if (4 * g + e == i) { S[e] += 1.f; ST[e] += 1.f; }
            const h4 hA = C1_H4(aN), hAT = C1_H4(aNT);
            const f32x4 P2 = C1_MM(hAT, hA, z4), P2T = C1_MM(hA, hAT, z4);
            const h4 hP2 = C1_H4(P2), hP2T = C1_H4(P2T);
            { const h4 hS = C1_H4(S); S = C1_MM(hP2T, hS, S); ST = C1_MM(hS, hP2T, ST); }
            const f32x4 P4 = C1_MM(hP2T, hP2, z4), P4T = C1_MM(hP2, hP2T, z4);
            const h4 hP4 = C1_H4(P4), hP4T = C1_H4(P4T);
            { const h4 hS = C1_H4(S); S = C1_MM(hP4T, hS, S); ST = C1_MM(hS, hP4T, ST); }
            const f32x4 P8T = C1_MM(hP4, hP4T, z4);
            const h4 hP8T = C1_H4(P8T);
            { const h4 hS = C1_H4(S); ST = C1_MM(hS, hP8T, ST); }
            const h4 hTT = C1_H4(ST), hMT = C1_H4(aMT);
            const f32x4 X1 = C1_MM(hTT, C1_H4(aNr), z4);
            const h4 hX1 = C1_H4(X1);
            const h4 bT = *(const LAS h4*)(IMG + C1_CM + c * 96 + 32 + g * 8);
            const f32x4 X2 = C1_MM(hTT, bT, z4);
            const float dl = *(const LAS float*)(IMG + C1_DL + c * 4), dm = *(const LAS float*)(IMG + C1_DM + c * 4);
            *(LAS f32x4*)(R + C1_ZT + c * 64 + 16 * g) = X2 * dl;
            const f32x4 Ea = C1_MM(hMT, C1_H4(X2), z4);
            const h4 kh = *(const LAS h4*)(IMG + C1_CM + c * 96 + 64 + g * 8);
            *(LAS f32x4*)(R + C1_ET + c * 64 + 16 * g) = (__builtin_convertvector(kh, f32x4) - Ea) * (dl * rcpf_(dm));
            const h4 kT = *(const LAS h4*)(IMG + C1_CM + c * 96 + g * 8);
            const f32x4 Qa = C1_MM(kT, hX1, z4);
            const h4 rh = *(const LAS h4*)(IMG + C1_SC + (16 + i) * C1_SCST + (16 * wa + 4 * g) * 2);
            const f32x4 dm4 = *(const LAS f32x4*)(IMG + C1_DM + (16 * wa + 4 * g) * 4);
            *(LAS f32x4*)(R + C1_QT + i * 256 + (16 * wa + 4 * g) * 4) = (__builtin_convertvector(rh, f32x4) - Qa) * dm4;
            if (wa == 0) { const f32x4 Ca = C1_MM(hMT, hX1, z4); *(LAS f32x4*)(R + C1_CT + i * 64 + 16 * g) = aMr - Ca; }
            *(LAS h4*)(R + C1_UH + c * 32 + 8 * g) = kT;
            if (g == 0) *(LAS float*)(R + C1_DA + c * 4) = dl;
#undef C1_H4
#undef C1_MM
        }
        }
        C1_BAR();
    }
    for (int itv = 2; itv < 32; ++itv)
    {
        const int it = itv;
        { const int B = B0 + it; LAS unsigned char* IMG = lds + C1_IMG + ((it & 1) * 2 + d) * C1_IMG_D; (void)B;
        if (MODE != 3) {
            v4u dv = (v4u){0u, 0u, 0u, 0u}, iv = dv;
            if (g < 2) { iv = ivr;
#pragma unroll
                for (int q = 0; q < 4; ++q) dv[q] = pk2(tanhf_(bflo(dvr[q])), tanhf_(bfhi(dvr[q]))); }
            const f32x4 z4 = (f32x4){0.f, 0.f, 0.f, 0.f};
            const f32x4 Dw = __builtin_amdgcn_mfma_f32_16x16x32_bf16(__builtin_bit_cast(bf16x8, dv), Bw, z4, 0, 0, 0);
            const f32x4 Da = __builtin_amdgcn_mfma_f32_16x16x32_bf16(__builtin_bit_cast(bf16x8, iv), Ba, z4, 0, 0, 0);
            float vw[4], vk[4], vb[4], ve[4], vr[4];
#pragma unroll
            for (int e = 0; e < 4; ++e) {
                float ss = 0.f;
#pragma unroll
                for (int t = 0; t < 4; ++t) { const float x = bf2f(kq[t][e]) * kkg[t]; ss += x * x; }
                ss = row16_sum(ss);
                const float k = bf2f(kown[e]); const float kk = k * kkgw * rsqf_(ss + 1e-12f);
                const float wv = __expf(-DECAY_SCALE * sigmoidf_(w0c + Dw[e])), av = sigmoidf_(a0c + Da[e]);
                vw[e] = wv; vk[e] = kk; vb[e] = kk * av; ve[e] = k * (1.f + (av - 1.f) * kag); vr[e] = bf2f(rq[e]); }
            if (d) {
#define C1_SWAP(a_) do { float t0_ = a_[0], t1_ = a_[1]; a_[0] = a_[3]; a_[1] = a_[2]; a_[2] = t1_; a_[3] = t0_; } while (0)
                C1_SWAP(vw); C1_SWAP(vk); C1_SWAP(vb); C1_SWAP(ve); C1_SWAP(vr);
#undef C1_SWAP
            }
            float Dp[4], Dt[4];
            const float c1 = vw[0], c2 = c1 * vw[1], c3 = c2 * vw[2], c4 = c3 * vw[3];
            const float q0 = __shfl(c4, (d ? 48 : 0) + i), q1 = __shfl(c4, (d ? 32 : 16) + i), q2 = __shfl(c4, (d ? 16 : 32) + i);
            const float Dm = q0 * q1;
            const float off = sq == 0 ? 1.f : (sq == 1 ? q0 : (sq == 2 ? Dm : Dm * q2));
            Dp[0] = off; Dp[1] = off * c1; Dp[2] = off * c2; Dp[3] = off * c3;
            Dt[0] = Dp[1]; Dt[1] = Dp[2]; Dt[2] = Dp[3]; Dt[3] = off * c4;
            const float rDm = rcpf_(Dm);
            h4 hk, hb, he;
#pragma unroll
            for (int e = 0; e < 4; ++e) { const float rDt = rcpf_(Dt[e]);
                const float kap = vk[e] * Dp[e] * rDm, rr = vr[e] * Dt[e] * rDm, bq = vb[e] * Dm * rDt, eq = ve[e] * Dm * rDt;
                const int s = 4 * sq + e;
                ((LAS _Float16*)(IMG + C1_SC + (0 * 16 + s) * C1_SCST))[c] = (_Float16)kap; ((LAS _Float16*)(IMG + C1_SC + (1 * 16 + s) * C1_SCST))[c] = (_Float16)rr;
                ((LAS _Float16*)(IMG + C1_SC + (2 * 16 + s) * C1_SCST))[c] = (_Float16)bq;  ((LAS _Float16*)(IMG + C1_SC + (3 * 16 + s) * C1_SCST))[c] = (_Float16)eq;
                hk[e] = (_Float16)kap; hb[e] = (_Float16)bq; he[e] = (_Float16)eq; }
            *(LAS h4*)(IMG + C1_CM + c * 96 + 0 + sq * 8) = hk; *(LAS h4*)(IMG + C1_CM + c * 96 + 32 + sq * 8) = hb; *(LAS h4*)(IMG + C1_CM + c * 96 + 64 + sq * 8) = he;
            if (sq == 3) *(LAS float*)(IMG + C1_DL + c * 4) = Dt[3];
            if (sq == 0) *(LAS float*)(IMG + C1_DM + c * 4) = Dm;
        }
        }
        if (it + 1 < 32) C1_LOAD(B0 + it + 1);
        { const LAS unsigned char* IMG = lds + C1_IMG + (((it - 1) & 1) * 2 + d) * C1_IMG_D; LAS unsigned char* R = lds + C1_RES + (((it - 1) & 1) * 2 + d) * C1_RES_D;
        if (MODE != 1 && MODE != 4) {
            h8 fk[2], fr[2], fb[2], fe[2];
#pragma unroll
            for (int ks = 0; ks < 2; ++ks) { const LAS unsigned char* p = IMG + C1_SC + i * C1_SCST + (8 * g + 32 * ks) * 2;
                fk[ks] = *(const LAS h8*)(p); fr[ks] = *(const LAS h8*)(p + 16 * C1_SCST); fb[ks] = *(const LAS h8*)(p + 32 * C1_SCST); fe[ks] = *(const LAS h8*)(p + 48 * C1_SCST); }
            const f32x4 z4 = (f32x4){0.f, 0.f, 0.f, 0.f};
            f32x4 aN = z4, aNT = z4, aM = z4, aMT = z4, aNr = z4, aMr = z4;
#pragma unroll
            for (int ks = 0; ks < 2; ++ks) {
                aN  = __builtin_amdgcn_mfma_f32_16x16x32_f16(fb[ks], fk[ks], aN, 0, 0, 0);  aNT = __builtin_amdgcn_mfma_f32_16x16x32_f16(fk[ks], fb[ks], aNT, 0, 0, 0);
                aM  = __builtin_amdgcn_mfma_f32_16x16x32_f16(fe[ks], fk[ks], aM, 0, 0, 0);  aMT = __builtin_amdgcn_mfma_f32_16x16x32_f16(fk[ks], fe[ks], aMT, 0, 0, 0);
                aNr = __builtin_amdgcn_mfma_f32_16x16x32_f16(fb[ks], fr[ks], aNr, 0, 0, 0); aMr = __builtin_amdgcn_mfma_f32_16x16x32_f16(fe[ks], fr[ks], aMr, 0, 0, 0); }
#pragma unroll
            for (int e = 0; e < 4; ++e) { const int row = 4 * g + e;
                aN[e] = row < i ? -aN[e] : 0.f; aNT[e] = i < row ? -aNT[e] : 0.f; aM[e] = row < i ? aM[e] : 0.f; aMT[e] = i < row ? aMT[e] : 0.f;
                aNr[e] = row <= i ? aNr[e] : 0.f; aMr[e] = row <= i ? aMr[e] : 0.f; }
#define C1_H4(x_) __builtin_convertvector((x_), h4)
#define C1_MM(a_, b_, c_) __builtin_amdgcn_mfma_f32_16x16x16f16((a_), (b_), (c_), 0, 0, 0)
            f32x4 S = aN, ST = aNT;
#pragma unroll
            for (int e = 0; e < 4; ++e) if (4 * g + e == i) { S[e] += 1.f; ST[e] += 1.f; }
            const h4 hA = C1_H4(aN), hAT = C1_H4(aNT);
            const f32x4 P2 = C1_MM(hAT, hA, z4), P2T = C1_MM(hA, hAT, z4);
            const h4 hP2 = C1_H4(P2), hP2T = C1_H4(P2T);
            { const h4 hS = C1_H4(S); S = C1_MM(hP2T, hS, S); ST = C1_MM(hS, hP2T, ST); }
            const f32x4 P4 = C1_MM(hP2T, hP2, z4), P4T = C1_MM(hP2, hP2T, z4);
            const h4 hP4 = C1_H4(P4), hP4T = C1_H4(P4T);
            { const h4 hS = C1_H4(S); S = C1_MM(hP4T, hS, S); ST = C1_MM(hS, hP4T, ST); }
            const f32x4 P8T = C1_MM(hP4, hP4T, z4);
            const h4 hP8T = C1_H4(P8T);
            { const h4 hS = C1_H4(S); ST = C1_MM(hS, hP8T, ST); }
            const h4 hTT = C1_H4(ST), hMT = C1_H4(aMT);
            const f32x4 X1 = C1_MM(hTT, C1_H4(aNr), z4);
            const h4 hX1 = C1_H4(X1);
            const h4 bT = *(const LAS h4*)(IMG + C1_CM + c * 96 + 32 + g * 8);
            const f32x4 X2 = C1_MM(hTT, bT, z4);
            const float dl = *(const LAS float*)(IMG + C1_DL + c * 4), dm = *(const LAS float*)(IMG + C1_DM + c * 4);
            *(LAS f32x4*)(R + C1_ZT + c * 64 + 16 * g) = X2 * dl;
            const f32x4 Ea = C1_MM(hMT, C1_H4(X2), z4);
            const h4 kh = *(const LAS h4*)(IMG + C1_CM + c * 96 + 64 + g * 8);
            *(LAS f32x4*)(R + C1_ET + c * 64 + 16 * g) = (__builtin_convertvector(kh, f32x4) - Ea) * (dl * rcpf_(dm));
            const h4 kT = *(const LAS h4*)(IMG + C1_CM + c * 96 + g * 8);
            const f32x4 Qa = C1_MM(kT, hX1, z4);
            const h4 rh = *(const LAS h4*)(IMG + C1_SC + (16 + i) * C1_SCST + (16 * wa + 4 * g) * 2);
            const f32x4 dm4 = *(const LAS f32x4*)(IMG + C1_DM + (16 * wa + 4 * g) * 4);
            *(LAS f32x4*)(R + C1_QT + i * 256 + (16 * wa + 4 * g) * 4) = (__builtin_convertvector(rh, f32x4) - Qa) * dm4;
            if (wa == 0) { const f32x4 Ca = C1_MM(hMT, hX1, z4); *(LAS f32x4*)(R + C1_CT + i * 64 + 16 * g) = aMr - Ca; }
            *(LAS h4*)(R + C1_UH + c * 32 + 8 * g) = kT;
            if (g == 0) *(LAS float*)(R + C1_DA + c * 4) = dl;
#undef C1_H4
#undef C1_MM
        }
        }
        { const int B = B0 + it - 2; const LAS unsigned char* R = lds + C1_RES + ((it & 1) * 2 + d) * C1_RES_D;
        if (MODE != 2 && MODE != 4) {
            const int n = d ? 255 - B : B;
            GAS unsigned char* gt = (d ? (GAS unsigned char*)F.out : F.ws + WS_GT0) + ((size_t)(bb * 4 + h) * 256 + n) * GT_CHUNK;
            const int nt = wa;
            bf16x8 zf = (bf16x8){0, 0, 0, 0, 0, 0, 0, 0};
            if (g < 2) { const LAS f32x4* zp = (const LAS f32x4*)(R + C1_ZT + (16 * nt + i) * 64 + 32 * g); zf = pack8(zp[0], zp[1]); }
            f32x4 pp[4];
#pragma unroll
            for (int ct = 0; ct < 4; ++ct) {
                bf16x8 uf = (bf16x8){0, 0, 0, 0, 0, 0, 0, 0};
                if (g < 2) { const LAS h4* up = (const LAS h4*)(R + C1_UH + (16 * ct + i) * 32 + 16 * g); uf = pack8(__builtin_convertvector(up[0], f32x4), __builtin_convertvector(up[1], f32x4)); }
                const f32x4 dd = __builtin_amdgcn_mfma_f32_16x16x32_bf16(uf, zf, (f32x4){0.f, 0.f, 0.f, 0.f}, 0, 0, 0);
                f32x4 pv = -dd;
                if (ct == nt) { const f32x4 da = *(const LAS f32x4*)(R + C1_DA + (16 * ct + 4 * g) * 4);
#pragma unroll
                    for (int e = 0; e < 4; ++e) if (4 * g + e == i) pv[e] += da[e]; }
                pp[ct] = pv; }
#undef C1_ST
#define C1_ST(p_, v_) do { const bf16x8 v__ = (v_); if (MODE == 0) *(GAS bf16x8*)(p_) = v__; else asm volatile("" :: "v"(v__)); } while (0)
            C1_ST(gt + (nt * 2 + 0) * 1024 + lane * 16, pack8(pp[0], pp[1]));
            C1_ST(gt + (nt * 2 + 1) * 1024 + lane * 16, pack8(pp[2], pp[3]));
            if (g < 2) { const LAS f32x4* ep = (const LAS f32x4*)(R + C1_ET + (16 * nt + i) * 64 + 32 * g); C1_ST(gt + 10240 + nt * 512 + lane * 16, pack8(ep[0], ep[1])); }
            if (wa == 0) {
#pragma unroll
                for (int ks = 0; ks < 2; ++ks) { const LAS f32x4* qp = (const LAS f32x4*)(R + C1_QT + i * 256 + (32 * ks + 4 * g) * 4);
                    C1_ST(gt + (8 + ks) * 1024 + lane * 16, pack8(qp[0], qp[4])); }
                if (g < 2) { const LAS f32x4* cp = (const LAS f32x4*)(R + C1_CT + i * 64 + 32 * g); C1_ST(gt + 10240 + 4 * 512 + lane * 16, pack8(cp[0], cp[1])); }
            }
        }
        }
        C1_BAR();
    }
    {
        const int it = 32;
        { const LAS unsigned char* IMG = lds + C1_IMG + (((it - 1) & 1) * 2 + d) * C1_IMG_D; LAS unsigned char* R = lds + C1_RES + (((it - 1) & 1) * 2 + d) * C1_RES_D;
        if (MODE != 1 && MODE != 4) {
            h8 fk[2], fr[2], fb[2], fe[2];
#pragma unroll
            for (int ks = 0; ks < 2; ++ks) { const LAS unsigned char* p = IMG + C1_SC + i * C1_SCST + (8 * g + 32 * ks) * 2;
                fk[ks] = *(const LAS h8*)(p); fr[ks] = *(const LAS h8*)(p + 16 * C1_SCST); fb[ks] = *(const LAS h8*)(p + 32 * C1_SCST); fe[ks] = *(const LAS h8*)(p + 48 * C1_SCST); }
            const f32x4 z4 = (f32x4){0.f, 0.f, 0.f, 0.f};
            f32x4 aN = z4, aNT = z4, aM = z4, aMT = z4, aNr = z4, aMr = z4;
#pragma unroll
            for (int ks = 0; ks < 2; ++ks) {
                aN  = __builtin_amdgcn_mfma_f32_16x16x32_f16(fb[ks], fk[ks], aN, 0, 0, 0);  aNT = __builtin_amdgcn_mfma_f32_16x16x32_f16(fk[ks], fb[ks], aNT, 0, 0, 0);
                aM  = __builtin_amdgcn_mfma_f32_16x16x32_f16(fe[ks], fk[ks], aM, 0, 0, 0);  aMT = __builtin_amdgcn_mfma_f32_16x16x32_f16(fk[ks], fe[ks], aMT, 0, 0, 0);
                aNr = __builtin_amdgcn_mfma_f32_16x16x32_f16(fb[ks], fr[ks], aNr, 0, 0, 0); aMr = __builtin_amdgcn_mfma_f32_16x16x32_f16(fe[ks], fr[ks], aMr, 0, 0, 0); }
#pragma unroll
            for (int e = 0; e < 4; ++e) { const int row = 4 * g + e;
                aN[e] = row < i ? -aN[e] : 0.f; aNT[e] = i < row ? -aNT[e] : 0.f; aM[e] = row < i ? aM[e] : 0.f; aMT[e] = i < row ? aMT[e] : 0.f;
                aNr[e] = row <= i ? aNr[e] : 0.f; aMr[e] = row <= i ? aMr[e] : 0.f; }
#define C1_H4(x_) __builtin_convertvector((x_), h4)
#define C1_MM(a_, b_, c_) __builtin_amdgcn_mfma_f32_16x16x16f16((a_), (b_), (c_), 0, 0, 0)
            f32x4 S = aN, ST = aNT;
#pragma unroll
            for (int e = 0; e < 4; ++e) if (4 * g + e == i) { S[e] += 1.f; ST[e] += 1.f; }
            const h4 hA = C1_H4(aN), hAT = C1_H4(aNT);
            const f32x4 P2 = C1_MM(hAT, hA, z4), P2T = C1_MM(hA, hAT, z4);
            const h4 hP2 = C1_H4(P2), hP2T = C1_H4(P2T);
            { const h4 hS = C1_H4(S); S = C1_MM(hP2T, hS, S); ST = C1_MM(hS, hP2T, ST); }
            const f32x4 P4 = C1_MM(hP2T, hP2, z4), P4T = C1_MM(hP2, hP2T, z4);
            const h4 hP4 = C1_H4(P4), hP4T = C1_H4(P4T);
            { const h4 hS = C1_H4(S); S = C1_MM(hP4T, hS, S); ST = C1_MM(hS, hP4T, ST); }
            const f32x4 P8T = C1_MM(hP4, hP4T, z4);
            const h4 hP8T = C1_H4(P8T);
            { const h4 hS = C1_H4(S); ST = C1_MM(hS, hP8T, ST); }
            const h4 hTT = C1_H4(ST), hMT = C1_H4(aMT);
            const f32x4 X1 = C1_MM(hTT, C1_H4(aNr), z4);
            const h4 hX1 = C1_H4(X1);
            const h4 bT = *(const LAS h4*)(IMG + C1_CM + c * 96 + 32 + g * 8);
            const f32x4 X2 = C1_MM(hTT, bT, z4);
            const float dl = *(const LAS float*)(IMG + C1_DL + c * 4), dm = *(const LAS float*)(IMG + C1_DM + c * 4);
            *(LAS f32x4*)(R + C1_ZT + c * 64 + 16 * g) = X2 * dl;
            const f32x4 Ea = C1_MM(hMT, C1_H4(X2), z4);
            const h4 kh = *(const LAS h4*)(IMG + C1_CM + c * 96 + 64 + g * 8);
            *(LAS f32x4*)(R + C1_ET + c * 64 + 16 * g) = (__builtin_convertvector(kh, f32x4) - Ea) * (dl * rcpf_(dm));
            const h4 kT = *(const LAS h4*)(IMG + C1_CM + c * 96 + g * 8);
            const f32x4 Qa = C1_MM(kT, hX1, z4);
            const h4 rh = *(const LAS h4*)(IMG + C1_SC + (16 + i) * C1_SCST + (16 * wa + 4 * g) * 2);
            const f32x4 dm4 = *(const LAS f32x4*)(IMG + C1_DM + (16 * wa + 4 * g) * 4);
            *(LAS f32x4*)(R + C1_QT + i * 256 + (16 * wa + 4 * g) * 4) = (__builtin_convertvector(rh, f32x4) - Qa) * dm4;
            if (wa == 0) { const f32x4 Ca = C1_MM(hMT, hX1, z4); *(LAS f32x4*)(R + C1_CT + i * 64 + 16 * g) = aMr - Ca; }
            *(LAS h4*)(R + C1_UH + c * 32 + 8 * g) = kT;
            if (g == 0) *(LAS float*)(R + C1_DA + c * 4) = dl;
#undef C1_H4
#undef C1_MM
        }
        }
        { const int B = B0 + it - 2; const LAS unsigned char* R = lds + C1_RES + ((it & 1) * 2 + d) * C1_RES_D;
        if (MODE != 2 && MODE != 4) {
            const int n = d ? 255 - B : B;
            GAS unsigned char* gt = (d ? (GAS unsigned char*)F.out : F.ws + WS_GT0) + ((size_t)(bb * 4 + h) * 256 + n) * GT_CHUNK;
            const int nt = wa;
            bf16x8 zf = (bf16x8){0, 0, 0, 0, 0, 0, 0, 0};
            if (g < 2) { const LAS f32x4* zp = (const LAS f32x4*)(R + C1_ZT + (16 * nt + i) * 64 + 32 * g); zf = pack8(zp[0], zp[1]); }
            f32x4 pp[4];
#pragma unroll
            for (int ct = 0; ct < 4; ++ct) {
                bf16x8 uf = (bf16x8){0, 0, 0, 0, 0, 0, 0, 0};
                if (g < 2) { const LAS h4* up = (const LAS h4*)(R + C1_UH + (16 * ct + i) * 32 + 16 * g); uf = pack8(__builtin_convertvector(up[0], f32x4), __builtin_convertvector(up[1], f32x4)); }
                const f32x4 dd = __builtin_amdgcn_mfma_f32_16x16x32_bf16(uf, zf, (f32x4){0.f, 0.f, 0.f, 0.f}, 0, 0, 0);
                f32x4 pv = -dd;
                if (ct == nt) { const f32x4 da = *(const LAS f32x4*)(R + C1_DA + (16 * ct + 4 * g) * 4);
#pragma unroll
                    for (int e = 0; e < 4; ++e) if (4 * g + e == i) pv[e] += da[e]; }
                pp[ct] = pv; }
#undef C1_ST
#define C1_ST(p_, v_) do { const bf16x8 v__ = (v_); if (MODE == 0) *(GAS bf16x8*)(p_) = v__; else asm volatile("" :: "v"(v__)); } while (0)
            C1_ST(gt + (nt * 2 + 0) * 1024 + lane * 16, pack8(pp[0], pp[1]));
            C1_ST(gt + (nt * 2 + 1) * 1024 + lane * 16, pack8(pp[2], pp[3]));
            if (g < 2) { const LAS f32x4* ep = (const LAS f32x4*)(R + C1_ET + (16 * nt + i) * 64 + 32 * g); C1_ST(gt + 10240 + nt * 512 + lane * 16, pack8(ep[0], ep[1])); }
            if (wa == 0) {
#pragma unroll
                for (int ks = 0; ks < 2; ++ks) { const LAS f32x4* qp = (const LAS f32x4*)(R + C1_QT + i * 256 + (32 * ks + 4 * g) * 4);
                    C1_ST(gt + (8 + ks) * 1024 + lane * 16, pack8(qp[0], qp[4])); }
                if (g < 2) { const LAS f32x4* cp = (const LAS f32x4*)(R + C1_CT + i * 64 + 32 * g); C1_ST(gt + 10240 + 4 * 512 + lane * 16, pack8(cp[0], cp[1])); }
            }
        }
        }
        C1_BAR();
    }
    {
        const int it = 33;
        { const int B = B0 + it - 2; const LAS unsigned char* R = lds + C1_RES + ((it & 1) * 2 + d) * C1_RES_D;
        if (MODE != 2 && MODE != 4) {
            const int n = d ? 255 - B : B;
            GAS unsigned char* gt = (d ? (GAS unsigned char*)F.out : F.ws + WS_GT0) + ((size_t)(bb * 4 + h) * 256 + n) * GT_CHUNK;
            const int nt = wa;
            bf16x8 zf = (bf16x8){0, 0, 0, 0, 0, 0, 0, 0};
            if (g < 2) { const LAS f32x4* zp = (const LAS f32x4*)(R + C1_ZT + (16 * nt + i) * 64 + 32 * g); zf = pack8(zp[0], zp[1]); }
            f32x4 pp[4];
#pragma unroll
            for (int ct = 0; ct < 4; ++ct) {
                bf16x8 uf = (bf16x8){0, 0, 0, 0, 0, 0, 0, 0};
                if (g < 2) { const LAS h4* up = (const LAS h4*)(R + C1_UH + (16 * ct + i) * 32 + 16 * g); uf = pack8(__builtin_convertvector(up[0], f32x4), __builtin_convertvector(up[1], f32x4)); }
                const f32x4 dd = __builtin_amdgcn_mfma_f32_16x16x32_bf16(uf, zf, (f32x4){0.f, 0.f, 0.f, 0.f}, 0, 0, 0);
                f32x4 pv = -dd;
                if (ct == nt) { const f32x4 da = *(const LAS f32x4*)(R + C1_DA + (16 * ct + 4 * g) * 4);
#pragma unroll
                    for (int e = 0; e < 4; ++e) if (4 * g + e == i) pv[e] += da[e]; }
                pp[ct] = pv; }
#undef C1_ST
#define C1_ST(p_, v_) do { const bf16x8 v__ = (v_); if (MODE == 0) *(GAS bf16x8*)(p_) = v__; else asm volatile("" :: "v"(v__)); } while (0)
            C1_ST(gt + (nt * 2 + 0) * 1024 + lane * 16, pack8(pp[0], pp[1]));
            C1_ST(gt + (nt * 2 + 1) * 1024 + lane * 16, pack8(pp[2], pp[3]));
            if (g < 2) { const LAS f32x4* ep = (const LAS f32x4*)(R + C1_ET + (16 * nt + i) * 64 + 32 * g); C1_ST(gt + 10240 + nt * 512 + lane * 16, pack8(ep[0], ep[1])); }
            if (wa == 0) {
#pragma unroll
                for (int ks = 0; ks < 2; ++ks) { const LAS f32x4* qp = (const LAS f32x4*)(R + C1_QT + i * 256 + (32 * ks + 4 * g) * 4);
                    C1_ST(gt + (8 + ks) * 1024 + lane * 16, pack8(qp[0], qp[4])); }
                if (g < 2) { const LAS f32x4* cp = (const LAS f32x4*)(R + C1_CT + i * 64 + 32 * g); C1_ST(gt + 10240 + 4 * 512 + lane * 16, pack8(cp[0], cp[1])); }
            }
        }
        }
        C1_BAR();
    }
#undef C1_LOAD
#undef C1_BAR
    __syncthreads();
}
#define C2_BAR() do { asm volatile("s_waitcnt lgkmcnt(0)" ::: "memory"); __builtin_amdgcn_s_barrier(); asm volatile("" ::: "memory"); } while (0)
constexpr int C2_SLOT = 16384, C2_YOFF = 4 * C2_SLOT;
template <int MODE>
__device__ __forceinline__ void phase_scan_c2(Frame& F, int l) {
    LAUNDER(F);
    if (F.vcu >= 128) { if (MODE == 0) phase_mix_na(F, l, F.vcu - 128, 128); return; }
    const GAS bf16* proj = (const GAS bf16*)(F.ws + WS_PROJ);
    const int lane = F.lane, i = lane & 15, g = lane >> 4;
    LAS unsigned char* lds = F.lds;
    if (F.vcu < 128) {
    const int ci = F.vcu >> 1, tp = F.vcu & 1, d = ci >> 5, bb = (ci >> 2) & 7, h = ci & 3;
    for (int q = F.tid; q < 4 * 5 * 32; q += NTHREADS) { const int sl = q / 160, r = q % 160; *(LAS v4u*)(lds + sl * C2_SLOT + 10240 + (r >> 5) * 1024 + 512 + (r & 31) * 16) = (v4u){0u, 0u, 0u, 0u}; }
    __syncthreads();
    if (F.wave < 2) {
        const int cw = F.wave;
        f32x4 st[4];
#pragma unroll
        for (int t = 0; t < 4; ++t) st[t] = (f32x4){0.f, 0.f, 0.f, 0.f};
        v4u af[15], vf, nf[15], nvf;
#define C2_RD(AF, VF, c_) do { const LAS unsigned char* p_ = lds + ((c_) & 3) * C2_SLOT + lane * 16; \
            _Pragma("unroll") for (int f_ = 0; f_ < 15; ++f_) AF[f_] = *(const LAS v4u*)(p_ + f_ * 1024); \
            VF = *(const LAS v4u*)(lds + ((c_) & 3) * C2_SLOT + 15360 + cw * 512 + i * 32 + (g & 1) * 16); } while (0)
#define C2_STEP(AF, VF, NF, NVF, n_) do { \
            if ((n_) + 1 < 256) C2_RD(NF, NVF, (n_) + 1); \
            const bf16x8 b0_ = pack8(st[0], st[1]), b1_ = pack8(st[2], st[3]); const v4u vz_ = (g < 2) ? VF : (v4u){0u, 0u, 0u, 0u}; const bf16x8 bv_ = __builtin_bit_cast(bf16x8, vz_); \
            f32x4 o_[5]; \
            _Pragma("unroll") for (int nt = 0; nt < 5; ++nt) { if (MODE >= 2) { o_[nt] = __builtin_bit_cast(f32x4, AF[nt]) + __builtin_bit_cast(f32x4, AF[10 + nt]) * st[nt & 3]; continue; } \
                f32x4 a_ = __builtin_amdgcn_mfma_f32_16x16x32_bf16(__builtin_bit_cast(bf16x8, AF[nt * 2]), b0_, (f32x4){0.f, 0.f, 0.f, 0.f}, 0, 0, 0); \
                a_ = __builtin_amdgcn_mfma_f32_16x16x32_bf16(__builtin_bit_cast(bf16x8, AF[nt * 2 + 1]), b1_, a_, 0, 0, 0); \
                o_[nt] = __builtin_amdgcn_mfma_f32_16x16x32_bf16(__builtin_bit_cast(bf16x8, AF[10 + nt]), bv_, a_, 0, 0, 0); } \
            _Pragma("unroll") for (int t = 0; t < 4; ++t) st[t] = o_[t]; \
            { v2u yw_; yw_.x = pk2(o_[4].x, o_[4].y); yw_.y = pk2(o_[4].z, o_[4].w); \
              *(LAS v2u*)(lds + C2_YOFF + (cw * 8 + ((n_) & 7)) * 512 + i * 32 + g * 8) = yw_; }     \
            } while (0)
        C2_BAR();
        C2_RD(af, vf, 0);
        for (int n = 0; n < 256; n += 2) { C2_STEP(af, vf, nf, nvf, n); C2_STEP(nf, nvf, af, vf, n + 1); C2_BAR(); }
        C2_BAR();
#undef C2_STEP
#undef C2_RD
    } else {
        const int hl = F.tid - 128;
        const GAS unsigned char* gt = (d ? (const GAS unsigned char*)F.out : F.ws + WS_GT0) + ((size_t)(bb * 4 + h) * 256) * GT_CHUNK;
        GAS bf16* ysc = (GAS bf16*)(d ? (GAS unsigned char*)F.out + GT_DIR : F.ws + WS_YSC0) + (size_t)bb * T * 256 + h * 64 + 32 * tp;
        const int p0 = hl, p1 = hl + 384, p2 = hl + 768; const bool has2 = p2 < 800;
#define C2_OFF(p_) ((p_) < 640 ? (p_) * 16 : 10240 + (((p_) - 640) >> 5) * 1024 + (((p_) - 640) & 31) * 16)
        const int o0 = C2_OFF(p0), o1 = C2_OFF(p1), o2 = C2_OFF(has2 ? p2 : 799);
        const int e0 = hl, e1 = hl + 384; const bool hasv1 = e1 < 512;
        const GAS bf16* vs0 = proj + (size_t)bb * T * NPROJP + C_V + h * 64 + 32 * tp + 16 * (e0 >> 8) + (e0 & 15);
        const GAS bf16* vs1 = proj + (size_t)bb * T * NPROJP + C_V + h * 64 + 32 * tp + 16 * ((hasv1 ? e1 : 0) >> 8) + (e1 & 15);
        const int vt0 = (e0 >> 4) & 15, vt1 = (e1 >> 4) & 15;
        const int vo0 = 15360 + (e0 >> 8) * 512 + (e0 & 15) * 32 + vt0 * 2, vo1 = 15360 + ((hasv1 ? e1 : 0) >> 8) * 512 + (e1 & 15) * 32 + vt1 * 2;
        constexpr int RD = 12;
        v4u r0[RD], r1[RD], r2[RD]; unsigned short rv0[RD], rv1[RD];
        if (MODE == 1 || MODE == 3) {
#pragma unroll
            for (int k = 0; k < RD; ++k) { r0[k] = (v4u){1u, 2u, 3u, 4u}; r1[k] = r0[k]; r2[k] = r0[k]; rv0[k] = 0; rv1[k] = 0; } }
#define C2_GLD(k_, n_) do { if (MODE == 1 || MODE == 3) break; const GAS unsigned char* c_ = gt + (size_t)(n_) * GT_CHUNK; r0[k_] = *(const GAS v4u*)(c_ + p0 * 16); r1[k_] = *(const GAS v4u*)(c_ + p1 * 16); \
            if (has2) r2[k_] = *(const GAS v4u*)(c_ + p2 * 16); \
            { const int gs_ = 16 * (n_) + vt0, t_ = d ? (T - 1 - gs_) : gs_; rv0[k_] = vs0[(size_t)t_ * NPROJP]; } \
            if (hasv1) { const int gs_ = 16 * (n_) + vt1, t_ = d ? (T - 1 - gs_) : gs_; rv1[k_] = vs1[(size_t)t_ * NPROJP]; } } while (0)
#define C2_WR(k_, n_) do { LAS unsigned char* p_ = lds + ((n_) & 3) * C2_SLOT; *(LAS v4u*)(p_ + o0) = r0[k_]; *(LAS v4u*)(p_ + o1) = r1[k_]; if (has2) *(LAS v4u*)(p_ + o2) = r2[k_]; \
            *(LAS unsigned short*)(p_ + vo0) = rv0[k_]; if (hasv1) *(LAS unsigned short*)(p_ + vo1) = rv1[k_]; } while (0)
#define C2_YST(m_) do { if (hl < 64) { const int cw_ = hl >> 5, s_ = (hl >> 1) & 15, hf_ = hl & 1; const LAS unsigned short* yp_ = (const LAS unsigned short*)(lds + C2_YOFF + (cw_ * 8 + ((m_) & 7)) * 512) + s_; \
            v4u w_; _Pragma("unroll") for (int e_ = 0; e_ < 4; ++e_) w_[e_] = (unsigned)yp_[(8 * hf_ + 2 * e_) * 16] | ((unsigned)yp_[(8 * hf_ + 2 * e_ + 1) * 16] << 16); \
            const int gs_ = 16 * (m_) + s_, t_ = d ? (T - 1 - gs_) : gs_; if (MODE == 0) *(GAS v4u*)(ysc + (size_t)t_ * 256 + 16 * cw_ + 8 * hf_) = w_; else asm volatile("" :: "v"(w_)); } } while (0)
#pragma unroll
        for (int k = 0; k < RD; ++k) C2_GLD(k, k);
        C2_WR(0, 0); C2_GLD(0, RD); C2_WR(1, 1); C2_GLD(1, RD + 1); C2_WR(2, 2); C2_GLD(2, RD + 2);
        C2_BAR();
        for (int m6 = 0; m6 < 128; m6 += RD / 2) {
#pragma unroll
            for (int k = 0; k < RD / 2; ++k) { const int m = m6 + k;
                if (m < 128) {
                    const int ca = 2 * m + 3, cb = 2 * m + 4, ka = (2 * k + 3) % RD, kb = (2 * k + 4) % RD;
                    if (ca < 256) { C2_WR(ka, ca); if (ca + RD < 256) C2_GLD(ka, ca + RD); }
                    if (cb < 256) { C2_WR(kb, cb); if (cb + RD < 256) C2_GLD(kb, cb + RD); }
                    if (m > 0) { C2_YST(2 * m - 2); C2_YST(2 * m - 1); }
                    C2_BAR(); } }
        }
        C2_YST(254); C2_YST(255);
        C2_BAR();
#undef C2_GLD
#undef C2_WR
#undef C2_YST
#undef C2_OFF
    }
    }
    __syncthreads();
}
#undef C2_BAR
#undef CK_DOT
#undef CK_RED2

__device__ __forceinline__ void phase_rwkv_post(Frame& F, int l) {
    LAUNDER(F);
    const GAS bf16* proj = (const GAS bf16*)(F.ws + WS_PROJ); GAS bf16* merged = (GAS bf16*)(F.ws + WS_MERGED); const GAS bf16* ysc0 = (const GAS bf16*)(F.ws + WS_YSC0); const GAS bf16* ysc1 = (const GAS bf16*)((const GAS unsigned char*)F.out + GT_DIR);
    const int lane = F.lane, c4 = 4 * lane, hd = lane >> 4;
    LAS float* GUP = (LAS float*)F.lds;
    for (int q = F.tid; q < 32 * 256; q += NTHREADS) GUP[q] = INP(F, I_RGUP)[(size_t)l * 32 * 256 + q];
    __syncthreads();
    const f32x4 lw = *(const f32x4*)(INP(F, I_LNXW) + l * 256 + c4), lb = *(const f32x4*)(INP(F, I_LNXB) + l * 256 + c4), rk = *(const f32x4*)(INP(F, I_RRK) + l * 256 + c4);
    const int mstep = F.G * NWAVES; int m = F.vcu * NWAVES + F.wave;
    v2u n_yf, n_yb, n_r, n_k, n_v; unsigned short n_g;
#define POST_LOAD(mm) do { const GAS bf16* row_ = proj + (size_t)(mm) * NPROJP; n_yf = *(const GAS v2u*)(ysc0 + (size_t)(mm) * 256 + c4); n_yb = *(const GAS v2u*)(ysc1 + (size_t)(mm) * 256 + c4); \
        n_r = *(const GAS v2u*)(row_ + C_R + c4); n_k = *(const GAS v2u*)(row_ + C_K + c4); n_v = *(const GAS v2u*)(row_ + C_V + c4); n_g = row_[C_GDN + (lane & 31)]; } while (0)
    POST_LOAD(m);
    for (; m < M; m += mstep) {
        const v2u yf = n_yf, yb = n_yb, ru = n_r, ku = n_k, vu = n_v; const unsigned short gu = n_g;
        if (m + mstep < M) POST_LOAD(m + mstep);
        f32x4 y = (f32x4){bflo(yf.x) + bflo(yb.x), bfhi(yf.x) + bfhi(yb.x), bflo(yf.y) + bflo(yb.y), bfhi(yf.y) + bfhi(yb.y)};
        const float mu = row16_sum((y.x + y.y) + (y.z + y.w)) * (1.f / 64.f);
        y = y - mu;
        const float var = row16_sum((y.x * y.x + y.y * y.y) + (y.z * y.z + y.w * y.w)) * (1.f / 64.f);
        const float rstd = rsqf_(var + GN_EPS);
        y = y * rstd * lw + lb;
        const f32x4 r = (f32x4){bflo(ru.x), bfhi(ru.x), bflo(ru.y), bfhi(ru.y)}, k = (f32x4){bflo(ku.x), bfhi(ku.x), bflo(ku.y), bfhi(ku.y)}, v = (f32x4){bflo(vu.x), bfhi(vu.x), bflo(vu.y), bfhi(vu.y)};
        const f32x4 rkk = r * k * rk;
        const float bsum = row16_sum((rkk.x + rkk.y) + (rkk.z + rkk.w));
        y = y + v * bsum;
        const float gd = sigmoidf_(bf2f(gu));
        f32x4 gt = (f32x4){0.f, 0.f, 0.f, 0.f};
#pragma unroll
        for (int j = 0; j < 32; ++j) { const float gj = __builtin_bit_cast(float, __builtin_amdgcn_readlane(__builtin_bit_cast(int, gd), j)); gt = gt + *(const LAS f32x4*)(GUP + j * 256 + c4) * gj; }
        y = y * gt;
        const float ss = wave_sum((y.x * y.x + y.y * y.y) + (y.z * y.z + y.w * y.w));
        const float sc = rsqf_(ss * (1.f / 256.f) + NORM_EPS);
        v2u o; o.x = pk2(y.x * sc, y.y * sc); o.y = pk2(y.z * sc, y.w * sc);
        *(GAS v2u*)(merged + (size_t)m * DM + 256 + c4) = o;
    }
#undef POST_LOAD
    (void)hd;
}

__device__ __forceinline__ void phase_residual(Frame& F, const GAS float* gain, const bool IN_F32, const bool LAST) {
    LAUNDER(F);
    const GAS bf16* y = (const GAS bf16*)(F.ws + WS_Y); const GAS float* part = (const GAS float*)(F.ws + WS_PART);
    GAS bf16* xb = (GAS bf16*)(F.ws + WS_XB); GAS float* rs = (GAS float*)(F.ws + WS_RS); const GAS float* xin = INP(F, I_X);
    const int lane = F.lane;
    f32x4 gv[4];
#pragma unroll
    for (int j = 0; j < 4; ++j) gv[j] = *((const f32x4*)gain + lane + 64 * j);
    for (int m = F.vcu * NWAVES + F.wave; m < M; m += F.G * NWAVES) {
        const f32x4* pp = (const f32x4*)(part + (size_t)m * 16);
        const f32x4 p0 = *(const GAS f32x4*)(pp), p1 = *(const GAS f32x4*)(pp + 1), p2 = *(const GAS f32x4*)(pp + 2), p3 = *(const GAS f32x4*)(pp + 3);
        const float tot = ((p0.x + p0.y) + (p0.z + p0.w)) + ((p1.x + p1.y) + (p1.z + p1.w)) + ((p2.x + p2.y) + (p2.z + p2.w)) + ((p3.x + p3.y) + (p3.z + p3.w));
        const float sc = rsqf_(tot * (1.f / DM) + NORM_EPS);
        const GAS v2u* yr = (const GAS v2u*)(y + (size_t)m * DM) + lane;
        f32x4 v[4]; float s = 0.f;
#pragma unroll
        for (int j = 0; j < 4; ++j) { const v2u yu = yr[64 * j]; const f32x4 yv = (f32x4){bflo(yu.x), bfhi(yu.x), bflo(yu.y), bfhi(yu.y)};
            f32x4 xv;
            if (IN_F32) xv = ((const GAS f32x4*)(xin + (size_t)m * DM) + lane)[64 * j];
            else { const v2u xu = ((const GAS v2u*)(xb + (size_t)m * DM) + lane)[64 * j]; xv = (f32x4){bflo(xu.x), bfhi(xu.x), bflo(xu.y), bfhi(xu.y)}; }
            v[j] = xv + yv * sc * gv[j]; s += (v[j].x * v[j].x + v[j].y * v[j].y) + (v[j].z * v[j].z + v[j].w * v[j].w); }
        if (LAST) {
            GAS f32x4* orow = (GAS f32x4*)(F.out + (size_t)m * DM) + lane;
#pragma unroll
            for (int j = 0; j < 4; ++j) orow[64 * j] = v[j];
        } else {
            s = wave_sum(s);
            GAS v2u* o8 = (GAS v2u*)(xb + (size_t)m * DM) + lane;
#pragma unroll
            for (int j = 0; j < 4; ++j) { v2u o; o.x = pk2(v[j].x, v[j].y); o.y = pk2(v[j].z, v[j].w); o8[64 * j] = o; }
            if (lane == 0) rs[m] = rsqf_(s * (1.f / DM) + NORM_EPS);
        }
    }
}
__device__ __forceinline__ void phase_ffn_conv(Frame& F, int l) {
    LAUNDER(F);
    const GAS bf16* G = (const GAS bf16*)(F.ws + WS_G); GAS bf16* L = (GAS bf16*)(F.ws + WS_L);
    const GAS float* cw = INP(F, I_FCONV) + (size_t)l * 3 * DFF;
    constexpr int CPR = DFF / 8;
    const int nitems = (M / 256) * 2 * CPR;
    for (int it = F.vcu * NTHREADS + F.tid; it < nitems; it += F.G * NTHREADS) {
        const int ck = it % CPR, rr = it / CPR, m = (rr >> 1) * 256 + ((rr & 1) ? 255 : 0), t = m % T, c8 = 8 * ck;
        float w0[8], w1[8], w2[8];
#pragma unroll
        for (int j = 0; j < 8; ++j) { w0[j] = cw[c8 + j]; w1[j] = cw[DFF + c8 + j]; w2[j] = cw[2 * DFF + c8 + j]; }
        const v4u z = (v4u){0u, 0u, 0u, 0u};
        const v4u gp = (t > 0) ? *(const GAS v4u*)(G + (size_t)(m - 1) * DFF + c8) : z, gc = *(const GAS v4u*)(G + (size_t)m * DFF + c8), gn = (t < T - 1) ? *(const GAS v4u*)(G + (size_t)(m + 1) * DFF + c8) : z;
        const v4u lv = *(const GAS v4u*)(L + (size_t)m * DFF + c8);
        v4u o;
#pragma unroll
        for (int q = 0; q < 4; ++q) {
            const float a0 = w0[2 * q] * bflo(gp[q]) + w1[2 * q] * bflo(gc[q]) + w2[2 * q] * bflo(gn[q]);
            const float a1 = w0[2 * q + 1] * bfhi(gp[q]) + w1[2 * q + 1] * bfhi(gc[q]) + w2[2 * q + 1] * bfhi(gn[q]);
            o[q] = pk2(gelu_tanh(a0) * bflo(lv[q]), gelu_tanh(a1) * bfhi(lv[q])); }
        *(GAS v4u*)(L + (size_t)m * DFF + c8) = o;
    }
}

#ifndef MK_N_LAUNCHES
#define MK_N_LAUNCHES 1
#endif
constexpr int NPH = 1 + 8 * DEPTH;
struct Args { const float* in[26]; float* out; unsigned char* ws; int ph_lo, ph_hi; };
__global__ void __launch_bounds__(NTHREADS, 2) enc_fwd(Args args) {
    extern __shared__ __attribute__((aligned(16))) unsigned char lds_raw[];
    Frame F;
    F.lds = (LAS unsigned char*)lds_raw;
    F.MISC = (volatile LAS unsigned*)(F.lds + MISC_OFF);
    F.tid = threadIdx.x; F.lane = F.tid & 63; F.wave = __builtin_amdgcn_readfirstlane(F.tid >> 6);
    F.G = gridDim.x; { const int bx = blockIdx.x; F.vcu = (F.G % 8 == 0) ? (bx % 8) * (F.G / 8) + bx / 8 : bx; }
    F.ws = (GAS unsigned char*)args.ws; F.out = (GAS float*)args.out; F.ctl = (gu32*)(F.ws + WS_CTL);
    F.karg = (kq_t*)__builtin_amdgcn_kernarg_segment_ptr();
    for (int u = F.tid; u < LDS_BYTES / 16; u += NTHREADS) ((LAS v4u*)F.lds)[u] = (v4u){0u, 0u, 0u, 0u};
    __syncthreads();
    const int lo = args.ph_lo, hi = args.ph_hi;
    if (hi - lo > 1) (void)xcd_barrier_post((unsigned*)(F.ctl + CW_BAR), F.MISC + 8);
#define GRID_BAR() do { XcdBarrier bar_; bar_.bar = (unsigned*)(F.ctl + CW_BAR); bar_.x = xb_xcc_id(); bar_.st = F.MISC + 8; xcd_barrier(bar_); } while (0)
#ifndef PH_ENABLE
#define PH_ENABLE 0x7ff
#endif
#define IN(k) (lo <= (k) && (k) < hi)
#define EN(t) (((PH_ENABLE) >> (t)) & 1)
#pragma unroll 1
#ifdef REPEAT_T
    for (int step = lo; step < hi; ++step) {
        const int p1 = REPEAT_T, p2 = REPEAT_T + 8;
        const int ph = step - (step > p1 ? 1 : 0) - ((step > p2 + 1 && REPEAT_T != 7) ? 1 : 0);
#else
    for (int ph = lo; ph < hi; ++ph) {
#endif
        LAUNDER(F);
        const int l = ph == 0 ? 0 : (ph - 1) / 8, tt = ph == 0 ? 0 : 1 + (ph - 1) % 8;
        const int t = tt == 0 ? 0 : (tt == 1 ? 1 : (tt <= 5 ? tt + 1 : tt + 2));
        GAS unsigned char* wl = F.ws + WS_W + (size_t)l * W_LAYER;
      {
        if (t == 1 || t == 8) {
            pg8::Gemm g; pg8::EpiUni E;
            g.M = M; E.split_cols = 0; E.split_stride = 0; E.convw = nullptr; E.G = nullptr; E.xl = (pg8::PG8_LAS_T*)(F.lds + RING_BYTES + 1024); E.part = nullptr; E.rs = (const GAS float*)(F.ws + WS_RS);
            g.A = (const GAS bf16*)(F.ws + WS_XB); g.K = DM;
            if (t == 1) { g.Bt = (const GAS bf16*)(wl + W_IN); g.N = NPROJP; E.O = (GAS bf16*)(F.ws + WS_PROJ); E.ldc = NPROJP; }
            else        { g.Bt = (const GAS bf16*)(wl + W_UP); g.N = NUP;    E.O = (GAS bf16*)(F.ws + WS_L); E.ldc = DFF; E.convw = INP(F, I_FCONV) + (size_t)l * 3 * DFF; E.G = (GAS bf16*)(F.ws + WS_G); }
            g.Bt = launder_p(g.Bt); E.O = launder_p(E.O); E.convw = launder_p(E.convw); E.G = launder_p(E.G); g.N = launder_u(g.N); E.ldc = launder_u(E.ldc);
            g.A = launder_p(g.A); E.rs = launder_p(E.rs);
            pg8::StaticOrder S; S.init(M, g.N, F.G, (int)blockIdx.x);
            pg8::gemm_phase<pg8::EpiUni, pg8::StaticOrder, true, true>(F.lds, g, S, E);
        }
        else if (t == 6 || t == 10) {
            pg8::Gemm g; pg8::EpiResid E;
            g.M = M; g.N = DM; E.xl = (pg8::PG8_LAS_T*)(F.lds + RING_BYTES + 1024);
            E.xb = (GAS bf16*)(F.ws + WS_XB); E.outf = F.out; E.rsw = (GAS float*)(F.ws + WS_RS); E.xs = (GAS float*)(F.ws + WS_XS); E.resid = 1;
            if (t == 6) { g.A = (const GAS bf16*)(F.ws + WS_MERGED); g.Bt = (const GAS bf16*)(wl + W_OUT); g.K = DM;  E.gain = INP(F, I_NMPOST) + l * DM; E.cnt = (GAS unsigned*)(F.ctl + CW_PANEL) + (size_t)(l * 2 + 0) * 2 * 128 * 64; }
            else        { g.A = (const GAS bf16*)(F.ws + WS_L);      g.Bt = (const GAS bf16*)(wl + W_DN);  g.K = DFF; E.gain = INP(F, I_NFPOST) + l * DM; if (l + 1 == DEPTH) E.resid = 2; E.cnt = (GAS unsigned*)(F.ctl + CW_PANEL) + (size_t)(l * 2 + 1) * 2 * 128 * 64; }
            g.A = launder_p(g.A); g.Bt = launder_p(g.Bt); g.K = launder_u(g.K); E.gain = launder_p(E.gain); E.cnt = launder_p(E.cnt); E.resid = launder_u(E.resid);
            E.xb = launder_p(E.xb); E.outf = launder_p(E.outf); E.rsw = launder_p(E.rsw); E.xs = launder_p(E.xs);
            pg8::StaticOrder S; S.init(M, g.N, F.G, (int)blockIdx.x);
            pg8::gemm_phase<pg8::EpiResid, pg8::StaticOrder, true, true>(F.lds, g, S, E);
        }
        else if (t == 0) p0_prologue(F);
#ifdef C1_EXP
        else if (t == 3) { phase_mixers(F, l); phase_scan_c1<0>(F, l); phase_scan_c1<C1_EXP>(F, l); }
#else
        else if (t == 3) { phase_mixers(F, l); phase_scan_c1<0>(F, l); }
#endif
#ifdef C2_EXP
        else if (t == 4) { phase_scan_c2<0>(F, l); phase_scan_c2<C2_EXP>(F, l); }
#else
        else if (t == 4) phase_scan_c2<0>(F, l);
#endif
        else if (t == 5) phase_rwkv_post(F, l);
        else if (t == 9) phase_ffn_conv(F, l);
      }
#ifdef REPEAT_T
        if (step + 1 < hi) GRID_BAR();
#else
        if (ph + 1 < hi) GRID_BAR();
#endif
    }
    asm volatile("s_waitcnt vmcnt(0) lgkmcnt(0)" ::: "memory");
}


#ifdef DBG_CHECK
__global__ void dbg_check(const void* buf, size_t n, int kind, int code, unsigned* flag) {
    bool bad = false;
    for (size_t i = (size_t)blockIdx.x * blockDim.x + threadIdx.x; i < n; i += (size_t)gridDim.x * blockDim.x) {
        float v;
        if (kind == 0) v = bf2f(((const unsigned short*)buf)[i]);
        else if (kind == 1) v = ((const float*)buf)[i];
        else v = (float)((const _Float16*)buf)[i];
        if (!(fabsf(v) < 1e30f)) bad = true;
    }
    if (bad) atomicMax(flag, (unsigned)(1000000 - code));
}
__global__ void dbg_report(float* out, const unsigned* flag) { if (threadIdx.x == 0 && blockIdx.x == 0) { const unsigned f = *flag; if (f) out[0] = 100000.f * (float)(10 + 1000000 - (int)f); } }
#endif
extern "C" void kernel_launch(void* const* d_in, const int* in_sizes, int n_in, void* d_out, int out_size, void* d_ws, size_t ws_size, hipStream_t stream) {
    static int grid = 0;
    if (grid == 0) {
        if (n_in != 26 || in_sizes[0] != M * DM || out_size != M * DM || ws_size < WS_END) { fprintf(stderr, "kernel_launch: unexpected shapes: n_in %d in0 %d out %d ws %zu (need >= %zu)\n", n_in, n_in > 0 ? in_sizes[0] : -1, out_size, ws_size, (size_t)WS_END); grid = -1; return; }
        int dev = 0, cus = 0, per_cu = 0;
        if (hipGetDevice(&dev) != hipSuccess || hipDeviceGetAttribute(&cus, hipDeviceAttributeMultiprocessorCount, dev) != hipSuccess) { grid = -1; return; }
        if (hipFuncSetAttribute((const void*)enc_fwd, hipFuncAttributeMaxDynamicSharedMemorySize, LDS_BYTES) != hipSuccess) { fprintf(stderr, "kernel_launch: hipFuncSetAttribute failed\n"); grid = -1; return; }
        if (hipOccupancyMaxActiveBlocksPerMultiprocessor(&per_cu, (const void*)enc_fwd, NTHREADS, LDS_BYTES) != hipSuccess || per_cu < 1) { fprintf(stderr, "kernel_launch: occupancy query says %d blocks per CU\n", per_cu); }
        (void)hipGetLastError();
        grid = cus;
        if (grid != 256) fprintf(stderr, "kernel_launch: %d CUs (built for 256)\n", grid);
    }
    if (grid < 0) return;
    (void)hipMemsetAsync((char*)d_ws + WS_CTL, 0, CTL_ZERO_BYTES, stream);
    Args a{};
    for (int i = 0; i < 26; ++i) a.in[i] = (const float*)d_in[i];
    a.out = (float*)d_out; a.ws = (unsigned char*)d_ws;
#if MK_N_LAUNCHES == 1
#ifdef REPEAT_T
    a.ph_lo = 0; a.ph_hi = NPH + (REPEAT_T == 7 ? 1 : 2);
#else
    a.ph_lo = 0; a.ph_hi = NPH;
#endif
    hipLaunchKernelGGL(enc_fwd, dim3(grid), dim3(NTHREADS), LDS_BYTES, stream, a);
#else
    for (int p = 0; p < NPH; ++p) { a.ph_lo = p; a.ph_hi = p + 1; hipLaunchKernelGGL(enc_fwd, dim3(grid), dim3(NTHREADS), LDS_BYTES, stream, a);
#ifdef DBG_CHECK
        unsigned* flag = (unsigned*)((char*)d_ws + 512 * 1024); char* ws = (char*)d_ws; const int t = p == 0 ? 0 : 1 + (p - 1) % 10;
#define CHK(ptr, n, kind, sub) hipLaunchKernelGGL(dbg_check, dim3(2048), dim3(256), 0, stream, (const void*)(ptr), (size_t)(n), kind, p * 4 + sub, flag)
        if (t == 0) { CHK(ws + WS_W, 2 * W_LAYER / 2, 0, 0); CHK(ws + WS_XB, (size_t)M * DM, 0, 1); CHK(ws + WS_RS, M, 1, 2); }
        if (t == 1) { CHK(ws + WS_PROJ, (size_t)M * NPROJP, 0, 0); }
        if (t == 2) { CHK(ws + WS_PREP, (size_t)64 * MiB, 2, 1); }
        if (t == 3) { CHK(d_out, (size_t)2 * M * 256, 0, 0); }
        if (t == 4) { CHK(ws + WS_MERGED, (size_t)M * DM, 0, 0); }
        if (t == 5 || t == 9) { CHK(ws + WS_Y, (size_t)M * DM, 1, 0); CHK(ws + WS_PART, (size_t)M * 16, 1, 1); }
        if (t == 6 || t == 10) { CHK(d_out, (size_t)M * DM, 1, 0); CHK(ws + WS_XB, (size_t)M * DM, 0, 1); CHK(ws + WS_RS, M, 1, 2); }
        if (t == 7) { CHK(ws + WS_G, (size_t)M * DFF, 0, 0); CHK(ws + WS_L, (size_t)M * DFF, 0, 1); }
        if (t == 8) { CHK(ws + WS_L, (size_t)M * DFF, 0, 0); }
        if (p == NPH - 1) hipLaunchKernelGGL(dbg_report, dim3(1), dim3(64), 0, stream, (float*)d_out, (const unsigned*)flag);
#endif
    }
#endif
}
```

```cpp
#include <hip/hip_runtime.h>
#include <cstdio>
#include <cstdint>
namespace pg8 {
#define PG8_LAS __attribute__((address_space(3)))
#define PG8_GAS __attribute__((address_space(1)))
typedef PG8_LAS unsigned char PG8_LAS_T;
typedef unsigned short bf16_t;
typedef short bf16x8 __attribute__((ext_vector_type(8)));
typedef float f32x4 __attribute__((ext_vector_type(4)));
typedef unsigned u32x4 __attribute__((ext_vector_type(4)));
constexpr int BM = 256, BK = 64, HALF = 128, HTB = HALF * BK * 2  , STAGE_BYTES = 8 * HTB, NXCD = 8, WGM = 4;

__host__ __device__ __forceinline__ int lds_byte(int r, int c) { const int st = (r >> 4) * 2 + (c >> 5), rr = r & 15, cc = c & 31, ob = rr * 64 + cc * 2; return st * 1024 + (ob ^ (((ob >> 9) & 1) << 5)); }
__host__ __device__ __forceinline__ void stage_rc(int b, int& R, int& C) { const int st = b / 1024, sb = b % 1024, swz = sb ^ (((sb >> 9) & 1) << 5); R = (st >> 1) * 16 + swz / 64; C = (st & 1) * 32 + (swz % 64) / 2; }
__host__ __device__ __forceinline__ int perm32(int rho) { const int n = rho >> 4, i = rho & 15; return 8 * (i >> 2) + 4 * n + (i & 3); }

struct Unit { int pm, pn; };
struct Gemm { const PG8_GAS bf16_t* A; const PG8_GAS bf16_t* Bt; int M, N, K; };

struct StaticOrder {
    int nM, nN, nwg, G, c;
    __host__ __device__ void init(int M, int N, int G_, int c_) { nM = M / BM; nN = N / BM; nwg = nM * nN; G = G_; c = c_; }
    __host__ __device__ bool next(int i, Unit& u) const {
        const long L = (long)i * G + c; if (L >= nwg) return false;
        int wgid = (int)L; { const int q = nwg / NXCD, r = nwg % NXCD, xcd = wgid % NXCD, off = wgid / NXCD; wgid = (xcd < r ? xcd * (q + 1) : r * (q + 1) + (xcd - r) * q) + off; }
        const int nig = WGM * nN, gid = wgid / nig, fm = gid * WGM, gsz = (nM - fm) < WGM ? (nM - fm) : WGM;
        u.pm = fm + ((wgid % nig) % gsz); u.pn = (wgid % nig) / gsz; return true;
    }
    __device__ __forceinline__ void a_ready(const Unit&) const {}
    __device__ __forceinline__ void done(const Unit&) const {}
};
typedef float f32x2c __attribute__((ext_vector_type(2)));
typedef __bf16 bf16x2c __attribute__((ext_vector_type(2)));
__device__ __forceinline__ unsigned cvt_pk_bf16(float lo, float hi) { const f32x2c v = {lo, hi}; return __builtin_bit_cast(unsigned, __builtin_convertvector(v, bf16x2c)); }
struct EpiUni {
    static constexpr bool AFTER_DRAIN = false;
    PG8_GAS bf16_t* O; int ldc; const PG8_GAS float* rs; int split_cols; size_t split_stride; PG8_GAS float* part;
    const PG8_GAS float* convw; PG8_GAS bf16_t* G; PG8_LAS unsigned char* xl;
    __device__ __forceinline__ bool perm() const { return true; }
    template <int CTRL> static __device__ __forceinline__ float dppo(float old, float x) { return __builtin_bit_cast(float, __builtin_amdgcn_update_dpp(__builtin_bit_cast(int, old), __builtin_bit_cast(int, x), CTRL, 0xF, 0xF, false)); }
    static __device__ __forceinline__ float gelu_t(float x) { const float u = 1.5957691216057308f * x * (1.f + 0.044715f * x * x); return x * __builtin_amdgcn_rcpf(1.f + __expf(-u)); }
    __device__ __forceinline__ void conv_epi(const f32x4 (&acc_)[2][2][4][2], const Unit& u, int wr, int wc, int fr, int fq) const {
        f32x4 (&acc)[2][2][4][2] = const_cast<f32x4 (&)[2][2][4][2]>(acc_);
        const int hcol = u.pn * HALF + wc * 32 + 8 * fq;
        const PG8_GAS float* rsp = rs + u.pm * BM + wr * 64 + fr;
        constexpr int LDH = 2816;
        const unsigned lane_off = (unsigned)((wr * 64 + fr) * LDH + hcol) * 2u;
        PG8_GAS char* Ob = (PG8_GAS char*)(O + (size_t)u.pm * BM * LDH); PG8_GAS char* Gb = (PG8_GAS char*)(G + (size_t)u.pm * BM * LDH);
        unsigned lp[2][4][2][2];
#pragma unroll
        for (int ai = 0; ai < 2; ++ai)
#pragma unroll
            for (int m = 0; m < 4; ++m) { const float r = rsp[ai * HALF + m * 16];
#pragma unroll
                for (int n = 0; n < 2; ++n) { const f32x4 l4 = acc[ai][1][m][n] * r; lp[ai][m][n][0] = cvt_pk_bf16(l4[0], l4[1]); lp[ai][m][n][1] = cvt_pk_bf16(l4[2], l4[3]); } }
#pragma unroll
        for (int ai = 0; ai < 2; ++ai) { const int k = 2 * ai + wr;
            if (fr == 0)  { const float r = rsp[ai * HALF]; PG8_LAS f32x4* p = (PG8_LAS f32x4*)(xl + ((k * 2 + 0) * 4 + wc) * 128 + fq * 32); p[0] = acc[ai][0][0][0] * r; p[1] = acc[ai][0][0][1] * r; }
            if (fr == 15) { const float r = rsp[ai * HALF + 48]; PG8_LAS f32x4* p = (PG8_LAS f32x4*)(xl + ((k * 2 + 1) * 4 + wc) * 128 + fq * 32); p[0] = acc[ai][0][3][0] * r; p[1] = acc[ai][0][3][1] * r; } }
        asm volatile("s_waitcnt lgkmcnt(0)" ::: "memory"); __builtin_amdgcn_s_barrier(); asm volatile("" ::: "memory");
#pragma unroll
        for (int ai = 0; ai < 2; ++ai) { const int k = 2 * ai + wr;
            float rsv[4];
#pragma unroll
            for (int m = 0; m < 4; ++m) { rsv[m] = rsp[ai * HALF + m * 16];
#pragma unroll
                for (int n = 0; n < 2; ++n) acc[ai][0][m][n] = acc[ai][0][m][n] * rsv[m]; }
            const int ku = k > 0 ? k - 1 : 0, kd = k < 3 ? k + 1 : 3;
#pragma unroll
            for (int n = 0; n < 2; ++n) {
                float w0[4], w1[4], w2[4];
#pragma unroll
                for (int j = 0; j < 4; ++j) { w0[j] = convw[hcol + 4 * n + j]; w1[j] = convw[LDH + hcol + 4 * n + j]; w2[j] = convw[2 * LDH + hcol + 4 * n + j]; }
                const f32x4 xt = *(const PG8_LAS f32x4*)(xl + ((ku * 2 + 1) * 4 + wc) * 128 + fq * 32 + n * 16), xb = *(const PG8_LAS f32x4*)(xl + ((kd * 2 + 0) * 4 + wc) * 128 + fq * 32 + n * 16);
#pragma unroll
                for (int m = 0; m < 4; ++m) { const int tr = 64 * k + 16 * m + fr; const unsigned coff = (unsigned)((ai * HALF + 16 * m) * LDH * 2 + 8 * n);
                    float hv[4];
#pragma unroll
                    for (int e = 0; e < 4; ++e) { const float cur = acc[ai][0][m][n][e];
                        const float upx = (m > 0) ? dppo<0x121>(0.f, acc[ai][0][m > 0 ? m - 1 : 0][n][e]) : xt[e];
                        const float dnx = (m < 3) ? dppo<0x12F>(0.f, acc[ai][0][m < 3 ? m + 1 : 3][n][e]) : xb[e];
                        const float up = dppo<0x111>(upx, cur), dn = dppo<0x101>(dnx, cur);
                        const float a = w0[e] * up + w1[e] * cur + w2[e] * dn;
                        const unsigned lw = lp[ai][m][n][e >> 1]; const float lv = (e & 1) ? __builtin_bit_cast(float, lw & 0xffff0000u) : __builtin_bit_cast(float, lw << 16);
                        hv[e] = (tr == 0 || tr == 255) ? lv : gelu_t(a) * lv; }
                    typedef unsigned u32x2_ __attribute__((ext_vector_type(2)));
                    u32x2_ w; w.x = cvt_pk_bf16(hv[0], hv[1]); w.y = cvt_pk_bf16(hv[2], hv[3]);
                    *(PG8_GAS u32x2_*)(Ob + coff + lane_off) = w;
                    if (tr <= 1 || tr >= 254) { u32x2_ gw; gw.x = cvt_pk_bf16(acc[ai][0][m][n][0], acc[ai][0][m][n][1]); gw.y = cvt_pk_bf16(acc[ai][0][m][n][2], acc[ai][0][m][n][3]);
                        *(PG8_GAS u32x2_*)(Gb + coff + lane_off) = gw; }
                    __builtin_amdgcn_sched_barrier(0); }
                asm volatile("" ::: "memory");
            }
        }
    }
    __device__ __forceinline__ void operator()(const f32x4 (&acc)[2][2][4][2], const Unit& u, int wr, int wc, int fr, int fq) const {
        if (convw != nullptr) { conv_epi(acc, u, wr, wc, fr, fq); return; }
        const int row0 = u.pm * BM + wr * 64 + fr; int colt = u.pn * BM; PG8_GAS bf16_t* base = O;
        if (split_cols) { const int t = colt / split_cols; base += (size_t)t * split_stride; colt -= t * split_cols; }
        const int col0 = colt + wc * 32 + 8 * fq;
        if (part == nullptr) {
#pragma unroll
            for (int ai = 0; ai < 2; ++ai)
#pragma unroll
                for (int m = 0; m < 4; ++m) { const int row = row0 + ai * HALF + m * 16; const float s = rs[row]; PG8_GAS bf16_t* rowp = base + (size_t)row * ldc + col0;
#pragma unroll
                    for (int bj = 0; bj < 2; ++bj) { const f32x4 v0 = acc[ai][bj][m][0] * s, v1 = acc[ai][bj][m][1] * s;
                        u32x4 w; w.x = cvt_pk_bf16(v0[0], v0[1]); w.y = cvt_pk_bf16(v0[2], v0[3]); w.z = cvt_pk_bf16(v1[0], v1[1]); w.w = cvt_pk_bf16(v1[2], v1[3]);
                        *(PG8_GAS u32x4*)(rowp + bj * HALF) = w; } }
        } else {
#pragma unroll
            for (int ai = 0; ai < 2; ++ai)
#pragma unroll
                for (int m = 0; m < 4; ++m) { const int row = row0 + ai * HALF + m * 16; PG8_GAS bf16_t* rowp = base + (size_t)row * ldc + col0; float ss = 0.f;
#pragma unroll
                    for (int bj = 0; bj < 2; ++bj) { const f32x4 v0 = acc[ai][bj][m][0], v1 = acc[ai][bj][m][1];
                        ss += ((v0[0] * v0[0] + v0[1] * v0[1]) + (v0[2] * v0[2] + v0[3] * v0[3])) + ((v1[0] * v1[0] + v1[1] * v1[1]) + (v1[2] * v1[2] + v1[3] * v1[3]));
                        u32x4 w; w.x = cvt_pk_bf16(v0[0], v0[1]); w.y = cvt_pk_bf16(v0[2], v0[3]); w.z = cvt_pk_bf16(v1[0], v1[1]); w.w = cvt_pk_bf16(v1[2], v1[3]);
                        *(PG8_GAS u32x4*)(rowp + bj * HALF) = w; }
                    ss += __shfl_xor(ss, 16); ss += __shfl_xor(ss, 32); if (fq == 0) part[(size_t)row * 16 + u.pn * 4 + wc] = ss; }
        }
    }
};
struct EpiResid {
    static constexpr bool AFTER_DRAIN = false;
    PG8_LAS unsigned char* xl;
    __device__ __forceinline__ bool perm() const { return true; }
    int resid; const PG8_GAS float* gain; PG8_GAS bf16_t* xb; PG8_GAS float* outf; PG8_GAS float* rsw; PG8_GAS float* xs; PG8_GAS unsigned* cnt;
    static __device__ __forceinline__ f32x4 unlo(unsigned a, unsigned b) { return (f32x4){__builtin_bit_cast(float, a << 16), __builtin_bit_cast(float, a & 0xffff0000u), __builtin_bit_cast(float, b << 16), __builtin_bit_cast(float, b & 0xffff0000u)}; }
    static __device__ __forceinline__ float hsum(const f32x4 v) { return (v[0] + v[1]) + (v[2] + v[3]); }
    __device__ __forceinline__ void resid_epi(const f32x4 (&acc_)[2][2][4][2], const Unit& u, int, int, int, int) const {
        f32x4 (&acc)[2][2][4][2] = const_cast<f32x4 (&)[2][2][4][2]>(acc_);
        int tid = threadIdx.x; asm volatile("" : "+v"(tid));
        const int wid = __builtin_amdgcn_readfirstlane(tid >> 6), wr = wid >> 2, wc = wid & 3, fr = tid & 15, fq = (tid >> 4) & 3;
        const int col0 = u.pn * BM + wc * 32 + 8 * fq;
        const unsigned lane_e = (unsigned)((wr * 64 + fr) * 1024 + col0);
        PG8_GAS char* xbb = (PG8_GAS char*)(xb + (size_t)u.pm * BM * 1024); PG8_GAS char* outb = (PG8_GAS char*)(outf + (size_t)u.pm * BM * 1024);
        PG8_LAS f32x4* P4 = (PG8_LAS f32x4*)xl; PG8_LAS float* S2 = (PG8_LAS float*)(xl + 16384);
        PG8_LAS float* GW = (PG8_LAS float*)(xl + 18432) + (wr * 4 + wc) * 64;
        { const int ln = fq * 16 + fr; GW[ln] = gain[u.pn * BM + (ln >> 5) * HALF + wc * 32 + (ln & 31)]; }
#pragma unroll
        for (int ai = 0; ai < 2; ++ai)
#pragma unroll
            for (int m = 0; m < 4; ++m) {
#pragma unroll
                for (int bj = 0; bj < 2; ++bj) { const f32x4 v0 = acc[ai][bj][m][0], v1 = acc[ai][bj][m][1];
                    u32x4 p; p.x = cvt_pk_bf16(v0[0], v0[1]); p.y = cvt_pk_bf16(v0[2], v0[3]); p.z = cvt_pk_bf16(v1[0], v1[1]); p.w = cvt_pk_bf16(v1[2], v1[3]);
                    acc[ai][bj][m][0] = __builtin_bit_cast(f32x4, p); }
                __builtin_amdgcn_sched_barrier(0); }
#define PG8_XLD(it_) do { unsigned le_ = lane_e; asm volatile("" : "+v"(le_)); _Pragma("unroll") for (int bj = 0; bj < 2; ++bj) \
            xq[(it_) % 3][bj] = *(const PG8_GAS u32x4*)(xbb + (size_t)((unsigned)(((((it_) >> 2) * HALF) + 16 * ((it_) & 3)) * 1024 + bj * HALF) + le_) * 2); } while (0)
        {   u32x4 xq[3][2];
            PG8_XLD(0); PG8_XLD(1);
#pragma unroll
            for (int it = 0; it < 8; ++it) { const int ai = it >> 2, m = it & 3;
                if (it + 2 < 8) PG8_XLD(it + 2);
                float sa = 0.f, sb = 0.f, sc = 0.f, sd = 0.f;
#pragma unroll
                for (int bj = 0; bj < 2; ++bj) { f32x4 py_ = acc[ai][bj][m][0]; asm volatile("" : "+v"(py_));
                    const u32x4 p = __builtin_bit_cast(u32x4, py_), xw = xq[it % 3][bj];
                    const f32x4 g0 = *(const PG8_LAS f32x4*)(GW + bj * 32 + 8 * fq), g1 = *(const PG8_LAS f32x4*)(GW + bj * 32 + 8 * fq + 4);
                    const f32x4 y0 = unlo(p.x, p.y), y1 = unlo(p.z, p.w), x0 = unlo(xw.x, xw.y), x1 = unlo(xw.z, xw.w), q0 = y0 * g0, q1 = y1 * g1;
                    sa += hsum(y0 * y0) + hsum(y1 * y1); sb += hsum(x0 * x0) + hsum(x1 * x1); sc += hsum(x0 * q0) + hsum(x1 * q1); sd += hsum(q0 * q0) + hsum(q1 * q1); }
                sa += __shfl_xor(sa, 16); sb += __shfl_xor(sb, 16); sc += __shfl_xor(sc, 16); sd += __shfl_xor(sd, 16);
                sa += __shfl_xor(sa, 32); sb += __shfl_xor(sb, 32); sc += __shfl_xor(sc, 32); sd += __shfl_xor(sd, 32);
                if (fq == 0) P4[(ai * HALF + wr * 64 + m * 16 + fr) * 4 + wc] = (f32x4){sa, sb, sc, sd};
                __builtin_amdgcn_sched_barrier(0); } }
        asm volatile("s_waitcnt lgkmcnt(0)" ::: "memory"); __builtin_amdgcn_s_barrier(); asm volatile("" ::: "memory");
        PG8_GAS float* slot = xs + (size_t)u.pm * BM * 16;
        PG8_GAS unsigned* c = cnt + u.pm * 64;
        if (tid < 256) { const f32x4 t4 = (P4[tid * 4 + 0] + P4[tid * 4 + 1]) + (P4[tid * 4 + 2] + P4[tid * 4 + 3]);
#pragma unroll
            for (int j = 0; j < 4; ++j) __hip_atomic_store(slot + tid * 16 + u.pn * 4 + j, t4[j], __ATOMIC_RELAXED, __HIP_MEMORY_SCOPE_AGENT);
            asm volatile("s_waitcnt vmcnt(0)" ::: "memory");
            if ((tid & 63) == 0) __hip_atomic_fetch_add(c, 1u, __ATOMIC_RELAXED, __HIP_MEMORY_SCOPE_AGENT); }
        if (tid < 64) { unsigned spins = 0;
            while ((unsigned)__builtin_amdgcn_readfirstlane(__hip_atomic_load(c, __ATOMIC_RELAXED, __HIP_MEMORY_SCOPE_AGENT)) < 16u) { __builtin_amdgcn_s_sleep(2); if (++spins > (1u << 22)) break; }
            __builtin_amdgcn_fence(__ATOMIC_ACQUIRE, "agent"); asm volatile("s_waitcnt vmcnt(0)" ::: "memory"); }
        asm volatile("s_waitcnt lgkmcnt(0)" ::: "memory"); __builtin_amdgcn_s_barrier(); asm volatile("" ::: "memory");
        if (tid < 256) { float t[4] = {0.f, 0.f, 0.f, 0.f};
#pragma unroll
            for (int q = 0; q < 4; ++q)
#pragma unroll
                for (int j = 0; j < 4; ++j) t[j] += __hip_atomic_load(slot + tid * 16 + q * 4 + j, __ATOMIC_RELAXED, __HIP_MEMORY_SCOPE_AGENT);
            const float ry = __builtin_amdgcn_rsqf(t[0] * (1.f / 1024.f) + 1e-6f);
            const float sx = t[1] + ry * (2.f * t[2] + ry * t[3]);
            const float rn = __builtin_amdgcn_rsqf(sx * (1.f / 1024.f) + 1e-6f);
            S2[tid * 2] = ry; S2[tid * 2 + 1] = rn;
            if (resid == 1 && u.pn == 0) rsw[(size_t)u.pm * BM + tid] = rn; }
        asm volatile("s_waitcnt lgkmcnt(0)" ::: "memory"); __builtin_amdgcn_s_barrier(); asm volatile("" ::: "memory");
        {   u32x4 xq[3][2];
            PG8_XLD(0); PG8_XLD(1);
#pragma unroll
            for (int it = 0; it < 8; ++it) { const int ai = it >> 2, m = it & 3;
                if (it + 2 < 8) PG8_XLD(it + 2);
                const float sc = S2[(ai * HALF + wr * 64 + m * 16 + fr) * 2];
                unsigned le = lane_e; asm volatile("" : "+v"(le));
#pragma unroll
                for (int bj = 0; bj < 2; ++bj) { const unsigned ce = (unsigned)((ai * HALF + 16 * m) * 1024 + bj * HALF);
                    f32x4 py_ = acc[ai][bj][m][0]; asm volatile("" : "+v"(py_));
                    const u32x4 p = __builtin_bit_cast(u32x4, py_), xw = xq[it % 3][bj];
                    const f32x4 g0 = *(const PG8_LAS f32x4*)(GW + bj * 32 + 8 * fq), g1 = *(const PG8_LAS f32x4*)(GW + bj * 32 + 8 * fq + 4);
                    const f32x4 v0 = unlo(xw.x, xw.y) + unlo(p.x, p.y) * sc * g0, v1 = unlo(xw.z, xw.w) + unlo(p.z, p.w) * sc * g1;
                    if (resid == 2) { PG8_GAS f32x4* op = (PG8_GAS f32x4*)(outb + (size_t)(ce + le) * 4); op[0] = v0; op[1] = v1; }
                    else { u32x4 w; w.x = cvt_pk_bf16(v0[0], v0[1]); w.y = cvt_pk_bf16(v0[2], v0[3]); w.z = cvt_pk_bf16(v1[0], v1[1]); w.w = cvt_pk_bf16(v1[2], v1[3]);
                        *(PG8_GAS u32x4*)(xbb + (size_t)(ce + le) * 2) = w; } }
                asm volatile("" ::: "memory"); __builtin_amdgcn_sched_barrier(0); } }
#undef PG8_XLD
    }
    __device__ __forceinline__ void operator()(const f32x4 (&acc)[2][2][4][2], const Unit& u, int wr, int wc, int fr, int fq) const { resid_epi(acc, u, wr, wc, fr, fq); }
};
template <class Epi, class Sched, bool ALIGN_EPI = false, bool SP2 = false>
__device__ __forceinline__ void gemm_phase(PG8_LAS unsigned char* lds, const Gemm g, const Sched& S, const Epi& E) {
    int tid_ = threadIdx.x; asm volatile("" : "+v"(tid_));
    const int tid = tid_, wid = __builtin_amdgcn_readfirstlane(tid >> 6), lane = tid & 63, wr = wid >> 2, wc = wid & 3, fr = lane & 15, fq = lane >> 4;
    const int K = g.K, nt = K / BK;
    unsigned voffA[2], voffB[2];
#pragma unroll
    for (int i = 0; i < 2; ++i) { int R, C; stage_rc(tid * 16 + i * 8192, R, C); const int Rb = E.perm() ? ((R & ~31) + perm32(R & 31)) : R;
        voffA[i] = (unsigned)(R * K + C) * 2u; voffB[i] = (unsigned)(Rb * K + C) * 2u; }
    const size_t kstep = (size_t)(BK * 2);
    const size_t hstep = (size_t)HALF * K * 2;
    const size_t tstep = 2 * hstep;
    const unsigned ldsw = (unsigned)wid * 1024u;
    const int aoff = lds_byte(wr * 64 + fr, fq * 8), boff = lds_byte(wc * 32 + fr, fq * 8);
#define PG8_SA(b, h) (((b) * 2 + (h)) * HTB)
#define PG8_SB(b, h) ((4 + (b) * 2 + (h)) * HTB)
#define PG8_STAGE(bufoff, gbase, voff) do { _Pragma("unroll") for (int _i = 0; _i < 2; ++_i) \
        __builtin_amdgcn_global_load_lds((const PG8_GAS unsigned*)((const PG8_GAS char*)(gbase) + (voff)[_i]), (PG8_LAS unsigned*)(lds + (bufoff) + ldsw + _i * 8192), 16, 0, 0); } while (0)
#define PG8_LDA(dst, b, h) do { _Pragma("unroll") for (int m = 0; m < 4; ++m) _Pragma("unroll") for (int k = 0; k < 2; ++k) dst[m][k] = *(const PG8_LAS bf16x8*)(lds + PG8_SA(b, h) + aoff + m * 2048 + k * 1024); } while (0)
#define PG8_LDB(dst, b, h) do { _Pragma("unroll") for (int n = 0; n < 2; ++n) _Pragma("unroll") for (int k = 0; k < 2; ++k) dst[n][k] = *(const PG8_LAS bf16x8*)(lds + PG8_SB(b, h) + boff + n * 2048 + k * 1024); } while (0)
#define PG8_MMA(ai, bj, At, Bt) do { __builtin_amdgcn_s_setprio(1); _Pragma("unroll") for (int m = 0; m < 4; ++m) _Pragma("unroll") for (int n = 0; n < 2; ++n) _Pragma("unroll") for (int k = 0; k < 2; ++k) \
        acc[ai][bj][m][n] = __builtin_amdgcn_mfma_f32_16x16x32_bf16(Bt[n][k], At[m][k], acc[ai][bj][m][n], 0, 0, 0); __builtin_amdgcn_s_setprio(0); } while (0)
#define PG8_WAIT_V(n) asm volatile("s_waitcnt vmcnt(" #n ")" ::: "memory")
#define PG8_WAIT_L(n) asm volatile("s_waitcnt lgkmcnt(" #n ")" ::: "memory")
#define PG8_BAR __builtin_amdgcn_s_barrier()
#define PG8_SCHED __builtin_amdgcn_sched_barrier(0)
    Unit cur, nxt; int ui = 0;
    if (!S.next(0, cur)) return;
    f32x4 acc[2][2][4][2];
#pragma unroll
    for (int a = 0; a < 2; ++a)
#pragma unroll
        for (int b = 0; b < 2; ++b)
#pragma unroll
            for (int m = 0; m < 4; ++m)
#pragma unroll
                for (int n = 0; n < 2; ++n) acc[a][b][m][n] = (f32x4){0.f, 0.f, 0.f, 0.f};
    bf16x8 At[4][2], B0[2][2], B1[2][2];
    const PG8_GAS char* cA = (const PG8_GAS char*)g.A + (size_t)cur.pm * tstep; const PG8_GAS char* cB = (const PG8_GAS char*)g.Bt + (size_t)cur.pn * tstep;
    S.a_ready(cur);
    if constexpr (SP2) {
        PG8_STAGE(PG8_SB(0, 0), cB, voffB); PG8_STAGE(PG8_SB(0, 1), cB + hstep, voffB); PG8_STAGE(PG8_SA(0, 0), cA, voffA); PG8_STAGE(PG8_SA(0, 1), cA + hstep, voffA);
        if (wr == 1) PG8_BAR;
        PG8_WAIT_V(2); PG8_BAR;
        PG8_STAGE(PG8_SB(1, 0), cB + kstep, voffB); PG8_STAGE(PG8_SA(1, 0), cA + kstep, voffA); PG8_STAGE(PG8_SB(1, 1), cB + hstep + kstep, voffB);
        PG8_WAIT_V(6); PG8_BAR;
    } else {
        PG8_STAGE(PG8_SB(0, 0), cB, voffB); PG8_STAGE(PG8_SA(0, 0), cA, voffA); PG8_STAGE(PG8_SB(0, 1), cB + hstep, voffB); PG8_STAGE(PG8_SA(0, 1), cA + hstep, voffA);
        if (wr == 1) PG8_BAR;
        PG8_WAIT_V(4); PG8_BAR;
        PG8_STAGE(PG8_SB(1, 0), cB + kstep, voffB); PG8_STAGE(PG8_SA(1, 0), cA + kstep, voffA); PG8_STAGE(PG8_SB(1, 1), cB + hstep + kstep, voffB);
        PG8_WAIT_V(6); PG8_BAR;
    }
    for (;;) {
        const bool has_next = S.next(ui + 1, nxt);
        const PG8_GAS char* nA = has_next ? (const PG8_GAS char*)g.A + (size_t)nxt.pm * tstep : cA; const PG8_GAS char* nB = has_next ? (const PG8_GAS char*)g.Bt + (size_t)nxt.pn * tstep : cB;
        for (int t = 0; t < nt; t += 2) {
            const bool last = (t == nt - 2);
            const PG8_GAS char* a1 = cA + (size_t)(t + 1) * kstep;
            const PG8_GAS char* a2 = last ? nA : cA + (size_t)(t + 2) * kstep; const PG8_GAS char* b2 = last ? nB : cB + (size_t)(t + 2) * kstep;
            const PG8_GAS char* a3 = a2 + kstep; const PG8_GAS char* b3 = b2 + kstep;
            if (last && has_next) S.a_ready(nxt);
            if constexpr (SP2) {
            PG8_LDB(B0, 0, 0); PG8_LDB(B1, 0, 1); PG8_SCHED; PG8_LDA(At, 0, 0); PG8_STAGE(PG8_SA(1, 1), a1 + hstep, voffA);
            PG8_WAIT_V(8); PG8_WAIT_L(0); PG8_BAR; PG8_MMA(0, 0, At, B0); PG8_MMA(0, 1, At, B1); PG8_BAR; PG8_SCHED;
            PG8_LDA(At, 0, 1); PG8_STAGE(PG8_SB(0, 0), b2, voffB); PG8_STAGE(PG8_SB(0, 1), b2 + hstep, voffB); PG8_STAGE(PG8_SA(0, 0), a2, voffA);
            PG8_WAIT_V(8); PG8_WAIT_L(0); PG8_BAR; PG8_MMA(1, 0, At, B0); PG8_MMA(1, 1, At, B1); PG8_BAR; PG8_SCHED;
            PG8_LDB(B0, 1, 0); PG8_LDB(B1, 1, 1); PG8_SCHED; PG8_LDA(At, 1, 0); PG8_STAGE(PG8_SA(0, 1), a2 + hstep, voffA);
            PG8_WAIT_V(8); PG8_WAIT_L(0); PG8_BAR; PG8_MMA(0, 0, At, B0); PG8_MMA(0, 1, At, B1); PG8_BAR; PG8_SCHED;
            PG8_LDA(At, 1, 1); PG8_STAGE(PG8_SB(1, 0), b3, voffB); PG8_STAGE(PG8_SB(1, 1), b3 + hstep, voffB); PG8_STAGE(PG8_SA(1, 0), a3, voffA);
            PG8_WAIT_V(8); PG8_WAIT_L(0); PG8_BAR; PG8_MMA(1, 0, At, B0); PG8_MMA(1, 1, At, B1); PG8_BAR; PG8_SCHED;
            } else {
            PG8_LDB(B0, 0, 0); PG8_SCHED; PG8_LDA(At, 0, 0); PG8_STAGE(PG8_SA(1, 1), a1 + hstep, voffA);
            PG8_WAIT_L(8); PG8_BAR; PG8_WAIT_L(0); PG8_MMA(0, 0, At, B0); PG8_BAR; PG8_SCHED;
            PG8_LDB(B1, 0, 1); PG8_STAGE(PG8_SB(0, 0), b2, voffB);
            PG8_BAR; PG8_WAIT_L(0); PG8_MMA(0, 1, At, B1); PG8_BAR;
            PG8_LDA(At, 0, 1); PG8_STAGE(PG8_SA(0, 0), a2, voffA);
            PG8_BAR; PG8_WAIT_L(0); PG8_MMA(1, 0, At, B0); PG8_BAR; PG8_SCHED;
            PG8_STAGE(PG8_SB(0, 1), b2 + hstep, voffB);
            PG8_WAIT_V(6); PG8_BAR; PG8_MMA(1, 1, At, B1); PG8_BAR;
            PG8_LDB(B0, 1, 0); PG8_SCHED; PG8_LDA(At, 1, 0); PG8_STAGE(PG8_SA(0, 1), a2 + hstep, voffA);
            PG8_WAIT_L(8); PG8_BAR; PG8_WAIT_L(0); PG8_MMA(0, 0, At, B0); PG8_BAR; PG8_SCHED;
            PG8_LDB(B1, 1, 1); PG8_STAGE(PG8_SB(1, 0), b3, voffB);
            PG8_BAR; PG8_WAIT_L(0); PG8_MMA(0, 1, At, B1); PG8_BAR;
            PG8_LDA(At, 1, 1); PG8_STAGE(PG8_SA(1, 0), a3, voffA);
            PG8_BAR; PG8_WAIT_L(0); PG8_MMA(1, 0, At, B0); PG8_BAR; PG8_SCHED;
            PG8_STAGE(PG8_SB(1, 1), b3 + hstep, voffB);
            PG8_WAIT_V(6); PG8_BAR; PG8_MMA(1, 1, At, B1); PG8_BAR;
            }
        }
        if constexpr (ALIGN_EPI) { if (wr == 0) PG8_BAR; }
        if constexpr (!Epi::AFTER_DRAIN) { E(acc, cur, wr, wc, fr, fq); S.done(cur); }
        if (!has_next) break;
#pragma unroll
        for (int a = 0; a < 2; ++a)
#pragma unroll
            for (int b = 0; b < 2; ++b)
#pragma unroll
                for (int m = 0; m < 4; ++m)
#pragma unroll
                    for (int n = 0; n < 2; ++n) acc[a][b][m][n] = (f32x4){0.f, 0.f, 0.f, 0.f};
        cur = nxt; cA = nA; cB = nB; ++ui;
        if constexpr (ALIGN_EPI) { if (wr == 1) PG8_BAR; }
    }
    PG8_WAIT_V(0);
    if constexpr (!ALIGN_EPI) { if (wr == 0) PG8_BAR; }
    PG8_BAR;
    if constexpr (Epi::AFTER_DRAIN) { E.fused(acc, cur, wr, wc, fr, fq, lds, wid, lane); S.done(cur); }
#undef PG8_SA
#undef PG8_SB
#undef PG8_STAGE
#undef PG8_LDA
#undef PG8_LDB
#undef PG8_MMA
#undef PG8_WAIT_V
#undef PG8_WAIT_L
#undef PG8_BAR
#undef PG8_SCHED
}
}

constexpr int NB = 8, T = 4096, DM = 1024, M = NB * T, DEPTH = 2;
constexpr int NPROJ = 2912, NPROJP = 3072, DFF = 2816, NUP = 2 * DFF;
constexpr int C_CH = 0, C_CB = 256, C_CC = 512, C_R = 768, C_K = 1024, C_V = 1280, C_DEC = 1536, C_GDN = 1600, C_NQ = 1632, C_NK = 1888, C_NV = 2144, C_SU = 2400, C_SV = 2656;
constexpr float NORM_EPS = 1e-6f, GN_EPS = 64e-5f, DECAY_SCALE = 0.60653065971263342f;
constexpr int NWAVES = 8, NTHREADS = 512;
constexpr size_t MiB = 1u << 20;
constexpr size_t WS_CTL = 0, CTL_ZERO_BYTES = 1 * MiB;
constexpr size_t WS_RS = 1 * MiB;
constexpr size_t WS_PART = 1 * MiB + 256 * 1024;
constexpr size_t WS_W = 4 * MiB, W_LAYER = 24 * MiB + 512 * 1024;
constexpr size_t W_IN = 0, W_OUT = 6 * MiB, W_UP = 8 * MiB, W_DN = 19 * MiB;
constexpr size_t WS_XB = 53 * MiB;
constexpr size_t WS_R = 117 * MiB;
constexpr size_t WS_PROJ = WS_R, WS_MERGED = WS_R + 192 * MiB, WS_PREP = WS_R + 256 * MiB;
constexpr size_t GT_CHUNK = 12800, GT_DIR = (size_t)NB * 4 * 256 * GT_CHUNK;
constexpr size_t WS_GT0 = WS_PREP, WS_YSC0 = WS_PREP + 100 * MiB;
static_assert(GT_DIR == 100 * MiB, "GT size");
constexpr size_t WS_Y = WS_R;
constexpr size_t WS_G = WS_R, WS_L = WS_R + 176 * MiB;
constexpr size_t WS_END = 501 * MiB;
static_assert(WS_W + 2 * W_LAYER <= WS_XB && WS_PREP + 128 * MiB <= WS_END && WS_L + 176 * MiB <= WS_END && WS_PART + (size_t)M * 64 <= WS_W, "ws map");
constexpr int CW_BAR = 4096;
constexpr int CW_PANEL = 16384;
constexpr size_t WS_XS = WS_PART;
constexpr int RING_BYTES = 131072, LDSCTL_OFF = RING_BYTES, MISC_OFF = LDSCTL_OFF + 320, LDS_BYTES = 152576;

#define GAS __attribute__((address_space(1)))
#define LAS __attribute__((address_space(3)))
typedef unsigned short bf16;
typedef unsigned v4u __attribute__((ext_vector_type(4)));
typedef unsigned v2u __attribute__((ext_vector_type(2)));
typedef float f32x4 __attribute__((ext_vector_type(4)));
typedef short bf16x8 __attribute__((ext_vector_type(8)));
typedef short s16x4 __attribute__((ext_vector_type(4)));
typedef _Float16 h2 __attribute__((ext_vector_type(2)));
typedef GAS unsigned gu32;
#define RLX_AGENT __ATOMIC_RELAXED, __HIP_MEMORY_SCOPE_AGENT
__device__ __forceinline__ unsigned pk2(float lo, float hi) { return pg8::cvt_pk_bf16(lo, hi); }
__device__ __forceinline__ unsigned f2bf(float f) { return (unsigned)__builtin_bit_cast(unsigned short, (__bf16)f); }
__device__ __forceinline__ float bflo(unsigned w) { return __builtin_bit_cast(float, w << 16); }
__device__ __forceinline__ float bfhi(unsigned w) { return __builtin_bit_cast(float, w & 0xffff0000u); }
__device__ __forceinline__ float bf2f(unsigned short b) { return __builtin_bit_cast(float, (unsigned)b << 16); }
__device__ __forceinline__ h2 as_h2(unsigned u) { return __builtin_bit_cast(h2, u); }
template <int CTRL> __device__ __forceinline__ float dppmov(float x) { return __builtin_bit_cast(float, __builtin_amdgcn_update_dpp(0, __builtin_bit_cast(int, x), CTRL, 0xF, 0xF, true)); }
__device__ __forceinline__ float row16_sum(float x) { x += dppmov<0xB1>(x); x += dppmov<0x4E>(x); x += dppmov<0x141>(x); x += dppmov<0x140>(x); return x; }
typedef unsigned u32x2_t __attribute__((ext_vector_type(2)));
__device__ __forceinline__ float xor16_sum(float x) { const u32x2_t r = __builtin_amdgcn_permlane16_swap(__builtin_bit_cast(unsigned, x), __builtin_bit_cast(unsigned, x), false, false);
    const unsigned a = r.x, b = r.y; return __builtin_bit_cast(float, a) + __builtin_bit_cast(float, b); }
__device__ __forceinline__ float xor32_sum(float x) { const u32x2_t r = __builtin_amdgcn_permlane32_swap(__builtin_bit_cast(unsigned, x), __builtin_bit_cast(unsigned, x), false, false);
    const unsigned a = r.x, b = r.y; return __builtin_bit_cast(float, a) + __builtin_bit_cast(float, b); }
__device__ __forceinline__ float wave_sum(float v) { return xor32_sum(xor16_sum(row16_sum(v))); }
__device__ __forceinline__ float row16_max(float x) { x = fmaxf(x, dppmov<0xB1>(x)); x = fmaxf(x, dppmov<0x4E>(x)); x = fmaxf(x, dppmov<0x141>(x)); x = fmaxf(x, dppmov<0x140>(x)); return x; }
__device__ __forceinline__ float rcpf_(float x) { return __builtin_amdgcn_rcpf(x); }
__device__ __forceinline__ float rsqf_(float x) { return __builtin_amdgcn_rsqf(x); }
__device__ __forceinline__ float sigmoidf_(float x) { return rcpf_(1.f + __expf(-x)); }
__device__ __forceinline__ float tanhf_(float x) { return 1.f - 2.f * rcpf_(__expf(2.f * x) + 1.f); }
__device__ __forceinline__ float gelu_tanh(float x) { const float u = 1.5957691216057308f * x * (1.f + 0.044715f * x * x); return x * rcpf_(1.f + __expf(-u)); }
#define XB_TMO      128
#define XB_XCNT(j)  (256  + 64 * (j))
#define XB_XSUB(j)  (1280 + 64 * (j))
#define XB_XGEN(j)  (2304 + 64 * (j))
#define XB_TOP      3328
#define XB_TOPGEN   3392
#define XCD_BAR_WORDS 3456
#define XB_SPIN_CAP (1u << 18)

__device__ __forceinline__ unsigned xb_ld(unsigned* p)              { return __hip_atomic_load(p, __ATOMIC_RELAXED, __HIP_MEMORY_SCOPE_AGENT); }
__device__ __forceinline__ unsigned xb_add(unsigned* p, unsigned v) { return __hip_atomic_fetch_add(p, v, __ATOMIC_RELAXED, __HIP_MEMORY_SCOPE_AGENT); }
__device__ __forceinline__ unsigned xb_xcc_id() { return (unsigned)__builtin_amdgcn_s_getreg((3 << 11) | 20) & 0xFu; }
#define XB_SPIN(cond, bar) do { unsigned _sp = 0; while (cond) { __builtin_amdgcn_s_sleep(1); \
    if ((++_sp & 255u) == 0u) { if (xb_ld(&(bar)[XB_TMO])) break; if (_sp > XB_SPIN_CAP) { atomicAdd(&(bar)[XB_TMO], 1u); break; } } } } while (0)

struct XcdBarrier {
    unsigned* bar; unsigned x;
    volatile LAS unsigned* st;
};

__device__ __forceinline__ XcdBarrier xcd_barrier_post(unsigned* bar, volatile LAS unsigned* st) {
    XcdBarrier b; b.bar = bar; b.x = xb_xcc_id(); b.st = st;
    if (threadIdx.x == 0) (void)xb_add(&bar[XB_XCNT(b.x)], 1u);
    return b;
}
__device__ __forceinline__ void xcd_barrier_complete(unsigned* bar, unsigned x, unsigned& nloc, unsigned& nx) {
    const unsigned G = gridDim.x * gridDim.y * gridDim.z;
    unsigned sum, cnt, mine, sp = 0u;
    for (;;) {
        sum = 0u; cnt = 0u; mine = 0u;
#pragma unroll
        for (unsigned j = 0; j < 16; ++j) { const unsigned c = xb_ld(&bar[XB_XCNT(j)]); sum += c; cnt += (c > 0u) ? 1u : 0u; mine = (j == x) ? c : mine; }
        if (sum == G) break;
        __builtin_amdgcn_s_sleep(1);
        if ((++sp & 255u) == 0u) { if (xb_ld(&bar[XB_TMO])) break; if (sp > XB_SPIN_CAP) { atomicAdd(&bar[XB_TMO], 1u); break; } }
    }
    nloc = mine > 0u ? mine : 1u; nx = cnt > 0u ? cnt : 1u;
}

__device__ __forceinline__ void xcd_barrier(const XcdBarrier& b) {
    asm volatile("s_waitcnt vmcnt(0)" ::: "memory");
    __syncthreads();
    if (threadIdx.x == 0) {
        unsigned* bar = b.bar;
        __builtin_amdgcn_s_waitcnt(0);
        unsigned nloc = b.st[0], nx = b.st[1];
        if (nloc == 0u) { xcd_barrier_complete(bar, b.x, nloc, nx); b.st[0] = nloc; b.st[1] = nx; }
        const unsigned old = xb_add(&bar[XB_XSUB(b.x)], 1u);
        const unsigned gen = old / nloc;
        if (old + 1u == (gen + 1u) * nloc) {
            __builtin_amdgcn_fence(__ATOMIC_RELEASE, "agent");
            asm volatile("s_waitcnt vmcnt(0)" ::: "memory");
            const unsigned og = xb_add(&bar[XB_TOP], 1u);
            const unsigned tg = og / nx;
            if (og + 1u == (tg + 1u) * nx) xb_add(&bar[XB_TOPGEN], 1u);
            else XB_SPIN(xb_ld(&bar[XB_TOPGEN]) == tg, bar);
            __builtin_amdgcn_fence(__ATOMIC_ACQUIRE, "agent");
            xb_add(&bar[XB_XGEN(b.x)], 1u);
            asm volatile("s_waitcnt vmcnt(0)" ::: "memory");
        } else {
            XB_SPIN(xb_ld(&bar[XB_XGEN(b.x)]) == gen, bar);
            __builtin_amdgcn_fence(__ATOMIC_ACQUIRE, "agent");
            asm volatile("s_waitcnt vmcnt(0)" ::: "memory");
        }
    }
    __syncthreads();
}

typedef __attribute__((address_space(4))) const unsigned long long kq_t;
struct Frame {
    LAS unsigned char* lds;
    volatile LAS unsigned* MISC;
    gu32* ctl;
    int tid, lane, wave, vcu, G;
    kq_t* karg; GAS float* out; GAS unsigned char* ws;
};
#define INP(F, i) ((const GAS float*)(F).karg[(i)])
enum { I_X = 0, I_NMPRE, I_NMPOST, I_NFPRE, I_NFPOST, I_WIN, I_CONVW, I_RW0, I_RWUP, I_RA0, I_RAUP, I_RGUP, I_RKK, I_RKA, I_RRK, I_LNXW, I_LNXB, I_RPB, I_SGUN, I_SGUW, I_SGUB, I_MGAIN, I_WOUT, I_WUP, I_FCONV, I_WDN };
__device__ __forceinline__ int launder_u(int x) { asm volatile("" : "+v"(x)); return __builtin_amdgcn_readfirstlane(x); }
template <class P> __device__ __forceinline__ P launder_p(P p) { unsigned long long v = (unsigned long long)p; unsigned lo = (unsigned)v, hi = (unsigned)(v >> 32); asm volatile("" : "+v"(lo), "+v"(hi));
    lo = __builtin_amdgcn_readfirstlane(lo); hi = __builtin_amdgcn_readfirstlane(hi); return (P)(((unsigned long long)hi << 32) | lo); }
#define LAUNDER(F) do { asm volatile("" : "+v"((F).tid)); asm volatile("" : "+v"((F).lane)); (F).wave = launder_u((F).wave); (F).vcu = launder_u((F).vcu); (F).karg = launder_p((F).karg); (F).ws = launder_p((F).ws); (F).out = launder_p((F).out); } while (0)
#define LDS_WAIT() asm volatile("s_waitcnt lgkmcnt(0)" ::: "memory")
#define CFENCE() asm volatile("" ::: "memory")

__device__ __forceinline__ void p0_transpose_item(const GAS float* W, const GAS float* gain, int K, int N, GAS bf16* WT, LAS float* scr, int item, int lane, bool glmap = false) {
    const int nblk = N / 32, kb = item / nblk, nb = item % nblk, k0 = 64 * kb, n0 = 32 * nb;
    const int r0 = !glmap ? n0 : (n0 < N / 2 ? 256 * (n0 >> 7) + (n0 & 127) : 256 * ((n0 - N / 2) >> 7) + 128 + ((n0 - N / 2) & 127));
#pragma unroll 8
    for (int i = 0; i < 32; ++i) { const int kk = 2 * i + (lane >> 5); const float g = gain ? gain[k0 + kk] : 1.f; scr[kk * 33 + (lane & 31)] = W[(size_t)(k0 + kk) * N + n0 + (lane & 31)] * g; }
    LDS_WAIT(); CFENCE();
    const int c = lane & 7;
#pragma unroll
    for (int j = 0; j < 4; ++j) { const int n = (lane >> 3) + 8 * j; const LAS float* s = scr + (8 * c) * 33 + n;
        v4u o; o.x = pk2(s[0 * 33], s[1 * 33]); o.y = pk2(s[2 * 33], s[3 * 33]); o.z = pk2(s[4 * 33], s[5 * 33]); o.w = pk2(s[6 * 33], s[7 * 33]);
        *(GAS v4u*)(WT + (size_t)(r0 + n) * K + k0 + 8 * c) = o; }
    LDS_WAIT(); CFENCE();
}
__device__ __forceinline__ void row_to_bf16_rs(const GAS float* xrow, GAS bf16* orow, GAS float* rs, int lane) {
    const GAS f32x4* xr = (const GAS f32x4*)xrow + lane;
    f32x4 v[4]; float s = 0.f;
#pragma unroll
    for (int j = 0; j < 4; ++j) { v[j] = xr[64 * j]; s += (v[j].x * v[j].x + v[j].y * v[j].y) + (v[j].z * v[j].z + v[j].w * v[j].w); }
    s = wave_sum(s);
    GAS v2u* o8 = (GAS v2u*)orow + lane;
#pragma unroll
    for (int j = 0; j < 4; ++j) { v2u o; o.x = pk2(v[j].x, v[j].y); o.y = pk2(v[j].z, v[j].w); o8[64 * j] = o; }
    if (lane == 0) *rs = rsqf_(s * (1.f / DM) + NORM_EPS);
}
__device__ __forceinline__ void p0_prologue(Frame& F) {
    LAUNDER(F);
    LAS float* scr = (LAS float*)(F.lds + F.wave * 16384);
    const int gw = F.vcu * NWAVES + F.wave, NGW = F.G * NWAVES;
    constexpr int I_IN = (DM / 64) * (NPROJ / 32), I_OUT = (DM / 64) * (DM / 32), I_UP = (DM / 64) * (NUP / 32), I_DN = (DFF / 64) * (DM / 32), I_L = I_IN + I_OUT + I_UP + I_DN;
    for (int it = gw; it < DEPTH * I_L; it += NGW) {
        const int l = it / I_L; int r = it % I_L; GAS unsigned char* wl = F.ws + WS_W + (size_t)l * W_LAYER;
        if (r < I_IN) { p0_transpose_item(INP(F, I_WIN) + (size_t)l * DM * NPROJ, INP(F, I_NMPRE) + l * DM, DM, NPROJ, (GAS bf16*)(wl + W_IN), scr, r, F.lane); continue; } r -= I_IN;
        if (r < I_OUT) { p0_transpose_item(INP(F, I_WOUT) + (size_t)l * DM * DM, INP(F, I_MGAIN) + l * DM, DM, DM, (GAS bf16*)(wl + W_OUT), scr, r, F.lane); continue; } r -= I_OUT;
        if (r < I_UP) { p0_transpose_item(INP(F, I_WUP) + (size_t)l * DM * NUP, INP(F, I_NFPRE) + l * DM, DM, NUP, (GAS bf16*)(wl + W_UP), scr, r, F.lane, true); continue; } r -= I_UP;
        p0_transpose_item(INP(F, I_WDN) + (size_t)l * DFF * DM, nullptr, DFF, DM, (GAS bf16*)(wl + W_DN), scr, r, F.lane);
    }
    unsigned zz = 0u; asm volatile("" : "+v"(zz));
    for (int i = F.vcu * NTHREADS + F.tid; i < DEPTH * 20480; i += F.G * NTHREADS) { const int l = i / 20480, r = i % 20480;
        *(GAS v4u*)(F.ws + WS_W + (size_t)l * W_LAYER + W_IN + (size_t)NPROJ * DM * 2 + (size_t)r * 16) = (v4u){zz, zz, zz, zz}; }
    for (int m = gw; m < M; m += NGW) row_to_bf16_rs(INP(F, I_X) + (size_t)m * DM, (GAS bf16*)(F.ws + WS_XB) + (size_t)m * DM, (GAS float*)(F.ws + WS_RS) + m, F.lane);
}

typedef float f32x16 __attribute__((ext_vector_type(16)));
__device__ __forceinline__ void mix_convprep_tile(Frame& F, int l, int tile) {
    LAUNDER(F);
    const GAS bf16* proj = (const GAS bf16*)(F.ws + WS_PROJ); GAS bf16* merged = (GAS bf16*)(F.ws + WS_MERGED);
    const int m0 = tile * 64, bb = m0 / T, t0 = m0 % T;
    const int lane = F.lane, w = F.wave;
    {
        const int c4 = 4 * lane; const GAS float* cw = INP(F, I_CONVW) + l * 768;
        const f32x4 w0 = *(const f32x4*)(cw + c4), w1 = *(const f32x4*)(cw + 256 + c4), w2 = *(const f32x4*)(cw + 512 + c4);
        const int ts = t0 + 8 * w;
        v2u hr[10], cr[10], br[8];
#pragma unroll
        for (int j = 0; j < 10; ++j) { const int t = ts - 1 + j; const bool ok = (t >= 0 && t < T); const GAS bf16* row = proj + (size_t)(bb * T + (ok ? t : ts)) * NPROJP;
            hr[j] = *(const GAS v2u*)(row + C_CH + c4); cr[j] = *(const GAS v2u*)(row + C_CC + c4); if (!ok) { hr[j] = (v2u){0u, 0u}; } }
#pragma unroll
        for (int j = 0; j < 8; ++j) { const GAS bf16* row = proj + (size_t)(bb * T + ts + j) * NPROJP; br[j] = *(const GAS v2u*)(row + C_CB + c4); }
#pragma unroll
        for (int i = 0; i < 8; ++i) { const int t = ts + i;
            f32x4 z[3];
#pragma unroll
            for (int q = 0; q < 3; ++q) { const v2u h = hr[i + q], c = cr[i + q]; z[q] = (f32x4){bflo(h.x) * bflo(c.x), bfhi(h.x) * bfhi(c.x), bflo(h.y) * bflo(c.y), bfhi(h.y) * bfhi(c.y)}; }
            const v2u b = br[i];
            const f32x4 bv = (f32x4){bflo(b.x), bfhi(b.x), bflo(b.y), bfhi(b.y)};
            const f32x4 y = bv * (w0 * z[0] + w1 * z[1] + w2 * z[2]);
            float ss = (y.x * y.x + y.y * y.y) + (y.z * y.z + y.w * y.w); ss = wave_sum(ss);
            const float sc = rsqf_(ss * (1.f / 256.f) + NORM_EPS);
            v2u o; o.x = pk2(y.x * sc, y.y * sc); o.y = pk2(y.z * sc, y.w * sc);
            *(GAS v2u*)(merged + (size_t)(bb * T + t) * DM + 0 + c4) = o;
}
    }
}

__device__ __forceinline__ void mix_na_item(Frame& F, int l, int item, LAS unsigned char* wl, const LAS float* RPB) {
    LAUNDER(F);
    const GAS bf16* proj = (const GAS bf16*)(F.ws + WS_PROJ); GAS bf16* merged = (GAS bf16*)(F.ws + WS_MERGED);
    const int lane = F.lane, i = lane & 15, g = lane >> 4;
    const int qg = item & 3, r = (item >> 2) & 63, bb = item >> 8;
    const int c0 = 16 * qg;
    int rs = r - 4; rs = rs < 0 ? 0 : (rs > 56 ? 56 : rs);
    int cs = c0 - 8; cs = cs < 0 ? 0 : (cs > 32 ? 32 : cs);
    LAS unsigned char* PL = wl; LAS unsigned char* VL = wl + 4096; LAS unsigned char* OL = wl + 8192;
    const size_t rowbase = (size_t)bb * T;
    float ssq[4] = {0.f, 0.f, 0.f, 0.f};
#pragma unroll 1
    for (int h = 0; h < 4; ++h) {
        bf16x8 qf[2];
        { const GAS bf16* qrow = proj + (rowbase + r * 64 + c0 + i) * NPROJP + C_NQ + h * 64 + 8 * g;
          qf[0] = *(const GAS bf16x8*)(qrow); qf[1] = *(const GAS bf16x8*)(qrow + 32); }
        f32x4 s[16];
#pragma unroll
        for (int kt = 0; kt < 16; ++kt) { const int kr = kt >> 1, hf = kt & 1;
            const GAS bf16* krow = proj + (rowbase + (rs + kr) * 64 + cs + 16 * hf + i) * NPROJP + C_NK + h * 64 + 8 * g;
            const bf16x8 k0 = *(const GAS bf16x8*)(krow), k1 = *(const GAS bf16x8*)(krow + 32);
            f32x4 a = (f32x4){0.f, 0.f, 0.f, 0.f};
            a = __builtin_amdgcn_mfma_f32_16x16x32_bf16(qf[0], k0, a, 0, 0, 0);
            a = __builtin_amdgcn_mfma_f32_16x16x32_bf16(qf[1], k1, a, 0, 0, 0);
            s[kt] = a; }
        const GAS bf16* vsrc = proj + (rowbase + rs * 64 + cs + (lane >> 3)) * NPROJP + C_NV + h * 64 + 8 * (lane & 7);
        v4u vreg[4][4];
#pragma unroll
        for (int k4 = 0; k4 < 4; ++k4)
#pragma unroll
            for (int q = 0; q < 4; ++q) vreg[k4][q] = *(const GAS v4u*)(vsrc + (size_t)(k4 * 64 + 8 * q) * NPROJP);
        float mx[4] = {-3e38f, -3e38f, -3e38f, -3e38f};
#pragma unroll
        for (int kt = 0; kt < 16; ++kt) { const int kr = kt >> 1, hf = kt & 1; const int cw = cs + 16 * hf + i; const int dy = rs + kr - r + 7;
#pragma unroll
            for (int e = 0; e < 4; ++e) { const int cq = c0 + 4 * g + e; int st = cq - 8; st = st < 0 ? 0 : (st > 48 ? 48 : st);
                int dx = cw - cq; dx = dx < -15 ? -15 : (dx > 15 ? 15 : dx); dx += 15;
                const bool valid = (cw >= st) && (cw < st + 16);
                float v = s[kt][e] * 0.125f + RPB[h * 465 + dy * 31 + dx];
                v = valid ? v : -1e30f; s[kt][e] = v; mx[e] = fmaxf(mx[e], v); } }
        float sm[4];
#pragma unroll
        for (int e = 0; e < 4; ++e) { mx[e] = row16_max(mx[e]); sm[e] = 0.f; }
#pragma unroll
        for (int kt = 0; kt < 16; ++kt)
#pragma unroll
            for (int e = 0; e < 4; ++e) { const float p = __expf(s[kt][e] - mx[e]); s[kt][e] = p; sm[e] += p; }
#pragma unroll
        for (int e = 0; e < 4; ++e) sm[e] = rcpf_(row16_sum(sm[e]));
        f32x4 oh[4];
#pragma unroll
        for (int dt = 0; dt < 4; ++dt) oh[dt] = (f32x4){0.f, 0.f, 0.f, 0.f};
#pragma unroll
        for (int half = 0; half < 2; ++half) {
            CFENCE();
#pragma unroll
            for (int k8 = 0; k8 < 8; ++k8) { const int kt = 8 * half + k8; v2u pw; pw.x = pk2(s[kt][0] * sm[0], s[kt][1] * sm[1]); pw.y = pk2(s[kt][2] * sm[2], s[kt][3] * sm[3]);
                *(LAS v2u*)(PL + (16 * k8 + i) * 32 + 8 * g) = pw; }
            CFENCE();
#pragma unroll
            for (int k4 = 0; k4 < 4; ++k4) { const int kr = 4 * half + k4;
                CFENCE();
#pragma unroll
                for (int q = 0; q < 4; ++q) *(LAS v4u*)(VL + ((lane >> 3) + 8 * q) * 128 + (lane & 7) * 16) = vreg[k4][q];
                if (half == 0) {
#pragma unroll
                    for (int q = 0; q < 4; ++q) vreg[k4][q] = *(const GAS v4u*)(vsrc + (size_t)((kr + 4) * 64 + 8 * q) * NPROJP); }
                CFENCE();
                const LAS unsigned char* pa = PL + (32 * k4 + 8 * g + (i >> 2)) * 32 + 8 * (i & 3);
                const s16x4 plo = __builtin_bit_cast(s16x4, __builtin_amdgcn_ds_read_tr16_b64_v4i16((LAS s16x4*)(pa)));
                const s16x4 phi = __builtin_bit_cast(s16x4, __builtin_amdgcn_ds_read_tr16_b64_v4i16((LAS s16x4*)(pa + 128)));
                const bf16x8 pf = (bf16x8){plo[0], plo[1], plo[2], plo[3], phi[0], phi[1], phi[2], phi[3]};
#pragma unroll
                for (int dt = 0; dt < 4; ++dt) {
                    const LAS unsigned char* va = VL + (8 * g + (i >> 2)) * 128 + (16 * dt + 4 * (i & 3)) * 2;
                    const s16x4 vlo = __builtin_bit_cast(s16x4, __builtin_amdgcn_ds_read_tr16_b64_v4i16((LAS s16x4*)(va)));
                    const s16x4 vhi = __builtin_bit_cast(s16x4, __builtin_amdgcn_ds_read_tr16_b64_v4i16((LAS s16x4*)(va + 512)));
                    const bf16x8 vf = (bf16x8){vlo[0], vlo[1], vlo[2], vlo[3], vhi[0], vhi[1], vhi[2], vhi[3]};
                    oh[dt] = __builtin_amdgcn_mfma_f32_16x16x32_bf16(pf, vf, oh[dt], 0, 0, 0); }
            }
        }
        CFENCE();
#pragma unroll
        for (int dt = 0; dt < 4; ++dt)
#pragma unroll
            for (int e = 0; e < 4; ++e) { ssq[e] += oh[dt][e] * oh[dt][e]; *(LAS unsigned short*)(OL + (4 * g + e) * 512 + (h * 64 + 16 * dt + i) * 2) = (unsigned short)f2bf(oh[dt][e]); }
        CFENCE();
    }
    LAS float* SCL = (LAS float*)VL;
    CFENCE();
#pragma unroll
    for (int e = 0; e < 4; ++e) { const float sc = rsqf_(row16_sum(ssq[e]) * (1.f / 256.f) + NORM_EPS); if (i == 0) SCL[4 * g + e] = sc; }
    CFENCE();
#pragma unroll
    for (int q = 0; q < 8; ++q) { const int e = lane + 64 * q, row = e >> 5, ch = e & 31;
        const v4u v = *(const LAS v4u*)(OL + row * 512 + ch * 16); const float sc = SCL[row];
        v4u o;
#pragma unroll
        for (int t = 0; t < 4; ++t) o[t] = pk2(bflo(v[t]) * sc, bfhi(v[t]) * sc);
        *(GAS v4u*)(merged + (rowbase + r * 64 + c0 + row) * DM + 512 + 8 * ch) = o; }
    CFENCE();
}

constexpr int SG_PITCH = 528;
__device__ __forceinline__ void mix_sgu_item(Frame& F, int l, int item) {
    LAUNDER(F);
    const GAS bf16* proj = (const GAS bf16*)(F.ws + WS_PROJ); GAS bf16* merged = (GAS bf16*)(F.ws + WS_MERGED);
    const int lane = F.lane, w = F.wave, tid = F.tid, i = lane & 15, g = lane >> 4;
    const size_t m0 = (size_t)item * 128;
    LAS unsigned char* VI = F.lds; LAS float* SS = (LAS float*)(F.lds + 128 * SG_PITCH);
    { const int c4 = 4 * lane; const f32x4 gn = *(const f32x4*)(INP(F, I_SGUN) + l * 256 + c4);
      v2u xr[16];
#pragma unroll
      for (int j = 0; j < 16; ++j) xr[j] = *(const GAS v2u*)(proj + (m0 + 16 * w + j) * NPROJP + C_SV + c4);
#pragma unroll
      for (int j = 0; j < 16; ++j) { const int q = 16 * w + j; const v2u x = xr[j];
          f32x4 v = (f32x4){gelu_tanh(bflo(x.x)), gelu_tanh(bfhi(x.x)), gelu_tanh(bflo(x.y)), gelu_tanh(bfhi(x.y))};
          const float mu = wave_sum((v.x + v.y) + (v.z + v.w)) * (1.f / 256.f);
          v = v - mu;
          const float var = wave_sum((v.x * v.x + v.y * v.y) + (v.z * v.z + v.w * v.w)) * (1.f / 256.f);
          const float rstd = rsqf_(var + NORM_EPS);
          v2u o; o.x = pk2(v.x * rstd * gn.x, v.y * rstd * gn.y); o.y = pk2(v.z * rstd * gn.z, v.w * rstd * gn.w);
          *(LAS v2u*)(VI + q * SG_PITCH + c4 * 2) = o; } }
    __syncthreads();
    const int hh = w >> 1, ph = w & 1;
    f32x4 acc[4][4];
#pragma unroll
    for (int a = 0; a < 4; ++a)
#pragma unroll
        for (int b = 0; b < 4; ++b) acc[a][b] = (f32x4){0.f, 0.f, 0.f, 0.f};
    const GAS float* ws_ = INP(F, I_SGUW) + ((size_t)(l * 4 + hh) * 128) * 128;
#pragma unroll
    for (int ks = 0; ks < 4; ++ks) {
        bf16x8 af[4], bfr[4];
#pragma unroll
        for (int pt = 0; pt < 4; ++pt) { const GAS float* ap = ws_ + (size_t)(64 * ph + 16 * pt + i) * 128 + 32 * ks + 8 * g;
            const f32x4 x0 = *(const f32x4*)ap, x1 = *(const f32x4*)(ap + 4);
            const unsigned u0 = pk2(x0.x, x0.y), u1 = pk2(x0.z, x0.w), u2 = pk2(x1.x, x1.y), u3 = pk2(x1.z, x1.w);
            af[pt] = __builtin_bit_cast(bf16x8, (v4u){u0, u1, u2, u3}); }
#pragma unroll
        for (int dt = 0; dt < 4; ++dt) { const LAS unsigned char* va = VI + (32 * ks + 8 * g + (i >> 2)) * SG_PITCH + (hh * 64 + 16 * dt + 4 * (i & 3)) * 2;
            const s16x4 lo = __builtin_bit_cast(s16x4, __builtin_amdgcn_ds_read_tr16_b64_v4i16((LAS s16x4*)(va)));
            const s16x4 hi = __builtin_bit_cast(s16x4, __builtin_amdgcn_ds_read_tr16_b64_v4i16((LAS s16x4*)(va + 4 * SG_PITCH)));
            bfr[dt] = (bf16x8){lo[0], lo[1], lo[2], lo[3], hi[0], hi[1], hi[2], hi[3]}; }
#pragma unroll
        for (int pt = 0; pt < 4; ++pt)
#pragma unroll
            for (int dt = 0; dt < 4; ++dt) acc[pt][dt] = __builtin_amdgcn_mfma_f32_16x16x32_bf16(af[pt], bfr[dt], acc[pt][dt], 0, 0, 0);
    }
#pragma unroll
    for (int pt = 0; pt < 4; ++pt) {
        unsigned short ur[4][4];
#pragma unroll
        for (int e = 0; e < 4; ++e)
#pragma unroll
            for (int dt = 0; dt < 4; ++dt) ur[e][dt] = proj[(m0 + 64 * ph + 16 * pt + 4 * g + e) * NPROJP + C_SU + hh * 64 + 16 * dt + i];
#pragma unroll
        for (int e = 0; e < 4; ++e) { const int p = 64 * ph + 16 * pt + 4 * g + e; const float bs = INP(F, I_SGUB)[(l * 4 + hh) * 128 + p]; float ss = 0.f;
#pragma unroll
            for (int dt = 0; dt < 4; ++dt) { const float u = gelu_tanh(bf2f(ur[e][dt]));
                const float v = u * (acc[pt][dt][e] + bs); acc[pt][dt][e] = v; ss += v * v; }
            ss = row16_sum(ss); if (i == 0) SS[p * 4 + hh] = ss; } }
    __syncthreads();
#pragma unroll
    for (int pt = 0; pt < 4; ++pt)
#pragma unroll
        for (int e = 0; e < 4; ++e) { const int p = 64 * ph + 16 * pt + 4 * g + e; const f32x4 s4 = *(const LAS f32x4*)(SS + p * 4);
            const float sc = rsqf_(((s4.x + s4.y) + (s4.z + s4.w)) * (1.f / 256.f) + NORM_EPS);
#pragma unroll
            for (int dt = 0; dt < 4; ++dt) *(LAS unsigned short*)(VI + p * SG_PITCH + (hh * 64 + 16 * dt + i) * 2) = (unsigned short)f2bf(acc[pt][dt][e] * sc); }
    __syncthreads();
#pragma unroll
    for (int q = 0; q < 8; ++q) { const int e = tid + 512 * q, row = e >> 5, ch = e & 31;
        const v4u v = *(const LAS v4u*)(VI + row * SG_PITCH + ch * 16);
        *(GAS v4u*)(merged + (m0 + row) * DM + 768 + 8 * ch) = v; }
    __syncthreads();
}

__device__ __forceinline__ void phase_mix_na(Frame& F, int l, int bidx, int nblk) {
    LAUNDER(F);
    LAS float* RPB = (LAS float*)(F.lds + RING_BYTES + 1024);
    for (int q = F.tid; q < 4 * 465; q += NTHREADS) RPB[q] = INP(F, I_RPB)[l * 4 * 465 + q];
    __syncthreads();
    for (int it = bidx * NWAVES + F.wave; it < NB * 64 * 4; it += nblk * NWAVES) mix_na_item(F, l, it, F.lds + F.wave * 16384, RPB);
    __syncthreads();
#ifdef SGU_IN_C2
    for (int it = bidx; it < NB * 32; it += nblk) mix_sgu_item(F, l, it);
#endif
}
__device__ __forceinline__ void phase_mixers(Frame& F, int l) {
    LAUNDER(F);
    for (int tile = F.vcu; tile < M / 64; tile += F.G) mix_convprep_tile(F, l, tile);
    __syncthreads();
#ifndef SGU_IN_C2
    for (int it = F.vcu; it < NB * 32; it += F.G) mix_sgu_item(F, l, it);
#endif
}

constexpr int C1_RES = 65536, C1_RES_D = 15616;
constexpr int C1_ZT = 0, C1_ET = 4096, C1_QT = 8192, C1_CT = 12288, C1_DA = 13312, C1_UH = 13568;
constexpr int C1_IMG = 0, C1_IMG_D = 16384, C1_SC = 0, C1_SCST = 144, C1_CM = 9216, C1_DM = 15360, C1_DL = 15616;
typedef _Float16 h4 __attribute__((ext_vector_type(4)));
typedef _Float16 h8 __attribute__((ext_vector_type(8)));
__device__ __forceinline__ bf16x8 pack8(f32x4 lo, f32x4 hi) { return __builtin_bit_cast(bf16x8, (v4u){pg8::cvt_pk_bf16(lo.x, lo.y), pg8::cvt_pk_bf16(lo.z, lo.w), pg8::cvt_pk_bf16(hi.x, hi.y), pg8::cvt_pk_bf16(hi.z, hi.w)}); }
template <int MODE>
__device__ __forceinline__ void phase_scan_c1(Frame& F, int l) {
    LAUNDER(F);
    const GAS bf16* proj = (const GAS bf16*)(F.ws + WS_PROJ);
    const int lane = F.lane, w = F.wave, i = lane & 15, g = lane >> 4;
    const int d = w >> 2, wa = w & 3;
    const int bh = F.vcu >> 3, bb = bh >> 2, h = bh & 3;
    LAS unsigned char* lds = F.lds;
    bf16x8 Bw, Ba;
    { f32x4 xw0 = (f32x4){0.f, 0.f, 0.f, 0.f}, xw1 = xw0, xa0 = xw0, xa1 = xw0;
      if (g < 2) { const GAS float* pw = INP(F, I_RWUP) + ((size_t)(l * 2 + d) * 16 + 8 * g) * 256 + h * 64 + 16 * wa + i; const GAS float* pa = INP(F, I_RAUP) + ((size_t)(l * 2 + d) * 16 + 8 * g) * 256 + h * 64 + 16 * wa + i;
          xw0 = (f32x4){pw[0], pw[256], pw[512], pw[768]}; xw1 = (f32x4){pw[1024], pw[1280], pw[1536], pw[1792]};
          xa0 = (f32x4){pa[0], pa[256], pa[512], pa[768]}; xa1 = (f32x4){pa[1024], pa[1280], pa[1536], pa[1792]}; }
      Bw = pack8(xw0, xw1); Ba = pack8(xa0, xa1); }
    const float w0c = INP(F, I_RW0)[(l * 2 + d) * 256 + h * 64 + 16 * wa + i], a0c = INP(F, I_RA0)[(l * 2 + d) * 256 + h * 64 + 16 * wa + i], kag = INP(F, I_RKA)[l * 256 + h * 64 + 16 * wa + i];
    float kkg[4];
#pragma unroll
    for (int t = 0; t < 4; ++t) kkg[t] = INP(F, I_RKK)[l * 256 + h * 64 + 16 * t + i];
    const float kkgw = INP(F, I_RKK)[l * 256 + h * 64 + 16 * wa + i];
    const int c = 16 * wa + i;
    const int sq = d ? 3 - g : g;
#define C1_BAR() do { asm volatile("s_waitcnt lgkmcnt(0)" ::: "memory"); __builtin_amdgcn_s_barrier(); asm volatile("" ::: "memory"); } while (0)
    unsigned short kq[4][4], kown[4], rq[4]; v4u dvr, ivr;
#define C1_LOAD(B_) do { const size_t m0_ = (size_t)bb * T + 16 * (B_); \
        _Pragma("unroll") for (int e_ = 0; e_ < 4; ++e_) { const GAS bf16* row_ = proj + (m0_ + 4 * g + e_) * NPROJP; \
            _Pragma("unroll") for (int t_ = 0; t_ < 4; ++t_) kq[t_][e_] = row_[C_K + h * 64 + 16 * t_ + i]; \
            rq[e_] = row_[C_R + h * 64 + 16 * wa + i]; kown[e_] = row_[C_K + h * 64 + 16 * wa + i]; } \
        { const GAS bf16* arow_ = proj + (m0_ + i) * NPROJP + C_DEC + 16 * d + 8 * (g & 1); dvr = *(const GAS v4u*)(arow_); ivr = *(const GAS v4u*)(arow_ + 32); } } while (0)
    const int B0 = (F.vcu & 7) * 32;
    C1_LOAD(B0);
    {
        const int it = 0;
        { const int B = B0 + it; LAS unsigned char* IMG = lds + C1_IMG + ((it & 1) * 2 + d) * C1_IMG_D; (void)B;
        if (MODE != 3) {
            v4u dv = (v4u){0u, 0u, 0u, 0u}, iv = dv;
            if (g < 2) { iv = ivr;
#pragma unroll
                for (int q = 0; q < 4; ++q) dv[q] = pk2(tanhf_(bflo(dvr[q])), tanhf_(bfhi(dvr[q]))); }
            const f32x4 z4 = (f32x4){0.f, 0.f, 0.f, 0.f};
            const f32x4 Dw = __builtin_amdgcn_mfma_f32_16x16x32_bf16(__builtin_bit_cast(bf16x8, dv), Bw, z4, 0, 0, 0);
            const f32x4 Da = __builtin_amdgcn_mfma_f32_16x16x32_bf16(__builtin_bit_cast(bf16x8, iv), Ba, z4, 0, 0, 0);
            float vw[4], vk[4], vb[4], ve[4], vr[4];
#pragma unroll
            for (int e = 0; e < 4; ++e) {
                float ss = 0.f;
#pragma unroll
                for (int t = 0; t < 4; ++t) { const float x = bf2f(kq[t][e]) * kkg[t]; ss += x * x; }
                ss = row16_sum(ss);
                const float k = bf2f(kown[e]); const float kk = k * kkgw * rsqf_(ss + 1e-12f);
                const float wv = __expf(-DECAY_SCALE * sigmoidf_(w0c + Dw[e])), av = sigmoidf_(a0c + Da[e]);
                vw[e] = wv; vk[e] = kk; vb[e] = kk * av; ve[e] = k * (1.f + (av - 1.f) * kag); vr[e] = bf2f(rq[e]); }
            if (d) {
#define C1_SWAP(a_) do { float t0_ = a_[0], t1_ = a_[1]; a_[0] = a_[3]; a_[1] = a_[2]; a_[2] = t1_; a_[3] = t0_; } while (0)
                C1_SWAP(vw); C1_SWAP(vk); C1_SWAP(vb); C1_SWAP(ve); C1_SWAP(vr);
#undef C1_SWAP
            }
            float Dp[4], Dt[4];
            const float c1 = vw[0], c2 = c1 * vw[1], c3 = c2 * vw[2], c4 = c3 * vw[3];
            const float q0 = __shfl(c4, (d ? 48 : 0) + i), q1 = __shfl(c4, (d ? 32 : 16) + i), q2 = __shfl(c4, (d ? 16 : 32) + i);
            const float Dm = q0 * q1;
            const float off = sq == 0 ? 1.f : (sq == 1 ? q0 : (sq == 2 ? Dm : Dm * q2));
            Dp[0] = off; Dp[1] = off * c1; Dp[2] = off * c2; Dp[3] = off * c3;
            Dt[0] = Dp[1]; Dt[1] = Dp[2]; Dt[2] = Dp[3]; Dt[3] = off * c4;
            const float rDm = rcpf_(Dm);
            h4 hk, hb, he;
#pragma unroll
            for (int e = 0; e < 4; ++e) { const float rDt = rcpf_(Dt[e]);
                const float kap = vk[e] * Dp[e] * rDm, rr = vr[e] * Dt[e] * rDm, bq = vb[e] * Dm * rDt, eq = ve[e] * Dm * rDt;
                const int s = 4 * sq + e;
                ((LAS _Float16*)(IMG + C1_SC + (0 * 16 + s) * C1_SCST))[c] = (_Float16)kap; ((LAS _Float16*)(IMG + C1_SC + (1 * 16 + s) * C1_SCST))[c] = (_Float16)rr;
                ((LAS _Float16*)(IMG + C1_SC + (2 * 16 + s) * C1_SCST))[c] = (_Float16)bq;  ((LAS _Float16*)(IMG + C1_SC + (3 * 16 + s) * C1_SCST))[c] = (_Float16)eq;
                hk[e] = (_Float16)kap; hb[e] = (_Float16)bq; he[e] = (_Float16)eq; }
            *(LAS h4*)(IMG + C1_CM + c * 96 + 0 + sq * 8) = hk; *(LAS h4*)(IMG + C1_CM + c * 96 + 32 + sq * 8) = hb; *(LAS h4*)(IMG + C1_CM + c * 96 + 64 + sq * 8) = he;
            if (sq == 3) *(LAS float*)(IMG + C1_DL + c * 4) = Dt[3];
            if (sq == 0) *(LAS float*)(IMG + C1_DM + c * 4) = Dm;
        }
        }
        if (it + 1 < 32) C1_LOAD(B0 + it + 1);
        C1_BAR();
    }
    {
        const int it = 1;
        { const int B = B0 + it; LAS unsigned char* IMG = lds + C1_IMG + ((it & 1) * 2 + d) * C1_IMG_D; (void)B;
        if (MODE != 3) {
            v4u dv = (v4u){0u, 0u, 0u, 0u}, iv = dv;
            if (g < 2) { iv = ivr;
#pragma unroll
                for (int q = 0; q < 4; ++q) dv[q] = pk2(tanhf_(bflo(dvr[q])), tanhf_(bfhi(dvr[q]))); }
            const f32x4 z4 = (f32x4){0.f, 0.f, 0.f, 0.f};
            const f32x4 Dw = __builtin_amdgcn_mfma_f32_16x16x32_bf16(__builtin_bit_cast(bf16x8, dv), Bw, z4, 0, 0, 0);
            const f32x4 Da = __builtin_amdgcn_mfma_f32_16x16x32_bf16(__builtin_bit_cast(bf16x8, iv), Ba, z4, 0, 0, 0);
            float vw[4], vk[4], vb[4], ve[4], vr[4];
#pragma unroll
            for (int e = 0; e < 4; ++e) {
                float ss = 0.f;
#pragma unroll
                for (int t = 0; t < 4; ++t) { const float x = bf2f(kq[t][e]) * kkg[t]; ss += x * x; }
                ss = row16_sum(ss);
                const float k = bf2f(kown[e]); const float kk = k * kkgw * rsqf_(ss + 1e-12f);
                const float wv = __expf(-DECAY_SCALE * sigmoidf_(w0c + Dw[e])), av = sigmoidf_(a0c + Da[e]);
                vw[e] = wv; vk[e] = kk; vb[e] = kk * av; ve[e] = k * (1.f + (av - 1.f) * kag); vr[e] = bf2f(rq[e]); }
            if (d) {
#define C1_SWAP(a_) do { float t0_ = a_[0], t1_ = a_[1]; a_[0] = a_[3]; a_[1] = a_[2]; a_[2] = t1_; a_[3] = t0_; } while (0)
                C1_SWAP(vw); C1_SWAP(vk); C1_SWAP(vb); C1_SWAP(ve); C1_SWAP(vr);
#undef C1_SWAP
            }
            float Dp[4], Dt[4];
            const float c1 = vw[0], c2 = c1 * vw[1], c3 = c2 * vw[2], c4 = c3 * vw[3];
            const float q0 = __shfl(c4, (d ? 48 : 0) + i), q1 = __shfl(c4, (d ? 32 : 16) + i), q2 = __shfl(c4, (d ? 16 : 32) + i);
            const float Dm = q0 * q1;
            const float off = sq == 0 ? 1.f : (sq == 1 ? q0 : (sq == 2 ? Dm : Dm * q2));
            Dp[0] = off; Dp[1] = off * c1; Dp[2] = off * c2; Dp[3] = off * c3;
            Dt[0] = Dp[1]; Dt[1] = Dp[2]; Dt[2] = Dp[3]; Dt[3] = off * c4;
            const float rDm = rcpf_(Dm);
            h4 hk, hb, he;
#pragma unroll
            for (int e = 0; e < 4; ++e) { const float rDt = rcpf_(Dt[e]);
                const float kap = vk[e] * Dp[e] * rDm, rr = vr[e] * Dt[e] * rDm, bq = vb[e] * Dm * rDt, eq = ve[e] * Dm * rDt;
                const int s = 4 * sq + e;
                ((LAS _Float16*)(IMG + C1_SC + (0 * 16 + s) * C1_SCST))[c] = (_Float16)kap; ((LAS _Float16*)(IMG + C1_SC + (1 * 16 + s) * C1_SCST))[c] = (_Float16)rr;
                ((LAS _Float16*)(IMG + C1_SC + (2 * 16 + s) * C1_SCST))[c] = (_Float16)bq;  ((LAS _Float16*)(IMG + C1_SC + (3 * 16 + s) * C1_SCST))[c] = (_Float16)eq;
                hk[e] = (_Float16)kap; hb[e] = (_Float16)bq; he[e] = (_Float16)eq; }
            *(LAS h4*)(IMG + C1_CM + c * 96 + 0 + sq * 8) = hk; *(LAS h4*)(IMG + C1_CM + c * 96 + 32 + sq * 8) = hb; *(LAS h4*)(IMG + C1_CM + c * 96 + 64 + sq * 8) = he;
            if (sq == 3) *(LAS float*)(IMG + C1_DL + c * 4) = Dt[3];
            if (sq == 0) *(LAS float*)(IMG + C1_DM + c * 4) = Dm;
        }
        }
        if (it + 1 < 32) C1_LOAD(B0 + it + 1);
        { const LAS unsigned char* IMG = lds + C1_IMG + (((it - 1) & 1) * 2 + d) * C1_IMG_D; LAS unsigned char* R = lds + C1_RES + (((it - 1) & 1) * 2 + d) * C1_RES_D;
        if (MODE != 1 && MODE != 4) {
            h8 fk[2], fr[2], fb[2], fe[2];
#pragma unroll
            for (int ks = 0; ks < 2; ++ks) { const LAS unsigned char* p = IMG + C1_SC + i * C1_SCST + (8 * g + 32 * ks) * 2;
                fk[ks] = *(const LAS h8*)(p); fr[ks] = *(const LAS h8*)(p + 16 * C1_SCST); fb[ks] = *(const LAS h8*)(p + 32 * C1_SCST); fe[ks] = *(const LAS h8*)(p + 48 * C1_SCST); }
            const f32x4 z4 = (f32x4){0.f, 0.f, 0.f, 0.f};
            f32x4 aN = z4, aNT = z4, aM = z4, aMT = z4, aNr = z4, aMr = z4;
#pragma unroll
            for (int ks = 0; ks < 2; ++ks) {
                aN  = __builtin_amdgcn_mfma_f32_16x16x32_f16(fb[ks], fk[ks], aN, 0, 0, 0);  aNT = __builtin_amdgcn_mfma_f32_16x16x32_f16(fk[ks], fb[ks], aNT, 0, 0, 0);
                aM  = __builtin_amdgcn_mfma_f32_16x16x32_f16(fe[ks], fk[ks], aM, 0, 0, 0);  aMT = __builtin_amdgcn_mfma_f32_16x16x32_f16(fk[ks], fe[ks], aMT, 0, 0, 0);
                aNr = __builtin_amdgcn_mfma_f32_16x16x32_f16(fb[ks], fr[ks], aNr, 0, 0, 0); aMr = __builtin_amdgcn_mfma_f32_16x16x32_f16(fe[ks], fr[ks], aMr, 0, 0, 0); }
#pragma unroll
            for (int e = 0; e < 4; ++e) { const int row = 4 * g + e;
                aN[e] = row < i ? -aN[e] : 0.f; aNT[e] = i < row ? -aNT[e] : 0.f; aM[e] = row < i ? aM[e] : 0.f; aMT[e] = i < row ? aMT[e] : 0.f;
                aNr[e] = row <= i ? aNr[e] : 0.f; aMr[e] = row <= i ? aMr[e] : 0.f; }
#define C1_H4(x_) __builtin_convertvector((x_), h4)
#define C1_MM(a_, b_, c_) __builtin_amdgcn_mfma_f32_16x16x16f16((a_), (b_), (c_), 0, 0, 0)
            f32x4 S = aN, ST = aNT;
#pragma unroll
            for (int e = 0; e < 4; ++e) if (4 * g + e == i) { S[e] += 1.f; ST[e] += 1.f; }
            const h4 hA = C1_H4(aN), hAT = C1_H4(aNT);
            const f32x4 P2 = C1_MM(hAT, hA, z4), P2T = C1_MM(hA, hAT, z4);
            const h4 hP2 = C1_H4(P2), hP2T = C1_H4(P2T);
            { const h4 hS = C1_H4(S); S = C1_MM(hP2T, hS, S); ST = C1_MM(hS, hP2T, ST); }
            const f32x4 P4 = C1_MM(hP2T, hP2, z4), P4T = C1_MM(hP2, hP2T, z4);
            const h4 hP4 = C1_H4(P4), hP4T = C1_H4(P4T);
            { const h4 hS = C1_H4(S); S = C1_MM(hP4T, hS, S); ST = C1_MM(hS, hP4T, ST); }
            const f32x4 P8T = C1_MM(hP4, hP4T, z4);
            const h4 hP8T = C1_H4(P8T);
            { const h4 hS = C1_H4(S); ST = C1_MM(hS, hP8T, ST); }
            const h4 hTT = C1_H4(ST), hMT = C1_H4(aMT);
            const f32x4 X1 = C1_MM(hTT, C1_H4(aNr), z4);
            const h4 hX1 = C1_H4(X1);
            const h4 bT = *(const LAS h4*)(IMG + C1_CM + c * 96 + 32 + g * 8);
            const f32x4 X2 = C1_MM(hTT, bT, z4);
            const float dl = *(const LAS float*)(IMG + C1_DL + c * 4), dm = *(const LAS float*)(IMG + C1_DM + c * 4);
            *(LAS f32x4*)(R + C1_ZT + c * 64 + 16 * g) = X2 * dl;
            const f32x4 Ea = C1_MM(hMT, C1_H4(X2), z4);
            const h4 kh = *(const LAS h4*)(IMG + C1_CM + c * 96 + 64 + g * 8);
            *(LAS f32x4*)(R + C1_ET + c * 64 + 16 * g) = (__builtin_convertvector(kh, f32x4) - Ea) * (dl * rcpf_(dm));
            const h4 kT = *(const LAS h4*)(IMG + C1_CM + c * 96 + g * 8);
            const f32x4 Qa = C1_MM(kT, hX1, z4);
            const h4 rh = *(const LAS h4*)(IMG + C1_SC + (16 + i) * C1_SCST + (16 * wa + 4 * g) * 2);
            const f32x4 dm4 = *(const LAS f32x4*)(IMG + C1_DM + (16 * wa + 4 * g) * 4);
            *(LAS f32x4*)(R + C1_QT + i * 256 + (16 * wa + 4 * g) * 4) = (__builtin_convertvector(rh, f32x4) - Qa) * dm4;
            if (wa == 0) { const f32x4 Ca = C1_MM(hMT, hX1, z4); *(LAS f32x4*)(R + C1_CT + i * 64 + 16 * g) = aMr - Ca; }
            *(LAS h4*)(R + C1_UH + c * 32 + 8 * g) = kT;
            if (g == 0) *(LAS float*)(R + C1_DA + c * 4) = dl;
#undef C1_H4
#undef C1_MM
        }
        }
        C1_BAR();
    }
    for (int itv = 2; itv < 32; ++itv)
    {
        const int it = itv;
        { const int B = B0 + it; LAS unsigned char* IMG = lds + C1_IMG + ((it & 1) * 2 + d) * C1_IMG_D; (void)B;
        if (MODE != 3) {
            v4u dv = (v4u){0u, 0u, 0u, 0u}, iv = dv;
            if (g < 2) { iv = ivr;
#pragma unroll
                for (int q = 0; q < 4; ++q) dv[q] = pk2(tanhf_(bflo(dvr[q])), tanhf_(bfhi(dvr[q]))); }
            const f32x4 z4 = (f32x4){0.f, 0.f, 0.f, 0.f};
            const f32x4 Dw = __builtin_amdgcn_mfma_f32_16x16x32_bf16(__builtin_bit_cast(bf16x8, dv), Bw, z4, 0, 0, 0);
            const f32x4 Da = __builtin_amdgcn_mfma_f32_16x16x32_bf16(__builtin_bit_cast(bf16x8, iv), Ba, z4, 0, 0, 0);
            float vw[4], vk[4], vb[4], ve[4], vr[4];
#pragma unroll
            for (int e = 0; e < 4; ++e) {
                float ss = 0.f;
#pragma unroll
                for (int t = 0; t < 4; ++t) { const float x = bf2f(kq[t][e]) * kkg[t]; ss += x * x; }
                ss = row16_sum(ss);
                const float k = bf2f(kown[e]); const float kk = k * kkgw * rsqf_(ss + 1e-12f);
                const float wv = __expf(-DECAY_SCALE * sigmoidf_(w0c + Dw[e])), av = sigmoidf_(a0c + Da[e]);
                vw[e] = wv; vk[e] = kk; vb[e] = kk * av; ve[e] = k * (1.f + (av - 1.f) * kag); vr[e] = bf2f(rq[e]); }
            if (d) {
#define C1_SWAP(a_) do { float t0_ = a_[0], t1_ = a_[1]; a_[0] = a_[3]; a_[1] = a_[2]; a_[2] = t1_; a_[3] = t0_; } while (0)
                C1_SWAP(vw); C1_SWAP(vk); C1_SWAP(vb); C1_SWAP(ve); C1_SWAP(vr);
#undef C1_SWAP
            }
            float Dp[4], Dt[4];
            const float c1 = vw[0], c2 = c1 * vw[1], c3 = c2 * vw[2], c4 = c3 * vw[3];
            const float q0 = __shfl(c4, (d ? 48 : 0) + i), q1 = __shfl(c4, (d ? 32 : 16) + i), q2 = __shfl(c4, (d ? 16 : 32) + i);
            const float Dm = q0 * q1;
            const float off = sq == 0 ? 1.f : (sq == 1 ? q0 : (sq == 2 ? Dm : Dm * q2));
            Dp[0] = off; Dp[1] = off * c1; Dp[2] = off * c2; Dp[3] = off * c3;
            Dt[0] = Dp[1]; Dt[1] = Dp[2]; Dt[2] = Dp[3]; Dt[3] = off * c4;
            const float rDm = rcpf_(Dm);
            h4 hk, hb, he;
#pragma unroll
            for (int e = 0; e < 4; ++e) { const float rDt = rcpf_(Dt[e]);
                const float kap = vk[e] * Dp[e] * rDm, rr = vr[e] * Dt[e] * rDm, bq = vb[e] * Dm * rDt, eq = ve[e] * Dm * rDt;
                const int s = 4 * sq + e;
                ((LAS _Float16*)(IMG + C1_SC + (0 * 16 + s) * C1_SCST))[c] = (_Float16)kap; ((LAS _Float16*)(IMG + C1_SC + (1 * 16 + s) * C1_SCST))[c] = (_Float16)rr;
                ((LAS _Float16*)(IMG + C1_SC + (2 * 16 + s) * C1_SCST))[c] = (_Float16)bq;  ((LAS _Float16*)(IMG + C1_SC + (3 * 16 + s) * C1_SCST))[c] = (_Float16)eq;
                hk[e] = (_Float16)kap; hb[e] = (_Float16)bq; he[e] = (_Float16)eq; }
            *(LAS h4*)(IMG + C1_CM + c * 96 + 0 + sq * 8) = hk; *(LAS h4*)(IMG + C1_CM + c * 96 + 32 + sq * 8) = hb; *(LAS h4*)(IMG + C1_CM + c * 96 + 64 + sq * 8) = he;
            if (sq == 3) *(LAS float*)(IMG + C1_DL + c * 4) = Dt[3];
            if (sq == 0) *(LAS float*)(IMG + C1_DM + c * 4) = Dm;
        }
        }
        if (it + 1 < 32) C1_LOAD(B0 + it + 1);
        { const LAS unsigned char* IMG = lds + C1_IMG + (((it - 1) & 1) * 2 + d) * C1_IMG_D; LAS unsigned char* R = lds + C1_RES + (((it - 1) & 1) * 2 + d) * C1_RES_D;
        if (MODE != 1 && MODE != 4) {
            h8 fk[2], fr[2], fb[2], fe[2];
#pragma unroll
            for (int ks = 0; ks < 2; ++ks) { const LAS unsigned char* p = IMG + C1_SC + i * C1_SCST + (8 * g + 32 * ks) * 2;
                fk[ks] = *(const LAS h8*)(p); fr[ks] = *(const LAS h8*)(p + 16 * C1_SCST); fb[ks] = *(const LAS h8*)(p + 32 * C1_SCST); fe[ks] = *(const LAS h8*)(p + 48 * C1_SCST); }
            const f32x4 z4 = (f32x4){0.f, 0.f, 0.f, 0.f};
            f32x4 aN = z4, aNT = z4, aM = z4, aMT = z4, aNr = z4, aMr = z4;
#pragma unroll
            for (int ks = 0; ks < 2; ++ks) {
                aN  = __builtin_amdgcn_mfma_f32_16x16x32_f16(fb[ks], fk[ks], aN, 0, 0, 0);  aNT = __builtin_amdgcn_mfma_f32_16x16x32_f16(fk[ks], fb[ks], aNT, 0, 0, 0);
                aM  = __builtin_amdgcn_mfma_f32_16x16x32_f16(fe[ks], fk[ks], aM, 0, 0, 0);  aMT = __builtin_amdgcn_mfma_f32_16x16x32_f16(fk[ks], fe[ks], aMT, 0, 0, 0);
                aNr = __builtin_amdgcn_mfma_f32_16x16x32_f16(fb[ks], fr[ks], aNr, 0, 0, 0); aMr = __builtin_amdgcn_mfma_f32_16x16x32_f16(fe[ks], fr[ks], aMr, 0, 0, 0); }
#pragma unroll
            for (int e = 0; e < 4; ++e) { const int row = 4 * g + e;
                aN[e] = row < i ? -aN[e] : 0.f; aNT[e] = i < row ? -aNT[e] : 0.f; aM[e] = row < i ? aM[e] : 0.f; aMT[e] = i < row ? aMT[e] : 0.f;
                aNr[e] = row <= i ? aNr[e] : 0.f; aMr[e] = row <= i ? aMr[e] : 0.f; }
#define C1_H4(x_) __builtin_convertvector((x_), h4)
#define C1_MM(a_, b_, c_) __builtin_amdgcn_mfma_f32_16x16x16f16((a_), (b_), (c_), 0, 0, 0)
            f32x4 S = aN, ST = aNT;
#pragma unroll
            for (int e = 0; e < 4; ++e) if (4 * g + e == i) { S[e] += 1.f; ST[e] += 1.f; }
            const h4 hA = C1_H4(aN), hAT = C1_H4(aNT);
            const f32x4 P2 = C1_MM(hAT, hA, z4), P2T = C1_MM(hA, hAT, z4);
            const h4 hP2 = C1_H4(P2), hP2T = C1_H4(P2T);
            { const h4 hS = C1_H4(S); S = C1_MM(hP2T, hS, S); ST = C1_MM(hS, hP2T, ST); }
            const f32x4 P4 = C1_MM(hP2T, hP2, z4), P4T = C1_MM(hP2, hP2T, z4);
            const h4 hP4 = C1_H4(P4), hP4T = C1_H4(P4T);
            { const h4 hS = C1_H4(S); S = C1_MM(hP4T, hS, S); ST = C1_MM(hS, hP4T, ST); }
            const f32x4 P8T = C1_MM(hP4, hP4T, z4);
            const h4 hP8T = C1_H4(P8T);
            { const h4 hS = C1_H4(S); ST = C1_MM(hS, hP8T, ST); }
            const h4 hTT = C1_H4(ST), hMT = C1_H4(aMT);
            const f32x4 X1 = C1_MM(hTT, C1_H4(aNr), z4);
            const h4 hX1 = C1_H4(X1);
            const h4 bT = *(const LAS h4*)(IMG + C1_CM + c * 96 + 32 + g * 8);
            const f32x4 X2 = C1_MM(hTT, bT, z4);
            const float dl = *(const LAS float*)(IMG + C1_DL + c * 4), dm = *(const LAS float*)(IMG + C1_DM + c * 4);
            *(LAS f32x4*)(R + C1_ZT + c * 64 + 16 * g) = X2 * dl;
            const f32x4 Ea = C1_MM(hMT, C1_H4(X2), z4);
            const h4 kh = *(const LAS h4*)(IMG + C1_CM + c * 96 + 64 + g * 8);
            *(LAS f32x4*)(R + C1_ET + c * 64 + 16 * g) = (__builtin_convertvector(kh, f32x4) - Ea) * (dl * rcpf_(dm));
            const h4 kT = *(const LAS h4*)(IMG + C1_CM + c * 96 + g * 8);
            const f32x4 Qa = C1_MM(kT, hX1, z4);
            const h4 rh = *(const LAS h4*)(IMG + C1_SC + (16 + i) * C1_SCST + (16 * wa + 4 * g) * 2);
            const f32x4 dm4 = *(const LAS f32x4*)(IMG + C1_DM + (16 * wa + 4 * g) * 4);
            *(LAS f32x4*)(R + C1_QT + i * 256 + (16 * wa + 4 * g) * 4) = (__builtin_convertvector(rh, f32x4) - Qa) * dm4;
            if (wa == 0) { const f32x4 Ca = C1_MM(hMT, hX1, z4); *(LAS f32x4*)(R + C1_CT + i * 64 + 16 * g) = aMr - Ca; }
            *(LAS h4*)(R + C1_UH + c * 32 + 8 * g) = kT;
            if (g == 0) *(LAS float*)(R + C1_DA + c * 4) = dl;
#undef C1_H4
#undef C1_MM
        }
        }
        { const int B = B0 + it - 2; const LAS unsigned char* R = lds + C1_RES + ((it & 1) * 2 + d) * C1_RES_D;
        if (MODE != 2 && MODE != 4) {
            const int n = d ? 255 - B : B;
            GAS unsigned char* gt = (d ? (GAS unsigned char*)F.out : F.ws + WS_GT0) + ((size_t)(bb * 4 + h) * 256 + n) * GT_CHUNK;
            const int nt = wa;
            bf16x8 zf = (bf16x8){0, 0, 0, 0, 0, 0, 0, 0};
            if (g < 2) { const LAS f32x4* zp = (const LAS f32x4*)(R + C1_ZT + (16 * nt + i) * 64 + 32 * g); zf = pack8(zp[0], zp[1]); }
            f32x4 pp[4];
#pragma unroll
            for (int ct = 0; ct < 4; ++ct) {
                bf16x8 uf = (bf16x8){0, 0, 0, 0, 0, 0, 0, 0};
                if (g < 2) { const LAS h4* up = (const LAS h4*)(R + C1_UH + (16 * ct + i) * 32 + 16 * g); uf = pack8(__builtin_convertvector(up[0], f32x4), __builtin_convertvector(up[1], f32x4)); }
                const f32x4 dd = __builtin_amdgcn_mfma_f32_16x16x32_bf16(uf, zf, (f32x4){0.f, 0.f, 0.f, 0.f}, 0, 0, 0);
                f32x4 pv = -dd;
                if (ct == nt) { const f32x4 da = *(const LAS f32x4*)(R + C1_DA + (16 * ct + 4 * g) * 4);
#pragma unroll
                    for (int e = 0; e < 4; ++e) if (4 * g + e == i) pv[e] += da[e]; }
                pp[ct] = pv; }
#undef C1_ST
#define C1_ST(p_, v_) do { const bf16x8 v__ = (v_); if (MODE == 0) *(GAS bf16x8*)(p_) = v__; else asm volatile("" :: "v"(v__)); } while (0)
            C1_ST(gt + (nt * 2 + 0) * 1024 + lane * 16, pack8(pp[0], pp[1]));
            C1_ST(gt + (nt * 2 + 1) * 1024 + lane * 16, pack8(pp[2], pp[3]));
            if (g < 2) { const LAS f32x4* ep = (const LAS f32x4*)(R + C1_ET + (16 * nt + i) * 64 + 32 * g); C1_ST(gt + 10240 + nt * 512 + lane * 16, pack8(ep[0], ep[1])); }
            if (wa == 0) {
#pragma unroll
                for (int ks = 0; ks < 2; ++ks) { const LAS f32x4* qp = (const LAS f32x4*)(R + C1_QT + i * 256 + (32 * ks + 4 * g) * 4);
                    C1_ST(gt + (8 + ks) * 1024 + lane * 16, pack8(qp[0], qp[4])); }
                if (g < 2) { const LAS f32x4* cp = (const LAS f32x4*)(R + C1_CT + i * 64 + 32 * g); C1_ST(gt + 10240 + 4 * 512 + lane * 16, pack8(cp[0], cp[1])); }
            }
        }
        }
        C1_BAR();
    }
    {
        const int it = 32;
        { const LAS unsigned char* IMG = lds + C1_IMG + (((it - 1) & 1) * 2 + d) * C1_IMG_D; LAS unsigned char* R = lds + C1_RES + (((it - 1) & 1) * 2 + d) * C1_RES_D;
        if (MODE != 1 && MODE != 4) {
            h8 fk[2], fr[2], fb[2], fe[2];
#pragma unroll
            for (int ks = 0; ks < 2; ++ks) { const LAS unsigned char* p = IMG + C1_SC + i * C1_SCST + (8 * g + 32 * ks) * 2;
                fk[ks] = *(const LAS h8*)(p); fr[ks] = *(const LAS h8*)(p + 16 * C1_SCST); fb[ks] = *(const LAS h8*)(p + 32 * C1_SCST); fe[ks] = *(const LAS h8*)(p + 48 * C1_SCST); }
            const f32x4 z4 = (f32x4){0.f, 0.f, 0.f, 0.f};
            f32x4 aN = z4, aNT = z4, aM = z4, aMT = z4, aNr = z4, aMr = z4;
#pragma unroll
            for (int ks = 0; ks < 2; ++ks) {
                aN  = __builtin_amdgcn_mfma_f32_16x16x32_f16(fb[ks], fk[ks], aN, 0, 0, 0);  aNT = __builtin_amdgcn_mfma_f32_16x16x32_f16(fk[ks], fb[ks], aNT, 0, 0, 0);
                aM  = __builtin_amdgcn_mfma_f32_16x16x32_f16(fe[ks], fk[ks], aM, 0, 0, 0);  aMT = __builtin_amdgcn_mfma_f32_16x16x32_f16(fk[ks], fe[ks], aMT, 0, 0, 0);
                aNr = __builtin_amdgcn_mfma_f32_16x16x32_f16(fb[ks], fr[ks], aNr, 0, 0, 0); aMr = __builtin_amdgcn_mfma_f32_16x16x32_f16(fe[ks], fr[ks], aMr, 0, 0, 0); }
#pragma unroll
            for (int e = 0; e < 4; ++e) { const int row = 4 * g + e;
                aN[e] = row < i ? -aN[e] : 0.f; aNT[e] = i < row ? -aNT[e] : 0.f; aM[e] = row < i ? aM[e] : 0.f; aMT[e] = i < row ? aMT[e] : 0.f;
                aNr[e] = row <= i ? aNr[e] : 0.f; aMr[e] = row <= i ? aMr[e] : 0.f; }
#define C1_H4(x_) __builtin_convertvector((x_), h4)
#define C1_MM(a_, b_, c_) __builtin_amdgcn_mfma_f32_16x16x16f16((a_), (b_), (c_), 0, 0, 0)
            f32x4 S = aN, ST = aNT;
#pragma unroll
            for (int e = 0; e < 4; ++e) if (4 * g + e == i) { S[e] += 1.f; ST[e] += 1.f; }
            const h4 hA = C1_H4(aN), hAT = C1_H4(aNT);
            const f32x4 P2 = C1_MM(hAT, hA, z4), P2T = C1_MM(hA, hAT, z4);
            const h4 hP2 = C1_H4(P2), hP2T = C1_H4(P2T);
            { const h4 hS = C1_H4(S); S = C1_MM(hP2T, hS, S); ST = C1_MM(hS, hP2T, ST); }
            const f32x4 P4 = C1_MM(hP2T, hP2, z4), P4T = C1_MM(hP2, hP2T, z4);
            const h4 hP4 = C1_H4(P4), hP4T = C1_H4(P4T);
            { const h4 hS = C1_H4(S); S = C1_MM(hP4T, hS, S); ST = C1_MM(hS, hP4T, ST); }
            const f32x4 P8T = C1_MM(hP4, hP4T, z4);
            const h4 hP8T = C1_H4(P8T);
            { const h4 hS = C1_H4(S); ST = C1_MM(hS, hP8T, ST); }
            const h4 hTT = C1_H4(ST), hMT = C1_H4(aMT);
            const f32x4 X1 = C1_MM(hTT, C1_H4(aNr), z4);
            const h4 hX1 = C1_H4(X1);
            const h4 bT = *(const LAS h4*)(IMG + C1_CM + c * 96 + 32 + g * 8);
            const f32x4 X2 = C1_MM(hTT, bT, z4);
            const float dl = *(const LAS float*)(IMG + C1_DL + c * 4), dm = *(const LAS float*)(IMG + C1_DM + c * 4);
            *(LAS f32x4*)(R + C1_ZT + c * 64 + 16 * g) = X2 * dl;
            const f32x4 Ea = C1_MM(hMT, C1_H4(X2), z4);
            const h4 kh = *(const LAS h4*)(IMG + C1_CM + c * 96 + 64 + g * 8);
            *(LAS f32x4*)(R + C1_ET + c * 64 + 16 * g) = (__builtin_convertvector(kh, f32x4) - Ea) * (dl * rcpf_(dm));
            const h4 kT = *(const LAS h4*)(IMG + C1_CM + c * 96 + g * 8);
            const f32x4 Qa = C1_MM(kT, hX1, z4);
            const h4 rh = *(const LAS h4*)(IMG + C1_SC + (16 + i) * C1_SCST + (16 * wa + 4 * g) * 2);
            const f32x4 dm4 = *(const LAS f32x4*)(IMG + C1_DM + (16 * wa + 4 * g) * 4);
            *(LAS f32x4*)(R + C1_QT + i * 256 + (16 * wa + 4 * g) * 4) = (__builtin_convertvector(rh, f32x4) - Qa) * dm4;
            if (wa == 0) { const f32x4 Ca = C1_MM(hMT, hX1, z4); *(LAS f32x4*)(R + C1_CT + i * 64 + 16 * g) = aMr - Ca; }
            *(LAS h4*)(R + C1_UH + c * 32 + 8 * g) = kT;
            if (g == 0) *(LAS float*)(R + C1_DA + c * 4) = dl;
#undef C1_H4
#undef C1_MM
        }
        }
        { const int B = B0 + it - 2; const LAS unsigned char* R = lds + C1_RES + ((it & 1) * 2 + d) * C1_RES_D;
        if (MODE != 2 && MODE != 4) {
            const int n = d ? 255 - B : B;
            GAS unsigned char* gt = (d ? (GAS unsigned char*)F.out : F.ws + WS_GT0) + ((size_t)(bb * 4 + h) * 256 + n) * GT_CHUNK;
            const int nt = wa;
            bf16x8 zf = (bf16x8){0, 0, 0, 0, 0, 0, 0, 0};
            if (g < 2) { const LAS f32x4* zp = (const LAS f32x4*)(R + C1_ZT + (16 * nt + i) * 64 + 32 * g); zf = pack8(zp[0], zp[1]); }
            f32x4 pp[4];
#pragma unroll
            for (int ct = 0; ct < 4; ++ct) {
                bf16x8 uf = (bf16x8){0, 0, 0, 0, 0, 0, 0, 0};
                if (g < 2) { const LAS h4* up = (const LAS h4*)(R + C1_UH + (16 * ct + i) * 32 + 16 * g); uf = pack8(__builtin_convertvector(up[0], f32x4), __builtin_convertvector(up[1], f32x4)); }
                const f32x4 dd = __builtin_amdgcn_mfma_f32_16x16x32_bf16(uf, zf, (f32x4){0.f, 0.f, 0.f, 0.f}, 0, 0, 0);
                f32x4 pv = -dd;
                if (ct == nt) { const f32x4 da = *(const LAS f32x4*)(R + C1_DA + (16 * ct + 4 * g) * 4);
#pragma unroll
                    for (int e = 0; e < 4; ++e) if (4 * g + e == i) pv[e] += da[e]; }
                pp[ct] = pv; }
#undef C1_ST
#define C1_ST(p_, v_) do { const bf16x8 v__ = (v_); if (MODE == 0) *(GAS bf16x8*)(p_) = v__; else asm volatile("" :: "v"(v__)); } while (0)
            C1_ST(gt + (nt * 2 + 0) * 1024 + lane * 16, pack8(pp[0], pp[1]));
            C1_ST(gt + (nt * 2 + 1) * 1024 + lane * 16, pack8(pp[2], pp[3]));
            if (g < 2) { const LAS f32x4* ep = (const LAS f32x4*)(R + C1_ET + (16 * nt + i) * 64 + 32 * g); C1_ST(gt + 10240 + nt * 512 + lane * 16, pack8(ep[0], ep[1])); }
            if (wa == 0) {
#pragma unroll
                for (int ks = 0; ks < 2; ++ks) { const LAS f32x4* qp = (const LAS f32x4*)(R + C1_QT + i * 256 + (32 * ks + 4 * g) * 4);
                    C1_ST(gt + (8 + ks) * 1024 + lane * 16, pack8(qp[0], qp[4])); }
                if (g < 2) { const LAS f32x4* cp = (const LAS f32x4*)(R + C1_CT + i * 64 + 32 * g); C1_ST(gt + 10240 + 4 * 512 + lane * 16, pack8(cp[0], cp[1])); }
            }
        }
        }
        C1_BAR();
    }
    {
        const int it = 33;
        { const int B = B0 + it - 2; const LAS unsigned char* R = lds + C1_RES + ((it & 1) * 2 + d) * C1_RES_D;
        if (MODE != 2 && MODE != 4) {
            const int n = d ? 255 - B : B;
            GAS unsigned char* gt = (d ? (GAS unsigned char*)F.out : F.ws + WS_GT0) + ((size_t)(bb * 4 + h) * 256 + n) * GT_CHUNK;
            const int nt = wa;
            bf16x8 zf = (bf16x8){0, 0, 0, 0, 0, 0, 0, 0};
            if (g < 2) { const LAS f32x4* zp = (const LAS f32x4*)(R + C1_ZT + (16 * nt + i) * 64 + 32 * g); zf = pack8(zp[0], zp[1]); }
            f32x4 pp[4];
#pragma unroll
            for (int ct = 0; ct < 4; ++ct) {
                bf16x8 uf = (bf16x8){0, 0, 0, 0, 0, 0, 0, 0};
                if (g < 2) { const LAS h4* up = (const LAS h4*)(R + C1_UH + (16 * ct + i) * 32 + 16 * g); uf = pack8(__builtin_convertvector(up[0], f32x4), __builtin_convertvector(up[1], f32x4)); }
                const f32x4 dd = __builtin_amdgcn_mfma_f32_16x16x32_bf16(uf, zf, (f32x4){0.f, 0.f, 0.f, 0.f}, 0, 0, 0);
                f32x4 pv = -dd;
                if (ct == nt) { const f32x4 da = *(const LAS f32x4*)(R + C1_DA + (16 * ct + 4 * g) * 4);
#pragma unroll
                    for (int e = 0; e < 4; ++e) if (4 * g + e == i) pv[e] += da[e]; }
                pp[ct] = pv; }
#undef C1_ST
#define C1_ST(p_, v_) do { const bf16x8 v__ = (v_); if (MODE == 0) *(GAS bf16x8*)(p_) = v__; else asm volatile("" :: "v"(v__)); } while (0)
            C1_ST(gt + (nt * 2 + 0) * 1024 + lane * 16, pack8(pp[0], pp[1]));
            C1_ST(gt + (nt * 2 + 1) * 1024 + lane * 16, pack8(pp[2], pp[3]));
            if (g < 2) { const LAS f32x4* ep = (const LAS f32x4*)(R + C1_ET + (16 * nt + i) * 64 + 32 * g); C1_ST(gt + 10240 + nt * 512 + lane * 16, pack8(ep[0], ep[1])); }
            if (wa == 0) {
#pragma unroll
                for (int ks = 0; ks < 2; ++ks) { const LAS f32x4* qp = (const LAS f32x4*)(R + C1_QT + i * 256 + (32 * ks + 4 * g) * 4);
                    C1_ST(gt + (8 + ks) * 1024 + lane * 16, pack8(qp[0], qp[4])); }
                if (g < 2) { const LAS f32x4* cp = (const LAS f32x4*)(R + C1_CT + i * 64 + 32 * g); C1_ST(gt + 10240 + 4 * 512 + lane * 16, pack8(cp[0], cp[1])); }
            }
        }
        }
        C1_BAR();
    }
#undef C1_LOAD
#undef C1_BAR
    __syncthreads();
}
#define C2_BAR() do { asm volatile("s_waitcnt lgkmcnt(0)" ::: "memory"); __builtin_amdgcn_s_barrier(); asm volatile("" ::: "memory"); } while (0)
constexpr int C2_SLOT = 16384, C2_YOFF = 4 * C2_SLOT;
template <int MODE>
__device__ __forceinline__ void phase_scan_c2(Frame& F, int l) {
    LAUNDER(F);
    if (F.vcu >= 128) { if (MODE == 0) phase_mix_na(F, l, F.vcu - 128, 128); return; }
    const GAS bf16* proj = (const GAS bf16*)(F.ws + WS_PROJ);
    const int lane = F.lane, i = lane & 15, g = lane >> 4;
    LAS unsigned char* lds = F.lds;
    if (F.vcu < 128) {
    const int ci = F.vcu >> 1, tp = F.vcu & 1, d = ci >> 5, bb = (ci >> 2) & 7, h = ci & 3;
    for (int q = F.tid; q < 4 * 5 * 32; q += NTHREADS) { const int sl = q / 160, r = q % 160; *(LAS v4u*)(lds + sl * C2_SLOT + 10240 + (r >> 5) * 1024 + 512 + (r & 31) * 16) = (v4u){0u, 0u, 0u, 0u}; }
    __syncthreads();
    if (F.wave < 2) {
        const int cw = F.wave;
        f32x4 st[4];
#pragma unroll
        for (int t = 0; t < 4; ++t) st[t] = (f32x4){0.f, 0.f, 0.f, 0.f};
        v4u af[15], vf, nf[15], nvf;
#define C2_RD(AF, VF, c_) do { const LAS unsigned char* p_ = lds + ((c_) & 3) * C2_SLOT + lane * 16; \
            _Pragma("unroll") for (int f_ = 0; f_ < 15; ++f_) AF[f_] = *(const LAS v4u*)(p_ + f_ * 1024); \
            VF = *(const LAS v4u*)(lds + ((c_) & 3) * C2_SLOT + 15360 + cw * 512 + i * 32 + (g & 1) * 16); } while (0)
#define C2_STEP(AF, VF, NF, NVF, n_) do { \
            if ((n_) + 1 < 256) C2_RD(NF, NVF, (n_) + 1); \
            const bf16x8 b0_ = pack8(st[0], st[1]), b1_ = pack8(st[2], st[3]); const v4u vz_ = (g < 2) ? VF : (v4u){0u, 0u, 0u, 0u}; const bf16x8 bv_ = __builtin_bit_cast(bf16x8, vz_); \
            f32x4 o_[5]; \
            _Pragma("unroll") for (int nt = 0; nt < 5; ++nt) { if (MODE >= 2) { o_[nt] = __builtin_bit_cast(f32x4, AF[nt]) + __builtin_bit_cast(f32x4, AF[10 + nt]) * st[nt & 3]; continue; } \
                f32x4 a_ = __builtin_amdgcn_mfma_f32_16x16x32_bf16(__builtin_bit_cast(bf16x8, AF[nt * 2]), b0_, (f32x4){0.f, 0.f, 0.f, 0.f}, 0, 0, 0); \
                a_ = __builtin_amdgcn_mfma_f32_16x16x32_bf16(__builtin_bit_cast(bf16x8, AF[nt * 2 + 1]), b1_, a_, 0, 0, 0); \
                o_[nt] = __builtin_amdgcn_mfma_f32_16x16x32_bf16(__builtin_bit_cast(bf16x8, AF[10 + nt]), bv_, a_, 0, 0, 0); } \
            _Pragma("unroll") for (int t = 0; t < 4; ++t) st[t] = o_[t]; \
            { v2u yw_; yw_.x = pk2(o_[4].x, o_[4].y); yw_.y = pk2(o_[4].z, o_[4].w); \
              *(LAS v2u*)(lds + C2_YOFF + (cw * 8 + ((n_) & 7)) * 512 + i * 32 + g * 8) = yw_; }     \
            } while (0)
        C2_BAR();
        C2_RD(af, vf, 0);
        for (int n = 0; n < 256; n += 2) { C2_STEP(af, vf, nf, nvf, n); C2_STEP(nf, nvf, af, vf, n + 1); C2_BAR(); }
        C2_BAR();
#undef C2_STEP
#undef C2_RD
    } else {
        const int hl = F.tid - 128;
        const GAS unsigned char* gt = (d ? (const GAS unsigned char*)F.out : F.ws + WS_GT0) + ((size_t)(bb * 4 + h) * 256) * GT_CHUNK;
        GAS bf16* ysc = (GAS bf16*)(d ? (GAS unsigned char*)F.out + GT_DIR : F.ws + WS_YSC0) + (size_t)bb * T * 256 + h * 64 + 32 * tp;
        const int p0 = hl, p1 = hl + 384, p2 = hl + 768; const bool has2 = p2 < 800;
#define C2_OFF(p_) ((p_) < 640 ? (p_) * 16 : 10240 + (((p_) - 640) >> 5) * 1024 + (((p_) - 640) & 31) * 16)
        const int o0 = C2_OFF(p0), o1 = C2_OFF(p1), o2 = C2_OFF(has2 ? p2 : 799);
        const int e0 = hl, e1 = hl + 384; const bool hasv1 = e1 < 512;
        const GAS bf16* vs0 = proj + (size_t)bb * T * NPROJP + C_V + h * 64 + 32 * tp + 16 * (e0 >> 8) + (e0 & 15);
        const GAS bf16* vs1 = proj + (size_t)bb * T * NPROJP + C_V + h * 64 + 32 * tp + 16 * ((hasv1 ? e1 : 0) >> 8) + (e1 & 15);
        const int vt0 = (e0 >> 4) & 15, vt1 = (e1 >> 4) & 15;
        const int vo0 = 15360 + (e0 >> 8) * 512 + (e0 & 15) * 32 + vt0 * 2, vo1 = 15360 + ((hasv1 ? e1 : 0) >> 8) * 512 + (e1 & 15) * 32 + vt1 * 2;
        constexpr int RD = 12;
        v4u r0[RD], r1[RD], r2[RD]; unsigned short rv0[RD], rv1[RD];
        if (MODE == 1 || MODE == 3) {
#pragma unroll
            for (int k = 0; k < RD; ++k) { r0[k] = (v4u){1u, 2u, 3u, 4u}; r1[k] = r0[k]; r2[k] = r0[k]; rv0[k] = 0; rv1[k] = 0; } }
#define C2_GLD(k_, n_) do { if (MODE == 1 || MODE == 3) break; const GAS unsigned char* c_ = gt + (size_t)(n_) * GT_CHUNK; r0[k_] = *(const GAS v4u*)(c_ + p0 * 16); r1[k_] = *(const GAS v4u*)(c_ + p1 * 16); \
            if (has2) r2[k_] = *(const GAS v4u*)(c_ + p2 * 16); \
            { const int gs_ = 16 * (n_) + vt0, t_ = d ? (T - 1 - gs_) : gs_; rv0[k_] = vs0[(size_t)t_ * NPROJP]; } \
            if (hasv1) { const int gs_ = 16 * (n_) + vt1, t_ = d ? (T - 1 - gs_) : gs_; rv1[k_] = vs1[(size_t)t_ * NPROJP]; } } while (0)
#define C2_WR(k_, n_) do { LAS unsigned char* p_ = lds + ((n_) & 3) * C2_SLOT; *(LAS v4u*)(p_ + o0) = r0[k_]; *(LAS v4u*)(p_ + o1) = r1[k_]; if (has2) *(LAS v4u*)(p_ + o2) = r2[k_]; \
            *(LAS unsigned short*)(p_ + vo0) = rv0[k_]; if (hasv1) *(LAS unsigned short*)(p_ + vo1) = rv1[k_]; } while (0)
#define C2_YST(m_) do { if (hl < 64) { const int cw_ = hl >> 5, s_ = (hl >> 1) & 15, hf_ = hl & 1; const LAS unsigned short* yp_ = (const LAS unsigned short*)(lds + C2_YOFF + (cw_ * 8 + ((m_) & 7)) * 512) + s_; \
            v4u w_; _Pragma("unroll") for (int e_ = 0; e_ < 4; ++e_) w_[e_] = (unsigned)yp_[(8 * hf_ + 2 * e_) * 16] | ((unsigned)yp_[(8 * hf_ + 2 * e_ + 1) * 16] << 16); \
            const int gs_ = 16 * (m_) + s_, t_ = d ? (T - 1 - gs_) : gs_; if (MODE == 0) *(GAS v4u*)(ysc + (size_t)t_ * 256 + 16 * cw_ + 8 * hf_) = w_; else asm volatile("" :: "v"(w_)); } } while (0)
#pragma unroll
        for (int k = 0; k < RD; ++k) C2_GLD(k, k);
        C2_WR(0, 0); C2_GLD(0, RD); C2_WR(1, 1); C2_GLD(1, RD + 1); C2_WR(2, 2); C2_GLD(2, RD + 2);
        C2_BAR();
        for (int m6 = 0; m6 < 128; m6 += RD / 2) {
#pragma unroll
            for (int k = 0; k < RD / 2; ++k) { const int m = m6 + k;
                if (m < 128) {
                    const int ca = 2 * m + 3, cb = 2 * m + 4, ka = (2 * k + 3) % RD, kb = (2 * k + 4) % RD;
                    if (ca < 256) { C2_WR(ka, ca); if (ca + RD < 256) C2_GLD(ka, ca + RD); }
                    if (cb < 256) { C2_WR(kb, cb); if (cb + RD < 256) C2_GLD(kb, cb + RD); }
                    if (m > 0) { C2_YST(2 * m - 2); C2_YST(2 * m - 1); }
                    C2_BAR(); } }
        }
        C2_YST(254); C2_YST(255);
        C2_BAR();
#undef C2_GLD
#undef C2_WR
#undef C2_YST
#undef C2_OFF
    }
    }
    __syncthreads();
}
#undef C2_BAR
#undef CK_DOT
#undef CK_RED2

__device__ __forceinline__ void phase_rwkv_post(Frame& F, int l) {
    LAUNDER(F);
    const GAS bf16* proj = (const GAS bf16*)(F.ws + WS_PROJ); GAS bf16* merged = (GAS bf16*)(F.ws + WS_MERGED); const GAS bf16* ysc0 = (const GAS bf16*)(F.ws + WS_YSC0); const GAS bf16* ysc1 = (const GAS bf16*)((const GAS unsigned char*)F.out + GT_DIR);
    const int lane = F.lane, c4 = 4 * lane, i = lane & 15, g = lane >> 4;
    bf16x8 Bg[16];
    {   LAS bf16x8* GB = (LAS bf16x8*)F.lds;
        for (int q = F.tid; q < 1024; q += NTHREADS) { const int ct = q >> 6, ln = q & 63; const GAS float* gp = INP(F, I_RGUP) + ((size_t)l * 32 + 8 * (ln >> 4)) * 256 + 16 * ct + (ln & 15);
            GB[q] = pack8((f32x4){gp[0], gp[256], gp[512], gp[768]}, (f32x4){gp[1024], gp[1280], gp[1536], gp[1792]}); }
        __syncthreads();
#pragma unroll
        for (int ct = 0; ct < 16; ++ct) Bg[ct] = GB[ct * 64 + lane];
        __syncthreads(); }
    LAS float* GL = (LAS float*)(F.lds + F.wave * 16384);
    const f32x4 lw = *(const f32x4*)(INP(F, I_LNXW) + l * 256 + c4), lb = *(const f32x4*)(INP(F, I_LNXB) + l * 256 + c4), rk = *(const f32x4*)(INP(F, I_RRK) + l * 256 + c4);
    const int mstep = F.G * NWAVES;
    for (int m0 = F.vcu * NWAVES + F.wave; m0 < M; m0 += 16 * mstep) {
        v2u n_yf[4], n_yb[4], n_r[4], n_k[4], n_v[4];
#define POST_LOAD4(tb_) do { _Pragma("unroll") for (int q_ = 0; q_ < 4; ++q_) { const size_t mm_ = (size_t)(m0 + ((tb_) + q_) * mstep); const GAS bf16* row_ = proj + mm_ * NPROJP; \
        n_yf[q_] = *(const GAS v2u*)(ysc0 + mm_ * 256 + c4); n_yb[q_] = *(const GAS v2u*)(ysc1 + mm_ * 256 + c4); \
        n_r[q_] = *(const GAS v2u*)(row_ + C_R + c4); n_k[q_] = *(const GAS v2u*)(row_ + C_K + c4); n_v[q_] = *(const GAS v2u*)(row_ + C_V + c4); } } while (0)
        POST_LOAD4(0);
        {   const v4u raw = *(const GAS v4u*)(proj + (size_t)(m0 + i * mstep) * NPROJP + C_GDN + 8 * g);
            const bf16x8 Af = pack8((f32x4){sigmoidf_(bflo(raw.x)), sigmoidf_(bfhi(raw.x)), sigmoidf_(bflo(raw.y)), sigmoidf_(bfhi(raw.y))}, (f32x4){sigmoidf_(bflo(raw.z)), sigmoidf_(bfhi(raw.z)), sigmoidf_(bflo(raw.w)), sigmoidf_(bfhi(raw.w))});
            CFENCE();
#pragma unroll
            for (int ct = 0; ct < 16; ++ct) { const f32x4 a = __builtin_amdgcn_mfma_f32_16x16x32_bf16(Af, Bg[ct], (f32x4){0.f, 0.f, 0.f, 0.f}, 0, 0, 0);
#pragma unroll
                for (int e = 0; e < 4; ++e) GL[(4 * g + e) * 256 + 16 * ct + i] = a[e]; }
            LDS_WAIT(); CFENCE(); }
        for (int tb = 0; tb < 16; tb += 4) {
            v2u c_yf[4], c_yb[4], c_r[4], c_k[4], c_v[4];
#pragma unroll
            for (int q = 0; q < 4; ++q) { c_yf[q] = n_yf[q]; c_yb[q] = n_yb[q]; c_r[q] = n_r[q]; c_k[q] = n_k[q]; c_v[q] = n_v[q]; }
            if (tb + 4 < 16) POST_LOAD4(tb + 4);
#pragma unroll
            for (int q = 0; q < 4; ++q) { const int t = tb + q, m = m0 + t * mstep;
                const v2u yf = c_yf[q], yb = c_yb[q], ru = c_r[q], ku = c_k[q], vu = c_v[q];
                f32x4 y = (f32x4){bflo(yf.x) + bflo(yb.x), bfhi(yf.x) + bfhi(yb.x), bflo(yf.y) + bflo(yb.y), bfhi(yf.y) + bfhi(yb.y)};
                const float mu = row16_sum((y.x + y.y) + (y.z + y.w)) * (1.f / 64.f);
                y = y - mu;
                const float var = row16_sum((y.x * y.x + y.y * y.y) + (y.z * y.z + y.w * y.w)) * (1.f / 64.f);
                const float rstd = rsqf_(var + GN_EPS);
                y = y * rstd * lw + lb;
                const f32x4 r = (f32x4){bflo(ru.x), bfhi(ru.x), bflo(ru.y), bfhi(ru.y)}, k = (f32x4){bflo(ku.x), bfhi(ku.x), bflo(ku.y), bfhi(ku.y)}, v = (f32x4){bflo(vu.x), bfhi(vu.x), bflo(vu.y), bfhi(vu.y)};
                const f32x4 rkk = r * k * rk;
                const float bsum = row16_sum((rkk.x + rkk.y) + (rkk.z + rkk.w));
                y = y + v * bsum;
                y = y * *(const LAS f32x4*)(GL + t * 256 + c4);
                const float ss = wave_sum((y.x * y.x + y.y * y.y) + (y.z * y.z + y.w * y.w));
                const float sc = rsqf_(ss * (1.f / 256.f) + NORM_EPS);
                v2u o; o.x = pk2(y.x * sc, y.y * sc); o.y = pk2(y.z * sc, y.w * sc);
                *(GAS v2u*)(merged + (size_t)m * DM + 256 + c4) = o; } }
        CFENCE();
    }
#undef POST_LOAD4
}

__device__ __forceinline__ void phase_residual(Frame& F, const GAS float* gain, const bool IN_F32, const bool LAST) {
    LAUNDER(F);
    const GAS bf16* y = (const GAS bf16*)(F.ws + WS_Y); const GAS float* part = (const GAS float*)(F.ws + WS_PART);
    GAS bf16* xb = (GAS bf16*)(F.ws + WS_XB); GAS float* rs = (GAS float*)(F.ws + WS_RS); const GAS float* xin = INP(F, I_X);
    const int lane = F.lane;
    f32x4 gv[4];
#pragma unroll
    for (int j = 0; j < 4; ++j) gv[j] = *((const f32x4*)gain + lane + 64 * j);
    for (int m = F.vcu * NWAVES + F.wave; m < M; m += F.G * NWAVES) {
        const f32x4* pp = (const f32x4*)(part + (size_t)m * 16);
        const f32x4 p0 = *(const GAS f32x4*)(pp), p1 = *(const GAS f32x4*)(pp + 1), p2 = *(const GAS f32x4*)(pp + 2), p3 = *(const GAS f32x4*)(pp + 3);
        const float tot = ((p0.x + p0.y) + (p0.z + p0.w)) + ((p1.x + p1.y) + (p1.z + p1.w)) + ((p2.x + p2.y) + (p2.z + p2.w)) + ((p3.x + p3.y) + (p3.z + p3.w));
        const float sc = rsqf_(tot * (1.f / DM) + NORM_EPS);
        const GAS v2u* yr = (const GAS v2u*)(y + (size_t)m * DM) + lane;
        f32x4 v[4]; float s = 0.f;
#pragma unroll
        for (int j = 0; j < 4; ++j) { const v2u yu = yr[64 * j]; const f32x4 yv = (f32x4){bflo(yu.x), bfhi(yu.x), bflo(yu.y), bfhi(yu.y)};
            f32x4 xv;
            if (IN_F32) xv = ((const GAS f32x4*)(xin + (size_t)m * DM) + lane)[64 * j];
            else { const v2u xu = ((const GAS v2u*)(xb + (size_t)m * DM) + lane)[64 * j]; xv = (f32x4){bflo(xu.x), bfhi(xu.x), bflo(xu.y), bfhi(xu.y)}; }
            v[j] = xv + yv * sc * gv[j]; s += (v[j].x * v[j].x + v[j].y * v[j].y) + (v[j].z * v[j].z + v[j].w * v[j].w); }
        if (LAST) {
            GAS f32x4* orow = (GAS f32x4*)(F.out + (size_t)m * DM) + lane;
#pragma unroll
            for (int j = 0; j < 4; ++j) orow[64 * j] = v[j];
        } else {
            s = wave_sum(s);
            GAS v2u* o8 = (GAS v2u*)(xb + (size_t)m * DM) + lane;
#pragma unroll
            for (int j = 0; j < 4; ++j) { v2u o; o.x = pk2(v[j].x, v[j].y); o.y = pk2(v[j].z, v[j].w); o8[64 * j] = o; }
            if (lane == 0) rs[m] = rsqf_(s * (1.f / DM) + NORM_EPS);
        }
    }
}
__device__ __forceinline__ void phase_ffn_conv(Frame& F, int l) {
    LAUNDER(F);
    const GAS bf16* G = (const GAS bf16*)(F.ws + WS_G); GAS bf16* L = (GAS bf16*)(F.ws + WS_L);
    const GAS float* cw = INP(F, I_FCONV) + (size_t)l * 3 * DFF;
    constexpr int CPR = DFF / 8;
    const int nitems = (M / 256) * 2 * CPR;
    for (int it = F.vcu * NTHREADS + F.tid; it < nitems; it += F.G * NTHREADS) {
        const int ck = it % CPR, rr = it / CPR, m = (rr >> 1) * 256 + ((rr & 1) ? 255 : 0), t = m % T, c8 = 8 * ck;
        float w0[8], w1[8], w2[8];
#pragma unroll
        for (int j = 0; j < 8; ++j) { w0[j] = cw[c8 + j]; w1[j] = cw[DFF + c8 + j]; w2[j] = cw[2 * DFF + c8 + j]; }
        const v4u z = (v4u){0u, 0u, 0u, 0u};
        const v4u gp = (t > 0) ? *(const GAS v4u*)(G + (size_t)(m - 1) * DFF + c8) : z, gc = *(const GAS v4u*)(G + (size_t)m * DFF + c8), gn = (t < T - 1) ? *(const GAS v4u*)(G + (size_t)(m + 1) * DFF + c8) : z;
        const v4u lv = *(const GAS v4u*)(L + (size_t)m * DFF + c8);
        v4u o;
#pragma unroll
        for (int q = 0; q < 4; ++q) {
            const float a0 = w0[2 * q] * bflo(gp[q]) + w1[2 * q] * bflo(gc[q]) + w2[2 * q] * bflo(gn[q]);
            const float a1 = w0[2 * q + 1] * bfhi(gp[q]) + w1[2 * q + 1] * bfhi(gc[q]) + w2[2 * q + 1] * bfhi(gn[q]);
            o[q] = pk2(gelu_tanh(a0) * bflo(lv[q]), gelu_tanh(a1) * bfhi(lv[q])); }
        *(GAS v4u*)(L + (size_t)m * DFF + c8) = o;
    }
}

#ifndef MK_N_LAUNCHES
#define MK_N_LAUNCHES 1
#endif
constexpr int NPH = 1 + 8 * DEPTH;
struct Args { const float* in[26]; float* out; unsigned char* ws; int ph_lo, ph_hi; };
__global__ void __launch_bounds__(NTHREADS, 2) enc_fwd(Args args) {
    extern __shared__ __attribute__((aligned(16))) unsigned char lds_raw[];
    Frame F;
    F.lds = (LAS unsigned char*)lds_raw;
    F.MISC = (volatile LAS unsigned*)(F.lds + MISC_OFF);
    F.tid = threadIdx.x; F.lane = F.tid & 63; F.wave = __builtin_amdgcn_readfirstlane(F.tid >> 6);
    F.G = gridDim.x; { const int bx = blockIdx.x; F.vcu = (F.G % 8 == 0) ? (bx % 8) * (F.G / 8) + bx / 8 : bx; }
    F.ws = (GAS unsigned char*)args.ws; F.out = (GAS float*)args.out; F.ctl = (gu32*)(F.ws + WS_CTL);
    F.karg = (kq_t*)__builtin_amdgcn_kernarg_segment_ptr();
    for (int u = F.tid; u < LDS_BYTES / 16; u += NTHREADS) ((LAS v4u*)F.lds)[u] = (v4u){0u, 0u, 0u, 0u};
    __syncthreads();
    const int lo = args.ph_lo, hi = args.ph_hi;
    if (hi - lo > 1) (void)xcd_barrier_post((unsigned*)(F.ctl + CW_BAR), F.MISC + 8);
#define GRID_BAR() do { XcdBarrier bar_; bar_.bar = (unsigned*)(F.ctl + CW_BAR); bar_.x = xb_xcc_id(); bar_.st = F.MISC + 8; xcd_barrier(bar_); } while (0)
#ifndef PH_ENABLE
#define PH_ENABLE 0x7ff
#endif
#define IN(k) (lo <= (k) && (k) < hi)
#define EN(t) (((PH_ENABLE) >> (t)) & 1)
#pragma unroll 1
#ifdef REPEAT_T
    for (int step = lo; step < hi; ++step) {
        const int p1 = REPEAT_T, p2 = REPEAT_T + 8;
        const int ph = step - (step > p1 ? 1 : 0) - ((step > p2 + 1 && REPEAT_T != 7) ? 1 : 0);
#else
    for (int ph = lo; ph < hi; ++ph) {
#endif
        LAUNDER(F);
        const int l = ph == 0 ? 0 : (ph - 1) / 8, tt = ph == 0 ? 0 : 1 + (ph - 1) % 8;
        const int t = tt == 0 ? 0 : (tt == 1 ? 1 : (tt <= 5 ? tt + 1 : tt + 2));
        GAS unsigned char* wl = F.ws + WS_W + (size_t)l * W_LAYER;
      {
        if (t == 1 || t == 8) {
            pg8::Gemm g; pg8::EpiUni E;
            g.M = M; E.split_cols = 0; E.split_stride = 0; E.convw = nullptr; E.G = nullptr; E.xl = (pg8::PG8_LAS_T*)(F.lds + RING_BYTES + 1024); E.part = nullptr; E.rs = (const GAS float*)(F.ws + WS_RS);
            g.A = (const GAS bf16*)(F.ws + WS_XB); g.K = DM;
            if (t == 1) { g.Bt = (const GAS bf16*)(wl + W_IN); g.N = NPROJP; E.O = (GAS bf16*)(F.ws + WS_PROJ); E.ldc = NPROJP; }
            else        { g.Bt = (const GAS bf16*)(wl + W_UP); g.N = NUP;    E.O = (GAS bf16*)(F.ws + WS_L); E.ldc = DFF; E.convw = INP(F, I_FCONV) + (size_t)l * 3 * DFF; E.G = (GAS bf16*)(F.ws + WS_G); }
            g.Bt = launder_p(g.Bt); E.O = launder_p(E.O); E.convw = launder_p(E.convw); E.G = launder_p(E.G); g.N = launder_u(g.N); E.ldc = launder_u(E.ldc);
            g.A = launder_p(g.A); E.rs = launder_p(E.rs);
            pg8::StaticOrder S; S.init(M, g.N, F.G, (int)blockIdx.x);
            pg8::gemm_phase<pg8::EpiUni, pg8::StaticOrder, true, true>(F.lds, g, S, E);
        }
        else if (t == 6 || t == 10) {
            pg8::Gemm g; pg8::EpiResid E;
            g.M = M; g.N = DM; E.xl = (pg8::PG8_LAS_T*)(F.lds + RING_BYTES + 1024);
            E.xb = (GAS bf16*)(F.ws + WS_XB); E.outf = F.out; E.rsw = (GAS float*)(F.ws + WS_RS); E.xs = (GAS float*)(F.ws + WS_XS); E.resid = 1;
            if (t == 6) { g.A = (const GAS bf16*)(F.ws + WS_MERGED); g.Bt = (const GAS bf16*)(wl + W_OUT); g.K = DM;  E.gain = INP(F, I_NMPOST) + l * DM; E.cnt = (GAS unsigned*)(F.ctl + CW_PANEL) + (size_t)(l * 2 + 0) * 2 * 128 * 64; }
            else        { g.A = (const GAS bf16*)(F.ws + WS_L);      g.Bt = (const GAS bf16*)(wl + W_DN);  g.K = DFF; E.gain = INP(F, I_NFPOST) + l * DM; if (l + 1 == DEPTH) E.resid = 2; E.cnt = (GAS unsigned*)(F.ctl + CW_PANEL) + (size_t)(l * 2 + 1) * 2 * 128 * 64; }
            g.A = launder_p(g.A); g.Bt = launder_p(g.Bt); g.K = launder_u(g.K); E.gain = launder_p(E.gain); E.cnt = launder_p(E.cnt); E.resid = launder_u(E.resid);
            E.xb = launder_p(E.xb); E.outf = launder_p(E.outf); E.rsw = launder_p(E.rsw); E.xs = launder_p(E.xs);
            pg8::StaticOrder S; S.init(M, g.N, F.G, (int)blockIdx.x);
            pg8::gemm_phase<pg8::EpiResid, pg8::StaticOrder, true, true>(F.lds, g, S, E);
        }
        else if (t == 0) p0_prologue(F);
#ifdef C1_EXP
        else if (t == 3) { phase_mixers(F, l); phase_scan_c1<0>(F, l); phase_scan_c1<C1_EXP>(F, l); }
#else
        else if (t == 3) { phase_mixers(F, l); phase_scan_c1<0>(F, l); }
#endif
#ifdef C2_EXP
        else if (t == 4) { phase_scan_c2<0>(F, l); phase_scan_c2<C2_EXP>(F, l); }
#else
        else if (t == 4) phase_scan_c2<0>(F, l);
#endif
        else if (t == 5) phase_rwkv_post(F, l);
        else if (t == 9) phase_ffn_conv(F, l);
      }
#ifdef REPEAT_T
        if (step + 1 < hi) GRID_BAR();
#else
        if (ph + 1 < hi) GRID_BAR();
#endif
    }
    asm volatile("s_waitcnt vmcnt(0) lgkmcnt(0)" ::: "memory");
}


#ifdef DBG_CHECK
__global__ void dbg_check(const void* buf, size_t n, int kind, int code, unsigned* flag) {
    bool bad = false;
    for (size_t i = (size_t)blockIdx.x * blockDim.x + threadIdx.x; i < n; i += (size_t)gridDim.x * blockDim.x) {
        float v;
        if (kind == 0) v = bf2f(((const unsigned short*)buf)[i]);
        else if (kind == 1) v = ((const float*)buf)[i];
        else v = (float)((const _Float16*)buf)[i];
        if (!(fabsf(v) < 1e30f)) bad = true;
    }
    if (bad) atomicMax(flag, (unsigned)(1000000 - code));
}
__global__ void dbg_report(float* out, const unsigned* flag) { if (threadIdx.x == 0 && blockIdx.x == 0) { const unsigned f = *flag; if (f) out[0] = 100000.f * (float)(10 + 1000000 - (int)f); } }
#endif
extern "C" void kernel_launch(void* const* d_in, const int* in_sizes, int n_in, void* d_out, int out_size, void* d_ws, size_t ws_size, hipStream_t stream) {
    static int grid = 0;
    if (grid == 0) {
        if (n_in != 26 || in_sizes[0] != M * DM || out_size != M * DM || ws_size < WS_END) { fprintf(stderr, "kernel_launch: unexpected shapes: n_in %d in0 %d out %d ws %zu (need >= %zu)\n", n_in, n_in > 0 ? in_sizes[0] : -1, out_size, ws_size, (size_t)WS_END); grid = -1; return; }
        int dev = 0, cus = 0, per_cu = 0;
        if (hipGetDevice(&dev) != hipSuccess || hipDeviceGetAttribute(&cus, hipDeviceAttributeMultiprocessorCount, dev) != hipSuccess) { grid = -1; return; }
        if (hipFuncSetAttribute((const void*)enc_fwd, hipFuncAttributeMaxDynamicSharedMemorySize, LDS_BYTES) != hipSuccess) { fprintf(stderr, "kernel_launch: hipFuncSetAttribute failed\n"); grid = -1; return; }
        if (hipOccupancyMaxActiveBlocksPerMultiprocessor(&per_cu, (const void*)enc_fwd, NTHREADS, LDS_BYTES) != hipSuccess || per_cu < 1) { fprintf(stderr, "kernel_launch: occupancy query says %d blocks per CU\n", per_cu); }
        (void)hipGetLastError();
        grid = cus;
        if (grid != 256) fprintf(stderr, "kernel_launch: %d CUs (built for 256)\n", grid);
    }
    if (grid < 0) return;
    (void)hipMemsetAsync((char*)d_ws + WS_CTL, 0, CTL_ZERO_BYTES, stream);
    Args a{};
    for (int i = 0; i < 26; ++i) a.in[i] = (const float*)d_in[i];
    a.out = (float*)d_out; a.ws = (unsigned char*)d_ws;
#if MK_N_LAUNCHES == 1
#ifdef REPEAT_T
    a.ph_lo = 0; a.ph_hi = NPH + (REPEAT_T == 7 ? 1 : 2);
#else
    a.ph_lo = 0; a.ph_hi = NPH;
#endif
    hipLaunchKernelGGL(enc_fwd, dim3(grid), dim3(NTHREADS), LDS_BYTES, stream, a);
#else
    for (int p = 0; p < NPH; ++p) { a.ph_lo = p; a.ph_hi = p + 1; hipLaunchKernelGGL(enc_fwd, dim3(grid), dim3(NTHREADS), LDS_BYTES, stream, a);
#ifdef DBG_CHECK
        unsigned* flag = (unsigned*)((char*)d_ws + 512 * 1024); char* ws = (char*)d_ws; const int t = p == 0 ? 0 : 1 + (p - 1) % 10;
#define CHK(ptr, n, kind, sub) hipLaunchKernelGGL(dbg_check, dim3(2048), dim3(256), 0, stream, (const void*)(ptr), (size_t)(n), kind, p * 4 + sub, flag)
        if (t == 0) { CHK(ws + WS_W, 2 * W_LAYER / 2, 0, 0); CHK(ws + WS_XB, (size_t)M * DM, 0, 1); CHK(ws + WS_RS, M, 1, 2); }
        if (t == 1) { CHK(ws + WS_PROJ, (size_t)M * NPROJP, 0, 0); }
        if (t == 2) { CHK(ws + WS_PREP, (size_t)64 * MiB, 2, 1); }
        if (t == 3) { CHK(d_out, (size_t)2 * M * 256, 0, 0); }
        if (t == 4) { CHK(ws + WS_MERGED, (size_t)M * DM, 0, 0); }
        if (t == 5 || t == 9) { CHK(ws + WS_Y, (size_t)M * DM, 1, 0); CHK(ws + WS_PART, (size_t)M * 16, 1, 1); }
        if (t == 6 || t == 10) { CHK(d_out, (size_t)M * DM, 1, 0); CHK(ws + WS_XB, (size_t)M * DM, 0, 1); CHK(ws + WS_RS, M, 1, 2); }
        if (t == 7) { CHK(ws + WS_G, (size_t)M * DFF, 0, 0); CHK(ws + WS_L, (size_t)M * DFF, 0, 1); }
        if (t == 8) { CHK(ws + WS_L, (size_t)M * DFF, 0, 0); }
        if (p == NPH - 1) hipLaunchKernelGGL(dbg_report, dim3(1), dim3(64), 0, stream, (float*)d_out, (const unsigned*)flag);
#endif
    }
#endif
}
```

```cpp
#include <hip/hip_runtime.h>
#include <cstdio>
#include <cstdint>
namespace pg8 {
#define PG8_LAS __attribute__((address_space(3)))
#define PG8_GAS __attribute__((address_space(1)))
typedef PG8_LAS unsigned char PG8_LAS_T;
typedef unsigned short bf16_t;
typedef short bf16x8 __attribute__((ext_vector_type(8)));
typedef float f32x4 __attribute__((ext_vector_type(4)));
typedef unsigned u32x4 __attribute__((ext_vector_type(4)));
constexpr int BM = 256, BK = 64, HALF = 128, HTB = HALF * BK * 2  , STAGE_BYTES = 8 * HTB, NXCD = 8, WGM = 4;

__host__ __device__ __forceinline__ int lds_byte(int r, int c) { const int st = (r >> 4) * 2 + (c >> 5), rr = r & 15, cc = c & 31, ob = rr * 64 + cc * 2; return st * 1024 + (ob ^ (((ob >> 9) & 1) << 5)); }
__host__ __device__ __forceinline__ void stage_rc(int b, int& R, int& C) { const int st = b / 1024, sb = b % 1024, swz = sb ^ (((sb >> 9) & 1) << 5); R = (st >> 1) * 16 + swz / 64; C = (st & 1) * 32 + (swz % 64) / 2; }
__host__ __device__ __forceinline__ int perm32(int rho) { const int n = rho >> 4, i = rho & 15; return 8 * (i >> 2) + 4 * n + (i & 3); }

struct Unit { int pm, pn; };
struct Gemm { const PG8_GAS bf16_t* A; const PG8_GAS bf16_t* Bt; int M, N, K; };

struct StaticOrder {
    int nM, nN, nwg, G, c;
    __host__ __device__ void init(int M, int N, int G_, int c_) { nM = M / BM; nN = N / BM; nwg = nM * nN; G = G_; c = c_; }
    __host__ __device__ bool next(int i, Unit& u) const {
        const long L = (long)i * G + c; if (L >= nwg) return false;
        int wgid = (int)L; { const int q = nwg / NXCD, r = nwg % NXCD, xcd = wgid % NXCD, off = wgid / NXCD; wgid = (xcd < r ? xcd * (q + 1) : r * (q + 1) + (xcd - r) * q) + off; }
        const int nig = WGM * nN, gid = wgid / nig, fm = gid * WGM, gsz = (nM - fm) < WGM ? (nM - fm) : WGM;
        u.pm = fm + ((wgid % nig) % gsz); u.pn = (wgid % nig) / gsz; return true;
    }
    __device__ __forceinline__ void a_ready(const Unit&) const {}
    __device__ __forceinline__ void done(const Unit&) const {}
};
typedef float f32x2c __attribute__((ext_vector_type(2)));
typedef __bf16 bf16x2c __attribute__((ext_vector_type(2)));
__device__ __forceinline__ unsigned cvt_pk_bf16(float lo, float hi) { const f32x2c v = {lo, hi}; return __builtin_bit_cast(unsigned, __builtin_convertvector(v, bf16x2c)); }
struct EpiUni {
    static constexpr bool AFTER_DRAIN = false;
    PG8_GAS bf16_t* O; int ldc; const PG8_GAS float* rs; int split_cols; size_t split_stride; PG8_GAS float* part;
    const PG8_GAS float* convw; PG8_GAS bf16_t* G; PG8_LAS unsigned char* xl;
    __device__ __forceinline__ bool perm() const { return true; }
    template <int CTRL> static __device__ __forceinline__ float dppo(float old, float x) { return __builtin_bit_cast(float, __builtin_amdgcn_update_dpp(__builtin_bit_cast(int, old), __builtin_bit_cast(int, x), CTRL, 0xF, 0xF, false)); }
    static __device__ __forceinline__ float gelu_t(float x) { const float u = 1.5957691216057308f * x * (1.f + 0.044715f * x * x); return x * __builtin_amdgcn_rcpf(1.f + __expf(-u)); }
    __device__ __forceinline__ void conv_epi(const f32x4 (&acc_)[2][2][4][2], const Unit& u, int wr, int wc, int fr, int fq) const {
        f32x4 (&acc)[2][2][4][2] = const_cast<f32x4 (&)[2][2][4][2]>(acc_);
        const int hcol = u.pn * HALF + wc * 32 + 8 * fq;
        const PG8_GAS float* rsp = rs + u.pm * BM + wr * 64 + fr;
        constexpr int LDH = 2816;
        const unsigned lane_off = (unsigned)((wr * 64 + fr) * LDH + hcol) * 2u;
        PG8_GAS char* Ob = (PG8_GAS char*)(O + (size_t)u.pm * BM * LDH); PG8_GAS char* Gb = (PG8_GAS char*)(G + (size_t)u.pm * BM * LDH);
        unsigned lp[2][4][2][2];
#pragma unroll
        for (int ai = 0; ai < 2; ++ai)
#pragma unroll
            for (int m = 0; m < 4; ++m) { const float r = rsp[ai * HALF + m * 16];
#pragma unroll
                for (int n = 0; n < 2; ++n) { const f32x4 l4 = acc[ai][1][m][n] * r; lp[ai][m][n][0] = cvt_pk_bf16(l4[0], l4[1]); lp[ai][m][n][1] = cvt_pk_bf16(l4[2], l4[3]); } }
#pragma unroll
        for (int ai = 0; ai < 2; ++ai) { const int k = 2 * ai + wr;
            if (fr == 0)  { const float r = rsp[ai * HALF]; PG8_LAS f32x4* p = (PG8_LAS f32x4*)(xl + ((k * 2 + 0) * 4 + wc) * 128 + fq * 32); p[0] = acc[ai][0][0][0] * r; p[1] = acc[ai][0][0][1] * r; }
            if (fr == 15) { const float r = rsp[ai * HALF + 48]; PG8_LAS f32x4* p = (PG8_LAS f32x4*)(xl + ((k * 2 + 1) * 4 + wc) * 128 + fq * 32); p[0] = acc[ai][0][3][0] * r; p[1] = acc[ai][0][3][1] * r; } }
        asm volatile("s_waitcnt lgkmcnt(0)" ::: "memory"); __builtin_amdgcn_s_barrier(); asm volatile("" ::: "memory");
#pragma unroll
        for (int ai = 0; ai < 2; ++ai) { const int k = 2 * ai + wr;
            float rsv[4];
#pragma unroll
            for (int m = 0; m < 4; ++m) { rsv[m] = rsp[ai * HALF + m * 16];
#pragma unroll
                for (int n = 0; n < 2; ++n) acc[ai][0][m][n] = acc[ai][0][m][n] * rsv[m]; }
            const int ku = k > 0 ? k - 1 : 0, kd = k < 3 ? k + 1 : 3;
#pragma unroll
            for (int n = 0; n < 2; ++n) {
                float w0[4], w1[4], w2[4];
#pragma unroll
                for (int j = 0; j < 4; ++j) { w0[j] = convw[hcol + 4 * n + j]; w1[j] = convw[LDH + hcol + 4 * n + j]; w2[j] = convw[2 * LDH + hcol + 4 * n + j]; }
                const f32x4 xt = *(const PG8_LAS f32x4*)(xl + ((ku * 2 + 1) * 4 + wc) * 128 + fq * 32 + n * 16), xb = *(const PG8_LAS f32x4*)(xl + ((kd * 2 + 0) * 4 + wc) * 128 + fq * 32 + n * 16);
#pragma unroll
                for (int m = 0; m < 4; ++m) { const int tr = 64 * k + 16 * m + fr; const unsigned coff = (unsigned)((ai * HALF + 16 * m) * LDH * 2 + 8 * n);
                    float hv[4];
#pragma unroll
                    for (int e = 0; e < 4; ++e) { const float cur = acc[ai][0][m][n][e];
                        const float upx = (m > 0) ? dppo<0x121>(0.f, acc[ai][0][m > 0 ? m - 1 : 0][n][e]) : xt[e];
                        const float dnx = (m < 3) ? dppo<0x12F>(0.f, acc[ai][0][m < 3 ? m + 1 : 3][n][e]) : xb[e];
                        const float up = dppo<0x111>(upx, cur), dn = dppo<0x101>(dnx, cur);
                        const float a = w0[e] * up + w1[e] * cur + w2[e] * dn;
                        const unsigned lw = lp[ai][m][n][e >> 1]; const float lv = (e & 1) ? __builtin_bit_cast(float, lw & 0xffff0000u) : __builtin_bit_cast(float, lw << 16);
                        hv[e] = (tr == 0 || tr == 255) ? lv : gelu_t(a) * lv; }
                    typedef unsigned u32x2_ __attribute__((ext_vector_type(2)));
                    u32x2_ w; w.x = cvt_pk_bf16(hv[0], hv[1]); w.y = cvt_pk_bf16(hv[2], hv[3]);
                    *(PG8_GAS u32x2_*)(Ob + coff + lane_off) = w;
                    if (tr <= 1 || tr >= 254) { u32x2_ gw; gw.x = cvt_pk_bf16(acc[ai][0][m][n][0], acc[ai][0][m][n][1]); gw.y = cvt_pk_bf16(acc[ai][0][m][n][2], acc[ai][0][m][n][3]);
                        *(PG8_GAS u32x2_*)(Gb + coff + lane_off) = gw; }
                    __builtin_amdgcn_sched_barrier(0); }
                asm volatile("" ::: "memory");
            }
        }
    }
    __device__ __forceinline__ void operator()(const f32x4 (&acc)[2][2][4][2], const Unit& u, int wr, int wc, int fr, int fq) const {
        if (convw != nullptr) { conv_epi(acc, u, wr, wc, fr, fq); return; }
        const int row0 = u.pm * BM + wr * 64 + fr; int colt = u.pn * BM; PG8_GAS bf16_t* base = O;
        if (split_cols) { const int t = colt / split_cols; base += (size_t)t * split_stride; colt -= t * split_cols; }
        const int col0 = colt + wc * 32 + 8 * fq;
        if (part == nullptr) {
#pragma unroll
            for (int ai = 0; ai < 2; ++ai)
#pragma unroll
                for (int m = 0; m < 4; ++m) { const int row = row0 + ai * HALF + m * 16; const float s = rs[row]; PG8_GAS bf16_t* rowp = base + (size_t)row * ldc + col0;
#pragma unroll
                    for (int bj = 0; bj < 2; ++bj) { const f32x4 v0 = acc[ai][bj][m][0] * s, v1 = acc[ai][bj][m][1] * s;
                        u32x4 w; w.x = cvt_pk_bf16(v0[0], v0[1]); w.y = cvt_pk_bf16(v0[2], v0[3]); w.z = cvt_pk_bf16(v1[0], v1[1]); w.w = cvt_pk_bf16(v1[2], v1[3]);
                        *(PG8_GAS u32x4*)(rowp + bj * HALF) = w; } }
        } else {
#pragma unroll
            for (int ai = 0; ai < 2; ++ai)
#pragma unroll
                for (int m = 0; m < 4; ++m) { const int row = row0 + ai * HALF + m * 16; PG8_GAS bf16_t* rowp = base + (size_t)row * ldc + col0; float ss = 0.f;
#pragma unroll
                    for (int bj = 0; bj < 2; ++bj) { const f32x4 v0 = acc[ai][bj][m][0], v1 = acc[ai][bj][m][1];
                        ss += ((v0[0] * v0[0] + v0[1] * v0[1]) + (v0[2] * v0[2] + v0[3] * v0[3])) + ((v1[0] * v1[0] + v1[1] * v1[1]) + (v1[2] * v1[2] + v1[3] * v1[3]));
                        u32x4 w; w.x = cvt_pk_bf16(v0[0], v0[1]); w.y = cvt_pk_bf16(v0[2], v0[3]); w.z = cvt_pk_bf16(v1[0], v1[1]); w.w = cvt_pk_bf16(v1[2], v1[3]);
                        *(PG8_GAS u32x4*)(rowp + bj * HALF) = w; }
                    ss += __shfl_xor(ss, 16); ss += __shfl_xor(ss, 32); if (fq == 0) part[(size_t)row * 16 + u.pn * 4 + wc] = ss; }
        }
    }
};
struct EpiResid {
    static constexpr bool AFTER_DRAIN = false;
    PG8_LAS unsigned char* xl;
    __device__ __forceinline__ bool perm() const { return true; }
    int resid; const PG8_GAS float* gain; PG8_GAS bf16_t* xb; PG8_GAS float* outf; PG8_GAS float* rsw; PG8_GAS float* xs; PG8_GAS unsigned* cnt;
    static __device__ __forceinline__ f32x4 unlo(unsigned a, unsigned b) { return (f32x4){__builtin_bit_cast(float, a << 16), __builtin_bit_cast(float, a & 0xffff0000u), __builtin_bit_cast(float, b << 16), __builtin_bit_cast(float, b & 0xffff0000u)}; }
    static __device__ __forceinline__ float hsum(const f32x4 v) { return (v[0] + v[1]) + (v[2] + v[3]); }
    __device__ __forceinline__ void resid_epi(const f32x4 (&acc_)[2][2][4][2], const Unit& u, int, int, int, int) const {
        f32x4 (&acc)[2][2][4][2] = const_cast<f32x4 (&)[2][2][4][2]>(acc_);
        int tid = threadIdx.x; asm volatile("" : "+v"(tid));
        const int wid = __builtin_amdgcn_readfirstlane(tid >> 6), wr = wid >> 2, wc = wid & 3, fr = tid & 15, fq = (tid >> 4) & 3;
        const int col0 = u.pn * BM + wc * 32 + 8 * fq;
        const unsigned lane_e = (unsigned)((wr * 64 + fr) * 1024 + col0);
        PG8_GAS char* xbb = (PG8_GAS char*)(xb + (size_t)u.pm * BM * 1024); PG8_GAS char* outb = (PG8_GAS char*)(outf + (size_t)u.pm * BM * 1024);
        PG8_LAS f32x4* P4 = (PG8_LAS f32x4*)xl; PG8_LAS float* S2 = (PG8_LAS float*)(xl + 16384);
        PG8_LAS float* GW = (PG8_LAS float*)(xl + 18432) + (wr * 4 + wc) * 64;
        { const int ln = fq * 16 + fr; GW[ln] = gain[u.pn * BM + (ln >> 5) * HALF + wc * 32 + (ln & 31)]; }
#pragma unroll
        for (int ai = 0; ai < 2; ++ai)
#pragma unroll
            for (int m = 0; m < 4; ++m) {
#pragma unroll
                for (int bj = 0; bj < 2; ++bj) { const f32x4 v0 = acc[ai][bj][m][0], v1 = acc[ai][bj][m][1];
                    u32x4 p; p.x = cvt_pk_bf16(v0[0], v0[1]); p.y = cvt_pk_bf16(v0[2], v0[3]); p.z = cvt_pk_bf16(v1[0], v1[1]); p.w = cvt_pk_bf16(v1[2], v1[3]);
                    acc[ai][bj][m][0] = __builtin_bit_cast(f32x4, p); }
                __builtin_amdgcn_sched_barrier(0); }
#define PG8_XLD(it_) do { unsigned le_ = lane_e; asm volatile("" : "+v"(le_)); _Pragma("unroll") for (int bj = 0; bj < 2; ++bj) \
            xq[(it_) % 3][bj] = *(const PG8_GAS u32x4*)(xbb + (size_t)((unsigned)(((((it_) >> 2) * HALF) + 16 * ((it_) & 3)) * 1024 + bj * HALF) + le_) * 2); } while (0)
        {   u32x4 xq[3][2];
            PG8_XLD(0); PG8_XLD(1);
#pragma unroll
            for (int it = 0; it < 8; ++it) { const int ai = it >> 2, m = it & 3;
                if (it + 2 < 8) PG8_XLD(it + 2);
                float sa = 0.f, sb = 0.f, sc = 0.f, sd = 0.f;
#pragma unroll
                for (int bj = 0; bj < 2; ++bj) { f32x4 py_ = acc[ai][bj][m][0]; asm volatile("" : "+v"(py_));
                    const u32x4 p = __builtin_bit_cast(u32x4, py_), xw = xq[it % 3][bj];
                    const f32x4 g0 = *(const PG8_LAS f32x4*)(GW + bj * 32 + 8 * fq), g1 = *(const PG8_LAS f32x4*)(GW + bj * 32 + 8 * fq + 4);
                    const f32x4 y0 = unlo(p.x, p.y), y1 = unlo(p.z, p.w), x0 = unlo(xw.x, xw.y), x1 = unlo(xw.z, xw.w), q0 = y0 * g0, q1 = y1 * g1;
                    sa += hsum(y0 * y0) + hsum(y1 * y1); sb += hsum(x0 * x0) + hsum(x1 * x1); sc += hsum(x0 * q0) + hsum(x1 * q1); sd += hsum(q0 * q0) + hsum(q1 * q1); }
                sa += __shfl_xor(sa, 16); sb += __shfl_xor(sb, 16); sc += __shfl_xor(sc, 16); sd += __shfl_xor(sd, 16);
                sa += __shfl_xor(sa, 32); sb += __shfl_xor(sb, 32); sc += __shfl_xor(sc, 32); sd += __shfl_xor(sd, 32);
                if (fq == 0) P4[(ai * HALF + wr * 64 + m * 16 + fr) * 4 + wc] = (f32x4){sa, sb, sc, sd};
                __builtin_amdgcn_sched_barrier(0); } }
        asm volatile("s_waitcnt lgkmcnt(0)" ::: "memory"); __builtin_amdgcn_s_barrier(); asm volatile("" ::: "memory");
        PG8_GAS float* slot = xs + (size_t)u.pm * BM * 16;
        PG8_GAS unsigned* c = cnt + u.pm * 64;
        if (tid < 256) { const f32x4 t4 = (P4[tid * 4 + 0] + P4[tid * 4 + 1]) + (P4[tid * 4 + 2] + P4[tid * 4 + 3]);
#pragma unroll
            for (int j = 0; j < 4; ++j) __hip_atomic_store(slot + tid * 16 + u.pn * 4 + j, t4[j], __ATOMIC_RELAXED, __HIP_MEMORY_SCOPE_AGENT);
            asm volatile("s_waitcnt vmcnt(0)" ::: "memory");
            if ((tid & 63) == 0) __hip_atomic_fetch_add(c, 1u, __ATOMIC_RELAXED, __HIP_MEMORY_SCOPE_AGENT); }
        if (tid < 64) { unsigned spins = 0;
            while ((unsigned)__builtin_amdgcn_readfirstlane(__hip_atomic_load(c, __ATOMIC_RELAXED, __HIP_MEMORY_SCOPE_AGENT)) < 16u) { __builtin_amdgcn_s_sleep(2); if (++spins > (1u << 22)) break; }
            __builtin_amdgcn_fence(__ATOMIC_ACQUIRE, "agent"); asm volatile("s_waitcnt vmcnt(0)" ::: "memory"); }
        asm volatile("s_waitcnt lgkmcnt(0)" ::: "memory"); __builtin_amdgcn_s_barrier(); asm volatile("" ::: "memory");
        if (tid < 256) { float t[4] = {0.f, 0.f, 0.f, 0.f};
#pragma unroll
            for (int q = 0; q < 4; ++q)
#pragma unroll
                for (int j = 0; j < 4; ++j) t[j] += __hip_atomic_load(slot + tid * 16 + q * 4 + j, __ATOMIC_RELAXED, __HIP_MEMORY_SCOPE_AGENT);
            const float ry = __builtin_amdgcn_rsqf(t[0] * (1.f / 1024.f) + 1e-6f);
            const float sx = t[1] + ry * (2.f * t[2] + ry * t[3]);
            const float rn = __builtin_amdgcn_rsqf(sx * (1.f / 1024.f) + 1e-6f);
            S2[tid * 2] = ry; S2[tid * 2 + 1] = rn;
            if (resid == 1 && u.pn == 0) rsw[(size_t)u.pm * BM + tid] = rn; }
        asm volatile("s_waitcnt lgkmcnt(0)" ::: "memory"); __builtin_amdgcn_s_barrier(); asm volatile("" ::: "memory");
        {   u32x4 xq[3][2];
            PG8_XLD(0); PG8_XLD(1);
#pragma unroll
            for (int it = 0; it < 8; ++it) { const int ai = it >> 2, m = it & 3;
                if (it + 2 < 8) PG8_XLD(it + 2);
                const float sc = S2[(ai * HALF + wr * 64 + m * 16 + fr) * 2];
                unsigned le = lane_e; asm volatile("" : "+v"(le));
#pragma unroll
                for (int bj = 0; bj < 2; ++bj) { const unsigned ce = (unsigned)((ai * HALF + 16 * m) * 1024 + bj * HALF);
                    f32x4 py_ = acc[ai][bj][m][0]; asm volatile("" : "+v"(py_));
                    const u32x4 p = __builtin_bit_cast(u32x4, py_), xw = xq[it % 3][bj];
                    const f32x4 g0 = *(const PG8_LAS f32x4*)(GW + bj * 32 + 8 * fq), g1 = *(const PG8_LAS f32x4*)(GW + bj * 32 + 8 * fq + 4);
                    const f32x4 v0 = unlo(xw.x, xw.y) + unlo(p.x, p.y) * sc * g0, v1 = unlo(xw.z, xw.w) + unlo(p.z, p.w) * sc * g1;
                    if (resid == 2) { PG8_GAS f32x4* op = (PG8_GAS f32x4*)(outb + (size_t)(ce + le) * 4); op[0] = v0; op[1] = v1; }
                    else { u32x4 w; w.x = cvt_pk_bf16(v0[0], v0[1]); w.y = cvt_pk_bf16(v0[2], v0[3]); w.z = cvt_pk_bf16(v1[0], v1[1]); w.w = cvt_pk_bf16(v1[2], v1[3]);
                        *(PG8_GAS u32x4*)(xbb + (size_t)(ce + le) * 2) = w; } }
                asm volatile("" ::: "memory"); __builtin_amdgcn_sched_barrier(0); } }
#undef PG8_XLD
    }
    __device__ __forceinline__ void operator()(const f32x4 (&acc)[2][2][4][2], const Unit& u, int wr, int wc, int fr, int fq) const { resid_epi(acc, u, wr, wc, fr, fq); }
};
template <class Epi, class Sched, bool ALIGN_EPI = false, bool SP2 = false>
__device__ __forceinline__ void gemm_phase(PG8_LAS unsigned char* lds, const Gemm g, const Sched& S, const Epi& E) {
    int tid_ = threadIdx.x; asm volatile("" : "+v"(tid_));
    const int tid = tid_, wid = __builtin_amdgcn_readfirstlane(tid >> 6), lane = tid & 63, wr = wid >> 2, wc = wid & 3, fr = lane & 15, fq = lane >> 4;
    const int K = g.K, nt = K / BK;
    unsigned voffA[2], voffB[2];
#pragma unroll
    for (int i = 0; i < 2; ++i) { int R, C; stage_rc(tid * 16 + i * 8192, R, C); const int Rb = E.perm() ? ((R & ~31) + perm32(R & 31)) : R;
        voffA[i] = (unsigned)(R * K + C) * 2u; voffB[i] = (unsigned)(Rb * K + C) * 2u; }
    const size_t kstep = (size_t)(BK * 2);
    const size_t hstep = (size_t)HALF * K * 2;
    const size_t tstep = 2 * hstep;
    const unsigned ldsw = (unsigned)wid * 1024u;
    const int aoff = lds_byte(wr * 64 + fr, fq * 8), boff = lds_byte(wc * 32 + fr, fq * 8);
#define PG8_SA(b, h) (((b) * 2 + (h)) * HTB)
#define PG8_SB(b, h) ((4 + (b) * 2 + (h)) * HTB)
#define PG8_STAGE(bufoff, gbase, voff) do { _Pragma("unroll") for (int _i = 0; _i < 2; ++_i) \
        __builtin_amdgcn_global_load_lds((const PG8_GAS unsigned*)((const PG8_GAS char*)(gbase) + (voff)[_i]), (PG8_LAS unsigned*)(lds + (bufoff) + ldsw + _i * 8192), 16, 0, 0); } while (0)
#define PG8_LDA(dst, b, h) do { _Pragma("unroll") for (int m = 0; m < 4; ++m) _Pragma("unroll") for (int k = 0; k < 2; ++k) dst[m][k] = *(const PG8_LAS bf16x8*)(lds + PG8_SA(b, h) + aoff + m * 2048 + k * 1024); } while (0)
#define PG8_LDB(dst, b, h) do { _Pragma("unroll") for (int n = 0; n < 2; ++n) _Pragma("unroll") for (int k = 0; k < 2; ++k) dst[n][k] = *(const PG8_LAS bf16x8*)(lds + PG8_SB(b, h) + boff + n * 2048 + k * 1024); } while (0)
#define PG8_MMA(ai, bj, At, Bt) do { __builtin_amdgcn_s_setprio(1); _Pragma("unroll") for (int m = 0; m < 4; ++m) _Pragma("unroll") for (int n = 0; n < 2; ++n) _Pragma("unroll") for (int k = 0; k < 2; ++k) \
        acc[ai][bj][m][n] = __builtin_amdgcn_mfma_f32_16x16x32_bf16(Bt[n][k], At[m][k], acc[ai][bj][m][n], 0, 0, 0); __builtin_amdgcn_s_setprio(0); } while (0)
#define PG8_WAIT_V(n) asm volatile("s_waitcnt vmcnt(" #n ")" ::: "memory")
#define PG8_WAIT_L(n) asm volatile("s_waitcnt lgkmcnt(" #n ")" ::: "memory")
#define PG8_BAR __builtin_amdgcn_s_barrier()
#define PG8_SCHED __builtin_amdgcn_sched_barrier(0)
    Unit cur, nxt; int ui = 0;
    if (!S.next(0, cur)) return;
    f32x4 acc[2][2][4][2];
#pragma unroll
    for (int a = 0; a < 2; ++a)
#pragma unroll
        for (int b = 0; b < 2; ++b)
#pragma unroll
            for (int m = 0; m < 4; ++m)
#pragma unroll
                for (int n = 0; n < 2; ++n) acc[a][b][m][n] = (f32x4){0.f, 0.f, 0.f, 0.f};
    bf16x8 At[4][2], B0[2][2], B1[2][2];
    const PG8_GAS char* cA = (const PG8_GAS char*)g.A + (size_t)cur.pm * tstep; const PG8_GAS char* cB = (const PG8_GAS char*)g.Bt + (size_t)cur.pn * tstep;
    S.a_ready(cur);
    if constexpr (SP2) {
        PG8_STAGE(PG8_SB(0, 0), cB, voffB); PG8_STAGE(PG8_SB(0, 1), cB + hstep, voffB); PG8_STAGE(PG8_SA(0, 0), cA, voffA); PG8_STAGE(PG8_SA(0, 1), cA + hstep, voffA);
        if (wr == 1) PG8_BAR;
        PG8_WAIT_V(2); PG8_BAR;
        PG8_STAGE(PG8_SB(1, 0), cB + kstep, voffB); PG8_STAGE(PG8_SA(1, 0), cA + kstep, voffA); PG8_STAGE(PG8_SB(1, 1), cB + hstep + kstep, voffB);
        PG8_WAIT_V(6); PG8_BAR;
    } else {
        PG8_STAGE(PG8_SB(0, 0), cB, voffB); PG8_STAGE(PG8_SA(0, 0), cA, voffA); PG8_STAGE(PG8_SB(0, 1), cB + hstep, voffB); PG8_STAGE(PG8_SA(0, 1), cA + hstep, voffA);
        if (wr == 1) PG8_BAR;
        PG8_WAIT_V(4); PG8_BAR;
        PG8_STAGE(PG8_SB(1, 0), cB + kstep, voffB); PG8_STAGE(PG8_SA(1, 0), cA + kstep, voffA); PG8_STAGE(PG8_SB(1, 1), cB + hstep + kstep, voffB);
        PG8_WAIT_V(6); PG8_BAR;
    }
    for (;;) {
        const bool has_next = S.next(ui + 1, nxt);
        const PG8_GAS char* nA = has_next ? (const PG8_GAS char*)g.A + (size_t)nxt.pm * tstep : cA; const PG8_GAS char* nB = has_next ? (const PG8_GAS char*)g.Bt + (size_t)nxt.pn * tstep : cB;
        for (int t = 0; t < nt; t += 2) {
            const bool last = (t == nt - 2);
            const PG8_GAS char* a1 = cA + (size_t)(t + 1) * kstep;
            const PG8_GAS char* a2 = last ? nA : cA + (size_t)(t + 2) * kstep; const PG8_GAS char* b2 = last ? nB : cB + (size_t)(t + 2) * kstep;
            const PG8_GAS char* a3 = a2 + kstep; const PG8_GAS char* b3 = b2 + kstep;
            if (last && has_next) S.a_ready(nxt);
            if constexpr (SP2) {
            PG8_LDB(B0, 0, 0); PG8_LDB(B1, 0, 1); PG8_SCHED; PG8_LDA(At, 0, 0); PG8_STAGE(PG8_SA(1, 1), a1 + hstep, voffA);
            PG8_WAIT_V(8); PG8_WAIT_L(0); PG8_BAR; PG8_MMA(0, 0, At, B0); PG8_MMA(0, 1, At, B1); PG8_BAR; PG8_SCHED;
            PG8_LDA(At, 0, 1); PG8_STAGE(PG8_SB(0, 0), b2, voffB); PG8_STAGE(PG8_SB(0, 1), b2 + hstep, voffB); PG8_STAGE(PG8_SA(0, 0), a2, voffA);
            PG8_WAIT_V(8); PG8_WAIT_L(0); PG8_BAR; PG8_MMA(1, 0, At, B0); PG8_MMA(1, 1, At, B1); PG8_BAR; PG8_SCHED;
            PG8_LDB(B0, 1, 0); PG8_LDB(B1, 1, 1); PG8_SCHED; PG8_LDA(At, 1, 0); PG8_STAGE(PG8_SA(0, 1), a2 + hstep, voffA);
            PG8_WAIT_V(8); PG8_WAIT_L(0); PG8_BAR; PG8_MMA(0, 0, At, B0); PG8_MMA(0, 1, At, B1); PG8_BAR; PG8_SCHED;
            PG8_LDA(At, 1, 1); PG8_STAGE(PG8_SB(1, 0), b3, voffB); PG8_STAGE(PG8_SB(1, 1), b3 + hstep, voffB); PG8_STAGE(PG8_SA(1, 0), a3, voffA);
            PG8_WAIT_V(8); PG8_WAIT_L(0); PG8_BAR; PG8_MMA(1, 0, At, B0); PG8_MMA(1, 1, At, B1); PG8_BAR; PG8_SCHED;
            } else {
            PG8_LDB(B0, 0, 0); PG8_SCHED; PG8_LDA(At, 0, 0); PG8_STAGE(PG8_SA(1, 1), a1 + hstep, voffA);
            PG8_WAIT_L(8); PG8_BAR; PG8_WAIT_L(0); PG8_MMA(0, 0, At, B0); PG8_BAR; PG8_SCHED;
            PG8_LDB(B1, 0, 1); PG8_STAGE(PG8_SB(0, 0), b2, voffB);
            PG8_BAR; PG8_WAIT_L(0); PG8_MMA(0, 1, At, B1); PG8_BAR;
            PG8_LDA(At, 0, 1); PG8_STAGE(PG8_SA(0, 0), a2, voffA);
            PG8_BAR; PG8_WAIT_L(0); PG8_MMA(1, 0, At, B0); PG8_BAR; PG8_SCHED;
            PG8_STAGE(PG8_SB(0, 1), b2 + hstep, voffB);
            PG8_WAIT_V(6); PG8_BAR; PG8_MMA(1, 1, At, B1); PG8_BAR;
            PG8_LDB(B0, 1, 0); PG8_SCHED; PG8_LDA(At, 1, 0); PG8_STAGE(PG8_SA(0, 1), a2 + hstep, voffA);
            PG8_WAIT_L(8); PG8_BAR; PG8_WAIT_L(0); PG8_MMA(0, 0, At, B0); PG8_BAR; PG8_SCHED;
            PG8_LDB(B1, 1, 1); PG8_STAGE(PG8_SB(1, 0), b3, voffB);
            PG8_BAR; PG8_WAIT_L(0); PG8_MMA(0, 1, At, B1); PG8_BAR;
            PG8_LDA(At, 1, 1); PG8_STAGE(PG8_SA(1, 0), a3, voffA);
            PG8_BAR; PG8_WAIT_L(0); PG8_MMA(1, 0, At, B0); PG8_BAR; PG8_SCHED;
            PG8_STAGE(PG8_SB(1, 1), b3 + hstep, voffB);
            PG8_WAIT_V(6); PG8_BAR; PG8_MMA(1, 1, At, B1); PG8_BAR;
            }
        }
        if constexpr (ALIGN_EPI) { if (wr == 0) PG8_BAR; }
        if constexpr (!Epi::AFTER_DRAIN) { E(acc, cur, wr, wc, fr, fq); S.done(cur); }
        if (!has_next) break;
#pragma unroll
        for (int a = 0; a < 2; ++a)
#pragma unroll
            for (int b = 0; b < 2; ++b)
#pragma unroll
                for (int m = 0; m < 4; ++m)
#pragma unroll
                    for (int n = 0; n < 2; ++n) acc[a][b][m][n] = (f32x4){0.f, 0.f, 0.f, 0.f};
        cur = nxt; cA = nA; cB = nB; ++ui;
        if constexpr (ALIGN_EPI) { if (wr == 1) PG8_BAR; }
    }
    PG8_WAIT_V(0);
    if constexpr (!ALIGN_EPI) { if (wr == 0) PG8_BAR; }
    PG8_BAR;
    if constexpr (Epi::AFTER_DRAIN) { E.fused(acc, cur, wr, wc, fr, fq, lds, wid, lane); S.done(cur); }
#undef PG8_SA
#undef PG8_SB
#undef PG8_STAGE
#undef PG8_LDA
#undef PG8_LDB
#undef PG8_MMA
#undef PG8_WAIT_V
#undef PG8_WAIT_L
#undef PG8_BAR
#undef PG8_SCHED
}
}

constexpr int NB = 8, T = 4096, DM = 1024, M = NB * T, DEPTH = 2;
constexpr int NPROJ = 2912, NPROJP = 3072, DFF = 2816, NUP = 2 * DFF;
constexpr int C_CH = 0, C_CB = 256, C_CC = 512, C_R = 768, C_K = 1024, C_V = 1280, C_DEC = 1536, C_GDN = 1600, C_NQ = 1632, C_NK = 1888, C_NV = 2144, C_SU = 2400, C_SV = 2656;
constexpr float NORM_EPS = 1e-6f, GN_EPS = 64e-5f, DECAY_SCALE = 0.60653065971263342f;
constexpr int NWAVES = 8, NTHREADS = 512;
constexpr size_t MiB = 1u << 20;
constexpr size_t WS_CTL = 0, CTL_ZERO_BYTES = 1 * MiB;
constexpr size_t WS_RS = 1 * MiB;
constexpr size_t WS_PART = 1 * MiB + 256 * 1024;
constexpr size_t WS_W = 4 * MiB, W_LAYER = 24 * MiB + 512 * 1024;
constexpr size_t W_IN = 0, W_OUT = 6 * MiB, W_UP = 8 * MiB, W_DN = 19 * MiB;
constexpr size_t WS_XB = 53 * MiB;
constexpr size_t WS_R = 117 * MiB;
constexpr size_t WS_PROJ = WS_R, WS_MERGED = WS_R + 192 * MiB, WS_PREP = WS_R + 256 * MiB;
constexpr size_t GT_CHUNK = 12800, GT_DIR = (size_t)NB * 4 * 256 * GT_CHUNK;
constexpr size_t WS_GT0 = WS_PREP, WS_YSC0 = WS_PREP + 100 * MiB;
static_assert(GT_DIR == 100 * MiB, "GT size");
constexpr size_t WS_Y = WS_R;
constexpr size_t WS_G = WS_R, WS_L = WS_R + 176 * MiB;
constexpr size_t WS_END = 501 * MiB;
static_assert(WS_W + 2 * W_LAYER <= WS_XB && WS_PREP + 128 * MiB <= WS_END && WS_L + 176 * MiB <= WS_END && WS_PART + (size_t)M * 64 <= WS_W, "ws map");
constexpr int CW_BAR = 4096;
constexpr int CW_PANEL = 16384;
constexpr size_t WS_XS = WS_PART;
constexpr int RING_BYTES = 131072, LDSCTL_OFF = RING_BYTES, MISC_OFF = LDSCTL_OFF + 320, LDS_BYTES = 152576;

#define GAS __attribute__((address_space(1)))
#define LAS __attribute__((address_space(3)))
typedef unsigned short bf16;
typedef unsigned v4u __attribute__((ext_vector_type(4)));
typedef unsigned v2u __attribute__((ext_vector_type(2)));
typedef float f32x4 __attribute__((ext_vector_type(4)));
typedef short bf16x8 __attribute__((ext_vector_type(8)));
typedef short s16x4 __attribute__((ext_vector_type(4)));
typedef _Float16 h2 __attribute__((ext_vector_type(2)));
typedef GAS unsigned gu32;
#define RLX_AGENT __ATOMIC_RELAXED, __HIP_MEMORY_SCOPE_AGENT
__device__ __forceinline__ unsigned pk2(float lo, float hi) { return pg8::cvt_pk_bf16(lo, hi); }
__device__ __forceinline__ unsigned f2bf(float f) { return (unsigned)__builtin_bit_cast(unsigned short, (__bf16)f); }
__device__ __forceinline__ float bflo(unsigned w) { return __builtin_bit_cast(float, w << 16); }
__device__ __forceinline__ float bfhi(unsigned w) { return __builtin_bit_cast(float, w & 0xffff0000u); }
__device__ __forceinline__ float bf2f(unsigned short b) { return __builtin_bit_cast(float, (unsigned)b << 16); }
__device__ __forceinline__ h2 as_h2(unsigned u) { return __builtin_bit_cast(h2, u); }
template <int CTRL> __device__ __forceinline__ float dppmov(float x) { return __builtin_bit_cast(float, __builtin_amdgcn_update_dpp(0, __builtin_bit_cast(int, x), CTRL, 0xF, 0xF, true)); }
__device__ __forceinline__ float row16_sum(float x) { x += dppmov<0xB1>(x); x += dppmov<0x4E>(x); x += dppmov<0x141>(x); x += dppmov<0x140>(x); return x; }
typedef unsigned u32x2_t __attribute__((ext_vector_type(2)));
__device__ __forceinline__ float xor16_sum(float x) { const u32x2_t r = __builtin_amdgcn_permlane16_swap(__builtin_bit_cast(unsigned, x), __builtin_bit_cast(unsigned, x), false, false);
    const unsigned a = r.x, b = r.y; return __builtin_bit_cast(float, a) + __builtin_bit_cast(float, b); }
__device__ __forceinline__ float xor32_sum(float x) { const u32x2_t r = __builtin_amdgcn_permlane32_swap(__builtin_bit_cast(unsigned, x), __builtin_bit_cast(unsigned, x), false, false);
    const unsigned a = r.x, b = r.y; return __builtin_bit_cast(float, a) + __builtin_bit_cast(float, b); }
__device__ __forceinline__ float wave_sum(float v) { return xor32_sum(xor16_sum(row16_sum(v))); }
__device__ __forceinline__ float row16_max(float x) { x = fmaxf(x, dppmov<0xB1>(x)); x = fmaxf(x, dppmov<0x4E>(x)); x = fmaxf(x, dppmov<0x141>(x)); x = fmaxf(x, dppmov<0x140>(x)); return x; }
__device__ __forceinline__ float rcpf_(float x) { return __builtin_amdgcn_rcpf(x); }
__device__ __forceinline__ float rsqf_(float x) { return __builtin_amdgcn_rsqf(x); }
__device__ __forceinline__ float sigmoidf_(float x) { return rcpf_(1.f + __expf(-x)); }
__device__ __forceinline__ float tanhf_(float x) { return 1.f - 2.f * rcpf_(__expf(2.f * x) + 1.f); }
__device__ __forceinline__ float gelu_tanh(float x) { const float u = 1.5957691216057308f * x * (1.f + 0.044715f * x * x); return x * rcpf_(1.f + __expf(-u)); }
#define XB_TMO      128
#define XB_XCNT(j)  (256  + 64 * (j))
#define XB_XSUB(j)  (1280 + 64 * (j))
#define XB_XGEN(j)  (2304 + 64 * (j))
#define XB_TOP      3328
#define XB_TOPGEN   3392
#define XCD_BAR_WORDS 3456
#define XB_SPIN_CAP (1u << 18)

__device__ __forceinline__ unsigned xb_ld(unsigned* p)              { return __hip_atomic_load(p, __ATOMIC_RELAXED, __HIP_MEMORY_SCOPE_AGENT); }
__device__ __forceinline__ unsigned xb_add(unsigned* p, unsigned v) { return __hip_atomic_fetch_add(p, v, __ATOMIC_RELAXED, __HIP_MEMORY_SCOPE_AGENT); }
__device__ __forceinline__ unsigned xb_xcc_id() { return (unsigned)__builtin_amdgcn_s_getreg((3 << 11) | 20) & 0xFu; }
#define XB_SPIN(cond, bar) do { unsigned _sp = 0; while (cond) { __builtin_amdgcn_s_sleep(1); \
    if ((++_sp & 255u) == 0u) { if (xb_ld(&(bar)[XB_TMO])) break; if (_sp > XB_SPIN_CAP) { atomicAdd(&(bar)[XB_TMO], 1u); break; } } } } while (0)

struct XcdBarrier {
    unsigned* bar; unsigned x;
    volatile LAS unsigned* st;
};

__device__ __forceinline__ XcdBarrier xcd_barrier_post(unsigned* bar, volatile LAS unsigned* st) {
    XcdBarrier b; b.bar = bar; b.x = xb_xcc_id(); b.st = st;
    if (threadIdx.x == 0) (void)xb_add(&bar[XB_XCNT(b.x)], 1u);
    return b;
}
__device__ __forceinline__ void xcd_barrier_complete(unsigned* bar, unsigned x, unsigned& nloc, unsigned& nx) {
    const unsigned G = gridDim.x * gridDim.y * gridDim.z;
    unsigned sum, cnt, mine, sp = 0u;
    for (;;) {
        sum = 0u; cnt = 0u; mine = 0u;
#pragma unroll
        for (unsigned j = 0; j < 16; ++j) { const unsigned c = xb_ld(&bar[XB_XCNT(j)]); sum += c; cnt += (c > 0u) ? 1u : 0u; mine = (j == x) ? c : mine; }
        if (sum == G) break;
        __builtin_amdgcn_s_sleep(1);
        if ((++sp & 255u) == 0u) { if (xb_ld(&bar[XB_TMO])) break; if (sp > XB_SPIN_CAP) { atomicAdd(&bar[XB_TMO], 1u); break; } }
    }
    nloc = mine > 0u ? mine : 1u; nx = cnt > 0u ? cnt : 1u;
}

__device__ __forceinline__ void xcd_barrier(const XcdBarrier& b) {
    asm volatile("s_waitcnt vmcnt(0)" ::: "memory");
    __syncthreads();
    if (threadIdx.x == 0) {
        unsigned* bar = b.bar;
        __builtin_amdgcn_s_waitcnt(0);
        unsigned nloc = b.st[0], nx = b.st[1];
        if (nloc == 0u) { xcd_barrier_complete(bar, b.x, nloc, nx); b.st[0] = nloc; b.st[1] = nx; }
        const unsigned old = xb_add(&bar[XB_XSUB(b.x)], 1u);
        const unsigned gen = old / nloc;
        if (old + 1u == (gen + 1u) * nloc) {
            __builtin_amdgcn_fence(__ATOMIC_RELEASE, "agent");
            asm volatile("s_waitcnt vmcnt(0)" ::: "memory");
            (void)xb_add(&bar[XB_TOP], 1u);
            XB_SPIN(xb_ld(&bar[XB_TOP]) < (gen + 1u) * nx, bar);
            __builtin_amdgcn_fence(__ATOMIC_ACQUIRE, "agent");
            asm volatile("s_waitcnt vmcnt(0)" ::: "memory");
        } else {
            XB_SPIN(xb_ld(&bar[XB_TOP]) < (gen + 1u) * nx, bar);
            __builtin_amdgcn_fence(__ATOMIC_ACQUIRE, "agent");
            asm volatile("s_waitcnt vmcnt(0)" ::: "memory");
        }
    }
    __syncthreads();
}

typedef __attribute__((address_space(4))) const unsigned long long kq_t;
struct Frame {
    LAS unsigned char* lds;
    volatile LAS unsigned* MISC;
    gu32* ctl;
    int tid, lane, wave, vcu, G;
    kq_t* karg; GAS float* out; GAS unsigned char* ws;
};
#define INP(F, i) ((const GAS float*)(F).karg[(i)])
enum { I_X = 0, I_NMPRE, I_NMPOST, I_NFPRE, I_NFPOST, I_WIN, I_CONVW, I_RW0, I_RWUP, I_RA0, I_RAUP, I_RGUP, I_RKK, I_RKA, I_RRK, I_LNXW, I_LNXB, I_RPB, I_SGUN, I_SGUW, I_SGUB, I_MGAIN, I_WOUT, I_WUP, I_FCONV, I_WDN };
__device__ __forceinline__ int launder_u(int x) { asm volatile("" : "+v"(x)); return __builtin_amdgcn_readfirstlane(x); }
template <class P> __device__ __forceinline__ P launder_p(P p) { unsigned long long v = (unsigned long long)p; unsigned lo = (unsigned)v, hi = (unsigned)(v >> 32); asm volatile("" : "+v"(lo), "+v"(hi));
    lo = __builtin_amdgcn_readfirstlane(lo); hi = __builtin_amdgcn_readfirstlane(hi); return (P)(((unsigned long long)hi << 32) | lo); }
#define LAUNDER(F) do { asm volatile("" : "+v"((F).tid)); asm volatile("" : "+v"((F).lane)); (F).wave = launder_u((F).wave); (F).vcu = launder_u((F).vcu); (F).karg = launder_p((F).karg); (F).ws = launder_p((F).ws); (F).out = launder_p((F).out); } while (0)
#define LDS_WAIT() asm volatile("s_waitcnt lgkmcnt(0)" ::: "memory")
#define CFENCE() asm volatile("" ::: "memory")

__device__ __forceinline__ void p0_transpose_item(const GAS float* W, const GAS float* gain, int K, int N, GAS bf16* WT, LAS float* scr, int item, int lane, bool glmap = false) {
    const int nblk = N / 32, kb = item / nblk, nb = item % nblk, k0 = 64 * kb, n0 = 32 * nb;
    const int r0 = !glmap ? n0 : (n0 < N / 2 ? 256 * (n0 >> 7) + (n0 & 127) : 256 * ((n0 - N / 2) >> 7) + 128 + ((n0 - N / 2) & 127));
#pragma unroll 8
    for (int i = 0; i < 32; ++i) { const int kk = 2 * i + (lane >> 5); const float g = gain ? gain[k0 + kk] : 1.f; scr[kk * 33 + (lane & 31)] = W[(size_t)(k0 + kk) * N + n0 + (lane & 31)] * g; }
    LDS_WAIT(); CFENCE();
    const int c = lane & 7;
#pragma unroll
    for (int j = 0; j < 4; ++j) { const int n = (lane >> 3) + 8 * j; const LAS float* s = scr + (8 * c) * 33 + n;
        v4u o; o.x = pk2(s[0 * 33], s[1 * 33]); o.y = pk2(s[2 * 33], s[3 * 33]); o.z = pk2(s[4 * 33], s[5 * 33]); o.w = pk2(s[6 * 33], s[7 * 33]);
        *(GAS v4u*)(WT + (size_t)(r0 + n) * K + k0 + 8 * c) = o; }
    LDS_WAIT(); CFENCE();
}
__device__ __forceinline__ void row_to_bf16_rs(const GAS float* xrow, GAS bf16* orow, GAS float* rs, int lane) {
    const GAS f32x4* xr = (const GAS f32x4*)xrow + lane;
    f32x4 v[4]; float s = 0.f;
#pragma unroll
    for (int j = 0; j < 4; ++j) { v[j] = xr[64 * j]; s += (v[j].x * v[j].x + v[j].y * v[j].y) + (v[j].z * v[j].z + v[j].w * v[j].w); }
    s = wave_sum(s);
    GAS v2u* o8 = (GAS v2u*)orow + lane;
#pragma unroll
    for (int j = 0; j < 4; ++j) { v2u o; o.x = pk2(v[j].x, v[j].y); o.y = pk2(v[j].z, v[j].w); o8[64 * j] = o; }
    if (lane == 0) *rs = rsqf_(s * (1.f / DM) + NORM_EPS);
}
__device__ __forceinline__ void p0_prologue(Frame& F) {
    LAUNDER(F);
    LAS float* scr = (LAS float*)(F.lds + F.wave * 16384);
    const int gw = F.vcu * NWAVES + F.wave, NGW = F.G * NWAVES;
    constexpr int I_IN = (DM / 64) * (NPROJ / 32), I_OUT = (DM / 64) * (DM / 32), I_UP = (DM / 64) * (NUP / 32), I_DN = (DFF / 64) * (DM / 32), I_L = I_IN + I_OUT + I_UP + I_DN;
    for (int it = gw; it < DEPTH * I_L; it += NGW) {
        const int l = it / I_L; int r = it % I_L; GAS unsigned char* wl = F.ws + WS_W + (size_t)l * W_LAYER;
        if (r < I_IN) { p0_transpose_item(INP(F, I_WIN) + (size_t)l * DM * NPROJ, INP(F, I_NMPRE) + l * DM, DM, NPROJ, (GAS bf16*)(wl + W_IN), scr, r, F.lane); continue; } r -= I_IN;
        if (r < I_OUT) { p0_transpose_item(INP(F, I_WOUT) + (size_t)l * DM * DM, INP(F, I_MGAIN) + l * DM, DM, DM, (GAS bf16*)(wl + W_OUT), scr, r, F.lane); continue; } r -= I_OUT;
        if (r < I_UP) { p0_transpose_item(INP(F, I_WUP) + (size_t)l * DM * NUP, INP(F, I_NFPRE) + l * DM, DM, NUP, (GAS bf16*)(wl + W_UP), scr, r, F.lane, true); continue; } r -= I_UP;
        p0_transpose_item(INP(F, I_WDN) + (size_t)l * DFF * DM, nullptr, DFF, DM, (GAS bf16*)(wl + W_DN), scr, r, F.lane);
    }
    unsigned zz = 0u; asm volatile("" : "+v"(zz));
    for (int i = F.vcu * NTHREADS + F.tid; i < DEPTH * 20480; i += F.G * NTHREADS) { const int l = i / 20480, r = i % 20480;
        *(GAS v4u*)(F.ws + WS_W + (size_t)l * W_LAYER + W_IN + (size_t)NPROJ * DM * 2 + (size_t)r * 16) = (v4u){zz, zz, zz, zz}; }
    for (int m = gw; m < M; m += NGW) row_to_bf16_rs(INP(F, I_X) + (size_t)m * DM, (GAS bf16*)(F.ws + WS_XB) + (size_t)m * DM, (GAS float*)(F.ws + WS_RS) + m, F.lane);
}

typedef float f32x16 __attribute__((ext_vector_type(16)));
__device__ __forceinline__ void mix_convprep_tile(Frame& F, int l, int tile) {
    LAUNDER(F);
    const GAS bf16* proj = (const GAS bf16*)(F.ws + WS_PROJ); GAS bf16* merged = (GAS bf16*)(F.ws + WS_MERGED);
    const int m0 = tile * 64, bb = m0 / T, t0 = m0 % T;
    const int lane = F.lane, w = F.wave;
    {
        const int c4 = 4 * lane; const GAS float* cw = INP(F, I_CONVW) + l * 768;
        const f32x4 w0 = *(const f32x4*)(cw + c4), w1 = *(const f32x4*)(cw + 256 + c4), w2 = *(const f32x4*)(cw + 512 + c4);
        const int ts = t0 + 8 * w;
        v2u hr[10], cr[10], br[8];
#pragma unroll
        for (int j = 0; j < 10; ++j) { const int t = ts - 1 + j; const bool ok = (t >= 0 && t < T); const GAS bf16* row = proj + (size_t)(bb * T + (ok ? t : ts)) * NPROJP;
            hr[j] = *(const GAS v2u*)(row + C_CH + c4); cr[j] = *(const GAS v2u*)(row + C_CC + c4); if (!ok) { hr[j] = (v2u){0u, 0u}; } }
#pragma unroll
        for (int j = 0; j < 8; ++j) { const GAS bf16* row = proj + (size_t)(bb * T + ts + j) * NPROJP; br[j] = *(const GAS v2u*)(row + C_CB + c4); }
#pragma unroll
        for (int i = 0; i < 8; ++i) { const int t = ts + i;
            f32x4 z[3];
#pragma unroll
            for (int q = 0; q < 3; ++q) { const v2u h = hr[i + q], c = cr[i + q]; z[q] = (f32x4){bflo(h.x) * bflo(c.x), bfhi(h.x) * bfhi(c.x), bflo(h.y) * bflo(c.y), bfhi(h.y) * bfhi(c.y)}; }
            const v2u b = br[i];
            const f32x4 bv = (f32x4){bflo(b.x), bfhi(b.x), bflo(b.y), bfhi(b.y)};
            const f32x4 y = bv * (w0 * z[0] + w1 * z[1] + w2 * z[2]);
            float ss = (y.x * y.x + y.y * y.y) + (y.z * y.z + y.w * y.w); ss = wave_sum(ss);
            const float sc = rsqf_(ss * (1.f / 256.f) + NORM_EPS);
            v2u o; o.x = pk2(y.x * sc, y.y * sc); o.y = pk2(y.z * sc, y.w * sc);
            *(GAS v2u*)(merged + (size_t)(bb * T + t) * DM + 0 + c4) = o;
}
    }
}

__device__ __forceinline__ void mix_na_item(Frame& F, int l, int item, LAS unsigned char* wl, const LAS float* RPB) {
    LAUNDER(F);
    const GAS bf16* proj = (const GAS bf16*)(F.ws + WS_PROJ); GAS bf16* merged = (GAS bf16*)(F.ws + WS_MERGED);
    const int lane = F.lane, i = lane & 15, g = lane >> 4;
    const int qg = item & 3, r = (item >> 2) & 63, bb = item >> 8;
    const int c0 = 16 * qg;
    int rs = r - 4; rs = rs < 0 ? 0 : (rs > 56 ? 56 : rs);
    int cs = c0 - 8; cs = cs < 0 ? 0 : (cs > 32 ? 32 : cs);
    LAS unsigned char* PL = wl; LAS unsigned char* VL = wl + 4096; LAS unsigned char* OL = wl + 8192;
    const size_t rowbase = (size_t)bb * T;
    float ssq[4] = {0.f, 0.f, 0.f, 0.f};
#pragma unroll 1
    for (int h = 0; h < 4; ++h) {
        bf16x8 qf[2];
        { const GAS bf16* qrow = proj + (rowbase + r * 64 + c0 + i) * NPROJP + C_NQ + h * 64 + 8 * g;
          qf[0] = *(const GAS bf16x8*)(qrow); qf[1] = *(const GAS bf16x8*)(qrow + 32); }
        f32x4 s[16];
#pragma unroll
        for (int kt = 0; kt < 16; ++kt) { const int kr = kt >> 1, hf = kt & 1;
            const GAS bf16* krow = proj + (rowbase + (rs + kr) * 64 + cs + 16 * hf + i) * NPROJP + C_NK + h * 64 + 8 * g;
            const bf16x8 k0 = *(const GAS bf16x8*)(krow), k1 = *(const GAS bf16x8*)(krow + 32);
            f32x4 a = (f32x4){0.f, 0.f, 0.f, 0.f};
            a = __builtin_amdgcn_mfma_f32_16x16x32_bf16(qf[0], k0, a, 0, 0, 0);
            a = __builtin_amdgcn_mfma_f32_16x16x32_bf16(qf[1], k1, a, 0, 0, 0);
            s[kt] = a; }
        const GAS bf16* vsrc = proj + (rowbase + rs * 64 + cs + (lane >> 3)) * NPROJP + C_NV + h * 64 + 8 * (lane & 7);
        v4u vreg[4][4];
#pragma unroll
        for (int k4 = 0; k4 < 4; ++k4)
#pragma unroll
            for (int q = 0; q < 4; ++q) vreg[k4][q] = *(const GAS v4u*)(vsrc + (size_t)(k4 * 64 + 8 * q) * NPROJP);
        float mx[4] = {-3e38f, -3e38f, -3e38f, -3e38f};
#pragma unroll
        for (int kt = 0; kt < 16; ++kt) { const int kr = kt >> 1, hf = kt & 1; const int cw = cs + 16 * hf + i; const int dy = rs + kr - r + 7;
#pragma unroll
            for (int e = 0; e < 4; ++e) { const int cq = c0 + 4 * g + e; int st = cq - 8; st = st < 0 ? 0 : (st > 48 ? 48 : st);
                int dx = cw - cq; dx = dx < -15 ? -15 : (dx > 15 ? 15 : dx); dx += 15;
                const bool valid = (cw >= st) && (cw < st + 16);
                float v = s[kt][e] * 0.125f + RPB[h * 465 + dy * 31 + dx];
                v = valid ? v : -1e30f; s[kt][e] = v; mx[e] = fmaxf(mx[e], v); } }
        float sm[4];
#pragma unroll
        for (int e = 0; e < 4; ++e) { mx[e] = row16_max(mx[e]); sm[e] = 0.f; }
#pragma unroll
        for (int kt = 0; kt < 16; ++kt)
#pragma unroll
            for (int e = 0; e < 4; ++e) { const float p = __expf(s[kt][e] - mx[e]); s[kt][e] = p; sm[e] += p; }
#pragma unroll
        for (int e = 0; e < 4; ++e) sm[e] = rcpf_(row16_sum(sm[e]));
        f32x4 oh[4];
#pragma unroll
        for (int dt = 0; dt < 4; ++dt) oh[dt] = (f32x4){0.f, 0.f, 0.f, 0.f};
#pragma unroll
        for (int half = 0; half < 2; ++half) {
            CFENCE();
#pragma unroll
            for (int k8 = 0; k8 < 8; ++k8) { const int kt = 8 * half + k8; v2u pw; pw.x = pk2(s[kt][0] * sm[0], s[kt][1] * sm[1]); pw.y = pk2(s[kt][2] * sm[2], s[kt][3] * sm[3]);
                *(LAS v2u*)(PL + (16 * k8 + i) * 32 + 8 * g) = pw; }
            CFENCE();
#pragma unroll
            for (int k4 = 0; k4 < 4; ++k4) { const int kr = 4 * half + k4;
                CFENCE();
#pragma unroll
                for (int q = 0; q < 4; ++q) *(LAS v4u*)(VL + ((lane >> 3) + 8 * q) * 128 + (lane & 7) * 16) = vreg[k4][q];
                if (half == 0) {
#pragma unroll
                    for (int q = 0; q < 4; ++q) vreg[k4][q] = *(const GAS v4u*)(vsrc + (size_t)((kr + 4) * 64 + 8 * q) * NPROJP); }
                CFENCE();
                const LAS unsigned char* pa = PL + (32 * k4 + 8 * g + (i >> 2)) * 32 + 8 * (i & 3);
                const s16x4 plo = __builtin_bit_cast(s16x4, __builtin_amdgcn_ds_read_tr16_b64_v4i16((LAS s16x4*)(pa)));
                const s16x4 phi = __builtin_bit_cast(s16x4, __builtin_amdgcn_ds_read_tr16_b64_v4i16((LAS s16x4*)(pa + 128)));
                const bf16x8 pf = (bf16x8){plo[0], plo[1], plo[2], plo[3], phi[0], phi[1], phi[2], phi[3]};
#pragma unroll
                for (int dt = 0; dt < 4; ++dt) {
                    const LAS unsigned char* va = VL + (8 * g + (i >> 2)) * 128 + (16 * dt + 4 * (i & 3)) * 2;
                    const s16x4 vlo = __builtin_bit_cast(s16x4, __builtin_amdgcn_ds_read_tr16_b64_v4i16((LAS s16x4*)(va)));
                    const s16x4 vhi = __builtin_bit_cast(s16x4, __builtin_amdgcn_ds_read_tr16_b64_v4i16((LAS s16x4*)(va + 512)));
                    const bf16x8 vf = (bf16x8){vlo[0], vlo[1], vlo[2], vlo[3], vhi[0], vhi[1], vhi[2], vhi[3]};
                    oh[dt] = __builtin_amdgcn_mfma_f32_16x16x32_bf16(pf, vf, oh[dt], 0, 0, 0); }
            }
        }
        CFENCE();
#pragma unroll
        for (int dt = 0; dt < 4; ++dt)
#pragma unroll
            for (int e = 0; e < 4; ++e) { ssq[e] += oh[dt][e] * oh[dt][e]; *(LAS unsigned short*)(OL + (4 * g + e) * 512 + (h * 64 + 16 * dt + i) * 2) = (unsigned short)f2bf(oh[dt][e]); }
        CFENCE();
    }
    LAS float* SCL = (LAS float*)VL;
    CFENCE();
#pragma unroll
    for (int e = 0; e < 4; ++e) { const float sc = rsqf_(row16_sum(ssq[e]) * (1.f / 256.f) + NORM_EPS); if (i == 0) SCL[4 * g + e] = sc; }
    CFENCE();
#pragma unroll
    for (int q = 0; q < 8; ++q) { const int e = lane + 64 * q, row = e >> 5, ch = e & 31;
        const v4u v = *(const LAS v4u*)(OL + row * 512 + ch * 16); const float sc = SCL[row];
        v4u o;
#pragma unroll
        for (int t = 0; t < 4; ++t) o[t] = pk2(bflo(v[t]) * sc, bfhi(v[t]) * sc);
        *(GAS v4u*)(merged + (rowbase + r * 64 + c0 + row) * DM + 512 + 8 * ch) = o; }
    CFENCE();
}

constexpr int SG_PITCH = 528;
__device__ __forceinline__ void mix_sgu_item(Frame& F, int l, int item) {
    LAUNDER(F);
    const GAS bf16* proj = (const GAS bf16*)(F.ws + WS_PROJ); GAS bf16* merged = (GAS bf16*)(F.ws + WS_MERGED);
    const int lane = F.lane, w = F.wave, tid = F.tid, i = lane & 15, g = lane >> 4;
    const size_t m0 = (size_t)item * 128;
    LAS unsigned char* VI = F.lds; LAS float* SS = (LAS float*)(F.lds + 128 * SG_PITCH);
    { const int c4 = 4 * lane; const f32x4 gn = *(const f32x4*)(INP(F, I_SGUN) + l * 256 + c4);
      v2u xr[16];
#pragma unroll
      for (int j = 0; j < 16; ++j) xr[j] = *(const GAS v2u*)(proj + (m0 + 16 * w + j) * NPROJP + C_SV + c4);
#pragma unroll
      for (int j = 0; j < 16; ++j) { const int q = 16 * w + j; const v2u x = xr[j];
          f32x4 v = (f32x4){gelu_tanh(bflo(x.x)), gelu_tanh(bfhi(x.x)), gelu_tanh(bflo(x.y)), gelu_tanh(bfhi(x.y))};
          const float mu = wave_sum((v.x + v.y) + (v.z + v.w)) * (1.f / 256.f);
          v = v - mu;
          const float var = wave_sum((v.x * v.x + v.y * v.y) + (v.z * v.z + v.w * v.w)) * (1.f / 256.f);
          const float rstd = rsqf_(var + NORM_EPS);
          v2u o; o.x = pk2(v.x * rstd * gn.x, v.y * rstd * gn.y); o.y = pk2(v.z * rstd * gn.z, v.w * rstd * gn.w);
          *(LAS v2u*)(VI + q * SG_PITCH + c4 * 2) = o; } }
    __syncthreads();
    const int hh = w >> 1, ph = w & 1;
    f32x4 acc[4][4];
#pragma unroll
    for (int a = 0; a < 4; ++a)
#pragma unroll
        for (int b = 0; b < 4; ++b) acc[a][b] = (f32x4){0.f, 0.f, 0.f, 0.f};
    const GAS float* ws_ = INP(F, I_SGUW) + ((size_t)(l * 4 + hh) * 128) * 128;
#pragma unroll
    for (int ks = 0; ks < 4; ++ks) {
        bf16x8 af[4], bfr[4];
#pragma unroll
        for (int pt = 0; pt < 4; ++pt) { const GAS float* ap = ws_ + (size_t)(64 * ph + 16 * pt + i) * 128 + 32 * ks + 8 * g;
            const f32x4 x0 = *(const f32x4*)ap, x1 = *(const f32x4*)(ap + 4);
            const unsigned u0 = pk2(x0.x, x0.y), u1 = pk2(x0.z, x0.w), u2 = pk2(x1.x, x1.y), u3 = pk2(x1.z, x1.w);
            af[pt] = __builtin_bit_cast(bf16x8, (v4u){u0, u1, u2, u3}); }
#pragma unroll
        for (int dt = 0; dt < 4; ++dt) { const LAS unsigned char* va = VI + (32 * ks + 8 * g + (i >> 2)) * SG_PITCH + (hh * 64 + 16 * dt + 4 * (i & 3)) * 2;
            const s16x4 lo = __builtin_bit_cast(s16x4, __builtin_amdgcn_ds_read_tr16_b64_v4i16((LAS s16x4*)(va)));
            const s16x4 hi = __builtin_bit_cast(s16x4, __builtin_amdgcn_ds_read_tr16_b64_v4i16((LAS s16x4*)(va + 4 * SG_PITCH)));
            bfr[dt] = (bf16x8){lo[0], lo[1], lo[2], lo[3], hi[0], hi[1], hi[2], hi[3]}; }
#pragma unroll
        for (int pt = 0; pt < 4; ++pt)
#pragma unroll
            for (int dt = 0; dt < 4; ++dt) acc[pt][dt] = __builtin_amdgcn_mfma_f32_16x16x32_bf16(af[pt], bfr[dt], acc[pt][dt], 0, 0, 0);
    }
#pragma unroll
    for (int pt = 0; pt < 4; ++pt) {
        unsigned short ur[4][4];
#pragma unroll
        for (int e = 0; e < 4; ++e)
#pragma unroll
            for (int dt = 0; dt < 4; ++dt) ur[e][dt] = proj[(m0 + 64 * ph + 16 * pt + 4 * g + e) * NPROJP + C_SU + hh * 64 + 16 * dt + i];
#pragma unroll
        for (int e = 0; e < 4; ++e) { const int p = 64 * ph + 16 * pt + 4 * g + e; const float bs = INP(F, I_SGUB)[(l * 4 + hh) * 128 + p]; float ss = 0.f;
#pragma unroll
            for (int dt = 0; dt < 4; ++dt) { const float u = gelu_tanh(bf2f(ur[e][dt]));
                const float v = u * (acc[pt][dt][e] + bs); acc[pt][dt][e] = v; ss += v * v; }
            ss = row16_sum(ss); if (i == 0) SS[p * 4 + hh] = ss; } }
    __syncthreads();
#pragma unroll
    for (int pt = 0; pt < 4; ++pt)
#pragma unroll
        for (int e = 0; e < 4; ++e) { const int p = 64 * ph + 16 * pt + 4 * g + e; const f32x4 s4 = *(const LAS f32x4*)(SS + p * 4);
            const float sc = rsqf_(((s4.x + s4.y) + (s4.z + s4.w)) * (1.f / 256.f) + NORM_EPS);
#pragma unroll
            for (int dt = 0; dt < 4; ++dt) *(LAS unsigned short*)(VI + p * SG_PITCH + (hh * 64 + 16 * dt + i) * 2) = (unsigned short)f2bf(acc[pt][dt][e] * sc); }
    __syncthreads();
#pragma unroll
    for (int q = 0; q < 8; ++q) { const int e = tid + 512 * q, row = e >> 5, ch = e & 31;
        const v4u v = *(const LAS v4u*)(VI + row * SG_PITCH + ch * 16);
        *(GAS v4u*)(merged + (m0 + row) * DM + 768 + 8 * ch) = v; }
    __syncthreads();
}

__device__ __forceinline__ void phase_mix_na(Frame& F, int l, int bidx, int nblk) {
    LAUNDER(F);
    LAS float* RPB = (LAS float*)(F.lds + RING_BYTES + 1024);
    for (int q = F.tid; q < 4 * 465; q += NTHREADS) RPB[q] = INP(F, I_RPB)[l * 4 * 465 + q];
    __syncthreads();
    for (int it = bidx * NWAVES + F.wave; it < NB * 64 * 4; it += nblk * NWAVES) mix_na_item(F, l, it, F.lds + F.wave * 16384, RPB);
    __syncthreads();
#ifdef SGU_IN_C2
    for (int it = bidx; it < NB * 32; it += nblk) mix_sgu_item(F, l, it);
#endif
}
__device__ __forceinline__ void phase_mixers(Frame& F, int l) {
    LAUNDER(F);
    for (int tile = F.vcu; tile < M / 64; tile += F.G) mix_convprep_tile(F, l, tile);
    __syncthreads();
#ifndef SGU_IN_C2
    for (int it = F.vcu; it < NB * 32; it += F.G) mix_sgu_item(F, l, it);
#endif
}

constexpr int C1_RES = 65536, C1_RES_D = 15616;
constexpr int C1_ZT = 0, C1_ET = 4096, C1_QT = 8192, C1_CT = 12288, C1_DA = 13312, C1_UH = 13568;
constexpr int C1_IMG = 0, C1_IMG_D = 16384, C1_SC = 0, C1_SCST = 144, C1_CM = 9216, C1_DM = 15360, C1_DL = 15616;
typedef _Float16 h4 __attribute__((ext_vector_type(4)));
typedef _Float16 h8 __attribute__((ext_vector_type(8)));
__device__ __forceinline__ bf16x8 pack8(f32x4 lo, f32x4 hi) { return __builtin_bit_cast(bf16x8, (v4u){pg8::cvt_pk_bf16(lo.x, lo.y), pg8::cvt_pk_bf16(lo.z, lo.w), pg8::cvt_pk_bf16(hi.x, hi.y), pg8::cvt_pk_bf16(hi.z, hi.w)}); }
template <int MODE>
__device__ __forceinline__ void phase_scan_c1(Frame& F, int l) {
    LAUNDER(F);
    const GAS bf16* proj = (const GAS bf16*)(F.ws + WS_PROJ);
    const int lane = F.lane, w = F.wave, i = lane & 15, g = lane >> 4;
    const int d = w >> 2, wa = w & 3;
    const int bh = F.vcu >> 3, bb = bh >> 2, h = bh & 3;
    LAS unsigned char* lds = F.lds;
    bf16x8 Bw, Ba;
    { f32x4 xw0 = (f32x4){0.f, 0.f, 0.f, 0.f}, xw1 = xw0, xa0 = xw0, xa1 = xw0;
      if (g < 2) { const GAS float* pw = INP(F, I_RWUP) + ((size_t)(l * 2 + d) * 16 + 8 * g) * 256 + h * 64 + 16 * wa + i; const GAS float* pa = INP(F, I_RAUP) + ((size_t)(l * 2 + d) * 16 + 8 * g) * 256 + h * 64 + 16 * wa + i;
          xw0 = (f32x4){pw[0], pw[256], pw[512], pw[768]}; xw1 = (f32x4){pw[1024], pw[1280], pw[1536], pw[1792]};
          xa0 = (f32x4){pa[0], pa[256], pa[512], pa[768]}; xa1 = (f32x4){pa[1024], pa[1280], pa[1536], pa[1792]}; }
      Bw = pack8(xw0, xw1); Ba = pack8(xa0, xa1); }
    const float w0c = INP(F, I_RW0)[(l * 2 + d) * 256 + h * 64 + 16 * wa + i], a0c = INP(F, I_RA0)[(l * 2 + d) * 256 + h * 64 + 16 * wa + i], kag = INP(F, I_RKA)[l * 256 + h * 64 + 16 * wa + i];
    float kkg[4];
#pragma unroll
    for (int t = 0; t < 4; ++t) kkg[t] = INP(F, I_RKK)[l * 256 + h * 64 + 16 * t + i];
    const float kkgw = INP(F, I_RKK)[l * 256 + h * 64 + 16 * wa + i];
    const int c = 16 * wa + i;
    const int sq = d ? 3 - g : g;
#define C1_BAR() do { asm volatile("s_waitcnt lgkmcnt(0)" ::: "memory"); __builtin_amdgcn_s_barrier(); asm volatile("" ::: "memory"); } while (0)
    unsigned short kq[4][4], kown[4], rq[4]; v4u dvr, ivr;
#define C1_LOAD(B_) do { const size_t m0_ = (size_t)bb * T + 16 * (B_); \
        _Pragma("unroll") for (int e_ = 0; e_ < 4; ++e_) { const GAS bf16* row_ = proj + (m0_ + 4 * g + e_) * NPROJP; \
            _Pragma("unroll") for (int t_ = 0; t_ < 4; ++t_) kq[t_][e_] = row_[C_K + h * 64 + 16 * t_ + i]; \
            rq[e_] = row_[C_R + h * 64 + 16 * wa + i]; kown[e_] = row_[C_K + h * 64 + 16 * wa + i]; } \
        { const GAS bf16* arow_ = proj + (m0_ + i) * NPROJP + C_DEC + 16 * d + 8 * (g & 1); dvr = *(const GAS v4u*)(arow_); ivr = *(const GAS v4u*)(arow_ + 32); } } while (0)
    const int B0 = (F.vcu & 7) * 32;
    C1_LOAD(B0);
    {
        const int it = 0;
        { const int B = B0 + it; LAS unsigned char* IMG = lds + C1_IMG + ((it & 1) * 2 + d) * C1_IMG_D; (void)B;
        if (MODE != 3) {
            v4u dv = (v4u){0u, 0u, 0u, 0u}, iv = dv;
            if (g < 2) { iv = ivr;
#pragma unroll
                for (int q = 0; q < 4; ++q) dv[q] = pk2(tanhf_(bflo(dvr[q])), tanhf_(bfhi(dvr[q]))); }
            const f32x4 z4 = (f32x4){0.f, 0.f, 0.f, 0.f};
            const f32x4 Dw = __builtin_amdgcn_mfma_f32_16x16x32_bf16(__builtin_bit_cast(bf16x8, dv), Bw, z4, 0, 0, 0);
            const f32x4 Da = __builtin_amdgcn_mfma_f32_16x16x32_bf16(__builtin_bit_cast(bf16x8, iv), Ba, z4, 0, 0, 0);
            float vw[4], vk[4], vb[4], ve[4], vr[4];
#pragma unroll
            for (int e = 0; e < 4; ++e) {
                float ss = 0.f;
#pragma unroll
                for (int t = 0; t < 4; ++t) { const float x = bf2f(kq[t][e]) * kkg[t]; ss += x * x; }
                ss = row16_sum(ss);
                const float k = bf2f(kown[e]); const float kk = k * kkgw * rsqf_(ss + 1e-12f);
                const float wv = __expf(-DECAY_SCALE * sigmoidf_(w0c + Dw[e])), av = sigmoidf_(a0c + Da[e]);
                vw[e] = wv; vk[e] = kk; vb[e] = kk * av; ve[e] = k * (1.f + (av - 1.f) * kag); vr[e] = bf2f(rq[e]); }
            if (d) {
#define C1_SWAP(a_) do { float t0_ = a_[0], t1_ = a_[1]; a_[0] = a_[3]; a_[1] = a_[2]; a_[2] = t1_; a_[3] = t0_; } while (0)
                C1_SWAP(vw); C1_SWAP(vk); C1_SWAP(vb); C1_SWAP(ve); C1_SWAP(vr);
#undef C1_SWAP
            }
            float Dp[4], Dt[4];
            const float c1 = vw[0], c2 = c1 * vw[1], c3 = c2 * vw[2], c4 = c3 * vw[3];
            const float q0 = __shfl(c4, (d ? 48 : 0) + i), q1 = __shfl(c4, (d ? 32 : 16) + i), q2 = __shfl(c4, (d ? 16 : 32) + i);
            const float Dm = q0 * q1;
            const float off = sq == 0 ? 1.f : (sq == 1 ? q0 : (sq == 2 ? Dm : Dm * q2));
            Dp[0] = off; Dp[1] = off * c1; Dp[2] = off * c2; Dp[3] = off * c3;
            Dt[0] = Dp[1]; Dt[1] = Dp[2]; Dt[2] = Dp[3]; Dt[3] = off * c4;
            const float rDm = rcpf_(Dm);
            h4 hk, hb, he;
#pragma unroll
            for (int e = 0; e < 4; ++e) { const float rDt = rcpf_(Dt[e]);
                const float kap = vk[e] * Dp[e] * rDm, rr = vr[e] * Dt[e] * rDm, bq = vb[e] * Dm * rDt, eq = ve[e] * Dm * rDt;
                const int s = 4 * sq + e;
                ((LAS _Float16*)(IMG + C1_SC + (0 * 16 + s) * C1_SCST))[c] = (_Float16)kap; ((LAS _Float16*)(IMG + C1_SC + (1 * 16 + s) * C1_SCST))[c] = (_Float16)rr;
                ((LAS _Float16*)(IMG + C1_SC + (2 * 16 + s) * C1_SCST))[c] = (_Float16)bq;  ((LAS _Float16*)(IMG + C1_SC + (3 * 16 + s) * C1_SCST))[c] = (_Float16)eq;
                hk[e] = (_Float16)kap; hb[e] = (_Float16)bq; he[e] = (_Float16)eq; }
            *(LAS h4*)(IMG + C1_CM + c * 96 + 0 + sq * 8) = hk; *(LAS h4*)(IMG + C1_CM + c * 96 + 32 + sq * 8) = hb; *(LAS h4*)(IMG + C1_CM + c * 96 + 64 + sq * 8) = he;
            if (sq == 3) *(LAS float*)(IMG + C1_DL + c * 4) = Dt[3];
            if (sq == 0) *(LAS float*)(IMG + C1_DM + c * 4) = Dm;
        }
        }
        if (it + 1 < 32) C1_LOAD(B0 + it + 1);
        C1_BAR();
    }
    {
        const int it = 1;
        { const int B = B0 + it; LAS unsigned char* IMG = lds + C1_IMG + ((it & 1) * 2 + d) * C1_IMG_D; (void)B;
        if (MODE != 3) {
            v4u dv = (v4u){0u, 0u, 0u, 0u}, iv = dv;
            if (g < 2) { iv = ivr;
#pragma unroll
                for (int q = 0; q < 4; ++q) dv[q] = pk2(tanhf_(bflo(dvr[q])), tanhf_(bfhi(dvr[q]))); }
            const f32x4 z4 = (f32x4){0.f, 0.f, 0.f, 0.f};
            const f32x4 Dw = __builtin_amdgcn_mfma_f32_16x16x32_bf16(__builtin_bit_cast(bf16x8, dv), Bw, z4, 0, 0, 0);
            const f32x4 Da = __builtin_amdgcn_mfma_f32_16x16x32_bf16(__builtin_bit_cast(bf16x8, iv), Ba, z4, 0, 0, 0);
            float vw[4], vk[4], vb[4], ve[4], vr[4];
#pragma unroll
            for (int e = 0; e < 4; ++e) {
                float ss = 0.f;
#pragma unroll
                for (int t = 0; t < 4; ++t) { const float x = bf2f(kq[t][e]) * kkg[t]; ss += x * x; }
                ss = row16_sum(ss);
                const float k = bf2f(kown[e]); const float kk = k * kkgw * rsqf_(ss + 1e-12f);
                const float wv = __expf(-DECAY_SCALE * sigmoidf_(w0c + Dw[e])), av = sigmoidf_(a0c + Da[e]);
                vw[e] = wv; vk[e] = kk; vb[e] = kk * av; ve[e] = k * (1.f + (av - 1.f) * kag); vr[e] = bf2f(rq[e]); }
            if (d) {
#define C1_SWAP(a_) do { float t0_ = a_[0], t1_ = a_[1]; a_[0] = a_[3]; a_[1] = a_[2]; a_[2] = t1_; a_[3] = t0_; } while (0)
                C1_SWAP(vw); C1_SWAP(vk); C1_SWAP(vb); C1_SWAP(ve); C1_SWAP(vr);
#undef C1_SWAP
            }
            float Dp[4], Dt[4];
            const float c1 = vw[0], c2 = c1 * vw[1], c3 = c2 * vw[2], c4 = c3 * vw[3];
            const float q0 = __shfl(c4, (d ? 48 : 0) + i), q1 = __shfl(c4, (d ? 32 : 16) + i), q2 = __shfl(c4, (d ? 16 : 32) + i);
            const float Dm = q0 * q1;
            const float off = sq == 0 ? 1.f : (sq == 1 ? q0 : (sq == 2 ? Dm : Dm * q2));
            Dp[0] = off; Dp[1] = off * c1; Dp[2] = off * c2; Dp[3] = off * c3;
            Dt[0] = Dp[1]; Dt[1] = Dp[2]; Dt[2] = Dp[3]; Dt[3] = off * c4;
            const float rDm = rcpf_(Dm);
            h4 hk, hb, he;
#pragma unroll
            for (int e = 0; e < 4; ++e) { const float rDt = rcpf_(Dt[e]);
                const float kap = vk[e] * Dp[e] * rDm, rr = vr[e] * Dt[e] * rDm, bq = vb[e] * Dm * rDt, eq = ve[e] * Dm * rDt;
                const int s = 4 * sq + e;
                ((LAS _Float16*)(IMG + C1_SC + (0 * 16 + s) * C1_SCST))[c] = (_Float16)kap; ((LAS _Float16*)(IMG + C1_SC + (1 * 16 + s) * C1_SCST))[c] = (_Float16)rr;
                ((LAS _Float16*)(IMG + C1_SC + (2 * 16 + s) * C1_SCST))[c] = (_Float16)bq;  ((LAS _Float16*)(IMG + C1_SC + (3 * 16 + s) * C1_SCST))[c] = (_Float16)eq;
                hk[e] = (_Float16)kap; hb[e] = (_Float16)bq; he[e] = (_Float16)eq; }
            *(LAS h4*)(IMG + C1_CM + c * 96 + 0 + sq * 8) = hk; *(LAS h4*)(IMG + C1_CM + c * 96 + 32 + sq * 8) = hb; *(LAS h4*)(IMG + C1_CM + c * 96 + 64 + sq * 8) = he;
            if (sq == 3) *(LAS float*)(IMG + C1_DL + c * 4) = Dt[3];
            if (sq == 0) *(LAS float*)(IMG + C1_DM + c * 4) = Dm;
        }
        }
        if (it + 1 < 32) C1_LOAD(B0 + it + 1);
        { const LAS unsigned char* IMG = lds + C1_IMG + (((it - 1) & 1) * 2 + d) * C1_IMG_D; LAS unsigned char* R = lds + C1_RES + (((it - 1) & 1) * 2 + d) * C1_RES_D;
        if (MODE != 1 && MODE != 4) {
            h8 fk[2], fr[2], fb[2], fe[2];
#pragma unroll
            for (int ks = 0; ks < 2; ++ks) { const LAS unsigned char* p = IMG + C1_SC + i * C1_SCST + (8 * g + 32 * ks) * 2;
                fk[ks] = *(const LAS h8*)(p); fr[ks] = *(const LAS h8*)(p + 16 * C1_SCST); fb[ks] = *(const LAS h8*)(p + 32 * C1_SCST); fe[ks] = *(const LAS h8*)(p + 48 * C1_SCST); }
            const f32x4 z4 = (f32x4){0.f, 0.f, 0.f, 0.f};
            f32x4 aN = z4, aNT = z4, aM = z4, aMT = z4, aNr = z4, aMr = z4;
#pragma unroll
            for (int ks = 0; ks < 2; ++ks) {
                aN  = __builtin_amdgcn_mfma_f32_16x16x32_f16(fb[ks], fk[ks], aN, 0, 0, 0);  aNT = __builtin_amdgcn_mfma_f32_16x16x32_f16(fk[ks], fb[ks], aNT, 0, 0, 0);
                aM  = __builtin_amdgcn_mfma_f32_16x16x32_f16(fe[ks], fk[ks], aM, 0, 0, 0);  aMT = __builtin_amdgcn_mfma_f32_16x16x32_f16(fk[ks], fe[ks], aMT, 0, 0, 0);
                aNr = __builtin_amdgcn_mfma_f32_16x16x32_f16(fb[ks], fr[ks], aNr, 0, 0, 0); aMr = __builtin_amdgcn_mfma_f32_16x16x32_f16(fe[ks], fr[ks], aMr, 0, 0, 0); }
#pragma unroll
            for (int e = 0; e < 4; ++e) { const int row = 4 * g + e;
                aN[e] = row < i ? -aN[e] : 0.f; aNT[e] = i < row ? -aNT[e] : 0.f; aM[e] = row < i ? aM[e] : 0.f; aMT[e] = i < row ? aMT[e] : 0.f;
                aNr[e] = row <= i ? aNr[e] : 0.f; aMr[e] = row <= i ? aMr[e] : 0.f; }
#define C1_H4(x_) __builtin_convertvector((x_), h4)
#define C1_MM(a_, b_, c_) __builtin_amdgcn_mfma_f32_16x16x16f16((a_), (b_), (c_), 0, 0, 0)
            f32x4 S = aN, ST = aNT;
#pragma unroll
            for (int e = 0; e < 4; ++e) if (4 * g + e == i) { S[e] += 1.f; ST[e] += 1.f; }
            const h4 hA = C1_H4(aN), hAT = C1_H4(aNT);
            const f32x4 P2 = C1_MM(hAT, hA, z4), P2T = C1_MM(hA, hAT, z4);
            const h4 hP2 = C1_H4(P2), hP2T = C1_H4(P2T);
            { const h4 hS = C1_H4(S); S = C1_MM(hP2T, hS, S); ST = C1_MM(hS, hP2T, ST); }
            const f32x4 P4 = C1_MM(hP2T, hP2, z4), P4T = C1_MM(hP2, hP2T, z4);
            const h4 hP4 = C1_H4(P4), hP4T = C1_H4(P4T);
            { const h4 hS = C1_H4(S); S = C1_MM(hP4T, hS, S); ST = C1_MM(hS, hP4T, ST); }
            const f32x4 P8T = C1_MM(hP4, hP4T, z4);
            const h4 hP8T = C1_H4(P8T);
            { const h4 hS = C1_H4(S); ST = C1_MM(hS, hP8T, ST); }
            const h4 hTT = C1_H4(ST), hMT = C1_H4(aMT);
            const f32x4 X1 = C1_MM(hTT, C1_H4(aNr), z4);
            const h4 hX1 = C1_H4(X1);
            const h4 bT = *(const LAS h4*)(IMG + C1_CM + c * 96 + 32 + g * 8);
            const f32x4 X2 = C1_MM(hTT, bT, z4);
            const float dl = *(const LAS float*)(IMG + C1_DL + c * 4), dm = *(const LAS float*)(IMG + C1_DM + c * 4);
            *(LAS f32x4*)(R + C1_ZT + c * 64 + 16 * g) = X2 * dl;
            const f32x4 Ea = C1_MM(hMT, C1_H4(X2), z4);
            const h4 kh = *(const LAS h4*)(IMG + C1_CM + c * 96 + 64 + g * 8);
            *(LAS f32x4*)(R + C1_ET + c * 64 + 16 * g) = (__builtin_convertvector(kh, f32x4) - Ea) * (dl * rcpf_(dm));
            const h4 kT = *(const LAS h4*)(IMG + C1_CM + c * 96 + g * 8);
            const f32x4 Qa = C1_MM(kT, hX1, z4);
            const h4 rh = *(const LAS h4*)(IMG + C1_SC + (16 + i) * C1_SCST + (16 * wa + 4 * g) * 2);
            const f32x4 dm4 = *(const LAS f32x4*)(IMG + C1_DM + (16 * wa + 4 * g) * 4);
            *(LAS f32x4*)(R + C1_QT + i * 256 + (16 * wa + 4 * g) * 4) = (__builtin_convertvector(rh, f32x4) - Qa) * dm4;
            if (wa == 0) { const f32x4 Ca = C1_MM(hMT, hX1, z4); *(LAS f32x4*)(R + C1_CT + i * 64 + 16 * g) = aMr - Ca; }
            *(LAS h4*)(R + C1_UH + c * 32 + 8 * g) = kT;
            if (g == 0) *(LAS float*)(R + C1_DA + c * 4) = dl;
#undef C1_H4
#undef C1_MM
        }
        }
        C1_BAR();
    }
    for (int itv = 2; itv < 32; ++itv)
    {
        const int it = itv;
        { const int B = B0 + it; LAS unsigned char* IMG = lds + C1_IMG + ((it & 1) * 2 + d) * C1_IMG_D; (void)B;
        if (MODE != 3) {
            v4u dv = (v4u){0u, 0u, 0u, 0u}, iv = dv;
            if (g < 2) { iv = ivr;
#pragma unroll
                for (int q = 0; q < 4; ++q) dv[q] = pk2(tanhf_(bflo(dvr[q])), tanhf_(bfhi(dvr[q]))); }
            const f32x4 z4 = (f32x4){0.f, 0.f, 0.f, 0.f};
            const f32x4 Dw = __builtin_amdgcn_mfma_f32_16x16x32_bf16(__builtin_bit_cast(bf16x8, dv), Bw, z4, 0, 0, 0);
            const f32x4 Da = __builtin_amdgcn_mfma_f32_16x16x32_bf16(__builtin_bit_cast(bf16x8, iv), Ba, z4, 0, 0, 0);
            float vw[4], vk[4], vb[4], ve[4], vr[4];
#pragma unroll
            for (int e = 0; e < 4; ++e) {
                float ss = 0.f;
#pragma unroll
                for (int t = 0; t < 4; ++t) { const float x = bf2f(kq[t][e]) * kkg[t]; ss += x * x; }
                ss = row16_sum(ss);
                const float k = bf2f(kown[e]); const float kk = k * kkgw * rsqf_(ss + 1e-12f);
                const float wv = __expf(-DECAY_SCALE * sigmoidf_(w0c + Dw[e])), av = sigmoidf_(a0c + Da[e]);
                vw[e] = wv; vk[e] = kk; vb[e] = kk * av; ve[e] = k * (1.f + (av - 1.f) * kag); vr[e] = bf2f(rq[e]); }
            if (d) {
#define C1_SWAP(a_) do { float t0_ = a_[0], t1_ = a_[1]; a_[0] = a_[3]; a_[1] = a_[2]; a_[2] = t1_; a_[3] = t0_; } while (0)
                C1_SWAP(vw); C1_SWAP(vk); C1_SWAP(vb); C1_SWAP(ve); C1_SWAP(vr);
#undef C1_SWAP
            }
            float Dp[4], Dt[4];
            const float c1 = vw[0], c2 = c1 * vw[1], c3 = c2 * vw[2], c4 = c3 * vw[3];
            const float q0 = __shfl(c4, (d ? 48 : 0) + i), q1 = __shfl(c4, (d ? 32 : 16) + i), q2 = __shfl(c4, (d ? 16 : 32) + i);
            const float Dm = q0 * q1;
            const float off = sq == 0 ? 1.f : (sq == 1 ? q0 : (sq == 2 ? Dm : Dm * q2));
            Dp[0] = off; Dp[1] = off * c1; Dp[2] = off * c2; Dp[3] = off * c3;
            Dt[0] = Dp[1]; Dt[1] = Dp[2]; Dt[2] = Dp[3]; Dt[3] = off * c4;
            const float rDm = rcpf_(Dm);
            h4 hk, hb, he;
#pragma unroll
            for (int e = 0; e < 4; ++e) { const float rDt = rcpf_(Dt[e]);
                const float kap = vk[e] * Dp[e] * rDm, rr = vr[e] * Dt[e] * rDm, bq = vb[e] * Dm * rDt, eq = ve[e] * Dm * rDt;
                const int s = 4 * sq + e;
                ((LAS _Float16*)(IMG + C1_SC + (0 * 16 + s) * C1_SCST))[c] = (_Float16)kap; ((LAS _Float16*)(IMG + C1_SC + (1 * 16 + s) * C1_SCST))[c] = (_Float16)rr;
                ((LAS _Float16*)(IMG + C1_SC + (2 * 16 + s) * C1_SCST))[c] = (_Float16)bq;  ((LAS _Float16*)(IMG + C1_SC + (3 * 16 + s) * C1_SCST))[c] = (_Float16)eq;
                hk[e] = (_Float16)kap; hb[e] = (_Float16)bq; he[e] = (_Float16)eq; }
            *(LAS h4*)(IMG + C1_CM + c * 96 + 0 + sq * 8) = hk; *(LAS h4*)(IMG + C1_CM + c * 96 + 32 + sq * 8) = hb; *(LAS h4*)(IMG + C1_CM + c * 96 + 64 + sq * 8) = he;
            if (sq == 3) *(LAS float*)(IMG + C1_DL + c * 4) = Dt[3];
            if (sq == 0) *(LAS float*)(IMG + C1_DM + c * 4) = Dm;
        }
        }
        if (it + 1 < 32) C1_LOAD(B0 + it + 1);
        { const LAS unsigned char* IMG = lds + C1_IMG + (((it - 1) & 1) * 2 + d) * C1_IMG_D; LAS unsigned char* R = lds + C1_RES + (((it - 1) & 1) * 2 + d) * C1_RES_D;
        if (MODE != 1 && MODE != 4) {
            h8 fk[2], fr[2], fb[2], fe[2];
#pragma unroll
            for (int ks = 0; ks < 2; ++ks) { const LAS unsigned char* p = IMG + C1_SC + i * C1_SCST + (8 * g + 32 * ks) * 2;
                fk[ks] = *(const LAS h8*)(p); fr[ks] = *(const LAS h8*)(p + 16 * C1_SCST); fb[ks] = *(const LAS h8*)(p + 32 * C1_SCST); fe[ks] = *(const LAS h8*)(p + 48 * C1_SCST); }
            const f32x4 z4 = (f32x4){0.f, 0.f, 0.f, 0.f};
            f32x4 aN = z4, aNT = z4, aM = z4, aMT = z4, aNr = z4, aMr = z4;
#pragma unroll
            for (int ks = 0; ks < 2; ++ks) {
                aN  = __builtin_amdgcn_mfma_f32_16x16x32_f16(fb[ks], fk[ks], aN, 0, 0, 0);  aNT = __builtin_amdgcn_mfma_f32_16x16x32_f16(fk[ks], fb[ks], aNT, 0, 0, 0);
                aM  = __builtin_amdgcn_mfma_f32_16x16x32_f16(fe[ks], fk[ks], aM, 0, 0, 0);  aMT = __builtin_amdgcn_mfma_f32_16x16x32_f16(fk[ks], fe[ks], aMT, 0, 0, 0);
                aNr = __builtin_amdgcn_mfma_f32_16x16x32_f16(fb[ks], fr[ks], aNr, 0, 0, 0); aMr = __builtin_amdgcn_mfma_f32_16x16x32_f16(fe[ks], fr[ks], aMr, 0, 0, 0); }
#pragma unroll
            for (int e = 0; e < 4; ++e) { const int row = 4 * g + e;
                aN[e] = row < i ? -aN[e] : 0.f; aNT[e] = i < row ? -aNT[e] : 0.f; aM[e] = row < i ? aM[e] : 0.f; aMT[e] = i < row ? aMT[e] : 0.f;
                aNr[e] = row <= i ? aNr[e] : 0.f; aMr[e] = row <= i ? aMr[e] : 0.f; }
#define C1_H4(x_) __builtin_convertvector((x_), h4)
#define C1_MM(a_, b_, c_) __builtin_amdgcn_mfma_f32_16x16x16f16((a_), (b_), (c_), 0, 0, 0)
            f32x4 S = aN, ST = aNT;
#pragma unroll
            for (int e = 0; e < 4; ++e) if (4 * g + e == i) { S[e] += 1.f; ST[e] += 1.f; }
            const h4 hA = C1_H4(aN), hAT = C1_H4(aNT);
            const f32x4 P2 = C1_MM(hAT, hA, z4), P2T = C1_MM(hA, hAT, z4);
            const h4 hP2 = C1_H4(P2), hP2T = C1_H4(P2T);
            { const h4 hS = C1_H4(S); S = C1_MM(hP2T, hS, S); ST = C1_MM(hS, hP2T, ST); }
            const f32x4 P4 = C1_MM(hP2T, hP2, z4), P4T = C1_MM(hP2, hP2T, z4);
            const h4 hP4 = C1_H4(P4), hP4T = C1_H4(P4T);
            { const h4 hS = C1_H4(S); S = C1_MM(hP4T, hS, S); ST = C1_MM(hS, hP4T, ST); }
            const f32x4 P8T = C1_MM(hP4, hP4T, z4);
            const h4 hP8T = C1_H4(P8T);
            { const h4 hS = C1_H4(S); ST = C1_MM(hS, hP8T, ST); }
            const h4 hTT = C1_H4(ST), hMT = C1_H4(aMT);
            const f32x4 X1 = C1_MM(hTT, C1_H4(aNr), z4);
            const h4 hX1 = C1_H4(X1);
            const h4 bT = *(const LAS h4*)(IMG + C1_CM + c * 96 + 32 + g * 8);
            const f32x4 X2 = C1_MM(hTT, bT, z4);
            const float dl = *(const LAS float*)(IMG + C1_DL + c * 4), dm = *(const LAS float*)(IMG + C1_DM + c * 4);
            *(LAS f32x4*)(R + C1_ZT + c * 64 + 16 * g) = X2 * dl;
            const f32x4 Ea = C1_MM(hMT, C1_H4(X2), z4);
            const h4 kh = *(const LAS h4*)(IMG + C1_CM + c * 96 + 64 + g * 8);
            *(LAS f32x4*)(R + C1_ET + c * 64 + 16 * g) = (__builtin_convertvector(kh, f32x4) - Ea) * (dl * rcpf_(dm));
            const h4 kT = *(const LAS h4*)(IMG + C1_CM + c * 96 + g * 8);
            const f32x4 Qa = C1_MM(kT, hX1, z4);
            const h4 rh = *(const LAS h4*)(IMG + C1_SC + (16 + i) * C1_SCST + (16 * wa + 4 * g) * 2);
            const f32x4 dm4 = *(const LAS f32x4*)(IMG + C1_DM + (16 * wa + 4 * g) * 4);
            *(LAS f32x4*)(R + C1_QT + i * 256 + (16 * wa + 4 * g) * 4) = (__builtin_convertvector(rh, f32x4) - Qa) * dm4;
            if (wa == 0) { const f32x4 Ca = C1_MM(hMT, hX1, z4); *(LAS f32x4*)(R + C1_CT + i * 64 + 16 * g) = aMr - Ca; }
            *(LAS h4*)(R + C1_UH + c * 32 + 8 * g) = kT;
            if (g == 0) *(LAS float*)(R + C1_DA + c * 4) = dl;
#undef C1_H4
#undef C1_MM
        }
        }
        { const int B = B0 + it - 2; const LAS unsigned char* R = lds + C1_RES + ((it & 1) * 2 + d) * C1_RES_D;
        if (MODE != 2 && MODE != 4) {
            const int n = d ? 255 - B : B;
            GAS unsigned char* gt = (d ? (GAS unsigned char*)F.out : F.ws + WS_GT0) + ((size_t)(bb * 4 + h) * 256 + n) * GT_CHUNK;
            const int nt = wa;
            bf16x8 zf = (bf16x8){0, 0, 0, 0, 0, 0, 0, 0};
            if (g < 2) { const LAS f32x4* zp = (const LAS f32x4*)(R + C1_ZT + (16 * nt + i) * 64 + 32 * g); zf = pack8(zp[0], zp[1]); }
            f32x4 pp[4];
#pragma unroll
            for (int ct = 0; ct < 4; ++ct) {
                bf16x8 uf = (bf16x8){0, 0, 0, 0, 0, 0, 0, 0};
                if (g < 2) { const LAS h4* up = (const LAS h4*)(R + C1_UH + (16 * ct + i) * 32 + 16 * g); uf = pack8(__builtin_convertvector(up[0], f32x4), __builtin_convertvector(up[1], f32x4)); }
                const f32x4 dd = __builtin_amdgcn_mfma_f32_16x16x32_bf16(uf, zf, (f32x4){0.f, 0.f, 0.f, 0.f}, 0, 0, 0);
                f32x4 pv = -dd;
                if (ct == nt) { const f32x4 da = *(const LAS f32x4*)(R + C1_DA + (16 * ct + 4 * g) * 4);
#pragma unroll
                    for (int e = 0; e < 4; ++e) if (4 * g + e == i) pv[e] += da[e]; }
                pp[ct] = pv; }
#undef C1_ST
#define C1_ST(p_, v_) do { const bf16x8 v__ = (v_); if (MODE == 0) *(GAS bf16x8*)(p_) = v__; else asm volatile("" :: "v"(v__)); } while (0)
            C1_ST(gt + (nt * 2 + 0) * 1024 + lane * 16, pack8(pp[0], pp[1]));
            C1_ST(gt + (nt * 2 + 1) * 1024 + lane * 16, pack8(pp[2], pp[3]));
            if (g < 2) { const LAS f32x4* ep = (const LAS f32x4*)(R + C1_ET + (16 * nt + i) * 64 + 32 * g); C1_ST(gt + 10240 + nt * 512 + lane * 16, pack8(ep[0], ep[1])); }
            if (wa == 0) {
#pragma unroll
                for (int ks = 0; ks < 2; ++ks) { const LAS f32x4* qp = (const LAS f32x4*)(R + C1_QT + i * 256 + (32 * ks + 4 * g) * 4);
                    C1_ST(gt + (8 + ks) * 1024 + lane * 16, pack8(qp[0], qp[4])); }
                if (g < 2) { const LAS f32x4* cp = (const LAS f32x4*)(R + C1_CT + i * 64 + 32 * g); C1_ST(gt + 10240 + 4 * 512 + lane * 16, pack8(cp[0], cp[1])); }
            }
        }
        }
        C1_BAR();
    }
    {
        const int it = 32;
        { const LAS unsigned char* IMG = lds + C1_IMG + (((it - 1) & 1) * 2 + d) * C1_IMG_D; LAS unsigned char* R = lds + C1_RES + (((it - 1) & 1) * 2 + d) * C1_RES_D;
        if (MODE != 1 && MODE != 4) {
            h8 fk[2], fr[2], fb[2], fe[2];
#pragma unroll
            for (int ks = 0; ks < 2; ++ks) { const LAS unsigned char* p = IMG + C1_SC + i * C1_SCST + (8 * g + 32 * ks) * 2;
                fk[ks] = *(const LAS h8*)(p); fr[ks] = *(const LAS h8*)(p + 16 * C1_SCST); fb[ks] = *(const LAS h8*)(p + 32 * C1_SCST); fe[ks] = *(const LAS h8*)(p + 48 * C1_SCST); }
            const f32x4 z4 = (f32x4){0.f, 0.f, 0.f, 0.f};
            f32x4 aN = z4, aNT = z4, aM = z4, aMT = z4, aNr = z4, aMr = z4;
#pragma unroll
            for (int ks = 0; ks < 2; ++ks) {
                aN  = __builtin_amdgcn_mfma_f32_16x16x32_f16(fb[ks], fk[ks], aN, 0, 0, 0);  aNT = __builtin_amdgcn_mfma_f32_16x16x32_f16(fk[ks], fb[ks], aNT, 0, 0, 0);
                aM  = __builtin_amdgcn_mfma_f32_16x16x32_f16(fe[ks], fk[ks], aM, 0, 0, 0);  aMT = __builtin_amdgcn_mfma_f32_16x16x32_f16(fk[ks], fe[ks], aMT, 0, 0, 0);
                aNr = __builtin_amdgcn_mfma_f32_16x16x32_f16(fb[ks], fr[ks], aNr, 0, 0, 0); aMr = __builtin_amdgcn_mfma_f32_16x16x32_f16(fe[ks], fr[ks], aMr, 0, 0, 0); }
#pragma unroll
            for (int e = 0; e < 4; ++e) { const int row = 4 * g + e;
                aN[e] = row < i ? -aN[e] : 0.f; aNT[e] = i < row ? -aNT[e] : 0.f; aM[e] = row < i ? aM[e] : 0.f; aMT[e] = i < row ? aMT[e] : 0.f;
                aNr[e] = row <= i ? aNr[e] : 0.f; aMr[e] = row <= i ? aMr[e] : 0.f; }
#define C1_H4(x_) __builtin_convertvector((x_), h4)
#define C1_MM(a_, b_, c_) __builtin_amdgcn_mfma_f32_16x16x16f16((a_), (b_), (c_), 0, 0, 0)
            f32x4 S = aN, ST = aNT;
#pragma unroll
            for (int e = 0; e < 4; ++e) if (4 * g + e == i) { S[e] += 1.f; ST[e] += 1.f; }
            const h4 hA = C1_H4(aN), hAT = C1_H4(aNT);
            const f32x4 P2 = C1_MM(hAT, hA, z4), P2T = C1_MM(hA, hAT, z4);
            const h4 hP2 = C1_H4(P2), hP2T = C1_H4(P2T);
            { const h4 hS = C1_H4(S); S = C1_MM(hP2T, hS, S); ST = C1_MM(hS, hP2T, ST); }
            const f32x4 P4 = C1_MM(hP2T, hP2, z4), P4T = C1_MM(hP2, hP2T, z4);
            const h4 hP4 = C1_H4(P4), hP4T = C1_H4(P4T);
            { const h4 hS = C1_H4(S); S = C1_MM(hP4T, hS, S); ST = C1_MM(hS, hP4T, ST); }
            const f32x4 P8T = C1_MM(hP4, hP4T, z4);
            const h4 hP8T = C1_H4(P8T);
            { const h4 hS = C1_H4(S); ST = C1_MM(hS, hP8T, ST); }
            const h4 hTT = C1_H4(ST), hMT = C1_H4(aMT);
            const f32x4 X1 = C1_MM(hTT, C1_H4(aNr), z4);
            const h4 hX1 = C1_H4(X1);
            const h4 bT = *(const LAS h4*)(IMG + C1_CM + c * 96 + 32 + g * 8);
            const f32x4 X2 = C1_MM(hTT, bT, z4);
            const float dl = *(const LAS float*)(IMG + C1_DL + c * 4), dm = *(const LAS float*)(IMG + C1_DM + c * 4);
            *(LAS f32x4*)(R + C1_ZT + c * 64 + 16 * g) = X2 * dl;
            const f32x4 Ea = C1_MM(hMT, C1_H4(X2), z4);
            const h4 kh = *(const LAS h4*)(IMG + C1_CM + c * 96 + 64 + g * 8);
            *(LAS f32x4*)(R + C1_ET + c * 64 + 16 * g) = (__builtin_convertvector(kh, f32x4) - Ea) * (dl * rcpf_(dm));
            const h4 kT = *(const LAS h4*)(IMG + C1_CM + c * 96 + g * 8);
            const f32x4 Qa = C1_MM(kT, hX1, z4);
            const h4 rh = *(const LAS h4*)(IMG + C1_SC + (16 + i) * C1_SCST + (16 * wa + 4 * g) * 2);
            const f32x4 dm4 = *(const LAS f32x4*)(IMG + C1_DM + (16 * wa + 4 * g) * 4);
            *(LAS f32x4*)(R + C1_QT + i * 256 + (16 * wa + 4 * g) * 4) = (__builtin_convertvector(rh, f32x4) - Qa) * dm4;
            if (wa == 0) { const f32x4 Ca = C1_MM(hMT, hX1, z4); *(LAS f32x4*)(R + C1_CT + i * 64 + 16 * g) = aMr - Ca; }
            *(LAS h4*)(R + C1_UH + c * 32 + 8 * g) = kT;
            if (g == 0) *(LAS float*)(R + C1_DA + c * 4) = dl;
#undef C1_H4
#undef C1_MM
        }
        }
        { const int B = B0 + it - 2; const LAS unsigned char* R = lds + C1_RES + ((it & 1) * 2 + d) * C1_RES_D;
        if (MODE != 2 && MODE != 4) {
            const int n = d ? 255 - B : B;
            GAS unsigned char* gt = (d ? (GAS unsigned char*)F.out : F.ws + WS_GT0) + ((size_t)(bb * 4 + h) * 256 + n) * GT_CHUNK;
            const int nt = wa;
            bf16x8 zf = (bf16x8){0, 0, 0, 0, 0, 0, 0, 0};
            if (g < 2) { const LAS f32x4* zp = (const LAS f32x4*)(R + C1_ZT + (16 * nt + i) * 64 + 32 * g); zf = pack8(zp[0], zp[1]); }
            f32x4 pp[4];
#pragma unroll
            for (int ct = 0; ct < 4; ++ct) {
                bf16x8 uf = (bf16x8){0, 0, 0, 0, 0, 0, 0, 0};
                if (g < 2) { const LAS h4* up = (const LAS h4*)(R + C1_UH + (16 * ct + i) * 32 + 16 * g); uf = pack8(__builtin_convertvector(up[0], f32x4), __builtin_convertvector(up[1], f32x4)); }
                const f32x4 dd = __builtin_amdgcn_mfma_f32_16x16x32_bf16(uf, zf, (f32x4){0.f, 0.f, 0.f, 0.f}, 0, 0, 0);
                f32x4 pv = -dd;
                if (ct == nt) { const f32x4 da = *(const LAS f32x4*)(R + C1_DA + (16 * ct + 4 * g) * 4);
#pragma unroll
                    for (int e = 0; e < 4; ++e) if (4 * g + e == i) pv[e] += da[e]; }
                pp[ct] = pv; }
#undef C1_ST
#define C1_ST(p_, v_) do { const bf16x8 v__ = (v_); if (MODE == 0) *(GAS bf16x8*)(p_) = v__; else asm volatile("" :: "v"(v__)); } while (0)
            C1_ST(gt + (nt * 2 + 0) * 1024 + lane * 16, pack8(pp[0], pp[1]));
            C1_ST(gt + (nt * 2 + 1) * 1024 + lane * 16, pack8(pp[2], pp[3]));
            if (g < 2) { const LAS f32x4* ep = (const LAS f32x4*)(R + C1_ET + (16 * nt + i) * 64 + 32 * g); C1_ST(gt + 10240 + nt * 512 + lane * 16, pack8(ep[0], ep[1])); }
            if (wa == 0) {
#pragma unroll
                for (int ks = 0; ks < 2; ++ks) { const LAS f32x4* qp = (const LAS f32x4*)(R + C1_QT + i * 256 + (32 * ks + 4 * g) * 4);
                    C1_ST(gt + (8 + ks) * 1024 + lane * 16, pack8(qp[0], qp[4])); }
                if (g < 2) { const LAS f32x4* cp = (const LAS f32x4*)(R + C1_CT + i * 64 + 32 * g); C1_ST(gt + 10240 + 4 * 512 + lane * 16, pack8(cp[0], cp[1])); }
            }
        }
        }
        C1_BAR();
    }
    {
        const int it = 33;
        { const int B = B0 + it - 2; const LAS unsigned char* R = lds + C1_RES + ((it & 1) * 2 + d) * C1_RES_D;
        if (MODE != 2 && MODE != 4) {
            const int n = d ? 255 - B : B;
            GAS unsigned char* gt = (d ? (GAS unsigned char*)F.out : F.ws + WS_GT0) + ((size_t)(bb * 4 + h) * 256 + n) * GT_CHUNK;
            const int nt = wa;
            bf16x8 zf = (bf16x8){0, 0, 0, 0, 0, 0, 0, 0};
            if (g < 2) { const LAS f32x4* zp = (const LAS f32x4*)(R + C1_ZT + (16 * nt + i) * 64 + 32 * g); zf = pack8(zp[0], zp[1]); }
            f32x4 pp[4];
#pragma unroll
            for (int ct = 0; ct < 4; ++ct) {
                bf16x8 uf = (bf16x8){0, 0, 0, 0, 0, 0, 0, 0};
                if (g < 2) { const LAS h4* up = (const LAS h4*)(R + C1_UH + (16 * ct + i) * 32 + 16 * g); uf = pack8(__builtin_convertvector(up[0], f32x4), __builtin_convertvector(up[1], f32x4)); }
                const f32x4 dd = __builtin_amdgcn_mfma_f32_16x16x32_bf16(uf, zf, (f32x4){0.f, 0.f, 0.f, 0.f}, 0, 0, 0);
                f32x4 pv = -dd;
                if (ct == nt) { const f32x4 da = *(const LAS f32x4*)(R + C1_DA + (16 * ct + 4 * g) * 4);
#pragma unroll
                    for (int e = 0; e < 4; ++e) if (4 * g + e == i) pv[e] += da[e]; }
                pp[ct] = pv; }
#undef C1_ST
#define C1_ST(p_, v_) do { const bf16x8 v__ = (v_); if (MODE == 0) *(GAS bf16x8*)(p_) = v__; else asm volatile("" :: "v"(v__)); } while (0)
            C1_ST(gt + (nt * 2 + 0) * 1024 + lane * 16, pack8(pp[0], pp[1]));
            C1_ST(gt + (nt * 2 + 1) * 1024 + lane * 16, pack8(pp[2], pp[3]));
            if (g < 2) { const LAS f32x4* ep = (const LAS f32x4*)(R + C1_ET + (16 * nt + i) * 64 + 32 * g); C1_ST(gt + 10240 + nt * 512 + lane * 16, pack8(ep[0], ep[1])); }
            if (wa == 0) {
#pragma unroll
                for (int ks = 0; ks < 2; ++ks) { const LAS f32x4* qp = (const LAS f32x4*)(R + C1_QT + i * 256 + (32 * ks + 4 * g) * 4);
                    C1_ST(gt + (8 + ks) * 1024 + lane * 16, pack8(qp[0], qp[4])); }
                if (g < 2) { const LAS f32x4* cp = (const LAS f32x4*)(R + C1_CT + i * 64 + 32 * g); C1_ST(gt + 10240 + 4 * 512 + lane * 16, pack8(cp[0], cp[1])); }
            }
        }
        }
        C1_BAR();
    }
#undef C1_LOAD
#undef C1_BAR
    __syncthreads();
}
#define C2_BAR() do { asm volatile("s_waitcnt lgkmcnt(0)" ::: "memory"); __builtin_amdgcn_s_barrier(); asm volatile("" ::: "memory"); } while (0)
constexpr int C2_SLOT = 16384, C2_YOFF = 4 * C2_SLOT;
template <int MODE>
__device__ __forceinline__ void phase_scan_c2(Frame& F, int l) {
    LAUNDER(F);
    if (F.vcu >= 128) { if (MODE == 0) phase_mix_na(F, l, F.vcu - 128, 128); return; }
    const GAS bf16* proj = (const GAS bf16*)(F.ws + WS_PROJ);
    const int lane = F.lane, i = lane & 15, g = lane >> 4;
    LAS unsigned char* lds = F.lds;
    if (F.vcu < 128) {
    const int ci = F.vcu >> 1, tp = F.vcu & 1, d = ci >> 5, bb = (ci >> 2) & 7, h = ci & 3;
    for (int q = F.tid; q < 4 * 5 * 32; q += NTHREADS) { const int sl = q / 160, r = q % 160; *(LAS v4u*)(lds + sl * C2_SLOT + 10240 + (r >> 5) * 1024 + 512 + (r & 31) * 16) = (v4u){0u, 0u, 0u, 0u}; }
    __syncthreads();
    if (F.wave < 2) {
        const int cw = F.wave;
        f32x4 st[4];
#pragma unroll
        for (int t = 0; t < 4; ++t) st[t] = (f32x4){0.f, 0.f, 0.f, 0.f};
        v4u af[15], vf, nf[15], nvf;
#define C2_RD(AF, VF, c_) do { const LAS unsigned char* p_ = lds + ((c_) & 3) * C2_SLOT + lane * 16; \
            _Pragma("unroll") for (int f_ = 0; f_ < 15; ++f_) AF[f_] = *(const LAS v4u*)(p_ + f_ * 1024); \
            VF = *(const LAS v4u*)(lds + ((c_) & 3) * C2_SLOT + 15360 + cw * 512 + i * 32 + (g & 1) * 16); } while (0)
#define C2_STEP(AF, VF, NF, NVF, n_) do { \
            if ((n_) + 1 < 256) C2_RD(NF, NVF, (n_) + 1); \
            const bf16x8 b0_ = pack8(st[0], st[1]), b1_ = pack8(st[2], st[3]); const v4u vz_ = (g < 2) ? VF : (v4u){0u, 0u, 0u, 0u}; const bf16x8 bv_ = __builtin_bit_cast(bf16x8, vz_); \
            f32x4 o_[5]; \
            _Pragma("unroll") for (int nt = 0; nt < 5; ++nt) { if (MODE >= 2) { o_[nt] = __builtin_bit_cast(f32x4, AF[nt]) + __builtin_bit_cast(f32x4, AF[10 + nt]) * st[nt & 3]; continue; } \
                f32x4 a_ = __builtin_amdgcn_mfma_f32_16x16x32_bf16(__builtin_bit_cast(bf16x8, AF[nt * 2]), b0_, (f32x4){0.f, 0.f, 0.f, 0.f}, 0, 0, 0); \
                a_ = __builtin_amdgcn_mfma_f32_16x16x32_bf16(__builtin_bit_cast(bf16x8, AF[nt * 2 + 1]), b1_, a_, 0, 0, 0); \
                o_[nt] = __builtin_amdgcn_mfma_f32_16x16x32_bf16(__builtin_bit_cast(bf16x8, AF[10 + nt]), bv_, a_, 0, 0, 0); } \
            _Pragma("unroll") for (int t = 0; t < 4; ++t) st[t] = o_[t]; \
            { v2u yw_; yw_.x = pk2(o_[4].x, o_[4].y); yw_.y = pk2(o_[4].z, o_[4].w); \
              *(LAS v2u*)(lds + C2_YOFF + (cw * 8 + ((n_) & 7)) * 512 + i * 32 + g * 8) = yw_; }     \
            } while (0)
        C2_BAR();
        C2_RD(af, vf, 0);
        for (int n = 0; n < 256; n += 2) { C2_STEP(af, vf, nf, nvf, n); C2_STEP(nf, nvf, af, vf, n + 1); C2_BAR(); }
        C2_BAR();
#undef C2_STEP
#undef C2_RD
    } else {
        const int hl = F.tid - 128;
        const GAS unsigned char* gt = (d ? (const GAS unsigned char*)F.out : F.ws + WS_GT0) + ((size_t)(bb * 4 + h) * 256) * GT_CHUNK;
        GAS bf16* ysc = (GAS bf16*)(d ? (GAS unsigned char*)F.out + GT_DIR : F.ws + WS_YSC0) + (size_t)bb * T * 256 + h * 64 + 32 * tp;
        const int p0 = hl, p1 = hl + 384, p2 = hl + 768; const bool has2 = p2 < 800;
#define C2_OFF(p_) ((p_) < 640 ? (p_) * 16 : 10240 + (((p_) - 640) >> 5) * 1024 + (((p_) - 640) & 31) * 16)
        const int o0 = C2_OFF(p0), o1 = C2_OFF(p1), o2 = C2_OFF(has2 ? p2 : 799);
        const int e0 = hl, e1 = hl + 384; const bool hasv1 = e1 < 512;
        const GAS bf16* vs0 = proj + (size_t)bb * T * NPROJP + C_V + h * 64 + 32 * tp + 16 * (e0 >> 8) + (e0 & 15);
        const GAS bf16* vs1 = proj + (size_t)bb * T * NPROJP + C_V + h * 64 + 32 * tp + 16 * ((hasv1 ? e1 : 0) >> 8) + (e1 & 15);
        const int vt0 = (e0 >> 4) & 15, vt1 = (e1 >> 4) & 15;
        const int vo0 = 15360 + (e0 >> 8) * 512 + (e0 & 15) * 32 + vt0 * 2, vo1 = 15360 + ((hasv1 ? e1 : 0) >> 8) * 512 + (e1 & 15) * 32 + vt1 * 2;
        constexpr int RD = 12;
        v4u r0[RD], r1[RD], r2[RD]; unsigned short rv0[RD], rv1[RD];
        if (MODE == 1 || MODE == 3) {
#pragma unroll
            for (int k = 0; k < RD; ++k) { r0[k] = (v4u){1u, 2u, 3u, 4u}; r1[k] = r0[k]; r2[k] = r0[k]; rv0[k] = 0; rv1[k] = 0; } }
#define C2_GLD(k_, n_) do { if (MODE == 1 || MODE == 3) break; const GAS unsigned char* c_ = gt + (size_t)(n_) * GT_CHUNK; r0[k_] = *(const GAS v4u*)(c_ + p0 * 16); r1[k_] = *(const GAS v4u*)(c_ + p1 * 16); \
            if (has2) r2[k_] = *(const GAS v4u*)(c_ + p2 * 16); \
            { const int gs_ = 16 * (n_) + vt0, t_ = d ? (T - 1 - gs_) : gs_; rv0[k_] = vs0[(size_t)t_ * NPROJP]; } \
            if (hasv1) { const int gs_ = 16 * (n_) + vt1, t_ = d ? (T - 1 - gs_) : gs_; rv1[k_] = vs1[(size_t)t_ * NPROJP]; } } while (0)
#define C2_WR(k_, n_) do { LAS unsigned char* p_ = lds + ((n_) & 3) * C2_SLOT; *(LAS v4u*)(p_ + o0) = r0[k_]; *(LAS v4u*)(p_ + o1) = r1[k_]; if (has2) *(LAS v4u*)(p_ + o2) = r2[k_]; \
            *(LAS unsigned short*)(p_ + vo0) = rv0[k_]; if (hasv1) *(LAS unsigned short*)(p_ + vo1) = rv1[k_]; } while (0)
#define C2_YST(m_) do { if (hl < 64) { const int cw_ = hl >> 5, s_ = (hl >> 1) & 15, hf_ = hl & 1; const LAS unsigned short* yp_ = (const LAS unsigned short*)(lds + C2_YOFF + (cw_ * 8 + ((m_) & 7)) * 512) + s_; \
            v4u w_; _Pragma("unroll") for (int e_ = 0; e_ < 4; ++e_) w_[e_] = (unsigned)yp_[(8 * hf_ + 2 * e_) * 16] | ((unsigned)yp_[(8 * hf_ + 2 * e_ + 1) * 16] << 16); \
            const int gs_ = 16 * (m_) + s_, t_ = d ? (T - 1 - gs_) : gs_; if (MODE == 0) *(GAS v4u*)(ysc + (size_t)t_ * 256 + 16 * cw_ + 8 * hf_) = w_; else asm volatile("" :: "v"(w_)); } } while (0)
#pragma unroll
        for (int k = 0; k < RD; ++k) C2_GLD(k, k);
        C2_WR(0, 0); C2_GLD(0, RD); C2_WR(1, 1); C2_GLD(1, RD + 1); C2_WR(2, 2); C2_GLD(2, RD + 2);
        C2_BAR();
        for (int m6 = 0; m6 < 128; m6 += RD / 2) {
#pragma unroll
            for (int k = 0; k < RD / 2; ++k) { const int m = m6 + k;
                if (m < 128) {
                    const int ca = 2 * m + 3, cb = 2 * m + 4, ka = (2 * k + 3) % RD, kb = (2 * k + 4) % RD;
                    if (ca < 256) { C2_WR(ka, ca); if (ca + RD < 256) C2_GLD(ka, ca + RD); }
                    if (cb < 256) { C2_WR(kb, cb); if (cb + RD < 256) C2_GLD(kb, cb + RD); }
                    if (m > 0) { C2_YST(2 * m - 2); C2_YST(2 * m - 1); }
                    C2_BAR(); } }
        }
        C2_YST(254); C2_YST(255);
        C2_BAR();
#undef C2_GLD
#undef C2_WR
#undef C2_YST
#undef C2_OFF
    }
    }
    __syncthreads();
}
#undef C2_BAR
#undef CK_DOT
#undef CK_RED2

__device__ __forceinline__ void phase_rwkv_post(Frame& F, int l) {
    LAUNDER(F);
    const GAS bf16* proj = (const GAS bf16*)(F.ws + WS_PROJ); GAS bf16* merged = (GAS bf16*)(F.ws + WS_MERGED); const GAS bf16* ysc0 = (const GAS bf16*)(F.ws + WS_YSC0); const GAS bf16* ysc1 = (const GAS bf16*)((const GAS unsigned char*)F.out + GT_DIR);
    const int lane = F.lane, c4 = 4 * lane, i = lane & 15, g = lane >> 4;
    bf16x8 Bg[16];
    {   LAS bf16x8* GB = (LAS bf16x8*)F.lds;
        for (int q = F.tid; q < 1024; q += NTHREADS) { const int ct = q >> 6, ln = q & 63; const GAS float* gp = INP(F, I_RGUP) + ((size_t)l * 32 + 8 * (ln >> 4)) * 256 + 16 * ct + (ln & 15);
            GB[q] = pack8((f32x4){gp[0], gp[256], gp[512], gp[768]}, (f32x4){gp[1024], gp[1280], gp[1536], gp[1792]}); }
        __syncthreads();
#pragma unroll
        for (int ct = 0; ct < 16; ++ct) Bg[ct] = GB[ct * 64 + lane];
        __syncthreads(); }
    LAS float* GL = (LAS float*)(F.lds + F.wave * 16384);
    const f32x4 lw = *(const f32x4*)(INP(F, I_LNXW) + l * 256 + c4), lb = *(const f32x4*)(INP(F, I_LNXB) + l * 256 + c4), rk = *(const f32x4*)(INP(F, I_RRK) + l * 256 + c4);
    const int mstep = F.G * NWAVES;
    for (int m0 = F.vcu * NWAVES + F.wave; m0 < M; m0 += 16 * mstep) {
        v2u n_yf[4], n_yb[4], n_r[4], n_k[4], n_v[4];
#define POST_LOAD4(tb_) do { _Pragma("unroll") for (int q_ = 0; q_ < 4; ++q_) { const size_t mm_ = (size_t)(m0 + ((tb_) + q_) * mstep); const GAS bf16* row_ = proj + mm_ * NPROJP; \
        n_yf[q_] = *(const GAS v2u*)(ysc0 + mm_ * 256 + c4); n_yb[q_] = *(const GAS v2u*)(ysc1 + mm_ * 256 + c4); \
        n_r[q_] = *(const GAS v2u*)(row_ + C_R + c4); n_k[q_] = *(const GAS v2u*)(row_ + C_K + c4); n_v[q_] = *(const GAS v2u*)(row_ + C_V + c4); } } while (0)
        POST_LOAD4(0);
        {   const v4u raw = *(const GAS v4u*)(proj + (size_t)(m0 + i * mstep) * NPROJP + C_GDN + 8 * g);
            const bf16x8 Af = pack8((f32x4){sigmoidf_(bflo(raw.x)), sigmoidf_(bfhi(raw.x)), sigmoidf_(bflo(raw.y)), sigmoidf_(bfhi(raw.y))}, (f32x4){sigmoidf_(bflo(raw.z)), sigmoidf_(bfhi(raw.z)), sigmoidf_(bflo(raw.w)), sigmoidf_(bfhi(raw.w))});
            CFENCE();
#pragma unroll
            for (int ct = 0; ct < 16; ++ct) { const f32x4 a = __builtin_amdgcn_mfma_f32_16x16x32_bf16(Af, Bg[ct], (f32x4){0.f, 0.f, 0.f, 0.f}, 0, 0, 0);
#pragma unroll
                for (int e = 0; e < 4; ++e) GL[(4 * g + e) * 256 + 16 * ct + i] = a[e]; }
            LDS_WAIT(); CFENCE(); }
        for (int tb = 0; tb < 16; tb += 4) {
            v2u c_yf[4], c_yb[4], c_r[4], c_k[4], c_v[4];
#pragma unroll
            for (int q = 0; q < 4; ++q) { c_yf[q] = n_yf[q]; c_yb[q] = n_yb[q]; c_r[q] = n_r[q]; c_k[q] = n_k[q]; c_v[q] = n_v[q]; }
            if (tb + 4 < 16) POST_LOAD4(tb + 4);
#pragma unroll
            for (int q = 0; q < 4; ++q) { const int t = tb + q, m = m0 + t * mstep;
                const v2u yf = c_yf[q], yb = c_yb[q], ru = c_r[q], ku = c_k[q], vu = c_v[q];
                f32x4 y = (f32x4){bflo(yf.x) + bflo(yb.x), bfhi(yf.x) + bfhi(yb.x), bflo(yf.y) + bflo(yb.y), bfhi(yf.y) + bfhi(yb.y)};
                const float mu = row16_sum((y.x + y.y) + (y.z + y.w)) * (1.f / 64.f);
                y = y - mu;
                const float var = row16_sum((y.x * y.x + y.y * y.y) + (y.z * y.z + y.w * y.w)) * (1.f / 64.f);
                const float rstd = rsqf_(var + GN_EPS);
                y = y * rstd * lw + lb;
                const f32x4 r = (f32x4){bflo(ru.x), bfhi(ru.x), bflo(ru.y), bfhi(ru.y)}, k = (f32x4){bflo(ku.x), bfhi(ku.x), bflo(ku.y), bfhi(ku.y)}, v = (f32x4){bflo(vu.x), bfhi(vu.x), bflo(vu.y), bfhi(vu.y)};
                const f32x4 rkk = r * k * rk;
                const float bsum = row16_sum((rkk.x + rkk.y) + (rkk.z + rkk.w));
                y = y + v * bsum;
                y = y * *(const LAS f32x4*)(GL + t * 256 + c4);
                const float ss = wave_sum((y.x * y.x + y.y * y.y) + (y.z * y.z + y.w * y.w));
                const float sc = rsqf_(ss * (1.f / 256.f) + NORM_EPS);
                v2u o; o.x = pk2(y.x * sc, y.y * sc); o.y = pk2(y.z * sc, y.w * sc);
                *(GAS v2u*)(merged + (size_t)m * DM + 256 + c4) = o; } }
        CFENCE();
    }
#undef POST_LOAD4
}

__device__ __forceinline__ void phase_residual(Frame& F, const GAS float* gain, const bool IN_F32, const bool LAST) {
    LAUNDER(F);
    const GAS bf16* y = (const GAS bf16*)(F.ws + WS_Y); const GAS float* part = (const GAS float*)(F.ws + WS_PART);
    GAS bf16* xb = (GAS bf16*)(F.ws + WS_XB); GAS float* rs = (GAS float*)(F.ws + WS_RS); const GAS float* xin = INP(F, I_X);
    const int lane = F.lane;
    f32x4 gv[4];
#pragma unroll
    for (int j = 0; j < 4; ++j) gv[j] = *((const f32x4*)gain + lane + 64 * j);
    for (int m = F.vcu * NWAVES + F.wave; m < M; m += F.G * NWAVES) {
        const f32x4* pp = (const f32x4*)(part + (size_t)m * 16);
        const f32x4 p0 = *(const GAS f32x4*)(pp), p1 = *(const GAS f32x4*)(pp + 1), p2 = *(const GAS f32x4*)(pp + 2), p3 = *(const GAS f32x4*)(pp + 3);
        const float tot = ((p0.x + p0.y) + (p0.z + p0.w)) + ((p1.x + p1.y) + (p1.z + p1.w)) + ((p2.x + p2.y) + (p2.z + p2.w)) + ((p3.x + p3.y) + (p3.z + p3.w));
        const float sc = rsqf_(tot * (1.f / DM) + NORM_EPS);
        const GAS v2u* yr = (const GAS v2u*)(y + (size_t)m * DM) + lane;
        f32x4 v[4]; float s = 0.f;
#pragma unroll
        for (int j = 0; j < 4; ++j) { const v2u yu = yr[64 * j]; const f32x4 yv = (f32x4){bflo(yu.x), bfhi(yu.x), bflo(yu.y), bfhi(yu.y)};
            f32x4 xv;
            if (IN_F32) xv = ((const GAS f32x4*)(xin + (size_t)m * DM) + lane)[64 * j];
            else { const v2u xu = ((const GAS v2u*)(xb + (size_t)m * DM) + lane)[64 * j]; xv = (f32x4){bflo(xu.x), bfhi(xu.x), bflo(xu.y), bfhi(xu.y)}; }
            v[j] = xv + yv * sc * gv[j]; s += (v[j].x * v[j].x + v[j].y * v[j].y) + (v[j].z * v[j].z + v[j].w * v[j].w); }
        if (LAST) {
            GAS f32x4* orow = (GAS f32x4*)(F.out + (size_t)m * DM) + lane;
#pragma unroll
            for (int j = 0; j < 4; ++j) orow[64 * j] = v[j];
        } else {
            s = wave_sum(s);
            GAS v2u* o8 = (GAS v2u*)(xb + (size_t)m * DM) + lane;
#pragma unroll
            for (int j = 0; j < 4; ++j) { v2u o; o.x = pk2(v[j].x, v[j].y); o.y = pk2(v[j].z, v[j].w); o8[64 * j] = o; }
            if (lane == 0) rs[m] = rsqf_(s * (1.f / DM) + NORM_EPS);
        }
    }
}
__device__ __forceinline__ void phase_ffn_conv(Frame& F, int l) {
    LAUNDER(F);
    const GAS bf16* G = (const GAS bf16*)(F.ws + WS_G); GAS bf16* L = (GAS bf16*)(F.ws + WS_L);
    const GAS float* cw = INP(F, I_FCONV) + (size_t)l * 3 * DFF;
    constexpr int CPR = DFF / 8;
    const int nitems = (M / 256) * 2 * CPR;
    for (int it = F.vcu * NTHREADS + F.tid; it < nitems; it += F.G * NTHREADS) {
        const int ck = it % CPR, rr = it / CPR, m = (rr >> 1) * 256 + ((rr & 1) ? 255 : 0), t = m % T, c8 = 8 * ck;
        float w0[8], w1[8], w2[8];
#pragma unroll
        for (int j = 0; j < 8; ++j) { w0[j] = cw[c8 + j]; w1[j] = cw[DFF + c8 + j]; w2[j] = cw[2 * DFF + c8 + j]; }
        const v4u z = (v4u){0u, 0u, 0u, 0u};
        const v4u gp = (t > 0) ? *(const GAS v4u*)(G + (size_t)(m - 1) * DFF + c8) : z, gc = *(const GAS v4u*)(G + (size_t)m * DFF + c8), gn = (t < T - 1) ? *(const GAS v4u*)(G + (size_t)(m + 1) * DFF + c8) : z;
        const v4u lv = *(const GAS v4u*)(L + (size_t)m * DFF + c8);
        v4u o;
#pragma unroll
        for (int q = 0; q < 4; ++q) {
            const float a0 = w0[2 * q] * bflo(gp[q]) + w1[2 * q] * bflo(gc[q]) + w2[2 * q] * bflo(gn[q]);
            const float a1 = w0[2 * q + 1] * bfhi(gp[q]) + w1[2 * q + 1] * bfhi(gc[q]) + w2[2 * q + 1] * bfhi(gn[q]);
            o[q] = pk2(gelu_tanh(a0) * bflo(lv[q]), gelu_tanh(a1) * bfhi(lv[q])); }
        *(GAS v4u*)(L + (size_t)m * DFF + c8) = o;
    }
}

#ifndef MK_N_LAUNCHES
#define MK_N_LAUNCHES 1
#endif
constexpr int NPH = 1 + 8 * DEPTH;
struct Args { const float* in[26]; float* out; unsigned char* ws; int ph_lo, ph_hi; };
__global__ void __launch_bounds__(NTHREADS, 2) enc_fwd(Args args) {
    extern __shared__ __attribute__((aligned(16))) unsigned char lds_raw[];
    Frame F;
    F.lds = (LAS unsigned char*)lds_raw;
    F.MISC = (volatile LAS unsigned*)(F.lds + MISC_OFF);
    F.tid = threadIdx.x; F.lane = F.tid & 63; F.wave = __builtin_amdgcn_readfirstlane(F.tid >> 6);
    F.G = gridDim.x; { const int bx = blockIdx.x; F.vcu = (F.G % 8 == 0) ? (bx % 8) * (F.G / 8) + bx / 8 : bx; }
    F.ws = (GAS unsigned char*)args.ws; F.out = (GAS float*)args.out; F.ctl = (gu32*)(F.ws + WS_CTL);
    F.karg = (kq_t*)__builtin_amdgcn_kernarg_segment_ptr();
    for (int u = F.tid; u < LDS_BYTES / 16; u += NTHREADS) ((LAS v4u*)F.lds)[u] = (v4u){0u, 0u, 0u, 0u};
    __syncthreads();
    const int lo = args.ph_lo, hi = args.ph_hi;
    if (hi - lo > 1) (void)xcd_barrier_post((unsigned*)(F.ctl + CW_BAR), F.MISC + 8);
#define GRID_BAR() do { XcdBarrier bar_; bar_.bar = (unsigned*)(F.ctl + CW_BAR); bar_.x = xb_xcc_id(); bar_.st = F.MISC + 8; xcd_barrier(bar_); } while (0)
#ifndef PH_ENABLE
#define PH_ENABLE 0x7ff
#endif
#define IN(k) (lo <= (k) && (k) < hi)
#define EN(t) (((PH_ENABLE) >> (t)) & 1)
#pragma unroll 1
#ifdef REPEAT_T
    for (int step = lo; step < hi; ++step) {
        const int p1 = REPEAT_T, p2 = REPEAT_T + 8;
        const int ph = step - (step > p1 ? 1 : 0) - ((step > p2 + 1 && REPEAT_T != 7) ? 1 : 0);
#else
    for (int ph = lo; ph < hi; ++ph) {
#endif
        LAUNDER(F);
        const int l = ph == 0 ? 0 : (ph - 1) / 8, tt = ph == 0 ? 0 : 1 + (ph - 1) % 8;
        const int t = tt == 0 ? 0 : (tt == 1 ? 1 : (tt <= 5 ? tt + 1 : tt + 2));
        GAS unsigned char* wl = F.ws + WS_W + (size_t)l * W_LAYER;
      {
        if (t == 1 || t == 8) {
            pg8::Gemm g; pg8::EpiUni E;
            g.M = M; E.split_cols = 0; E.split_stride = 0; E.convw = nullptr; E.G = nullptr; E.xl = (pg8::PG8_LAS_T*)(F.lds + RING_BYTES + 1024); E.part = nullptr; E.rs = (const GAS float*)(F.ws + WS_RS);
            g.A = (const GAS bf16*)(F.ws + WS_XB); g.K = DM;
            if (t == 1) { g.Bt = (const GAS bf16*)(wl + W_IN); g.N = NPROJP; E.O = (GAS bf16*)(F.ws + WS_PROJ); E.ldc = NPROJP; }
            else        { g.Bt = (const GAS bf16*)(wl + W_UP); g.N = NUP;    E.O = (GAS bf16*)(F.ws + WS_L); E.ldc = DFF; E.convw = INP(F, I_FCONV) + (size_t)l * 3 * DFF; E.G = (GAS bf16*)(F.ws + WS_G); }
            g.Bt = launder_p(g.Bt); E.O = launder_p(E.O); E.convw = launder_p(E.convw); E.G = launder_p(E.G); g.N = launder_u(g.N); E.ldc = launder_u(E.ldc);
            g.A = launder_p(g.A); E.rs = launder_p(E.rs);
            pg8::StaticOrder S; S.init(M, g.N, F.G, (int)blockIdx.x);
            pg8::gemm_phase<pg8::EpiUni, pg8::StaticOrder, true, true>(F.lds, g, S, E);
        }
        else if (t == 6 || t == 10) {
            pg8::Gemm g; pg8::EpiResid E;
            g.M = M; g.N = DM; E.xl = (pg8::PG8_LAS_T*)(F.lds + RING_BYTES + 1024);
            E.xb = (GAS bf16*)(F.ws + WS_XB); E.outf = F.out; E.rsw = (GAS float*)(F.ws + WS_RS); E.xs = (GAS float*)(F.ws + WS_XS); E.resid = 1;
            if (t == 6) { g.A = (const GAS bf16*)(F.ws + WS_MERGED); g.Bt = (const GAS bf16*)(wl + W_OUT); g.K = DM;  E.gain = INP(F, I_NMPOST) + l * DM; E.cnt = (GAS unsigned*)(F.ctl + CW_PANEL) + (size_t)(l * 2 + 0) * 2 * 128 * 64; }
            else        { g.A = (const GAS bf16*)(F.ws + WS_L);      g.Bt = (const GAS bf16*)(wl + W_DN);  g.K = DFF; E.gain = INP(F, I_NFPOST) + l * DM; if (l + 1 == DEPTH) E.resid = 2; E.cnt = (GAS unsigned*)(F.ctl + CW_PANEL) + (size_t)(l * 2 + 1) * 2 * 128 * 64; }
            g.A = launder_p(g.A); g.Bt = launder_p(g.Bt); g.K = launder_u(g.K); E.gain = launder_p(E.gain); E.cnt = launder_p(E.cnt); E.resid = launder_u(E.resid);
            E.xb = launder_p(E.xb); E.outf = launder_p(E.outf); E.rsw = launder_p(E.rsw); E.xs = launder_p(E.xs);
            pg8::StaticOrder S; S.init(M, g.N, F.G, (int)blockIdx.x);
            pg8::gemm_phase<pg8::EpiResid, pg8::StaticOrder, true, true>(F.lds, g, S, E);
        }
        else if (t == 0) p0_prologue(F);
#ifdef C1_EXP
        else if (t == 3) { phase_mixers(F, l); phase_scan_c1<0>(F, l); phase_scan_c1<C1_EXP>(F, l); }
#else
        else if (t == 3) { phase_mixers(F, l); phase_scan_c1<0>(F, l); }
#endif
#ifdef C2_EXP
        else if (t == 4) { phase_scan_c2<0>(F, l); phase_scan_c2<C2_EXP>(F, l); }
#else
        else if (t == 4) phase_scan_c2<0>(F, l);
#endif
        else if (t == 5) phase_rwkv_post(F, l);
        else if (t == 9) phase_ffn_conv(F, l);
      }
#ifdef REPEAT_T
        if (step + 1 < hi) GRID_BAR();
#else
        if (ph + 1 < hi) GRID_BAR();
#endif
    }
    asm volatile("s_waitcnt vmcnt(0) lgkmcnt(0)" ::: "memory");
}


#ifdef DBG_CHECK
__global__ void dbg_check(const void* buf, size_t n, int kind, int code, unsigned* flag) {
    bool bad = false;
    for (size_t i = (size_t)blockIdx.x * blockDim.x + threadIdx.x; i < n; i += (size_t)gridDim.x * blockDim.x) {
        float v;
        if (kind == 0) v = bf2f(((const unsigned short*)buf)[i]);
        else if (kind == 1) v = ((const float*)buf)[i];
        else v = (float)((const _Float16*)buf)[i];
        if (!(fabsf(v) < 1e30f)) bad = true;
    }
    if (bad) atomicMax(flag, (unsigned)(1000000 - code));
}
__global__ void dbg_report(float* out, const unsigned* flag) { if (threadIdx.x == 0 && blockIdx.x == 0) { const unsigned f = *flag; if (f) out[0] = 100000.f * (float)(10 + 1000000 - (int)f); } }
#endif
extern "C" void kernel_launch(void* const* d_in, const int* in_sizes, int n_in, void* d_out, int out_size, void* d_ws, size_t ws_size, hipStream_t stream) {
    static int grid = 0;
    if (grid == 0) {
        if (n_in != 26 || in_sizes[0] != M * DM || out_size != M * DM || ws_size < WS_END) { fprintf(stderr, "kernel_launch: unexpected shapes: n_in %d in0 %d out %d ws %zu (need >= %zu)\n", n_in, n_in > 0 ? in_sizes[0] : -1, out_size, ws_size, (size_t)WS_END); grid = -1; return; }
        int dev = 0, cus = 0, per_cu = 0;
        if (hipGetDevice(&dev) != hipSuccess || hipDeviceGetAttribute(&cus, hipDeviceAttributeMultiprocessorCount, dev) != hipSuccess) { grid = -1; return; }
        if (hipFuncSetAttribute((const void*)enc_fwd, hipFuncAttributeMaxDynamicSharedMemorySize, LDS_BYTES) != hipSuccess) { fprintf(stderr, "kernel_launch: hipFuncSetAttribute failed\n"); grid = -1; return; }
        if (hipOccupancyMaxActiveBlocksPerMultiprocessor(&per_cu, (const void*)enc_fwd, NTHREADS, LDS_BYTES) != hipSuccess || per_cu < 1) { fprintf(stderr, "kernel_launch: occupancy query says %d blocks per CU\n", per_cu); }
        (void)hipGetLastError();
        grid = cus;
        if (grid != 256) fprintf(stderr, "kernel_launch: %d CUs (built for 256)\n", grid);
    }
    if (grid < 0) return;
    (void)hipMemsetAsync((char*)d_ws + WS_CTL, 0, CTL_ZERO_BYTES, stream);
    Args a{};
    for (int i = 0; i < 26; ++i) a.in[i] = (const float*)d_in[i];
    a.out = (float*)d_out; a.ws = (unsigned char*)d_ws;
#if MK_N_LAUNCHES == 1
#ifdef REPEAT_T
    a.ph_lo = 0; a.ph_hi = NPH + (REPEAT_T == 7 ? 1 : 2);
#else
    a.ph_lo = 0; a.ph_hi = NPH;
#endif
    hipLaunchKernelGGL(enc_fwd, dim3(grid), dim3(NTHREADS), LDS_BYTES, stream, a);
#else
    for (int p = 0; p < NPH; ++p) { a.ph_lo = p; a.ph_hi = p + 1; hipLaunchKernelGGL(enc_fwd, dim3(grid), dim3(NTHREADS), LDS_BYTES, stream, a);
#ifdef DBG_CHECK
        unsigned* flag = (unsigned*)((char*)d_ws + 512 * 1024); char* ws = (char*)d_ws; const int t = p == 0 ? 0 : 1 + (p - 1) % 10;
#define CHK(ptr, n, kind, sub) hipLaunchKernelGGL(dbg_check, dim3(2048), dim3(256), 0, stream, (const void*)(ptr), (size_t)(n), kind, p * 4 + sub, flag)
        if (t == 0) { CHK(ws + WS_W, 2 * W_LAYER / 2, 0, 0); CHK(ws + WS_XB, (size_t)M * DM, 0, 1); CHK(ws + WS_RS, M, 1, 2); }
        if (t == 1) { CHK(ws + WS_PROJ, (size_t)M * NPROJP, 0, 0); }
        if (t == 2) { CHK(ws + WS_PREP, (size_t)64 * MiB, 2, 1); }
        if (t == 3) { CHK(d_out, (size_t)2 * M * 256, 0, 0); }
        if (t == 4) { CHK(ws + WS_MERGED, (size_t)M * DM, 0, 0); }
        if (t == 5 || t == 9) { CHK(ws + WS_Y, (size_t)M * DM, 1, 0); CHK(ws + WS_PART, (size_t)M * 16, 1, 1); }
        if (t == 6 || t == 10) { CHK(d_out, (size_t)M * DM, 1, 0); CHK(ws + WS_XB, (size_t)M * DM, 0, 1); CHK(ws + WS_RS, M, 1, 2); }
        if (t == 7) { CHK(ws + WS_G, (size_t)M * DFF, 0, 0); CHK(ws + WS_L, (size_t)M * DFF, 0, 1); }
        if (t == 8) { CHK(ws + WS_L, (size_t)M * DFF, 0, 0); }
        if (p == NPH - 1) hipLaunchKernelGGL(dbg_report, dim3(1), dim3(64), 0, stream, (float*)d_out, (const unsigned*)flag);
#endif
    }
#endif
}
```

```cpp
#include <hip/hip_runtime.h>
#include <cstdio>
#include <cstdint>
namespace pg8 {
#define PG8_LAS __attribute__((address_space(3)))
#define PG8_GAS __attribute__((address_space(1)))
typedef PG8_LAS unsigned char PG8_LAS_T;
typedef unsigned short bf16_t;
typedef short bf16x8 __attribute__((ext_vector_type(8)));
typedef float f32x4 __attribute__((ext_vector_type(4)));
typedef unsigned u32x4 __attribute__((ext_vector_type(4)));
constexpr int BM = 256, BK = 64, HALF = 128, HTB = HALF * BK * 2  , STAGE_BYTES = 8 * HTB, NXCD = 8, WGM = 4;

__host__ __device__ __forceinline__ int lds_byte(int r, int c) { const int st = (r >> 4) * 2 + (c >> 5), rr = r & 15, cc = c & 31, ob = rr * 64 + cc * 2; return st * 1024 + (ob ^ (((ob >> 9) & 1) << 5)); }
__host__ __device__ __forceinline__ void stage_rc(int b, int& R, int& C) { const int st = b / 1024, sb = b % 1024, swz = sb ^ (((sb >> 9) & 1) << 5); R = (st >> 1) * 16 + swz / 64; C = (st & 1) * 32 + (swz % 64) / 2; }
__host__ __device__ __forceinline__ int perm32(int rho) { const int n = rho >> 4, i = rho & 15; return 8 * (i >> 2) + 4 * n + (i & 3); }

struct Unit { int pm, pn; };
struct Gemm { const PG8_GAS bf16_t* A; const PG8_GAS bf16_t* Bt; int M, N, K; };

struct StaticOrder {
    int nM, nN, nwg, G, c;
    __host__ __device__ void init(int M, int N, int G_, int c_) { nM = M / BM; nN = N / BM; nwg = nM * nN; G = G_; c = c_; }
    __host__ __device__ bool next(int i, Unit& u) const {
        const long L = (long)i * G + c; if (L >= nwg) return false;
        int wgid = (int)L; { const int q = nwg / NXCD, r = nwg % NXCD, xcd = wgid % NXCD, off = wgid / NXCD; wgid = (xcd < r ? xcd * (q + 1) : r * (q + 1) + (xcd - r) * q) + off; }
        const int nig = WGM * nN, gid = wgid / nig, fm = gid * WGM, gsz = (nM - fm) < WGM ? (nM - fm) : WGM;
        u.pm = fm + ((wgid % nig) % gsz); u.pn = (wgid % nig) / gsz; return true;
    }
    __device__ __forceinline__ void a_ready(const Unit&) const {}
    __device__ __forceinline__ void done(const Unit&) const {}
};
typedef float f32x2c __attribute__((ext_vector_type(2)));
typedef __bf16 bf16x2c __attribute__((ext_vector_type(2)));
__device__ __forceinline__ unsigned cvt_pk_bf16(float lo, float hi) { const f32x2c v = {lo, hi}; return __builtin_bit_cast(unsigned, __builtin_convertvector(v, bf16x2c)); }
struct EpiUni {
    static constexpr bool AFTER_DRAIN = false;
    PG8_GAS bf16_t* O; int ldc; const PG8_GAS float* rs; int split_cols; size_t split_stride; PG8_GAS float* part;
    const PG8_GAS float* convw; PG8_GAS bf16_t* G; PG8_LAS unsigned char* xl;
    __device__ __forceinline__ bool perm() const { return true; }
    template <int CTRL> static __device__ __forceinline__ float dppo(float old, float x) { return __builtin_bit_cast(float, __builtin_amdgcn_update_dpp(__builtin_bit_cast(int, old), __builtin_bit_cast(int, x), CTRL, 0xF, 0xF, false)); }
    static __device__ __forceinline__ float gelu_t(float x) { const float u = 1.5957691216057308f * x * (1.f + 0.044715f * x * x); return x * __builtin_amdgcn_rcpf(1.f + __expf(-u)); }
    __device__ __forceinline__ void conv_epi(const f32x4 (&acc_)[2][2][4][2], const Unit& u, int wr, int wc, int fr, int fq) const {
        f32x4 (&acc)[2][2][4][2] = const_cast<f32x4 (&)[2][2][4][2]>(acc_);
        const int hcol = u.pn * HALF + wc * 32 + 8 * fq;
        const PG8_GAS float* rsp = rs + u.pm * BM + wr * 64 + fr;
        constexpr int LDH = 2816;
        const unsigned lane_off = (unsigned)((wr * 64 + fr) * LDH + hcol) * 2u;
        PG8_GAS char* Ob = (PG8_GAS char*)(O + (size_t)u.pm * BM * LDH); PG8_GAS char* Gb = (PG8_GAS char*)(G + (size_t)u.pm * BM * LDH);
        unsigned lp[2][4][2][2];
#pragma unroll
        for (int ai = 0; ai < 2; ++ai)
#pragma unroll
            for (int m = 0; m < 4; ++m) { const float r = rsp[ai * HALF + m * 16];
#pragma unroll
                for (int n = 0; n < 2; ++n) { const f32x4 l4 = acc[ai][1][m][n] * r; lp[ai][m][n][0] = cvt_pk_bf16(l4[0], l4[1]); lp[ai][m][n][1] = cvt_pk_bf16(l4[2], l4[3]); } }
#pragma unroll
        for (int ai = 0; ai < 2; ++ai) { const int k = 2 * ai + wr;
            if (fr == 0)  { const float r = rsp[ai * HALF]; PG8_LAS f32x4* p = (PG8_LAS f32x4*)(xl + ((k * 2 + 0) * 4 + wc) * 128 + fq * 32); p[0] = acc[ai][0][0][0] * r; p[1] = acc[ai][0][0][1] * r; }
            if (fr == 15) { const float r = rsp[ai * HALF + 48]; PG8_LAS f32x4* p = (PG8_LAS f32x4*)(xl + ((k * 2 + 1) * 4 + wc) * 128 + fq * 32); p[0] = acc[ai][0][3][0] * r; p[1] = acc[ai][0][3][1] * r; } }
        asm volatile("s_waitcnt lgkmcnt(0)" ::: "memory"); __builtin_amdgcn_s_barrier(); asm volatile("" ::: "memory");
#pragma unroll
        for (int ai = 0; ai < 2; ++ai) { const int k = 2 * ai + wr;
            float rsv[4];
#pragma unroll
            for (int m = 0; m < 4; ++m) { rsv[m] = rsp[ai * HALF + m * 16];
#pragma unroll
                for (int n = 0; n < 2; ++n) acc[ai][0][m][n] = acc[ai][0][m][n] * rsv[m]; }
            const int ku = k > 0 ? k - 1 : 0, kd = k < 3 ? k + 1 : 3;
#pragma unroll
            for (int n = 0; n < 2; ++n) {
                float w0[4], w1[4], w2[4];
#pragma unroll
                for (int j = 0; j < 4; ++j) { w0[j] = convw[hcol + 4 * n + j]; w1[j] = convw[LDH + hcol + 4 * n + j]; w2[j] = convw[2 * LDH + hcol + 4 * n + j]; }
                const f32x4 xt = *(const PG8_LAS f32x4*)(xl + ((ku * 2 + 1) * 4 + wc) * 128 + fq * 32 + n * 16), xb = *(const PG8_LAS f32x4*)(xl + ((kd * 2 + 0) * 4 + wc) * 128 + fq * 32 + n * 16);
#pragma unroll
                for (int m = 0; m < 4; ++m) { const int tr = 64 * k + 16 * m + fr; const unsigned coff = (unsigned)((ai * HALF + 16 * m) * LDH * 2 + 8 * n);
                    float hv[4];
#pragma unroll
                    for (int e = 0; e < 4; ++e) { const float cur = acc[ai][0][m][n][e];
                        const float upx = (m > 0) ? dppo<0x121>(0.f, acc[ai][0][m > 0 ? m - 1 : 0][n][e]) : xt[e];
                        const float dnx = (m < 3) ? dppo<0x12F>(0.f, acc[ai][0][m < 3 ? m + 1 : 3][n][e]) : xb[e];
                        const float up = dppo<0x111>(upx, cur), dn = dppo<0x101>(dnx, cur);
                        const float a = w0[e] * up + w1[e] * cur + w2[e] * dn;
                        const unsigned lw = lp[ai][m][n][e >> 1]; const float lv = (e & 1) ? __builtin_bit_cast(float, lw & 0xffff0000u) : __builtin_bit_cast(float, lw << 16);
                        hv[e] = (tr == 0 || tr == 255) ? lv : gelu_t(a) * lv; }
                    typedef unsigned u32x2_ __attribute__((ext_vector_type(2)));
                    u32x2_ w; w.x = cvt_pk_bf16(hv[0], hv[1]); w.y = cvt_pk_bf16(hv[2], hv[3]);
                    if (ai == 0 && m == 0 && tr == 0) *(PG8_GAS u32x2_*)(Gb + coff + lane_off + 2 * LDH * 2) = w;
                    else if (ai == 1 && m == 3 && tr == 255) *(PG8_GAS u32x2_*)(Gb + coff + lane_off - 2 * LDH * 2) = w;
                    else *(PG8_GAS u32x2_*)(Ob + coff + lane_off) = w;
                    if (tr <= 1 || tr >= 254) { u32x2_ gw; gw.x = cvt_pk_bf16(acc[ai][0][m][n][0], acc[ai][0][m][n][1]); gw.y = cvt_pk_bf16(acc[ai][0][m][n][2], acc[ai][0][m][n][3]);
                        *(PG8_GAS u32x2_*)(Gb + coff + lane_off) = gw; }
                    __builtin_amdgcn_sched_barrier(0); }
                asm volatile("" ::: "memory");
            }
        }
    }
    __device__ __forceinline__ void operator()(const f32x4 (&acc)[2][2][4][2], const Unit& u, int wr, int wc, int fr, int fq) const {
        if (convw != nullptr) { conv_epi(acc, u, wr, wc, fr, fq); return; }
        const int row0 = u.pm * BM + wr * 64 + fr; int colt = u.pn * BM; PG8_GAS bf16_t* base = O;
        if (split_cols) { const int t = colt / split_cols; base += (size_t)t * split_stride; colt -= t * split_cols; }
        const int col0 = colt + wc * 32 + 8 * fq;
        if (part == nullptr) {
#pragma unroll
            for (int ai = 0; ai < 2; ++ai)
#pragma unroll
                for (int m = 0; m < 4; ++m) { const int row = row0 + ai * HALF + m * 16; const float s = rs[row]; PG8_GAS bf16_t* rowp = base + (size_t)row * ldc + col0;
#pragma unroll
                    for (int bj = 0; bj < 2; ++bj) { const f32x4 v0 = acc[ai][bj][m][0] * s, v1 = acc[ai][bj][m][1] * s;
                        u32x4 w; w.x = cvt_pk_bf16(v0[0], v0[1]); w.y = cvt_pk_bf16(v0[2], v0[3]); w.z = cvt_pk_bf16(v1[0], v1[1]); w.w = cvt_pk_bf16(v1[2], v1[3]);
                        *(PG8_GAS u32x4*)(rowp + bj * HALF) = w; } }
        } else {
#pragma unroll
            for (int ai = 0; ai < 2; ++ai)
#pragma unroll
                for (int m = 0; m < 4; ++m) { const int row = row0 + ai * HALF + m * 16; PG8_GAS bf16_t* rowp = base + (size_t)row * ldc + col0; float ss = 0.f;
#pragma unroll
                    for (int bj = 0; bj < 2; ++bj) { const f32x4 v0 = acc[ai][bj][m][0], v1 = acc[ai][bj][m][1];
                        ss += ((v0[0] * v0[0] + v0[1] * v0[1]) + (v0[2] * v0[2] + v0[3] * v0[3])) + ((v1[0] * v1[0] + v1[1] * v1[1]) + (v1[2] * v1[2] + v1[3] * v1[3]));
                        u32x4 w; w.x = cvt_pk_bf16(v0[0], v0[1]); w.y = cvt_pk_bf16(v0[2], v0[3]); w.z = cvt_pk_bf16(v1[0], v1[1]); w.w = cvt_pk_bf16(v1[2], v1[3]);
                        *(PG8_GAS u32x4*)(rowp + bj * HALF) = w; }
                    ss += __shfl_xor(ss, 16); ss += __shfl_xor(ss, 32); if (fq == 0) part[(size_t)row * 16 + u.pn * 4 + wc] = ss; }
        }
    }
};
struct EpiResid {
    static constexpr bool AFTER_DRAIN = false;
    PG8_LAS unsigned char* xl;
    __device__ __forceinline__ bool perm() const { return true; }
    int resid; const PG8_GAS float* gain; PG8_GAS bf16_t* xb; PG8_GAS float* outf; PG8_GAS float* rsw; PG8_GAS float* xs; PG8_GAS unsigned* cnt;
    static __device__ __forceinline__ f32x4 unlo(unsigned a, unsigned b) { return (f32x4){__builtin_bit_cast(float, a << 16), __builtin_bit_cast(float, a & 0xffff0000u), __builtin_bit_cast(float, b << 16), __builtin_bit_cast(float, b & 0xffff0000u)}; }
    static __device__ __forceinline__ float hsum(const f32x4 v) { return (v[0] + v[1]) + (v[2] + v[3]); }
    __device__ __forceinline__ void resid_epi(const f32x4 (&acc_)[2][2][4][2], const Unit& u, int, int, int, int) const {
        f32x4 (&acc)[2][2][4][2] = const_cast<f32x4 (&)[2][2][4][2]>(acc_);
        int tid = threadIdx.x; asm volatile("" : "+v"(tid));
        const int wid = __builtin_amdgcn_readfirstlane(tid >> 6), wr = wid >> 2, wc = wid & 3, fr = tid & 15, fq = (tid >> 4) & 3;
        const int col0 = u.pn * BM + wc * 32 + 8 * fq;
        const unsigned lane_e = (unsigned)((wr * 64 + fr) * 1024 + col0);
        PG8_GAS char* xbb = (PG8_GAS char*)(xb + (size_t)u.pm * BM * 1024); PG8_GAS char* outb = (PG8_GAS char*)(outf + (size_t)u.pm * BM * 1024);
        PG8_LAS f32x4* P4 = (PG8_LAS f32x4*)xl; PG8_LAS float* S2 = (PG8_LAS float*)(xl + 16384);
        PG8_LAS float* GW = (PG8_LAS float*)(xl + 18432) + (wr * 4 + wc) * 64;
        { const int ln = fq * 16 + fr; GW[ln] = gain[u.pn * BM + (ln >> 5) * HALF + wc * 32 + (ln & 31)]; }
#pragma unroll
        for (int ai = 0; ai < 2; ++ai)
#pragma unroll
            for (int m = 0; m < 4; ++m) {
#pragma unroll
                for (int bj = 0; bj < 2; ++bj) { const f32x4 v0 = acc[ai][bj][m][0], v1 = acc[ai][bj][m][1];
                    u32x4 p; p.x = cvt_pk_bf16(v0[0], v0[1]); p.y = cvt_pk_bf16(v0[2], v0[3]); p.z = cvt_pk_bf16(v1[0], v1[1]); p.w = cvt_pk_bf16(v1[2], v1[3]);
                    acc[ai][bj][m][0] = __builtin_bit_cast(f32x4, p); }
                __builtin_amdgcn_sched_barrier(0); }
#define PG8_XLD(it_) do { unsigned le_ = lane_e; asm volatile("" : "+v"(le_)); _Pragma("unroll") for (int bj = 0; bj < 2; ++bj) \
            xq[(it_) % 3][bj] = *(const PG8_GAS u32x4*)(xbb + (size_t)((unsigned)(((((it_) >> 2) * HALF) + 16 * ((it_) & 3)) * 1024 + bj * HALF) + le_) * 2); } while (0)
        {   u32x4 xq[3][2];
            PG8_XLD(0); PG8_XLD(1);
#pragma unroll
            for (int it = 0; it < 8; ++it) { const int ai = it >> 2, m = it & 3;
                if (it + 2 < 8) PG8_XLD(it + 2);
                float sa = 0.f, sb = 0.f, sc = 0.f, sd = 0.f;
#pragma unroll
                for (int bj = 0; bj < 2; ++bj) { f32x4 py_ = acc[ai][bj][m][0]; asm volatile("" : "+v"(py_));
                    const u32x4 p = __builtin_bit_cast(u32x4, py_), xw = xq[it % 3][bj];
                    const f32x4 g0 = *(const PG8_LAS f32x4*)(GW + bj * 32 + 8 * fq), g1 = *(const PG8_LAS f32x4*)(GW + bj * 32 + 8 * fq + 4);
                    const f32x4 y0 = unlo(p.x, p.y), y1 = unlo(p.z, p.w), x0 = unlo(xw.x, xw.y), x1 = unlo(xw.z, xw.w), q0 = y0 * g0, q1 = y1 * g1;
                    sa += hsum(y0 * y0) + hsum(y1 * y1); sb += hsum(x0 * x0) + hsum(x1 * x1); sc += hsum(x0 * q0) + hsum(x1 * q1); sd += hsum(q0 * q0) + hsum(q1 * q1); }
                sa += __shfl_xor(sa, 16); sb += __shfl_xor(sb, 16); sc += __shfl_xor(sc, 16); sd += __shfl_xor(sd, 16);
                sa += __shfl_xor(sa, 32); sb += __shfl_xor(sb, 32); sc += __shfl_xor(sc, 32); sd += __shfl_xor(sd, 32);
                if (fq == 0) P4[(ai * HALF + wr * 64 + m * 16 + fr) * 4 + wc] = (f32x4){sa, sb, sc, sd};
                __builtin_amdgcn_sched_barrier(0); } }
        asm volatile("s_waitcnt lgkmcnt(0)" ::: "memory"); __builtin_amdgcn_s_barrier(); asm volatile("" ::: "memory");
        PG8_GAS float* slot = xs + (size_t)u.pm * BM * 16;
        PG8_GAS unsigned* c = cnt + u.pm * 64;
        if (tid < 256) { const f32x4 t4 = (P4[tid * 4 + 0] + P4[tid * 4 + 1]) + (P4[tid * 4 + 2] + P4[tid * 4 + 3]);
#pragma unroll
            for (int j = 0; j < 4; ++j) __hip_atomic_store(slot + tid * 16 + u.pn * 4 + j, t4[j], __ATOMIC_RELAXED, __HIP_MEMORY_SCOPE_AGENT);
            asm volatile("s_waitcnt vmcnt(0)" ::: "memory");
            if ((tid & 63) == 0) __hip_atomic_fetch_add(c, 1u, __ATOMIC_RELAXED, __HIP_MEMORY_SCOPE_AGENT); }
        if (tid < 64) { unsigned spins = 0;
            while ((unsigned)__builtin_amdgcn_readfirstlane(__hip_atomic_load(c, __ATOMIC_RELAXED, __HIP_MEMORY_SCOPE_AGENT)) < 16u) { __builtin_amdgcn_s_sleep(2); if (++spins > (1u << 22)) break; }
            __builtin_amdgcn_fence(__ATOMIC_ACQUIRE, "agent"); asm volatile("s_waitcnt vmcnt(0)" ::: "memory"); }
        asm volatile("s_waitcnt lgkmcnt(0)" ::: "memory"); __builtin_amdgcn_s_barrier(); asm volatile("" ::: "memory");
        if (tid < 256) { float t[4] = {0.f, 0.f, 0.f, 0.f};
#pragma unroll
            for (int q = 0; q < 4; ++q)
#pragma unroll
                for (int j = 0; j < 4; ++j) t[j] += __hip_atomic_load(slot + tid * 16 + q * 4 + j, __ATOMIC_RELAXED, __HIP_MEMORY_SCOPE_AGENT);
            const float ry = __builtin_amdgcn_rsqf(t[0] * (1.f / 1024.f) + 1e-6f);
            const float sx = t[1] + ry * (2.f * t[2] + ry * t[3]);
            const float rn = __builtin_amdgcn_rsqf(sx * (1.f / 1024.f) + 1e-6f);
            S2[tid * 2] = ry; S2[tid * 2 + 1] = rn;
            if (resid == 1 && u.pn == 0) rsw[(size_t)u.pm * BM + tid] = rn; }
        asm volatile("s_waitcnt lgkmcnt(0)" ::: "memory"); __builtin_amdgcn_s_barrier(); asm volatile("" ::: "memory");
        {   u32x4 xq[3][2];
            PG8_XLD(0); PG8_XLD(1);
#pragma unroll
            for (int it = 0; it < 8; ++it) { const int ai = it >> 2, m = it & 3;
                if (it + 2 < 8) PG8_XLD(it + 2);
                const float sc = S2[(ai * HALF + wr * 64 + m * 16 + fr) * 2];
                unsigned le = lane_e; asm volatile("" : "+v"(le));
#pragma unroll
                for (int bj = 0; bj < 2; ++bj) { const unsigned ce = (unsigned)((ai * HALF + 16 * m) * 1024 + bj * HALF);
                    f32x4 py_ = acc[ai][bj][m][0]; asm volatile("" : "+v"(py_));
                    const u32x4 p = __builtin_bit_cast(u32x4, py_), xw = xq[it % 3][bj];
                    const f32x4 g0 = *(const PG8_LAS f32x4*)(GW + bj * 32 + 8 * fq), g1 = *(const PG8_LAS f32x4*)(GW + bj * 32 + 8 * fq + 4);
                    const f32x4 v0 = unlo(xw.x, xw.y) + unlo(p.x, p.y) * sc * g0, v1 = unlo(xw.z, xw.w) + unlo(p.z, p.w) * sc * g1;
                    if (resid == 2) { PG8_GAS f32x4* op = (PG8_GAS f32x4*)(outb + (size_t)(ce + le) * 4); op[0] = v0; op[1] = v1; }
                    else { u32x4 w; w.x = cvt_pk_bf16(v0[0], v0[1]); w.y = cvt_pk_bf16(v0[2], v0[3]); w.z = cvt_pk_bf16(v1[0], v1[1]); w.w = cvt_pk_bf16(v1[2], v1[3]);
                        *(PG8_GAS u32x4*)(xbb + (size_t)(ce + le) * 2) = w; } }
                asm volatile("" ::: "memory"); __builtin_amdgcn_sched_barrier(0); } }
#undef PG8_XLD
    }
    __device__ __forceinline__ void operator()(const f32x4 (&acc)[2][2][4][2], const Unit& u, int wr, int wc, int fr, int fq) const { resid_epi(acc, u, wr, wc, fr, fq); }
};
template <class Epi, class Sched, bool ALIGN_EPI = false, bool SP2 = false>
__device__ __forceinline__ void gemm_phase(PG8_LAS unsigned char* lds, const Gemm g, const Sched& S, const Epi& E) {
    int tid_ = threadIdx.x; asm volatile("" : "+v"(tid_));
    const int tid = tid_, wid = __builtin_amdgcn_readfirstlane(tid >> 6), lane = tid & 63, wr = wid >> 2, wc = wid & 3, fr = lane & 15, fq = lane >> 4;
    const int K = g.K, nt = K / BK;
    unsigned voffA[2], voffB[2];
#pragma unroll
    for (int i = 0; i < 2; ++i) { int R, C; stage_rc(tid * 16 + i * 8192, R, C); const int Rb = E.perm() ? ((R & ~31) + perm32(R & 31)) : R;
        voffA[i] = (unsigned)(R * K + C) * 2u; voffB[i] = (unsigned)(Rb * K + C) * 2u; }
    const size_t kstep = (size_t)(BK * 2);
    const size_t hstep = (size_t)HALF * K * 2;
    const size_t tstep = 2 * hstep;
    const unsigned ldsw = (unsigned)wid * 1024u;
    const int aoff = lds_byte(wr * 64 + fr, fq * 8), boff = lds_byte(wc * 32 + fr, fq * 8);
#define PG8_SA(b, h) (((b) * 2 + (h)) * HTB)
#define PG8_SB(b, h) ((4 + (b) * 2 + (h)) * HTB)
#define PG8_STAGE(bufoff, gbase, voff) do { _Pragma("unroll") for (int _i = 0; _i < 2; ++_i) \
        __builtin_amdgcn_global_load_lds((const PG8_GAS unsigned*)((const PG8_GAS char*)(gbase) + (voff)[_i]), (PG8_LAS unsigned*)(lds + (bufoff) + ldsw + _i * 8192), 16, 0, 0); } while (0)
#define PG8_LDA(dst, b, h) do { _Pragma("unroll") for (int m = 0; m < 4; ++m) _Pragma("unroll") for (int k = 0; k < 2; ++k) dst[m][k] = *(const PG8_LAS bf16x8*)(lds + PG8_SA(b, h) + aoff + m * 2048 + k * 1024); } while (0)
#define PG8_LDB(dst, b, h) do { _Pragma("unroll") for (int n = 0; n < 2; ++n) _Pragma("unroll") for (int k = 0; k < 2; ++k) dst[n][k] = *(const PG8_LAS bf16x8*)(lds + PG8_SB(b, h) + boff + n * 2048 + k * 1024); } while (0)
#define PG8_MMA(ai, bj, At, Bt) do { __builtin_amdgcn_s_setprio(1); _Pragma("unroll") for (int m = 0; m < 4; ++m) _Pragma("unroll") for (int n = 0; n < 2; ++n) _Pragma("unroll") for (int k = 0; k < 2; ++k) \
        acc[ai][bj][m][n] = __builtin_amdgcn_mfma_f32_16x16x32_bf16(Bt[n][k], At[m][k], acc[ai][bj][m][n], 0, 0, 0); __builtin_amdgcn_s_setprio(0); } while (0)
#define PG8_WAIT_V(n) asm volatile("s_waitcnt vmcnt(" #n ")" ::: "memory")
#define PG8_WAIT_L(n) asm volatile("s_waitcnt lgkmcnt(" #n ")" ::: "memory")
#define PG8_BAR __builtin_amdgcn_s_barrier()
#define PG8_SCHED __builtin_amdgcn_sched_barrier(0)
    Unit cur, nxt; int ui = 0;
    if (!S.next(0, cur)) return;
    f32x4 acc[2][2][4][2];
#pragma unroll
    for (int a = 0; a < 2; ++a)
#pragma unroll
        for (int b = 0; b < 2; ++b)
#pragma unroll
            for (int m = 0; m < 4; ++m)
#pragma unroll
                for (int n = 0; n < 2; ++n) acc[a][b][m][n] = (f32x4){0.f, 0.f, 0.f, 0.f};
    bf16x8 At[4][2], B0[2][2], B1[2][2];
    const PG8_GAS char* cA = (const PG8_GAS char*)g.A + (size_t)cur.pm * tstep; const PG8_GAS char* cB = (const PG8_GAS char*)g.Bt + (size_t)cur.pn * tstep;
    S.a_ready(cur);
    if constexpr (SP2) {
        PG8_STAGE(PG8_SB(0, 0), cB, voffB); PG8_STAGE(PG8_SB(0, 1), cB + hstep, voffB); PG8_STAGE(PG8_SA(0, 0), cA, voffA); PG8_STAGE(PG8_SA(0, 1), cA + hstep, voffA);
        if (wr == 1) PG8_BAR;
        PG8_WAIT_V(2); PG8_BAR;
        PG8_STAGE(PG8_SB(1, 0), cB + kstep, voffB); PG8_STAGE(PG8_SA(1, 0), cA + kstep, voffA); PG8_STAGE(PG8_SB(1, 1), cB + hstep + kstep, voffB);
        PG8_WAIT_V(6); PG8_BAR;
    } else {
        PG8_STAGE(PG8_SB(0, 0), cB, voffB); PG8_STAGE(PG8_SA(0, 0), cA, voffA); PG8_STAGE(PG8_SB(0, 1), cB + hstep, voffB); PG8_STAGE(PG8_SA(0, 1), cA + hstep, voffA);
        if (wr == 1) PG8_BAR;
        PG8_WAIT_V(4); PG8_BAR;
        PG8_STAGE(PG8_SB(1, 0), cB + kstep, voffB); PG8_STAGE(PG8_SA(1, 0), cA + kstep, voffA); PG8_STAGE(PG8_SB(1, 1), cB + hstep + kstep, voffB);
        PG8_WAIT_V(6); PG8_BAR;
    }
    for (;;) {
        const bool has_next = S.next(ui + 1, nxt);
        const PG8_GAS char* nA = has_next ? (const PG8_GAS char*)g.A + (size_t)nxt.pm * tstep : cA; const PG8_GAS char* nB = has_next ? (const PG8_GAS char*)g.Bt + (size_t)nxt.pn * tstep : cB;
        for (int t = 0; t < nt; t += 2) {
            const bool last = (t == nt - 2);
            const PG8_GAS char* a1 = cA + (size_t)(t + 1) * kstep;
            const PG8_GAS char* a2 = last ? nA : cA + (size_t)(t + 2) * kstep; const PG8_GAS char* b2 = last ? nB : cB + (size_t)(t + 2) * kstep;
            const PG8_GAS char* a3 = a2 + kstep; const PG8_GAS char* b3 = b2 + kstep;
            if (last && has_next) S.a_ready(nxt);
            if constexpr (SP2) {
            PG8_LDB(B0, 0, 0); PG8_LDB(B1, 0, 1); PG8_SCHED; PG8_LDA(At, 0, 0); PG8_STAGE(PG8_SA(1, 1), a1 + hstep, voffA);
            PG8_WAIT_V(8); PG8_WAIT_L(0); PG8_BAR; PG8_MMA(0, 0, At, B0); PG8_MMA(0, 1, At, B1); PG8_BAR; PG8_SCHED;
            PG8_LDA(At, 0, 1); PG8_STAGE(PG8_SB(0, 0), b2, voffB); PG8_STAGE(PG8_SB(0, 1), b2 + hstep, voffB); PG8_STAGE(PG8_SA(0, 0), a2, voffA);
            PG8_WAIT_V(8); PG8_WAIT_L(0); PG8_BAR; PG8_MMA(1, 0, At, B0); PG8_MMA(1, 1, At, B1); PG8_BAR; PG8_SCHED;
            PG8_LDB(B0, 1, 0); PG8_LDB(B1, 1, 1); PG8_SCHED; PG8_LDA(At, 1, 0); PG8_STAGE(PG8_SA(0, 1), a2 + hstep, voffA);
            PG8_WAIT_V(8); PG8_WAIT_L(0); PG8_BAR; PG8_MMA(0, 0, At, B0); PG8_MMA(0, 1, At, B1); PG8_BAR; PG8_SCHED;
            PG8_LDA(At, 1, 1); PG8_STAGE(PG8_SB(1, 0), b3, voffB); PG8_STAGE(PG8_SB(1, 1), b3 + hstep, voffB); PG8_STAGE(PG8_SA(1, 0), a3, voffA);
            PG8_WAIT_V(8); PG8_WAIT_L(0); PG8_BAR; PG8_MMA(1, 0, At, B0); PG8_MMA(1, 1, At, B1); PG8_BAR; PG8_SCHED;
            } else {
            PG8_LDB(B0, 0, 0); PG8_SCHED; PG8_LDA(At, 0, 0); PG8_STAGE(PG8_SA(1, 1), a1 + hstep, voffA);
            PG8_WAIT_L(8); PG8_BAR; PG8_WAIT_L(0); PG8_MMA(0, 0, At, B0); PG8_BAR; PG8_SCHED;
            PG8_LDB(B1, 0, 1); PG8_STAGE(PG8_SB(0, 0), b2, voffB);
            PG8_BAR; PG8_WAIT_L(0); PG8_MMA(0, 1, At, B1); PG8_BAR;
            PG8_LDA(At, 0, 1); PG8_STAGE(PG8_SA(0, 0), a2, voffA);
            PG8_BAR; PG8_WAIT_L(0); PG8_MMA(1, 0, At, B0); PG8_BAR; PG8_SCHED;
            PG8_STAGE(PG8_SB(0, 1), b2 + hstep, voffB);
            PG8_WAIT_V(6); PG8_BAR; PG8_MMA(1, 1, At, B1); PG8_BAR;
            PG8_LDB(B0, 1, 0); PG8_SCHED; PG8_LDA(At, 1, 0); PG8_STAGE(PG8_SA(0, 1), a2 + hstep, voffA);
            PG8_WAIT_L(8); PG8_BAR; PG8_WAIT_L(0); PG8_MMA(0, 0, At, B0); PG8_BAR; PG8_SCHED;
            PG8_LDB(B1, 1, 1); PG8_STAGE(PG8_SB(1, 0), b3, voffB);
            PG8_BAR; PG8_WAIT_L(0); PG8_MMA(0, 1, At, B1); PG8_BAR;
            PG8_LDA(At, 1, 1); PG8_STAGE(PG8_SA(1, 0), a3, voffA);
            PG8_BAR; PG8_WAIT_L(0); PG8_MMA(1, 0, At, B0); PG8_BAR; PG8_SCHED;
            PG8_STAGE(PG8_SB(1, 1), b3 + hstep, voffB);
            PG8_WAIT_V(6); PG8_BAR; PG8_MMA(1, 1, At, B1); PG8_BAR;
            }
        }
        if constexpr (ALIGN_EPI) { if (wr == 0) PG8_BAR; }
        if constexpr (!Epi::AFTER_DRAIN) { E(acc, cur, wr, wc, fr, fq); S.done(cur); }
        if (!has_next) break;
#pragma unroll
        for (int a = 0; a < 2; ++a)
#pragma unroll
            for (int b = 0; b < 2; ++b)
#pragma unroll
                for (int m = 0; m < 4; ++m)
#pragma unroll
                    for (int n = 0; n < 2; ++n) acc[a][b][m][n] = (f32x4){0.f, 0.f, 0.f, 0.f};
        cur = nxt; cA = nA; cB = nB; ++ui;
        if constexpr (ALIGN_EPI) { if (wr == 1) PG8_BAR; }
    }
    PG8_WAIT_V(0);
    if constexpr (!ALIGN_EPI) { if (wr == 0) PG8_BAR; }
    PG8_BAR;
    if constexpr (Epi::AFTER_DRAIN) { E.fused(acc, cur, wr, wc, fr, fq, lds, wid, lane); S.done(cur); }
#undef PG8_SA
#undef PG8_SB
#undef PG8_STAGE
#undef PG8_LDA
#undef PG8_LDB
#undef PG8_MMA
#undef PG8_WAIT_V
#undef PG8_WAIT_L
#undef PG8_BAR
#undef PG8_SCHED
}
}

constexpr int NB = 8, T = 4096, DM = 1024, M = NB * T, DEPTH = 2;
constexpr int NPROJ = 2912, NPROJP = 3072, DFF = 2816, NUP = 2 * DFF;
constexpr int C_CH = 0, C_CB = 256, C_CC = 512, C_R = 768, C_K = 1024, C_V = 1280, C_DEC = 1536, C_GDN = 1600, C_NQ = 1632, C_NK = 1888, C_NV = 2144, C_SU = 2400, C_SV = 2656;
constexpr float NORM_EPS = 1e-6f, GN_EPS = 64e-5f, DECAY_SCALE = 0.60653065971263342f;
constexpr int NWAVES = 8, NTHREADS = 512;
constexpr size_t MiB = 1u << 20;
constexpr size_t WS_CTL = 0, CTL_ZERO_BYTES = 1 * MiB;
constexpr size_t WS_RS = 1 * MiB;
constexpr size_t WS_PART = 1 * MiB + 256 * 1024;
constexpr size_t WS_W = 4 * MiB, W_LAYER = 24 * MiB + 512 * 1024;
constexpr size_t W_IN = 0, W_OUT = 6 * MiB, W_UP = 8 * MiB, W_DN = 19 * MiB;
constexpr size_t WS_XB = 53 * MiB;
constexpr size_t WS_R = 117 * MiB;
constexpr size_t WS_PROJ = WS_R, WS_MERGED = WS_R + 192 * MiB, WS_PREP = WS_R + 256 * MiB;
constexpr size_t GT_CHUNK = 12800, GT_DIR = (size_t)NB * 4 * 256 * GT_CHUNK;
constexpr size_t WS_GT0 = WS_PREP, WS_YSC0 = WS_PREP + 100 * MiB;
static_assert(GT_DIR == 100 * MiB, "GT size");
constexpr size_t WS_Y = WS_R;
constexpr size_t WS_G = WS_R, WS_L = WS_R + 176 * MiB;
constexpr size_t WS_END = 501 * MiB;
static_assert(WS_W + 2 * W_LAYER <= WS_XB && WS_PREP + 128 * MiB <= WS_END && WS_L + 176 * MiB <= WS_END && WS_PART + (size_t)M * 64 <= WS_W, "ws map");
constexpr int CW_BAR = 4096;
constexpr int CW_PANEL = 16384;
constexpr size_t WS_XS = WS_PART;
constexpr int RING_BYTES = 131072, LDSCTL_OFF = RING_BYTES, MISC_OFF = LDSCTL_OFF + 320, LDS_BYTES = 152576;

#define GAS __attribute__((address_space(1)))
#define LAS __attribute__((address_space(3)))
typedef unsigned short bf16;
typedef unsigned v4u __attribute__((ext_vector_type(4)));
typedef unsigned v2u __attribute__((ext_vector_type(2)));
typedef float f32x4 __attribute__((ext_vector_type(4)));
typedef short bf16x8 __attribute__((ext_vector_type(8)));
typedef short s16x4 __attribute__((ext_vector_type(4)));
typedef _Float16 h2 __attribute__((ext_vector_type(2)));
typedef GAS unsigned gu32;
#define RLX_AGENT __ATOMIC_RELAXED, __HIP_MEMORY_SCOPE_AGENT
__device__ __forceinline__ unsigned pk2(float lo, float hi) { return pg8::cvt_pk_bf16(lo, hi); }
__device__ __forceinline__ unsigned f2bf(float f) { return (unsigned)__builtin_bit_cast(unsigned short, (__bf16)f); }
__device__ __forceinline__ float bflo(unsigned w) { return __builtin_bit_cast(float, w << 16); }
__device__ __forceinline__ float bfhi(unsigned w) { return __builtin_bit_cast(float, w & 0xffff0000u); }
__device__ __forceinline__ float bf2f(unsigned short b) { return __builtin_bit_cast(float, (unsigned)b << 16); }
__device__ __forceinline__ h2 as_h2(unsigned u) { return __builtin_bit_cast(h2, u); }
template <int CTRL> __device__ __forceinline__ float dppmov(float x) { return __builtin_bit_cast(float, __builtin_amdgcn_update_dpp(0, __builtin_bit_cast(int, x), CTRL, 0xF, 0xF, true)); }
__device__ __forceinline__ float row16_sum(float x) { x += dppmov<0xB1>(x); x += dppmov<0x4E>(x); x += dppmov<0x141>(x); x += dppmov<0x140>(x); return x; }
typedef unsigned u32x2_t __attribute__((ext_vector_type(2)));
__device__ __forceinline__ float xor16_sum(float x) { const u32x2_t r = __builtin_amdgcn_permlane16_swap(__builtin_bit_cast(unsigned, x), __builtin_bit_cast(unsigned, x), false, false);
    const unsigned a = r.x, b = r.y; return __builtin_bit_cast(float, a) + __builtin_bit_cast(float, b); }
__device__ __forceinline__ float xor32_sum(float x) { const u32x2_t r = __builtin_amdgcn_permlane32_swap(__builtin_bit_cast(unsigned, x), __builtin_bit_cast(unsigned, x), false, false);
    const unsigned a = r.x, b = r.y; return __builtin_bit_cast(float, a) + __builtin_bit_cast(float, b); }
__device__ __forceinline__ float wave_sum(float v) { return xor32_sum(xor16_sum(row16_sum(v))); }
__device__ __forceinline__ float row16_max(float x) { x = fmaxf(x, dppmov<0xB1>(x)); x = fmaxf(x, dppmov<0x4E>(x)); x = fmaxf(x, dppmov<0x141>(x)); x = fmaxf(x, dppmov<0x140>(x)); return x; }
__device__ __forceinline__ float rcpf_(float x) { return __builtin_amdgcn_rcpf(x); }
__device__ __forceinline__ float rsqf_(float x) { return __builtin_amdgcn_rsqf(x); }
__device__ __forceinline__ float sigmoidf_(float x) { return rcpf_(1.f + __expf(-x)); }
__device__ __forceinline__ float tanhf_(float x) { return 1.f - 2.f * rcpf_(__expf(2.f * x) + 1.f); }
__device__ __forceinline__ float gelu_tanh(float x) { const float u = 1.5957691216057308f * x * (1.f + 0.044715f * x * x); return x * rcpf_(1.f + __expf(-u)); }
#define XB_TMO      128
#define XB_XCNT(j)  (256  + 64 * (j))
#define XB_XSUB(j)  (1280 + 64 * (j))
#define XB_XGEN(j)  (2304 + 64 * (j))
#define XB_TOP      3328
#define XB_TOPGEN   3392
#define XCD_BAR_WORDS 3456
#define XB_SPIN_CAP (1u << 18)

__device__ __forceinline__ unsigned xb_ld(unsigned* p)              { return __hip_atomic_load(p, __ATOMIC_RELAXED, __HIP_MEMORY_SCOPE_AGENT); }
__device__ __forceinline__ unsigned xb_add(unsigned* p, unsigned v) { return __hip_atomic_fetch_add(p, v, __ATOMIC_RELAXED, __HIP_MEMORY_SCOPE_AGENT); }
__device__ __forceinline__ unsigned xb_xcc_id() { return (unsigned)__builtin_amdgcn_s_getreg((3 << 11) | 20) & 0xFu; }
#define XB_SPIN(cond, bar) do { unsigned _sp = 0; while (cond) { __builtin_amdgcn_s_sleep(1); \
    if ((++_sp & 255u) == 0u) { if (xb_ld(&(bar)[XB_TMO])) break; if (_sp > XB_SPIN_CAP) { atomicAdd(&(bar)[XB_TMO], 1u); break; } } } } while (0)

struct XcdBarrier {
    unsigned* bar; unsigned x;
    volatile LAS unsigned* st;
};

__device__ __forceinline__ XcdBarrier xcd_barrier_post(unsigned* bar, volatile LAS unsigned* st) {
    XcdBarrier b; b.bar = bar; b.x = xb_xcc_id(); b.st = st;
    if (threadIdx.x == 0) (void)xb_add(&bar[XB_XCNT(b.x)], 1u);
    return b;
}
__device__ __forceinline__ void xcd_barrier_complete(unsigned* bar, unsigned x, unsigned& nloc, unsigned& nx) {
    const unsigned G = gridDim.x * gridDim.y * gridDim.z;
    unsigned sum, cnt, mine, sp = 0u;
    for (;;) {
        sum = 0u; cnt = 0u; mine = 0u;
#pragma unroll
        for (unsigned j = 0; j < 16; ++j) { const unsigned c = xb_ld(&bar[XB_XCNT(j)]); sum += c; cnt += (c > 0u) ? 1u : 0u; mine = (j == x) ? c : mine; }
        if (sum == G) break;
        __builtin_amdgcn_s_sleep(1);
        if ((++sp & 255u) == 0u) { if (xb_ld(&bar[XB_TMO])) break; if (sp > XB_SPIN_CAP) { atomicAdd(&bar[XB_TMO], 1u); break; } }
    }
    nloc = mine > 0u ? mine : 1u; nx = cnt > 0u ? cnt : 1u;
}

__device__ __forceinline__ void xcd_barrier(const XcdBarrier& b) {
    asm volatile("s_waitcnt vmcnt(0)" ::: "memory");
    __syncthreads();
    if (threadIdx.x == 0) {
        unsigned* bar = b.bar;
        __builtin_amdgcn_s_waitcnt(0);
        unsigned nloc = b.st[0], nx = b.st[1];
        if (nloc == 0u) { xcd_barrier_complete(bar, b.x, nloc, nx); b.st[0] = nloc; b.st[1] = nx; }
        const unsigned old = xb_add(&bar[XB_XSUB(b.x)], 1u);
        const unsigned gen = old / nloc;
        if (old + 1u == (gen + 1u) * nloc) {
            __builtin_amdgcn_fence(__ATOMIC_RELEASE, "agent");
            asm volatile("s_waitcnt vmcnt(0)" ::: "memory");
            const unsigned og = xb_add(&bar[XB_TOP], 1u);
            const unsigned tg = og / nx;
            if (og + 1u == (tg + 1u) * nx) xb_add(&bar[XB_TOPGEN], 1u);
            else XB_SPIN(xb_ld(&bar[XB_TOPGEN]) == tg, bar);
            __builtin_amdgcn_fence(__ATOMIC_ACQUIRE, "agent");
            xb_add(&bar[XB_XGEN(b.x)], 1u);
            asm volatile("s_waitcnt vmcnt(0)" ::: "memory");
        } else {
            XB_SPIN(xb_ld(&bar[XB_XGEN(b.x)]) == gen, bar);
            __builtin_amdgcn_fence(__ATOMIC_ACQUIRE, "agent");
            asm volatile("s_waitcnt vmcnt(0)" ::: "memory");
        }
    }
    __syncthreads();
}

typedef __attribute__((address_space(4))) const unsigned long long kq_t;
struct Frame {
    LAS unsigned char* lds;
    volatile LAS unsigned* MISC;
    gu32* ctl;
    int tid, lane, wave, vcu, G;
    kq_t* karg; GAS float* out; GAS unsigned char* ws;
};
#define INP(F, i) ((const GAS float*)(F).karg[(i)])
enum { I_X = 0, I_NMPRE, I_NMPOST, I_NFPRE, I_NFPOST, I_WIN, I_CONVW, I_RW0, I_RWUP, I_RA0, I_RAUP, I_RGUP, I_RKK, I_RKA, I_RRK, I_LNXW, I_LNXB, I_RPB, I_SGUN, I_SGUW, I_SGUB, I_MGAIN, I_WOUT, I_WUP, I_FCONV, I_WDN };
__device__ __forceinline__ int launder_u(int x) { asm volatile("" : "+v"(x)); return __builtin_amdgcn_readfirstlane(x); }
template <class P> __device__ __forceinline__ P launder_p(P p) { unsigned long long v = (unsigned long long)p; unsigned lo = (unsigned)v, hi = (unsigned)(v >> 32); asm volatile("" : "+v"(lo), "+v"(hi));
    lo = __builtin_amdgcn_readfirstlane(lo); hi = __builtin_amdgcn_readfirstlane(hi); return (P)(((unsigned long long)hi << 32) | lo); }
#define LAUNDER(F) do { asm volatile("" : "+v"((F).tid)); asm volatile("" : "+v"((F).lane)); (F).wave = launder_u((F).wave); (F).vcu = launder_u((F).vcu); (F).karg = launder_p((F).karg); (F).ws = launder_p((F).ws); (F).out = launder_p((F).out); } while (0)
#define LDS_WAIT() asm volatile("s_waitcnt lgkmcnt(0)" ::: "memory")
#define CFENCE() asm volatile("" ::: "memory")

__device__ __forceinline__ void p0_transpose_item(const GAS float* W, const GAS float* gain, int K, int N, GAS bf16* WT, LAS float* scr, int item, int lane, bool glmap = false) {
    const int nblk = N / 32, kb = item / nblk, nb = item % nblk, k0 = 64 * kb, n0 = 32 * nb;
    const int r0 = !glmap ? n0 : (n0 < N / 2 ? 256 * (n0 >> 7) + (n0 & 127) : 256 * ((n0 - N / 2) >> 7) + 128 + ((n0 - N / 2) & 127));
#pragma unroll 8
    for (int i = 0; i < 32; ++i) { const int kk = 2 * i + (lane >> 5); const float g = gain ? gain[k0 + kk] : 1.f; scr[kk * 33 + (lane & 31)] = W[(size_t)(k0 + kk) * N + n0 + (lane & 31)] * g; }
    LDS_WAIT(); CFENCE();
    const int c = lane & 7;
#pragma unroll
    for (int j = 0; j < 4; ++j) { const int n = (lane >> 3) + 8 * j; const LAS float* s = scr + (8 * c) * 33 + n;
        v4u o; o.x = pk2(s[0 * 33], s[1 * 33]); o.y = pk2(s[2 * 33], s[3 * 33]); o.z = pk2(s[4 * 33], s[5 * 33]); o.w = pk2(s[6 * 33], s[7 * 33]);
        *(GAS v4u*)(WT + (size_t)(r0 + n) * K + k0 + 8 * c) = o; }
    LDS_WAIT(); CFENCE();
}
__device__ __forceinline__ void row_to_bf16_rs(const GAS float* xrow, GAS bf16* orow, GAS float* rs, int lane) {
    const GAS f32x4* xr = (const GAS f32x4*)xrow + lane;
    f32x4 v[4]; float s = 0.f;
#pragma unroll
    for (int j = 0; j < 4; ++j) { v[j] = xr[64 * j]; s += (v[j].x * v[j].x + v[j].y * v[j].y) + (v[j].z * v[j].z + v[j].w * v[j].w); }
    s = wave_sum(s);
    GAS v2u* o8 = (GAS v2u*)orow + lane;
#pragma unroll
    for (int j = 0; j < 4; ++j) { v2u o; o.x = pk2(v[j].x, v[j].y); o.y = pk2(v[j].z, v[j].w); o8[64 * j] = o; }
    if (lane == 0) *rs = rsqf_(s * (1.f / DM) + NORM_EPS);
}
__device__ __forceinline__ void p0_prologue(Frame& F) {
    LAUNDER(F);
    LAS float* scr = (LAS float*)(F.lds + F.wave * 16384);
    const int gw = F.vcu * NWAVES + F.wave, NGW = F.G * NWAVES;
    constexpr int I_IN = (DM / 64) * (NPROJ / 32), I_OUT = (DM / 64) * (DM / 32), I_UP = (DM / 64) * (NUP / 32), I_DN = (DFF / 64) * (DM / 32), I_L = I_IN + I_OUT + I_UP + I_DN;
    for (int it = gw; it < DEPTH * I_L; it += NGW) {
        const int l = it / I_L; int r = it % I_L; GAS unsigned char* wl = F.ws + WS_W + (size_t)l * W_LAYER;
        if (r < I_IN) { p0_transpose_item(INP(F, I_WIN) + (size_t)l * DM * NPROJ, INP(F, I_NMPRE) + l * DM, DM, NPROJ, (GAS bf16*)(wl + W_IN), scr, r, F.lane); continue; } r -= I_IN;
        if (r < I_OUT) { p0_transpose_item(INP(F, I_WOUT) + (size_t)l * DM * DM, INP(F, I_MGAIN) + l * DM, DM, DM, (GAS bf16*)(wl + W_OUT), scr, r, F.lane); continue; } r -= I_OUT;
        if (r < I_UP) { p0_transpose_item(INP(F, I_WUP) + (size_t)l * DM * NUP, INP(F, I_NFPRE) + l * DM, DM, NUP, (GAS bf16*)(wl + W_UP), scr, r, F.lane, true); continue; } r -= I_UP;
        p0_transpose_item(INP(F, I_WDN) + (size_t)l * DFF * DM, nullptr, DFF, DM, (GAS bf16*)(wl + W_DN), scr, r, F.lane);
    }
    unsigned zz = 0u; asm volatile("" : "+v"(zz));
    for (int i = F.vcu * NTHREADS + F.tid; i < DEPTH * 20480; i += F.G * NTHREADS) { const int l = i / 20480, r = i % 20480;
        *(GAS v4u*)(F.ws + WS_W + (size_t)l * W_LAYER + W_IN + (size_t)NPROJ * DM * 2 + (size_t)r * 16) = (v4u){zz, zz, zz, zz}; }
    for (int m = gw; m < M; m += NGW) row_to_bf16_rs(INP(F, I_X) + (size_t)m * DM, (GAS bf16*)(F.ws + WS_XB) + (size_t)m * DM, (GAS float*)(F.ws + WS_RS) + m, F.lane);
}

typedef float f32x16 __attribute__((ext_vector_type(16)));
__device__ __forceinline__ void mix_convprep_tile(Frame& F, int l, int tile) {
    LAUNDER(F);
    const GAS bf16* proj = (const GAS bf16*)(F.ws + WS_PROJ); GAS bf16* merged = (GAS bf16*)(F.ws + WS_MERGED);
    const int m0 = tile * 64, bb = m0 / T, t0 = m0 % T;
    const int lane = F.lane, w = F.wave;
    {
        const int c4 = 4 * lane; const GAS float* cw = INP(F, I_CONVW) + l * 768;
        const f32x4 w0 = *(const f32x4*)(cw + c4), w1 = *(const f32x4*)(cw + 256 + c4), w2 = *(const f32x4*)(cw + 512 + c4);
        const int ts = t0 + 8 * w;
        v2u hr[10], cr[10], br[8];
#pragma unroll
        for (int j = 0; j < 10; ++j) { const int t = ts - 1 + j; const bool ok = (t >= 0 && t < T); const GAS bf16* row = proj + (size_t)(bb * T + (ok ? t : ts)) * NPROJP;
            hr[j] = *(const GAS v2u*)(row + C_CH + c4); cr[j] = *(const GAS v2u*)(row + C_CC + c4); if (!ok) { hr[j] = (v2u){0u, 0u}; } }
#pragma unroll
        for (int j = 0; j < 8; ++j) { const GAS bf16* row = proj + (size_t)(bb * T + ts + j) * NPROJP; br[j] = *(const GAS v2u*)(row + C_CB + c4); }
#pragma unroll
        for (int i = 0; i < 8; ++i) { const int t = ts + i;
            f32x4 z[3];
#pragma unroll
            for (int q = 0; q < 3; ++q) { const v2u h = hr[i + q], c = cr[i + q]; z[q] = (f32x4){bflo(h.x) * bflo(c.x), bfhi(h.x) * bfhi(c.x), bflo(h.y) * bflo(c.y), bfhi(h.y) * bfhi(c.y)}; }
            const v2u b = br[i];
            const f32x4 bv = (f32x4){bflo(b.x), bfhi(b.x), bflo(b.y), bfhi(b.y)};
            const f32x4 y = bv * (w0 * z[0] + w1 * z[1] + w2 * z[2]);
            float ss = (y.x * y.x + y.y * y.y) + (y.z * y.z + y.w * y.w); ss = wave_sum(ss);
            const float sc = rsqf_(ss * (1.f / 256.f) + NORM_EPS);
            v2u o; o.x = pk2(y.x * sc, y.y * sc); o.y = pk2(y.z * sc, y.w * sc);
            *(GAS v2u*)(merged + (size_t)(bb * T + t) * DM + 0 + c4) = o;
}
    }
}

__device__ __forceinline__ void mix_na_item(Frame& F, int l, int item, LAS unsigned char* wl, const LAS float* RPB) {
    LAUNDER(F);
    const GAS bf16* proj = (const GAS bf16*)(F.ws + WS_PROJ); GAS bf16* merged = (GAS bf16*)(F.ws + WS_MERGED);
    const int lane = F.lane, i = lane & 15, g = lane >> 4;
    const int qg = item & 3, r = (item >> 2) & 63, bb = item >> 8;
    const int c0 = 16 * qg;
    int rs = r - 4; rs = rs < 0 ? 0 : (rs > 56 ? 56 : rs);
    int cs = c0 - 8; cs = cs < 0 ? 0 : (cs > 32 ? 32 : cs);
    LAS unsigned char* PL = wl; LAS unsigned char* VL = wl + 4096; LAS unsigned char* OL = wl + 8192;
    const size_t rowbase = (size_t)bb * T;
    float ssq[4] = {0.f, 0.f, 0.f, 0.f};
#pragma unroll 1
    for (int h = 0; h < 4; ++h) {
        bf16x8 qf[2];
        { const GAS bf16* qrow = proj + (rowbase + r * 64 + c0 + i) * NPROJP + C_NQ + h * 64 + 8 * g;
          qf[0] = *(const GAS bf16x8*)(qrow); qf[1] = *(const GAS bf16x8*)(qrow + 32); }
        f32x4 s[16];
#pragma unroll
        for (int kt = 0; kt < 16; ++kt) { const int kr = kt >> 1, hf = kt & 1;
            const GAS bf16* krow = proj + (rowbase + (rs + kr) * 64 + cs + 16 * hf + i) * NPROJP + C_NK + h * 64 + 8 * g;
            const bf16x8 k0 = *(const GAS bf16x8*)(krow), k1 = *(const GAS bf16x8*)(krow + 32);
            f32x4 a = (f32x4){0.f, 0.f, 0.f, 0.f};
            a = __builtin_amdgcn_mfma_f32_16x16x32_bf16(qf[0], k0, a, 0, 0, 0);
            a = __builtin_amdgcn_mfma_f32_16x16x32_bf16(qf[1], k1, a, 0, 0, 0);
            s[kt] = a; }
        const GAS bf16* vsrc = proj + (rowbase + rs * 64 + cs + (lane >> 3)) * NPROJP + C_NV + h * 64 + 8 * (lane & 7);
        v4u vreg[4][4];
#pragma unroll
        for (int k4 = 0; k4 < 4; ++k4)
#pragma unroll
            for (int q = 0; q < 4; ++q) vreg[k4][q] = *(const GAS v4u*)(vsrc + (size_t)(k4 * 64 + 8 * q) * NPROJP);
        float mx[4] = {-3e38f, -3e38f, -3e38f, -3e38f};
#pragma unroll
        for (int kt = 0; kt < 16; ++kt) { const int kr = kt >> 1, hf = kt & 1; const int cw = cs + 16 * hf + i; const int dy = rs + kr - r + 7;
#pragma unroll
            for (int e = 0; e < 4; ++e) { const int cq = c0 + 4 * g + e; int st = cq - 8; st = st < 0 ? 0 : (st > 48 ? 48 : st);
                int dx = cw - cq; dx = dx < -15 ? -15 : (dx > 15 ? 15 : dx); dx += 15;
                const bool valid = (cw >= st) && (cw < st + 16);
                float v = s[kt][e] * 0.125f + RPB[h * 465 + dy * 31 + dx];
                v = valid ? v : -1e30f; s[kt][e] = v; mx[e] = fmaxf(mx[e], v); } }
        float sm[4];
#pragma unroll
        for (int e = 0; e < 4; ++e) { mx[e] = row16_max(mx[e]); sm[e] = 0.f; }
#pragma unroll
        for (int kt = 0; kt < 16; ++kt)
#pragma unroll
            for (int e = 0; e < 4; ++e) { const float p = __expf(s[kt][e] - mx[e]); s[kt][e] = p; sm[e] += p; }
#pragma unroll
        for (int e = 0; e < 4; ++e) sm[e] = rcpf_(row16_sum(sm[e]));
        f32x4 oh[4];
#pragma unroll
        for (int dt = 0; dt < 4; ++dt) oh[dt] = (f32x4){0.f, 0.f, 0.f, 0.f};
#pragma unroll
        for (int half = 0; half < 2; ++half) {
            CFENCE();
#pragma unroll
            for (int k8 = 0; k8 < 8; ++k8) { const int kt = 8 * half + k8; v2u pw; pw.x = pk2(s[kt][0] * sm[0], s[kt][1] * sm[1]); pw.y = pk2(s[kt][2] * sm[2], s[kt][3] * sm[3]);
                *(LAS v2u*)(PL + (16 * k8 + i) * 32 + 8 * g) = pw; }
            CFENCE();
#pragma unroll
            for (int k4 = 0; k4 < 4; ++k4) { const int kr = 4 * half + k4;
                CFENCE();
#pragma unroll
                for (int q = 0; q < 4; ++q) *(LAS v4u*)(VL + ((lane >> 3) + 8 * q) * 128 + (lane & 7) * 16) = vreg[k4][q];
                if (half == 0) {
#pragma unroll
                    for (int q = 0; q < 4; ++q) vreg[k4][q] = *(const GAS v4u*)(vsrc + (size_t)((kr + 4) * 64 + 8 * q) * NPROJP); }
                CFENCE();
                const LAS unsigned char* pa = PL + (32 * k4 + 8 * g + (i >> 2)) * 32 + 8 * (i & 3);
                const s16x4 plo = __builtin_bit_cast(s16x4, __builtin_amdgcn_ds_read_tr16_b64_v4i16((LAS s16x4*)(pa)));
                const s16x4 phi = __builtin_bit_cast(s16x4, __builtin_amdgcn_ds_read_tr16_b64_v4i16((LAS s16x4*)(pa + 128)));
                const bf16x8 pf = (bf16x8){plo[0], plo[1], plo[2], plo[3], phi[0], phi[1], phi[2], phi[3]};
#pragma unroll
                for (int dt = 0; dt < 4; ++dt) {
                    const LAS unsigned char* va = VL + (8 * g + (i >> 2)) * 128 + (16 * dt + 4 * (i & 3)) * 2;
                    const s16x4 vlo = __builtin_bit_cast(s16x4, __builtin_amdgcn_ds_read_tr16_b64_v4i16((LAS s16x4*)(va)));
                    const s16x4 vhi = __builtin_bit_cast(s16x4, __builtin_amdgcn_ds_read_tr16_b64_v4i16((LAS s16x4*)(va + 512)));
                    const bf16x8 vf = (bf16x8){vlo[0], vlo[1], vlo[2], vlo[3], vhi[0], vhi[1], vhi[2], vhi[3]};
                    oh[dt] = __builtin_amdgcn_mfma_f32_16x16x32_bf16(pf, vf, oh[dt], 0, 0, 0); }
            }
        }
        CFENCE();
#pragma unroll
        for (int dt = 0; dt < 4; ++dt)
#pragma unroll
            for (int e = 0; e < 4; ++e) { ssq[e] += oh[dt][e] * oh[dt][e]; *(LAS unsigned short*)(OL + (4 * g + e) * 512 + (h * 64 + 16 * dt + i) * 2) = (unsigned short)f2bf(oh[dt][e]); }
        CFENCE();
    }
    LAS float* SCL = (LAS float*)VL;
    CFENCE();
#pragma unroll
    for (int e = 0; e < 4; ++e) { const float sc = rsqf_(row16_sum(ssq[e]) * (1.f / 256.f) + NORM_EPS); if (i == 0) SCL[4 * g + e] = sc; }
    CFENCE();
#pragma unroll
    for (int q = 0; q < 8; ++q) { const int e = lane + 64 * q, row = e >> 5, ch = e & 31;
        const v4u v = *(const LAS v4u*)(OL + row * 512 + ch * 16); const float sc = SCL[row];
        v4u o;
#pragma unroll
        for (int t = 0; t < 4; ++t) o[t] = pk2(bflo(v[t]) * sc, bfhi(v[t]) * sc);
        *(GAS v4u*)(merged + (rowbase + r * 64 + c0 + row) * DM + 512 + 8 * ch) = o; }
    CFENCE();
}

constexpr int SG_PITCH = 528;
__device__ __forceinline__ void mix_sgu_item(Frame& F, int l, int item) {
    LAUNDER(F);
    const GAS bf16* proj = (const GAS bf16*)(F.ws + WS_PROJ); GAS bf16* merged = (GAS bf16*)(F.ws + WS_MERGED);
    const int lane = F.lane, w = F.wave, tid = F.tid, i = lane & 15, g = lane >> 4;
    const size_t m0 = (size_t)item * 128;
    LAS unsigned char* VI = F.lds; LAS float* SS = (LAS float*)(F.lds + 128 * SG_PITCH);
    { const int c4 = 4 * lane; const f32x4 gn = *(const f32x4*)(INP(F, I_SGUN) + l * 256 + c4);
      v2u xr[16];
#pragma unroll
      for (int j = 0; j < 16; ++j) xr[j] = *(const GAS v2u*)(proj + (m0 + 16 * w + j) * NPROJP + C_SV + c4);
#pragma unroll
      for (int j = 0; j < 16; ++j) { const int q = 16 * w + j; const v2u x = xr[j];
          f32x4 v = (f32x4){gelu_tanh(bflo(x.x)), gelu_tanh(bfhi(x.x)), gelu_tanh(bflo(x.y)), gelu_tanh(bfhi(x.y))};
          const float mu = wave_sum((v.x + v.y) + (v.z + v.w)) * (1.f / 256.f);
          v = v - mu;
          const float var = wave_sum((v.x * v.x + v.y * v.y) + (v.z * v.z + v.w * v.w)) * (1.f / 256.f);
          const float rstd = rsqf_(var + NORM_EPS);
          v2u o; o.x = pk2(v.x * rstd * gn.x, v.y * rstd * gn.y); o.y = pk2(v.z * rstd * gn.z, v.w * rstd * gn.w);
          *(LAS v2u*)(VI + q * SG_PITCH + c4 * 2) = o; } }
    __syncthreads();
    const int hh = w >> 1, ph = w & 1;
    f32x4 acc[4][4];
#pragma unroll
    for (int a = 0; a < 4; ++a)
#pragma unroll
        for (int b = 0; b < 4; ++b) acc[a][b] = (f32x4){0.f, 0.f, 0.f, 0.f};
    const GAS float* ws_ = INP(F, I_SGUW) + ((size_t)(l * 4 + hh) * 128) * 128;
#pragma unroll
    for (int ks = 0; ks < 4; ++ks) {
        bf16x8 af[4], bfr[4];
#pragma unroll
        for (int pt = 0; pt < 4; ++pt) { const GAS float* ap = ws_ + (size_t)(64 * ph + 16 * pt + i) * 128 + 32 * ks + 8 * g;
            const f32x4 x0 = *(const f32x4*)ap, x1 = *(const f32x4*)(ap + 4);
            const unsigned u0 = pk2(x0.x, x0.y), u1 = pk2(x0.z, x0.w), u2 = pk2(x1.x, x1.y), u3 = pk2(x1.z, x1.w);
            af[pt] = __builtin_bit_cast(bf16x8, (v4u){u0, u1, u2, u3}); }
#pragma unroll
        for (int dt = 0; dt < 4; ++dt) { const LAS unsigned char* va = VI + (32 * ks + 8 * g + (i >> 2)) * SG_PITCH + (hh * 64 + 16 * dt + 4 * (i & 3)) * 2;
            const s16x4 lo = __builtin_bit_cast(s16x4, __builtin_amdgcn_ds_read_tr16_b64_v4i16((LAS s16x4*)(va)));
            const s16x4 hi = __builtin_bit_cast(s16x4, __builtin_amdgcn_ds_read_tr16_b64_v4i16((LAS s16x4*)(va + 4 * SG_PITCH)));
            bfr[dt] = (bf16x8){lo[0], lo[1], lo[2], lo[3], hi[0], hi[1], hi[2], hi[3]}; }
#pragma unroll
        for (int pt = 0; pt < 4; ++pt)
#pragma unroll
            for (int dt = 0; dt < 4; ++dt) acc[pt][dt] = __builtin_amdgcn_mfma_f32_16x16x32_bf16(af[pt], bfr[dt], acc[pt][dt], 0, 0, 0);
    }
#pragma unroll
    for (int pt = 0; pt < 4; ++pt) {
        unsigned short ur[4][4];
#pragma unroll
        for (int e = 0; e < 4; ++e)
#pragma unroll
            for (int dt = 0; dt < 4; ++dt) ur[e][dt] = proj[(m0 + 64 * ph + 16 * pt + 4 * g + e) * NPROJP + C_SU + hh * 64 + 16 * dt + i];
#pragma unroll
        for (int e = 0; e < 4; ++e) { const int p = 64 * ph + 16 * pt + 4 * g + e; const float bs = INP(F, I_SGUB)[(l * 4 + hh) * 128 + p]; float ss = 0.f;
#pragma unroll
            for (int dt = 0; dt < 4; ++dt) { const float u = gelu_tanh(bf2f(ur[e][dt]));
                const float v = u * (acc[pt][dt][e] + bs); acc[pt][dt][e] = v; ss += v * v; }
            ss = row16_sum(ss); if (i == 0) SS[p * 4 + hh] = ss; } }
    __syncthreads();
#pragma unroll
    for (int pt = 0; pt < 4; ++pt)
#pragma unroll
        for (int e = 0; e < 4; ++e) { const int p = 64 * ph + 16 * pt + 4 * g + e; const f32x4 s4 = *(const LAS f32x4*)(SS + p * 4);
            const float sc = rsqf_(((s4.x + s4.y) + (s4.z + s4.w)) * (1.f / 256.f) + NORM_EPS);
#pragma unroll
            for (int dt = 0; dt < 4; ++dt) *(LAS unsigned short*)(VI + p * SG_PITCH + (hh * 64 + 16 * dt + i) * 2) = (unsigned short)f2bf(acc[pt][dt][e] * sc); }
    __syncthreads();
#pragma unroll
    for (int q = 0; q < 8; ++q) { const int e = tid + 512 * q, row = e >> 5, ch = e & 31;
        const v4u v = *(const LAS v4u*)(VI + row * SG_PITCH + ch * 16);
        *(GAS v4u*)(merged + (m0 + row) * DM + 768 + 8 * ch) = v; }
    __syncthreads();
}

__device__ __forceinline__ void phase_mix_na(Frame& F, int l, int bidx, int nblk) {
    LAUNDER(F);
    LAS float* RPB = (LAS float*)(F.lds + RING_BYTES + 1024);
    for (int q = F.tid; q < 4 * 465; q += NTHREADS) RPB[q] = INP(F, I_RPB)[l * 4 * 465 + q];
    __syncthreads();
    for (int it = bidx * NWAVES + F.wave; it < NB * 64 * 4; it += nblk * NWAVES) mix_na_item(F, l, it, F.lds + F.wave * 16384, RPB);
    __syncthreads();
#ifdef SGU_IN_C2
    for (int it = bidx; it < NB * 32; it += nblk) mix_sgu_item(F, l, it);
#endif
}
__device__ __forceinline__ void phase_mixers(Frame& F, int l) {
    LAUNDER(F);
    for (int tile = F.vcu; tile < M / 64; tile += F.G) mix_convprep_tile(F, l, tile);
    __syncthreads();
#ifndef SGU_IN_C2
    for (int it = F.vcu; it < NB * 32; it += F.G) mix_sgu_item(F, l, it);
#endif
}

constexpr int C1_RES = 65536, C1_RES_D = 15616;
constexpr int C1_ZT = 0, C1_ET = 4096, C1_QT = 8192, C1_CT = 12288, C1_DA = 13312, C1_UH = 13568;
constexpr int C1_IMG = 0, C1_IMG_D = 16384, C1_SC = 0, C1_SCST = 144, C1_CM = 9216, C1_DM = 15360, C1_DL = 15616;
typedef _Float16 h4 __attribute__((ext_vector_type(4)));
typedef _Float16 h8 __attribute__((ext_vector_type(8)));
__device__ __forceinline__ bf16x8 pack8(f32x4 lo, f32x4 hi) { return __builtin_bit_cast(bf16x8, (v4u){pg8::cvt_pk_bf16(lo.x, lo.y), pg8::cvt_pk_bf16(lo.z, lo.w), pg8::cvt_pk_bf16(hi.x, hi.y), pg8::cvt_pk_bf16(hi.z, hi.w)}); }
template <int MODE>
__device__ __forceinline__ void phase_scan_c1(Frame& F, int l) {
    LAUNDER(F);
    const GAS bf16* proj = (const GAS bf16*)(F.ws + WS_PROJ);
    const int lane = F.lane, w = F.wave, i = lane & 15, g = lane >> 4;
    const int d = w >> 2, wa = w & 3;
    const int bh = F.vcu >> 3, bb = bh >> 2, h = bh & 3;
    LAS unsigned char* lds = F.lds;
    bf16x8 Bw, Ba;
    { f32x4 xw0 = (f32x4){0.f, 0.f, 0.f, 0.f}, xw1 = xw0, xa0 = xw0, xa1 = xw0;
      if (g < 2) { const GAS float* pw = INP(F, I_RWUP) + ((size_t)(l * 2 + d) * 16 + 8 * g) * 256 + h * 64 + 16 * wa + i; const GAS float* pa = INP(F, I_RAUP) + ((size_t)(l * 2 + d) * 16 + 8 * g) * 256 + h * 64 + 16 * wa + i;
          xw0 = (f32x4){pw[0], pw[256], pw[512], pw[768]}; xw1 = (f32x4){pw[1024], pw[1280], pw[1536], pw[1792]};
          xa0 = (f32x4){pa[0], pa[256], pa[512], pa[768]}; xa1 = (f32x4){pa[1024], pa[1280], pa[1536], pa[1792]}; }
      Bw = pack8(xw0, xw1); Ba = pack8(xa0, xa1); }
    const float w0c = INP(F, I_RW0)[(l * 2 + d) * 256 + h * 64 + 16 * wa + i], a0c = INP(F, I_RA0)[(l * 2 + d) * 256 + h * 64 + 16 * wa + i], kag = INP(F, I_RKA)[l * 256 + h * 64 + 16 * wa + i];
    float kkg[4];
#pragma unroll
    for (int t = 0; t < 4; ++t) kkg[t] = INP(F, I_RKK)[l * 256 + h * 64 + 16 * t + i];
    const float kkgw = INP(F, I_RKK)[l * 256 + h * 64 + 16 * wa + i];
    const int c = 16 * wa + i;
    const int sq = d ? 3 - g : g;
#define C1_BAR() do { asm volatile("s_waitcnt lgkmcnt(0)" ::: "memory"); __builtin_amdgcn_s_barrier(); asm volatile("" ::: "memory"); } while (0)
    unsigned short kq[4][4], kown[4], rq[4]; v4u dvr, ivr;
#define C1_LOAD(B_) do { const size_t m0_ = (size_t)bb * T + 16 * (B_); \
        _Pragma("unroll") for (int e_ = 0; e_ < 4; ++e_) { const GAS bf16* row_ = proj + (m0_ + 4 * g + e_) * NPROJP; \
            _Pragma("unroll") for (int t_ = 0; t_ < 4; ++t_) kq[t_][e_] = row_[C_K + h * 64 + 16 * t_ + i]; \
            rq[e_] = row_[C_R + h * 64 + 16 * wa + i]; kown[e_] = row_[C_K + h * 64 + 16 * wa + i]; } \
        { const GAS bf16* arow_ = proj + (m0_ + i) * NPROJP + C_DEC + 16 * d + 8 * (g & 1); dvr = *(const GAS v4u*)(arow_); ivr = *(const GAS v4u*)(arow_ + 32); } } while (0)
    const int B0 = (F.vcu & 7) * 32;
    C1_LOAD(B0);
    {
        const int it = 0;
        { const int B = B0 + it; LAS unsigned char* IMG = lds + C1_IMG + ((it & 1) * 2 + d) * C1_IMG_D; (void)B;
        if (MODE != 3) {
            v4u dv = (v4u){0u, 0u, 0u, 0u}, iv = dv;
            if (g < 2) { iv = ivr;
#pragma unroll
                for (int q = 0; q < 4; ++q) dv[q] = pk2(tanhf_(bflo(dvr[q])), tanhf_(bfhi(dvr[q]))); }
            const f32x4 z4 = (f32x4){0.f, 0.f, 0.f, 0.f};
            const f32x4 Dw = __builtin_amdgcn_mfma_f32_16x16x32_bf16(__builtin_bit_cast(bf16x8, dv), Bw, z4, 0, 0, 0);
            const f32x4 Da = __builtin_amdgcn_mfma_f32_16x16x32_bf16(__builtin_bit_cast(bf16x8, iv), Ba, z4, 0, 0, 0);
            float vw[4], vk[4], vb[4], ve[4], vr[4];
#pragma unroll
            for (int e = 0; e < 4; ++e) {
                float ss = 0.f;
#pragma unroll
                for (int t = 0; t < 4; ++t) { const float x = bf2f(kq[t][e]) * kkg[t]; ss += x * x; }
                ss = row16_sum(ss);
                const float k = bf2f(kown[e]); const float kk = k * kkgw * rsqf_(ss + 1e-12f);
                const float wv = __expf(-DECAY_SCALE * sigmoidf_(w0c + Dw[e])), av = sigmoidf_(a0c + Da[e]);
                vw[e] = wv; vk[e] = kk; vb[e] = kk * av; ve[e] = k * (1.f + (av - 1.f) * kag); vr[e] = bf2f(rq[e]); }
            if (d) {
#define C1_SWAP(a_) do { float t0_ = a_[0], t1_ = a_[1]; a_[0] = a_[3]; a_[1] = a_[2]; a_[2] = t1_; a_[3] = t0_; } while (0)
                C1_SWAP(vw); C1_SWAP(vk); C1_SWAP(vb); C1_SWAP(ve); C1_SWAP(vr);
#undef C1_SWAP
            }
            float Dp[4], Dt[4];
            const float c1 = vw[0], c2 = c1 * vw[1], c3 = c2 * vw[2], c4 = c3 * vw[3];
            const float q0 = __shfl(c4, (d ? 48 : 0) + i), q1 = __shfl(c4, (d ? 32 : 16) + i), q2 = __shfl(c4, (d ? 16 : 32) + i);
            const float Dm = q0 * q1;
            const float off = sq == 0 ? 1.f : (sq == 1 ? q0 : (sq == 2 ? Dm : Dm * q2));
            Dp[0] = off; Dp[1] = off * c1; Dp[2] = off * c2; Dp[3] = off * c3;
            Dt[0] = Dp[1]; Dt[1] = Dp[2]; Dt[2] = Dp[3]; Dt[3] = off * c4;
            const float rDm = rcpf_(Dm);
            h4 hk, hb, he;
#pragma unroll
            for (int e = 0; e < 4; ++e) { const float rDt = rcpf_(Dt[e]);
                const float kap = vk[e] * Dp[e] * rDm, rr = vr[e] * Dt[e] * rDm, bq = vb[e] * Dm * rDt, eq = ve[e] * Dm * rDt;
                const int s = 4 * sq + e;
                ((LAS _Float16*)(IMG + C1_SC + (0 * 16 + s) * C1_SCST))[c] = (_Float16)kap; ((LAS _Float16*)(IMG + C1_SC + (1 * 16 + s) * C1_SCST))[c] = (_Float16)rr;
                ((LAS _Float16*)(IMG + C1_SC + (2 * 16 + s) * C1_SCST))[c] = (_Float16)bq;  ((LAS _Float16*)(IMG + C1_SC + (3 * 16 + s) * C1_SCST))[c] = (_Float16)eq;
                hk[e] = (_Float16)kap; hb[e] = (_Float16)bq; he[e] = (_Float16)eq; }
            *(LAS h4*)(IMG + C1_CM + c * 96 + 0 + sq * 8) = hk; *(LAS h4*)(IMG + C1_CM + c * 96 + 32 + sq * 8) = hb; *(LAS h4*)(IMG + C1_CM + c * 96 + 64 + sq * 8) = he;
            if (sq == 3) *(LAS float*)(IMG + C1_DL + c * 4) = Dt[3];
            if (sq == 0) *(LAS float*)(IMG + C1_DM + c * 4) = Dm;
        }
        }
        if (it + 1 < 32) C1_LOAD(B0 + it + 1);
        C1_BAR();
    }
    {
        const int it = 1;
        { const int B = B0 + it; LAS unsigned char* IMG = lds + C1_IMG + ((it & 1) * 2 + d) * C1_IMG_D; (void)B;
        if (MODE != 3) {
            v4u dv = (v4u){0u, 0u, 0u, 0u}, iv = dv;
            if (g < 2) { iv = ivr;
#pragma unroll
                for (int q = 0; q < 4; ++q) dv[q] = pk2(tanhf_(bflo(dvr[q])), tanhf_(bfhi(dvr[q]))); }
            const f32x4 z4 = (f32x4){0.f, 0.f, 0.f, 0.f};
            const f32x4 Dw = __builtin_amdgcn_mfma_f32_16x16x32_bf16(__builtin_bit_cast(bf16x8, dv), Bw, z4, 0, 0, 0);
            const f32x4 Da = __builtin_amdgcn_mfma_f32_16x16x32_bf16(__builtin_bit_cast(bf16x8, iv), Ba, z4, 0, 0, 0);
            float vw[4], vk[4], vb[4], ve[4], vr[4];
#pragma unroll
            for (int e = 0; e < 4; ++e) {
                float ss = 0.f;
#pragma unroll
                for (int t = 0; t < 4; ++t) { const float x = bf2f(kq[t][e]) * kkg[t]; ss += x * x; }
                ss = row16_sum(ss);
                const float k = bf2f(kown[e]); const float kk = k * kkgw * rsqf_(ss + 1e-12f);
                const float wv = __expf(-DECAY_SCALE * sigmoidf_(w0c + Dw[e])), av = sigmoidf_(a0c + Da[e]);
                vw[e] = wv; vk[e] = kk; vb[e] = kk * av; ve[e] = k * (1.f + (av - 1.f) * kag); vr[e] = bf2f(rq[e]); }
            if (d) {
#define C1_SWAP(a_) do { float t0_ = a_[0], t1_ = a_[1]; a_[0] = a_[3]; a_[1] = a_[2]; a_[2] = t1_; a_[3] = t0_; } while (0)
                C1_SWAP(vw); C1_SWAP(vk); C1_SWAP(vb); C1_SWAP(ve); C1_SWAP(vr);
#undef C1_SWAP
            }
            float Dp[4], Dt[4];
            const float c1 = vw[0], c2 = c1 * vw[1], c3 = c2 * vw[2], c4 = c3 * vw[3];
            const float q0 = __shfl(c4, (d ? 48 : 0) + i), q1 = __shfl(c4, (d ? 32 : 16) + i), q2 = __shfl(c4, (d ? 16 : 32) + i);
            const float Dm = q0 * q1;
            const float off = sq == 0 ? 1.f : (sq == 1 ? q0 : (sq == 2 ? Dm : Dm * q2));
            Dp[0] = off; Dp[1] = off * c1; Dp[2] = off * c2; Dp[3] = off * c3;
            Dt[0] = Dp[1]; Dt[1] = Dp[2]; Dt[2] = Dp[3]; Dt[3] = off * c4;
            const float rDm = rcpf_(Dm);
            h4 hk, hb, he;
#pragma unroll
            for (int e = 0; e < 4; ++e) { const float rDt = rcpf_(Dt[e]);
                const float kap = vk[e] * Dp[e] * rDm, rr = vr[e] * Dt[e] * rDm, bq = vb[e] * Dm * rDt, eq = ve[e] * Dm * rDt;
                const int s = 4 * sq + e;
                ((LAS _Float16*)(IMG + C1_SC + (0 * 16 + s) * C1_SCST))[c] = (_Float16)kap; ((LAS _Float16*)(IMG + C1_SC + (1 * 16 + s) * C1_SCST))[c] = (_Float16)rr;
                ((LAS _Float16*)(IMG + C1_SC + (2 * 16 + s) * C1_SCST))[c] = (_Float16)bq;  ((LAS _Float16*)(IMG + C1_SC + (3 * 16 + s) * C1_SCST))[c] = (_Float16)eq;
                hk[e] = (_Float16)kap; hb[e] = (_Float16)bq; he[e] = (_Float16)eq; }
            *(LAS h4*)(IMG + C1_CM + c * 96 + 0 + sq * 8) = hk; *(LAS h4*)(IMG + C1_CM + c * 96 + 32 + sq * 8) = hb; *(LAS h4*)(IMG + C1_CM + c * 96 + 64 + sq * 8) = he;
            if (sq == 3) *(LAS float*)(IMG + C1_DL + c * 4) = Dt[3];
            if (sq == 0) *(LAS float*)(IMG + C1_DM + c * 4) = Dm;
        }
        }
        if (it + 1 < 32) C1_LOAD(B0 + it + 1);
        { const LAS unsigned char* IMG = lds + C1_IMG + (((it - 1) & 1) * 2 + d) * C1_IMG_D; LAS unsigned char* R = lds + C1_RES + (((it - 1) & 1) * 2 + d) * C1_RES_D;
        if (MODE != 1 && MODE != 4) {
            h8 fk[2], fr[2], fb[2], fe[2];
#pragma unroll
            for (int ks = 0; ks < 2; ++ks) { const LAS unsigned char* p = IMG + C1_SC + i * C1_SCST + (8 * g + 32 * ks) * 2;
                fk[ks] = *(const LAS h8*)(p); fr[ks] = *(const LAS h8*)(p + 16 * C1_SCST); fb[ks] = *(const LAS h8*)(p + 32 * C1_SCST); fe[ks] = *(const LAS h8*)(p + 48 * C1_SCST); }
            const f32x4 z4 = (f32x4){0.f, 0.f, 0.f, 0.f};
            f32x4 aN = z4, aNT = z4, aM = z4, aMT = z4, aNr = z4, aMr = z4;
#pragma unroll
            for (int ks = 0; ks < 2; ++ks) {
                aN  = __builtin_amdgcn_mfma_f32_16x16x32_f16(fb[ks], fk[ks], aN, 0, 0, 0);  aNT = __builtin_amdgcn_mfma_f32_16x16x32_f16(fk[ks], fb[ks], aNT, 0, 0, 0);
                aM  = __builtin_amdgcn_mfma_f32_16x16x32_f16(fe[ks], fk[ks], aM, 0, 0, 0);  aMT = __builtin_amdgcn_mfma_f32_16x16x32_f16(fk[ks], fe[ks], aMT, 0, 0, 0);
                aNr = __builtin_amdgcn_mfma_f32_16x16x32_f16(fb[ks], fr[ks], aNr, 0, 0, 0); aMr = __builtin_amdgcn_mfma_f32_16x16x32_f16(fe[ks], fr[ks], aMr, 0, 0, 0); }
#pragma unroll
            for (int e = 0; e < 4; ++e) { const int row = 4 * g + e;
                aN[e] = row < i ? -aN[e] : 0.f; aNT[e] = i < row ? -aNT[e] : 0.f; aM[e] = row < i ? aM[e] : 0.f; aMT[e] = i < row ? aMT[e] : 0.f;
                aNr[e] = row <= i ? aNr[e] : 0.f; aMr[e] = row <= i ? aMr[e] : 0.f; }
#define C1_H4(x_) __builtin_convertvector((x_), h4)
#define C1_MM(a_, b_, c_) __builtin_amdgcn_mfma_f32_16x16x16f16((a_), (b_), (c_), 0, 0, 0)
            f32x4 S = aN, ST = aNT;
#pragma unroll
            for (int e = 0; e < 4; ++e) if (4 * g + e == i) { S[e] += 1.f; ST[e] += 1.f; }
            const h4 hA = C1_H4(aN), hAT = C1_H4(aNT);
            const f32x4 P2 = C1_MM(hAT, hA, z4), P2T = C1_MM(hA, hAT, z4);
            const h4 hP2 = C1_H4(P2), hP2T = C1_H4(P2T);
            { const h4 hS = C1_H4(S); S = C1_MM(hP2T, hS, S); ST = C1_MM(hS, hP2T, ST); }
            const f32x4 P4 = C1_MM(hP2T, hP2, z4), P4T = C1_MM(hP2, hP2T, z4);
            const h4 hP4 = C1_H4(P4), hP4T = C1_H4(P4T);
            { const h4 hS = C1_H4(S); S = C1_MM(hP4T, hS, S); ST = C1_MM(hS, hP4T, ST); }
            const f32x4 P8T = C1_MM(hP4, hP4T, z4);
            const h4 hP8T = C1_H4(P8T);
            { const h4 hS = C1_H4(S); ST = C1_MM(hS, hP8T, ST); }
            const h4 hTT = C1_H4(ST), hMT = C1_H4(aMT);
            const f32x4 X1 = C1_MM(hTT, C1_H4(aNr), z4);
            const h4 hX1 = C1_H4(X1);
            const h4 bT = *(const LAS h4*)(IMG + C1_CM + c * 96 + 32 + g * 8);
            const f32x4 X2 = C1_MM(hTT, bT, z4);
            const float dl = *(const LAS float*)(IMG + C1_DL + c * 4), dm = *(const LAS float*)(IMG + C1_DM + c * 4);
            *(LAS f32x4*)(R + C1_ZT + c * 64 + 16 * g) = X2 * dl;
            const f32x4 Ea = C1_MM(hMT, C1_H4(X2), z4);
            const h4 kh = *(const LAS h4*)(IMG + C1_CM + c * 96 + 64 + g * 8);
            *(LAS f32x4*)(R + C1_ET + c * 64 + 16 * g) = (__builtin_convertvector(kh, f32x4) - Ea) * (dl * rcpf_(dm));
            const h4 kT = *(const LAS h4*)(IMG + C1_CM + c * 96 + g * 8);
            const f32x4 Qa = C1_MM(kT, hX1, z4);
            const h4 rh = *(const LAS h4*)(IMG + C1_SC + (16 + i) * C1_SCST + (16 * wa + 4 * g) * 2);
            const f32x4 dm4 = *(const LAS f32x4*)(IMG + C1_DM + (16 * wa + 4 * g) * 4);
            *(LAS f32x4*)(R + C1_QT + i * 256 + (16 * wa + 4 * g) * 4) = (__builtin_convertvector(rh, f32x4) - Qa) * dm4;
            if (wa == 0) { const f32x4 Ca = C1_MM(hMT, hX1, z4); *(LAS f32x4*)(R + C1_CT + i * 64 + 16 * g) = aMr - Ca; }
            *(LAS h4*)(R + C1_UH + c * 32 + 8 * g) = kT;
            if (g == 0) *(LAS float*)(R + C1_DA + c * 4) = dl;
#undef C1_H4
#undef C1_MM
        }
        }
        C1_BAR();
    }
    for (int itv = 2; itv < 32; ++itv)
    {
        const int it = itv;
        { const int B = B0 + it; LAS unsigned char* IMG = lds + C1_IMG + ((it & 1) * 2 + d) * C1_IMG_D; (void)B;
        if (MODE != 3) {
            v4u dv = (v4u){0u, 0u, 0u, 0u}, iv = dv;
            if (g < 2) { iv = ivr;
#pragma unroll
                for (int q = 0; q < 4; ++q) dv[q] = pk2(tanhf_(bflo(dvr[q])), tanhf_(bfhi(dvr[q]))); }
            const f32x4 z4 = (f32x4){0.f, 0.f, 0.f, 0.f};
            const f32x4 Dw = __builtin_amdgcn_mfma_f32_16x16x32_bf16(__builtin_bit_cast(bf16x8, dv), Bw, z4, 0, 0, 0);
            const f32x4 Da = __builtin_amdgcn_mfma_f32_16x16x32_bf16(__builtin_bit_cast(bf16x8, iv), Ba, z4, 0, 0, 0);
            float vw[4], vk[4], vb[4], ve[4], vr[4];
#pragma unroll
            for (int e = 0; e < 4; ++e) {
                float ss = 0.f;
#pragma unroll
                for (int t = 0; t < 4; ++t) { const float x = bf2f(kq[t][e]) * kkg[t]; ss += x * x; }
                ss = row16_sum(ss);
                const float k = bf2f(kown[e]); const float kk = k * kkgw * rsqf_(ss + 1e-12f);
                const float wv = __expf(-DECAY_SCALE * sigmoidf_(w0c + Dw[e])), av = sigmoidf_(a0c + Da[e]);
                vw[e] = wv; vk[e] = kk; vb[e] = kk * av; ve[e] = k * (1.f + (av - 1.f) * kag); vr[e] = bf2f(rq[e]); }
            if (d) {
#define C1_SWAP(a_) do { float t0_ = a_[0], t1_ = a_[1]; a_[0] = a_[3]; a_[1] = a_[2]; a_[2] = t1_; a_[3] = t0_; } while (0)
                C1_SWAP(vw); C1_SWAP(vk); C1_SWAP(vb); C1_SWAP(ve); C1_SWAP(vr);
#undef C1_SWAP
            }
            float Dp[4], Dt[4];
            const float c1 = vw[0], c2 = c1 * vw[1], c3 = c2 * vw[2], c4 = c3 * vw[3];
            const float q0 = __shfl(c4, (d ? 48 : 0) + i), q1 = __shfl(c4, (d ? 32 : 16) + i), q2 = __shfl(c4, (d ? 16 : 32) + i);
            const float Dm = q0 * q1;
            const float off = sq == 0 ? 1.f : (sq == 1 ? q0 : (sq == 2 ? Dm : Dm * q2));
            Dp[0] = off; Dp[1] = off * c1; Dp[2] = off * c2; Dp[3] = off * c3;
            Dt[0] = Dp[1]; Dt[1] = Dp[2]; Dt[2] = Dp[3]; Dt[3] = off * c4;
            const float rDm = rcpf_(Dm);
            h4 hk, hb, he;
#pragma unroll
            for (int e = 0; e < 4; ++e) { const float rDt = rcpf_(Dt[e]);
                const float kap = vk[e] * Dp[e] * rDm, rr = vr[e] * Dt[e] * rDm, bq = vb[e] * Dm * rDt, eq = ve[e] * Dm * rDt;
                const int s = 4 * sq + e;
                ((LAS _Float16*)(IMG + C1_SC + (0 * 16 + s) * C1_SCST))[c] = (_Float16)kap; ((LAS _Float16*)(IMG + C1_SC + (1 * 16 + s) * C1_SCST))[c] = (_Float16)rr;
                ((LAS _Float16*)(IMG + C1_SC + (2 * 16 + s) * C1_SCST))[c] = (_Float16)bq;  ((LAS _Float16*)(IMG + C1_SC + (3 * 16 + s) * C1_SCST))[c] = (_Float16)eq;
                hk[e] = (_Float16)kap; hb[e] = (_Float16)bq; he[e] = (_Float16)eq; }
            *(LAS h4*)(IMG + C1_CM + c * 96 + 0 + sq * 8) = hk; *(LAS h4*)(IMG + C1_CM + c * 96 + 32 + sq * 8) = hb; *(LAS h4*)(IMG + C1_CM + c * 96 + 64 + sq * 8) = he;
            if (sq == 3) *(LAS float*)(IMG + C1_DL + c * 4) = Dt[3];
            if (sq == 0) *(LAS float*)(IMG + C1_DM + c * 4) = Dm;
        }
        }
        if (it + 1 < 32) C1_LOAD(B0 + it + 1);
        { const LAS unsigned char* IMG = lds + C1_IMG + (((it - 1) & 1) * 2 + d) * C1_IMG_D; LAS unsigned char* R = lds + C1_RES + (((it - 1) & 1) * 2 + d) * C1_RES_D;
        if (MODE != 1 && MODE != 4) {
            h8 fk[2], fr[2], fb[2], fe[2];
#pragma unroll
            for (int ks = 0; ks < 2; ++ks) { const LAS unsigned char* p = IMG + C1_SC + i * C1_SCST + (8 * g + 32 * ks) * 2;
                fk[ks] = *(const LAS h8*)(p); fr[ks] = *(const LAS h8*)(p + 16 * C1_SCST); fb[ks] = *(const LAS h8*)(p + 32 * C1_SCST); fe[ks] = *(const LAS h8*)(p + 48 * C1_SCST); }
            const f32x4 z4 = (f32x4){0.f, 0.f, 0.f, 0.f};
            f32x4 aN = z4, aNT = z4, aM = z4, aMT = z4, aNr = z4, aMr = z4;
#pragma unroll
            for (int ks = 0; ks < 2; ++ks) {
                aN  = __builtin_amdgcn_mfma_f32_16x16x32_f16(fb[ks], fk[ks], aN, 0, 0, 0);  aNT = __builtin_amdgcn_mfma_f32_16x16x32_f16(fk[ks], fb[ks], aNT, 0, 0, 0);
                aM  = __builtin_amdgcn_mfma_f32_16x16x32_f16(fe[ks], fk[ks], aM, 0, 0, 0);  aMT = __builtin_amdgcn_mfma_f32_16x16x32_f16(fk[ks], fe[ks], aMT, 0, 0, 0);
                aNr = __builtin_amdgcn_mfma_f32_16x16x32_f16(fb[ks], fr[ks], aNr, 0, 0, 0); aMr = __builtin_amdgcn_mfma_f32_16x16x32_f16(fe[ks], fr[ks], aMr, 0, 0, 0); }
#pragma unroll
            for (int e = 0; e < 4; ++e) { const int row = 4 * g + e;
                aN[e] = row < i ? -aN[e] : 0.f; aNT[e] = i < row ? -aNT[e] : 0.f; aM[e] = row < i ? aM[e] : 0.f; aMT[e] = i < row ? aMT[e] : 0.f;
                aNr[e] = row <= i ? aNr[e] : 0.f; aMr[e] = row <= i ? aMr[e] : 0.f; }
#define C1_H4(x_) __builtin_convertvector((x_), h4)
#define C1_MM(a_, b_, c_) __builtin_amdgcn_mfma_f32_16x16x16f16((a_), (b_), (c_), 0, 0, 0)
            f32x4 S = aN, ST = aNT;
#pragma unroll
            for (int e = 0; e < 4; ++e) if (4 * g + e == i) { S[e] += 1.f; ST[e] += 1.f; }
            const h4 hA = C1_H4(aN), hAT = C1_H4(aNT);
            const f32x4 P2 = C1_MM(hAT, hA, z4), P2T = C1_MM(hA, hAT, z4);
            const h4 hP2 = C1_H4(P2), hP2T = C1_H4(P2T);
            { const h4 hS = C1_H4(S); S = C1_MM(hP2T, hS, S); ST = C1_MM(hS, hP2T, ST); }
            const f32x4 P4 = C1_MM(hP2T, hP2, z4), P4T = C1_MM(hP2, hP2T, z4);
            const h4 hP4 = C1_H4(P4), hP4T = C1_H4(P4T);
            { const h4 hS = C1_H4(S); S = C1_MM(hP4T, hS, S); ST = C1_MM(hS, hP4T, ST); }
            const f32x4 P8T = C1_MM(hP4, hP4T, z4);
            const h4 hP8T = C1_H4(P8T);
            { const h4 hS = C1_H4(S); ST = C1_MM(hS, hP8T, ST); }
            const h4 hTT = C1_H4(ST), hMT = C1_H4(aMT);
            const f32x4 X1 = C1_MM(hTT, C1_H4(aNr), z4);
            const h4 hX1 = C1_H4(X1);
            const h4 bT = *(const LAS h4*)(IMG + C1_CM + c * 96 + 32 + g * 8);
            const f32x4 X2 = C1_MM(hTT, bT, z4);
            const float dl = *(const LAS float*)(IMG + C1_DL + c * 4), dm = *(const LAS float*)(IMG + C1_DM + c * 4);
            *(LAS f32x4*)(R + C1_ZT + c * 64 + 16 * g) = X2 * dl;
            const f32x4 Ea = C1_MM(hMT, C1_H4(X2), z4);
            const h4 kh = *(const LAS h4*)(IMG + C1_CM + c * 96 + 64 + g * 8);
            *(LAS f32x4*)(R + C1_ET + c * 64 + 16 * g) = (__builtin_convertvector(kh, f32x4) - Ea) * (dl * rcpf_(dm));
            const h4 kT = *(const LAS h4*)(IMG + C1_CM + c * 96 + g * 8);
            const f32x4 Qa = C1_MM(kT, hX1, z4);
            const h4 rh = *(const LAS h4*)(IMG + C1_SC + (16 + i) * C1_SCST + (16 * wa + 4 * g) * 2);
            const f32x4 dm4 = *(const LAS f32x4*)(IMG + C1_DM + (16 * wa + 4 * g) * 4);
            *(LAS f32x4*)(R + C1_QT + i * 256 + (16 * wa + 4 * g) * 4) = (__builtin_convertvector(rh, f32x4) - Qa) * dm4;
            if (wa == 0) { const f32x4 Ca = C1_MM(hMT, hX1, z4); *(LAS f32x4*)(R + C1_CT + i * 64 + 16 * g) = aMr - Ca; }
            *(LAS h4*)(R + C1_UH + c * 32 + 8 * g) = kT;
            if (g == 0) *(LAS float*)(R + C1_DA + c * 4) = dl;
#undef C1_H4
#undef C1_MM
        }
        }
        { const int B = B0 + it - 2; const LAS unsigned char* R = lds + C1_RES + ((it & 1) * 2 + d) * C1_RES_D;
        if (MODE != 2 && MODE != 4) {
            const int n = d ? 255 - B : B;
            GAS unsigned char* gt = (d ? (GAS unsigned char*)F.out : F.ws + WS_GT0) + ((size_t)(bb * 4 + h) * 256 + n) * GT_CHUNK;
            const int nt = wa;
            bf16x8 zf = (bf16x8){0, 0, 0, 0, 0, 0, 0, 0};
            if (g < 2) { const LAS f32x4* zp = (const LAS f32x4*)(R + C1_ZT + (16 * nt + i) * 64 + 32 * g); zf = pack8(zp[0], zp[1]); }
            f32x4 pp[4];
#pragma unroll
            for (int ct = 0; ct < 4; ++ct) {
                bf16x8 uf = (bf16x8){0, 0, 0, 0, 0, 0, 0, 0};
                if (g < 2) { const LAS h4* up = (const LAS h4*)(R + C1_UH + (16 * ct + i) * 32 + 16 * g); uf = pack8(__builtin_convertvector(up[0], f32x4), __builtin_convertvector(up[1], f32x4)); }
                const f32x4 dd = __builtin_amdgcn_mfma_f32_16x16x32_bf16(uf, zf, (f32x4){0.f, 0.f, 0.f, 0.f}, 0, 0, 0);
                f32x4 pv = -dd;
                if (ct == nt) { const f32x4 da = *(const LAS f32x4*)(R + C1_DA + (16 * ct + 4 * g) * 4);
#pragma unroll
                    for (int e = 0; e < 4; ++e) if (4 * g + e == i) pv[e] += da[e]; }
                pp[ct] = pv; }
#undef C1_ST
#define C1_ST(p_, v_) do { const bf16x8 v__ = (v_); if (MODE == 0) *(GAS bf16x8*)(p_) = v__; else asm volatile("" :: "v"(v__)); } while (0)
            C1_ST(gt + (nt * 2 + 0) * 1024 + lane * 16, pack8(pp[0], pp[1]));
            C1_ST(gt + (nt * 2 + 1) * 1024 + lane * 16, pack8(pp[2], pp[3]));
            if (g < 2) { const LAS f32x4* ep = (const LAS f32x4*)(R + C1_ET + (16 * nt + i) * 64 + 32 * g); C1_ST(gt + 10240 + nt * 512 + lane * 16, pack8(ep[0], ep[1])); }
            if (wa == 0) {
#pragma unroll
                for (int ks = 0; ks < 2; ++ks) { const LAS f32x4* qp = (const LAS f32x4*)(R + C1_QT + i * 256 + (32 * ks + 4 * g) * 4);
                    C1_ST(gt + (8 + ks) * 1024 + lane * 16, pack8(qp[0], qp[4])); }
                if (g < 2) { const LAS f32x4* cp = (const LAS f32x4*)(R + C1_CT + i * 64 + 32 * g); C1_ST(gt + 10240 + 4 * 512 + lane * 16, pack8(cp[0], cp[1])); }
            }
        }
        }
        C1_BAR();
    }
    {
        const int it = 32;
        { const LAS unsigned char* IMG = lds + C1_IMG + (((it - 1) & 1) * 2 + d) * C1_IMG_D; LAS unsigned char* R = lds + C1_RES + (((it - 1) & 1) * 2 + d) * C1_RES_D;
        if (MODE != 1 && MODE != 4) {
            h8 fk[2], fr[2], fb[2], fe[2];
#pragma unroll
            for (int ks = 0; ks < 2; ++ks) { const LAS unsigned char* p = IMG + C1_SC + i * C1_SCST + (8 * g + 32 * ks) * 2;
                fk[ks] = *(const LAS h8*)(p); fr[ks] = *(const LAS h8*)(p + 16 * C1_SCST); fb[ks] = *(const LAS h8*)(p + 32 * C1_SCST); fe[ks] = *(const LAS h8*)(p + 48 * C1_SCST); }
            const f32x4 z4 = (f32x4){0.f, 0.f, 0.f, 0.f};
            f32x4 aN = z4, aNT = z4, aM = z4, aMT = z4, aNr = z4, aMr = z4;
#pragma unroll
            for (int ks = 0; ks < 2; ++ks) {
                aN  = __builtin_amdgcn_mfma_f32_16x16x32_f16(fb[ks], fk[ks], aN, 0, 0, 0);  aNT = __builtin_amdgcn_mfma_f32_16x16x32_f16(fk[ks], fb[ks], aNT, 0, 0, 0);
                aM  = __builtin_amdgcn_mfma_f32_16x16x32_f16(fe[ks], fk[ks], aM, 0, 0, 0);  aMT = __builtin_amdgcn_mfma_f32_16x16x32_f16(fk[ks], fe[ks], aMT, 0, 0, 0);
                aNr = __builtin_amdgcn_mfma_f32_16x16x32_f16(fb[ks], fr[ks], aNr, 0, 0, 0); aMr = __builtin_amdgcn_mfma_f32_16x16x32_f16(fe[ks], fr[ks], aMr, 0, 0, 0); }
#pragma unroll
            for (int e = 0; e < 4; ++e) { const int row = 4 * g + e;
                aN[e] = row < i ? -aN[e] : 0.f; aNT[e] = i < row ? -aNT[e] : 0.f; aM[e] = row < i ? aM[e] : 0.f; aMT[e] = i < row ? aMT[e] : 0.f;
                aNr[e] = row <= i ? aNr[e] : 0.f; aMr[e] = row <= i ? aMr[e] : 0.f; }
#define C1_H4(x_) __builtin_convertvector((x_), h4)
#define C1_MM(a_, b_, c_) __builtin_amdgcn_mfma_f32_16x16x16f16((a_), (b_), (c_), 0, 0, 0)
            f32x4 S = aN, ST = aNT;
#pragma unroll
            for (int e = 0; e < 4; ++e) if (4 * g + e == i) { S[e] += 1.f; ST[e] += 1.f; }
            const h4 hA = C1_H4(aN), hAT = C1_H4(aNT);
            const f32x4 P2 = C1_MM(hAT, hA, z4), P2T = C1_MM(hA, hAT, z4);
            const h4 hP2 = C1_H4(P2), hP2T = C1_H4(P2T);
            { const h4 hS = C1_H4(S); S = C1_MM(hP2T, hS, S); ST = C1_MM(hS, hP2T, ST); }
            const f32x4 P4 = C1_MM(hP2T, hP2, z4), P4T = C1_MM(hP2, hP2T, z4);
            const h4 hP4 = C1_H4(P4), hP4T = C1_H4(P4T);
            { const h4 hS = C1_H4(S); S = C1_MM(hP4T, hS, S); ST = C1_MM(hS, hP4T, ST); }
            const f32x4 P8T = C1_MM(hP4, hP4T, z4);
            const h4 hP8T = C1_H4(P8T);
            { const h4 hS = C1_H4(S); ST = C1_MM(hS, hP8T, ST); }
            const h4 hTT = C1_H4(ST), hMT = C1_H4(aMT);
            const f32x4 X1 = C1_MM(hTT, C1_H4(aNr), z4);
            const h4 hX1 = C1_H4(X1);
            const h4 bT = *(const LAS h4*)(IMG + C1_CM + c * 96 + 32 + g * 8);
            const f32x4 X2 = C1_MM(hTT, bT, z4);
            const float dl = *(const LAS float*)(IMG + C1_DL + c * 4), dm = *(const LAS float*)(IMG + C1_DM + c * 4);
            *(LAS f32x4*)(R + C1_ZT + c * 64 + 16 * g) = X2 * dl;
            const f32x4 Ea = C1_MM(hMT, C1_H4(X2), z4);
            const h4 kh = *(const LAS h4*)(IMG + C1_CM + c * 96 + 64 + g * 8);
            *(LAS f32x4*)(R + C1_ET + c * 64 + 16 * g) = (__builtin_convertvector(kh, f32x4) - Ea) * (dl * rcpf_(dm));
            const h4 kT = *(const LAS h4*)(IMG + C1_CM + c * 96 + g * 8);
            const f32x4 Qa = C1_MM(kT, hX1, z4);
            const h4 rh = *(const LAS h4*)(IMG + C1_SC + (16 + i) * C1_SCST + (16 * wa + 4 * g) * 2);
            const f32x4 dm4 = *(const LAS f32x4*)(IMG + C1_DM + (16 * wa + 4 * g) * 4);
            *(LAS f32x4*)(R + C1_QT + i * 256 + (16 * wa + 4 * g) * 4) = (__builtin_convertvector(rh, f32x4) - Qa) * dm4;
            if (wa == 0) { const f32x4 Ca = C1_MM(hMT, hX1, z4); *(LAS f32x4*)(R + C1_CT + i * 64 + 16 * g) = aMr - Ca; }
            *(LAS h4*)(R + C1_UH + c * 32 + 8 * g) = kT;
            if (g == 0) *(LAS float*)(R + C1_DA + c * 4) = dl;
#undef C1_H4
#undef C1_MM
        }
        }
        { const int B = B0 + it - 2; const LAS unsigned char* R = lds + C1_RES + ((it & 1) * 2 + d) * C1_RES_D;
        if (MODE != 2 && MODE != 4) {
            const int n = d ? 255 - B : B;
            GAS unsigned char* gt = (d ? (GAS unsigned char*)F.out : F.ws + WS_GT0) + ((size_t)(bb * 4 + h) * 256 + n) * GT_CHUNK;
            const int nt = wa;
            bf16x8 zf = (bf16x8){0, 0, 0, 0, 0, 0, 0, 0};
            if (g < 2) { const LAS f32x4* zp = (const LAS f32x4*)(R + C1_ZT + (16 * nt + i) * 64 + 32 * g); zf = pack8(zp[0], zp[1]); }
            f32x4 pp[4];
#pragma unroll
            for (int ct = 0; ct < 4; ++ct) {
                bf16x8 uf = (bf16x8){0, 0, 0, 0, 0, 0, 0, 0};
                if (g < 2) { const LAS h4* up = (const LAS h4*)(R + C1_UH + (16 * ct + i) * 32 + 16 * g); uf = pack8(__builtin_convertvector(up[0], f32x4), __builtin_convertvector(up[1], f32x4)); }
                const f32x4 dd = __builtin_amdgcn_mfma_f32_16x16x32_bf16(uf, zf, (f32x4){0.f, 0.f, 0.f, 0.f}, 0, 0, 0);
                f32x4 pv = -dd;
                if (ct == nt) { const f32x4 da = *(const LAS f32x4*)(R + C1_DA + (16 * ct + 4 * g) * 4);
#pragma unroll
                    for (int e = 0; e < 4; ++e) if (4 * g + e == i) pv[e] += da[e]; }
                pp[ct] = pv; }
#undef C1_ST
#define C1_ST(p_, v_) do { const bf16x8 v__ = (v_); if (MODE == 0) *(GAS bf16x8*)(p_) = v__; else asm volatile("" :: "v"(v__)); } while (0)
            C1_ST(gt + (nt * 2 + 0) * 1024 + lane * 16, pack8(pp[0], pp[1]));
            C1_ST(gt + (nt * 2 + 1) * 1024 + lane * 16, pack8(pp[2], pp[3]));
            if (g < 2) { const LAS f32x4* ep = (const LAS f32x4*)(R + C1_ET + (16 * nt + i) * 64 + 32 * g); C1_ST(gt + 10240 + nt * 512 + lane * 16, pack8(ep[0], ep[1])); }
            if (wa == 0) {
#pragma unroll
                for (int ks = 0; ks < 2; ++ks) { const LAS f32x4* qp = (const LAS f32x4*)(R + C1_QT + i * 256 + (32 * ks + 4 * g) * 4);
                    C1_ST(gt + (8 + ks) * 1024 + lane * 16, pack8(qp[0], qp[4])); }
                if (g < 2) { const LAS f32x4* cp = (const LAS f32x4*)(R + C1_CT + i * 64 + 32 * g); C1_ST(gt + 10240 + 4 * 512 + lane * 16, pack8(cp[0], cp[1])); }
            }
        }
        }
        C1_BAR();
    }
    {
        const int it = 33;
        { const int B = B0 + it - 2; const LAS unsigned char* R = lds + C1_RES + ((it & 1) * 2 + d) * C1_RES_D;
        if (MODE != 2 && MODE != 4) {
            const int n = d ? 255 - B : B;
            GAS unsigned char* gt = (d ? (GAS unsigned char*)F.out : F.ws + WS_GT0) + ((size_t)(bb * 4 + h) * 256 + n) * GT_CHUNK;
            const int nt = wa;
            bf16x8 zf = (bf16x8){0, 0, 0, 0, 0, 0, 0, 0};
            if (g < 2) { const LAS f32x4* zp = (const LAS f32x4*)(R + C1_ZT + (16 * nt + i) * 64 + 32 * g); zf = pack8(zp[0], zp[1]); }
            f32x4 pp[4];
#pragma unroll
            for (int ct = 0; ct < 4; ++ct) {
                bf16x8 uf = (bf16x8){0, 0, 0, 0, 0, 0, 0, 0};
                if (g < 2) { const LAS h4* up = (const LAS h4*)(R + C1_UH + (16 * ct + i) * 32 + 16 * g); uf = pack8(__builtin_convertvector(up[0], f32x4), __builtin_convertvector(up[1], f32x4)); }
                const f32x4 dd = __builtin_amdgcn_mfma_f32_16x16x32_bf16(uf, zf, (f32x4){0.f, 0.f, 0.f, 0.f}, 0, 0, 0);
                f32x4 pv = -dd;
                if (ct == nt) { const f32x4 da = *(const LAS f32x4*)(R + C1_DA + (16 * ct + 4 * g) * 4);
#pragma unroll
                    for (int e = 0; e < 4; ++e) if (4 * g + e == i) pv[e] += da[e]; }
                pp[ct] = pv; }
#undef C1_ST
#define C1_ST(p_, v_) do { const bf16x8 v__ = (v_); if (MODE == 0) *(GAS bf16x8*)(p_) = v__; else asm volatile("" :: "v"(v__)); } while (0)
            C1_ST(gt + (nt * 2 + 0) * 1024 + lane * 16, pack8(pp[0], pp[1]));
            C1_ST(gt + (nt * 2 + 1) * 1024 + lane * 16, pack8(pp[2], pp[3]));
            if (g < 2) { const LAS f32x4* ep = (const LAS f32x4*)(R + C1_ET + (16 * nt + i) * 64 + 32 * g); C1_ST(gt + 10240 + nt * 512 + lane * 16, pack8(ep[0], ep[1])); }
            if (wa == 0) {
#pragma unroll
                for (int ks = 0; ks < 2; ++ks) { const LAS f32x4* qp = (const LAS f32x4*)(R + C1_QT + i * 256 + (32 * ks + 4 * g) * 4);
                    C1_ST(gt + (8 + ks) * 1024 + lane * 16, pack8(qp[0], qp[4])); }
                if (g < 2) { const LAS f32x4* cp = (const LAS f32x4*)(R + C1_CT + i * 64 + 32 * g); C1_ST(gt + 10240 + 4 * 512 + lane * 16, pack8(cp[0], cp[1])); }
            }
        }
        }
        C1_BAR();
    }
#undef C1_LOAD
#undef C1_BAR
    __syncthreads();
}
#define C2_BAR() do { asm volatile("s_waitcnt lgkmcnt(0)" ::: "memory"); __builtin_amdgcn_s_barrier(); asm volatile("" ::: "memory"); } while (0)
constexpr int C2_SLOT = 16384, C2_YOFF = 4 * C2_SLOT;
template <int MODE>
__device__ __forceinline__ void phase_scan_c2(Frame& F, int l) {
    LAUNDER(F);
    if (F.vcu >= 128) { if (MODE == 0) phase_mix_na(F, l, F.vcu - 128, 128); return; }
    const GAS bf16* proj = (const GAS bf16*)(F.ws + WS_PROJ);
    const int lane = F.lane, i = lane & 15, g = lane >> 4;
    LAS unsigned char* lds = F.lds;
    if (F.vcu < 128) {
    const int ci = F.vcu >> 1, tp = F.vcu & 1, d = ci >> 5, bb = (ci >> 2) & 7, h = ci & 3;
    for (int q = F.tid; q < 4 * 5 * 32; q += NTHREADS) { const int sl = q / 160, r = q % 160; *(LAS v4u*)(lds + sl * C2_SLOT + 10240 + (r >> 5) * 1024 + 512 + (r & 31) * 16) = (v4u){0u, 0u, 0u, 0u}; }
    __syncthreads();
    if (F.wave < 2) {
        const int cw = F.wave;
        f32x4 st[4];
#pragma unroll
        for (int t = 0; t < 4; ++t) st[t] = (f32x4){0.f, 0.f, 0.f, 0.f};
        v4u af[15], vf, nf[15], nvf;
#define C2_RD(AF, VF, c_) do { const LAS unsigned char* p_ = lds + ((c_) & 3) * C2_SLOT + lane * 16; \
            _Pragma("unroll") for (int f_ = 0; f_ < 15; ++f_) AF[f_] = *(const LAS v4u*)(p_ + f_ * 1024); \
            VF = *(const LAS v4u*)(lds + ((c_) & 3) * C2_SLOT + 15360 + cw * 512 + i * 32 + (g & 1) * 16); } while (0)
#define C2_STEP(AF, VF, NF, NVF, n_) do { \
            if ((n_) + 1 < 256) C2_RD(NF, NVF, (n_) + 1); \
            const bf16x8 b0_ = pack8(st[0], st[1]), b1_ = pack8(st[2], st[3]); const v4u vz_ = (g < 2) ? VF : (v4u){0u, 0u, 0u, 0u}; const bf16x8 bv_ = __builtin_bit_cast(bf16x8, vz_); \
            f32x4 o_[5]; \
            _Pragma("unroll") for (int nt = 0; nt < 5; ++nt) { if (MODE >= 2) { o_[nt] = __builtin_bit_cast(f32x4, AF[nt]) + __builtin_bit_cast(f32x4, AF[10 + nt]) * st[nt & 3]; continue; } \
                f32x4 a_ = __builtin_amdgcn_mfma_f32_16x16x32_bf16(__builtin_bit_cast(bf16x8, AF[nt * 2]), b0_, (f32x4){0.f, 0.f, 0.f, 0.f}, 0, 0, 0); \
                a_ = __builtin_amdgcn_mfma_f32_16x16x32_bf16(__builtin_bit_cast(bf16x8, AF[nt * 2 + 1]), b1_, a_, 0, 0, 0); \
                o_[nt] = __builtin_amdgcn_mfma_f32_16x16x32_bf16(__builtin_bit_cast(bf16x8, AF[10 + nt]), bv_, a_, 0, 0, 0); } \
            _Pragma("unroll") for (int t = 0; t < 4; ++t) st[t] = o_[t]; \
            { v2u yw_; yw_.x = pk2(o_[4].x, o_[4].y); yw_.y = pk2(o_[4].z, o_[4].w); \
              *(LAS v2u*)(lds + C2_YOFF + (cw * 8 + ((n_) & 7)) * 512 + i * 32 + g * 8) = yw_; }     \
            } while (0)
        C2_BAR();
        C2_RD(af, vf, 0);
        for (int n = 0; n < 256; n += 2) { C2_STEP(af, vf, nf, nvf, n); C2_STEP(nf, nvf, af, vf, n + 1); C2_BAR(); }
        C2_BAR();
#undef C2_STEP
#undef C2_RD
    } else {
        const int hl = F.tid - 128;
        const GAS unsigned char* gt = (d ? (const GAS unsigned char*)F.out : F.ws + WS_GT0) + ((size_t)(bb * 4 + h) * 256) * GT_CHUNK;
        GAS bf16* ysc = (GAS bf16*)(d ? (GAS unsigned char*)F.out + GT_DIR : F.ws + WS_YSC0) + (size_t)bb * T * 256 + h * 64 + 32 * tp;
        const int p0 = hl, p1 = hl + 384, p2 = hl + 768; const bool has2 = p2 < 800;
#define C2_OFF(p_) ((p_) < 640 ? (p_) * 16 : 10240 + (((p_) - 640) >> 5) * 1024 + (((p_) - 640) & 31) * 16)
        const int o0 = C2_OFF(p0), o1 = C2_OFF(p1), o2 = C2_OFF(has2 ? p2 : 799);
        const int e0 = hl, e1 = hl + 384; const bool hasv1 = e1 < 512;
        const GAS bf16* vs0 = proj + (size_t)bb * T * NPROJP + C_V + h * 64 + 32 * tp + 16 * (e0 >> 8) + (e0 & 15);
        const GAS bf16* vs1 = proj + (size_t)bb * T * NPROJP + C_V + h * 64 + 32 * tp + 16 * ((hasv1 ? e1 : 0) >> 8) + (e1 & 15);
        const int vt0 = (e0 >> 4) & 15, vt1 = (e1 >> 4) & 15;
        const int vo0 = 15360 + (e0 >> 8) * 512 + (e0 & 15) * 32 + vt0 * 2, vo1 = 15360 + ((hasv1 ? e1 : 0) >> 8) * 512 + (e1 & 15) * 32 + vt1 * 2;
        constexpr int RD = 12;
        v4u r0[RD], r1[RD], r2[RD]; unsigned short rv0[RD], rv1[RD];
        if (MODE == 1 || MODE == 3) {
#pragma unroll
            for (int k = 0; k < RD; ++k) { r0[k] = (v4u){1u, 2u, 3u, 4u}; r1[k] = r0[k]; r2[k] = r0[k]; rv0[k] = 0; rv1[k] = 0; } }
#define C2_GLD(k_, n_) do { if (MODE == 1 || MODE == 3) break; const GAS unsigned char* c_ = gt + (size_t)(n_) * GT_CHUNK; r0[k_] = *(const GAS v4u*)(c_ + p0 * 16); r1[k_] = *(const GAS v4u*)(c_ + p1 * 16); \
            if (has2) r2[k_] = *(const GAS v4u*)(c_ + p2 * 16); \
            { const int gs_ = 16 * (n_) + vt0, t_ = d ? (T - 1 - gs_) : gs_; rv0[k_] = vs0[(size_t)t_ * NPROJP]; } \
            if (hasv1) { const int gs_ = 16 * (n_) + vt1, t_ = d ? (T - 1 - gs_) : gs_; rv1[k_] = vs1[(size_t)t_ * NPROJP]; } } while (0)
#define C2_WR(k_, n_) do { LAS unsigned char* p_ = lds + ((n_) & 3) * C2_SLOT; *(LAS v4u*)(p_ + o0) = r0[k_]; *(LAS v4u*)(p_ + o1) = r1[k_]; if (has2) *(LAS v4u*)(p_ + o2) = r2[k_]; \
            *(LAS unsigned short*)(p_ + vo0) = rv0[k_]; if (hasv1) *(LAS unsigned short*)(p_ + vo1) = rv1[k_]; } while (0)
#define C2_YST(m_) do { if (hl < 64) { const int cw_ = hl >> 5, s_ = (hl >> 1) & 15, hf_ = hl & 1; const LAS unsigned short* yp_ = (const LAS unsigned short*)(lds + C2_YOFF + (cw_ * 8 + ((m_) & 7)) * 512) + s_; \
            v4u w_; _Pragma("unroll") for (int e_ = 0; e_ < 4; ++e_) w_[e_] = (unsigned)yp_[(8 * hf_ + 2 * e_) * 16] | ((unsigned)yp_[(8 * hf_ + 2 * e_ + 1) * 16] << 16); \
            const int gs_ = 16 * (m_) + s_, t_ = d ? (T - 1 - gs_) : gs_; if (MODE == 0) *(GAS v4u*)(ysc + (size_t)t_ * 256 + 16 * cw_ + 8 * hf_) = w_; else asm volatile("" :: "v"(w_)); } } while (0)
#pragma unroll
        for (int k = 0; k < RD; ++k) C2_GLD(k, k);
        C2_WR(0, 0); C2_GLD(0, RD); C2_WR(1, 1); C2_GLD(1, RD + 1); C2_WR(2, 2); C2_GLD(2, RD + 2);
        C2_BAR();
        for (int m6 = 0; m6 < 128; m6 += RD / 2) {
#pragma unroll
            for (int k = 0; k < RD / 2; ++k) { const int m = m6 + k;
                if (m < 128) {
                    const int ca = 2 * m + 3, cb = 2 * m + 4, ka = (2 * k + 3) % RD, kb = (2 * k + 4) % RD;
                    if (ca < 256) { C2_WR(ka, ca); if (ca + RD < 256) C2_GLD(ka, ca + RD); }
                    if (cb < 256) { C2_WR(kb, cb); if (cb + RD < 256) C2_GLD(kb, cb + RD); }
                    if (m > 0) { C2_YST(2 * m - 2); C2_YST(2 * m - 1); }
                    C2_BAR(); } }
        }
        C2_YST(254); C2_YST(255);
        C2_BAR();
#undef C2_GLD
#undef C2_WR
#undef C2_YST
#undef C2_OFF
    }
    }
    __syncthreads();
}
#undef C2_BAR
#undef CK_DOT
#undef CK_RED2

__device__ __forceinline__ void phase_rwkv_post(Frame& F, int l) {
    LAUNDER(F);
    const GAS bf16* proj = (const GAS bf16*)(F.ws + WS_PROJ); GAS bf16* merged = (GAS bf16*)(F.ws + WS_MERGED); const GAS bf16* ysc0 = (const GAS bf16*)(F.ws + WS_YSC0); const GAS bf16* ysc1 = (const GAS bf16*)((const GAS unsigned char*)F.out + GT_DIR);
    const int lane = F.lane, c4 = 4 * lane, i = lane & 15, g = lane >> 4;
    bf16x8 Bg[16];
    {   LAS bf16x8* GB = (LAS bf16x8*)F.lds;
        for (int q = F.tid; q < 1024; q += NTHREADS) { const int ct = q >> 6, ln = q & 63; const GAS float* gp = INP(F, I_RGUP) + ((size_t)l * 32 + 8 * (ln >> 4)) * 256 + 16 * ct + (ln & 15);
            GB[q] = pack8((f32x4){gp[0], gp[256], gp[512], gp[768]}, (f32x4){gp[1024], gp[1280], gp[1536], gp[1792]}); }
        __syncthreads();
#pragma unroll
        for (int ct = 0; ct < 16; ++ct) Bg[ct] = GB[ct * 64 + lane];
        __syncthreads(); }
    LAS float* GL = (LAS float*)(F.lds + F.wave * 16384);
    const f32x4 lw = *(const f32x4*)(INP(F, I_LNXW) + l * 256 + c4), lb = *(const f32x4*)(INP(F, I_LNXB) + l * 256 + c4), rk = *(const f32x4*)(INP(F, I_RRK) + l * 256 + c4);
    const int mstep = F.G * NWAVES;
    for (int m0 = F.vcu * NWAVES + F.wave; m0 < M; m0 += 16 * mstep) {
        v2u n_yf[4], n_yb[4], n_r[4], n_k[4], n_v[4];
#define POST_LOAD4(tb_) do { _Pragma("unroll") for (int q_ = 0; q_ < 4; ++q_) { const size_t mm_ = (size_t)(m0 + ((tb_) + q_) * mstep); const GAS bf16* row_ = proj + mm_ * NPROJP; \
        n_yf[q_] = *(const GAS v2u*)(ysc0 + mm_ * 256 + c4); n_yb[q_] = *(const GAS v2u*)(ysc1 + mm_ * 256 + c4); \
        n_r[q_] = *(const GAS v2u*)(row_ + C_R + c4); n_k[q_] = *(const GAS v2u*)(row_ + C_K + c4); n_v[q_] = *(const GAS v2u*)(row_ + C_V + c4); } } while (0)
        POST_LOAD4(0);
        {   const v4u raw = *(const GAS v4u*)(proj + (size_t)(m0 + i * mstep) * NPROJP + C_GDN + 8 * g);
            const bf16x8 Af = pack8((f32x4){sigmoidf_(bflo(raw.x)), sigmoidf_(bfhi(raw.x)), sigmoidf_(bflo(raw.y)), sigmoidf_(bfhi(raw.y))}, (f32x4){sigmoidf_(bflo(raw.z)), sigmoidf_(bfhi(raw.z)), sigmoidf_(bflo(raw.w)), sigmoidf_(bfhi(raw.w))});
            CFENCE();
#pragma unroll
            for (int ct = 0; ct < 16; ++ct) { const f32x4 a = __builtin_amdgcn_mfma_f32_16x16x32_bf16(Af, Bg[ct], (f32x4){0.f, 0.f, 0.f, 0.f}, 0, 0, 0);
#pragma unroll
                for (int e = 0; e < 4; ++e) GL[(4 * g + e) * 256 + 16 * ct + i] = a[e]; }
            LDS_WAIT(); CFENCE(); }
        for (int tb = 0; tb < 16; tb += 4) {
            v2u c_yf[4], c_yb[4], c_r[4], c_k[4], c_v[4];
#pragma unroll
            for (int q = 0; q < 4; ++q) { c_yf[q] = n_yf[q]; c_yb[q] = n_yb[q]; c_r[q] = n_r[q]; c_k[q] = n_k[q]; c_v[q] = n_v[q]; }
            if (tb + 4 < 16) POST_LOAD4(tb + 4);
#pragma unroll
            for (int q = 0; q < 4; ++q) { const int t = tb + q, m = m0 + t * mstep;
                const v2u yf = c_yf[q], yb = c_yb[q], ru = c_r[q], ku = c_k[q], vu = c_v[q];
                f32x4 y = (f32x4){bflo(yf.x) + bflo(yb.x), bfhi(yf.x) + bfhi(yb.x), bflo(yf.y) + bflo(yb.y), bfhi(yf.y) + bfhi(yb.y)};
                const float mu = row16_sum((y.x + y.y) + (y.z + y.w)) * (1.f / 64.f);
                y = y - mu;
                const float var = row16_sum((y.x * y.x + y.y * y.y) + (y.z * y.z + y.w * y.w)) * (1.f / 64.f);
                const float rstd = rsqf_(var + GN_EPS);
                y = y * rstd * lw + lb;
                const f32x4 r = (f32x4){bflo(ru.x), bfhi(ru.x), bflo(ru.y), bfhi(ru.y)}, k = (f32x4){bflo(ku.x), bfhi(ku.x), bflo(ku.y), bfhi(ku.y)}, v = (f32x4){bflo(vu.x), bfhi(vu.x), bflo(vu.y), bfhi(vu.y)};
                const f32x4 rkk = r * k * rk;
                const float bsum = row16_sum((rkk.x + rkk.y) + (rkk.z + rkk.w));
                y = y + v * bsum;
                y = y * *(const LAS f32x4*)(GL + t * 256 + c4);
                const float ss = wave_sum((y.x * y.x + y.y * y.y) + (y.z * y.z + y.w * y.w));
                const float sc = rsqf_(ss * (1.f / 256.f) + NORM_EPS);
                v2u o; o.x = pk2(y.x * sc, y.y * sc); o.y = pk2(y.z * sc, y.w * sc);
                *(GAS v2u*)(merged + (size_t)m * DM + 256 + c4) = o; } }
        CFENCE();
    }
#undef POST_LOAD4
}

__device__ __forceinline__ void phase_residual(Frame& F, const GAS float* gain, const bool IN_F32, const bool LAST) {
    LAUNDER(F);
    const GAS bf16* y = (const GAS bf16*)(F.ws + WS_Y); const GAS float* part = (const GAS float*)(F.ws + WS_PART);
    GAS bf16* xb = (GAS bf16*)(F.ws + WS_XB); GAS float* rs = (GAS float*)(F.ws + WS_RS); const GAS float* xin = INP(F, I_X);
    const int lane = F.lane;
    f32x4 gv[4];
#pragma unroll
    for (int j = 0; j < 4; ++j) gv[j] = *((const f32x4*)gain + lane + 64 * j);
    for (int m = F.vcu * NWAVES + F.wave; m < M; m += F.G * NWAVES) {
        const f32x4* pp = (const f32x4*)(part + (size_t)m * 16);
        const f32x4 p0 = *(const GAS f32x4*)(pp), p1 = *(const GAS f32x4*)(pp + 1), p2 = *(const GAS f32x4*)(pp + 2), p3 = *(const GAS f32x4*)(pp + 3);
        const float tot = ((p0.x + p0.y) + (p0.z + p0.w)) + ((p1.x + p1.y) + (p1.z + p1.w)) + ((p2.x + p2.y) + (p2.z + p2.w)) + ((p3.x + p3.y) + (p3.z + p3.w));
        const float sc = rsqf_(tot * (1.f / DM) + NORM_EPS);
        const GAS v2u* yr = (const GAS v2u*)(y + (size_t)m * DM) + lane;
        f32x4 v[4]; float s = 0.f;
#pragma unroll
        for (int j = 0; j < 4; ++j) { const v2u yu = yr[64 * j]; const f32x4 yv = (f32x4){bflo(yu.x), bfhi(yu.x), bflo(yu.y), bfhi(yu.y)};
            f32x4 xv;
            if (IN_F32) xv = ((const GAS f32x4*)(xin + (size_t)m * DM) + lane)[64 * j];
            else { const v2u xu = ((const GAS v2u*)(xb + (size_t)m * DM) + lane)[64 * j]; xv = (f32x4){bflo(xu.x), bfhi(xu.x), bflo(xu.y), bfhi(xu.y)}; }
            v[j] = xv + yv * sc * gv[j]; s += (v[j].x * v[j].x + v[j].y * v[j].y) + (v[j].z * v[j].z + v[j].w * v[j].w); }
        if (LAST) {
            GAS f32x4* orow = (GAS f32x4*)(F.out + (size_t)m * DM) + lane;
#pragma unroll
            for (int j = 0; j < 4; ++j) orow[64 * j] = v[j];
        } else {
            s = wave_sum(s);
            GAS v2u* o8 = (GAS v2u*)(xb + (size_t)m * DM) + lane;
#pragma unroll
            for (int j = 0; j < 4; ++j) { v2u o; o.x = pk2(v[j].x, v[j].y); o.y = pk2(v[j].z, v[j].w); o8[64 * j] = o; }
            if (lane == 0) rs[m] = rsqf_(s * (1.f / DM) + NORM_EPS);
        }
    }
}
__device__ __forceinline__ void ffn_fix_panel(Frame& F, int l, int pm) {
    const GAS bf16* G = (const GAS bf16*)(F.ws + WS_G); GAS bf16* L = (GAS bf16*)(F.ws + WS_L);
    const GAS float* cw = INP(F, I_FCONV) + (size_t)l * 3 * DFF;
    constexpr int CPR = DFF / 8;
    for (int it = F.tid; it < 2 * CPR; it += NTHREADS) {
        const int ck = it % CPR, rr = it / CPR, m = pm * 256 + (rr ? 255 : 0), t = m % T, c8 = 8 * ck;
        float w0[8], w1[8], w2[8];
#pragma unroll
        for (int j = 0; j < 8; ++j) { w0[j] = cw[c8 + j]; w1[j] = cw[DFF + c8 + j]; w2[j] = cw[2 * DFF + c8 + j]; }
        const v4u z = (v4u){0u, 0u, 0u, 0u};
        const v4u gp = (t > 0) ? *(const GAS v4u*)(G + (size_t)(m - 1) * DFF + c8) : z, gc = *(const GAS v4u*)(G + (size_t)m * DFF + c8), gn = (t < T - 1) ? *(const GAS v4u*)(G + (size_t)(m + 1) * DFF + c8) : z;
        const v4u lv = *(const GAS v4u*)(G + (size_t)(rr ? m - 2 : m + 2) * DFF + c8);
        v4u o;
#pragma unroll
        for (int q = 0; q < 4; ++q) {
            const float a0 = w0[2 * q] * bflo(gp[q]) + w1[2 * q] * bflo(gc[q]) + w2[2 * q] * bflo(gn[q]);
            const float a1 = w0[2 * q + 1] * bfhi(gp[q]) + w1[2 * q + 1] * bfhi(gc[q]) + w2[2 * q + 1] * bfhi(gn[q]);
            o[q] = pk2(gelu_tanh(a0) * bflo(lv[q]), gelu_tanh(a1) * bfhi(lv[q])); }
        *(GAS v4u*)(L + (size_t)m * DFF + c8) = o;
    }
}

#ifndef MK_N_LAUNCHES
#define MK_N_LAUNCHES 1
#endif
constexpr int PPL = 7, NPH = 1 + PPL * DEPTH;
struct Args { const float* in[26]; float* out; unsigned char* ws; int ph_lo, ph_hi; };
__global__ void __launch_bounds__(NTHREADS, 2) enc_fwd(Args args) {
    extern __shared__ __attribute__((aligned(16))) unsigned char lds_raw[];
    Frame F;
    F.lds = (LAS unsigned char*)lds_raw;
    F.MISC = (volatile LAS unsigned*)(F.lds + MISC_OFF);
    F.tid = threadIdx.x; F.lane = F.tid & 63; F.wave = __builtin_amdgcn_readfirstlane(F.tid >> 6);
    F.G = gridDim.x; { const int bx = blockIdx.x; F.vcu = (F.G % 8 == 0) ? (bx % 8) * (F.G / 8) + bx / 8 : bx; }
    F.ws = (GAS unsigned char*)args.ws; F.out = (GAS float*)args.out; F.ctl = (gu32*)(F.ws + WS_CTL);
    F.karg = (kq_t*)__builtin_amdgcn_kernarg_segment_ptr();
    for (int u = F.tid; u < LDS_BYTES / 16; u += NTHREADS) ((LAS v4u*)F.lds)[u] = (v4u){0u, 0u, 0u, 0u};
    __syncthreads();
    const int lo = args.ph_lo, hi = args.ph_hi;
    if (hi - lo > 1) (void)xcd_barrier_post((unsigned*)(F.ctl + CW_BAR), F.MISC + 8);
#define GRID_BAR() do { XcdBarrier bar_; bar_.bar = (unsigned*)(F.ctl + CW_BAR); bar_.x = xb_xcc_id(); bar_.st = F.MISC + 8; xcd_barrier(bar_); } while (0)
#ifndef PH_ENABLE
#define PH_ENABLE 0x7ff
#endif
#define IN(k) (lo <= (k) && (k) < hi)
#define EN(t) (((PH_ENABLE) >> (t)) & 1)
#pragma unroll 1
#ifdef REPEAT_T
    for (int step = lo; step < hi; ++step) {
        const int p1 = REPEAT_T, p2 = REPEAT_T + PPL;
        const int ph = step - (step > p1 ? 1 : 0) - ((step > p2 + 1) ? 1 : 0);
#else
    for (int ph = lo; ph < hi; ++ph) {
#endif
        LAUNDER(F);
        const int l = ph == 0 ? 0 : (ph - 1) / PPL, tt = ph == 0 ? 0 : 1 + (ph - 1) % PPL;
        const int t = tt == 0 ? 0 : (tt == 1 ? 1 : (tt <= 5 ? tt + 1 : (tt == 6 ? 8 : 10)));
        GAS unsigned char* wl = F.ws + WS_W + (size_t)l * W_LAYER;
      {
        if (t == 1 || t == 8) {
            pg8::Gemm g; pg8::EpiUni E;
            g.M = M; E.split_cols = 0; E.split_stride = 0; E.convw = nullptr; E.G = nullptr; E.xl = (pg8::PG8_LAS_T*)(F.lds + RING_BYTES + 1024); E.part = nullptr; E.rs = (const GAS float*)(F.ws + WS_RS);
            g.A = (const GAS bf16*)(F.ws + WS_XB); g.K = DM;
            if (t == 1) { g.Bt = (const GAS bf16*)(wl + W_IN); g.N = NPROJP; E.O = (GAS bf16*)(F.ws + WS_PROJ); E.ldc = NPROJP; }
            else        { g.Bt = (const GAS bf16*)(wl + W_UP); g.N = NUP;    E.O = (GAS bf16*)(F.ws + WS_L); E.ldc = DFF; E.convw = INP(F, I_FCONV) + (size_t)l * 3 * DFF; E.G = (GAS bf16*)(F.ws + WS_G); }
            g.Bt = launder_p(g.Bt); E.O = launder_p(E.O); E.convw = launder_p(E.convw); E.G = launder_p(E.G); g.N = launder_u(g.N); E.ldc = launder_u(E.ldc);
            g.A = launder_p(g.A); E.rs = launder_p(E.rs);
            pg8::StaticOrder S; S.init(M, g.N, F.G, (int)blockIdx.x);
            pg8::gemm_phase<pg8::EpiUni, pg8::StaticOrder, true, true>(F.lds, g, S, E);
        }
        else if (t == 6 || t == 10) {
            pg8::Gemm g; pg8::EpiResid E;
            g.M = M; g.N = DM; E.xl = (pg8::PG8_LAS_T*)(F.lds + RING_BYTES + 1024);
            E.xb = (GAS bf16*)(F.ws + WS_XB); E.outf = F.out; E.rsw = (GAS float*)(F.ws + WS_RS); E.xs = (GAS float*)(F.ws + WS_XS); E.resid = 1;
            if (t == 6) { g.A = (const GAS bf16*)(F.ws + WS_MERGED); g.Bt = (const GAS bf16*)(wl + W_OUT); g.K = DM;  E.gain = INP(F, I_NMPOST) + l * DM; E.cnt = (GAS unsigned*)(F.ctl + CW_PANEL) + (size_t)(l * 2 + 0) * 2 * 128 * 64; }
            else        { g.A = (const GAS bf16*)(F.ws + WS_L);      g.Bt = (const GAS bf16*)(wl + W_DN);  g.K = DFF; E.gain = INP(F, I_NFPOST) + l * DM; if (l + 1 == DEPTH) E.resid = 2; E.cnt = (GAS unsigned*)(F.ctl + CW_PANEL) + (size_t)(l * 2 + 1) * 2 * 128 * 64; }
            g.A = launder_p(g.A); g.Bt = launder_p(g.Bt); g.K = launder_u(g.K); E.gain = launder_p(E.gain); E.cnt = launder_p(E.cnt); E.resid = launder_u(E.resid);
            E.xb = launder_p(E.xb); E.outf = launder_p(E.outf); E.rsw = launder_p(E.rsw); E.xs = launder_p(E.xs);
            pg8::StaticOrder S; S.init(M, g.N, F.G, (int)blockIdx.x);
            if (t == 10) {
                pg8::Unit u_; for (int q = 0; S.next(q, u_); ++q) ffn_fix_panel(F, l, u_.pm);
                asm volatile("s_waitcnt vmcnt(0)" ::: "memory"); __syncthreads(); }
            pg8::gemm_phase<pg8::EpiResid, pg8::StaticOrder, true, true>(F.lds, g, S, E);
        }
        else if (t == 0) p0_prologue(F);
#ifdef C1_EXP
        else if (t == 3) { phase_mixers(F, l); phase_scan_c1<0>(F, l); phase_scan_c1<C1_EXP>(F, l); }
#else
        else if (t == 3) { phase_mixers(F, l); phase_scan_c1<0>(F, l); }
#endif
#ifdef C2_EXP
        else if (t == 4) { phase_scan_c2<0>(F, l); phase_scan_c2<C2_EXP>(F, l); }
#else
        else if (t == 4) phase_scan_c2<0>(F, l);
#endif
        else if (t == 5) phase_rwkv_post(F, l);
      }
#ifdef REPEAT_T
        if (step + 1 < hi) GRID_BAR();
#else
        if (ph + 1 < hi) GRID_BAR();
#endif
    }
    asm volatile("s_waitcnt vmcnt(0) lgkmcnt(0)" ::: "memory");
}


#ifdef DBG_CHECK
__global__ void dbg_check(const void* buf, size_t n, int kind, int code, unsigned* flag) {
    bool bad = false;
    for (size_t i = (size_t)blockIdx.x * blockDim.x + threadIdx.x; i < n; i += (size_t)gridDim.x * blockDim.x) {
        float v;
        if (kind == 0) v = bf2f(((const unsigned short*)buf)[i]);
        else if (kind == 1) v = ((const float*)buf)[i];
        else v = (float)((const _Float16*)buf)[i];
        if (!(fabsf(v) < 1e30f)) bad = true;
    }
    if (bad) atomicMax(flag, (unsigned)(1000000 - code));
}
__global__ void dbg_report(float* out, const unsigned* flag) { if (threadIdx.x == 0 && blockIdx.x == 0) { const unsigned f = *flag; if (f) out[0] = 100000.f * (float)(10 + 1000000 - (int)f); } }
#endif
extern "C" void kernel_launch(void* const* d_in, const int* in_sizes, int n_in, void* d_out, int out_size, void* d_ws, size_t ws_size, hipStream_t stream) {
    static int grid = 0;
    if (grid == 0) {
        if (n_in != 26 || in_sizes[0] != M * DM || out_size != M * DM || ws_size < WS_END) { fprintf(stderr, "kernel_launch: unexpected shapes: n_in %d in0 %d out %d ws %zu (need >= %zu)\n", n_in, n_in > 0 ? in_sizes[0] : -1, out_size, ws_size, (size_t)WS_END); grid = -1; return; }
        int dev = 0, cus = 0, per_cu = 0;
        if (hipGetDevice(&dev) != hipSuccess || hipDeviceGetAttribute(&cus, hipDeviceAttributeMultiprocessorCount, dev) != hipSuccess) { grid = -1; return; }
        if (hipFuncSetAttribute((const void*)enc_fwd, hipFuncAttributeMaxDynamicSharedMemorySize, LDS_BYTES) != hipSuccess) { fprintf(stderr, "kernel_launch: hipFuncSetAttribute failed\n"); grid = -1; return; }
        if (hipOccupancyMaxActiveBlocksPerMultiprocessor(&per_cu, (const void*)enc_fwd, NTHREADS, LDS_BYTES) != hipSuccess || per_cu < 1) { fprintf(stderr, "kernel_launch: occupancy query says %d blocks per CU\n", per_cu); }
        (void)hipGetLastError();
        grid = cus;
        if (grid != 256) fprintf(stderr, "kernel_launch: %d CUs (built for 256)\n", grid);
    }
    if (grid < 0) return;
    (void)hipMemsetAsync((char*)d_ws + WS_CTL, 0, CTL_ZERO_BYTES, stream);
    Args a{};
    for (int i = 0; i < 26; ++i) a.in[i] = (const float*)d_in[i];
    a.out = (float*)d_out; a.ws = (unsigned char*)d_ws;
#if MK_N_LAUNCHES == 1
#ifdef REPEAT_T
    a.ph_lo = 0; a.ph_hi = NPH + 2;
#else
    a.ph_lo = 0; a.ph_hi = NPH;
#endif
    hipLaunchKernelGGL(enc_fwd, dim3(grid), dim3(NTHREADS), LDS_BYTES, stream, a);
#else
    for (int p = 0; p < NPH; ++p) { a.ph_lo = p; a.ph_hi = p + 1; hipLaunchKernelGGL(enc_fwd, dim3(grid), dim3(NTHREADS), LDS_BYTES, stream, a);
#ifdef DBG_CHECK
        unsigned* flag = (unsigned*)((char*)d_ws + 512 * 1024); char* ws = (char*)d_ws; const int t = p == 0 ? 0 : 1 + (p - 1) % 10;
#define CHK(ptr, n, kind, sub) hipLaunchKernelGGL(dbg_check, dim3(2048), dim3(256), 0, stream, (const void*)(ptr), (size_t)(n), kind, p * 4 + sub, flag)
        if (t == 0) { CHK(ws + WS_W, 2 * W_LAYER / 2, 0, 0); CHK(ws + WS_XB, (size_t)M * DM, 0, 1); CHK(ws + WS_RS, M, 1, 2); }
        if (t == 1) { CHK(ws + WS_PROJ, (size_t)M * NPROJP, 0, 0); }
        if (t == 2) { CHK(ws + WS_PREP, (size_t)64 * MiB, 2, 1); }
        if (t == 3) { CHK(d_out, (size_t)2 * M * 256, 0, 0); }
        if (t == 4) { CHK(ws + WS_MERGED, (size_t)M * DM, 0, 0); }
        if (t == 5 || t == 9) { CHK(ws + WS_Y, (size_t)M * DM, 1, 0); CHK(ws + WS_PART, (size_t)M * 16, 1, 1); }
        if (t == 6 || t == 10) { CHK(d_out, (size_t)M * DM, 1, 0); CHK(ws + WS_XB, (size_t)M * DM, 0, 1); CHK(ws + WS_RS, M, 1, 2); }
        if (t == 7) { CHK(ws + WS_G, (size_t)M * DFF, 0, 0); CHK(ws + WS_L, (size_t)M * DFF, 0, 1); }
        if (t == 8) { CHK(ws + WS_L, (size_t)M * DFF, 0, 0); }
        if (p == NPH - 1) hipLaunchKernelGGL(dbg_report, dim3(1), dim3(64), 0, stream, (float*)d_out, (const unsigned*)flag);
#endif
    }
#endif
}
```
